# Optimizing an MI355X kernel written in HIP

```python
import math
import jax, jax.numpy as jnp
from jax import lax
import numpy as np

D_MODEL = 1024
BATCH = 2
SEQ = 8192
DEPTH = 1
DEC_BATCH = 8
DEC_SEQ = 16
PAST_LEN = 2048

CHUNK = 64
Q_BLOCK = 128
EPS = 1e-6
NEG_INF = -1e30
ROPE_THETA = 10000.0
MLA_HEADS = 8
Q_LORA = 768
KV_LORA = 512
QK_NOPE = 128
QK_ROPE = 64
V_HEAD = 128
MLA_SCALE = (QK_NOPE + QK_ROPE) ** -0.5
MLA_WIDTH = MLA_HEADS * V_HEAD
RET_HEADS = 4
RET_DK = 128
RET_DV = 256
RET_WIDTH = RET_HEADS * RET_DV
D_FF = 2816
CONV_W = 3
IN_SIZES = (Q_LORA, KV_LORA, QK_ROPE, RET_HEADS * RET_DK, RET_HEADS * RET_DK,
            RET_WIDTH, RET_WIDTH, D_MODEL, D_MODEL)
IN_WIDTH = Q_LORA + KV_LORA + QK_ROPE + 2 * RET_HEADS * RET_DK + 2 * RET_WIDTH + 2 * D_MODEL

kernel_name = "hybrid_mla_retention_convffn_stream_step"


def rms_norm(x, gain):
    xf = x.astype(jnp.float32)
    inv = lax.rsqrt(jnp.mean(xf * xf, axis=-1, keepdims=True) + EPS)
    return (xf * inv * gain.astype(jnp.float32)).astype(x.dtype)


def rope(x, pos):
    half = x.shape[-1] // 2
    freqs = ROPE_THETA ** (-jnp.arange(half, dtype=jnp.float32) / half)
    ang = pos.astype(jnp.float32)[:, None] * freqs[None, :]
    cos = jnp.cos(ang)[:, None, :]
    sin = jnp.sin(ang)[:, None, :]
    xf = x.astype(jnp.float32)
    x1, x2 = xf[..., :half], xf[..., half:]
    out = jnp.concatenate([x1 * cos - x2 * sin, x1 * sin + x2 * cos], axis=-1)
    return out.astype(x.dtype)


def retention_log_decay():
    return jnp.log1p(-(2.0 ** (-5.0 - jnp.arange(RET_HEADS, dtype=jnp.float32))))


def retention_chunk(q, k, v, S, lg):
    L = q.shape[1]
    idx = jnp.arange(L, dtype=jnp.float32)
    diff = idx[:, None] - idx[None, :]
    decay = jnp.where(diff[None] >= 0,
                      jnp.exp(jnp.maximum(diff, 0.0)[None] * lg[:, None, None]), 0.0)
    s = jnp.einsum('bihd,bjhd->bhij', q, k) * decay[None]
    inner = jnp.einsum('bhij,bjhe->bihe', s, v)
    q_dec = jnp.exp((idx + 1.0)[:, None] * lg[None, :])[None, :, :, None]
    cross = jnp.einsum('bihd,bhde->bihe', q, S) * q_dec
    k_dec = k * jnp.exp((L - 1.0 - idx)[:, None] * lg[None, :])[None, :, :, None]
    S_new = S * jnp.exp(L * lg)[None, :, None, None] + jnp.einsum('bjhd,bjhe->bhde', k_dec, v)
    return inner + cross, S_new


def head_group_norm(y, gain):
    mu = jnp.mean(y, axis=-1, keepdims=True)
    yc = y - mu
    var = jnp.mean(yc * yc, axis=-1, keepdims=True)
    return yc * lax.rsqrt(var + EPS) * gain.astype(jnp.float32)


def mla_expand(c_kv, w_kv_up, g_k_nope):
    B, T = c_kv.shape[:2]
    kv = (c_kv @ w_kv_up).reshape(B, T, MLA_HEADS, QK_NOPE + V_HEAD)
    return rms_norm(kv[..., :QK_NOPE], g_k_nope), kv[..., QK_NOPE:]


def mla_scores(qn, qp, k_nope, k_pe):
    s = jnp.einsum('bqhd,bkhd->bhqk', qn, k_nope) + jnp.einsum('bqhr,bkr->bhqk', qp, k_pe)
    return s.astype(jnp.float32) * MLA_SCALE


def mla_prompt_attention(q_nope, q_pe, k_nope, k_pe, v):
    B, T = q_nope.shape[:2]
    nb = T // Q_BLOCK
    qn = jnp.moveaxis(q_nope.reshape(B, nb, Q_BLOCK, MLA_HEADS, QK_NOPE), 1, 0)
    qp = jnp.moveaxis(q_pe.reshape(B, nb, Q_BLOCK, MLA_HEADS, QK_ROPE), 1, 0)
    k_chunk = jnp.arange(T) // CHUNK

    def block(args):
        qn_b, qp_b, i = args
        q_chunk = (i * Q_BLOCK + jnp.arange(Q_BLOCK)) // CHUNK
        s = mla_scores(qn_b, qp_b, k_nope, k_pe)
        s = jnp.where((k_chunk[None, :] <= q_chunk[:, None])[None, None], s, NEG_INF)
        p = jax.nn.softmax(s, axis=-1).astype(v.dtype)
        return jnp.einsum('bhqk,bkhd->bqhd', p, v)

    o = lax.map(block, (qn, qp, jnp.arange(nb)))
    return jnp.moveaxis(o, 0, 1).reshape(B, T, MLA_WIDTH)


def mla_sample_attention(q_nope, q_pe, k_nope, k_pe, v):
    B, T = q_nope.shape[:2]
    p = jax.nn.softmax(mla_scores(q_nope, q_pe, k_nope, k_pe), axis=-1).astype(v.dtype)
    return jnp.einsum('bhqk,bkhd->bqhd', p, v).reshape(B, T, MLA_WIDTH)


def hybrid_layer(x, pos, past, w):
    B, T, _ = x.shape
    h = rms_norm(x, w['g_norm_mix'])
    z = h @ w['w_in']
    offs = [int(o) for o in np.cumsum(IN_SIZES)[:-1]]
    q_lat, kv_lat, k_pe, rq, rk, rv, rg, ga, gb = jnp.split(z, offs, axis=-1)

    q = (rms_norm(q_lat, w['g_q_lat']) @ w['w_q_up']).reshape(B, T, MLA_HEADS, QK_NOPE + QK_ROPE)
    q_nope = rms_norm(q[..., :QK_NOPE], w['g_q_nope'])
    q_pe = rope(rms_norm(q[..., QK_NOPE:], w['g_q_rope']), pos)
    c_kv = rms_norm(kv_lat, w['g_kv_lat'])
    k_pe = rope(rms_norm(k_pe, w['g_k_rope'])[:, :, None, :], pos)[:, :, 0, :]
    if past is None:
        k_nope, v = mla_expand(c_kv, w['w_kv_up'], w['g_k_nope'])
        attn = mla_prompt_attention(q_nope, q_pe, k_nope, k_pe, v)
    else:
        lat_all = jnp.concatenate([past[0].astype(c_kv.dtype), c_kv], axis=1)
        pe_all = jnp.concatenate([past[1].astype(k_pe.dtype), k_pe], axis=1)
        k_nope, v = mla_expand(lat_all, w['w_kv_up'], w['g_k_nope'])
        attn = mla_sample_attention(q_nope, q_pe, k_nope, pe_all, v)

    lg = retention_log_decay()
    rq = rope(rq.reshape(B, T, RET_HEADS, RET_DK), pos).astype(jnp.float32)
    rk = rope(rk.reshape(B, T, RET_HEADS, RET_DK), pos).astype(jnp.float32) * (RET_DK ** -0.5)
    rv = rv.reshape(B, T, RET_HEADS, RET_DV).astype(jnp.float32)
    if past is None:
        nc = T // CHUNK

        def to_chunks(a):
            return jnp.swapaxes(a.reshape(B, nc, CHUNK, *a.shape[2:]), 0, 1)

        def step(S, xs):
            o, S = retention_chunk(xs[0], xs[1], xs[2], S, lg)
            return S, o

        S0 = jnp.zeros((B, RET_HEADS, RET_DK, RET_DV), jnp.float32)
        S_fin, o = lax.scan(step, S0, (to_chunks(rq), to_chunks(rk), to_chunks(rv)))
        ret = jnp.swapaxes(o, 0, 1).reshape(B, T, RET_HEADS, RET_DV)
    else:
        ret, S_fin = retention_chunk(rq, rk, rv, past[2].astype(jnp.float32), lg)
    ret = head_group_norm(ret, w['g_ret_out']).reshape(B, T, RET_WIDTH)
    ret = (jax.nn.silu(rg.astype(jnp.float32)) * ret).astype(x.dtype)

    a_d = attn @ w['w_o_branch'][:MLA_WIDTH]
    r_d = ret @ w['w_o_branch'][MLA_WIDTH:]
    merged = jax.nn.sigmoid(ga) * a_d + jax.nn.sigmoid(gb) * r_d
    x = x + merged @ w['w_out']

    u = rms_norm(x, w['g_norm_ffn']) @ w['w_ffn_up']
    if past is None:
        prev = jnp.zeros((B, CONV_W - 1, 2 * D_FF), u.dtype)
    else:
        prev = past[3].astype(u.dtype)
    up = jnp.concatenate([prev, u], axis=1)
    cw = w['ffn_conv_w']
    c = up[:, 0:T] * cw[0] + up[:, 1:T + 1] * cw[1] + up[:, 2:T + 2] * cw[2] + w['ffn_conv_b']
    gate, val = c[..., :D_FF], c[..., D_FF:]
    x = x + (jax.nn.silu(gate) * val) @ w['w_ffn_down']
    new_state = (c_kv, k_pe, S_fin.astype(x.dtype), up[:, -(CONV_W - 1):])
    return x, new_state


def setup_inputs(seed: int = 0) -> dict:
    key = jax.random.key(seed)
    ks = jax.random.split(key, 32)
    f32 = jnp.float32
    nrm = lambda k, shape, scale: jax.random.normal(k, shape, f32) * scale
    gain = lambda k, n: 1.0 + 0.1 * jax.random.normal(k, (DEPTH,) + n, f32)
    return {
        'x_prompt': nrm(ks[0], (BATCH, SEQ, D_MODEL), 1.0),
        'x_sample': nrm(ks[1], (DEC_BATCH, DEC_SEQ, D_MODEL), 1.0),
        'cache_mla_latent': nrm(ks[2], (DEPTH, DEC_BATCH, PAST_LEN, KV_LORA), 1.0),
        'cache_mla_rope_key': nrm(ks[3], (DEPTH, DEC_BATCH, PAST_LEN, QK_ROPE), 1.0),
        'state_retention': nrm(ks[4], (DEPTH, DEC_BATCH, RET_HEADS, RET_DK, RET_DV), 1.0),
        'state_ffn_conv': nrm(ks[5], (DEPTH, DEC_BATCH, CONV_W - 1, 2 * D_FF), 1.0),
        'g_norm_mix': gain(ks[6], (D_MODEL,)),
        'w_in': nrm(ks[7], (DEPTH, D_MODEL, IN_WIDTH), D_MODEL ** -0.5),
        'g_q_lat': gain(ks[8], (Q_LORA,)),
        'w_q_up': nrm(ks[9], (DEPTH, Q_LORA, MLA_HEADS * (QK_NOPE + QK_ROPE)), Q_LORA ** -0.5),
        'g_q_nope': gain(ks[10], (QK_NOPE,)),
        'g_q_rope': gain(ks[11], (QK_ROPE,)),
        'g_kv_lat': gain(ks[12], (KV_LORA,)),
        'w_kv_up': nrm(ks[13], (DEPTH, KV_LORA, MLA_HEADS * (QK_NOPE + V_HEAD)), KV_LORA ** -0.5),
        'g_k_nope': gain(ks[14], (QK_NOPE,)),
        'g_k_rope': gain(ks[15], (QK_ROPE,)),
        'g_ret_out': gain(ks[16], (RET_HEADS, RET_DV)),
        'w_o_branch': nrm(ks[17], (DEPTH, MLA_WIDTH + RET_WIDTH, D_MODEL), MLA_WIDTH ** -0.5),
        'w_out': nrm(ks[18], (DEPTH, D_MODEL, D_MODEL), D_MODEL ** -0.5),
        'g_norm_ffn': gain(ks[19], (D_MODEL,)),
        'w_ffn_up': nrm(ks[20], (DEPTH, D_MODEL, 2 * D_FF), D_MODEL ** -0.5),
        'ffn_conv_w': nrm(ks[21], (DEPTH, CONV_W, 2 * D_FF), CONV_W ** -0.5),
        'ffn_conv_b': nrm(ks[22], (DEPTH, 2 * D_FF), 0.01),
        'w_ffn_down': nrm(ks[23], (DEPTH, D_FF, D_MODEL), D_FF ** -0.5),
    }


def reference(x_prompt, x_sample, cache_mla_latent, cache_mla_rope_key, state_retention,
              state_ffn_conv, g_norm_mix, w_in, g_q_lat, w_q_up, g_q_nope, g_q_rope,
              g_kv_lat, w_kv_up, g_k_nope, g_k_rope, g_ret_out, w_o_branch, w_out,
              g_norm_ffn, w_ffn_up, ffn_conv_w, ffn_conv_b, w_ffn_down):
    pos_p = jnp.arange(x_prompt.shape[1])
    pos_s = PAST_LEN + jnp.arange(x_sample.shape[1])
    yp, ys = x_prompt, x_sample
    st_p, st_s = [], []
    for l in range(DEPTH):
        wl = dict(g_norm_mix=g_norm_mix[l], w_in=w_in[l], g_q_lat=g_q_lat[l], w_q_up=w_q_up[l],
                  g_q_nope=g_q_nope[l], g_q_rope=g_q_rope[l], g_kv_lat=g_kv_lat[l],
                  w_kv_up=w_kv_up[l], g_k_nope=g_k_nope[l], g_k_rope=g_k_rope[l],
                  g_ret_out=g_ret_out[l], w_o_branch=w_o_branch[l], w_out=w_out[l],
                  g_norm_ffn=g_norm_ffn[l], w_ffn_up=w_ffn_up[l], ffn_conv_w=ffn_conv_w[l],
                  ffn_conv_b=ffn_conv_b[l], w_ffn_down=w_ffn_down[l])
        yp, sp = hybrid_layer(yp, pos_p, None, wl)
        past = (cache_mla_latent[l], cache_mla_rope_key[l], state_retention[l], state_ffn_conv[l])
        ys, ss = hybrid_layer(ys, pos_s, past, wl)
        st_p.append(sp)
        st_s.append(ss)
    stk = lambda lst, i: jnp.stack([s[i] for s in lst], axis=0)
    return (yp, ys, stk(st_p, 0), stk(st_p, 1), stk(st_p, 2), stk(st_p, 3),
            stk(st_s, 0), stk(st_s, 1), stk(st_s, 2), stk(st_s, 3))
```

```cpp
#include <hip/hip_runtime.h>
#include <stdint.h>
#include <cstdio>

typedef unsigned short bf16_t;
typedef short bf16x8 __attribute__((ext_vector_type(8)));
typedef float f32x4 __attribute__((ext_vector_type(4)));
typedef unsigned u32x4 __attribute__((ext_vector_type(4)));

constexpr int D_MODEL = 1024, BATCH = 2, SEQ = 8192, DEC_BATCH = 8, DEC_SEQ = 16, PAST = 2048;
constexpr int MP = BATCH * SEQ, MS = DEC_BATCH * DEC_SEQ, MT = MP + MS;
constexpr int Q_LORA = 768, KV_LORA = 512, QK_NOPE = 128, QK_ROPE = 64, V_HEAD = 128, HEADS = 8;
constexpr int RET_H = 4, RET_DK = 128, RET_DV = 256;
constexpr int D_FF = 2816, FF2 = 2 * D_FF;
constexpr int IN_W = 6464;
constexpr int SKEYS = PAST + DEC_SEQ;
constexpr int LROWS = DEC_BATCH * SKEYS;
constexpr float EPS = 1e-6f;
constexpr int C_QLAT = 0, C_KVLAT = 768, C_KPE = 1280, C_RQ = 1344, C_RK = 1856, C_RV = 2368, C_RG = 3392, C_GA = 4416, C_GB = 5440;

constexpr size_t O_YP = 0, O_YS = 16777216, O_LATP = 16908288, O_RKP = 25296896, O_RETP = 26345472, O_CONVP = 26607616,
                 O_LATS = 26630144, O_RKS = 26695680, O_RETS = 26703872, O_CONVS = 27752448;

constexpr size_t MiB = 1u << 20, KiB = 1024;
constexpr size_t WS_SQ = 0, WS_SKV = 128 * KiB;
constexpr size_t WS_WUP = 1 * MiB, WS_WDOWN = 12 * MiB;
constexpr size_t WS_WIN = 19 * MiB, WS_WQUP = 32 * MiB, WS_WKVUP = 34 * MiB + 512 * KiB, WS_WKVUPN = 36 * MiB + 512 * KiB,
                 WS_WOBA = 38 * MiB + 512 * KiB, WS_WOBB = 40 * MiB + 512 * KiB, WS_WOUT = 42 * MiB + 512 * KiB,
                 WS_TAB32 = 44 * MiB + 512 * KiB, WS_TAB64 = 46 * MiB + 512 * KiB;
constexpr size_t WS_XN = 51 * MiB, WS_RET = 51 * MiB;
constexpr size_t WS_ZQ = 83 * MiB + 256 * KiB, WS_KVL = 107 * MiB + 512 * KiB, WS_KPE = 123 * MiB + 768 * KiB, WS_LATS = 126 * MiB, WS_PES = 142 * MiB + 256 * KiB;
constexpr size_t WS_RQ = 144 * MiB + 512 * KiB, WS_RK = 160 * MiB + 768 * KiB, WS_RV = 177 * MiB, WS_RG = 209 * MiB + 512 * KiB;
constexpr size_t WS_KN = 144 * MiB + 512 * KiB, WS_V = 177 * MiB, WS_ATT = 209 * MiB + 512 * KiB;
constexpr size_t WS_XN2 = 83 * MiB + 256 * KiB, WS_MERGED = 116 * MiB;
constexpr size_t WS_X1B = 19 * MiB, WS_U = 52 * MiB, WS_HALO = 232 * MiB;

__device__ __forceinline__ bf16_t f2bf(float f) { unsigned u = __float_as_uint(f); u = (u + 0x7fffu + ((u >> 16) & 1u)) >> 16; return (bf16_t)u; }
__device__ __forceinline__ float bf2f(bf16_t b) { return __uint_as_float(((unsigned)b) << 16); }
__device__ __forceinline__ float wave_sum(float v) {
#pragma unroll
    for (int o = 1; o < 64; o <<= 1) v += __shfl_xor(v, o);
    return v;
}
__device__ __forceinline__ float sigmoidf_(float x) { return 1.f / (1.f + __expf(-x)); }
__device__ __forceinline__ float siluf_(float x) { return x / (1.f + __expf(-x)); }

__global__ void k_convert_w(const float* __restrict__ W, int ldw, int K, int N, const float* __restrict__ gain, bf16_t* __restrict__ Wt) {
    __shared__ float tile[32][33];
    const int nb = N / 32, kb = blockIdx.x / nb, nbi = blockIdx.x % nb;
    const int tx = threadIdx.x & 31, ty = threadIdx.x >> 5;
    for (int i = ty; i < 32; i += 8) { const int k = kb * 32 + i; tile[i][tx] = W[(size_t)k * ldw + nbi * 32 + tx] * (gain ? gain[k] : 1.f); }
    __syncthreads();
    for (int i = ty; i < 32; i += 8) { const int n = nbi * 32 + i; Wt[(size_t)n * K + kb * 32 + tx] = f2bf(tile[tx][i]); }
}
__global__ void k_tables(float2* tab32, float2* tab64) {
    const int idx = blockIdx.x * blockDim.x + threadIdx.x;
    if (idx < 8192 * 32) { const int pos = idx / 32, i = idx % 32; const double f = pow(10000.0, -(double)i / 32.0), a = (double)pos * f; tab32[idx] = make_float2((float)cos(a), (float)sin(a)); }
    if (idx < 8192 * 64) { const int pos = idx / 64, i = idx % 64; const double f = pow(10000.0, -(double)i / 64.0), a = (double)pos * f; tab64[idx] = make_float2((float)cos(a), (float)sin(a)); }
}
__global__ void k_rownorm(const float* __restrict__ xa, const float* __restrict__ xb, bf16_t* __restrict__ out) {
    const int r = blockIdx.x * 4 + (threadIdx.x >> 6), lane = threadIdx.x & 63; if (r >= MT) return;
    const float* x = r < MP ? xa + (size_t)r * D_MODEL : xb + (size_t)(r - MP) * D_MODEL;
    f32x4 v[4]; float s = 0.f;
#pragma unroll
    for (int j = 0; j < 4; ++j) { v[j] = *(const f32x4*)(x + j * 256 + lane * 4); s += v[j][0] * v[j][0] + v[j][1] * v[j][1] + v[j][2] * v[j][2] + v[j][3] * v[j][3]; }
    const float inv = rsqrtf(wave_sum(s) * (1.f / D_MODEL) + EPS);
#pragma unroll
    for (int j = 0; j < 4; ++j) { bf16_t* o = out + (size_t)r * D_MODEL + j * 256 + lane * 4;
        o[0] = f2bf(v[j][0] * inv); o[1] = f2bf(v[j][1] * inv); o[2] = f2bf(v[j][2] * inv); o[3] = f2bf(v[j][3] * inv); }
}
__global__ void k_cache(const float* __restrict__ clat, const float* __restrict__ cpe, bf16_t* __restrict__ lats, bf16_t* __restrict__ pes) {
    const size_t idx = (size_t)blockIdx.x * blockDim.x + threadIdx.x;
    const size_t nlat = (size_t)DEC_BATCH * PAST * KV_LORA, npe = (size_t)DEC_BATCH * PAST * QK_ROPE;
    if (idx < nlat) { const int c = idx % KV_LORA; const size_t rj = idx / KV_LORA; const int j = rj % PAST, b = rj / PAST; lats[((size_t)b * SKEYS + j) * KV_LORA + c] = f2bf(clat[idx]); }
    if (idx < npe) { const int c = idx % QK_ROPE; const size_t rj = idx / QK_ROPE; const int j = rj % PAST, b = rj / PAST; pes[((size_t)b * SKEYS + j) * QK_ROPE + c] = f2bf(cpe[idx]); }
}

enum { EP_BF16 = 0, EP_SILU = 1, EP_SIGM = 2, EP_ROWSCALE = 3, EP_KVSPLIT = 4, EP_MUL = 5, EP_MULADD = 6, EP_RESID = 7, EP_RESID_INPLACE = 8 };
struct Epi {
    int mode; int ldo; bf16_t* o1; bf16_t* o2; const float* rs; const bf16_t* g; const float* xa; const float* xb; float* of;
};
__device__ __forceinline__ void epi_apply(const Epi& E, int r, int c, float v) {
    switch (E.mode) {
    case EP_BF16: E.o1[(size_t)r * E.ldo + c] = f2bf(v); break;
    case EP_SILU: E.o1[(size_t)r * E.ldo + c] = f2bf(siluf_(v)); break;
    case EP_SIGM: E.o1[(size_t)r * E.ldo + c] = f2bf(sigmoidf_(v)); break;
    case EP_ROWSCALE: E.o1[(size_t)r * E.ldo + c] = f2bf(v * E.rs[r]); break;
    case EP_KVSPLIT: { const int h = c >> 8, j = c & 255; const float s = E.rs ? E.rs[r] : 1.f;
        if (j < 128) E.o1[(size_t)r * 1024 + h * 128 + j] = f2bf(v * s); else E.o2[(size_t)r * 1024 + h * 128 + (j - 128)] = f2bf(v * s); } break;
    case EP_MUL: E.o1[(size_t)r * E.ldo + c] = f2bf(v * bf2f(E.g[(size_t)r * E.ldo + c])); break;
    case EP_MULADD: { const size_t i = (size_t)r * E.ldo + c; E.o1[i] = f2bf(bf2f(E.o1[i]) + v * bf2f(E.g[i])); } break;
    case EP_RESID: { const float x = r < MP ? E.xa[(size_t)r * D_MODEL + c] : E.xb[(size_t)(r - MP) * D_MODEL + c]; E.of[(size_t)r * D_MODEL + c] = x + v; } break;
    case EP_RESID_INPLACE: { const size_t i = (size_t)r * D_MODEL + c; E.of[i] = E.of[i] + v; } break;
    }
}
__global__ void __launch_bounds__(256) k_gemm(const bf16_t* __restrict__ A, int lda, const bf16_t* __restrict__ Bt, int K, int M, int N, Epi E) {
    __shared__ bf16_t As[64][72], Bs[64][72];
    const int nbn = N / 64, bm = blockIdx.x / nbn, bn = blockIdx.x % nbn;
    const int tid = threadIdx.x, w = tid >> 6, lane = tid & 63, fr = lane & 15, fq = lane >> 4;
    f32x4 acc[4] = {};
    const int lr = tid >> 2, lc = (tid & 3) * 16;
    for (int k0 = 0; k0 < K; k0 += 64) {
        const int ar = bm * 64 + lr;
        bf16x8 a0 = {}, a1 = {};
        if (ar < M) { a0 = *(const bf16x8*)(A + (size_t)ar * lda + k0 + lc); a1 = *(const bf16x8*)(A + (size_t)ar * lda + k0 + lc + 8); }
        const bf16x8 b0 = *(const bf16x8*)(Bt + (size_t)(bn * 64 + lr) * K + k0 + lc), b1 = *(const bf16x8*)(Bt + (size_t)(bn * 64 + lr) * K + k0 + lc + 8);
        __syncthreads();
        *(bf16x8*)&As[lr][lc] = a0; *(bf16x8*)&As[lr][lc + 8] = a1; *(bf16x8*)&Bs[lr][lc] = b0; *(bf16x8*)&Bs[lr][lc + 8] = b1;
        __syncthreads();
#pragma unroll
        for (int ks = 0; ks < 2; ++ks) {
            const bf16x8 af = *(const bf16x8*)&As[w * 16 + fr][ks * 32 + fq * 8];
#pragma unroll
            for (int n = 0; n < 4; ++n) { const bf16x8 bfr = *(const bf16x8*)&Bs[n * 16 + fr][ks * 32 + fq * 8];
                acc[n] = __builtin_amdgcn_mfma_f32_16x16x32_bf16(af, bfr, acc[n], 0, 0, 0); }
        }
    }
#pragma unroll
    for (int n = 0; n < 4; ++n)
#pragma unroll
        for (int i = 0; i < 4; ++i) { const int r = bm * 64 + w * 16 + fq * 4 + i, c = bn * 64 + n * 16 + fr; if (r < M) epi_apply(E, r, c, acc[n][i]); }
}

__global__ void k_zq_finish(const bf16_t* __restrict__ zq, float* __restrict__ sq) {
    const int r = blockIdx.x * 4 + (threadIdx.x >> 6), lane = threadIdx.x & 63; if (r >= MT) return;
    float s = 0.f; for (int c = lane; c < Q_LORA; c += 64) { const float v = bf2f(zq[(size_t)r * Q_LORA + c]); s += v * v; }
    s = wave_sum(s); if (lane == 0) sq[r] = rsqrtf(s * (1.f / Q_LORA) + EPS);
}
__global__ void k_kvl_finish(const bf16_t* __restrict__ kvl, const float* __restrict__ g, float* __restrict__ skv, float* __restrict__ dout, bf16_t* __restrict__ lats) {
    const int r = blockIdx.x * 4 + (threadIdx.x >> 6), lane = threadIdx.x & 63; if (r >= MT) return;
    float v[8]; float s = 0.f;
#pragma unroll
    for (int j = 0; j < 8; ++j) { v[j] = bf2f(kvl[(size_t)r * KV_LORA + j * 64 + lane]); s += v[j] * v[j]; }
    const float inv = rsqrtf(wave_sum(s) * (1.f / KV_LORA) + EPS); if (lane == 0) skv[r] = inv;
    float* o = r < MP ? dout + O_LATP + (size_t)r * KV_LORA : dout + O_LATS + (size_t)(r - MP) * KV_LORA;
#pragma unroll
    for (int j = 0; j < 8; ++j) { const int c = j * 64 + lane; const float y = v[j] * inv * g[c]; o[c] = y;
        if (r >= MP) { const int rs = r - MP, b = rs / DEC_SEQ, t = rs % DEC_SEQ; lats[((size_t)b * SKEYS + PAST + t) * KV_LORA + c] = f2bf(y); } }
}
__global__ void k_kpe_finish(const bf16_t* __restrict__ raw, const float* __restrict__ g, const float2* __restrict__ tab32, bf16_t* __restrict__ kpe, float* __restrict__ dout, bf16_t* __restrict__ pes) {
    const int r = blockIdx.x * 4 + (threadIdx.x >> 6), lane = threadIdx.x & 63; if (r >= MT) return;
    const float v = bf2f(raw[(size_t)r * 64 + lane]); const float inv = rsqrtf(wave_sum(v * v) * (1.f / 64.f) + EPS);
    const float y = v * inv * g[lane]; const float yo = __shfl_xor(y, 32);
    const int pos = r < MP ? (r % SEQ) : PAST + ((r - MP) % DEC_SEQ);
    const float2 cs = tab32[pos * 32 + (lane & 31)];
    const float o = lane < 32 ? y * cs.x - yo * cs.y : yo * cs.y + y * cs.x;
    kpe[(size_t)r * 64 + lane] = f2bf(o);
    if (r < MP) dout[O_RKP + (size_t)r * 64 + lane] = o;
    else { const int rs = r - MP, b = rs / DEC_SEQ, t = rs % DEC_SEQ; dout[O_RKS + (size_t)rs * 64 + lane] = o; pes[((size_t)b * SKEYS + PAST + t) * 64 + lane] = f2bf(o); }
}
__global__ void k_rope_r(bf16_t* __restrict__ buf, const float2* __restrict__ tab64, float scale) {
    const int r = blockIdx.x, tid = threadIdx.x;
    const int h = tid >> 6, i = tid & 63; const int pos = r < MP ? (r % SEQ) : PAST + ((r - MP) % DEC_SEQ);
    bf16_t* p = buf + (size_t)r * 512 + h * 128; const float x1 = bf2f(p[i]), x2 = bf2f(p[i + 64]); const float2 cs = tab64[pos * 64 + i];
    p[i] = f2bf((x1 * cs.x - x2 * cs.y) * scale); p[i + 64] = f2bf((x1 * cs.y + x2 * cs.x) * scale);
}
__global__ void k_q_finish(bf16_t* __restrict__ q, const float* __restrict__ gn, const float* __restrict__ gr, const float2* __restrict__ tab32, float c2) {
    const int r = blockIdx.x * 4 + (threadIdx.x >> 6), lane = threadIdx.x & 63; if (r >= MT) return;
    const int pos = r < MP ? (r % SEQ) : PAST + ((r - MP) % DEC_SEQ);
    for (int h = 0; h < HEADS; ++h) {
        bf16_t* p = q + (size_t)r * 1536 + h * 192;
        const float a = bf2f(p[lane]), b = bf2f(p[lane + 64]), c = bf2f(p[128 + lane]);
        const float in = rsqrtf(wave_sum(a * a + b * b) * (1.f / 128.f) + EPS), ir = rsqrtf(wave_sum(c * c) * (1.f / 64.f) + EPS);
        p[lane] = f2bf(a * in * gn[lane] * c2); p[lane + 64] = f2bf(b * in * gn[lane + 64] * c2);
        const float y = c * ir * gr[lane], yo = __shfl_xor(y, 32); const float2 cs = tab32[pos * 32 + (lane & 31)];
        p[128 + lane] = f2bf((lane < 32 ? y * cs.x - yo * cs.y : yo * cs.y + y * cs.x) * c2);
    }
}
__global__ void k_kn_finish(bf16_t* __restrict__ kn, const float* __restrict__ g, int rows) {
    const int r = blockIdx.x * 4 + (threadIdx.x >> 6), lane = threadIdx.x & 63; if (r >= rows) return;
    for (int h = 0; h < HEADS; ++h) { bf16_t* p = kn + (size_t)r * 1024 + h * 128; const float a = bf2f(p[lane]), b = bf2f(p[lane + 64]);
        const float in = rsqrtf(wave_sum(a * a + b * b) * (1.f / 128.f) + EPS); p[lane] = f2bf(a * in * g[lane]); p[lane + 64] = f2bf(b * in * g[lane + 64]); }
}
__global__ void k_ret_finish(bf16_t* __restrict__ ret, const float* __restrict__ g, const bf16_t* __restrict__ gate) {
    const int r = blockIdx.x * 4 + (threadIdx.x >> 6), lane = threadIdx.x & 63; if (r >= MT) return;
    for (int h = 0; h < RET_H; ++h) { bf16_t* p = ret + (size_t)r * 1024 + h * 256; float v[4]; float s = 0.f;
#pragma unroll
        for (int j = 0; j < 4; ++j) { v[j] = bf2f(p[j * 64 + lane]); s += v[j]; }
        const float mu = wave_sum(s) * (1.f / 256.f); float q = 0.f;
#pragma unroll
        for (int j = 0; j < 4; ++j) { v[j] -= mu; q += v[j] * v[j]; }
        const float inv = rsqrtf(wave_sum(q) * (1.f / 256.f) + EPS);
#pragma unroll
        for (int j = 0; j < 4; ++j) { const int c = h * 256 + j * 64 + lane; p[j * 64 + lane] = f2bf(v[j] * inv * g[c] * bf2f(gate[(size_t)r * 1024 + c])); } }
}
__global__ void k_x1_finish(const float* __restrict__ x1, bf16_t* __restrict__ out) {
    const int r = blockIdx.x * 4 + (threadIdx.x >> 6), lane = threadIdx.x & 63; if (r >= MT) return;
    const float* x = x1 + (size_t)r * D_MODEL; f32x4 v[4]; float s = 0.f;
#pragma unroll
    for (int j = 0; j < 4; ++j) { v[j] = *(const f32x4*)(x + j * 256 + lane * 4); s += v[j][0] * v[j][0] + v[j][1] * v[j][1] + v[j][2] * v[j][2] + v[j][3] * v[j][3]; }
    const float inv = rsqrtf(wave_sum(s) * (1.f / D_MODEL) + EPS);
#pragma unroll
    for (int j = 0; j < 4; ++j) { bf16_t* o = out + (size_t)r * D_MODEL + j * 256 + lane * 4;
        o[0] = f2bf(v[j][0] * inv); o[1] = f2bf(v[j][1] * inv); o[2] = f2bf(v[j][2] * inv); o[3] = f2bf(v[j][3] * inv); }
}

template <int NW>
__global__ void __launch_bounds__(NW * 64) k_attn(const bf16_t* __restrict__ Q, const bf16_t* __restrict__ KN, const bf16_t* __restrict__ KPE, const bf16_t* __restrict__ V,
                                                 bf16_t* __restrict__ att, int sample) {
    __shared__ bf16_t Ks[64][200]; __shared__ bf16_t Vt[128][72]; __shared__ bf16_t Ps[NW][16][72];
    const int tid = threadIdx.x, w = tid >> 6, lane = tid & 63, fr = lane & 15, fq = lane >> 4;
    int b, h, qrow0, krow0, nkeys;
    if (!sample) { const int c = blockIdx.x % 128, bh = blockIdx.x / 128; h = bh % HEADS; b = bh / HEADS; qrow0 = b * SEQ + c * 64 + w * 16; krow0 = b * SEQ; nkeys = (c + 1) * 64; }
    else { h = blockIdx.x % HEADS; b = blockIdx.x / HEADS; qrow0 = MP + b * DEC_SEQ; krow0 = b * SKEYS; nkeys = SKEYS; }
    bf16x8 qf[6];
#pragma unroll
    for (int s = 0; s < 6; ++s) qf[s] = *(const bf16x8*)(Q + (size_t)(qrow0 + fr) * 1536 + h * 192 + s * 32 + fq * 8);
    f32x4 o[8] = {}; float m[4], l[4];
#pragma unroll
    for (int i = 0; i < 4; ++i) { m[i] = -1e30f; l[i] = 0.f; }
    const int ntile = (nkeys + 63) / 64;
    for (int t = 0; t < ntile; ++t) {
        __syncthreads();
        for (int idx = tid; idx < 64 * 24; idx += NW * 64) { const int key = idx / 24, ch = idx % 24; const int kg = t * 64 + key; bf16x8 v = {};
            if (kg < nkeys) { if (ch < 16) v = *(const bf16x8*)(KN + (size_t)(krow0 + kg) * 1024 + h * 128 + ch * 8); else v = *(const bf16x8*)(KPE + (size_t)(krow0 + kg) * 64 + (ch - 16) * 8); }
            *(bf16x8*)&Ks[key][ch * 8] = v; }
        for (int idx = tid; idx < 64 * 16; idx += NW * 64) { const int key = idx / 16, ch = idx % 16; const int kg = t * 64 + key; bf16x8 v = {};
            if (kg < nkeys) v = *(const bf16x8*)(V + (size_t)(krow0 + kg) * 1024 + h * 128 + ch * 8);
#pragma unroll
            for (int e = 0; e < 8; ++e) Vt[ch * 8 + e][key] = (bf16_t)v[e]; }
        __syncthreads();
        f32x4 s[4] = {};
#pragma unroll
        for (int ks = 0; ks < 6; ++ks)
#pragma unroll
            for (int n = 0; n < 4; ++n) { const bf16x8 kf = *(const bf16x8*)&Ks[n * 16 + fr][ks * 32 + fq * 8]; s[n] = __builtin_amdgcn_mfma_f32_16x16x32_bf16(qf[ks], kf, s[n], 0, 0, 0); }
#pragma unroll
        for (int n = 0; n < 4; ++n) if (t * 64 + n * 16 + fr >= nkeys) { s[n][0] = -INFINITY; s[n][1] = -INFINITY; s[n][2] = -INFINITY; s[n][3] = -INFINITY; }
        float alpha[4];
#pragma unroll
        for (int i = 0; i < 4; ++i) { float mx = fmaxf(fmaxf(s[0][i], s[1][i]), fmaxf(s[2][i], s[3][i]));
            mx = fmaxf(mx, __shfl_xor(mx, 1)); mx = fmaxf(mx, __shfl_xor(mx, 2)); mx = fmaxf(mx, __shfl_xor(mx, 4)); mx = fmaxf(mx, __shfl_xor(mx, 8));
            const float mn = fmaxf(m[i], mx); alpha[i] = exp2f(m[i] - mn); m[i] = mn; float ps = 0.f;
#pragma unroll
            for (int n = 0; n < 4; ++n) { const float p = exp2f(s[n][i] - mn); s[n][i] = p; ps += p; }
            ps += __shfl_xor(ps, 1); ps += __shfl_xor(ps, 2); ps += __shfl_xor(ps, 4); ps += __shfl_xor(ps, 8);
            l[i] = l[i] * alpha[i] + ps; }
#pragma unroll
        for (int n = 0; n < 4; ++n)
#pragma unroll
            for (int i = 0; i < 4; ++i) Ps[w][fq * 4 + i][n * 16 + fr] = f2bf(s[n][i]);
#pragma unroll
        for (int n = 0; n < 8; ++n)
#pragma unroll
            for (int i = 0; i < 4; ++i) o[n][i] *= alpha[i];
#pragma unroll
        for (int ks = 0; ks < 2; ++ks) { const bf16x8 pf = *(const bf16x8*)&Ps[w][fr][ks * 32 + fq * 8];
#pragma unroll
            for (int n = 0; n < 8; ++n) { const bf16x8 vf = *(const bf16x8*)&Vt[n * 16 + fr][ks * 32 + fq * 8]; o[n] = __builtin_amdgcn_mfma_f32_16x16x32_bf16(pf, vf, o[n], 0, 0, 0); } }
    }
#pragma unroll
    for (int i = 0; i < 4; ++i) { const float rl = 1.f / l[i]; const int r = qrow0 + fq * 4 + i;
#pragma unroll
        for (int n = 0; n < 8; ++n) att[(size_t)r * 1024 + h * 128 + n * 16 + fr] = f2bf(o[n][i] * rl); }
}

__global__ void __launch_bounds__(256) k_ret(const bf16_t* __restrict__ rq, const bf16_t* __restrict__ rk, const bf16_t* __restrict__ rv, int rowbase, int rows_per_batch, int L, int nch,
                                             const float* __restrict__ Sinit, bf16_t* __restrict__ retraw, float* __restrict__ Sout) {
    extern __shared__ float sm[];
    float* qs = sm;
    float* ks = qs + 64 * 129;
    float* Ss = ks + 64 * 129;
    float* vs = Ss + 128 * 33;
    float* sc = vs + 64 * 33;
    const int tid = threadIdx.x; const int sl = blockIdx.x % 8, h = (blockIdx.x / 8) % RET_H, b = blockIdx.x / 32;
    const float gam = 1.f - exp2f(-5.f - (float)h), lg2 = log2f(gam);
    for (int i = tid; i < 128 * 32; i += 256) { const int d = i / 32, e = i % 32; Ss[d * 33 + e] = Sinit ? Sinit[(((size_t)b * RET_H + h) * RET_DK + d) * RET_DV + sl * 32 + e] : 0.f; }
    const float gL = exp2f(lg2 * (float)L);
    for (int c = 0; c < nch; ++c) {
        const size_t r0 = (size_t)rowbase + (size_t)b * rows_per_batch + (size_t)c * L;
        __syncthreads();
        for (int i = tid; i < L * 128; i += 256) { const int j = i / 128, d = i % 128; qs[j * 129 + d] = bf2f(rq[(r0 + j) * 512 + h * 128 + d]); ks[j * 129 + d] = bf2f(rk[(r0 + j) * 512 + h * 128 + d]); }
        for (int i = tid; i < L * 32; i += 256) { const int j = i / 32, e = i % 32; vs[j * 33 + e] = bf2f(rv[(r0 + j) * 1024 + h * 256 + sl * 32 + e]); }
        __syncthreads();
        for (int p = tid; p < L * L; p += 256) { const int i = p / L, j = p % L; float s = 0.f;
            if (j <= i) { for (int d = 0; d < 128; ++d) s += qs[i * 129 + d] * ks[j * 129 + d]; s *= exp2f(lg2 * (float)(i - j)); }
            sc[i * 65 + j] = s; }
        __syncthreads();
        for (int p = tid; p < L * 32; p += 256) { const int i = p / 32, e = p % 32; float a = 0.f, cr = 0.f;
            for (int j = 0; j <= i; ++j) a += sc[i * 65 + j] * vs[j * 33 + e];
            for (int d = 0; d < 128; ++d) cr += qs[i * 129 + d] * Ss[d * 33 + e];
            retraw[(r0 + i) * 1024 + h * 256 + sl * 32 + e] = f2bf(a + cr * exp2f(lg2 * (float)(i + 1))); }
        __syncthreads();
        for (int p = tid; p < 128 * 32; p += 256) { const int d = p / 32, e = p % 32; float a = Ss[d * 33 + e] * gL;
            for (int j = 0; j < L; ++j) a += ks[j * 129 + d] * exp2f(lg2 * (float)(L - 1 - j)) * vs[j * 33 + e];
            Ss[d * 33 + e] = a; }
    }
    __syncthreads();
    for (int i = tid; i < 128 * 32; i += 256) { const int d = i / 32, e = i % 32; Sout[(((size_t)b * RET_H + h) * RET_DK + d) * RET_DV + sl * 32 + e] = Ss[d * 33 + e]; }
}

__global__ void k_halo(const bf16_t* __restrict__ U, const float* __restrict__ prev_s, bf16_t* __restrict__ halo) {
    const int ch = blockIdx.x; const int tid = threadIdx.x;
    for (int i = tid; i < 2 * FF2; i += 256) { const int k = i / FF2, n = i % FF2; float v = 0.f;
        if (ch < 64) { const int r0 = ch * 256; if ((r0 % SEQ) != 0) v = bf2f(U[(size_t)(r0 - 2 + k) * FF2 + n]); }
        else { const int b = ch - 64; v = prev_s[((size_t)b * 2 + k) * FF2 + n]; }
        halo[(size_t)ch * 2 * FF2 + i] = f2bf(v); }
}
__global__ void __launch_bounds__(256) k_conv(bf16_t* __restrict__ U, const bf16_t* __restrict__ halo, const float* __restrict__ cw, const float* __restrict__ cb) {
    const int ch = blockIdx.x / 11, strip = blockIdx.x % 11; const int n = strip * 256 + threadIdx.x;
    int r0, nr; if (ch < 64) { r0 = ch * 256; nr = 256; } else { r0 = MP + (ch - 64) * DEC_SEQ; nr = DEC_SEQ; }
    const int nv = n + D_FF;
    const float wg0 = cw[n], wg1 = cw[FF2 + n], wg2 = cw[2 * FF2 + n], bg = cb[n], wv0 = cw[nv], wv1 = cw[FF2 + nv], wv2 = cw[2 * FF2 + nv], bv = cb[nv];
    float g2 = bf2f(halo[(size_t)ch * 2 * FF2 + n]), g1 = bf2f(halo[(size_t)ch * 2 * FF2 + FF2 + n]);
    float v2 = bf2f(halo[(size_t)ch * 2 * FF2 + nv]), v1 = bf2f(halo[(size_t)ch * 2 * FF2 + FF2 + nv]);
    for (int i = 0; i < nr; ++i) { bf16_t* row = U + (size_t)(r0 + i) * FF2; const float g0 = bf2f(row[n]), v0 = bf2f(row[nv]);
        const float cg = g2 * wg0 + g1 * wg1 + g0 * wg2 + bg, cv = v2 * wv0 + v1 * wv1 + v0 * wv2 + bv;
        row[n] = f2bf(siluf_(cg) * cv); g2 = g1; g1 = g0; v2 = v1; v1 = v0; }
}
__global__ void k_convout(const bf16_t* __restrict__ U, float* __restrict__ dout) {
    const int idx = blockIdx.x * blockDim.x + threadIdx.x;
    if (idx < BATCH * 2 * FF2) { const int n = idx % FF2, k = (idx / FF2) % 2, b = idx / (2 * FF2); dout[O_CONVP + idx] = bf2f(U[(size_t)(b * SEQ + SEQ - 2 + k) * FF2 + n]); }
    if (idx < DEC_BATCH * 2 * FF2) { const int n = idx % FF2, k = (idx / FF2) % 2, b = idx / (2 * FF2); dout[O_CONVS + idx] = bf2f(U[(size_t)(MP + b * DEC_SEQ + DEC_SEQ - 2 + k) * FF2 + n]); }
}

static void gemm(hipStream_t s, const bf16_t* A, int lda, const bf16_t* Bt, int K, int M, int N, const Epi& E) {
    const int nb = ((M + 63) / 64) * (N / 64);
    hipLaunchKernelGGL(k_gemm, dim3(nb), dim3(256), 0, s, A, lda, Bt, K, M, N, E);
}
static Epi mkepi(int mode, bf16_t* o1, int ldo) { Epi e{}; e.mode = mode; e.o1 = o1; e.ldo = ldo; return e; }

extern "C" void kernel_launch(void* const* d_in, const int* in_sizes, int n_in, void* d_out, int out_size, void* d_ws, size_t ws_size, hipStream_t stream) {
    const float* x_p = (const float*)d_in[0]; const float* x_s = (const float*)d_in[1];
    const float* c_lat = (const float*)d_in[2]; const float* c_pe = (const float*)d_in[3]; const float* st_ret = (const float*)d_in[4]; const float* st_conv = (const float*)d_in[5];
    const float* g_mix = (const float*)d_in[6]; const float* w_in = (const float*)d_in[7]; const float* g_qlat = (const float*)d_in[8]; const float* w_qup = (const float*)d_in[9];
    const float* g_qn = (const float*)d_in[10]; const float* g_qr = (const float*)d_in[11]; const float* g_kvlat = (const float*)d_in[12]; const float* w_kvup = (const float*)d_in[13];
    const float* g_kn = (const float*)d_in[14]; const float* g_kr = (const float*)d_in[15]; const float* g_ret = (const float*)d_in[16]; const float* w_ob = (const float*)d_in[17];
    const float* w_out = (const float*)d_in[18]; const float* g_ffn = (const float*)d_in[19]; const float* w_up = (const float*)d_in[20]; const float* cw = (const float*)d_in[21];
    const float* cb = (const float*)d_in[22]; const float* w_down = (const float*)d_in[23];
    float* out = (float*)d_out; char* ws = (char*)d_ws;
    if (ws_size < 256 * MiB) { fprintf(stderr, "ws too small: %zu\n", ws_size); return; }
#define WSB(off) ((bf16_t*)(ws + (off)))
    float* SQ = (float*)(ws + WS_SQ); float* SKV = (float*)(ws + WS_SKV);
    float2* TAB32 = (float2*)(ws + WS_TAB32); float2* TAB64 = (float2*)(ws + WS_TAB64);
    static bool attr_done = false;
    if (!attr_done) { hipFuncSetAttribute((const void*)k_ret, hipFuncAttributeMaxDynamicSharedMemorySize, 110 * 1024); attr_done = true; }

    auto conv = [&](const float* W, int ldw, int K, int N, const float* gain, size_t off) { hipLaunchKernelGGL(k_convert_w, dim3((K / 32) * (N / 32)), dim3(256), 0, stream, W, ldw, K, N, gain, WSB(off)); };
    conv(w_in, IN_W, 1024, IN_W, g_mix, WS_WIN);
    conv(w_qup, 1536, 768, 1536, g_qlat, WS_WQUP);
    conv(w_kvup, 2048, 512, 2048, g_kvlat, WS_WKVUP);
    conv(w_kvup, 2048, 512, 2048, nullptr, WS_WKVUPN);
    conv(w_ob, 1024, 1024, 1024, nullptr, WS_WOBA);
    conv(w_ob + (size_t)1024 * 1024, 1024, 1024, 1024, nullptr, WS_WOBB);
    conv(w_out, 1024, 1024, 1024, nullptr, WS_WOUT);
    conv(w_up, FF2, 1024, FF2, g_ffn, WS_WUP);
    conv(w_down, 1024, D_FF, 1024, nullptr, WS_WDOWN);
    hipLaunchKernelGGL(k_tables, dim3(8192 * 64 / 256), dim3(256), 0, stream, TAB32, TAB64);
    hipLaunchKernelGGL(k_rownorm, dim3(MT / 4), dim3(256), 0, stream, x_p, x_s, WSB(WS_XN));
    hipLaunchKernelGGL(k_cache, dim3((DEC_BATCH * PAST * KV_LORA) / 256), dim3(256), 0, stream, c_lat, c_pe, WSB(WS_LATS), WSB(WS_PES));

    const bf16_t* XN = WSB(WS_XN); const bf16_t* WIN = WSB(WS_WIN);
    gemm(stream, XN, 1024, WIN + (size_t)C_QLAT * 1024, 1024, MT, 768, mkepi(EP_BF16, WSB(WS_ZQ), 768));
    gemm(stream, XN, 1024, WIN + (size_t)C_KVLAT * 1024, 1024, MT, 512, mkepi(EP_BF16, WSB(WS_KVL), 512));
    gemm(stream, XN, 1024, WIN + (size_t)C_KPE * 1024, 1024, MT, 64, mkepi(EP_BF16, WSB(WS_KPE), 64));
    gemm(stream, XN, 1024, WIN + (size_t)C_RQ * 1024, 1024, MT, 512, mkepi(EP_BF16, WSB(WS_RQ), 512));
    gemm(stream, XN, 1024, WIN + (size_t)C_RK * 1024, 1024, MT, 512, mkepi(EP_BF16, WSB(WS_RK), 512));
    gemm(stream, XN, 1024, WIN + (size_t)C_RV * 1024, 1024, MT, 1024, mkepi(EP_BF16, WSB(WS_RV), 1024));
    gemm(stream, XN, 1024, WIN + (size_t)C_RG * 1024, 1024, MT, 1024, mkepi(EP_SILU, WSB(WS_RG), 1024));
    hipLaunchKernelGGL(k_zq_finish, dim3(MT / 4), dim3(256), 0, stream, WSB(WS_ZQ), SQ);
    hipLaunchKernelGGL(k_kvl_finish, dim3(MT / 4), dim3(256), 0, stream, WSB(WS_KVL), g_kvlat, SKV, out, WSB(WS_LATS));
    hipLaunchKernelGGL(k_kpe_finish, dim3(MT / 4), dim3(256), 0, stream, WSB(WS_KPE), g_kr, TAB32, WSB(WS_KPE), out, WSB(WS_PES));
    hipLaunchKernelGGL(k_rope_r, dim3(MT), dim3(256), 0, stream, WSB(WS_RQ), TAB64, 1.0f);
    hipLaunchKernelGGL(k_rope_r, dim3(MT), dim3(256), 0, stream, WSB(WS_RK), TAB64, 0.08838834764831845f);

    const size_t ret_lds = (size_t)(64 * 129 * 2 + 128 * 33 + 64 * 33 + 64 * 65) * 4;
    hipLaunchKernelGGL(k_ret, dim3(BATCH * RET_H * 8), dim3(256), ret_lds, stream, WSB(WS_RQ), WSB(WS_RK), WSB(WS_RV), 0, SEQ, 64, SEQ / 64, (const float*)nullptr, WSB(WS_RET), out + O_RETP);
    hipLaunchKernelGGL(k_ret, dim3(DEC_BATCH * RET_H * 8), dim3(256), ret_lds, stream, WSB(WS_RQ), WSB(WS_RK), WSB(WS_RV), MP, DEC_SEQ, DEC_SEQ, 1, st_ret, WSB(WS_RET), out + O_RETS);
    hipLaunchKernelGGL(k_ret_finish, dim3(MT / 4), dim3(256), 0, stream, WSB(WS_RET), g_ret, WSB(WS_RG));

    bf16_t* Qb = (bf16_t*)out;
    { Epi e = mkepi(EP_ROWSCALE, Qb, 1536); e.rs = SQ; gemm(stream, WSB(WS_ZQ), 768, WSB(WS_WQUP), 768, MT, 1536, e); }
    const float C2 = 0.07216878364870323f * 1.4426950408889634f;
    hipLaunchKernelGGL(k_q_finish, dim3(MT / 4), dim3(256), 0, stream, Qb, g_qn, g_qr, TAB32, C2);

    { Epi e = mkepi(EP_KVSPLIT, WSB(WS_KN), 0); e.o2 = WSB(WS_V); e.rs = nullptr; gemm(stream, WSB(WS_LATS), 512, WSB(WS_WKVUPN), 512, LROWS, 2048, e); }
    hipLaunchKernelGGL(k_kn_finish, dim3(LROWS / 4), dim3(256), 0, stream, WSB(WS_KN), g_kn, LROWS);
    hipLaunchKernelGGL(k_attn<1>, dim3(DEC_BATCH * HEADS), dim3(64), 0, stream, Qb, WSB(WS_KN), WSB(WS_PES), WSB(WS_V), WSB(WS_ATT), 1);
    { Epi e = mkepi(EP_KVSPLIT, WSB(WS_KN), 0); e.o2 = WSB(WS_V); e.rs = SKV; gemm(stream, WSB(WS_KVL), 512, WSB(WS_WKVUP), 512, MP, 2048, e); }
    hipLaunchKernelGGL(k_kn_finish, dim3(MP / 4), dim3(256), 0, stream, WSB(WS_KN), g_kn, MP);
    hipLaunchKernelGGL(k_attn<4>, dim3(BATCH * HEADS * 128), dim3(256), 0, stream, Qb, WSB(WS_KN), WSB(WS_KPE), WSB(WS_V), WSB(WS_ATT), 0);

    bf16_t* GA = (bf16_t*)out; bf16_t* GB = GA + (size_t)MT * 1024;
    hipLaunchKernelGGL(k_rownorm, dim3(MT / 4), dim3(256), 0, stream, x_p, x_s, WSB(WS_XN2));
    gemm(stream, WSB(WS_XN2), 1024, WIN + (size_t)C_GA * 1024, 1024, MT, 1024, mkepi(EP_SIGM, GA, 1024));
    gemm(stream, WSB(WS_XN2), 1024, WIN + (size_t)C_GB * 1024, 1024, MT, 1024, mkepi(EP_SIGM, GB, 1024));
    { Epi e = mkepi(EP_MUL, WSB(WS_MERGED), 1024); e.g = GA; gemm(stream, WSB(WS_ATT), 1024, WSB(WS_WOBA), 1024, MT, 1024, e); }
    { Epi e = mkepi(EP_MULADD, WSB(WS_MERGED), 1024); e.g = GB; gemm(stream, WSB(WS_RET), 1024, WSB(WS_WOBB), 1024, MT, 1024, e); }
    { Epi e = mkepi(EP_RESID, nullptr, 1024); e.xa = x_p; e.xb = x_s; e.of = out; gemm(stream, WSB(WS_MERGED), 1024, WSB(WS_WOUT), 1024, MT, 1024, e); }
    hipLaunchKernelGGL(k_x1_finish, dim3(MT / 4), dim3(256), 0, stream, out, WSB(WS_X1B));
    gemm(stream, WSB(WS_X1B), 1024, WSB(WS_WUP), 1024, MT, FF2, mkepi(EP_BF16, WSB(WS_U), FF2));
    hipLaunchKernelGGL(k_convout, dim3((DEC_BATCH * 2 * FF2 + 255) / 256), dim3(256), 0, stream, WSB(WS_U), out);
    hipLaunchKernelGGL(k_halo, dim3(64 + DEC_BATCH), dim3(256), 0, stream, WSB(WS_U), st_conv, WSB(WS_HALO));
    hipLaunchKernelGGL(k_conv, dim3((64 + DEC_BATCH) * 11), dim3(256), 0, stream, WSB(WS_U), WSB(WS_HALO), cw, cb);
    { Epi e = mkepi(EP_RESID_INPLACE, nullptr, 1024); e.of = out; gemm(stream, WSB(WS_U), FF2, WSB(WS_WDOWN), D_FF, MT, 1024, e); }
}
```

```cpp
#include <hip/hip_runtime.h>
#include <stdint.h>
#include <cstdio>

typedef unsigned short bf16_t;
typedef short bf16x8 __attribute__((ext_vector_type(8)));
typedef float f32x4 __attribute__((ext_vector_type(4)));
typedef float f32x2 __attribute__((ext_vector_type(2)));
typedef unsigned u32x4 __attribute__((ext_vector_type(4)));
typedef unsigned u32x2 __attribute__((ext_vector_type(2)));

constexpr int D_MODEL = 1024, BATCH = 2, SEQ = 8192, DEC_BATCH = 8, DEC_SEQ = 16, PAST = 2048;
constexpr int MP = BATCH * SEQ, MS = DEC_BATCH * DEC_SEQ, MT = MP + MS;
constexpr int MPAD = 16640;
constexpr int Q_LORA = 768, KV_LORA = 512, QK_NOPE = 128, QK_ROPE = 64, V_HEAD = 128, HEADS = 8;
constexpr int RET_H = 4, RET_DK = 128, RET_DV = 256;
constexpr int D_FF = 2816, FF2 = 2 * D_FF;
constexpr int IN_W = 6464;
constexpr int SKEYS = PAST + DEC_SEQ;
constexpr int LROWS = DEC_BATCH * SKEYS;
constexpr float EPS = 1e-6f;
constexpr int C_QLAT = 0, C_KVLAT = 768, C_KPE = 1280, C_RQ = 1344, C_RK = 1856, C_RV = 2368, C_RG = 3392, C_GA = 4416, C_GB = 5440;

constexpr size_t O_YP = 0, O_YS = 16777216, O_LATP = 16908288, O_RKP = 25296896, O_RETP = 26345472, O_CONVP = 26607616,
                 O_LATS = 26630144, O_RKS = 26695680, O_RETS = 26703872, O_CONVS = 27752448;

constexpr size_t MiB = 1u << 20, KiB = 1024;
constexpr size_t WS_CTL = 0, CTL_BYTES = 64 * KiB, WS_SQ = 64 * KiB, WS_SKV = 192 * KiB;
constexpr size_t WS_WUP = 1 * MiB, WS_WDOWN = 12 * MiB;
constexpr size_t WS_WIN = 19 * MiB, WS_WQUP = 32 * MiB, WS_WKVUP = 34 * MiB + 512 * KiB, WS_WKVUPN = 36 * MiB + 512 * KiB,
                 WS_WOBA = 38 * MiB + 512 * KiB, WS_WOBB = 40 * MiB + 512 * KiB, WS_WOUT = 42 * MiB + 512 * KiB,
                 WS_TAB32 = 44 * MiB + 512 * KiB, WS_TAB64 = 46 * MiB + 512 * KiB;
constexpr size_t WS_XN = 51 * MiB, WS_RET = 51 * MiB;
constexpr size_t WS_ZQ = 83 * MiB + 512 * KiB, WS_KVL = 108 * MiB, WS_KPE = 124 * MiB + 512 * KiB, WS_LATS = 126 * MiB + 768 * KiB, WS_PES = 143 * MiB;
constexpr size_t WS_RQ = 145 * MiB + 256 * KiB, WS_RK = 161 * MiB + 512 * KiB, WS_RV = 177 * MiB + 768 * KiB, WS_RG = 210 * MiB + 256 * KiB;
constexpr size_t WS_KN = 145 * MiB + 256 * KiB, WS_V = 177 * MiB + 768 * KiB, WS_ATT = 210 * MiB + 256 * KiB;
constexpr size_t WS_XN2 = 83 * MiB + 512 * KiB, WS_MERGED = 116 * MiB;
constexpr size_t WS_X1B = 19 * MiB, WS_U = 52 * MiB, WS_HALO = 232 * MiB;
constexpr size_t WS_FWIN = 243 * MiB;
constexpr size_t DO_SLOTQ = 56 * MiB, DO_SLOTKV = 57 * MiB;

__device__ __forceinline__ bf16_t f2bf(float f) { unsigned u = __float_as_uint(f); u = (u + 0x7fffu + ((u >> 16) & 1u)) >> 16; return (bf16_t)u; }
__device__ __forceinline__ float bf2f(bf16_t b) { return __uint_as_float(((unsigned)b) << 16); }
__device__ __forceinline__ float wave_sum(float v) {
#pragma unroll
    for (int o = 1; o < 64; o <<= 1) v += __shfl_xor(v, o);
    return v;
}
__device__ __forceinline__ float sigmoidf_(float x) { return 1.f / (1.f + __expf(-x)); }
__device__ __forceinline__ float siluf_(float x) { return x / (1.f + __expf(-x)); }

__global__ void k_convert_w(const float* __restrict__ W, int ldw, int K, int N, const float* __restrict__ gain, bf16_t* __restrict__ Wt) {
    __shared__ float tile[32][33];
    const int nb = N / 32, kb = blockIdx.x / nb, nbi = blockIdx.x % nb;
    const int tx = threadIdx.x & 31, ty = threadIdx.x >> 5;
    for (int i = ty; i < 32; i += 8) { const int k = kb * 32 + i; tile[i][tx] = W[(size_t)k * ldw + nbi * 32 + tx] * (gain ? gain[k] : 1.f); }
    __syncthreads();
    for (int i = ty; i < 32; i += 8) { const int n = nbi * 32 + i; Wt[(size_t)n * K + kb * 32 + tx] = f2bf(tile[tx][i]); }
}
__global__ void k_tables(float2* tab32, float2* tab64) {
    const int idx = blockIdx.x * blockDim.x + threadIdx.x;
    if (idx < 8192 * 32) { const int pos = idx / 32, i = idx % 32; const double f = pow(10000.0, -(double)i / 32.0), a = (double)pos * f; tab32[idx] = make_float2((float)cos(a), (float)sin(a)); }
    if (idx < 8192 * 64) { const int pos = idx / 64, i = idx % 64; const double f = pow(10000.0, -(double)i / 64.0), a = (double)pos * f; tab64[idx] = make_float2((float)cos(a), (float)sin(a)); }
}
__global__ void k_rownorm(const float* __restrict__ xa, const float* __restrict__ xb, bf16_t* __restrict__ out) {
    const int r = blockIdx.x * 4 + (threadIdx.x >> 6), lane = threadIdx.x & 63; if (r >= MT) return;
    const float* x = r < MP ? xa + (size_t)r * D_MODEL : xb + (size_t)(r - MP) * D_MODEL;
    f32x4 v[4]; float s = 0.f;
#pragma unroll
    for (int j = 0; j < 4; ++j) { v[j] = *(const f32x4*)(x + j * 256 + lane * 4); s += v[j][0] * v[j][0] + v[j][1] * v[j][1] + v[j][2] * v[j][2] + v[j][3] * v[j][3]; }
    const float inv = rsqrtf(wave_sum(s) * (1.f / D_MODEL) + EPS);
#pragma unroll
    for (int j = 0; j < 4; ++j) { bf16_t* o = out + (size_t)r * D_MODEL + j * 256 + lane * 4;
        o[0] = f2bf(v[j][0] * inv); o[1] = f2bf(v[j][1] * inv); o[2] = f2bf(v[j][2] * inv); o[3] = f2bf(v[j][3] * inv); }
}
__global__ void k_cache(const float* __restrict__ clat, const float* __restrict__ cpe, bf16_t* __restrict__ lats, bf16_t* __restrict__ pes) {
    const size_t idx = (size_t)blockIdx.x * blockDim.x + threadIdx.x;
    const size_t nlat = (size_t)DEC_BATCH * PAST * KV_LORA, npe = (size_t)DEC_BATCH * PAST * QK_ROPE;
    if (idx < nlat) { const int c = idx % KV_LORA; const size_t rj = idx / KV_LORA; const int j = rj % PAST, b = rj / PAST; lats[((size_t)b * SKEYS + j) * KV_LORA + c] = f2bf(clat[idx]); }
    if (idx < npe) { const int c = idx % QK_ROPE; const size_t rj = idx / QK_ROPE; const int j = rj % PAST, b = rj / PAST; pes[((size_t)b * SKEYS + j) * QK_ROPE + c] = f2bf(cpe[idx]); }
}

enum { EP_BF16 = 0, EP_SILU = 1, EP_SIGM = 2, EP_ROWSCALE = 3, EP_KVSPLIT = 4, EP_MUL = 5, EP_MULADD = 6, EP_RESID = 7, EP_RESID_INPLACE = 8 };
struct Epi {
    int mode; int ldo; bf16_t* o1; bf16_t* o2; const float* rs; const bf16_t* g; const float* xa; const float* xb; float* of;
};
__device__ __forceinline__ void epi_apply(const Epi& E, int r, int c, float v) {
    switch (E.mode) {
    case EP_BF16: E.o1[(size_t)r * E.ldo + c] = f2bf(v); break;
    case EP_SILU: E.o1[(size_t)r * E.ldo + c] = f2bf(siluf_(v)); break;
    case EP_SIGM: E.o1[(size_t)r * E.ldo + c] = f2bf(sigmoidf_(v)); break;
    case EP_ROWSCALE: E.o1[(size_t)r * E.ldo + c] = f2bf(v * E.rs[r]); break;
    case EP_KVSPLIT: { const int h = c >> 8, j = c & 255; const float s = E.rs ? E.rs[r] : 1.f;
        if (j < 128) E.o1[(size_t)r * 1024 + h * 128 + j] = f2bf(v * s); else E.o2[(size_t)r * 1024 + h * 128 + (j - 128)] = f2bf(v * s); } break;
    case EP_MUL: E.o1[(size_t)r * E.ldo + c] = f2bf(v * bf2f(E.g[(size_t)r * E.ldo + c])); break;
    case EP_MULADD: { const size_t i = (size_t)r * E.ldo + c; E.o1[i] = f2bf(bf2f(E.o1[i]) + v * bf2f(E.g[i])); } break;
    case EP_RESID: { const float x = r < MP ? E.xa[(size_t)r * D_MODEL + c] : E.xb[(size_t)(r - MP) * D_MODEL + c]; E.of[(size_t)r * D_MODEL + c] = x + v; } break;
    case EP_RESID_INPLACE: { const size_t i = (size_t)r * D_MODEL + c; E.of[i] = E.of[i] + v; } break;
    }
}
__global__ void __launch_bounds__(256) k_gemm(const bf16_t* __restrict__ A, int lda, const bf16_t* __restrict__ Bt, int K, int M, int N, Epi E) {
    __shared__ bf16_t As[64][72], Bs[64][72];
    const int nbn = N / 64, bm = blockIdx.x / nbn, bn = blockIdx.x % nbn;
    const int tid = threadIdx.x, w = tid >> 6, lane = tid & 63, fr = lane & 15, fq = lane >> 4;
    f32x4 acc[4] = {};
    const int lr = tid >> 2, lc = (tid & 3) * 16;
    for (int k0 = 0; k0 < K; k0 += 64) {
        const int ar = bm * 64 + lr;
        bf16x8 a0 = {}, a1 = {};
        if (ar < M) { a0 = *(const bf16x8*)(A + (size_t)ar * lda + k0 + lc); a1 = *(const bf16x8*)(A + (size_t)ar * lda + k0 + lc + 8); }
        const bf16x8 b0 = *(const bf16x8*)(Bt + (size_t)(bn * 64 + lr) * K + k0 + lc), b1 = *(const bf16x8*)(Bt + (size_t)(bn * 64 + lr) * K + k0 + lc + 8);
        __syncthreads();
        *(bf16x8*)&As[lr][lc] = a0; *(bf16x8*)&As[lr][lc + 8] = a1; *(bf16x8*)&Bs[lr][lc] = b0; *(bf16x8*)&Bs[lr][lc + 8] = b1;
        __syncthreads();
#pragma unroll
        for (int ks = 0; ks < 2; ++ks) {
            const bf16x8 af = *(const bf16x8*)&As[w * 16 + fr][ks * 32 + fq * 8];
#pragma unroll
            for (int n = 0; n < 4; ++n) { const bf16x8 bfr = *(const bf16x8*)&Bs[n * 16 + fr][ks * 32 + fq * 8];
                acc[n] = __builtin_amdgcn_mfma_f32_16x16x32_bf16(af, bfr, acc[n], 0, 0, 0); }
        }
    }
#pragma unroll
    for (int n = 0; n < 4; ++n)
#pragma unroll
        for (int i = 0; i < 4; ++i) { const int r = bm * 64 + w * 16 + fq * 4 + i, c = bn * 64 + n * 16 + fr; if (r < M) epi_apply(E, r, c, acc[n][i]); }
}

__global__ void k_zq_finish(const bf16_t* __restrict__ zq, float* __restrict__ sq) {
    const int r = blockIdx.x * 4 + (threadIdx.x >> 6), lane = threadIdx.x & 63; if (r >= MT) return;
    float s = 0.f; for (int c = lane; c < Q_LORA; c += 64) { const float v = bf2f(zq[(size_t)r * Q_LORA + c]); s += v * v; }
    s = wave_sum(s); if (lane == 0) sq[r] = rsqrtf(s * (1.f / Q_LORA) + EPS);
}
__global__ void k_kvl_finish(const bf16_t* __restrict__ kvl, const float* __restrict__ g, float* __restrict__ skv, float* __restrict__ dout, bf16_t* __restrict__ lats) {
    const int r = blockIdx.x * 4 + (threadIdx.x >> 6), lane = threadIdx.x & 63; if (r >= MT) return;
    float v[8]; float s = 0.f;
#pragma unroll
    for (int j = 0; j < 8; ++j) { v[j] = bf2f(kvl[(size_t)r * KV_LORA + j * 64 + lane]); s += v[j] * v[j]; }
    const float inv = rsqrtf(wave_sum(s) * (1.f / KV_LORA) + EPS); if (lane == 0) skv[r] = inv;
    float* o = r < MP ? dout + O_LATP + (size_t)r * KV_LORA : dout + O_LATS + (size_t)(r - MP) * KV_LORA;
#pragma unroll
    for (int j = 0; j < 8; ++j) { const int c = j * 64 + lane; const float y = v[j] * inv * g[c]; o[c] = y;
        if (r >= MP) { const int rs = r - MP, b = rs / DEC_SEQ, t = rs % DEC_SEQ; lats[((size_t)b * SKEYS + PAST + t) * KV_LORA + c] = f2bf(y); } }
}
__global__ void k_kpe_finish(const bf16_t* __restrict__ raw, const float* __restrict__ g, const float2* __restrict__ tab32, bf16_t* __restrict__ kpe, float* __restrict__ dout, bf16_t* __restrict__ pes) {
    const int r = blockIdx.x * 4 + (threadIdx.x >> 6), lane = threadIdx.x & 63; if (r >= MT) return;
    const float v = bf2f(raw[(size_t)r * 64 + lane]); const float inv = rsqrtf(wave_sum(v * v) * (1.f / 64.f) + EPS);
    const float y = v * inv * g[lane]; const float yo = __shfl_xor(y, 32);
    const int pos = r < MP ? (r % SEQ) : PAST + ((r - MP) % DEC_SEQ);
    const float2 cs = tab32[pos * 32 + (lane & 31)];
    const float o = lane < 32 ? y * cs.x - yo * cs.y : yo * cs.y + y * cs.x;
    kpe[(size_t)r * 64 + lane] = f2bf(o);
    if (r < MP) dout[O_RKP + (size_t)r * 64 + lane] = o;
    else { const int rs = r - MP, b = rs / DEC_SEQ, t = rs % DEC_SEQ; dout[O_RKS + (size_t)rs * 64 + lane] = o; pes[((size_t)b * SKEYS + PAST + t) * 64 + lane] = f2bf(o); }
}
__global__ void k_rope_r(bf16_t* __restrict__ buf, const float2* __restrict__ tab64, float scale) {
    const int r = blockIdx.x, tid = threadIdx.x;
    const int h = tid >> 6, i = tid & 63; const int pos = r < MP ? (r % SEQ) : PAST + ((r - MP) % DEC_SEQ);
    bf16_t* p = buf + (size_t)r * 512 + h * 128; const float x1 = bf2f(p[i]), x2 = bf2f(p[i + 64]); const float2 cs = tab64[pos * 64 + i];
    p[i] = f2bf((x1 * cs.x - x2 * cs.y) * scale); p[i + 64] = f2bf((x1 * cs.y + x2 * cs.x) * scale);
}
__global__ void k_q_finish(bf16_t* __restrict__ q, const float* __restrict__ gn, const float* __restrict__ gr, const float2* __restrict__ tab32, float c2) {
    const int r = blockIdx.x * 4 + (threadIdx.x >> 6), lane = threadIdx.x & 63; if (r >= MT) return;
    const int pos = r < MP ? (r % SEQ) : PAST + ((r - MP) % DEC_SEQ);
    for (int h = 0; h < HEADS; ++h) {
        bf16_t* p = q + (size_t)r * 1536 + h * 192;
        const float a = bf2f(p[lane]), b = bf2f(p[lane + 64]), c = bf2f(p[128 + lane]);
        const float in = rsqrtf(wave_sum(a * a + b * b) * (1.f / 128.f) + EPS), ir = rsqrtf(wave_sum(c * c) * (1.f / 64.f) + EPS);
        p[lane] = f2bf(a * in * gn[lane] * c2); p[lane + 64] = f2bf(b * in * gn[lane + 64] * c2);
        const float y = c * ir * gr[lane], yo = __shfl_xor(y, 32); const float2 cs = tab32[pos * 32 + (lane & 31)];
        p[128 + lane] = f2bf((lane < 32 ? y * cs.x - yo * cs.y : yo * cs.y + y * cs.x) * c2);
    }
}
__global__ void k_kn_finish(bf16_t* __restrict__ kn, const float* __restrict__ g, int rows) {
    const int r = blockIdx.x * 4 + (threadIdx.x >> 6), lane = threadIdx.x & 63; if (r >= rows) return;
    for (int h = 0; h < HEADS; ++h) { bf16_t* p = kn + (size_t)r * 1024 + h * 128; const float a = bf2f(p[lane]), b = bf2f(p[lane + 64]);
        const float in = rsqrtf(wave_sum(a * a + b * b) * (1.f / 128.f) + EPS); p[lane] = f2bf(a * in * g[lane]); p[lane + 64] = f2bf(b * in * g[lane + 64]); }
}
__global__ void k_ret_finish(bf16_t* __restrict__ ret, const float* __restrict__ g, const bf16_t* __restrict__ gate) {
    const int r = blockIdx.x * 4 + (threadIdx.x >> 6), lane = threadIdx.x & 63; if (r >= MT) return;
    for (int h = 0; h < RET_H; ++h) { bf16_t* p = ret + (size_t)r * 1024 + h * 256; float v[4]; float s = 0.f;
#pragma unroll
        for (int j = 0; j < 4; ++j) { v[j] = bf2f(p[j * 64 + lane]); s += v[j]; }
        const float mu = wave_sum(s) * (1.f / 256.f); float q = 0.f;
#pragma unroll
        for (int j = 0; j < 4; ++j) { v[j] -= mu; q += v[j] * v[j]; }
        const float inv = rsqrtf(wave_sum(q) * (1.f / 256.f) + EPS);
#pragma unroll
        for (int j = 0; j < 4; ++j) { const int c = h * 256 + j * 64 + lane; p[j * 64 + lane] = f2bf(v[j] * inv * g[c] * bf2f(gate[(size_t)r * 1024 + c])); } }
}
__global__ void k_x1_finish(const float* __restrict__ x1, bf16_t* __restrict__ out) {
    const int r = blockIdx.x * 4 + (threadIdx.x >> 6), lane = threadIdx.x & 63; if (r >= MT) return;
    const float* x = x1 + (size_t)r * D_MODEL; f32x4 v[4]; float s = 0.f;
#pragma unroll
    for (int j = 0; j < 4; ++j) { v[j] = *(const f32x4*)(x + j * 256 + lane * 4); s += v[j][0] * v[j][0] + v[j][1] * v[j][1] + v[j][2] * v[j][2] + v[j][3] * v[j][3]; }
    const float inv = rsqrtf(wave_sum(s) * (1.f / D_MODEL) + EPS);
#pragma unroll
    for (int j = 0; j < 4; ++j) { bf16_t* o = out + (size_t)r * D_MODEL + j * 256 + lane * 4;
        o[0] = f2bf(v[j][0] * inv); o[1] = f2bf(v[j][1] * inv); o[2] = f2bf(v[j][2] * inv); o[3] = f2bf(v[j][3] * inv); }
}

template <int NW>
__global__ void __launch_bounds__(NW * 64) k_attn(const bf16_t* __restrict__ Q, const bf16_t* __restrict__ KN, const bf16_t* __restrict__ KPE, const bf16_t* __restrict__ V,
                                                 bf16_t* __restrict__ att, int sample) {
    __shared__ bf16_t Ks[64][200]; __shared__ bf16_t Vt[128][72]; __shared__ bf16_t Ps[NW][16][72];
    const int tid = threadIdx.x, w = tid >> 6, lane = tid & 63, fr = lane & 15, fq = lane >> 4;
    int b, h, qrow0, krow0, nkeys;
    if (!sample) { const int c = blockIdx.x % 128, bh = blockIdx.x / 128; h = bh % HEADS; b = bh / HEADS; qrow0 = b * SEQ + c * 64 + w * 16; krow0 = b * SEQ; nkeys = (c + 1) * 64; }
    else { h = blockIdx.x % HEADS; b = blockIdx.x / HEADS; qrow0 = MP + b * DEC_SEQ; krow0 = b * SKEYS; nkeys = SKEYS; }
    bf16x8 qf[6];
#pragma unroll
    for (int s = 0; s < 6; ++s) qf[s] = *(const bf16x8*)(Q + (size_t)(qrow0 + fr) * 1536 + h * 192 + s * 32 + fq * 8);
    f32x4 o[8] = {}; float m[4], l[4];
#pragma unroll
    for (int i = 0; i < 4; ++i) { m[i] = -1e30f; l[i] = 0.f; }
    const int ntile = (nkeys + 63) / 64;
    for (int t = 0; t < ntile; ++t) {
        __syncthreads();
        for (int idx = tid; idx < 64 * 24; idx += NW * 64) { const int key = idx / 24, ch = idx % 24; const int kg = t * 64 + key; bf16x8 v = {};
            if (kg < nkeys) { if (ch < 16) v = *(const bf16x8*)(KN + (size_t)(krow0 + kg) * 1024 + h * 128 + ch * 8); else v = *(const bf16x8*)(KPE + (size_t)(krow0 + kg) * 64 + (ch - 16) * 8); }
            *(bf16x8*)&Ks[key][ch * 8] = v; }
        for (int idx = tid; idx < 64 * 16; idx += NW * 64) { const int key = idx / 16, ch = idx % 16; const int kg = t * 64 + key; bf16x8 v = {};
            if (kg < nkeys) v = *(const bf16x8*)(V + (size_t)(krow0 + kg) * 1024 + h * 128 + ch * 8);
#pragma unroll
            for (int e = 0; e < 8; ++e) Vt[ch * 8 + e][key] = (bf16_t)v[e]; }
        __syncthreads();
        f32x4 s[4] = {};
#pragma unroll
        for (int ks = 0; ks < 6; ++ks)
#pragma unroll
            for (int n = 0; n < 4; ++n) { const bf16x8 kf = *(const bf16x8*)&Ks[n * 16 + fr][ks * 32 + fq * 8]; s[n] = __builtin_amdgcn_mfma_f32_16x16x32_bf16(qf[ks], kf, s[n], 0, 0, 0); }
#pragma unroll
        for (int n = 0; n < 4; ++n) if (t * 64 + n * 16 + fr >= nkeys) { s[n][0] = -INFINITY; s[n][1] = -INFINITY; s[n][2] = -INFINITY; s[n][3] = -INFINITY; }
        float alpha[4];
#pragma unroll
        for (int i = 0; i < 4; ++i) { float mx = fmaxf(fmaxf(s[0][i], s[1][i]), fmaxf(s[2][i], s[3][i]));
            mx = fmaxf(mx, __shfl_xor(mx, 1)); mx = fmaxf(mx, __shfl_xor(mx, 2)); mx = fmaxf(mx, __shfl_xor(mx, 4)); mx = fmaxf(mx, __shfl_xor(mx, 8));
            const float mn = fmaxf(m[i], mx); alpha[i] = exp2f(m[i] - mn); m[i] = mn; float ps = 0.f;
#pragma unroll
            for (int n = 0; n < 4; ++n) { const float p = exp2f(s[n][i] - mn); s[n][i] = p; ps += p; }
            ps += __shfl_xor(ps, 1); ps += __shfl_xor(ps, 2); ps += __shfl_xor(ps, 4); ps += __shfl_xor(ps, 8);
            l[i] = l[i] * alpha[i] + ps; }
#pragma unroll
        for (int n = 0; n < 4; ++n)
#pragma unroll
            for (int i = 0; i < 4; ++i) Ps[w][fq * 4 + i][n * 16 + fr] = f2bf(s[n][i]);
#pragma unroll
        for (int n = 0; n < 8; ++n)
#pragma unroll
            for (int i = 0; i < 4; ++i) o[n][i] *= alpha[i];
#pragma unroll
        for (int ks = 0; ks < 2; ++ks) { const bf16x8 pf = *(const bf16x8*)&Ps[w][fr][ks * 32 + fq * 8];
#pragma unroll
            for (int n = 0; n < 8; ++n) { const bf16x8 vf = *(const bf16x8*)&Vt[n * 16 + fr][ks * 32 + fq * 8]; o[n] = __builtin_amdgcn_mfma_f32_16x16x32_bf16(pf, vf, o[n], 0, 0, 0); } }
    }
#pragma unroll
    for (int i = 0; i < 4; ++i) { const float rl = 1.f / l[i]; const int r = qrow0 + fq * 4 + i;
#pragma unroll
        for (int n = 0; n < 8; ++n) att[(size_t)r * 1024 + h * 128 + n * 16 + fr] = f2bf(o[n][i] * rl); }
}

__global__ void __launch_bounds__(256) k_ret(const bf16_t* __restrict__ rq, const bf16_t* __restrict__ rk, const bf16_t* __restrict__ rv, int rowbase, int rows_per_batch, int L, int nch,
                                             const float* __restrict__ Sinit, bf16_t* __restrict__ retraw, float* __restrict__ Sout) {
    extern __shared__ float sm[];
    float* qs = sm;
    float* ks = qs + 64 * 129;
    float* Ss = ks + 64 * 129;
    float* vs = Ss + 128 * 33;
    float* sc = vs + 64 * 33;
    const int tid = threadIdx.x; const int sl = blockIdx.x % 8, h = (blockIdx.x / 8) % RET_H, b = blockIdx.x / 32;
    const float gam = 1.f - exp2f(-5.f - (float)h), lg2 = log2f(gam);
    for (int i = tid; i < 128 * 32; i += 256) { const int d = i / 32, e = i % 32; Ss[d * 33 + e] = Sinit ? Sinit[(((size_t)b * RET_H + h) * RET_DK + d) * RET_DV + sl * 32 + e] : 0.f; }
    const float gL = exp2f(lg2 * (float)L);
    for (int c = 0; c < nch; ++c) {
        const size_t r0 = (size_t)rowbase + (size_t)b * rows_per_batch + (size_t)c * L;
        __syncthreads();
        for (int i = tid; i < L * 128; i += 256) { const int j = i / 128, d = i % 128; qs[j * 129 + d] = bf2f(rq[(r0 + j) * 512 + h * 128 + d]); ks[j * 129 + d] = bf2f(rk[(r0 + j) * 512 + h * 128 + d]); }
        for (int i = tid; i < L * 32; i += 256) { const int j = i / 32, e = i % 32; vs[j * 33 + e] = bf2f(rv[(r0 + j) * 1024 + h * 256 + sl * 32 + e]); }
        __syncthreads();
        for (int p = tid; p < L * L; p += 256) { const int i = p / L, j = p % L; float s = 0.f;
            if (j <= i) { for (int d = 0; d < 128; ++d) s += qs[i * 129 + d] * ks[j * 129 + d]; s *= exp2f(lg2 * (float)(i - j)); }
            sc[i * 65 + j] = s; }
        __syncthreads();
        for (int p = tid; p < L * 32; p += 256) { const int i = p / 32, e = p % 32; float a = 0.f, cr = 0.f;
            for (int j = 0; j <= i; ++j) a += sc[i * 65 + j] * vs[j * 33 + e];
            for (int d = 0; d < 128; ++d) cr += qs[i * 129 + d] * Ss[d * 33 + e];
            retraw[(r0 + i) * 1024 + h * 256 + sl * 32 + e] = f2bf(a + cr * exp2f(lg2 * (float)(i + 1))); }
        __syncthreads();
        for (int p = tid; p < 128 * 32; p += 256) { const int d = p / 32, e = p % 32; float a = Ss[d * 33 + e] * gL;
            for (int j = 0; j < L; ++j) a += ks[j * 129 + d] * exp2f(lg2 * (float)(L - 1 - j)) * vs[j * 33 + e];
            Ss[d * 33 + e] = a; }
    }
    __syncthreads();
    for (int i = tid; i < 128 * 32; i += 256) { const int d = i / 32, e = i % 32; Sout[(((size_t)b * RET_H + h) * RET_DK + d) * RET_DV + sl * 32 + e] = Ss[d * 33 + e]; }
}

__global__ void k_halo(const bf16_t* __restrict__ U, const float* __restrict__ prev_s, bf16_t* __restrict__ halo) {
    const int ch = blockIdx.x; const int tid = threadIdx.x;
    for (int i = tid; i < 2 * FF2; i += 256) { const int k = i / FF2, n = i % FF2; float v = 0.f;
        if (ch < 64) { const int r0 = ch * 256; if ((r0 % SEQ) != 0) v = bf2f(U[(size_t)(r0 - 2 + k) * FF2 + n]); }
        else { const int b = ch - 64; v = prev_s[((size_t)b * 2 + k) * FF2 + n]; }
        halo[(size_t)ch * 2 * FF2 + i] = f2bf(v); }
}
__global__ void __launch_bounds__(256) k_conv(bf16_t* __restrict__ U, const bf16_t* __restrict__ halo, const float* __restrict__ cw, const float* __restrict__ cb) {
    const int ch = blockIdx.x / 11, strip = blockIdx.x % 11; const int n = strip * 256 + threadIdx.x;
    int r0, nr; if (ch < 64) { r0 = ch * 256; nr = 256; } else { r0 = MP + (ch - 64) * DEC_SEQ; nr = DEC_SEQ; }
    const int nv = n + D_FF;
    const float wg0 = cw[n], wg1 = cw[FF2 + n], wg2 = cw[2 * FF2 + n], bg = cb[n], wv0 = cw[nv], wv1 = cw[FF2 + nv], wv2 = cw[2 * FF2 + nv], bv = cb[nv];
    float g2 = bf2f(halo[(size_t)ch * 2 * FF2 + n]), g1 = bf2f(halo[(size_t)ch * 2 * FF2 + FF2 + n]);
    float v2 = bf2f(halo[(size_t)ch * 2 * FF2 + nv]), v1 = bf2f(halo[(size_t)ch * 2 * FF2 + FF2 + nv]);
    for (int i = 0; i < nr; ++i) { bf16_t* row = U + (size_t)(r0 + i) * FF2; const float g0 = bf2f(row[n]), v0 = bf2f(row[nv]);
        const float cg = g2 * wg0 + g1 * wg1 + g0 * wg2 + bg, cv = v2 * wv0 + v1 * wv1 + v0 * wv2 + bv;
        row[n] = f2bf(siluf_(cg) * cv); g2 = g1; g1 = g0; v2 = v1; v1 = v0; }
}
__global__ void k_convout(const bf16_t* __restrict__ U, float* __restrict__ dout) {
    const int idx = blockIdx.x * blockDim.x + threadIdx.x;
    if (idx < BATCH * 2 * FF2) { const int n = idx % FF2, k = (idx / FF2) % 2, b = idx / (2 * FF2); dout[O_CONVP + idx] = bf2f(U[(size_t)(b * SEQ + SEQ - 2 + k) * FF2 + n]); }
    if (idx < DEC_BATCH * 2 * FF2) { const int n = idx % FF2, k = (idx / FF2) % 2, b = idx / (2 * FF2); dout[O_CONVS + idx] = bf2f(U[(size_t)(MP + b * DEC_SEQ + DEC_SEQ - 2 + k) * FF2 + n]); }
}

#define LAS __attribute__((address_space(3)))
#define GAS __attribute__((address_space(1)))
constexpr int NTHR = 512;
constexpr int RING_BYTES = 131072, EPI_OFF = RING_BYTES, EPI_BYTES = 8192, MISC_OFF = EPI_OFF + EPI_BYTES, LDS_BYTES = 147456;
constexpr int CW_BAR = 1024;

__device__ __forceinline__ unsigned cvt_pk_bf16(float lo, float hi) { unsigned r; asm volatile("v_cvt_pk_bf16_f32 %0, %1, %2" : "=v"(r) : "v"(lo), "v"(hi)); return r; }
__device__ __forceinline__ u32x4 pack8f(const f32x4& a, const f32x4& b) { u32x4 w; w.x = cvt_pk_bf16(a[0], a[1]); w.y = cvt_pk_bf16(a[2], a[3]); w.z = cvt_pk_bf16(b[0], b[1]); w.w = cvt_pk_bf16(b[2], b[3]); return w; }
__device__ __forceinline__ int row_pos(int row) { return row < MP ? (row & (SEQ - 1)) : PAST + ((row - MP) & (DEC_SEQ - 1)); }

#define XB_TMO      128
#define XB_XCNT(j)  (256  + 64 * (j))
#define XB_XSUB(j)  (1280 + 64 * (j))
#define XB_XGEN(j)  (2304 + 64 * (j))
#define XB_TOP      3328
#define XB_TOPGEN   3392
#define XCD_BAR_WORDS 3456
#define XB_SPIN_CAP (1u << 18)
__device__ __forceinline__ unsigned xb_ld(unsigned* p)              { return __hip_atomic_load(p, __ATOMIC_RELAXED, __HIP_MEMORY_SCOPE_AGENT); }
__device__ __forceinline__ unsigned xb_add(unsigned* p, unsigned v) { return __hip_atomic_fetch_add(p, v, __ATOMIC_RELAXED, __HIP_MEMORY_SCOPE_AGENT); }
__device__ __forceinline__ unsigned xb_xcc_id() { return (unsigned)__builtin_amdgcn_s_getreg((3 << 11) | 20) & 0xFu; }
#define XB_SPIN(cond, bar) do { unsigned _sp = 0; while (cond) { __builtin_amdgcn_s_sleep(1); \
    if ((++_sp & 255u) == 0u) { if (xb_ld(&(bar)[XB_TMO])) break; if (_sp > XB_SPIN_CAP) { atomicAdd(&(bar)[XB_TMO], 1u); break; } } } } while (0)
struct XcdBarrier { unsigned* bar; unsigned x; volatile LAS unsigned* st; };
__device__ __forceinline__ XcdBarrier xcd_barrier_post(unsigned* bar, volatile LAS unsigned* st) {
    XcdBarrier b; b.bar = bar; b.x = xb_xcc_id(); b.st = st;
    if (threadIdx.x == 0) (void)xb_add(&bar[XB_XCNT(b.x)], 1u);
    return b;
}
__device__ __forceinline__ void xcd_barrier_complete(unsigned* bar, unsigned x, unsigned& nloc, unsigned& nx) {
    const unsigned G = gridDim.x * gridDim.y * gridDim.z;
    unsigned sum, cnt, mine, sp = 0u;
    for (;;) {
        sum = 0u; cnt = 0u; mine = 0u;
#pragma unroll
        for (unsigned j = 0; j < 16; ++j) { const unsigned c = xb_ld(&bar[XB_XCNT(j)]); sum += c; cnt += (c > 0u) ? 1u : 0u; mine = (j == x) ? c : mine; }
        if (sum == G) break;
        __builtin_amdgcn_s_sleep(1);
        if ((++sp & 255u) == 0u) { if (xb_ld(&bar[XB_TMO])) break; if (sp > XB_SPIN_CAP) { atomicAdd(&bar[XB_TMO], 1u); break; } }
    }
    nloc = mine > 0u ? mine : 1u; nx = cnt > 0u ? cnt : 1u;
}
__device__ __forceinline__ void xcd_barrier(const XcdBarrier& b) {
    asm volatile("s_waitcnt vmcnt(0)" ::: "memory");
    __syncthreads();
    if (threadIdx.x == 0) {
        unsigned* bar = b.bar;
        __builtin_amdgcn_s_waitcnt(0);
        unsigned nloc = b.st[0], nx = b.st[1];
        if (nloc == 0u) { xcd_barrier_complete(bar, b.x, nloc, nx); b.st[0] = nloc; b.st[1] = nx; }
        const unsigned old = xb_add(&bar[XB_XSUB(b.x)], 1u);
        const unsigned gen = old / nloc;
        if (old + 1u == (gen + 1u) * nloc) {
            __builtin_amdgcn_fence(__ATOMIC_RELEASE, "agent");
            asm volatile("s_waitcnt vmcnt(0)" ::: "memory");
            const unsigned og = xb_add(&bar[XB_TOP], 1u);
            const unsigned tg = og / nx;
            if (og + 1u == (tg + 1u) * nx) xb_add(&bar[XB_TOPGEN], 1u);
            else XB_SPIN(xb_ld(&bar[XB_TOPGEN]) == tg, bar);
            __builtin_amdgcn_fence(__ATOMIC_ACQUIRE, "agent");
            xb_add(&bar[XB_XGEN(b.x)], 1u);
            asm volatile("s_waitcnt vmcnt(0)" ::: "memory");
        } else {
            XB_SPIN(xb_ld(&bar[XB_XGEN(b.x)]) == gen, bar);
            __builtin_amdgcn_fence(__ATOMIC_ACQUIRE, "agent");
            asm volatile("s_waitcnt vmcnt(0)" ::: "memory");
        }
    }
    __syncthreads();
}

namespace pg {
constexpr int BK = 64, HALF = 128, HTB = HALF * BK * 2;
__host__ __device__ __forceinline__ int lds_byte(int r, int c) { const int st = (r >> 4) * 2 + (c >> 5), rr = r & 15, cc = c & 31, ob = rr * 64 + cc * 2; return st * 1024 + (ob ^ (((ob >> 9) & 1) << 5)); }
__host__ __device__ __forceinline__ void stage_rc(int b, int& R, int& C) { const int st = b / 1024, sb = b % 1024, swz = sb ^ (((sb >> 9) & 1) << 5); R = (st >> 1) * 16 + swz / 64; C = (st & 1) * 32 + (swz % 64) / 2; }
__host__ __device__ __forceinline__ int perm32(int rho) { const int n = rho >> 4, i = rho & 15; return 8 * (i >> 2) + 4 * n + (i & 3); }
struct UnitG { const char* A; const char* B; unsigned lda, ldb; int nt; int pm, pn, kind; };
typedef f32x4 Acc[2][2][4][2];

template <class Sched, class Epi>
__device__ __forceinline__ void gemm_stream(LAS unsigned char* lds, const Sched& S, const Epi& E) {
    const int tid = threadIdx.x, wid = __builtin_amdgcn_readfirstlane(tid >> 6), lane = tid & 63, wr = wid >> 2, wc = wid & 3, fr = lane & 15, fq = lane >> 4;
    unsigned Rr[2], Cc[2];
#pragma unroll
    for (int i = 0; i < 2; ++i) { int R, C; stage_rc(tid * 16 + i * 8192, R, C); Rr[i] = (unsigned)R; Cc[i] = (unsigned)C * 2u; }
    const unsigned ldsw = (unsigned)wid * 1024u;
    const int aoff = lds_byte(wr * 64 + fr, fq * 8), boff = lds_byte(wc * 32 + fr, fq * 8);
#define PG_SA(b, h) (((b) * 2 + (h)) * HTB)
#define PG_SB(b, h) ((4 + (b) * 2 + (h)) * HTB)
#define PG_STAGE(bufoff, gbase, ld) do { _Pragma("unroll") for (int _i = 0; _i < 2; ++_i) \
        __builtin_amdgcn_global_load_lds((const unsigned*)((const char*)(gbase) + (size_t)(Rr[_i] * (ld) + Cc[_i])), (LAS unsigned*)(lds + (bufoff) + ldsw + _i * 8192), 16, 0, 0); } while (0)
#define PG_LDA(dst, b, h) do { _Pragma("unroll") for (int m = 0; m < 4; ++m) _Pragma("unroll") for (int k = 0; k < 2; ++k) dst[m][k] = *(const LAS bf16x8*)(lds + PG_SA(b, h) + aoff + m * 2048 + k * 1024); } while (0)
#define PG_LDB(dst, b, h) do { _Pragma("unroll") for (int n = 0; n < 2; ++n) _Pragma("unroll") for (int k = 0; k < 2; ++k) dst[n][k] = *(const LAS bf16x8*)(lds + PG_SB(b, h) + boff + n * 2048 + k * 1024); } while (0)
#define PG_MMA(ai, bj, At, Bt) do { __builtin_amdgcn_s_setprio(1); _Pragma("unroll") for (int m = 0; m < 4; ++m) _Pragma("unroll") for (int n = 0; n < 2; ++n) _Pragma("unroll") for (int k = 0; k < 2; ++k) \
        acc[ai][bj][m][n] = __builtin_amdgcn_mfma_f32_16x16x32_bf16(Bt[n][k], At[m][k], acc[ai][bj][m][n], 0, 0, 0); __builtin_amdgcn_s_setprio(0); } while (0)
#define PG_WAIT_V(n) asm volatile("s_waitcnt vmcnt(" #n ")" ::: "memory")
#define PG_WAIT_L(n) asm volatile("s_waitcnt lgkmcnt(" #n ")" ::: "memory")
#define PG_BAR __builtin_amdgcn_s_barrier()
#define PG_SCHED __builtin_amdgcn_sched_barrier(0)
    UnitG cur, nxt; int ui = 0;
    if (!S.next(0, cur)) return;
    Acc acc;
#pragma unroll
    for (int a = 0; a < 2; ++a)
#pragma unroll
        for (int b = 0; b < 2; ++b)
#pragma unroll
            for (int m = 0; m < 4; ++m)
#pragma unroll
                for (int n = 0; n < 2; ++n) acc[a][b][m][n] = (f32x4){0.f, 0.f, 0.f, 0.f};
    bf16x8 At[4][2], B0[2][2], B1[2][2];
    const char* cA = cur.A; const char* cB = cur.B; unsigned clda = cur.lda, cldb = cur.ldb;
    PG_STAGE(PG_SB(0, 0), cB, cldb); PG_STAGE(PG_SB(0, 1), cB + (size_t)HALF * cldb, cldb); PG_STAGE(PG_SA(0, 0), cA, clda); PG_STAGE(PG_SA(0, 1), cA + (size_t)HALF * clda, clda);
    if (wr == 1) PG_BAR;
    PG_WAIT_V(2); PG_BAR;
    PG_STAGE(PG_SB(1, 0), cB + 128, cldb); PG_STAGE(PG_SA(1, 0), cA + 128, clda); PG_STAGE(PG_SB(1, 1), cB + (size_t)HALF * cldb + 128, cldb);
    PG_WAIT_V(6); PG_BAR;
    for (;;) {
        const bool has_next = S.next(ui + 1, nxt);
        const char* nA = has_next ? nxt.A : cA; const char* nB = has_next ? nxt.B : cB;
        const unsigned nlda = has_next ? nxt.lda : clda, nldb = has_next ? nxt.ldb : cldb;
        const int nt = cur.nt;
        for (int t = 0; t < nt; t += 2) {
            const bool last = (t == nt - 2);
            const char* a1 = cA + (size_t)(t + 1) * 128;
            const char* a2 = last ? nA : cA + (size_t)(t + 2) * 128; const char* b2 = last ? nB : cB + (size_t)(t + 2) * 128;
            const unsigned lda2 = last ? nlda : clda, ldb2 = last ? nldb : cldb;
            const char* a3 = a2 + 128; const char* b3 = b2 + 128;
            PG_LDB(B0, 0, 0); PG_LDB(B1, 0, 1); PG_SCHED; PG_LDA(At, 0, 0); PG_STAGE(PG_SA(1, 1), a1 + (size_t)HALF * clda, clda);
            PG_WAIT_V(8); PG_WAIT_L(0); PG_BAR; PG_MMA(0, 0, At, B0); PG_MMA(0, 1, At, B1); PG_BAR; PG_SCHED;
            PG_LDA(At, 0, 1); PG_STAGE(PG_SB(0, 0), b2, ldb2); PG_STAGE(PG_SB(0, 1), b2 + (size_t)HALF * ldb2, ldb2); PG_STAGE(PG_SA(0, 0), a2, lda2);
            PG_WAIT_V(8); PG_WAIT_L(0); PG_BAR; PG_MMA(1, 0, At, B0); PG_MMA(1, 1, At, B1); PG_BAR; PG_SCHED;
            PG_LDB(B0, 1, 0); PG_LDB(B1, 1, 1); PG_SCHED; PG_LDA(At, 1, 0); PG_STAGE(PG_SA(0, 1), a2 + (size_t)HALF * lda2, lda2);
            PG_WAIT_V(8); PG_WAIT_L(0); PG_BAR; PG_MMA(0, 0, At, B0); PG_MMA(0, 1, At, B1); PG_BAR; PG_SCHED;
            PG_LDA(At, 1, 1); PG_STAGE(PG_SB(1, 0), b3, ldb2); PG_STAGE(PG_SB(1, 1), b3 + (size_t)HALF * ldb2, ldb2); PG_STAGE(PG_SA(1, 0), a3, lda2);
            PG_WAIT_V(8); PG_WAIT_L(0); PG_BAR; PG_MMA(1, 0, At, B0); PG_MMA(1, 1, At, B1); PG_BAR; PG_SCHED;
        }
        if (wr == 0) PG_BAR;
        E(acc, cur, lds, wr, wc, fr, fq);
        if (!has_next) break;
#pragma unroll
        for (int a = 0; a < 2; ++a)
#pragma unroll
            for (int b = 0; b < 2; ++b)
#pragma unroll
                for (int m = 0; m < 4; ++m)
#pragma unroll
                    for (int n = 0; n < 2; ++n) acc[a][b][m][n] = (f32x4){0.f, 0.f, 0.f, 0.f};
        cur = nxt; cA = nA; cB = nB; clda = nlda; cldb = nldb; ++ui;
        if (wr == 1) PG_BAR;
    }
    PG_WAIT_V(0);
    PG_BAR;
#undef PG_SA
#undef PG_SB
#undef PG_STAGE
#undef PG_LDA
#undef PG_LDB
#undef PG_MMA
#undef PG_WAIT_V
#undef PG_WAIT_L
#undef PG_BAR
#undef PG_SCHED
}
}

struct MArgs { const float* in[24]; float* out; unsigned char* ws; int ph_lo, ph_hi; };
struct Frame {
    LAS unsigned char* lds; int tid, lane, wave; int x, j, vcu, G;
    const MArgs* a; float* out; unsigned char* ws;
};
#define FIN(k) (F.a->in[k])
__device__ __forceinline__ float fwave_sum(float v) {
#pragma unroll
    for (int o = 1; o < 64; o <<= 1) v += __shfl_xor(v, o);
    return v;
}

__device__ __forceinline__ void p0_weight_item(const float* __restrict__ W, int ldw, int K, const float* __restrict__ gain, int srcbase, bf16_t* __restrict__ Wt, int gd, int kb, LAS float* scr, int lane) {
    const int k0 = kb * 64;
    bf16_t* dst = Wt + (size_t)(gd * 32) * K + k0;
    if (srcbase < 0) {
        const int c = lane & 7;
#pragma unroll
        for (int jj = 0; jj < 4; ++jj) { const int n = (lane >> 3) + 8 * jj; *(u32x4*)(dst + (size_t)n * K + 8 * c) = (u32x4){0u, 0u, 0u, 0u}; }
        return;
    }
#pragma unroll 8
    for (int i = 0; i < 32; ++i) { const int kk = 2 * i + (lane >> 5); const float g = gain ? gain[k0 + kk] : 1.f; scr[kk * 33 + (lane & 31)] = W[(size_t)(k0 + kk) * ldw + srcbase + (lane & 31)] * g; }
    asm volatile("s_waitcnt lgkmcnt(0)" ::: "memory");
    const int c = lane & 7;
#pragma unroll
    for (int jj = 0; jj < 4; ++jj) { const int n = (lane >> 3) + 8 * jj; const LAS float* s = scr + (8 * c) * 33 + pg::perm32(n);
        u32x4 o; o.x = cvt_pk_bf16(s[0 * 33], s[1 * 33]); o.y = cvt_pk_bf16(s[2 * 33], s[3 * 33]); o.z = cvt_pk_bf16(s[4 * 33], s[5 * 33]); o.w = cvt_pk_bf16(s[6 * 33], s[7 * 33]);
        *(u32x4*)(dst + (size_t)n * K + 8 * c) = o; }
    asm volatile("s_waitcnt lgkmcnt(0)" ::: "memory");
}
__device__ __forceinline__ int win_src(int gd) {
    const int tile = gd >> 3, g = gd & 7, bj = g >> 2, wc = g & 3;
    if (tile < 3) return C_QLAT + gd * 32;
    if (tile < 5) return C_KVLAT + (gd - 24) * 32;
    if (tile == 5) return (wc == 0) ? C_KPE + bj * 32 : -1;
    if (tile < 10) { const int base = tile < 8 ? C_RQ : C_RK, tl = tile < 8 ? tile - 6 : tile - 8; const int head = 2 * tl + (wc >> 1); return base + head * 128 + bj * 64 + (wc & 1) * 32; }
    if (tile < 14) return C_RV + (gd - 80) * 32;
    if (tile < 18) return C_RG + (gd - 112) * 32;
    if (tile < 22) return C_GA + (gd - 144) * 32;
    return C_GB + (gd - 176) * 32;
}
__device__ __forceinline__ void p0_prologue(Frame& F) {
    LAS float* scr = (LAS float*)(F.lds + F.wave * 16384);
    const int gw = F.vcu * 8 + F.wave, NGW = F.G * 8;
    {   const float* W = FIN(7); const float* gain = FIN(6); bf16_t* Wt = (bf16_t*)(F.ws + WS_FWIN);
        for (int it = gw; it < 26 * 8 * 16; it += NGW) { const int gd = it >> 4, kb = it & 15; p0_weight_item(W, IN_W, 1024, gain, win_src(gd), Wt, gd, kb, scr, F.lane); } }
    {   bf16_t* XN = (bf16_t*)(F.ws + WS_XN);
        for (int r = gw; r < MPAD; r += NGW) {
            u32x2* o8 = (u32x2*)(XN + (size_t)r * D_MODEL) + F.lane;
            if (r >= MT) { for (int jj = 0; jj < 4; ++jj) o8[64 * jj] = (u32x2){0u, 0u}; continue; }
            const float* x = r < MP ? FIN(0) + (size_t)r * D_MODEL : FIN(1) + (size_t)(r - MP) * D_MODEL;
            const f32x4* xr = (const f32x4*)x + F.lane; f32x4 v[4]; float s = 0.f;
#pragma unroll
            for (int jj = 0; jj < 4; ++jj) { v[jj] = xr[64 * jj]; s += (v[jj][0] * v[jj][0] + v[jj][1] * v[jj][1]) + (v[jj][2] * v[jj][2] + v[jj][3] * v[jj][3]); }
            const float inv = rsqrtf(fwave_sum(s) * (1.f / D_MODEL) + EPS);
#pragma unroll
            for (int jj = 0; jj < 4; ++jj) { u32x2 w; w.x = cvt_pk_bf16(v[jj][0] * inv, v[jj][1] * inv); w.y = cvt_pk_bf16(v[jj][2] * inv, v[jj][3] * inv); o8[64 * jj] = w; }
        } }
    {   bf16_t* lats = (bf16_t*)(F.ws + WS_LATS); bf16_t* pes = (bf16_t*)(F.ws + WS_PES);
        const int gt = F.vcu * NTHR + F.tid, NG = F.G * NTHR;
        for (int i = gt; i < DEC_BATCH * PAST * (KV_LORA / 4); i += NG) { const int c4 = i % (KV_LORA / 4), rj = i / (KV_LORA / 4), jr = rj % PAST, b = rj / PAST;
            const f32x4 v = *((const f32x4*)FIN(2) + i); u32x2 w; w.x = cvt_pk_bf16(v[0], v[1]); w.y = cvt_pk_bf16(v[2], v[3]);
            *(u32x2*)(lats + ((size_t)b * SKEYS + jr) * KV_LORA + c4 * 4) = w; }
        for (int i = gt; i < DEC_BATCH * PAST * (QK_ROPE / 4); i += NG) { const int c4 = i % (QK_ROPE / 4), rj = i / (QK_ROPE / 4), jr = rj % PAST, b = rj / PAST;
            const f32x4 v = *((const f32x4*)FIN(3) + i); u32x2 w; w.x = cvt_pk_bf16(v[0], v[1]); w.y = cvt_pk_bf16(v[2], v[3]);
            *(u32x2*)(pes + ((size_t)b * SKEYS + jr) * QK_ROPE + c4 * 4) = w; }
        float2* tab32 = (float2*)(F.ws + WS_TAB32); float2* tab64 = (float2*)(F.ws + WS_TAB64);
        for (int i = gt; i < 8192 * 64; i += NG) {
            { const int pos = i / 64, k = i % 64; const double f = pow(10000.0, -(double)k / 64.0), a = (double)pos * f; tab64[i] = make_float2((float)cos(a), (float)sin(a)); }
            if (i < 8192 * 32) { const int pos = i / 32, k = i % 32; const double f = pow(10000.0, -(double)k / 32.0), a = (double)pos * f; tab32[i] = make_float2((float)cos(a), (float)sin(a)); }
        } }
}

enum { K_QLAT = 0, K_KVLAT, K_KPE, K_RQ, K_RK, K_RV, K_RG };
struct SchedP1 {
    int x, j; const char* XN; const char* W;
    __device__ __forceinline__ bool next(int i, pg::UnitG& u) const {
        int pm, pn; const int uidx = j + 32 * i;
        if (uidx < 144) { pm = 8 * x + (uidx & 7); pn = uidx >> 3; }
        else if (i == 4 && j >= 16) { const int k = (j - 16) * 8 + x; if (k >= 18) return false; pm = 64; pn = k; }
        else return false;
        u.pm = pm; u.pn = pn; u.A = XN + (size_t)pm * 256 * 2048; u.B = W + (size_t)pn * 256 * 2048; u.lda = 2048; u.ldb = 2048; u.nt = 16;
        u.kind = pn < 3 ? K_QLAT : pn < 5 ? K_KVLAT : pn == 5 ? K_KPE : pn < 8 ? K_RQ : pn < 10 ? K_RK : pn < 14 ? K_RV : K_RG;
        return true;
    }
};
struct EpiP1 {
    unsigned char* ws; float* out; const float *g_kvlat, *g_kr;
    __device__ __forceinline__ void operator()(const pg::Acc& acc, const pg::UnitG& u, LAS unsigned char* lds, int wr, int wc, int fr, int fq) const {
        bf16_t* const ZQ = (bf16_t*)(ws + WS_ZQ); bf16_t* const KVL = (bf16_t*)(ws + WS_KVL); bf16_t* const KPE = (bf16_t*)(ws + WS_KPE); bf16_t* const PES = (bf16_t*)(ws + WS_PES);
        bf16_t* const RQ = (bf16_t*)(ws + WS_RQ); bf16_t* const RK = (bf16_t*)(ws + WS_RK); bf16_t* const RV = (bf16_t*)(ws + WS_RV); bf16_t* const RG = (bf16_t*)(ws + WS_RG);
        float* const slotq = (float*)((char*)out + DO_SLOTQ); float* const slotkv = (float*)((char*)out + DO_SLOTKV);
        const float2* const tab32 = (const float2*)(ws + WS_TAB32); const float2* const tab64 = (const float2*)(ws + WS_TAB64);
        const int kind = u.kind, rb = u.pm * 256 + wr * 64 + fr, cw = wc * 32 + fq * 8;
        if (kind == K_QLAT || kind == K_KVLAT) {
            const int t = kind == K_QLAT ? u.pn : u.pn - 3; const int ld = kind == K_QLAT ? Q_LORA : KV_LORA; bf16_t* dst = kind == K_QLAT ? ZQ : KVL;
            f32x4 g[2][2];
#pragma unroll
            for (int bj = 0; bj < 2; ++bj)
#pragma unroll
                for (int n = 0; n < 2; ++n) g[bj][n] = kind == K_KVLAT ? *(const f32x4*)(g_kvlat + t * 256 + bj * 128 + cw + 4 * n) : (f32x4){1.f, 1.f, 1.f, 1.f};
#pragma unroll
            for (int ai = 0; ai < 2; ++ai)
#pragma unroll
                for (int m = 0; m < 4; ++m) { const int row = rb + ai * 128 + m * 16; float ss = 0.f;
#pragma unroll
                    for (int bj = 0; bj < 2; ++bj) { const f32x4 v0 = acc[ai][bj][m][0], v1 = acc[ai][bj][m][1];
                        ss += (v0[0] * v0[0] + v0[1] * v0[1]) + (v0[2] * v0[2] + v0[3] * v0[3]) + (v1[0] * v1[0] + v1[1] * v1[1]) + (v1[2] * v1[2] + v1[3] * v1[3]);
                        *(u32x4*)(dst + (size_t)row * ld + t * 256 + bj * 128 + cw) = pack8f(v0 * g[bj][0], v1 * g[bj][1]); }
                    ss += __shfl_xor(ss, 16); ss += __shfl_xor(ss, 32);
                    if (fq == 0) { if (kind == K_QLAT) slotq[(size_t)row * 12 + t * 4 + wc] = ss; else slotkv[(size_t)row * 8 + t * 4 + wc] = ss; } }
        } else if (kind == K_KPE) {
            if (wc != 0) return;
            const int d0 = fq * 8;
            f32x4 g1[2], g2[2];
#pragma unroll
            for (int n = 0; n < 2; ++n) { g1[n] = *(const f32x4*)(g_kr + d0 + 4 * n); g2[n] = *(const f32x4*)(g_kr + 32 + d0 + 4 * n); }
#pragma unroll
            for (int ai = 0; ai < 2; ++ai)
#pragma unroll
                for (int m = 0; m < 4; ++m) { const int row = rb + ai * 128 + m * 16; const int pos = row_pos(row < MT ? row : 0);
                    f32x4 x1[2], x2[2]; float ss = 0.f;
#pragma unroll
                    for (int n = 0; n < 2; ++n) { x1[n] = acc[ai][0][m][n]; x2[n] = acc[ai][1][m][n];
                        ss += (x1[n][0] * x1[n][0] + x1[n][1] * x1[n][1]) + (x1[n][2] * x1[n][2] + x1[n][3] * x1[n][3]) + (x2[n][0] * x2[n][0] + x2[n][1] * x2[n][1]) + (x2[n][2] * x2[n][2] + x2[n][3] * x2[n][3]); }
                    ss += __shfl_xor(ss, 16); ss += __shfl_xor(ss, 32);
                    const float inv = rsqrtf(ss * (1.f / 64.f) + EPS);
                    f32x4 o1[2], o2[2];
#pragma unroll
                    for (int n = 0; n < 2; ++n) { const f32x4 y1 = x1[n] * inv * g1[n], y2 = x2[n] * inv * g2[n];
                        const f32x4 cs0 = *(const f32x4*)(tab32 + pos * 32 + d0 + 4 * n), cs1 = *(const f32x4*)(tab32 + pos * 32 + d0 + 4 * n + 2);
                        const f32x4 c = {cs0[0], cs0[2], cs1[0], cs1[2]}, s = {cs0[1], cs0[3], cs1[1], cs1[3]};
                        o1[n] = y1 * c - y2 * s; o2[n] = y1 * s + y2 * c; }
                    *(u32x4*)(KPE + (size_t)row * 64 + d0) = pack8f(o1[0], o1[1]); *(u32x4*)(KPE + (size_t)row * 64 + 32 + d0) = pack8f(o2[0], o2[1]);
                    if (row < MT) {
                        float* o = row < MP ? out + O_RKP + (size_t)row * 64 : out + O_RKS + (size_t)(row - MP) * 64;
                        *(f32x4*)(o + d0) = o1[0]; *(f32x4*)(o + d0 + 4) = o1[1]; *(f32x4*)(o + 32 + d0) = o2[0]; *(f32x4*)(o + 32 + d0 + 4) = o2[1];
                        if (row >= MP) { const int rs = row - MP, b = rs / DEC_SEQ, tt = rs % DEC_SEQ; bf16_t* p = PES + ((size_t)b * SKEYS + PAST + tt) * 64;
                            *(u32x4*)(p + d0) = pack8f(o1[0], o1[1]); *(u32x4*)(p + 32 + d0) = pack8f(o2[0], o2[1]); } } }
        } else if (kind == K_RQ || kind == K_RK) {
            const int tl = kind == K_RQ ? u.pn - 6 : u.pn - 8; const int head = 2 * tl + (wc >> 1), i0 = 32 * (wc & 1) + fq * 8;
            bf16_t* dst = kind == K_RQ ? RQ : RK; const float sc = kind == K_RQ ? 1.0f : 0.08838834764831845f;
#pragma unroll
            for (int ai = 0; ai < 2; ++ai)
#pragma unroll
                for (int m = 0; m < 4; ++m) { const int row = rb + ai * 128 + m * 16; const int pos = row_pos(row < MT ? row : 0);
                    f32x4 o1[2], o2[2];
#pragma unroll
                    for (int n = 0; n < 2; ++n) { const f32x4 x1 = acc[ai][0][m][n], x2 = acc[ai][1][m][n];
                        const f32x4 cs0 = *(const f32x4*)(tab64 + pos * 64 + i0 + 4 * n), cs1 = *(const f32x4*)(tab64 + pos * 64 + i0 + 4 * n + 2);
                        const f32x4 c = {cs0[0], cs0[2], cs1[0], cs1[2]}, s = {cs0[1], cs0[3], cs1[1], cs1[3]};
                        o1[n] = (x1 * c - x2 * s) * sc; o2[n] = (x1 * s + x2 * c) * sc; }
                    *(u32x4*)(dst + (size_t)row * 512 + head * 128 + i0) = pack8f(o1[0], o1[1]); *(u32x4*)(dst + (size_t)row * 512 + head * 128 + 64 + i0) = pack8f(o2[0], o2[1]); }
        } else {
            const int t = kind == K_RV ? u.pn - 10 : u.pn - 14; bf16_t* dst = kind == K_RV ? RV : RG;
#pragma unroll
            for (int ai = 0; ai < 2; ++ai)
#pragma unroll
                for (int m = 0; m < 4; ++m) { const int row = rb + ai * 128 + m * 16;
#pragma unroll
                    for (int bj = 0; bj < 2; ++bj) { f32x4 v0 = acc[ai][bj][m][0], v1 = acc[ai][bj][m][1];
                        if (kind == K_RG) {
#pragma unroll
                            for (int e = 0; e < 4; ++e) { v0[e] = v0[e] / (1.f + __expf(-v0[e])); v1[e] = v1[e] / (1.f + __expf(-v1[e])); } }
                        *(u32x4*)(dst + (size_t)row * 1024 + t * 256 + bj * 128 + cw) = pack8f(v0, v1); } }
        }
    }
};
__device__ __forceinline__ void p1_inproj(Frame& F) {
    SchedP1 S{F.x, F.j, (const char*)(F.ws + WS_XN), (const char*)(F.ws + WS_FWIN)};
    EpiP1 E{F.ws, F.out, FIN(12), FIN(15)};
    pg::gemm_stream(F.lds, S, E);
}

constexpr int NPHASE = 2;
__global__ void __launch_bounds__(NTHR, 2) mk(const MArgs a) {
    extern __shared__ __attribute__((aligned(16))) unsigned char lds_raw[];
    Frame F;
    F.lds = (LAS unsigned char*)lds_raw;
    F.tid = threadIdx.x; F.lane = F.tid & 63; F.wave = __builtin_amdgcn_readfirstlane(F.tid >> 6);
    F.G = gridDim.x; F.x = blockIdx.x % 8; F.j = blockIdx.x / 8; F.vcu = F.x * (F.G / 8) + F.j;
    F.a = &a; F.out = a.out; F.ws = a.ws;
    volatile LAS unsigned* MISC = (volatile LAS unsigned*)(F.lds + MISC_OFF);
    if (F.tid < 32) MISC[F.tid] = 0u;
    __syncthreads();
    XcdBarrier bar = xcd_barrier_post((unsigned*)(a.ws + WS_CTL) + CW_BAR, MISC + 8);
    const int lo = a.ph_lo, hi = a.ph_hi;
#define IN_(k) (lo <= (k) && (k) < hi)
#define SEAM_(k) do { if (IN_(k) && IN_((k) + 1)) xcd_barrier(bar); } while (0)
    if (IN_(0)) { p0_prologue(F); } SEAM_(0);
    if (IN_(1)) { p1_inproj(F); } SEAM_(1);
}

__global__ void k_slotsum(const float* __restrict__ slotq, const float* __restrict__ slotkv, float* __restrict__ sq, float* __restrict__ skv) {
    const int r = blockIdx.x * blockDim.x + threadIdx.x; if (r >= MT) return;
    float a = 0.f; for (int i = 0; i < 12; ++i) a += slotq[(size_t)r * 12 + i]; sq[r] = rsqrtf(a * (1.f / Q_LORA) + EPS);
    float b = 0.f; for (int i = 0; i < 8; ++i) b += slotkv[(size_t)r * 8 + i]; skv[r] = rsqrtf(b * (1.f / KV_LORA) + EPS);
}
__global__ void k_kvl_finish2(const bf16_t* __restrict__ kvl, const float* __restrict__ skv, float* __restrict__ dout, bf16_t* __restrict__ lats) {
    const int r = blockIdx.x * 4 + (threadIdx.x >> 6), lane = threadIdx.x & 63; if (r >= MT) return;
    const float s = skv[r];
    float* o = r < MP ? dout + O_LATP + (size_t)r * KV_LORA : dout + O_LATS + (size_t)(r - MP) * KV_LORA;
#pragma unroll
    for (int jj = 0; jj < 8; ++jj) { const int c = jj * 64 + lane; const float y = bf2f(kvl[(size_t)r * KV_LORA + c]) * s; o[c] = y;
        if (r >= MP) { const int rs = r - MP, b = rs / DEC_SEQ, t = rs % DEC_SEQ; lats[((size_t)b * SKEYS + PAST + t) * KV_LORA + c] = f2bf(y); } }
}

static void gemm(hipStream_t s, const bf16_t* A, int lda, const bf16_t* Bt, int K, int M, int N, const Epi& E) {
    const int nb = ((M + 63) / 64) * (N / 64);
    hipLaunchKernelGGL(k_gemm, dim3(nb), dim3(256), 0, s, A, lda, Bt, K, M, N, E);
}
static Epi mkepi(int mode, bf16_t* o1, int ldo) { Epi e{}; e.mode = mode; e.o1 = o1; e.ldo = ldo; return e; }

extern "C" void kernel_launch(void* const* d_in, const int* in_sizes, int n_in, void* d_out, int out_size, void* d_ws, size_t ws_size, hipStream_t stream) {
    const float* x_p = (const float*)d_in[0]; const float* x_s = (const float*)d_in[1];
    const float* st_ret = (const float*)d_in[4]; const float* st_conv = (const float*)d_in[5];
    const float* w_in = (const float*)d_in[7]; const float* g_qlat = (const float*)d_in[8]; const float* w_qup = (const float*)d_in[9];
    const float* g_qn = (const float*)d_in[10]; const float* g_qr = (const float*)d_in[11]; const float* w_kvup = (const float*)d_in[13];
    const float* g_kn = (const float*)d_in[14]; const float* g_ret = (const float*)d_in[16]; const float* w_ob = (const float*)d_in[17];
    const float* w_out = (const float*)d_in[18]; const float* g_ffn = (const float*)d_in[19]; const float* w_up = (const float*)d_in[20]; const float* cw = (const float*)d_in[21];
    const float* cb = (const float*)d_in[22]; const float* w_down = (const float*)d_in[23]; const float* g_mix = (const float*)d_in[6];
    float* out = (float*)d_out; char* ws = (char*)d_ws;
    static int ok = 0;
    if (ok == 0) {
        ok = 1;
        if (ws_size < 256 * MiB || n_in != 24) { fprintf(stderr, "kernel_launch: bad ws/n_in: %zu %d\n", ws_size, n_in); ok = -1; }
        int dev = 0, cus = 0; hipGetDevice(&dev); hipDeviceGetAttribute(&cus, hipDeviceAttributeMultiprocessorCount, dev);
        if (cus != 256) { fprintf(stderr, "kernel_launch: built for 256 CUs, got %d\n", cus); ok = -1; }
        if (hipFuncSetAttribute((const void*)mk, hipFuncAttributeMaxDynamicSharedMemorySize, LDS_BYTES) != hipSuccess) { fprintf(stderr, "kernel_launch: hipFuncSetAttribute(mk) failed\n"); ok = -1; }
        if (hipFuncSetAttribute((const void*)k_ret, hipFuncAttributeMaxDynamicSharedMemorySize, 110 * 1024) != hipSuccess) { fprintf(stderr, "kernel_launch: hipFuncSetAttribute(k_ret) failed\n"); ok = -1; }
        (void)hipGetLastError();
    }
    if (ok < 0) return;
#define WSB(off) ((bf16_t*)(ws + (off)))
    float* SQ = (float*)(ws + WS_SQ); float* SKV = (float*)(ws + WS_SKV);
    float2* TAB32 = (float2*)(ws + WS_TAB32); float2* TAB64 = (float2*)(ws + WS_TAB64);

    (void)hipMemsetAsync(ws + WS_CTL, 0, CTL_BYTES, stream);
    { MArgs a{}; for (int i = 0; i < 24; ++i) a.in[i] = (const float*)d_in[i]; a.out = out; a.ws = (unsigned char*)ws; a.ph_lo = 0; a.ph_hi = 2;
      hipLaunchKernelGGL(mk, dim3(256), dim3(NTHR), LDS_BYTES, stream, a); }
    hipLaunchKernelGGL(k_slotsum, dim3((MT + 255) / 256), dim3(256), 0, stream, (const float*)((char*)out + DO_SLOTQ), (const float*)((char*)out + DO_SLOTKV), SQ, SKV);
    hipLaunchKernelGGL(k_kvl_finish2, dim3(MT / 4), dim3(256), 0, stream, WSB(WS_KVL), SKV, out, WSB(WS_LATS));

    auto conv = [&](const float* W, int ldw, int K, int N, const float* gain, size_t off) { hipLaunchKernelGGL(k_convert_w, dim3((K / 32) * (N / 32)), dim3(256), 0, stream, W, ldw, K, N, gain, WSB(off)); };
    conv(w_in, IN_W, 1024, IN_W, g_mix, WS_WIN);
    conv(w_qup, 1536, 768, 1536, g_qlat, WS_WQUP);
    conv(w_kvup, 2048, 512, 2048, nullptr, WS_WKVUPN);
    conv(w_ob, 1024, 1024, 1024, nullptr, WS_WOBA);
    conv(w_ob + (size_t)1024 * 1024, 1024, 1024, 1024, nullptr, WS_WOBB);
    conv(w_out, 1024, 1024, 1024, nullptr, WS_WOUT);
    conv(w_up, FF2, 1024, FF2, g_ffn, WS_WUP);
    conv(w_down, 1024, D_FF, 1024, nullptr, WS_WDOWN);
    const bf16_t* WIN = WSB(WS_WIN);

    const size_t ret_lds = (size_t)(64 * 129 * 2 + 128 * 33 + 64 * 33 + 64 * 65) * 4;
    hipLaunchKernelGGL(k_ret, dim3(BATCH * RET_H * 8), dim3(256), ret_lds, stream, WSB(WS_RQ), WSB(WS_RK), WSB(WS_RV), 0, SEQ, 64, SEQ / 64, (const float*)nullptr, WSB(WS_RET), out + O_RETP);
    hipLaunchKernelGGL(k_ret, dim3(DEC_BATCH * RET_H * 8), dim3(256), ret_lds, stream, WSB(WS_RQ), WSB(WS_RK), WSB(WS_RV), MP, DEC_SEQ, DEC_SEQ, 1, st_ret, WSB(WS_RET), out + O_RETS);
    hipLaunchKernelGGL(k_ret_finish, dim3(MT / 4), dim3(256), 0, stream, WSB(WS_RET), g_ret, WSB(WS_RG));

    bf16_t* Qb = (bf16_t*)out;
    { Epi e = mkepi(EP_ROWSCALE, Qb, 1536); e.rs = SQ; gemm(stream, WSB(WS_ZQ), 768, WSB(WS_WQUP), 768, MT, 1536, e); }
    const float C2 = 0.07216878364870323f * 1.4426950408889634f;
    hipLaunchKernelGGL(k_q_finish, dim3(MT / 4), dim3(256), 0, stream, Qb, g_qn, g_qr, TAB32, C2);

    { Epi e = mkepi(EP_KVSPLIT, WSB(WS_KN), 0); e.o2 = WSB(WS_V); e.rs = nullptr; gemm(stream, WSB(WS_LATS), 512, WSB(WS_WKVUPN), 512, LROWS, 2048, e); }
    hipLaunchKernelGGL(k_kn_finish, dim3(LROWS / 4), dim3(256), 0, stream, WSB(WS_KN), g_kn, LROWS);
    hipLaunchKernelGGL(k_attn<1>, dim3(DEC_BATCH * HEADS), dim3(64), 0, stream, Qb, WSB(WS_KN), WSB(WS_PES), WSB(WS_V), WSB(WS_ATT), 1);
    { Epi e = mkepi(EP_KVSPLIT, WSB(WS_KN), 0); e.o2 = WSB(WS_V); e.rs = SKV; gemm(stream, WSB(WS_KVL), 512, WSB(WS_WKVUPN), 512, MP, 2048, e); }
    hipLaunchKernelGGL(k_kn_finish, dim3(MP / 4), dim3(256), 0, stream, WSB(WS_KN), g_kn, MP);
    hipLaunchKernelGGL(k_attn<4>, dim3(BATCH * HEADS * 128), dim3(256), 0, stream, Qb, WSB(WS_KN), WSB(WS_KPE), WSB(WS_V), WSB(WS_ATT), 0);

    bf16_t* GA = (bf16_t*)out; bf16_t* GB = GA + (size_t)MT * 1024;
    hipLaunchKernelGGL(k_rownorm, dim3(MT / 4), dim3(256), 0, stream, x_p, x_s, WSB(WS_XN2));
    gemm(stream, WSB(WS_XN2), 1024, WIN + (size_t)C_GA * 1024, 1024, MT, 1024, mkepi(EP_SIGM, GA, 1024));
    gemm(stream, WSB(WS_XN2), 1024, WIN + (size_t)C_GB * 1024, 1024, MT, 1024, mkepi(EP_SIGM, GB, 1024));
    { Epi e = mkepi(EP_MUL, WSB(WS_MERGED), 1024); e.g = GA; gemm(stream, WSB(WS_ATT), 1024, WSB(WS_WOBA), 1024, MT, 1024, e); }
    { Epi e = mkepi(EP_MULADD, WSB(WS_MERGED), 1024); e.g = GB; gemm(stream, WSB(WS_RET), 1024, WSB(WS_WOBB), 1024, MT, 1024, e); }
    { Epi e = mkepi(EP_RESID, nullptr, 1024); e.xa = x_p; e.xb = x_s; e.of = out; gemm(stream, WSB(WS_MERGED), 1024, WSB(WS_WOUT), 1024, MT, 1024, e); }
    hipLaunchKernelGGL(k_x1_finish, dim3(MT / 4), dim3(256), 0, stream, out, WSB(WS_X1B));
    gemm(stream, WSB(WS_X1B), 1024, WSB(WS_WUP), 1024, MT, FF2, mkepi(EP_BF16, WSB(WS_U), FF2));
    hipLaunchKernelGGL(k_convout, dim3((DEC_BATCH * 2 * FF2 + 255) / 256), dim3(256), 0, stream, WSB(WS_U), out);
    hipLaunchKernelGGL(k_halo, dim3(64 + DEC_BATCH), dim3(256), 0, stream, WSB(WS_U), st_conv, WSB(WS_HALO));
    hipLaunchKernelGGL(k_conv, dim3((64 + DEC_BATCH) * 11), dim3(256), 0, stream, WSB(WS_U), WSB(WS_HALO), cw, cb);
    { Epi e = mkepi(EP_RESID_INPLACE, nullptr, 1024); e.of = out; gemm(stream, WSB(WS_U), FF2, WSB(WS_WDOWN), D_FF, MT, 1024, e); }
}
```

```cpp
#include <hip/hip_runtime.h>
#include <stdint.h>
#include <cstdio>

typedef unsigned short bf16_t;
typedef short bf16x8 __attribute__((ext_vector_type(8)));
typedef float f32x4 __attribute__((ext_vector_type(4)));
typedef float f32x2 __attribute__((ext_vector_type(2)));
typedef unsigned u32x4 __attribute__((ext_vector_type(4)));
typedef unsigned u32x2 __attribute__((ext_vector_type(2)));

constexpr int D_MODEL = 1024, BATCH = 2, SEQ = 8192, DEC_BATCH = 8, DEC_SEQ = 16, PAST = 2048;
constexpr int MP = BATCH * SEQ, MS = DEC_BATCH * DEC_SEQ, MT = MP + MS;
constexpr int MPAD = 16640;
constexpr int Q_LORA = 768, KV_LORA = 512, QK_NOPE = 128, QK_ROPE = 64, V_HEAD = 128, HEADS = 8;
constexpr int RET_H = 4, RET_DK = 128, RET_DV = 256;
constexpr int D_FF = 2816, FF2 = 2 * D_FF;
constexpr int IN_W = 6464;
constexpr int SKEYS = PAST + DEC_SEQ;
constexpr int LROWS = DEC_BATCH * SKEYS;
constexpr float EPS = 1e-6f;
constexpr int C_QLAT = 0, C_KVLAT = 768, C_KPE = 1280, C_RQ = 1344, C_RK = 1856, C_RV = 2368, C_RG = 3392, C_GA = 4416, C_GB = 5440;

constexpr size_t O_YP = 0, O_YS = 16777216, O_LATP = 16908288, O_RKP = 25296896, O_RETP = 26345472, O_CONVP = 26607616,
                 O_LATS = 26630144, O_RKS = 26695680, O_RETS = 26703872, O_CONVS = 27752448;

constexpr size_t MiB = 1u << 20, KiB = 1024;
constexpr size_t WS_CTL = 0, CTL_BYTES = 64 * KiB, WS_SQ = 64 * KiB, WS_SKV = 192 * KiB;
constexpr size_t WS_SLOTQ = 1 * MiB, WS_SLOTKV = 2 * MiB, WS_SLOTX1 = 3 * MiB;
constexpr size_t WS_TAB32 = 4 * MiB + 256 * KiB, WS_TAB64 = 6 * MiB + 256 * KiB;
constexpr size_t WS_FWUP = 10 * MiB + 512 * KiB, WS_FWDOWN = 21 * MiB + 512 * KiB, WS_FWIN = 27 * MiB, WS_FWQUP = 40 * MiB, WS_FWKVUP = 43 * MiB,
                 WS_FWOBA = 45 * MiB, WS_FWOBB = 47 * MiB, WS_FWOUT = 49 * MiB;
constexpr size_t WS_XN = 51 * MiB, WS_RET = 51 * MiB;
constexpr size_t WS_LATS = 83 * MiB + 512 * KiB, WS_PES = 99 * MiB + 768 * KiB, WS_ZQ = 102 * MiB, WS_KVL = 126 * MiB + 512 * KiB, WS_KPE = 142 * MiB + 768 * KiB;
constexpr size_t WS_RQ = 145 * MiB, WS_RK = 161 * MiB + 256 * KiB, WS_RV = 177 * MiB + 512 * KiB, WS_RG = 210 * MiB;
constexpr size_t WS_KN = 145 * MiB, WS_V = 177 * MiB + 512 * KiB, WS_ATTS = 242 * MiB + 512 * KiB, WS_XN2 = 210 * MiB, WS_ATT = 102 * MiB;
constexpr size_t WS_T1 = 166 * MiB + 512 * KiB, WS_MERGED = 134 * MiB;
constexpr size_t WS_X1B = 223 * MiB + 512 * KiB, WS_U = 27 * MiB, WS_HALO = 206 * MiB;

__device__ __forceinline__ bf16_t f2bf(float f) { unsigned u = __float_as_uint(f); u = (u + 0x7fffu + ((u >> 16) & 1u)) >> 16; return (bf16_t)u; }
__device__ __forceinline__ float bf2f(bf16_t b) { return __uint_as_float(((unsigned)b) << 16); }
__device__ __forceinline__ float wave_sum(float v) {
#pragma unroll
    for (int o = 1; o < 64; o <<= 1) v += __shfl_xor(v, o);
    return v;
}
__device__ __forceinline__ float sigmoidf_(float x) { return 1.f / (1.f + __expf(-x)); }
__device__ __forceinline__ float siluf_(float x) { return x / (1.f + __expf(-x)); }

__global__ void k_convert_w(const float* __restrict__ W, int ldw, int K, int N, const float* __restrict__ gain, bf16_t* __restrict__ Wt) {
    __shared__ float tile[32][33];
    const int nb = N / 32, kb = blockIdx.x / nb, nbi = blockIdx.x % nb;
    const int tx = threadIdx.x & 31, ty = threadIdx.x >> 5;
    for (int i = ty; i < 32; i += 8) { const int k = kb * 32 + i; tile[i][tx] = W[(size_t)k * ldw + nbi * 32 + tx] * (gain ? gain[k] : 1.f); }
    __syncthreads();
    for (int i = ty; i < 32; i += 8) { const int n = nbi * 32 + i; Wt[(size_t)n * K + kb * 32 + tx] = f2bf(tile[tx][i]); }
}
__global__ void k_tables(float2* tab32, float2* tab64) {
    const int idx = blockIdx.x * blockDim.x + threadIdx.x;
    if (idx < 8192 * 32) { const int pos = idx / 32, i = idx % 32; const double f = pow(10000.0, -(double)i / 32.0), a = (double)pos * f; tab32[idx] = make_float2((float)cos(a), (float)sin(a)); }
    if (idx < 8192 * 64) { const int pos = idx / 64, i = idx % 64; const double f = pow(10000.0, -(double)i / 64.0), a = (double)pos * f; tab64[idx] = make_float2((float)cos(a), (float)sin(a)); }
}
__global__ void k_rownorm(const float* __restrict__ xa, const float* __restrict__ xb, bf16_t* __restrict__ out) {
    const int r = blockIdx.x * 4 + (threadIdx.x >> 6), lane = threadIdx.x & 63; if (r >= MT) return;
    const float* x = r < MP ? xa + (size_t)r * D_MODEL : xb + (size_t)(r - MP) * D_MODEL;
    f32x4 v[4]; float s = 0.f;
#pragma unroll
    for (int j = 0; j < 4; ++j) { v[j] = *(const f32x4*)(x + j * 256 + lane * 4); s += v[j][0] * v[j][0] + v[j][1] * v[j][1] + v[j][2] * v[j][2] + v[j][3] * v[j][3]; }
    const float inv = rsqrtf(wave_sum(s) * (1.f / D_MODEL) + EPS);
#pragma unroll
    for (int j = 0; j < 4; ++j) { bf16_t* o = out + (size_t)r * D_MODEL + j * 256 + lane * 4;
        o[0] = f2bf(v[j][0] * inv); o[1] = f2bf(v[j][1] * inv); o[2] = f2bf(v[j][2] * inv); o[3] = f2bf(v[j][3] * inv); }
}
__global__ void k_cache(const float* __restrict__ clat, const float* __restrict__ cpe, bf16_t* __restrict__ lats, bf16_t* __restrict__ pes) {
    const size_t idx = (size_t)blockIdx.x * blockDim.x + threadIdx.x;
    const size_t nlat = (size_t)DEC_BATCH * PAST * KV_LORA, npe = (size_t)DEC_BATCH * PAST * QK_ROPE;
    if (idx < nlat) { const int c = idx % KV_LORA; const size_t rj = idx / KV_LORA; const int j = rj % PAST, b = rj / PAST; lats[((size_t)b * SKEYS + j) * KV_LORA + c] = f2bf(clat[idx]); }
    if (idx < npe) { const int c = idx % QK_ROPE; const size_t rj = idx / QK_ROPE; const int j = rj % PAST, b = rj / PAST; pes[((size_t)b * SKEYS + j) * QK_ROPE + c] = f2bf(cpe[idx]); }
}

enum { EP_BF16 = 0, EP_SILU = 1, EP_SIGM = 2, EP_ROWSCALE = 3, EP_KVSPLIT = 4, EP_MUL = 5, EP_MULADD = 6, EP_RESID = 7, EP_RESID_INPLACE = 8 };
struct Epi {
    int mode; int ldo; bf16_t* o1; bf16_t* o2; const float* rs; const bf16_t* g; const float* xa; const float* xb; float* of;
};
__device__ __forceinline__ void epi_apply(const Epi& E, int r, int c, float v) {
    switch (E.mode) {
    case EP_BF16: E.o1[(size_t)r * E.ldo + c] = f2bf(v); break;
    case EP_SILU: E.o1[(size_t)r * E.ldo + c] = f2bf(siluf_(v)); break;
    case EP_SIGM: E.o1[(size_t)r * E.ldo + c] = f2bf(sigmoidf_(v)); break;
    case EP_ROWSCALE: E.o1[(size_t)r * E.ldo + c] = f2bf(v * E.rs[r]); break;
    case EP_KVSPLIT: { const int h = c >> 8, j = c & 255; const float s = E.rs ? E.rs[r] : 1.f;
        if (j < 128) E.o1[(size_t)r * 1024 + h * 128 + j] = f2bf(v * s); else E.o2[(size_t)r * 1024 + h * 128 + (j - 128)] = f2bf(v * s); } break;
    case EP_MUL: E.o1[(size_t)r * E.ldo + c] = f2bf(v * bf2f(E.g[(size_t)r * E.ldo + c])); break;
    case EP_MULADD: { const size_t i = (size_t)r * E.ldo + c; E.o1[i] = f2bf(bf2f(E.o1[i]) + v * bf2f(E.g[i])); } break;
    case EP_RESID: { const float x = r < MP ? E.xa[(size_t)r * D_MODEL + c] : E.xb[(size_t)(r - MP) * D_MODEL + c]; E.of[(size_t)r * D_MODEL + c] = x + v; } break;
    case EP_RESID_INPLACE: { const size_t i = (size_t)r * D_MODEL + c; E.of[i] = E.of[i] + v; } break;
    }
}
__global__ void __launch_bounds__(256) k_gemm(const bf16_t* __restrict__ A, int lda, const bf16_t* __restrict__ Bt, int K, int M, int N, Epi E) {
    __shared__ bf16_t As[64][72], Bs[64][72];
    const int nbn = N / 64, bm = blockIdx.x / nbn, bn = blockIdx.x % nbn;
    const int tid = threadIdx.x, w = tid >> 6, lane = tid & 63, fr = lane & 15, fq = lane >> 4;
    f32x4 acc[4] = {};
    const int lr = tid >> 2, lc = (tid & 3) * 16;
    for (int k0 = 0; k0 < K; k0 += 64) {
        const int ar = bm * 64 + lr;
        bf16x8 a0 = {}, a1 = {};
        if (ar < M) { a0 = *(const bf16x8*)(A + (size_t)ar * lda + k0 + lc); a1 = *(const bf16x8*)(A + (size_t)ar * lda + k0 + lc + 8); }
        const bf16x8 b0 = *(const bf16x8*)(Bt + (size_t)(bn * 64 + lr) * K + k0 + lc), b1 = *(const bf16x8*)(Bt + (size_t)(bn * 64 + lr) * K + k0 + lc + 8);
        __syncthreads();
        *(bf16x8*)&As[lr][lc] = a0; *(bf16x8*)&As[lr][lc + 8] = a1; *(bf16x8*)&Bs[lr][lc] = b0; *(bf16x8*)&Bs[lr][lc + 8] = b1;
        __syncthreads();
#pragma unroll
        for (int ks = 0; ks < 2; ++ks) {
            const bf16x8 af = *(const bf16x8*)&As[w * 16 + fr][ks * 32 + fq * 8];
#pragma unroll
            for (int n = 0; n < 4; ++n) { const bf16x8 bfr = *(const bf16x8*)&Bs[n * 16 + fr][ks * 32 + fq * 8];
                acc[n] = __builtin_amdgcn_mfma_f32_16x16x32_bf16(af, bfr, acc[n], 0, 0, 0); }
        }
    }
#pragma unroll
    for (int n = 0; n < 4; ++n)
#pragma unroll
        for (int i = 0; i < 4; ++i) { const int r = bm * 64 + w * 16 + fq * 4 + i, c = bn * 64 + n * 16 + fr; if (r < M) epi_apply(E, r, c, acc[n][i]); }
}

__global__ void k_zq_finish(const bf16_t* __restrict__ zq, float* __restrict__ sq) {
    const int r = blockIdx.x * 4 + (threadIdx.x >> 6), lane = threadIdx.x & 63; if (r >= MT) return;
    float s = 0.f; for (int c = lane; c < Q_LORA; c += 64) { const float v = bf2f(zq[(size_t)r * Q_LORA + c]); s += v * v; }
    s = wave_sum(s); if (lane == 0) sq[r] = rsqrtf(s * (1.f / Q_LORA) + EPS);
}
__global__ void k_kvl_finish(const bf16_t* __restrict__ kvl, const float* __restrict__ g, float* __restrict__ skv, float* __restrict__ dout, bf16_t* __restrict__ lats) {
    const int r = blockIdx.x * 4 + (threadIdx.x >> 6), lane = threadIdx.x & 63; if (r >= MT) return;
    float v[8]; float s = 0.f;
#pragma unroll
    for (int j = 0; j < 8; ++j) { v[j] = bf2f(kvl[(size_t)r * KV_LORA + j * 64 + lane]); s += v[j] * v[j]; }
    const float inv = rsqrtf(wave_sum(s) * (1.f / KV_LORA) + EPS); if (lane == 0) skv[r] = inv;
    float* o = r < MP ? dout + O_LATP + (size_t)r * KV_LORA : dout + O_LATS + (size_t)(r - MP) * KV_LORA;
#pragma unroll
    for (int j = 0; j < 8; ++j) { const int c = j * 64 + lane; const float y = v[j] * inv * g[c]; o[c] = y;
        if (r >= MP) { const int rs = r - MP, b = rs / DEC_SEQ, t = rs % DEC_SEQ; lats[((size_t)b * SKEYS + PAST + t) * KV_LORA + c] = f2bf(y); } }
}
__global__ void k_kpe_finish(const bf16_t* __restrict__ raw, const float* __restrict__ g, const float2* __restrict__ tab32, bf16_t* __restrict__ kpe, float* __restrict__ dout, bf16_t* __restrict__ pes) {
    const int r = blockIdx.x * 4 + (threadIdx.x >> 6), lane = threadIdx.x & 63; if (r >= MT) return;
    const float v = bf2f(raw[(size_t)r * 64 + lane]); const float inv = rsqrtf(wave_sum(v * v) * (1.f / 64.f) + EPS);
    const float y = v * inv * g[lane]; const float yo = __shfl_xor(y, 32);
    const int pos = r < MP ? (r % SEQ) : PAST + ((r - MP) % DEC_SEQ);
    const float2 cs = tab32[pos * 32 + (lane & 31)];
    const float o = lane < 32 ? y * cs.x - yo * cs.y : yo * cs.y + y * cs.x;
    kpe[(size_t)r * 64 + lane] = f2bf(o);
    if (r < MP) dout[O_RKP + (size_t)r * 64 + lane] = o;
    else { const int rs = r - MP, b = rs / DEC_SEQ, t = rs % DEC_SEQ; dout[O_RKS + (size_t)rs * 64 + lane] = o; pes[((size_t)b * SKEYS + PAST + t) * 64 + lane] = f2bf(o); }
}
__global__ void k_rope_r(bf16_t* __restrict__ buf, const float2* __restrict__ tab64, float scale) {
    const int r = blockIdx.x, tid = threadIdx.x;
    const int h = tid >> 6, i = tid & 63; const int pos = r < MP ? (r % SEQ) : PAST + ((r - MP) % DEC_SEQ);
    bf16_t* p = buf + (size_t)r * 512 + h * 128; const float x1 = bf2f(p[i]), x2 = bf2f(p[i + 64]); const float2 cs = tab64[pos * 64 + i];
    p[i] = f2bf((x1 * cs.x - x2 * cs.y) * scale); p[i + 64] = f2bf((x1 * cs.y + x2 * cs.x) * scale);
}
__global__ void k_q_finish(bf16_t* __restrict__ q, const float* __restrict__ gn, const float* __restrict__ gr, const float2* __restrict__ tab32, float c2) {
    const int r = blockIdx.x * 4 + (threadIdx.x >> 6), lane = threadIdx.x & 63; if (r >= MT) return;
    const int pos = r < MP ? (r % SEQ) : PAST + ((r - MP) % DEC_SEQ);
    for (int h = 0; h < HEADS; ++h) {
        bf16_t* p = q + (size_t)r * 1536 + h * 192;
        const float a = bf2f(p[lane]), b = bf2f(p[lane + 64]), c = bf2f(p[128 + lane]);
        const float in = rsqrtf(wave_sum(a * a + b * b) * (1.f / 128.f) + EPS), ir = rsqrtf(wave_sum(c * c) * (1.f / 64.f) + EPS);
        p[lane] = f2bf(a * in * gn[lane] * c2); p[lane + 64] = f2bf(b * in * gn[lane + 64] * c2);
        const float y = c * ir * gr[lane], yo = __shfl_xor(y, 32); const float2 cs = tab32[pos * 32 + (lane & 31)];
        p[128 + lane] = f2bf((lane < 32 ? y * cs.x - yo * cs.y : yo * cs.y + y * cs.x) * c2);
    }
}
__global__ void k_kn_finish(bf16_t* __restrict__ kn, const float* __restrict__ g, int rows) {
    const int r = blockIdx.x * 4 + (threadIdx.x >> 6), lane = threadIdx.x & 63; if (r >= rows) return;
    for (int h = 0; h < HEADS; ++h) { bf16_t* p = kn + (size_t)r * 1024 + h * 128; const float a = bf2f(p[lane]), b = bf2f(p[lane + 64]);
        const float in = rsqrtf(wave_sum(a * a + b * b) * (1.f / 128.f) + EPS); p[lane] = f2bf(a * in * g[lane]); p[lane + 64] = f2bf(b * in * g[lane + 64]); }
}
__global__ void k_ret_finish(bf16_t* __restrict__ ret, const float* __restrict__ g, const bf16_t* __restrict__ gate) {
    const int r = blockIdx.x * 4 + (threadIdx.x >> 6), lane = threadIdx.x & 63; if (r >= MT) return;
    for (int h = 0; h < RET_H; ++h) { bf16_t* p = ret + (size_t)r * 1024 + h * 256; float v[4]; float s = 0.f;
#pragma unroll
        for (int j = 0; j < 4; ++j) { v[j] = bf2f(p[j * 64 + lane]); s += v[j]; }
        const float mu = wave_sum(s) * (1.f / 256.f); float q = 0.f;
#pragma unroll
        for (int j = 0; j < 4; ++j) { v[j] -= mu; q += v[j] * v[j]; }
        const float inv = rsqrtf(wave_sum(q) * (1.f / 256.f) + EPS);
#pragma unroll
        for (int j = 0; j < 4; ++j) { const int c = h * 256 + j * 64 + lane; p[j * 64 + lane] = f2bf(v[j] * inv * g[c] * bf2f(gate[(size_t)r * 1024 + c])); } }
}
__global__ void k_x1_finish(const float* __restrict__ x1, bf16_t* __restrict__ out) {
    const int r = blockIdx.x * 4 + (threadIdx.x >> 6), lane = threadIdx.x & 63; if (r >= MT) return;
    const float* x = x1 + (size_t)r * D_MODEL; f32x4 v[4]; float s = 0.f;
#pragma unroll
    for (int j = 0; j < 4; ++j) { v[j] = *(const f32x4*)(x + j * 256 + lane * 4); s += v[j][0] * v[j][0] + v[j][1] * v[j][1] + v[j][2] * v[j][2] + v[j][3] * v[j][3]; }
    const float inv = rsqrtf(wave_sum(s) * (1.f / D_MODEL) + EPS);
#pragma unroll
    for (int j = 0; j < 4; ++j) { bf16_t* o = out + (size_t)r * D_MODEL + j * 256 + lane * 4;
        o[0] = f2bf(v[j][0] * inv); o[1] = f2bf(v[j][1] * inv); o[2] = f2bf(v[j][2] * inv); o[3] = f2bf(v[j][3] * inv); }
}

template <int NW>
__global__ void __launch_bounds__(NW * 64) k_attn(const bf16_t* __restrict__ Q, const bf16_t* __restrict__ KN, const bf16_t* __restrict__ KPE, const bf16_t* __restrict__ V,
                                                 bf16_t* __restrict__ att, int sample) {
    __shared__ bf16_t Ks[64][200]; __shared__ bf16_t Vt[128][72]; __shared__ bf16_t Ps[NW][16][72];
    const int tid = threadIdx.x, w = tid >> 6, lane = tid & 63, fr = lane & 15, fq = lane >> 4;
    int b, h, qrow0, krow0, nkeys;
    if (!sample) { const int c = blockIdx.x % 128, bh = blockIdx.x / 128; h = bh % HEADS; b = bh / HEADS; qrow0 = b * SEQ + c * 64 + w * 16; krow0 = b * SEQ; nkeys = (c + 1) * 64; }
    else { h = blockIdx.x % HEADS; b = blockIdx.x / HEADS; qrow0 = MP + b * DEC_SEQ; krow0 = b * SKEYS; nkeys = SKEYS; }
    bf16x8 qf[6];
#pragma unroll
    for (int s = 0; s < 6; ++s) qf[s] = *(const bf16x8*)(Q + (size_t)(qrow0 + fr) * 1536 + h * 192 + s * 32 + fq * 8);
    f32x4 o[8] = {}; float m[4], l[4];
#pragma unroll
    for (int i = 0; i < 4; ++i) { m[i] = -1e30f; l[i] = 0.f; }
    const int ntile = (nkeys + 63) / 64;
    for (int t = 0; t < ntile; ++t) {
        __syncthreads();
        for (int idx = tid; idx < 64 * 24; idx += NW * 64) { const int key = idx / 24, ch = idx % 24; const int kg = t * 64 + key; bf16x8 v = {};
            if (kg < nkeys) { if (ch < 16) v = *(const bf16x8*)(KN + (size_t)(krow0 + kg) * 1024 + h * 128 + ch * 8); else v = *(const bf16x8*)(KPE + (size_t)(krow0 + kg) * 64 + (ch - 16) * 8); }
            *(bf16x8*)&Ks[key][ch * 8] = v; }
        for (int idx = tid; idx < 64 * 16; idx += NW * 64) { const int key = idx / 16, ch = idx % 16; const int kg = t * 64 + key; bf16x8 v = {};
            if (kg < nkeys) v = *(const bf16x8*)(V + (size_t)(krow0 + kg) * 1024 + h * 128 + ch * 8);
#pragma unroll
            for (int e = 0; e < 8; ++e) Vt[ch * 8 + e][key] = (bf16_t)v[e]; }
        __syncthreads();
        f32x4 s[4] = {};
#pragma unroll
        for (int ks = 0; ks < 6; ++ks)
#pragma unroll
            for (int n = 0; n < 4; ++n) { const bf16x8 kf = *(const bf16x8*)&Ks[n * 16 + fr][ks * 32 + fq * 8]; s[n] = __builtin_amdgcn_mfma_f32_16x16x32_bf16(qf[ks], kf, s[n], 0, 0, 0); }
#pragma unroll
        for (int n = 0; n < 4; ++n) if (t * 64 + n * 16 + fr >= nkeys) { s[n][0] = -INFINITY; s[n][1] = -INFINITY; s[n][2] = -INFINITY; s[n][3] = -INFINITY; }
        float alpha[4];
#pragma unroll
        for (int i = 0; i < 4; ++i) { float mx = fmaxf(fmaxf(s[0][i], s[1][i]), fmaxf(s[2][i], s[3][i]));
            mx = fmaxf(mx, __shfl_xor(mx, 1)); mx = fmaxf(mx, __shfl_xor(mx, 2)); mx = fmaxf(mx, __shfl_xor(mx, 4)); mx = fmaxf(mx, __shfl_xor(mx, 8));
            const float mn = fmaxf(m[i], mx); alpha[i] = exp2f(m[i] - mn); m[i] = mn; float ps = 0.f;
#pragma unroll
            for (int n = 0; n < 4; ++n) { const float p = exp2f(s[n][i] - mn); s[n][i] = p; ps += p; }
            ps += __shfl_xor(ps, 1); ps += __shfl_xor(ps, 2); ps += __shfl_xor(ps, 4); ps += __shfl_xor(ps, 8);
            l[i] = l[i] * alpha[i] + ps; }
#pragma unroll
        for (int n = 0; n < 4; ++n)
#pragma unroll
            for (int i = 0; i < 4; ++i) Ps[w][fq * 4 + i][n * 16 + fr] = f2bf(s[n][i]);
#pragma unroll
        for (int n = 0; n < 8; ++n)
#pragma unroll
            for (int i = 0; i < 4; ++i) o[n][i] *= alpha[i];
#pragma unroll
        for (int ks = 0; ks < 2; ++ks) { const bf16x8 pf = *(const bf16x8*)&Ps[w][fr][ks * 32 + fq * 8];
#pragma unroll
            for (int n = 0; n < 8; ++n) { const bf16x8 vf = *(const bf16x8*)&Vt[n * 16 + fr][ks * 32 + fq * 8]; o[n] = __builtin_amdgcn_mfma_f32_16x16x32_bf16(pf, vf, o[n], 0, 0, 0); } }
    }
#pragma unroll
    for (int i = 0; i < 4; ++i) { const float rl = 1.f / l[i]; const int r = qrow0 + fq * 4 + i;
#pragma unroll
        for (int n = 0; n < 8; ++n) att[(size_t)r * 1024 + h * 128 + n * 16 + fr] = f2bf(o[n][i] * rl); }
}

__global__ void __launch_bounds__(256) k_ret(const bf16_t* __restrict__ rq, const bf16_t* __restrict__ rk, const bf16_t* __restrict__ rv, int rowbase, int rows_per_batch, int L, int nch,
                                             const float* __restrict__ Sinit, bf16_t* __restrict__ retraw, float* __restrict__ Sout) {
    extern __shared__ float sm[];
    float* qs = sm;
    float* ks = qs + 64 * 129;
    float* Ss = ks + 64 * 129;
    float* vs = Ss + 128 * 33;
    float* sc = vs + 64 * 33;
    const int tid = threadIdx.x; const int sl = blockIdx.x % 8, h = (blockIdx.x / 8) % RET_H, b = blockIdx.x / 32;
    const float gam = 1.f - exp2f(-5.f - (float)h), lg2 = log2f(gam);
    for (int i = tid; i < 128 * 32; i += 256) { const int d = i / 32, e = i % 32; Ss[d * 33 + e] = Sinit ? Sinit[(((size_t)b * RET_H + h) * RET_DK + d) * RET_DV + sl * 32 + e] : 0.f; }
    const float gL = exp2f(lg2 * (float)L);
    for (int c = 0; c < nch; ++c) {
        const size_t r0 = (size_t)rowbase + (size_t)b * rows_per_batch + (size_t)c * L;
        __syncthreads();
        for (int i = tid; i < L * 128; i += 256) { const int j = i / 128, d = i % 128; qs[j * 129 + d] = bf2f(rq[(r0 + j) * 512 + h * 128 + d]); ks[j * 129 + d] = bf2f(rk[(r0 + j) * 512 + h * 128 + d]); }
        for (int i = tid; i < L * 32; i += 256) { const int j = i / 32, e = i % 32; vs[j * 33 + e] = bf2f(rv[(r0 + j) * 1024 + h * 256 + sl * 32 + e]); }
        __syncthreads();
        for (int p = tid; p < L * L; p += 256) { const int i = p / L, j = p % L; float s = 0.f;
            if (j <= i) { for (int d = 0; d < 128; ++d) s += qs[i * 129 + d] * ks[j * 129 + d]; s *= exp2f(lg2 * (float)(i - j)); }
            sc[i * 65 + j] = s; }
        __syncthreads();
        for (int p = tid; p < L * 32; p += 256) { const int i = p / 32, e = p % 32; float a = 0.f, cr = 0.f;
            for (int j = 0; j <= i; ++j) a += sc[i * 65 + j] * vs[j * 33 + e];
            for (int d = 0; d < 128; ++d) cr += qs[i * 129 + d] * Ss[d * 33 + e];
            retraw[(r0 + i) * 1024 + h * 256 + sl * 32 + e] = f2bf(a + cr * exp2f(lg2 * (float)(i + 1))); }
        __syncthreads();
        for (int p = tid; p < 128 * 32; p += 256) { const int d = p / 32, e = p % 32; float a = Ss[d * 33 + e] * gL;
            for (int j = 0; j < L; ++j) a += ks[j * 129 + d] * exp2f(lg2 * (float)(L - 1 - j)) * vs[j * 33 + e];
            Ss[d * 33 + e] = a; }
    }
    __syncthreads();
    for (int i = tid; i < 128 * 32; i += 256) { const int d = i / 32, e = i % 32; Sout[(((size_t)b * RET_H + h) * RET_DK + d) * RET_DV + sl * 32 + e] = Ss[d * 33 + e]; }
}

__global__ void k_halo(const bf16_t* __restrict__ U, const float* __restrict__ prev_s, bf16_t* __restrict__ halo) {
    const int ch = blockIdx.x; const int tid = threadIdx.x;
    for (int i = tid; i < 2 * FF2; i += 256) { const int k = i / FF2, n = i % FF2; float v = 0.f;
        if (ch < 64) { const int r0 = ch * 256; if ((r0 % SEQ) != 0) v = bf2f(U[(size_t)(r0 - 2 + k) * FF2 + n]); }
        else { const int b = ch - 64; v = prev_s[((size_t)b * 2 + k) * FF2 + n]; }
        halo[(size_t)ch * 2 * FF2 + i] = f2bf(v); }
}
__global__ void __launch_bounds__(256) k_conv(bf16_t* __restrict__ U, const bf16_t* __restrict__ halo, const float* __restrict__ cw, const float* __restrict__ cb) {
    const int ch = blockIdx.x / 11, strip = blockIdx.x % 11; const int n = strip * 256 + threadIdx.x;
    int r0, nr; if (ch < 64) { r0 = ch * 256; nr = 256; } else { r0 = MP + (ch - 64) * DEC_SEQ; nr = DEC_SEQ; }
    const int nv = n + D_FF;
    const float wg0 = cw[n], wg1 = cw[FF2 + n], wg2 = cw[2 * FF2 + n], bg = cb[n], wv0 = cw[nv], wv1 = cw[FF2 + nv], wv2 = cw[2 * FF2 + nv], bv = cb[nv];
    float g2 = bf2f(halo[(size_t)ch * 2 * FF2 + n]), g1 = bf2f(halo[(size_t)ch * 2 * FF2 + FF2 + n]);
    float v2 = bf2f(halo[(size_t)ch * 2 * FF2 + nv]), v1 = bf2f(halo[(size_t)ch * 2 * FF2 + FF2 + nv]);
    for (int i = 0; i < nr; ++i) { bf16_t* row = U + (size_t)(r0 + i) * FF2; const float g0 = bf2f(row[n]), v0 = bf2f(row[nv]);
        const float cg = g2 * wg0 + g1 * wg1 + g0 * wg2 + bg, cv = v2 * wv0 + v1 * wv1 + v0 * wv2 + bv;
        row[n] = f2bf(siluf_(cg) * cv); g2 = g1; g1 = g0; v2 = v1; v1 = v0; }
}
__global__ void k_convout(const bf16_t* __restrict__ U, float* __restrict__ dout) {
    const int idx = blockIdx.x * blockDim.x + threadIdx.x;
    if (idx < BATCH * 2 * FF2) { const int n = idx % FF2, k = (idx / FF2) % 2, b = idx / (2 * FF2); dout[O_CONVP + idx] = bf2f(U[(size_t)(b * SEQ + SEQ - 2 + k) * FF2 + n]); }
    if (idx < DEC_BATCH * 2 * FF2) { const int n = idx % FF2, k = (idx / FF2) % 2, b = idx / (2 * FF2); dout[O_CONVS + idx] = bf2f(U[(size_t)(MP + b * DEC_SEQ + DEC_SEQ - 2 + k) * FF2 + n]); }
}

#define LAS __attribute__((address_space(3)))
#define GAS __attribute__((address_space(1)))
constexpr int NTHR = 512;
constexpr int RING_BYTES = 131072, EPI_OFF = RING_BYTES, EPI_BYTES = 8192, MISC_OFF = EPI_OFF + EPI_BYTES, LDS_BYTES = 147456;
constexpr int CW_BAR = 1024;

__device__ __forceinline__ unsigned cvt_pk_bf16(float lo, float hi) { unsigned r; asm volatile("v_cvt_pk_bf16_f32 %0, %1, %2" : "=v"(r) : "v"(lo), "v"(hi)); return r; }
__device__ __forceinline__ u32x4 pack8f(const f32x4& a, const f32x4& b) { u32x4 w; w.x = cvt_pk_bf16(a[0], a[1]); w.y = cvt_pk_bf16(a[2], a[3]); w.z = cvt_pk_bf16(b[0], b[1]); w.w = cvt_pk_bf16(b[2], b[3]); return w; }
__device__ __forceinline__ int row_pos(int row) { return row < MP ? (row & (SEQ - 1)) : PAST + ((row - MP) & (DEC_SEQ - 1)); }

#define XB_TMO      128
#define XB_XCNT(j)  (256  + 64 * (j))
#define XB_XSUB(j)  (1280 + 64 * (j))
#define XB_XGEN(j)  (2304 + 64 * (j))
#define XB_TOP      3328
#define XB_TOPGEN   3392
#define XCD_BAR_WORDS 3456
#define XB_SPIN_CAP (1u << 18)
__device__ __forceinline__ unsigned xb_ld(unsigned* p)              { return __hip_atomic_load(p, __ATOMIC_RELAXED, __HIP_MEMORY_SCOPE_AGENT); }
__device__ __forceinline__ unsigned xb_add(unsigned* p, unsigned v) { return __hip_atomic_fetch_add(p, v, __ATOMIC_RELAXED, __HIP_MEMORY_SCOPE_AGENT); }
__device__ __forceinline__ unsigned xb_xcc_id() { return (unsigned)__builtin_amdgcn_s_getreg((3 << 11) | 20) & 0xFu; }
#define XB_SPIN(cond, bar) do { unsigned _sp = 0; while (cond) { __builtin_amdgcn_s_sleep(1); \
    if ((++_sp & 255u) == 0u) { if (xb_ld(&(bar)[XB_TMO])) break; if (_sp > XB_SPIN_CAP) { atomicAdd(&(bar)[XB_TMO], 1u); break; } } } } while (0)
struct XcdBarrier { unsigned* bar; unsigned x; volatile LAS unsigned* st; };
__device__ __forceinline__ XcdBarrier xcd_barrier_post(unsigned* bar, volatile LAS unsigned* st) {
    XcdBarrier b; b.bar = bar; b.x = xb_xcc_id(); b.st = st;
    if (threadIdx.x == 0) (void)xb_add(&bar[XB_XCNT(b.x)], 1u);
    return b;
}
__device__ __forceinline__ void xcd_barrier_complete(unsigned* bar, unsigned x, unsigned& nloc, unsigned& nx) {
    const unsigned G = gridDim.x * gridDim.y * gridDim.z;
    unsigned sum, cnt, mine, sp = 0u;
    for (;;) {
        sum = 0u; cnt = 0u; mine = 0u;
#pragma unroll
        for (unsigned j = 0; j < 16; ++j) { const unsigned c = xb_ld(&bar[XB_XCNT(j)]); sum += c; cnt += (c > 0u) ? 1u : 0u; mine = (j == x) ? c : mine; }
        if (sum == G) break;
        __builtin_amdgcn_s_sleep(1);
        if ((++sp & 255u) == 0u) { if (xb_ld(&bar[XB_TMO])) break; if (sp > XB_SPIN_CAP) { atomicAdd(&bar[XB_TMO], 1u); break; } }
    }
    nloc = mine > 0u ? mine : 1u; nx = cnt > 0u ? cnt : 1u;
}
__device__ __forceinline__ void xcd_barrier(const XcdBarrier& b) {
    asm volatile("s_waitcnt vmcnt(0)" ::: "memory");
    __syncthreads();
    if (threadIdx.x == 0) {
        unsigned* bar = b.bar;
        __builtin_amdgcn_s_waitcnt(0);
        unsigned nloc = b.st[0], nx = b.st[1];
        if (nloc == 0u) { xcd_barrier_complete(bar, b.x, nloc, nx); b.st[0] = nloc; b.st[1] = nx; }
        const unsigned old = xb_add(&bar[XB_XSUB(b.x)], 1u);
        const unsigned gen = old / nloc;
        if (old + 1u == (gen + 1u) * nloc) {
            __builtin_amdgcn_fence(__ATOMIC_RELEASE, "agent");
            asm volatile("s_waitcnt vmcnt(0)" ::: "memory");
            const unsigned og = xb_add(&bar[XB_TOP], 1u);
            const unsigned tg = og / nx;
            if (og + 1u == (tg + 1u) * nx) xb_add(&bar[XB_TOPGEN], 1u);
            else XB_SPIN(xb_ld(&bar[XB_TOPGEN]) == tg, bar);
            __builtin_amdgcn_fence(__ATOMIC_ACQUIRE, "agent");
            xb_add(&bar[XB_XGEN(b.x)], 1u);
            asm volatile("s_waitcnt vmcnt(0)" ::: "memory");
        } else {
            XB_SPIN(xb_ld(&bar[XB_XGEN(b.x)]) == gen, bar);
            __builtin_amdgcn_fence(__ATOMIC_ACQUIRE, "agent");
            asm volatile("s_waitcnt vmcnt(0)" ::: "memory");
        }
    }
    __syncthreads();
}

namespace pg {
constexpr int BK = 64, HALF = 128, HTB = HALF * BK * 2;
__host__ __device__ __forceinline__ int lds_byte(int r, int c) { const int st = (r >> 4) * 2 + (c >> 5), rr = r & 15, cc = c & 31, ob = rr * 64 + cc * 2; return st * 1024 + (ob ^ (((ob >> 9) & 1) << 5)); }
__host__ __device__ __forceinline__ void stage_rc(int b, int& R, int& C) { const int st = b / 1024, sb = b % 1024, swz = sb ^ (((sb >> 9) & 1) << 5); R = (st >> 1) * 16 + swz / 64; C = (st & 1) * 32 + (swz % 64) / 2; }
__host__ __device__ __forceinline__ int perm32(int rho) { const int n = rho >> 4, i = rho & 15; return 8 * (i >> 2) + 4 * n + (i & 3); }
struct UnitG { const char* A; const char* B; unsigned lda, ldb; int nt; int pm, pn, kind; };
typedef f32x4 Acc[2][2][4][2];

template <class Sched, class Epi>
__device__ __forceinline__ void gemm_stream(LAS unsigned char* lds, const Sched& S, const Epi& E) {
    const int tid = threadIdx.x, wid = __builtin_amdgcn_readfirstlane(tid >> 6), lane = tid & 63, wr = wid >> 2, wc = wid & 3, fr = lane & 15, fq = lane >> 4;
    unsigned Rr[2], Cc[2];
#pragma unroll
    for (int i = 0; i < 2; ++i) { int R, C; stage_rc(tid * 16 + i * 8192, R, C); Rr[i] = (unsigned)R; Cc[i] = (unsigned)C * 2u; }
    const unsigned ldsw = (unsigned)wid * 1024u;
    const int aoff = lds_byte(wr * 64 + fr, fq * 8), boff = lds_byte(wc * 32 + fr, fq * 8);
#define PG_SA(b, h) (((b) * 2 + (h)) * HTB)
#define PG_SB(b, h) ((4 + (b) * 2 + (h)) * HTB)
#define PG_STAGE(bufoff, gbase, ld) do { _Pragma("unroll") for (int _i = 0; _i < 2; ++_i) \
        __builtin_amdgcn_global_load_lds((const unsigned*)((const char*)(gbase) + (size_t)(Rr[_i] * (ld) + Cc[_i])), (LAS unsigned*)(lds + (bufoff) + ldsw + _i * 8192), 16, 0, 0); } while (0)
#define PG_LDA(dst, b, h) do { _Pragma("unroll") for (int m = 0; m < 4; ++m) _Pragma("unroll") for (int k = 0; k < 2; ++k) dst[m][k] = *(const LAS bf16x8*)(lds + PG_SA(b, h) + aoff + m * 2048 + k * 1024); } while (0)
#define PG_LDB(dst, b, h) do { _Pragma("unroll") for (int n = 0; n < 2; ++n) _Pragma("unroll") for (int k = 0; k < 2; ++k) dst[n][k] = *(const LAS bf16x8*)(lds + PG_SB(b, h) + boff + n * 2048 + k * 1024); } while (0)
#define PG_MMA(ai, bj, At, Bt) do { __builtin_amdgcn_s_setprio(1); _Pragma("unroll") for (int m = 0; m < 4; ++m) _Pragma("unroll") for (int n = 0; n < 2; ++n) _Pragma("unroll") for (int k = 0; k < 2; ++k) \
        acc[ai][bj][m][n] = __builtin_amdgcn_mfma_f32_16x16x32_bf16(Bt[n][k], At[m][k], acc[ai][bj][m][n], 0, 0, 0); __builtin_amdgcn_s_setprio(0); } while (0)
#define PG_WAIT_V(n) asm volatile("s_waitcnt vmcnt(" #n ")" ::: "memory")
#define PG_WAIT_L(n) asm volatile("s_waitcnt lgkmcnt(" #n ")" ::: "memory")
#define PG_BAR __builtin_amdgcn_s_barrier()
#define PG_SCHED __builtin_amdgcn_sched_barrier(0)
    UnitG cur, nxt; int ui = 0;
    if (!S.next(0, cur)) return;
    Acc acc;
#pragma unroll
    for (int a = 0; a < 2; ++a)
#pragma unroll
        for (int b = 0; b < 2; ++b)
#pragma unroll
            for (int m = 0; m < 4; ++m)
#pragma unroll
                for (int n = 0; n < 2; ++n) acc[a][b][m][n] = (f32x4){0.f, 0.f, 0.f, 0.f};
    bf16x8 At[4][2], B0[2][2], B1[2][2];
    const char* cA = cur.A; const char* cB = cur.B; unsigned clda = cur.lda, cldb = cur.ldb;
    PG_STAGE(PG_SB(0, 0), cB, cldb); PG_STAGE(PG_SB(0, 1), cB + (size_t)HALF * cldb, cldb); PG_STAGE(PG_SA(0, 0), cA, clda); PG_STAGE(PG_SA(0, 1), cA + (size_t)HALF * clda, clda);
    if (wr == 1) PG_BAR;
    PG_WAIT_V(2); PG_BAR;
    PG_STAGE(PG_SB(1, 0), cB + 128, cldb); PG_STAGE(PG_SA(1, 0), cA + 128, clda); PG_STAGE(PG_SB(1, 1), cB + (size_t)HALF * cldb + 128, cldb);
    PG_WAIT_V(6); PG_BAR;
    for (;;) {
        const bool has_next = S.next(ui + 1, nxt);
        const char* nA = has_next ? nxt.A : cA; const char* nB = has_next ? nxt.B : cB;
        const unsigned nlda = has_next ? nxt.lda : clda, nldb = has_next ? nxt.ldb : cldb;
        const int nt = cur.nt;
        for (int t = 0; t < nt; t += 2) {
            const bool last = (t == nt - 2);
            const char* a1 = cA + (size_t)(t + 1) * 128;
            const char* a2 = last ? nA : cA + (size_t)(t + 2) * 128; const char* b2 = last ? nB : cB + (size_t)(t + 2) * 128;
            const unsigned lda2 = last ? nlda : clda, ldb2 = last ? nldb : cldb;
            const char* a3 = a2 + 128; const char* b3 = b2 + 128;
            PG_LDB(B0, 0, 0); PG_LDB(B1, 0, 1); PG_SCHED; PG_LDA(At, 0, 0); PG_STAGE(PG_SA(1, 1), a1 + (size_t)HALF * clda, clda);
            PG_WAIT_V(8); PG_WAIT_L(0); PG_BAR; PG_MMA(0, 0, At, B0); PG_MMA(0, 1, At, B1); PG_BAR; PG_SCHED;
            PG_LDA(At, 0, 1); PG_STAGE(PG_SB(0, 0), b2, ldb2); PG_STAGE(PG_SB(0, 1), b2 + (size_t)HALF * ldb2, ldb2); PG_STAGE(PG_SA(0, 0), a2, lda2);
            PG_WAIT_V(8); PG_WAIT_L(0); PG_BAR; PG_MMA(1, 0, At, B0); PG_MMA(1, 1, At, B1); PG_BAR; PG_SCHED;
            PG_LDB(B0, 1, 0); PG_LDB(B1, 1, 1); PG_SCHED; PG_LDA(At, 1, 0); PG_STAGE(PG_SA(0, 1), a2 + (size_t)HALF * lda2, lda2);
            PG_WAIT_V(8); PG_WAIT_L(0); PG_BAR; PG_MMA(0, 0, At, B0); PG_MMA(0, 1, At, B1); PG_BAR; PG_SCHED;
            PG_LDA(At, 1, 1); PG_STAGE(PG_SB(1, 0), b3, ldb2); PG_STAGE(PG_SB(1, 1), b3 + (size_t)HALF * ldb2, ldb2); PG_STAGE(PG_SA(1, 0), a3, lda2);
            PG_WAIT_V(8); PG_WAIT_L(0); PG_BAR; PG_MMA(1, 0, At, B0); PG_MMA(1, 1, At, B1); PG_BAR; PG_SCHED;
        }
        if (wr == 0) PG_BAR;
        E(acc, cur, lds, wr, wc, fr, fq);
        if (!has_next) break;
#pragma unroll
        for (int a = 0; a < 2; ++a)
#pragma unroll
            for (int b = 0; b < 2; ++b)
#pragma unroll
                for (int m = 0; m < 4; ++m)
#pragma unroll
                    for (int n = 0; n < 2; ++n) acc[a][b][m][n] = (f32x4){0.f, 0.f, 0.f, 0.f};
        cur = nxt; cA = nA; cB = nB; clda = nlda; cldb = nldb; ++ui;
        if (wr == 1) PG_BAR;
    }
    PG_WAIT_V(0);
    PG_BAR;
#undef PG_SA
#undef PG_SB
#undef PG_STAGE
#undef PG_LDA
#undef PG_LDB
#undef PG_MMA
#undef PG_WAIT_V
#undef PG_WAIT_L
#undef PG_BAR
#undef PG_SCHED
}
}

struct MArgs { const float* in[24]; float* out; unsigned char* ws; int ph_lo, ph_hi, li, pad; };
struct Frame {
    LAS unsigned char* lds; int tid, lane, wave; int x, j, vcu, G;
    const MArgs* a; float* out; unsigned char* ws;
};
#define FIN(k) (F.a->in[k])
__device__ __forceinline__ float fwave_sum(float v) {
#pragma unroll
    for (int o = 1; o < 64; o <<= 1) v += __shfl_xor(v, o);
    return v;
}

enum { W_IN = 0, W_QUP, W_KVUP, W_OBA, W_OBB, W_OUT, W_UP, W_DOWN };
__device__ __forceinline__ int win_src(int gd) {
    const int tile = gd >> 3, g = gd & 7, bj = g >> 2, wc = g & 3;
    if (tile < 3) return C_QLAT + gd * 32;
    if (tile < 5) return C_KVLAT + (gd - 24) * 32;
    if (tile == 5) return (wc == 0) ? C_KPE + bj * 32 : -1;
    if (tile < 10) { const int base = tile < 8 ? C_RQ : C_RK, tl = tile < 8 ? tile - 6 : tile - 8; const int head = 2 * tl + (wc >> 1); return base + head * 128 + bj * 64 + (wc & 1) * 32; }
    if (tile < 14) return C_RV + (gd - 80) * 32;
    if (tile < 18) return C_RG + (gd - 112) * 32;
    if (tile < 22) return C_GA + (gd - 144) * 32;
    return C_GB + (gd - 176) * 32;
}
__device__ __forceinline__ int w_src_col(int wid, int row) {
    const int rho = row & 31, gd = row >> 5, p = pg::perm32(rho);
    const int s = row & 255, bj = s >> 7, wc = (s >> 5) & 3, t = row >> 8;
    switch (wid) {
    case W_IN: { const int b = win_src(gd); return b < 0 ? -1 : b + p; }
    case W_QUP: if (bj == 0) return t * 192 + 32 * wc + p; else { if (wc >= 2) return -1; const int n = rho >> 4, i = rho & 15; return t * 192 + 128 + 16 * wc + i + 32 * n; }
    case W_KVUP: return t * 256 + 128 * bj + 32 * wc + p;
    case W_UP: return (bj ? D_FF : 0) + 128 * t + 32 * wc + p;
    default: return gd * 32 + p;
    }
}
__device__ __forceinline__ void p0_weight_item(const float* __restrict__ W, int ldw, int K, const float* __restrict__ gain, int wid, bf16_t* __restrict__ Wt, int gd, int kb, LAS float* scr, int lane) {
    const int k0 = kb * 64; const int sc = w_src_col(wid, gd * 32 + (lane & 31));
    bf16_t* dst = Wt + (size_t)(gd * 32) * K + k0;
#pragma unroll 8
    for (int i = 0; i < 32; ++i) { const int kk = 2 * i + (lane >> 5); const float g = gain ? gain[k0 + kk] : 1.f; scr[kk * 33 + (lane & 31)] = sc < 0 ? 0.f : W[(size_t)(k0 + kk) * ldw + sc] * g; }
    asm volatile("s_waitcnt lgkmcnt(0)" ::: "memory");
    const int c = lane & 7;
#pragma unroll
    for (int jj = 0; jj < 4; ++jj) { const int n = (lane >> 3) + 8 * jj; const LAS float* s = scr + (8 * c) * 33 + n;
        u32x4 o; o.x = cvt_pk_bf16(s[0 * 33], s[1 * 33]); o.y = cvt_pk_bf16(s[2 * 33], s[3 * 33]); o.z = cvt_pk_bf16(s[4 * 33], s[5 * 33]); o.w = cvt_pk_bf16(s[6 * 33], s[7 * 33]);
        *(u32x4*)(dst + (size_t)n * K + 8 * c) = o; }
    asm volatile("s_waitcnt lgkmcnt(0)" ::: "memory");
}
__device__ __forceinline__ void p0_weights(Frame& F, LAS float* scr, int gw, int NGW, const float* W, int ldw, int K, const float* gain, int wid, size_t off, int ngroups) {
    const int nkb = K / 64; bf16_t* Wt = (bf16_t*)(F.ws + off);
    for (int it = gw; it < ngroups * nkb; it += NGW) { const int gd = it / nkb, kb = it % nkb; p0_weight_item(W, ldw, K, gain, wid, Wt, gd, kb, scr, F.lane); }
}
__device__ __forceinline__ void p0_prologue(Frame& F) {
    LAS float* scr = (LAS float*)(F.lds + F.wave * 16384);
    const int gw = F.vcu * 8 + F.wave, NGW = F.G * 8;
    p0_weights(F, scr, gw, NGW, FIN(7), IN_W, 1024, FIN(6), W_IN, WS_FWIN, 26 * 8);
    p0_weights(F, scr, gw, NGW, FIN(9), 1536, 768, FIN(8), W_QUP, WS_FWQUP, 8 * 8);
    p0_weights(F, scr, gw, NGW, FIN(13), 2048, 512, nullptr, W_KVUP, WS_FWKVUP, 8 * 8);
    p0_weights(F, scr, gw, NGW, FIN(17), 1024, 1024, nullptr, W_OBA, WS_FWOBA, 4 * 8);
    p0_weights(F, scr, gw, NGW, FIN(17) + (size_t)1024 * 1024, 1024, 1024, nullptr, W_OBB, WS_FWOBB, 4 * 8);
    p0_weights(F, scr, gw, NGW, FIN(18), 1024, 1024, nullptr, W_OUT, WS_FWOUT, 4 * 8);
    p0_weights(F, scr, gw, NGW, FIN(20), FF2, 1024, FIN(19), W_UP, WS_FWUP, 22 * 8);
    p0_weights(F, scr, gw, NGW, FIN(23), 1024, D_FF, nullptr, W_DOWN, WS_FWDOWN, 4 * 8);
    {   bf16_t* XN = (bf16_t*)(F.ws + WS_XN);
        for (int r = gw; r < MPAD; r += NGW) {
            u32x2* o8 = (u32x2*)(XN + (size_t)r * D_MODEL) + F.lane;
            if (r >= MT) { for (int jj = 0; jj < 4; ++jj) o8[64 * jj] = (u32x2){0u, 0u}; continue; }
            const float* x = r < MP ? FIN(0) + (size_t)r * D_MODEL : FIN(1) + (size_t)(r - MP) * D_MODEL;
            const f32x4* xr = (const f32x4*)x + F.lane; f32x4 v[4]; float s = 0.f;
#pragma unroll
            for (int jj = 0; jj < 4; ++jj) { v[jj] = xr[64 * jj]; s += (v[jj][0] * v[jj][0] + v[jj][1] * v[jj][1]) + (v[jj][2] * v[jj][2] + v[jj][3] * v[jj][3]); }
            const float inv = rsqrtf(fwave_sum(s) * (1.f / D_MODEL) + EPS);
#pragma unroll
            for (int jj = 0; jj < 4; ++jj) { u32x2 w; w.x = cvt_pk_bf16(v[jj][0] * inv, v[jj][1] * inv); w.y = cvt_pk_bf16(v[jj][2] * inv, v[jj][3] * inv); o8[64 * jj] = w; }
        } }
    {   bf16_t* lats = (bf16_t*)(F.ws + WS_LATS); bf16_t* pes = (bf16_t*)(F.ws + WS_PES);
        const int gt = F.vcu * NTHR + F.tid, NG = F.G * NTHR;
        for (int i = gt; i < DEC_BATCH * PAST * (KV_LORA / 4); i += NG) { const int c4 = i % (KV_LORA / 4), rj = i / (KV_LORA / 4), jr = rj % PAST, b = rj / PAST;
            const f32x4 v = *((const f32x4*)FIN(2) + i); u32x2 w; w.x = cvt_pk_bf16(v[0], v[1]); w.y = cvt_pk_bf16(v[2], v[3]);
            *(u32x2*)(lats + ((size_t)b * SKEYS + jr) * KV_LORA + c4 * 4) = w; }
        for (int i = gt; i < DEC_BATCH * PAST * (QK_ROPE / 4); i += NG) { const int c4 = i % (QK_ROPE / 4), rj = i / (QK_ROPE / 4), jr = rj % PAST, b = rj / PAST;
            const f32x4 v = *((const f32x4*)FIN(3) + i); u32x2 w; w.x = cvt_pk_bf16(v[0], v[1]); w.y = cvt_pk_bf16(v[2], v[3]);
            *(u32x2*)(pes + ((size_t)b * SKEYS + jr) * QK_ROPE + c4 * 4) = w; }
        float2* tab32 = (float2*)(F.ws + WS_TAB32); float2* tab64 = (float2*)(F.ws + WS_TAB64);
        for (int i = gt; i < 8192 * 64; i += NG) {
            { const int pos = i / 64, k = i % 64; const double f = pow(10000.0, -(double)k / 64.0), a = (double)pos * f; tab64[i] = make_float2((float)cos(a), (float)sin(a)); }
            if (i < 8192 * 32) { const int pos = i / 32, k = i % 32; const double f = pow(10000.0, -(double)k / 32.0), a = (double)pos * f; tab32[i] = make_float2((float)cos(a), (float)sin(a)); }
        } }
}

__device__ __forceinline__ bool reg_unit(int x, int j, int i, int nN, int& pm, int& pn) { const int u = j + 32 * i; if (u >= 8 * nN) return false; pm = 8 * x + (u & 7); pn = u >> 3; return true; }
#define LDS_F(off) ((LAS float*)(lds + EPI_OFF) + (off))

enum { K_QLAT = 0, K_KVLAT, K_KPE, K_RQ, K_RK, K_RV, K_RG, K_QUP, K_KVP, K_KVS, K_GA, K_AD, K_GB, K_RD, K_OUT, K_UP, K_DOWN };
struct SchedP1 {
    int x, j; const char* ws;
    __device__ __forceinline__ bool next(int i, pg::UnitG& u) const {
        int pm, pn;
        if (!reg_unit(x, j, i, 18, pm, pn)) { if (i == 4 && j >= 16) { const int k = (j - 16) * 8 + x; if (k >= 18) return false; pm = 64; pn = k; } else return false; }
        u.pm = pm; u.pn = pn; u.A = ws + WS_XN + (size_t)pm * 256 * 2048; u.B = ws + WS_FWIN + (size_t)pn * 256 * 2048; u.lda = 2048; u.ldb = 2048; u.nt = 16;
        u.kind = pn < 3 ? K_QLAT : pn < 5 ? K_KVLAT : pn == 5 ? K_KPE : pn < 8 ? K_RQ : pn < 10 ? K_RK : pn < 14 ? K_RV : K_RG;
        return true;
    }
};
struct EpiP1 {
    unsigned char* ws; float* out; const float *g_kvlat, *g_kr;
    __device__ __forceinline__ void operator()(const pg::Acc& acc, const pg::UnitG& u, LAS unsigned char* lds, int wr, int wc, int fr, int fq) const {
        bf16_t* const ZQ = (bf16_t*)(ws + WS_ZQ); bf16_t* const KVL = (bf16_t*)(ws + WS_KVL); bf16_t* const KPE = (bf16_t*)(ws + WS_KPE); bf16_t* const PES = (bf16_t*)(ws + WS_PES); bf16_t* const LATS = (bf16_t*)(ws + WS_LATS);
        bf16_t* const RQ = (bf16_t*)(ws + WS_RQ); bf16_t* const RK = (bf16_t*)(ws + WS_RK); bf16_t* const RV = (bf16_t*)(ws + WS_RV); bf16_t* const RG = (bf16_t*)(ws + WS_RG);
        float* const slotq = (float*)(ws + WS_SLOTQ); float* const slotkv = (float*)(ws + WS_SLOTKV);
        const float2* const tab32 = (const float2*)(ws + WS_TAB32); const float2* const tab64 = (const float2*)(ws + WS_TAB64);
        int rl0 = wr * 64 + fr, cw = wc * 32 + fq * 8; asm volatile("" : "+v"(rl0), "+v"(cw));
        const int kind = u.kind, rb = u.pm * 256 + rl0;
        if (kind == K_QLAT || kind == K_KVLAT) {
            const int t = kind == K_QLAT ? u.pn : u.pn - 3; const int ld = kind == K_QLAT ? Q_LORA : KV_LORA; bf16_t* dst = kind == K_QLAT ? ZQ : KVL;
            f32x4 g[2][2];
#pragma unroll
            for (int bj = 0; bj < 2; ++bj)
#pragma unroll
                for (int n = 0; n < 2; ++n) g[bj][n] = kind == K_KVLAT ? *(const f32x4*)(g_kvlat + t * 256 + bj * 128 + cw + 4 * n) : (f32x4){1.f, 1.f, 1.f, 1.f};
#pragma unroll
            for (int ai = 0; ai < 2; ++ai)
#pragma unroll
                for (int m = 0; m < 4; ++m) { const int row = rb + ai * 128 + m * 16; float ss = 0.f;
                    const bool snew = (kind == K_KVLAT) && row >= MP && row < MT;
                    const int rs = row - MP; bf16_t* lrow = LATS + ((size_t)(rs / DEC_SEQ) * SKEYS + PAST + (rs % DEC_SEQ)) * KV_LORA;
#pragma unroll
                    for (int bj = 0; bj < 2; ++bj) { const f32x4 v0 = acc[ai][bj][m][0], v1 = acc[ai][bj][m][1];
                        ss += (v0[0] * v0[0] + v0[1] * v0[1]) + (v0[2] * v0[2] + v0[3] * v0[3]) + (v1[0] * v1[0] + v1[1] * v1[1]) + (v1[2] * v1[2] + v1[3] * v1[3]);
                        const u32x4 w = pack8f(v0 * g[bj][0], v1 * g[bj][1]);
                        *(u32x4*)(dst + (size_t)row * ld + t * 256 + bj * 128 + cw) = w;
                        if (snew) *(u32x4*)(lrow + t * 256 + bj * 128 + cw) = w; }
                    ss += __shfl_xor(ss, 16); ss += __shfl_xor(ss, 32);
                    if (fq == 0) { if (kind == K_QLAT) slotq[(size_t)row * 12 + t * 4 + wc] = ss; else slotkv[(size_t)row * 8 + t * 4 + wc] = ss; } }
        } else if (kind == K_KPE) {
            if (wc != 0) return;
            const int d0 = fq * 8;
            f32x4 g1[2], g2[2];
#pragma unroll
            for (int n = 0; n < 2; ++n) { g1[n] = *(const f32x4*)(g_kr + d0 + 4 * n); g2[n] = *(const f32x4*)(g_kr + 32 + d0 + 4 * n); }
#pragma unroll
            for (int ai = 0; ai < 2; ++ai)
#pragma unroll
                for (int m = 0; m < 4; ++m) { const int row = rb + ai * 128 + m * 16; const int pos = row_pos(row < MT ? row : 0);
                    f32x4 x1[2], x2[2]; float ss = 0.f;
#pragma unroll
                    for (int n = 0; n < 2; ++n) { x1[n] = acc[ai][0][m][n]; x2[n] = acc[ai][1][m][n];
                        ss += (x1[n][0] * x1[n][0] + x1[n][1] * x1[n][1]) + (x1[n][2] * x1[n][2] + x1[n][3] * x1[n][3]) + (x2[n][0] * x2[n][0] + x2[n][1] * x2[n][1]) + (x2[n][2] * x2[n][2] + x2[n][3] * x2[n][3]); }
                    ss += __shfl_xor(ss, 16); ss += __shfl_xor(ss, 32);
                    const float inv = rsqrtf(ss * (1.f / 64.f) + EPS);
                    f32x4 o1[2], o2[2];
#pragma unroll
                    for (int n = 0; n < 2; ++n) { const f32x4 y1 = x1[n] * inv * g1[n], y2 = x2[n] * inv * g2[n];
                        const f32x4 cs0 = *(const f32x4*)(tab32 + pos * 32 + d0 + 4 * n), cs1 = *(const f32x4*)(tab32 + pos * 32 + d0 + 4 * n + 2);
                        const f32x4 c = {cs0[0], cs0[2], cs1[0], cs1[2]}, s = {cs0[1], cs0[3], cs1[1], cs1[3]};
                        o1[n] = y1 * c - y2 * s; o2[n] = y1 * s + y2 * c; }
                    *(u32x4*)(KPE + (size_t)row * 64 + d0) = pack8f(o1[0], o1[1]); *(u32x4*)(KPE + (size_t)row * 64 + 32 + d0) = pack8f(o2[0], o2[1]);
                    if (row < MT) {
                        float* o = row < MP ? out + O_RKP + (size_t)row * 64 : out + O_RKS + (size_t)(row - MP) * 64;
                        *(f32x4*)(o + d0) = o1[0]; *(f32x4*)(o + d0 + 4) = o1[1]; *(f32x4*)(o + 32 + d0) = o2[0]; *(f32x4*)(o + 32 + d0 + 4) = o2[1];
                        if (row >= MP) { const int rs = row - MP, b = rs / DEC_SEQ, tt = rs % DEC_SEQ; bf16_t* p = PES + ((size_t)b * SKEYS + PAST + tt) * 64;
                            *(u32x4*)(p + d0) = pack8f(o1[0], o1[1]); *(u32x4*)(p + 32 + d0) = pack8f(o2[0], o2[1]); } } }
        } else if (kind == K_RQ || kind == K_RK) {
            const int tl = kind == K_RQ ? u.pn - 6 : u.pn - 8; const int head = 2 * tl + (wc >> 1), i0 = 32 * (wc & 1) + fq * 8;
            bf16_t* dst = kind == K_RQ ? RQ : RK; const float sc = kind == K_RQ ? 1.0f : 0.08838834764831845f;
#pragma unroll
            for (int ai = 0; ai < 2; ++ai)
#pragma unroll
                for (int m = 0; m < 4; ++m) { const int row = rb + ai * 128 + m * 16; const int pos = row_pos(row < MT ? row : 0);
                    f32x4 o1[2], o2[2];
#pragma unroll
                    for (int n = 0; n < 2; ++n) { const f32x4 x1 = acc[ai][0][m][n], x2 = acc[ai][1][m][n];
                        const f32x4 cs0 = *(const f32x4*)(tab64 + pos * 64 + i0 + 4 * n), cs1 = *(const f32x4*)(tab64 + pos * 64 + i0 + 4 * n + 2);
                        const f32x4 c = {cs0[0], cs0[2], cs1[0], cs1[2]}, s = {cs0[1], cs0[3], cs1[1], cs1[3]};
                        o1[n] = (x1 * c - x2 * s) * sc; o2[n] = (x1 * s + x2 * c) * sc; }
                    *(u32x4*)(dst + (size_t)row * 512 + head * 128 + i0) = pack8f(o1[0], o1[1]); *(u32x4*)(dst + (size_t)row * 512 + head * 128 + 64 + i0) = pack8f(o2[0], o2[1]); }
        } else {
            const int t = kind == K_RV ? u.pn - 10 : u.pn - 14; bf16_t* dst = kind == K_RV ? RV : RG;
#pragma unroll
            for (int ai = 0; ai < 2; ++ai)
#pragma unroll
                for (int m = 0; m < 4; ++m) { const int row = rb + ai * 128 + m * 16;
#pragma unroll
                    for (int bj = 0; bj < 2; ++bj) { f32x4 v0 = acc[ai][bj][m][0], v1 = acc[ai][bj][m][1];
                        if (kind == K_RG) {
#pragma unroll
                            for (int e = 0; e < 4; ++e) { v0[e] = v0[e] / (1.f + __expf(-v0[e])); v1[e] = v1[e] / (1.f + __expf(-v1[e])); } }
                        *(u32x4*)(dst + (size_t)row * 1024 + t * 256 + bj * 128 + cw) = pack8f(v0, v1); } }
        }
    }
};
__device__ __forceinline__ void p1_inproj(Frame& F) {
    SchedP1 S{F.x, F.j, (const char*)F.ws};
    EpiP1 E{F.ws, F.out, FIN(12), FIN(15)};
    pg::gemm_stream(F.lds, S, E);
}

__device__ __forceinline__ float slot_rs(const float* slots, int n, float invn) {
    float a = 0.f; for (int i = 0; i < n; i += 4) { const f32x4 v = *(const f32x4*)(slots + i); a += (v[0] + v[1]) + (v[2] + v[3]); } return rsqrtf(a * invn + EPS);
}
struct SchedP2 {
    int x, j; const char* ws; int sample;
    __device__ __forceinline__ bool next(int i, pg::UnitG& u) const {
        int pm, pn, kind;
        if (sample) {
            if (i < 2) { reg_unit(x, j, i, 8, pm, pn); kind = K_QUP; }
            else if (i < 4) { reg_unit(x, j, i - 2, 8, pm, pn); kind = K_KVS; }
            else if (i == 4 && j < 2) { const int k = j * 8 + x; pm = 64; pn = k & 7; kind = k < 8 ? K_QUP : K_KVS; }
            else return false;
        } else { if (i >= 2) return false; reg_unit(x, j, i, 8, pm, pn); kind = K_KVP; }
        u.pm = pm; u.pn = pn; u.kind = kind;
        if (kind == K_QUP) { u.A = ws + WS_ZQ + (size_t)pm * 256 * 1536; u.lda = 1536; u.B = ws + WS_FWQUP + (size_t)pn * 256 * 1536; u.ldb = 1536; u.nt = 12; }
        else { u.A = ws + (kind == K_KVS ? WS_LATS : WS_KVL) + (size_t)pm * 256 * 1024; u.lda = 1024; u.B = ws + WS_FWKVUP + (size_t)pn * 256 * 1024; u.ldb = 1024; u.nt = 8; }
        return true;
    }
};
struct EpiP2 {
    unsigned char* ws; float* out; const float *g_qn, *g_qr, *g_kn;
    __device__ __forceinline__ void operator()(const pg::Acc& acc, const pg::UnitG& u, LAS unsigned char* lds, int wr, int wc, int fr, int fq) const {
        int rl0 = wr * 64 + fr, cw = wc * 32 + fq * 8; asm volatile("" : "+v"(rl0), "+v"(cw));
        const int kind = u.kind, h = u.pn, rb = u.pm * 256 + rl0;
        const float* const slotq = (const float*)(ws + WS_SLOTQ); const float* const slotkv = (const float*)(ws + WS_SLOTKV);
        float rs[2][4];
#pragma unroll
        for (int ai = 0; ai < 2; ++ai)
#pragma unroll
            for (int m = 0; m < 4; ++m) { const int row = rb + ai * 128 + m * 16;
                if (kind == K_QUP) rs[ai][m] = slot_rs(slotq + (size_t)row * 12, 12, 1.f / Q_LORA);
                else if (kind == K_KVP) rs[ai][m] = slot_rs(slotkv + (size_t)row * 8, 8, 1.f / KV_LORA);
                else { const int b = row / SKEYS, jj = row - b * SKEYS; rs[ai][m] = (row < LROWS && jj >= PAST) ? slot_rs(slotkv + (size_t)(MP + b * DEC_SEQ + jj - PAST) * 8, 8, 1.f / KV_LORA) : 1.f; } }
#pragma unroll
        for (int ai = 0; ai < 2; ++ai)
#pragma unroll
            for (int m = 0; m < 4; ++m) { float p0 = 0.f, p1 = 0.f; const float s2 = rs[ai][m] * rs[ai][m];
#pragma unroll
                for (int n = 0; n < 2; ++n) { const f32x4 a = acc[ai][0][m][n], b = acc[ai][1][m][n];
                    p0 += (a[0] * a[0] + a[1] * a[1]) + (a[2] * a[2] + a[3] * a[3]); p1 += (b[0] * b[0] + b[1] * b[1]) + (b[2] * b[2] + b[3] * b[3]); }
                p0 += __shfl_xor(p0, 16); p0 += __shfl_xor(p0, 32); p1 += __shfl_xor(p1, 16); p1 += __shfl_xor(p1, 32);
                if (fq == 0) { LAS float* d = LDS_F((rl0 + ai * 128 + m * 16) * 8 + wc * 2); d[0] = p0 * s2; d[1] = p1 * s2; } }
        asm volatile("s_waitcnt lgkmcnt(0)" ::: "memory"); __builtin_amdgcn_s_barrier(); asm volatile("" ::: "memory");
        if (kind == K_QUP) {
            bf16_t* const Q = (bf16_t*)out;
            const float2* const tab32 = (const float2*)(ws + WS_TAB32);
            const float C2 = 0.07216878364870323f * 1.4426950408889634f;
            f32x4 gn[2]; gn[0] = *(const f32x4*)(g_qn + cw); gn[1] = *(const f32x4*)(g_qn + cw + 4);
            const int ir = 16 * (wc & 1) + 4 * fq; const f32x4 gr1 = *(const f32x4*)(g_qr + ir), gr2 = *(const f32x4*)(g_qr + 32 + ir);
#pragma unroll
            for (int ai = 0; ai < 2; ++ai)
#pragma unroll
                for (int m = 0; m < 4; ++m) { const int row = rb + ai * 128 + m * 16; const int pos = row_pos(row < MT ? row : 0);
                    const LAS float* d = LDS_F((rl0 + ai * 128 + m * 16) * 8); const f32x4 e0 = *(const LAS f32x4*)d, e1 = *(const LAS f32x4*)(d + 4);
                    const float inn = rsqrtf((e0[0] + e0[2] + e1[0] + e1[2]) * (1.f / 128.f) + EPS) * rs[ai][m] * C2, inr = rsqrtf((e0[1] + e0[3]) * (1.f / 64.f) + EPS) * rs[ai][m];
                    bf16_t* qrow = Q + (size_t)row * 1536 + h * 192;
                    *(u32x4*)(qrow + cw) = pack8f(acc[ai][0][m][0] * inn * gn[0], acc[ai][0][m][1] * inn * gn[1]);
                    if (wc < 2) { const f32x4 y1 = acc[ai][1][m][0] * inr * gr1, y2 = acc[ai][1][m][1] * inr * gr2;
                        const f32x4 cs0 = *(const f32x4*)(tab32 + pos * 32 + ir), cs1 = *(const f32x4*)(tab32 + pos * 32 + ir + 2);
                        const f32x4 c = {cs0[0], cs0[2], cs1[0], cs1[2]}, s = {cs0[1], cs0[3], cs1[1], cs1[3]};
                        const f32x4 o1 = (y1 * c - y2 * s) * C2, o2 = (y1 * s + y2 * c) * C2;
                        u32x2 w1, w2; w1.x = cvt_pk_bf16(o1[0], o1[1]); w1.y = cvt_pk_bf16(o1[2], o1[3]); w2.x = cvt_pk_bf16(o2[0], o2[1]); w2.y = cvt_pk_bf16(o2[2], o2[3]);
                        *(u32x2*)(qrow + 128 + ir) = w1; *(u32x2*)(qrow + 160 + ir) = w2; } }
        } else {
            bf16_t* const KN = (bf16_t*)(ws + WS_KN); bf16_t* const V = (bf16_t*)(ws + WS_V);
            f32x4 gk[2]; gk[0] = *(const f32x4*)(g_kn + cw); gk[1] = *(const f32x4*)(g_kn + cw + 4);
#pragma unroll
            for (int ai = 0; ai < 2; ++ai)
#pragma unroll
                for (int m = 0; m < 4; ++m) { const int row = rb + ai * 128 + m * 16;
                    const LAS float* d = LDS_F((rl0 + ai * 128 + m * 16) * 8); const f32x4 e0 = *(const LAS f32x4*)d, e1 = *(const LAS f32x4*)(d + 4);
                    const float s = rs[ai][m], inn = rsqrtf((e0[0] + e0[2] + e1[0] + e1[2]) * (1.f / 128.f) + EPS) * s;
                    *(u32x4*)(KN + (size_t)row * 1024 + h * 128 + cw) = pack8f(acc[ai][0][m][0] * inn * gk[0], acc[ai][0][m][1] * inn * gk[1]);
                    *(u32x4*)(V + (size_t)row * 1024 + h * 128 + cw) = pack8f(acc[ai][1][m][0] * s, acc[ai][1][m][1] * s); }
        }
    }
};
__device__ __forceinline__ void p2_qkv(Frame& F, int sample) {
    SchedP2 S{F.x, F.j, (const char*)F.ws, sample};
    EpiP2 E{F.ws, F.out, FIN(10), FIN(11), FIN(14)};
    pg::gemm_stream(F.lds, S, E);
}

struct SchedP5 {
    int x, j, vcu; const char* ws; int phase;
    __device__ __forceinline__ const char* arow(size_t base, size_t base_s, int pm, size_t rowbytes) const { return ws + (pm < 64 ? base + (size_t)pm * 256 * rowbytes : base_s); }
    __device__ __forceinline__ bool next(int i, pg::UnitG& u) const {
        int pm, pn;
        if (phase == 5) {
            const int sub = i & 3, tile = i >> 2;
            if (tile == 0) { pm = 8 * x + (j & 7); pn = j >> 3; } else if (tile == 1 && j == 0 && x < 4) { pm = 64; pn = x; } else return false;
            u.pm = pm; u.pn = pn; u.kind = K_GA + sub; u.lda = 2048; u.ldb = 2048; u.nt = 16;
            if (sub == 0) { u.A = ws + WS_XN2 + (size_t)pm * 256 * 2048; u.B = ws + WS_FWIN + (size_t)(18 + pn) * 256 * 2048; }
            else if (sub == 1) { u.A = arow(WS_ATT, WS_ATTS, pm, 2048); u.B = ws + WS_FWOBA + (size_t)pn * 256 * 2048; }
            else if (sub == 2) { u.A = ws + WS_XN2 + (size_t)pm * 256 * 2048; u.B = ws + WS_FWIN + (size_t)(22 + pn) * 256 * 2048; }
            else { u.A = ws + WS_RET + (size_t)pm * 256 * 2048; u.B = ws + WS_FWOBB + (size_t)pn * 256 * 2048; }
            return true;
        }
        if (phase == 6 || phase == 9) {
            if (i == 0) { pm = 8 * x + (j & 7); pn = j >> 3; } else if (i == 1 && j == 0 && x < 4) { pm = 64; pn = x; } else return false;
            u.pm = pm; u.pn = pn;
            if (phase == 6) { u.kind = K_OUT; u.A = ws + WS_MERGED + (size_t)pm * 256 * 2048; u.lda = 2048; u.B = ws + WS_FWOUT + (size_t)pn * 256 * 2048; u.ldb = 2048; u.nt = 16; }
            else { u.kind = K_DOWN; u.A = ws + WS_U + (size_t)pm * 256 * (FF2 * 2); u.lda = FF2 * 2; u.B = ws + WS_FWDOWN + (size_t)pn * 256 * (D_FF * 2); u.ldb = D_FF * 2; u.nt = 44; }
            return true;
        }
        if (!reg_unit(x, j, i, 22, pm, pn)) { if (i == 5 && j >= 16) { const int k = (j - 16) * 8 + x; if (k >= 22) return false; pm = 64; pn = k; } else return false; }
        u.pm = pm; u.pn = pn; u.kind = K_UP; u.A = ws + WS_X1B + (size_t)pm * 256 * 2048; u.lda = 2048; u.B = ws + WS_FWUP + (size_t)pn * 256 * 2048; u.ldb = 2048; u.nt = 16;
        return true;
    }
};
struct EpiP5 {
    unsigned char* ws; float* out; const float* xp; const float* xs; int vcu;
    __device__ __forceinline__ void operator()(pg::Acc& acc, const pg::UnitG& u, LAS unsigned char* lds, int wr, int wc, int fr, int fq) const {
        int rl0 = wr * 64 + fr, cw = wc * 32 + fq * 8; asm volatile("" : "+v"(rl0), "+v"(cw));
        const int kind = u.kind, rb = u.pm * 256 + rl0;
        if (kind >= K_GA && kind <= K_RD) {
            bf16_t* const T1 = (bf16_t*)(ws + WS_T1) + (size_t)vcu * 65536; bf16_t* const T2 = (bf16_t*)out + (size_t)vcu * 65536;
            bf16_t* const MG = (bf16_t*)(ws + WS_MERGED);
#pragma unroll
            for (int ai = 0; ai < 2; ++ai)
#pragma unroll
                for (int m = 0; m < 4; ++m)
#pragma unroll
                    for (int bj = 0; bj < 2; ++bj) { const size_t so = (size_t)(rl0 + ai * 128 + m * 16) * 256 + bj * 128 + cw;
                        f32x4 v0 = acc[ai][bj][m][0], v1 = acc[ai][bj][m][1];
                        if (kind == K_GA || kind == K_GB) {
#pragma unroll
                            for (int e = 0; e < 4; ++e) { v0[e] = 1.f / (1.f + __expf(-v0[e])); v1[e] = 1.f / (1.f + __expf(-v1[e])); }
                            *(u32x4*)((kind == K_GA ? T1 : T2) + so) = pack8f(v0, v1);
                        } else if (kind == K_AD) {
                            const u32x4 t = *(const u32x4*)(T1 + so);
                            const f32x4 g0 = {__uint_as_float(t.x << 16), __uint_as_float(t.x & 0xffff0000u), __uint_as_float(t.y << 16), __uint_as_float(t.y & 0xffff0000u)};
                            const f32x4 g1 = {__uint_as_float(t.z << 16), __uint_as_float(t.z & 0xffff0000u), __uint_as_float(t.w << 16), __uint_as_float(t.w & 0xffff0000u)};
                            *(u32x4*)(T1 + so) = pack8f(v0 * g0, v1 * g1);
                        } else {
                            const u32x4 t = *(const u32x4*)(T1 + so), q = *(const u32x4*)(T2 + so);
                            const f32x4 a0 = {__uint_as_float(t.x << 16), __uint_as_float(t.x & 0xffff0000u), __uint_as_float(t.y << 16), __uint_as_float(t.y & 0xffff0000u)};
                            const f32x4 a1 = {__uint_as_float(t.z << 16), __uint_as_float(t.z & 0xffff0000u), __uint_as_float(t.w << 16), __uint_as_float(t.w & 0xffff0000u)};
                            const f32x4 g0 = {__uint_as_float(q.x << 16), __uint_as_float(q.x & 0xffff0000u), __uint_as_float(q.y << 16), __uint_as_float(q.y & 0xffff0000u)};
                            const f32x4 g1 = {__uint_as_float(q.z << 16), __uint_as_float(q.z & 0xffff0000u), __uint_as_float(q.w << 16), __uint_as_float(q.w & 0xffff0000u)};
                            *(u32x4*)(MG + (size_t)(rb + ai * 128 + m * 16) * 1024 + u.pn * 256 + bj * 128 + cw) = pack8f(a0 + v0 * g0, a1 + v1 * g1);
                        }
                        if (bj == 1 && (m & 1)) asm volatile("" ::: "memory"); }
            if (kind != K_RD) asm volatile("s_waitcnt vmcnt(0)" ::: "memory");
        } else if (kind == K_OUT) {
            float* const slotx = (float*)(ws + WS_SLOTX1); bf16_t* const X1B = (bf16_t*)(ws + WS_X1B);
#pragma unroll
            for (int ai = 0; ai < 2; ++ai)
#pragma unroll
                for (int m = 0; m < 4; ++m) { const int row = rb + ai * 128 + m * 16; float ss = 0.f;
                    const float* xr = row < MP ? xp + (size_t)row * D_MODEL : xs + (size_t)((row < MT ? row : MP) - MP) * D_MODEL;
#pragma unroll
                    for (int bj = 0; bj < 2; ++bj) { const int c = u.pn * 256 + bj * 128 + cw;
                        const f32x4 x0 = *(const f32x4*)(xr + c), x1 = *(const f32x4*)(xr + c + 4);
                        const f32x4 v0 = acc[ai][bj][m][0] + x0, v1 = acc[ai][bj][m][1] + x1;
                        ss += (v0[0] * v0[0] + v0[1] * v0[1]) + (v0[2] * v0[2] + v0[3] * v0[3]) + (v1[0] * v1[0] + v1[1] * v1[1]) + (v1[2] * v1[2] + v1[3] * v1[3]);
                        if (row < MT) { *(f32x4*)(out + (size_t)row * D_MODEL + c) = v0; *(f32x4*)(out + (size_t)row * D_MODEL + c + 4) = v1; }
                        *(u32x4*)(X1B + (size_t)row * D_MODEL + c) = pack8f(v0, v1); }
                    ss += __shfl_xor(ss, 16); ss += __shfl_xor(ss, 32);
                    if (fq == 0) slotx[(size_t)row * 16 + u.pn * 4 + wc] = ss;
                    asm volatile("" ::: "memory"); }
        } else if (kind == K_UP) {
            const float* const slotx = (const float*)(ws + WS_SLOTX1); bf16_t* const U = (bf16_t*)(ws + WS_U);
#pragma unroll
            for (int ai = 0; ai < 2; ++ai)
#pragma unroll
                for (int m = 0; m < 4; ++m) { const int row = rb + ai * 128 + m * 16;
                    float a = 0.f;
#pragma unroll
                    for (int i = 0; i < 16; i += 4) { const f32x4 v = *(const f32x4*)(slotx + (size_t)row * 16 + i); a += (v[0] + v[1]) + (v[2] + v[3]); }
                    const float s = rsqrtf(a * (1.f / D_MODEL) + EPS);
                    *(u32x4*)(U + (size_t)row * FF2 + u.pn * 128 + cw) = pack8f(acc[ai][0][m][0] * s, acc[ai][0][m][1] * s);
                    *(u32x4*)(U + (size_t)row * FF2 + D_FF + u.pn * 128 + cw) = pack8f(acc[ai][1][m][0] * s, acc[ai][1][m][1] * s);
                    if (m & 1) asm volatile("" ::: "memory"); }
        } else {
#pragma unroll
            for (int ai = 0; ai < 2; ++ai)
#pragma unroll
                for (int m = 0; m < 4; ++m) { const int row = rb + ai * 128 + m * 16; if (row >= MT) continue;
#pragma unroll
                    for (int bj = 0; bj < 2; ++bj) { float* p = out + (size_t)row * D_MODEL + u.pn * 256 + bj * 128 + cw;
                        const f32x4 x0 = *(const f32x4*)p, x1 = *(const f32x4*)(p + 4);
                        *(f32x4*)p = x0 + acc[ai][bj][m][0]; *(f32x4*)(p + 4) = x1 + acc[ai][bj][m][1]; }
                    asm volatile("" ::: "memory"); }
        }
    }
};
__device__ __forceinline__ void p5_gemm(Frame& F, int phase) {
    SchedP5 S{F.x, F.j, F.vcu, (const char*)F.ws, phase};
    EpiP5 E{F.ws, F.out, FIN(0), FIN(1), F.vcu};
    pg::gemm_stream(F.lds, S, E);
}

__global__ void __launch_bounds__(NTHR, 2) mk(const MArgs a) {
    extern __shared__ __attribute__((aligned(16))) unsigned char lds_raw[];
    Frame F;
    F.lds = (LAS unsigned char*)lds_raw;
    F.tid = threadIdx.x; F.lane = F.tid & 63; F.wave = __builtin_amdgcn_readfirstlane(F.tid >> 6);
    F.G = gridDim.x; F.x = blockIdx.x % 8; F.j = blockIdx.x / 8; F.vcu = F.x * (F.G / 8) + F.j;
    F.a = &a; F.out = a.out; F.ws = a.ws;
    volatile LAS unsigned* MISC = (volatile LAS unsigned*)(F.lds + MISC_OFF);
    if (F.tid < 32) MISC[F.tid] = 0u;
    __syncthreads();
    XcdBarrier bar = xcd_barrier_post((unsigned*)(a.ws + WS_CTL) + CW_BAR + a.li * XCD_BAR_WORDS, MISC + 8);
    const int lo = a.ph_lo, hi = a.ph_hi;
#define IN_(k) (lo <= (k) && (k) < hi)
#define SEAM_(k) do { if (IN_(k) && IN_((k) + 1)) xcd_barrier(bar); } while (0)
    if (IN_(0)) { p0_prologue(F); } SEAM_(0);
    if (IN_(1)) { p1_inproj(F); } SEAM_(1);
    if (IN_(5)) { p2_qkv(F, 1); } SEAM_(5);
    if (IN_(7)) { p2_qkv(F, 0); } SEAM_(7);
    if (IN_(9)) { p5_gemm(F, 5); } SEAM_(9);
    if (IN_(10)) { p5_gemm(F, 6); } SEAM_(10);
    if (IN_(11)) { p5_gemm(F, 7); } SEAM_(11);
    if (IN_(13)) { p5_gemm(F, 9); }
}

__global__ void k_slotsum(const float* __restrict__ slotkv, float* __restrict__ skv) {
    const int r = blockIdx.x * blockDim.x + threadIdx.x; if (r >= MT) return;
    float b = 0.f; for (int i = 0; i < 8; ++i) b += slotkv[(size_t)r * 8 + i]; skv[r] = rsqrtf(b * (1.f / KV_LORA) + EPS);
}
__global__ void k_kvl_finish2(const bf16_t* __restrict__ kvl, const float* __restrict__ skv, float* __restrict__ dout) {
    const int r = blockIdx.x * 4 + (threadIdx.x >> 6), lane = threadIdx.x & 63; if (r >= MT) return;
    const float s = skv[r];
    float* o = r < MP ? dout + O_LATP + (size_t)r * KV_LORA : dout + O_LATS + (size_t)(r - MP) * KV_LORA;
#pragma unroll
    for (int jj = 0; jj < 8; ++jj) { const int c = jj * 64 + lane; o[c] = bf2f(kvl[(size_t)r * KV_LORA + c]) * s; }
}

static void gemm(hipStream_t s, const bf16_t* A, int lda, const bf16_t* Bt, int K, int M, int N, const Epi& E) {
    const int nb = ((M + 63) / 64) * (N / 64);
    hipLaunchKernelGGL(k_gemm, dim3(nb), dim3(256), 0, s, A, lda, Bt, K, M, N, E);
}
static Epi mkepi(int mode, bf16_t* o1, int ldo) { Epi e{}; e.mode = mode; e.o1 = o1; e.ldo = ldo; return e; }

extern "C" void kernel_launch(void* const* d_in, const int* in_sizes, int n_in, void* d_out, int out_size, void* d_ws, size_t ws_size, hipStream_t stream) {
    const float* x_p = (const float*)d_in[0]; const float* x_s = (const float*)d_in[1];
    const float* st_ret = (const float*)d_in[4]; const float* st_conv = (const float*)d_in[5];
    const float* w_in = (const float*)d_in[7]; const float* g_qlat = (const float*)d_in[8]; const float* w_qup = (const float*)d_in[9];
    const float* g_qn = (const float*)d_in[10]; const float* g_qr = (const float*)d_in[11]; const float* w_kvup = (const float*)d_in[13];
    const float* g_kn = (const float*)d_in[14]; const float* g_ret = (const float*)d_in[16]; const float* w_ob = (const float*)d_in[17];
    const float* w_out = (const float*)d_in[18]; const float* g_ffn = (const float*)d_in[19]; const float* w_up = (const float*)d_in[20]; const float* cw = (const float*)d_in[21];
    const float* cb = (const float*)d_in[22]; const float* w_down = (const float*)d_in[23]; const float* g_mix = (const float*)d_in[6];
    float* out = (float*)d_out; char* ws = (char*)d_ws;
    static int ok = 0;
    if (ok == 0) {
        ok = 1;
        if (ws_size < 256 * MiB || n_in != 24) { fprintf(stderr, "kernel_launch: bad ws/n_in: %zu %d\n", ws_size, n_in); ok = -1; }
        int dev = 0, cus = 0; hipGetDevice(&dev); hipDeviceGetAttribute(&cus, hipDeviceAttributeMultiprocessorCount, dev);
        if (cus != 256) { fprintf(stderr, "kernel_launch: built for 256 CUs, got %d\n", cus); ok = -1; }
        if (hipFuncSetAttribute((const void*)mk, hipFuncAttributeMaxDynamicSharedMemorySize, LDS_BYTES) != hipSuccess) { fprintf(stderr, "kernel_launch: hipFuncSetAttribute(mk) failed\n"); ok = -1; }
        if (hipFuncSetAttribute((const void*)k_ret, hipFuncAttributeMaxDynamicSharedMemorySize, 110 * 1024) != hipSuccess) { fprintf(stderr, "kernel_launch: hipFuncSetAttribute(k_ret) failed\n"); ok = -1; }
        (void)hipGetLastError();
    }
    if (ok < 0) return;
#define WSB(off) ((bf16_t*)(ws + (off)))
    float* SQ = (float*)(ws + WS_SQ); float* SKV = (float*)(ws + WS_SKV);
    float2* TAB32 = (float2*)(ws + WS_TAB32); float2* TAB64 = (float2*)(ws + WS_TAB64);

    auto run = [&](int lo, int hi, int li) { MArgs a{}; for (int i = 0; i < 24; ++i) a.in[i] = (const float*)d_in[i]; a.out = out; a.ws = (unsigned char*)ws; a.ph_lo = lo; a.ph_hi = hi; a.li = li;
        hipLaunchKernelGGL(mk, dim3(256), dim3(NTHR), LDS_BYTES, stream, a); };
    (void)hipMemsetAsync(ws + WS_CTL, 0, CTL_BYTES, stream);
    run(0, 2, 0);
    hipLaunchKernelGGL(k_slotsum, dim3((MT + 255) / 256), dim3(256), 0, stream, (const float*)(ws + WS_SLOTKV), SKV);
    hipLaunchKernelGGL(k_kvl_finish2, dim3(MT / 4), dim3(256), 0, stream, WSB(WS_KVL), SKV, out);
    const size_t ret_lds = (size_t)(64 * 129 * 2 + 128 * 33 + 64 * 33 + 64 * 65) * 4;
    hipLaunchKernelGGL(k_ret, dim3(BATCH * RET_H * 8), dim3(256), ret_lds, stream, WSB(WS_RQ), WSB(WS_RK), WSB(WS_RV), 0, SEQ, 64, SEQ / 64, (const float*)nullptr, WSB(WS_RET), out + O_RETP);
    hipLaunchKernelGGL(k_ret, dim3(DEC_BATCH * RET_H * 8), dim3(256), ret_lds, stream, WSB(WS_RQ), WSB(WS_RK), WSB(WS_RV), MP, DEC_SEQ, DEC_SEQ, 1, st_ret, WSB(WS_RET), out + O_RETS);
    hipLaunchKernelGGL(k_ret_finish, dim3(MT / 4), dim3(256), 0, stream, WSB(WS_RET), g_ret, WSB(WS_RG));
    bf16_t* Qb = (bf16_t*)out;
    run(5, 6, 1);
    hipLaunchKernelGGL(k_attn<1>, dim3(DEC_BATCH * HEADS), dim3(64), 0, stream, Qb, WSB(WS_KN), WSB(WS_PES), WSB(WS_V), WSB(WS_ATTS) - (size_t)MP * 1024, 1);
    hipLaunchKernelGGL(k_rownorm, dim3(MT / 4), dim3(256), 0, stream, x_p, x_s, WSB(WS_XN2));
    run(7, 8, 1);
    hipLaunchKernelGGL(k_attn<4>, dim3(BATCH * HEADS * 128), dim3(256), 0, stream, Qb, WSB(WS_KN), WSB(WS_KPE), WSB(WS_V), WSB(WS_ATT), 0);
    run(9, 12, 2);
    hipLaunchKernelGGL(k_convout, dim3((DEC_BATCH * 2 * FF2 + 255) / 256), dim3(256), 0, stream, WSB(WS_U), out);
    hipLaunchKernelGGL(k_halo, dim3(64 + DEC_BATCH), dim3(256), 0, stream, WSB(WS_U), st_conv, WSB(WS_HALO));
    hipLaunchKernelGGL(k_conv, dim3((64 + DEC_BATCH) * 11), dim3(256), 0, stream, WSB(WS_U), WSB(WS_HALO), cw, cb);
    run(13, 14, 1);
}
```

```cpp
#include <hip/hip_runtime.h>
#include <stdint.h>
#include <cstdio>

typedef unsigned short bf16_t;
typedef short bf16x8 __attribute__((ext_vector_type(8)));
typedef float f32x4 __attribute__((ext_vector_type(4)));
typedef float f32x2 __attribute__((ext_vector_type(2)));
typedef unsigned u32x4 __attribute__((ext_vector_type(4)));
typedef unsigned u32x2 __attribute__((ext_vector_type(2)));

constexpr int D_MODEL = 1024, BATCH = 2, SEQ = 8192, DEC_BATCH = 8, DEC_SEQ = 16, PAST = 2048;
constexpr int MP = BATCH * SEQ, MS = DEC_BATCH * DEC_SEQ, MT = MP + MS;
constexpr int MPAD = 16640;
constexpr int Q_LORA = 768, KV_LORA = 512, QK_NOPE = 128, QK_ROPE = 64, V_HEAD = 128, HEADS = 8;
constexpr int RET_H = 4, RET_DK = 128, RET_DV = 256;
constexpr int D_FF = 2816, FF2 = 2 * D_FF;
constexpr int IN_W = 6464;
constexpr int SKEYS = PAST + DEC_SEQ;
constexpr int LROWS = DEC_BATCH * SKEYS;
constexpr float EPS = 1e-6f;
constexpr int C_QLAT = 0, C_KVLAT = 768, C_KPE = 1280, C_RQ = 1344, C_RK = 1856, C_RV = 2368, C_RG = 3392, C_GA = 4416, C_GB = 5440;

constexpr size_t O_YP = 0, O_YS = 16777216, O_LATP = 16908288, O_RKP = 25296896, O_RETP = 26345472, O_CONVP = 26607616,
                 O_LATS = 26630144, O_RKS = 26695680, O_RETS = 26703872, O_CONVS = 27752448;

constexpr size_t MiB = 1u << 20, KiB = 1024;
constexpr size_t WS_CTL = 0, CTL_BYTES = 64 * KiB, WS_SQ = 64 * KiB, WS_SKV = 192 * KiB;
constexpr size_t WS_SLOTQ = 1 * MiB, WS_SLOTKV = 2 * MiB, WS_SLOTX1 = 3 * MiB;
constexpr size_t WS_TAB32 = 4 * MiB + 256 * KiB, WS_TAB64 = 6 * MiB + 256 * KiB;
constexpr size_t WS_FWUP = 10 * MiB + 512 * KiB, WS_FWDOWN = 21 * MiB + 512 * KiB, WS_FWIN = 27 * MiB, WS_FWQUP = 40 * MiB, WS_FWKVUP = 43 * MiB,
                 WS_FWOBA = 45 * MiB, WS_FWOBB = 47 * MiB, WS_FWOUT = 49 * MiB;
constexpr size_t WS_XN = 51 * MiB, WS_RET = 51 * MiB;
constexpr size_t WS_LATS = 83 * MiB + 512 * KiB, WS_PES = 99 * MiB + 768 * KiB, WS_ZQ = 102 * MiB, WS_KVL = 126 * MiB + 512 * KiB, WS_KPE = 142 * MiB + 768 * KiB;
constexpr size_t WS_RQ = 145 * MiB, WS_RK = 161 * MiB + 256 * KiB, WS_RV = 177 * MiB + 512 * KiB, WS_RG = 210 * MiB;
constexpr size_t WS_KN = 145 * MiB, WS_V = 177 * MiB + 512 * KiB, WS_ATTS = 242 * MiB + 512 * KiB, WS_XN2 = 210 * MiB, WS_ATT = 102 * MiB;
constexpr size_t WS_T1 = 166 * MiB + 512 * KiB, WS_MERGED = 134 * MiB;
constexpr size_t WS_X1B = 223 * MiB + 512 * KiB, WS_U = 27 * MiB, WS_HALO = 206 * MiB;

__device__ __forceinline__ bf16_t f2bf(float f) { unsigned u = __float_as_uint(f); u = (u + 0x7fffu + ((u >> 16) & 1u)) >> 16; return (bf16_t)u; }
__device__ __forceinline__ float bf2f(bf16_t b) { return __uint_as_float(((unsigned)b) << 16); }
__device__ __forceinline__ float wave_sum(float v) {
#pragma unroll
    for (int o = 1; o < 64; o <<= 1) v += __shfl_xor(v, o);
    return v;
}
__device__ __forceinline__ float sigmoidf_(float x) { return 1.f / (1.f + __expf(-x)); }
__device__ __forceinline__ float siluf_(float x) { return x / (1.f + __expf(-x)); }

__global__ void k_convert_w(const float* __restrict__ W, int ldw, int K, int N, const float* __restrict__ gain, bf16_t* __restrict__ Wt) {
    __shared__ float tile[32][33];
    const int nb = N / 32, kb = blockIdx.x / nb, nbi = blockIdx.x % nb;
    const int tx = threadIdx.x & 31, ty = threadIdx.x >> 5;
    for (int i = ty; i < 32; i += 8) { const int k = kb * 32 + i; tile[i][tx] = W[(size_t)k * ldw + nbi * 32 + tx] * (gain ? gain[k] : 1.f); }
    __syncthreads();
    for (int i = ty; i < 32; i += 8) { const int n = nbi * 32 + i; Wt[(size_t)n * K + kb * 32 + tx] = f2bf(tile[tx][i]); }
}
__global__ void k_tables(float2* tab32, float2* tab64) {
    const int idx = blockIdx.x * blockDim.x + threadIdx.x;
    if (idx < 8192 * 32) { const int pos = idx / 32, i = idx % 32; const double f = pow(10000.0, -(double)i / 32.0), a = (double)pos * f; tab32[idx] = make_float2((float)cos(a), (float)sin(a)); }
    if (idx < 8192 * 64) { const int pos = idx / 64, i = idx % 64; const double f = pow(10000.0, -(double)i / 64.0), a = (double)pos * f; tab64[idx] = make_float2((float)cos(a), (float)sin(a)); }
}
__global__ void k_rownorm(const float* __restrict__ xa, const float* __restrict__ xb, bf16_t* __restrict__ out) {
    const int r = blockIdx.x * 4 + (threadIdx.x >> 6), lane = threadIdx.x & 63; if (r >= MT) return;
    const float* x = r < MP ? xa + (size_t)r * D_MODEL : xb + (size_t)(r - MP) * D_MODEL;
    f32x4 v[4]; float s = 0.f;
#pragma unroll
    for (int j = 0; j < 4; ++j) { v[j] = *(const f32x4*)(x + j * 256 + lane * 4); s += v[j][0] * v[j][0] + v[j][1] * v[j][1] + v[j][2] * v[j][2] + v[j][3] * v[j][3]; }
    const float inv = rsqrtf(wave_sum(s) * (1.f / D_MODEL) + EPS);
#pragma unroll
    for (int j = 0; j < 4; ++j) { bf16_t* o = out + (size_t)r * D_MODEL + j * 256 + lane * 4;
        o[0] = f2bf(v[j][0] * inv); o[1] = f2bf(v[j][1] * inv); o[2] = f2bf(v[j][2] * inv); o[3] = f2bf(v[j][3] * inv); }
}
__global__ void k_cache(const float* __restrict__ clat, const float* __restrict__ cpe, bf16_t* __restrict__ lats, bf16_t* __restrict__ pes) {
    const size_t idx = (size_t)blockIdx.x * blockDim.x + threadIdx.x;
    const size_t nlat = (size_t)DEC_BATCH * PAST * KV_LORA, npe = (size_t)DEC_BATCH * PAST * QK_ROPE;
    if (idx < nlat) { const int c = idx % KV_LORA; const size_t rj = idx / KV_LORA; const int j = rj % PAST, b = rj / PAST; lats[((size_t)b * SKEYS + j) * KV_LORA + c] = f2bf(clat[idx]); }
    if (idx < npe) { const int c = idx % QK_ROPE; const size_t rj = idx / QK_ROPE; const int j = rj % PAST, b = rj / PAST; pes[((size_t)b * SKEYS + j) * QK_ROPE + c] = f2bf(cpe[idx]); }
}

enum { EP_BF16 = 0, EP_SILU = 1, EP_SIGM = 2, EP_ROWSCALE = 3, EP_KVSPLIT = 4, EP_MUL = 5, EP_MULADD = 6, EP_RESID = 7, EP_RESID_INPLACE = 8 };
struct Epi {
    int mode; int ldo; bf16_t* o1; bf16_t* o2; const float* rs; const bf16_t* g; const float* xa; const float* xb; float* of;
};
__device__ __forceinline__ void epi_apply(const Epi& E, int r, int c, float v) {
    switch (E.mode) {
    case EP_BF16: E.o1[(size_t)r * E.ldo + c] = f2bf(v); break;
    case EP_SILU: E.o1[(size_t)r * E.ldo + c] = f2bf(siluf_(v)); break;
    case EP_SIGM: E.o1[(size_t)r * E.ldo + c] = f2bf(sigmoidf_(v)); break;
    case EP_ROWSCALE: E.o1[(size_t)r * E.ldo + c] = f2bf(v * E.rs[r]); break;
    case EP_KVSPLIT: { const int h = c >> 8, j = c & 255; const float s = E.rs ? E.rs[r] : 1.f;
        if (j < 128) E.o1[(size_t)r * 1024 + h * 128 + j] = f2bf(v * s); else E.o2[(size_t)r * 1024 + h * 128 + (j - 128)] = f2bf(v * s); } break;
    case EP_MUL: E.o1[(size_t)r * E.ldo + c] = f2bf(v * bf2f(E.g[(size_t)r * E.ldo + c])); break;
    case EP_MULADD: { const size_t i = (size_t)r * E.ldo + c; E.o1[i] = f2bf(bf2f(E.o1[i]) + v * bf2f(E.g[i])); } break;
    case EP_RESID: { const float x = r < MP ? E.xa[(size_t)r * D_MODEL + c] : E.xb[(size_t)(r - MP) * D_MODEL + c]; E.of[(size_t)r * D_MODEL + c] = x + v; } break;
    case EP_RESID_INPLACE: { const size_t i = (size_t)r * D_MODEL + c; E.of[i] = E.of[i] + v; } break;
    }
}
__global__ void __launch_bounds__(256) k_gemm(const bf16_t* __restrict__ A, int lda, const bf16_t* __restrict__ Bt, int K, int M, int N, Epi E) {
    __shared__ bf16_t As[64][72], Bs[64][72];
    const int nbn = N / 64, bm = blockIdx.x / nbn, bn = blockIdx.x % nbn;
    const int tid = threadIdx.x, w = tid >> 6, lane = tid & 63, fr = lane & 15, fq = lane >> 4;
    f32x4 acc[4] = {};
    const int lr = tid >> 2, lc = (tid & 3) * 16;
    for (int k0 = 0; k0 < K; k0 += 64) {
        const int ar = bm * 64 + lr;
        bf16x8 a0 = {}, a1 = {};
        if (ar < M) { a0 = *(const bf16x8*)(A + (size_t)ar * lda + k0 + lc); a1 = *(const bf16x8*)(A + (size_t)ar * lda + k0 + lc + 8); }
        const bf16x8 b0 = *(const bf16x8*)(Bt + (size_t)(bn * 64 + lr) * K + k0 + lc), b1 = *(const bf16x8*)(Bt + (size_t)(bn * 64 + lr) * K + k0 + lc + 8);
        __syncthreads();
        *(bf16x8*)&As[lr][lc] = a0; *(bf16x8*)&As[lr][lc + 8] = a1; *(bf16x8*)&Bs[lr][lc] = b0; *(bf16x8*)&Bs[lr][lc + 8] = b1;
        __syncthreads();
#pragma unroll
        for (int ks = 0; ks < 2; ++ks) {
            const bf16x8 af = *(const bf16x8*)&As[w * 16 + fr][ks * 32 + fq * 8];
#pragma unroll
            for (int n = 0; n < 4; ++n) { const bf16x8 bfr = *(const bf16x8*)&Bs[n * 16 + fr][ks * 32 + fq * 8];
                acc[n] = __builtin_amdgcn_mfma_f32_16x16x32_bf16(af, bfr, acc[n], 0, 0, 0); }
        }
    }
#pragma unroll
    for (int n = 0; n < 4; ++n)
#pragma unroll
        for (int i = 0; i < 4; ++i) { const int r = bm * 64 + w * 16 + fq * 4 + i, c = bn * 64 + n * 16 + fr; if (r < M) epi_apply(E, r, c, acc[n][i]); }
}

__global__ void k_zq_finish(const bf16_t* __restrict__ zq, float* __restrict__ sq) {
    const int r = blockIdx.x * 4 + (threadIdx.x >> 6), lane = threadIdx.x & 63; if (r >= MT) return;
    float s = 0.f; for (int c = lane; c < Q_LORA; c += 64) { const float v = bf2f(zq[(size_t)r * Q_LORA + c]); s += v * v; }
    s = wave_sum(s); if (lane == 0) sq[r] = rsqrtf(s * (1.f / Q_LORA) + EPS);
}
__global__ void k_kvl_finish(const bf16_t* __restrict__ kvl, const float* __restrict__ g, float* __restrict__ skv, float* __restrict__ dout, bf16_t* __restrict__ lats) {
    const int r = blockIdx.x * 4 + (threadIdx.x >> 6), lane = threadIdx.x & 63; if (r >= MT) return;
    float v[8]; float s = 0.f;
#pragma unroll
    for (int j = 0; j < 8; ++j) { v[j] = bf2f(kvl[(size_t)r * KV_LORA + j * 64 + lane]); s += v[j] * v[j]; }
    const float inv = rsqrtf(wave_sum(s) * (1.f / KV_LORA) + EPS); if (lane == 0) skv[r] = inv;
    float* o = r < MP ? dout + O_LATP + (size_t)r * KV_LORA : dout + O_LATS + (size_t)(r - MP) * KV_LORA;
#pragma unroll
    for (int j = 0; j < 8; ++j) { const int c = j * 64 + lane; const float y = v[j] * inv * g[c]; o[c] = y;
        if (r >= MP) { const int rs = r - MP, b = rs / DEC_SEQ, t = rs % DEC_SEQ; lats[((size_t)b * SKEYS + PAST + t) * KV_LORA + c] = f2bf(y); } }
}
__global__ void k_kpe_finish(const bf16_t* __restrict__ raw, const float* __restrict__ g, const float2* __restrict__ tab32, bf16_t* __restrict__ kpe, float* __restrict__ dout, bf16_t* __restrict__ pes) {
    const int r = blockIdx.x * 4 + (threadIdx.x >> 6), lane = threadIdx.x & 63; if (r >= MT) return;
    const float v = bf2f(raw[(size_t)r * 64 + lane]); const float inv = rsqrtf(wave_sum(v * v) * (1.f / 64.f) + EPS);
    const float y = v * inv * g[lane]; const float yo = __shfl_xor(y, 32);
    const int pos = r < MP ? (r % SEQ) : PAST + ((r - MP) % DEC_SEQ);
    const float2 cs = tab32[pos * 32 + (lane & 31)];
    const float o = lane < 32 ? y * cs.x - yo * cs.y : yo * cs.y + y * cs.x;
    kpe[(size_t)r * 64 + lane] = f2bf(o);
    if (r < MP) dout[O_RKP + (size_t)r * 64 + lane] = o;
    else { const int rs = r - MP, b = rs / DEC_SEQ, t = rs % DEC_SEQ; dout[O_RKS + (size_t)rs * 64 + lane] = o; pes[((size_t)b * SKEYS + PAST + t) * 64 + lane] = f2bf(o); }
}
__global__ void k_rope_r(bf16_t* __restrict__ buf, const float2* __restrict__ tab64, float scale) {
    const int r = blockIdx.x, tid = threadIdx.x;
    const int h = tid >> 6, i = tid & 63; const int pos = r < MP ? (r % SEQ) : PAST + ((r - MP) % DEC_SEQ);
    bf16_t* p = buf + (size_t)r * 512 + h * 128; const float x1 = bf2f(p[i]), x2 = bf2f(p[i + 64]); const float2 cs = tab64[pos * 64 + i];
    p[i] = f2bf((x1 * cs.x - x2 * cs.y) * scale); p[i + 64] = f2bf((x1 * cs.y + x2 * cs.x) * scale);
}
__global__ void k_q_finish(bf16_t* __restrict__ q, const float* __restrict__ gn, const float* __restrict__ gr, const float2* __restrict__ tab32, float c2) {
    const int r = blockIdx.x * 4 + (threadIdx.x >> 6), lane = threadIdx.x & 63; if (r >= MT) return;
    const int pos = r < MP ? (r % SEQ) : PAST + ((r - MP) % DEC_SEQ);
    for (int h = 0; h < HEADS; ++h) {
        bf16_t* p = q + (size_t)r * 1536 + h * 192;
        const float a = bf2f(p[lane]), b = bf2f(p[lane + 64]), c = bf2f(p[128 + lane]);
        const float in = rsqrtf(wave_sum(a * a + b * b) * (1.f / 128.f) + EPS), ir = rsqrtf(wave_sum(c * c) * (1.f / 64.f) + EPS);
        p[lane] = f2bf(a * in * gn[lane] * c2); p[lane + 64] = f2bf(b * in * gn[lane + 64] * c2);
        const float y = c * ir * gr[lane], yo = __shfl_xor(y, 32); const float2 cs = tab32[pos * 32 + (lane & 31)];
        p[128 + lane] = f2bf((lane < 32 ? y * cs.x - yo * cs.y : yo * cs.y + y * cs.x) * c2);
    }
}
__global__ void k_kn_finish(bf16_t* __restrict__ kn, const float* __restrict__ g, int rows) {
    const int r = blockIdx.x * 4 + (threadIdx.x >> 6), lane = threadIdx.x & 63; if (r >= rows) return;
    for (int h = 0; h < HEADS; ++h) { bf16_t* p = kn + (size_t)r * 1024 + h * 128; const float a = bf2f(p[lane]), b = bf2f(p[lane + 64]);
        const float in = rsqrtf(wave_sum(a * a + b * b) * (1.f / 128.f) + EPS); p[lane] = f2bf(a * in * g[lane]); p[lane + 64] = f2bf(b * in * g[lane + 64]); }
}
__global__ void k_ret_finish(bf16_t* __restrict__ ret, const float* __restrict__ g, const bf16_t* __restrict__ gate) {
    const int r = blockIdx.x * 4 + (threadIdx.x >> 6), lane = threadIdx.x & 63; if (r >= MT) return;
    for (int h = 0; h < RET_H; ++h) { bf16_t* p = ret + (size_t)r * 1024 + h * 256; float v[4]; float s = 0.f;
#pragma unroll
        for (int j = 0; j < 4; ++j) { v[j] = bf2f(p[j * 64 + lane]); s += v[j]; }
        const float mu = wave_sum(s) * (1.f / 256.f); float q = 0.f;
#pragma unroll
        for (int j = 0; j < 4; ++j) { v[j] -= mu; q += v[j] * v[j]; }
        const float inv = rsqrtf(wave_sum(q) * (1.f / 256.f) + EPS);
#pragma unroll
        for (int j = 0; j < 4; ++j) { const int c = h * 256 + j * 64 + lane; p[j * 64 + lane] = f2bf(v[j] * inv * g[c] * bf2f(gate[(size_t)r * 1024 + c])); } }
}
__global__ void k_x1_finish(const float* __restrict__ x1, bf16_t* __restrict__ out) {
    const int r = blockIdx.x * 4 + (threadIdx.x >> 6), lane = threadIdx.x & 63; if (r >= MT) return;
    const float* x = x1 + (size_t)r * D_MODEL; f32x4 v[4]; float s = 0.f;
#pragma unroll
    for (int j = 0; j < 4; ++j) { v[j] = *(const f32x4*)(x + j * 256 + lane * 4); s += v[j][0] * v[j][0] + v[j][1] * v[j][1] + v[j][2] * v[j][2] + v[j][3] * v[j][3]; }
    const float inv = rsqrtf(wave_sum(s) * (1.f / D_MODEL) + EPS);
#pragma unroll
    for (int j = 0; j < 4; ++j) { bf16_t* o = out + (size_t)r * D_MODEL + j * 256 + lane * 4;
        o[0] = f2bf(v[j][0] * inv); o[1] = f2bf(v[j][1] * inv); o[2] = f2bf(v[j][2] * inv); o[3] = f2bf(v[j][3] * inv); }
}

template <int NW>
__global__ void __launch_bounds__(NW * 64) k_attn(const bf16_t* __restrict__ Q, const bf16_t* __restrict__ KN, const bf16_t* __restrict__ KPE, const bf16_t* __restrict__ V,
                                                 bf16_t* __restrict__ att, int sample) {
    __shared__ bf16_t Ks[64][200]; __shared__ bf16_t Vt[128][72]; __shared__ bf16_t Ps[NW][16][72];
    const int tid = threadIdx.x, w = tid >> 6, lane = tid & 63, fr = lane & 15, fq = lane >> 4;
    int b, h, qrow0, krow0, nkeys;
    if (!sample) { const int c = blockIdx.x % 128, bh = blockIdx.x / 128; h = bh % HEADS; b = bh / HEADS; qrow0 = b * SEQ + c * 64 + w * 16; krow0 = b * SEQ; nkeys = (c + 1) * 64; }
    else { h = blockIdx.x % HEADS; b = blockIdx.x / HEADS; qrow0 = MP + b * DEC_SEQ; krow0 = b * SKEYS; nkeys = SKEYS; }
    bf16x8 qf[6];
#pragma unroll
    for (int s = 0; s < 6; ++s) qf[s] = *(const bf16x8*)(Q + (size_t)(qrow0 + fr) * 1536 + h * 192 + s * 32 + fq * 8);
    f32x4 o[8] = {}; float m[4], l[4];
#pragma unroll
    for (int i = 0; i < 4; ++i) { m[i] = -1e30f; l[i] = 0.f; }
    const int ntile = (nkeys + 63) / 64;
    for (int t = 0; t < ntile; ++t) {
        __syncthreads();
        for (int idx = tid; idx < 64 * 24; idx += NW * 64) { const int key = idx / 24, ch = idx % 24; const int kg = t * 64 + key; bf16x8 v = {};
            if (kg < nkeys) { if (ch < 16) v = *(const bf16x8*)(KN + (size_t)(krow0 + kg) * 1024 + h * 128 + ch * 8); else v = *(const bf16x8*)(KPE + (size_t)(krow0 + kg) * 64 + (ch - 16) * 8); }
            *(bf16x8*)&Ks[key][ch * 8] = v; }
        for (int idx = tid; idx < 64 * 16; idx += NW * 64) { const int key = idx / 16, ch = idx % 16; const int kg = t * 64 + key; bf16x8 v = {};
            if (kg < nkeys) v = *(const bf16x8*)(V + (size_t)(krow0 + kg) * 1024 + h * 128 + ch * 8);
#pragma unroll
            for (int e = 0; e < 8; ++e) Vt[ch * 8 + e][key] = (bf16_t)v[e]; }
        __syncthreads();
        f32x4 s[4] = {};
#pragma unroll
        for (int ks = 0; ks < 6; ++ks)
#pragma unroll
            for (int n = 0; n < 4; ++n) { const bf16x8 kf = *(const bf16x8*)&Ks[n * 16 + fr][ks * 32 + fq * 8]; s[n] = __builtin_amdgcn_mfma_f32_16x16x32_bf16(qf[ks], kf, s[n], 0, 0, 0); }
#pragma unroll
        for (int n = 0; n < 4; ++n) if (t * 64 + n * 16 + fr >= nkeys) { s[n][0] = -INFINITY; s[n][1] = -INFINITY; s[n][2] = -INFINITY; s[n][3] = -INFINITY; }
        float alpha[4];
#pragma unroll
        for (int i = 0; i < 4; ++i) { float mx = fmaxf(fmaxf(s[0][i], s[1][i]), fmaxf(s[2][i], s[3][i]));
            mx = fmaxf(mx, __shfl_xor(mx, 1)); mx = fmaxf(mx, __shfl_xor(mx, 2)); mx = fmaxf(mx, __shfl_xor(mx, 4)); mx = fmaxf(mx, __shfl_xor(mx, 8));
            const float mn = fmaxf(m[i], mx); alpha[i] = exp2f(m[i] - mn); m[i] = mn; float ps = 0.f;
#pragma unroll
            for (int n = 0; n < 4; ++n) { const float p = exp2f(s[n][i] - mn); s[n][i] = p; ps += p; }
            ps += __shfl_xor(ps, 1); ps += __shfl_xor(ps, 2); ps += __shfl_xor(ps, 4); ps += __shfl_xor(ps, 8);
            l[i] = l[i] * alpha[i] + ps; }
#pragma unroll
        for (int n = 0; n < 4; ++n)
#pragma unroll
            for (int i = 0; i < 4; ++i) Ps[w][fq * 4 + i][n * 16 + fr] = f2bf(s[n][i]);
#pragma unroll
        for (int n = 0; n < 8; ++n)
#pragma unroll
            for (int i = 0; i < 4; ++i) o[n][i] *= alpha[i];
#pragma unroll
        for (int ks = 0; ks < 2; ++ks) { const bf16x8 pf = *(const bf16x8*)&Ps[w][fr][ks * 32 + fq * 8];
#pragma unroll
            for (int n = 0; n < 8; ++n) { const bf16x8 vf = *(const bf16x8*)&Vt[n * 16 + fr][ks * 32 + fq * 8]; o[n] = __builtin_amdgcn_mfma_f32_16x16x32_bf16(pf, vf, o[n], 0, 0, 0); } }
    }
#pragma unroll
    for (int i = 0; i < 4; ++i) { const float rl = 1.f / l[i]; const int r = qrow0 + fq * 4 + i;
#pragma unroll
        for (int n = 0; n < 8; ++n) att[(size_t)r * 1024 + h * 128 + n * 16 + fr] = f2bf(o[n][i] * rl); }
}

__global__ void __launch_bounds__(256) k_ret(const bf16_t* __restrict__ rq, const bf16_t* __restrict__ rk, const bf16_t* __restrict__ rv, int rowbase, int rows_per_batch, int L, int nch,
                                             const float* __restrict__ Sinit, bf16_t* __restrict__ retraw, float* __restrict__ Sout) {
    extern __shared__ float sm[];
    float* qs = sm;
    float* ks = qs + 64 * 129;
    float* Ss = ks + 64 * 129;
    float* vs = Ss + 128 * 33;
    float* sc = vs + 64 * 33;
    const int tid = threadIdx.x; const int sl = blockIdx.x % 8, h = (blockIdx.x / 8) % RET_H, b = blockIdx.x / 32;
    const float gam = 1.f - exp2f(-5.f - (float)h), lg2 = log2f(gam);
    for (int i = tid; i < 128 * 32; i += 256) { const int d = i / 32, e = i % 32; Ss[d * 33 + e] = Sinit ? Sinit[(((size_t)b * RET_H + h) * RET_DK + d) * RET_DV + sl * 32 + e] : 0.f; }
    const float gL = exp2f(lg2 * (float)L);
    for (int c = 0; c < nch; ++c) {
        const size_t r0 = (size_t)rowbase + (size_t)b * rows_per_batch + (size_t)c * L;
        __syncthreads();
        for (int i = tid; i < L * 128; i += 256) { const int j = i / 128, d = i % 128; qs[j * 129 + d] = bf2f(rq[(r0 + j) * 512 + h * 128 + d]); ks[j * 129 + d] = bf2f(rk[(r0 + j) * 512 + h * 128 + d]); }
        for (int i = tid; i < L * 32; i += 256) { const int j = i / 32, e = i % 32; vs[j * 33 + e] = bf2f(rv[(r0 + j) * 1024 + h * 256 + sl * 32 + e]); }
        __syncthreads();
        for (int p = tid; p < L * L; p += 256) { const int i = p / L, j = p % L; float s = 0.f;
            if (j <= i) { for (int d = 0; d < 128; ++d) s += qs[i * 129 + d] * ks[j * 129 + d]; s *= exp2f(lg2 * (float)(i - j)); }
            sc[i * 65 + j] = s; }
        __syncthreads();
        for (int p = tid; p < L * 32; p += 256) { const int i = p / 32, e = p % 32; float a = 0.f, cr = 0.f;
            for (int j = 0; j <= i; ++j) a += sc[i * 65 + j] * vs[j * 33 + e];
            for (int d = 0; d < 128; ++d) cr += qs[i * 129 + d] * Ss[d * 33 + e];
            retraw[(r0 + i) * 1024 + h * 256 + sl * 32 + e] = f2bf(a + cr * exp2f(lg2 * (float)(i + 1))); }
        __syncthreads();
        for (int p = tid; p < 128 * 32; p += 256) { const int d = p / 32, e = p % 32; float a = Ss[d * 33 + e] * gL;
            for (int j = 0; j < L; ++j) a += ks[j * 129 + d] * exp2f(lg2 * (float)(L - 1 - j)) * vs[j * 33 + e];
            Ss[d * 33 + e] = a; }
    }
    __syncthreads();
    for (int i = tid; i < 128 * 32; i += 256) { const int d = i / 32, e = i % 32; Sout[(((size_t)b * RET_H + h) * RET_DK + d) * RET_DV + sl * 32 + e] = Ss[d * 33 + e]; }
}

__global__ void k_halo(const bf16_t* __restrict__ U, const float* __restrict__ prev_s, bf16_t* __restrict__ halo) {
    const int ch = blockIdx.x; const int tid = threadIdx.x;
    for (int i = tid; i < 2 * FF2; i += 256) { const int k = i / FF2, n = i % FF2; float v = 0.f;
        if (ch < 64) { const int r0 = ch * 256; if ((r0 % SEQ) != 0) v = bf2f(U[(size_t)(r0 - 2 + k) * FF2 + n]); }
        else { const int b = ch - 64; v = prev_s[((size_t)b * 2 + k) * FF2 + n]; }
        halo[(size_t)ch * 2 * FF2 + i] = f2bf(v); }
}
__global__ void __launch_bounds__(256) k_conv(bf16_t* __restrict__ U, const bf16_t* __restrict__ halo, const float* __restrict__ cw, const float* __restrict__ cb) {
    const int ch = blockIdx.x / 11, strip = blockIdx.x % 11; const int n = strip * 256 + threadIdx.x;
    int r0, nr; if (ch < 64) { r0 = ch * 256; nr = 256; } else { r0 = MP + (ch - 64) * DEC_SEQ; nr = DEC_SEQ; }
    const int nv = n + D_FF;
    const float wg0 = cw[n], wg1 = cw[FF2 + n], wg2 = cw[2 * FF2 + n], bg = cb[n], wv0 = cw[nv], wv1 = cw[FF2 + nv], wv2 = cw[2 * FF2 + nv], bv = cb[nv];
    float g2 = bf2f(halo[(size_t)ch * 2 * FF2 + n]), g1 = bf2f(halo[(size_t)ch * 2 * FF2 + FF2 + n]);
    float v2 = bf2f(halo[(size_t)ch * 2 * FF2 + nv]), v1 = bf2f(halo[(size_t)ch * 2 * FF2 + FF2 + nv]);
    for (int i = 0; i < nr; ++i) { bf16_t* row = U + (size_t)(r0 + i) * FF2; const float g0 = bf2f(row[n]), v0 = bf2f(row[nv]);
        const float cg = g2 * wg0 + g1 * wg1 + g0 * wg2 + bg, cv = v2 * wv0 + v1 * wv1 + v0 * wv2 + bv;
        row[n] = f2bf(siluf_(cg) * cv); g2 = g1; g1 = g0; v2 = v1; v1 = v0; }
}
__global__ void k_convout(const bf16_t* __restrict__ U, float* __restrict__ dout) {
    const int idx = blockIdx.x * blockDim.x + threadIdx.x;
    if (idx < BATCH * 2 * FF2) { const int n = idx % FF2, k = (idx / FF2) % 2, b = idx / (2 * FF2); dout[O_CONVP + idx] = bf2f(U[(size_t)(b * SEQ + SEQ - 2 + k) * FF2 + n]); }
    if (idx < DEC_BATCH * 2 * FF2) { const int n = idx % FF2, k = (idx / FF2) % 2, b = idx / (2 * FF2); dout[O_CONVS + idx] = bf2f(U[(size_t)(MP + b * DEC_SEQ + DEC_SEQ - 2 + k) * FF2 + n]); }
}

#define LAS __attribute__((address_space(3)))
#define GAS __attribute__((address_space(1)))
constexpr int NTHR = 512;
constexpr int RING_BYTES = 131072, EPI_OFF = RING_BYTES, EPI_BYTES = 8192, MISC_OFF = EPI_OFF + EPI_BYTES, LDS_BYTES = 147456;
constexpr int CW_BAR = 1024;

__device__ __forceinline__ unsigned cvt_pk_bf16(float lo, float hi) { unsigned r; asm volatile("v_cvt_pk_bf16_f32 %0, %1, %2" : "=v"(r) : "v"(lo), "v"(hi)); return r; }
__device__ __forceinline__ u32x4 pack8f(const f32x4& a, const f32x4& b) { u32x4 w; w.x = cvt_pk_bf16(a[0], a[1]); w.y = cvt_pk_bf16(a[2], a[3]); w.z = cvt_pk_bf16(b[0], b[1]); w.w = cvt_pk_bf16(b[2], b[3]); return w; }
__device__ __forceinline__ int row_pos(int row) { return row < MP ? (row & (SEQ - 1)) : PAST + ((row - MP) & (DEC_SEQ - 1)); }

#define XB_TMO      128
#define XB_XCNT(j)  (256  + 64 * (j))
#define XB_XSUB(j)  (1280 + 64 * (j))
#define XB_XGEN(j)  (2304 + 64 * (j))
#define XB_TOP      3328
#define XB_TOPGEN   3392
#define XCD_BAR_WORDS 3456
#define XB_SPIN_CAP (1u << 18)
__device__ __forceinline__ unsigned xb_ld(unsigned* p)              { return __hip_atomic_load(p, __ATOMIC_RELAXED, __HIP_MEMORY_SCOPE_AGENT); }
__device__ __forceinline__ unsigned xb_add(unsigned* p, unsigned v) { return __hip_atomic_fetch_add(p, v, __ATOMIC_RELAXED, __HIP_MEMORY_SCOPE_AGENT); }
__device__ __forceinline__ unsigned xb_xcc_id() { return (unsigned)__builtin_amdgcn_s_getreg((3 << 11) | 20) & 0xFu; }
#define XB_SPIN(cond, bar) do { unsigned _sp = 0; while (cond) { __builtin_amdgcn_s_sleep(1); \
    if ((++_sp & 255u) == 0u) { if (xb_ld(&(bar)[XB_TMO])) break; if (_sp > XB_SPIN_CAP) { atomicAdd(&(bar)[XB_TMO], 1u); break; } } } } while (0)
struct XcdBarrier { unsigned* bar; unsigned x; volatile LAS unsigned* st; };
__device__ __forceinline__ XcdBarrier xcd_barrier_post(unsigned* bar, volatile LAS unsigned* st) {
    XcdBarrier b; b.bar = bar; b.x = xb_xcc_id(); b.st = st;
    if (threadIdx.x == 0) (void)xb_add(&bar[XB_XCNT(b.x)], 1u);
    return b;
}
__device__ __forceinline__ void xcd_barrier_complete(unsigned* bar, unsigned x, unsigned& nloc, unsigned& nx) {
    const unsigned G = gridDim.x * gridDim.y * gridDim.z;
    unsigned sum, cnt, mine, sp = 0u;
    for (;;) {
        sum = 0u; cnt = 0u; mine = 0u;
#pragma unroll
        for (unsigned j = 0; j < 16; ++j) { const unsigned c = xb_ld(&bar[XB_XCNT(j)]); sum += c; cnt += (c > 0u) ? 1u : 0u; mine = (j == x) ? c : mine; }
        if (sum == G) break;
        __builtin_amdgcn_s_sleep(1);
        if ((++sp & 255u) == 0u) { if (xb_ld(&bar[XB_TMO])) break; if (sp > XB_SPIN_CAP) { atomicAdd(&bar[XB_TMO], 1u); break; } }
    }
    nloc = mine > 0u ? mine : 1u; nx = cnt > 0u ? cnt : 1u;
}
__device__ __forceinline__ void xcd_barrier(const XcdBarrier& b) {
    asm volatile("s_waitcnt vmcnt(0)" ::: "memory");
    __syncthreads();
    if (threadIdx.x == 0) {
        unsigned* bar = b.bar;
        __builtin_amdgcn_s_waitcnt(0);
        unsigned nloc = b.st[0], nx = b.st[1];
        if (nloc == 0u) { xcd_barrier_complete(bar, b.x, nloc, nx); b.st[0] = nloc; b.st[1] = nx; }
        const unsigned old = xb_add(&bar[XB_XSUB(b.x)], 1u);
        const unsigned gen = old / nloc;
        if (old + 1u == (gen + 1u) * nloc) {
            __builtin_amdgcn_fence(__ATOMIC_RELEASE, "agent");
            asm volatile("s_waitcnt vmcnt(0)" ::: "memory");
            const unsigned og = xb_add(&bar[XB_TOP], 1u);
            const unsigned tg = og / nx;
            if (og + 1u == (tg + 1u) * nx) xb_add(&bar[XB_TOPGEN], 1u);
            else XB_SPIN(xb_ld(&bar[XB_TOPGEN]) == tg, bar);
            __builtin_amdgcn_fence(__ATOMIC_ACQUIRE, "agent");
            xb_add(&bar[XB_XGEN(b.x)], 1u);
            asm volatile("s_waitcnt vmcnt(0)" ::: "memory");
        } else {
            XB_SPIN(xb_ld(&bar[XB_XGEN(b.x)]) == gen, bar);
            __builtin_amdgcn_fence(__ATOMIC_ACQUIRE, "agent");
            asm volatile("s_waitcnt vmcnt(0)" ::: "memory");
        }
    }
    __syncthreads();
}

namespace pg {
constexpr int BK = 64, HALF = 128, HTB = HALF * BK * 2;
__host__ __device__ __forceinline__ int lds_byte(int r, int c) { const int st = (r >> 4) * 2 + (c >> 5), rr = r & 15, cc = c & 31, ob = rr * 64 + cc * 2; return st * 1024 + (ob ^ (((ob >> 9) & 1) << 5)); }
__host__ __device__ __forceinline__ void stage_rc(int b, int& R, int& C) { const int st = b / 1024, sb = b % 1024, swz = sb ^ (((sb >> 9) & 1) << 5); R = (st >> 1) * 16 + swz / 64; C = (st & 1) * 32 + (swz % 64) / 2; }
__host__ __device__ __forceinline__ int perm32(int rho) { const int n = rho >> 4, i = rho & 15; return 8 * (i >> 2) + 4 * n + (i & 3); }
struct UnitG { const char* A; const char* B; unsigned lda, ldb; int nt; int pm, pn, kind; };
typedef f32x4 Acc[2][2][4][2];

template <class Sched, class Epi>
__device__ __forceinline__ void gemm_stream(LAS unsigned char* lds, const Sched& S, const Epi& E) {
    const int tid = threadIdx.x, wid = __builtin_amdgcn_readfirstlane(tid >> 6), lane = tid & 63, wr = wid >> 2, wc = wid & 3, fr = lane & 15, fq = lane >> 4;
    unsigned Rr[2], Cc[2];
#pragma unroll
    for (int i = 0; i < 2; ++i) { int R, C; stage_rc(tid * 16 + i * 8192, R, C); Rr[i] = (unsigned)R; Cc[i] = (unsigned)C * 2u; }
    const unsigned ldsw = (unsigned)wid * 1024u;
    const int aoff = lds_byte(wr * 64 + fr, fq * 8), boff = lds_byte(wc * 32 + fr, fq * 8);
#define PG_SA(b, h) (((b) * 2 + (h)) * HTB)
#define PG_SB(b, h) ((4 + (b) * 2 + (h)) * HTB)
#define PG_STAGE(bufoff, gbase, ld) do { _Pragma("unroll") for (int _i = 0; _i < 2; ++_i) \
        __builtin_amdgcn_global_load_lds((const unsigned*)((const char*)(gbase) + (size_t)(Rr[_i] * (ld) + Cc[_i])), (LAS unsigned*)(lds + (bufoff) + ldsw + _i * 8192), 16, 0, 0); } while (0)
#define PG_LDA(dst, b, h) do { _Pragma("unroll") for (int m = 0; m < 4; ++m) _Pragma("unroll") for (int k = 0; k < 2; ++k) dst[m][k] = *(const LAS bf16x8*)(lds + PG_SA(b, h) + aoff + m * 2048 + k * 1024); } while (0)
#define PG_LDB(dst, b, h) do { _Pragma("unroll") for (int n = 0; n < 2; ++n) _Pragma("unroll") for (int k = 0; k < 2; ++k) dst[n][k] = *(const LAS bf16x8*)(lds + PG_SB(b, h) + boff + n * 2048 + k * 1024); } while (0)
#define PG_MMA(ai, bj, At, Bt) do { __builtin_amdgcn_s_setprio(1); _Pragma("unroll") for (int m = 0; m < 4; ++m) _Pragma("unroll") for (int n = 0; n < 2; ++n) _Pragma("unroll") for (int k = 0; k < 2; ++k) \
        acc[ai][bj][m][n] = __builtin_amdgcn_mfma_f32_16x16x32_bf16(Bt[n][k], At[m][k], acc[ai][bj][m][n], 0, 0, 0); __builtin_amdgcn_s_setprio(0); } while (0)
#define PG_WAIT_V(n) asm volatile("s_waitcnt vmcnt(" #n ")" ::: "memory")
#define PG_WAIT_L(n) asm volatile("s_waitcnt lgkmcnt(" #n ")" ::: "memory")
#define PG_BAR __builtin_amdgcn_s_barrier()
#define PG_SCHED __builtin_amdgcn_sched_barrier(0)
    UnitG cur, nxt; int ui = 0;
    if (!S.next(0, cur)) return;
    Acc acc;
#pragma unroll
    for (int a = 0; a < 2; ++a)
#pragma unroll
        for (int b = 0; b < 2; ++b)
#pragma unroll
            for (int m = 0; m < 4; ++m)
#pragma unroll
                for (int n = 0; n < 2; ++n) acc[a][b][m][n] = (f32x4){0.f, 0.f, 0.f, 0.f};
    bf16x8 At[4][2], B0[2][2], B1[2][2];
    const char* cA = cur.A; const char* cB = cur.B; unsigned clda = cur.lda, cldb = cur.ldb;
    PG_STAGE(PG_SB(0, 0), cB, cldb); PG_STAGE(PG_SB(0, 1), cB + (size_t)HALF * cldb, cldb); PG_STAGE(PG_SA(0, 0), cA, clda); PG_STAGE(PG_SA(0, 1), cA + (size_t)HALF * clda, clda);
    if (wr == 1) PG_BAR;
    PG_WAIT_V(2); PG_BAR;
    PG_STAGE(PG_SB(1, 0), cB + 128, cldb); PG_STAGE(PG_SA(1, 0), cA + 128, clda); PG_STAGE(PG_SB(1, 1), cB + (size_t)HALF * cldb + 128, cldb);
    PG_WAIT_V(6); PG_BAR;
    for (;;) {
        const bool has_next = S.next(ui + 1, nxt);
        const char* nA = has_next ? nxt.A : cA; const char* nB = has_next ? nxt.B : cB;
        const unsigned nlda = has_next ? nxt.lda : clda, nldb = has_next ? nxt.ldb : cldb;
        const int nt = cur.nt;
        for (int t = 0; t < nt; t += 2) {
            const bool last = (t == nt - 2);
            const char* a1 = cA + (size_t)(t + 1) * 128;
            const char* a2 = last ? nA : cA + (size_t)(t + 2) * 128; const char* b2 = last ? nB : cB + (size_t)(t + 2) * 128;
            const unsigned lda2 = last ? nlda : clda, ldb2 = last ? nldb : cldb;
            const char* a3 = a2 + 128; const char* b3 = b2 + 128;
            PG_LDB(B0, 0, 0); PG_LDB(B1, 0, 1); PG_SCHED; PG_LDA(At, 0, 0); PG_STAGE(PG_SA(1, 1), a1 + (size_t)HALF * clda, clda);
            PG_WAIT_V(8); PG_WAIT_L(0); PG_BAR; PG_MMA(0, 0, At, B0); PG_MMA(0, 1, At, B1); PG_BAR; PG_SCHED;
            PG_LDA(At, 0, 1); PG_STAGE(PG_SB(0, 0), b2, ldb2); PG_STAGE(PG_SB(0, 1), b2 + (size_t)HALF * ldb2, ldb2); PG_STAGE(PG_SA(0, 0), a2, lda2);
            PG_WAIT_V(8); PG_WAIT_L(0); PG_BAR; PG_MMA(1, 0, At, B0); PG_MMA(1, 1, At, B1); PG_BAR; PG_SCHED;
            PG_LDB(B0, 1, 0); PG_LDB(B1, 1, 1); PG_SCHED; PG_LDA(At, 1, 0); PG_STAGE(PG_SA(0, 1), a2 + (size_t)HALF * lda2, lda2);
            PG_WAIT_V(8); PG_WAIT_L(0); PG_BAR; PG_MMA(0, 0, At, B0); PG_MMA(0, 1, At, B1); PG_BAR; PG_SCHED;
            PG_LDA(At, 1, 1); PG_STAGE(PG_SB(1, 0), b3, ldb2); PG_STAGE(PG_SB(1, 1), b3 + (size_t)HALF * ldb2, ldb2); PG_STAGE(PG_SA(1, 0), a3, lda2);
            PG_WAIT_V(8); PG_WAIT_L(0); PG_BAR; PG_MMA(1, 0, At, B0); PG_MMA(1, 1, At, B1); PG_BAR; PG_SCHED;
        }
        if (wr == 0) PG_BAR;
        E(acc, cur, lds, wr, wc, fr, fq);
        if (!has_next) break;
#pragma unroll
        for (int a = 0; a < 2; ++a)
#pragma unroll
            for (int b = 0; b < 2; ++b)
#pragma unroll
                for (int m = 0; m < 4; ++m)
#pragma unroll
                    for (int n = 0; n < 2; ++n) acc[a][b][m][n] = (f32x4){0.f, 0.f, 0.f, 0.f};
        cur = nxt; cA = nA; cB = nB; clda = nlda; cldb = nldb; ++ui;
        if (wr == 1) PG_BAR;
    }
    PG_WAIT_V(0);
    PG_BAR;
#undef PG_SA
#undef PG_SB
#undef PG_STAGE
#undef PG_LDA
#undef PG_LDB
#undef PG_MMA
#undef PG_WAIT_V
#undef PG_WAIT_L
#undef PG_BAR
#undef PG_SCHED
}
}

struct MArgs { const float* in[24]; float* out; unsigned char* ws; int ph_lo, ph_hi, li, pad; };
struct Frame {
    LAS unsigned char* lds; int tid, lane, wave; int x, j, vcu, G;
    const MArgs* a; float* out; unsigned char* ws;
};
#define FIN(k) (F.a->in[k])
__device__ __forceinline__ float fwave_sum(float v) {
#pragma unroll
    for (int o = 1; o < 64; o <<= 1) v += __shfl_xor(v, o);
    return v;
}

enum { W_IN = 0, W_QUP, W_KVUP, W_OBA, W_OBB, W_OUT, W_UP, W_DOWN };
__device__ __forceinline__ int win_src(int gd) {
    const int tile = gd >> 3, g = gd & 7, bj = g >> 2, wc = g & 3;
    if (tile < 3) return C_QLAT + gd * 32;
    if (tile < 5) return C_KVLAT + (gd - 24) * 32;
    if (tile == 5) return (wc == 0) ? C_KPE + bj * 32 : -1;
    if (tile < 10) { const int base = tile < 8 ? C_RQ : C_RK, tl = tile < 8 ? tile - 6 : tile - 8; const int head = 2 * tl + (wc >> 1); return base + head * 128 + bj * 64 + (wc & 1) * 32; }
    if (tile < 14) return C_RV + (gd - 80) * 32;
    if (tile < 18) return C_RG + (gd - 112) * 32;
    if (tile < 22) return C_GA + (gd - 144) * 32;
    return C_GB + (gd - 176) * 32;
}
__device__ __forceinline__ int w_src_col(int wid, int row) {
    const int rho = row & 31, gd = row >> 5, p = pg::perm32(rho);
    const int s = row & 255, bj = s >> 7, wc = (s >> 5) & 3, t = row >> 8;
    switch (wid) {
    case W_IN: { const int b = win_src(gd); return b < 0 ? -1 : b + p; }
    case W_QUP: if (bj == 0) return t * 192 + 32 * wc + p; else { if (wc >= 2) return -1; const int n = rho >> 4, i = rho & 15; return t * 192 + 128 + 16 * wc + i + 32 * n; }
    case W_KVUP: return t * 256 + 128 * bj + 32 * wc + p;
    case W_UP: return (bj ? D_FF : 0) + 128 * t + 32 * wc + p;
    default: return gd * 32 + p;
    }
}
__device__ __forceinline__ void p0_weight_item(const float* __restrict__ W, int ldw, int K, const float* __restrict__ gain, int wid, bf16_t* __restrict__ Wt, int gd, int kb, LAS float* scr, int lane) {
    const int k0 = kb * 64; const int sc = w_src_col(wid, gd * 32 + (lane & 31));
    bf16_t* dst = Wt + (size_t)(gd * 32) * K + k0;
#pragma unroll 8
    for (int i = 0; i < 32; ++i) { const int kk = 2 * i + (lane >> 5); const float g = gain ? gain[k0 + kk] : 1.f; scr[kk * 33 + (lane & 31)] = sc < 0 ? 0.f : W[(size_t)(k0 + kk) * ldw + sc] * g; }
    asm volatile("s_waitcnt lgkmcnt(0)" ::: "memory");
    const int c = lane & 7;
#pragma unroll
    for (int jj = 0; jj < 4; ++jj) { const int n = (lane >> 3) + 8 * jj; const LAS float* s = scr + (8 * c) * 33 + n;
        u32x4 o; o.x = cvt_pk_bf16(s[0 * 33], s[1 * 33]); o.y = cvt_pk_bf16(s[2 * 33], s[3 * 33]); o.z = cvt_pk_bf16(s[4 * 33], s[5 * 33]); o.w = cvt_pk_bf16(s[6 * 33], s[7 * 33]);
        *(u32x4*)(dst + (size_t)n * K + 8 * c) = o; }
    asm volatile("s_waitcnt lgkmcnt(0)" ::: "memory");
}
__device__ __forceinline__ void p0_weights(Frame& F, LAS float* scr, int gw, int NGW, const float* W, int ldw, int K, const float* gain, int wid, size_t off, int ngroups) {
    const int nkb = K / 64; bf16_t* Wt = (bf16_t*)(F.ws + off);
    for (int it = gw; it < ngroups * nkb; it += NGW) { const int gd = it / nkb, kb = it % nkb; p0_weight_item(W, ldw, K, gain, wid, Wt, gd, kb, scr, F.lane); }
}
__device__ __forceinline__ void p0_prologue(Frame& F) {
    LAS float* scr = (LAS float*)(F.lds + F.wave * 16384);
    const int gw = F.vcu * 8 + F.wave, NGW = F.G * 8;
    p0_weights(F, scr, gw, NGW, FIN(7), IN_W, 1024, FIN(6), W_IN, WS_FWIN, 26 * 8);
    p0_weights(F, scr, gw, NGW, FIN(9), 1536, 768, FIN(8), W_QUP, WS_FWQUP, 8 * 8);
    p0_weights(F, scr, gw, NGW, FIN(13), 2048, 512, nullptr, W_KVUP, WS_FWKVUP, 8 * 8);
    p0_weights(F, scr, gw, NGW, FIN(17), 1024, 1024, nullptr, W_OBA, WS_FWOBA, 4 * 8);
    p0_weights(F, scr, gw, NGW, FIN(17) + (size_t)1024 * 1024, 1024, 1024, nullptr, W_OBB, WS_FWOBB, 4 * 8);
    p0_weights(F, scr, gw, NGW, FIN(18), 1024, 1024, nullptr, W_OUT, WS_FWOUT, 4 * 8);
    p0_weights(F, scr, gw, NGW, FIN(20), FF2, 1024, FIN(19), W_UP, WS_FWUP, 22 * 8);
    p0_weights(F, scr, gw, NGW, FIN(23), 1024, D_FF, nullptr, W_DOWN, WS_FWDOWN, 4 * 8);
    {   bf16_t* XN = (bf16_t*)(F.ws + WS_XN);
        for (int r = gw; r < MPAD; r += NGW) {
            u32x2* o8 = (u32x2*)(XN + (size_t)r * D_MODEL) + F.lane;
            if (r >= MT) { for (int jj = 0; jj < 4; ++jj) o8[64 * jj] = (u32x2){0u, 0u}; continue; }
            const float* x = r < MP ? FIN(0) + (size_t)r * D_MODEL : FIN(1) + (size_t)(r - MP) * D_MODEL;
            const f32x4* xr = (const f32x4*)x + F.lane; f32x4 v[4]; float s = 0.f;
#pragma unroll
            for (int jj = 0; jj < 4; ++jj) { v[jj] = xr[64 * jj]; s += (v[jj][0] * v[jj][0] + v[jj][1] * v[jj][1]) + (v[jj][2] * v[jj][2] + v[jj][3] * v[jj][3]); }
            const float inv = rsqrtf(fwave_sum(s) * (1.f / D_MODEL) + EPS);
#pragma unroll
            for (int jj = 0; jj < 4; ++jj) { u32x2 w; w.x = cvt_pk_bf16(v[jj][0] * inv, v[jj][1] * inv); w.y = cvt_pk_bf16(v[jj][2] * inv, v[jj][3] * inv); o8[64 * jj] = w; }
        } }
    {   bf16_t* lats = (bf16_t*)(F.ws + WS_LATS); bf16_t* pes = (bf16_t*)(F.ws + WS_PES);
        const int gt = F.vcu * NTHR + F.tid, NG = F.G * NTHR;
        for (int i = gt; i < DEC_BATCH * PAST * (KV_LORA / 4); i += NG) { const int c4 = i % (KV_LORA / 4), rj = i / (KV_LORA / 4), jr = rj % PAST, b = rj / PAST;
            const f32x4 v = *((const f32x4*)FIN(2) + i); u32x2 w; w.x = cvt_pk_bf16(v[0], v[1]); w.y = cvt_pk_bf16(v[2], v[3]);
            *(u32x2*)(lats + ((size_t)b * SKEYS + jr) * KV_LORA + c4 * 4) = w; }
        for (int i = gt; i < DEC_BATCH * PAST * (QK_ROPE / 4); i += NG) { const int c4 = i % (QK_ROPE / 4), rj = i / (QK_ROPE / 4), jr = rj % PAST, b = rj / PAST;
            const f32x4 v = *((const f32x4*)FIN(3) + i); u32x2 w; w.x = cvt_pk_bf16(v[0], v[1]); w.y = cvt_pk_bf16(v[2], v[3]);
            *(u32x2*)(pes + ((size_t)b * SKEYS + jr) * QK_ROPE + c4 * 4) = w; }
        float2* tab32 = (float2*)(F.ws + WS_TAB32); float2* tab64 = (float2*)(F.ws + WS_TAB64);
        for (int i = gt; i < 8192 * 64; i += NG) {
            { const int pos = i / 64, k = i % 64; const double f = pow(10000.0, -(double)k / 64.0), a = (double)pos * f; tab64[i] = make_float2((float)cos(a), (float)sin(a)); }
            if (i < 8192 * 32) { const int pos = i / 32, k = i % 32; const double f = pow(10000.0, -(double)k / 32.0), a = (double)pos * f; tab32[i] = make_float2((float)cos(a), (float)sin(a)); }
        } }
}

__device__ __forceinline__ bool reg_unit(int x, int j, int i, int nN, int& pm, int& pn) { const int u = j + 32 * i; if (u >= 8 * nN) return false; pm = 8 * x + (u & 7); pn = u >> 3; return true; }
#define LDS_F(off) ((LAS float*)(lds + EPI_OFF) + (off))

enum { K_QLAT = 0, K_KVLAT, K_KPE, K_RQ, K_RK, K_RV, K_RG, K_QUP, K_KVP, K_KVS, K_GA, K_AD, K_GB, K_RD, K_OUT, K_UP, K_DOWN };
struct SchedP1 {
    int x, j; const char* ws;
    __device__ __forceinline__ bool next(int i, pg::UnitG& u) const {
        int pm, pn;
        if (!reg_unit(x, j, i, 18, pm, pn)) { if (i == 4 && j >= 16) { const int k = (j - 16) * 8 + x; if (k >= 18) return false; pm = 64; pn = k; } else return false; }
        u.pm = pm; u.pn = pn; u.A = ws + WS_XN + (size_t)pm * 256 * 2048; u.B = ws + WS_FWIN + (size_t)pn * 256 * 2048; u.lda = 2048; u.ldb = 2048; u.nt = 16;
        u.kind = pn < 3 ? K_QLAT : pn < 5 ? K_KVLAT : pn == 5 ? K_KPE : pn < 8 ? K_RQ : pn < 10 ? K_RK : pn < 14 ? K_RV : K_RG;
        return true;
    }
};
struct EpiP1 {
    unsigned char* ws; float* out; const float *g_kvlat, *g_kr;
    __device__ __forceinline__ void operator()(const pg::Acc& acc, const pg::UnitG& u, LAS unsigned char* lds, int wr, int wc, int fr, int fq) const {
        bf16_t* const ZQ = (bf16_t*)(ws + WS_ZQ); bf16_t* const KVL = (bf16_t*)(ws + WS_KVL); bf16_t* const KPE = (bf16_t*)(ws + WS_KPE); bf16_t* const PES = (bf16_t*)(ws + WS_PES); bf16_t* const LATS = (bf16_t*)(ws + WS_LATS);
        bf16_t* const RQ = (bf16_t*)(ws + WS_RQ); bf16_t* const RK = (bf16_t*)(ws + WS_RK); bf16_t* const RV = (bf16_t*)(ws + WS_RV); bf16_t* const RG = (bf16_t*)(ws + WS_RG);
        float* const slotq = (float*)(ws + WS_SLOTQ); float* const slotkv = (float*)(ws + WS_SLOTKV);
        const float2* const tab32 = (const float2*)(ws + WS_TAB32); const float2* const tab64 = (const float2*)(ws + WS_TAB64);
        int rl0 = wr * 64 + fr, cw = wc * 32 + fq * 8; asm volatile("" : "+v"(rl0), "+v"(cw));
        const int kind = u.kind, rb = u.pm * 256 + rl0;
        if (kind == K_QLAT || kind == K_KVLAT) {
            const int t = kind == K_QLAT ? u.pn : u.pn - 3; const int ld = kind == K_QLAT ? Q_LORA : KV_LORA; bf16_t* dst = kind == K_QLAT ? ZQ : KVL;
            f32x4 g[2][2];
#pragma unroll
            for (int bj = 0; bj < 2; ++bj)
#pragma unroll
                for (int n = 0; n < 2; ++n) g[bj][n] = kind == K_KVLAT ? *(const f32x4*)(g_kvlat + t * 256 + bj * 128 + cw + 4 * n) : (f32x4){1.f, 1.f, 1.f, 1.f};
#pragma unroll
            for (int ai = 0; ai < 2; ++ai)
#pragma unroll
                for (int m = 0; m < 4; ++m) { const int row = rb + ai * 128 + m * 16; float ss = 0.f;
                    const bool snew = (kind == K_KVLAT) && row >= MP && row < MT;
                    const int rs = row - MP; bf16_t* lrow = LATS + ((size_t)(rs / DEC_SEQ) * SKEYS + PAST + (rs % DEC_SEQ)) * KV_LORA;
#pragma unroll
                    for (int bj = 0; bj < 2; ++bj) { const f32x4 v0 = acc[ai][bj][m][0], v1 = acc[ai][bj][m][1];
                        ss += (v0[0] * v0[0] + v0[1] * v0[1]) + (v0[2] * v0[2] + v0[3] * v0[3]) + (v1[0] * v1[0] + v1[1] * v1[1]) + (v1[2] * v1[2] + v1[3] * v1[3]);
                        const u32x4 w = pack8f(v0 * g[bj][0], v1 * g[bj][1]);
                        *(u32x4*)(dst + (size_t)row * ld + t * 256 + bj * 128 + cw) = w;
                        if (snew) *(u32x4*)(lrow + t * 256 + bj * 128 + cw) = w; }
                    ss += __shfl_xor(ss, 16); ss += __shfl_xor(ss, 32);
                    if (fq == 0) { if (kind == K_QLAT) slotq[(size_t)row * 12 + t * 4 + wc] = ss; else slotkv[(size_t)row * 8 + t * 4 + wc] = ss; } }
        } else if (kind == K_KPE) {
            if (wc != 0) return;
            const int d0 = fq * 8;
            f32x4 g1[2], g2[2];
#pragma unroll
            for (int n = 0; n < 2; ++n) { g1[n] = *(const f32x4*)(g_kr + d0 + 4 * n); g2[n] = *(const f32x4*)(g_kr + 32 + d0 + 4 * n); }
#pragma unroll
            for (int ai = 0; ai < 2; ++ai)
#pragma unroll
                for (int m = 0; m < 4; ++m) { const int row = rb + ai * 128 + m * 16; const int pos = row_pos(row < MT ? row : 0);
                    f32x4 x1[2], x2[2]; float ss = 0.f;
#pragma unroll
                    for (int n = 0; n < 2; ++n) { x1[n] = acc[ai][0][m][n]; x2[n] = acc[ai][1][m][n];
                        ss += (x1[n][0] * x1[n][0] + x1[n][1] * x1[n][1]) + (x1[n][2] * x1[n][2] + x1[n][3] * x1[n][3]) + (x2[n][0] * x2[n][0] + x2[n][1] * x2[n][1]) + (x2[n][2] * x2[n][2] + x2[n][3] * x2[n][3]); }
                    ss += __shfl_xor(ss, 16); ss += __shfl_xor(ss, 32);
                    const float inv = rsqrtf(ss * (1.f / 64.f) + EPS);
                    f32x4 o1[2], o2[2];
#pragma unroll
                    for (int n = 0; n < 2; ++n) { const f32x4 y1 = x1[n] * inv * g1[n], y2 = x2[n] * inv * g2[n];
                        const f32x4 cs0 = *(const f32x4*)(tab32 + pos * 32 + d0 + 4 * n), cs1 = *(const f32x4*)(tab32 + pos * 32 + d0 + 4 * n + 2);
                        const f32x4 c = {cs0[0], cs0[2], cs1[0], cs1[2]}, s = {cs0[1], cs0[3], cs1[1], cs1[3]};
                        o1[n] = y1 * c - y2 * s; o2[n] = y1 * s + y2 * c; }
                    *(u32x4*)(KPE + (size_t)row * 64 + d0) = pack8f(o1[0], o1[1]); *(u32x4*)(KPE + (size_t)row * 64 + 32 + d0) = pack8f(o2[0], o2[1]);
                    if (row < MT) {
                        float* o = row < MP ? out + O_RKP + (size_t)row * 64 : out + O_RKS + (size_t)(row - MP) * 64;
                        *(f32x4*)(o + d0) = o1[0]; *(f32x4*)(o + d0 + 4) = o1[1]; *(f32x4*)(o + 32 + d0) = o2[0]; *(f32x4*)(o + 32 + d0 + 4) = o2[1];
                        if (row >= MP) { const int rs = row - MP, b = rs / DEC_SEQ, tt = rs % DEC_SEQ; bf16_t* p = PES + ((size_t)b * SKEYS + PAST + tt) * 64;
                            *(u32x4*)(p + d0) = pack8f(o1[0], o1[1]); *(u32x4*)(p + 32 + d0) = pack8f(o2[0], o2[1]); } } }
        } else if (kind == K_RQ || kind == K_RK) {
            const int tl = kind == K_RQ ? u.pn - 6 : u.pn - 8; const int head = 2 * tl + (wc >> 1), i0 = 32 * (wc & 1) + fq * 8;
            bf16_t* dst = kind == K_RQ ? RQ : RK; const float sc = kind == K_RQ ? 1.0f : 0.08838834764831845f;
#pragma unroll
            for (int ai = 0; ai < 2; ++ai)
#pragma unroll
                for (int m = 0; m < 4; ++m) { const int row = rb + ai * 128 + m * 16; const int pos = row_pos(row < MT ? row : 0);
                    f32x4 o1[2], o2[2];
#pragma unroll
                    for (int n = 0; n < 2; ++n) { const f32x4 x1 = acc[ai][0][m][n], x2 = acc[ai][1][m][n];
                        const f32x4 cs0 = *(const f32x4*)(tab64 + pos * 64 + i0 + 4 * n), cs1 = *(const f32x4*)(tab64 + pos * 64 + i0 + 4 * n + 2);
                        const f32x4 c = {cs0[0], cs0[2], cs1[0], cs1[2]}, s = {cs0[1], cs0[3], cs1[1], cs1[3]};
                        o1[n] = (x1 * c - x2 * s) * sc; o2[n] = (x1 * s + x2 * c) * sc; }
                    *(u32x4*)(dst + (size_t)row * 512 + head * 128 + i0) = pack8f(o1[0], o1[1]); *(u32x4*)(dst + (size_t)row * 512 + head * 128 + 64 + i0) = pack8f(o2[0], o2[1]); }
        } else {
            const int t = kind == K_RV ? u.pn - 10 : u.pn - 14; bf16_t* dst = kind == K_RV ? RV : RG;
#pragma unroll
            for (int ai = 0; ai < 2; ++ai)
#pragma unroll
                for (int m = 0; m < 4; ++m) { const int row = rb + ai * 128 + m * 16;
#pragma unroll
                    for (int bj = 0; bj < 2; ++bj) { f32x4 v0 = acc[ai][bj][m][0], v1 = acc[ai][bj][m][1];
                        if (kind == K_RG) {
#pragma unroll
                            for (int e = 0; e < 4; ++e) { v0[e] = v0[e] / (1.f + __expf(-v0[e])); v1[e] = v1[e] / (1.f + __expf(-v1[e])); } }
                        *(u32x4*)(dst + (size_t)row * 1024 + t * 256 + bj * 128 + cw) = pack8f(v0, v1); } }
        }
    }
};
__device__ __forceinline__ void p1_inproj(Frame& F) {
    SchedP1 S{F.x, F.j, (const char*)F.ws};
    EpiP1 E{F.ws, F.out, FIN(12), FIN(15)};
    pg::gemm_stream(F.lds, S, E);
}

__device__ __forceinline__ float slot_rs(const float* slots, int n, float invn) {
    float a = 0.f; for (int i = 0; i < n; i += 4) { const f32x4 v = *(const f32x4*)(slots + i); a += (v[0] + v[1]) + (v[2] + v[3]); } return rsqrtf(a * invn + EPS);
}
struct SchedP2 {
    int x, j; const char* ws; int sample;
    __device__ __forceinline__ bool next(int i, pg::UnitG& u) const {
        int pm, pn, kind;
        if (sample) {
            if (i < 2) { reg_unit(x, j, i, 8, pm, pn); kind = K_QUP; }
            else if (i < 4) { reg_unit(x, j, i - 2, 8, pm, pn); kind = K_KVS; }
            else if (i == 4 && j < 2) { const int k = j * 8 + x; pm = 64; pn = k & 7; kind = k < 8 ? K_QUP : K_KVS; }
            else return false;
        } else { if (i >= 2) return false; reg_unit(x, j, i, 8, pm, pn); kind = K_KVP; }
        u.pm = pm; u.pn = pn; u.kind = kind;
        if (kind == K_QUP) { u.A = ws + WS_ZQ + (size_t)pm * 256 * 1536; u.lda = 1536; u.B = ws + WS_FWQUP + (size_t)pn * 256 * 1536; u.ldb = 1536; u.nt = 12; }
        else { u.A = ws + (kind == K_KVS ? WS_LATS : WS_KVL) + (size_t)pm * 256 * 1024; u.lda = 1024; u.B = ws + WS_FWKVUP + (size_t)pn * 256 * 1024; u.ldb = 1024; u.nt = 8; }
        return true;
    }
};
struct EpiP2 {
    unsigned char* ws; float* out; const float *g_qn, *g_qr, *g_kn;
    __device__ __forceinline__ void operator()(const pg::Acc& acc, const pg::UnitG& u, LAS unsigned char* lds, int wr, int wc, int fr, int fq) const {
        int rl0 = wr * 64 + fr, cw = wc * 32 + fq * 8; asm volatile("" : "+v"(rl0), "+v"(cw));
        const int kind = u.kind, h = u.pn, rb = u.pm * 256 + rl0;
        const float* const slotq = (const float*)(ws + WS_SLOTQ); const float* const slotkv = (const float*)(ws + WS_SLOTKV);
        float rs[2][4];
#pragma unroll
        for (int ai = 0; ai < 2; ++ai)
#pragma unroll
            for (int m = 0; m < 4; ++m) { const int row = rb + ai * 128 + m * 16;
                if (kind == K_QUP) rs[ai][m] = slot_rs(slotq + (size_t)row * 12, 12, 1.f / Q_LORA);
                else if (kind == K_KVP) rs[ai][m] = slot_rs(slotkv + (size_t)row * 8, 8, 1.f / KV_LORA);
                else { const int b = row / SKEYS, jj = row - b * SKEYS; rs[ai][m] = (row < LROWS && jj >= PAST) ? slot_rs(slotkv + (size_t)(MP + b * DEC_SEQ + jj - PAST) * 8, 8, 1.f / KV_LORA) : 1.f; } }
#pragma unroll
        for (int ai = 0; ai < 2; ++ai)
#pragma unroll
            for (int m = 0; m < 4; ++m) { float p0 = 0.f, p1 = 0.f; const float s2 = rs[ai][m] * rs[ai][m];
#pragma unroll
                for (int n = 0; n < 2; ++n) { const f32x4 a = acc[ai][0][m][n], b = acc[ai][1][m][n];
                    p0 += (a[0] * a[0] + a[1] * a[1]) + (a[2] * a[2] + a[3] * a[3]); p1 += (b[0] * b[0] + b[1] * b[1]) + (b[2] * b[2] + b[3] * b[3]); }
                p0 += __shfl_xor(p0, 16); p0 += __shfl_xor(p0, 32); p1 += __shfl_xor(p1, 16); p1 += __shfl_xor(p1, 32);
                if (fq == 0) { LAS float* d = LDS_F((rl0 + ai * 128 + m * 16) * 8 + wc * 2); d[0] = p0 * s2; d[1] = p1 * s2; } }
        asm volatile("s_waitcnt lgkmcnt(0)" ::: "memory"); __builtin_amdgcn_s_barrier(); asm volatile("" ::: "memory");
        if (kind == K_QUP) {
            bf16_t* const Q = (bf16_t*)out;
            const float2* const tab32 = (const float2*)(ws + WS_TAB32);
            const float C2 = 0.07216878364870323f * 1.4426950408889634f;
            f32x4 gn[2]; gn[0] = *(const f32x4*)(g_qn + cw); gn[1] = *(const f32x4*)(g_qn + cw + 4);
            const int ir = 16 * (wc & 1) + 4 * fq; const f32x4 gr1 = *(const f32x4*)(g_qr + ir), gr2 = *(const f32x4*)(g_qr + 32 + ir);
#pragma unroll
            for (int ai = 0; ai < 2; ++ai)
#pragma unroll
                for (int m = 0; m < 4; ++m) { const int row = rb + ai * 128 + m * 16; const int pos = row_pos(row < MT ? row : 0);
                    const LAS float* d = LDS_F((rl0 + ai * 128 + m * 16) * 8); const f32x4 e0 = *(const LAS f32x4*)d, e1 = *(const LAS f32x4*)(d + 4);
                    const float inn = rsqrtf((e0[0] + e0[2] + e1[0] + e1[2]) * (1.f / 128.f) + EPS) * rs[ai][m] * C2, inr = rsqrtf((e0[1] + e0[3]) * (1.f / 64.f) + EPS) * rs[ai][m];
                    bf16_t* qrow = Q + (size_t)row * 1536 + h * 192;
                    *(u32x4*)(qrow + cw) = pack8f(acc[ai][0][m][0] * inn * gn[0], acc[ai][0][m][1] * inn * gn[1]);
                    if (wc < 2) { const f32x4 y1 = acc[ai][1][m][0] * inr * gr1, y2 = acc[ai][1][m][1] * inr * gr2;
                        const f32x4 cs0 = *(const f32x4*)(tab32 + pos * 32 + ir), cs1 = *(const f32x4*)(tab32 + pos * 32 + ir + 2);
                        const f32x4 c = {cs0[0], cs0[2], cs1[0], cs1[2]}, s = {cs0[1], cs0[3], cs1[1], cs1[3]};
                        const f32x4 o1 = (y1 * c - y2 * s) * C2, o2 = (y1 * s + y2 * c) * C2;
                        u32x2 w1, w2; w1.x = cvt_pk_bf16(o1[0], o1[1]); w1.y = cvt_pk_bf16(o1[2], o1[3]); w2.x = cvt_pk_bf16(o2[0], o2[1]); w2.y = cvt_pk_bf16(o2[2], o2[3]);
                        *(u32x2*)(qrow + 128 + ir) = w1; *(u32x2*)(qrow + 160 + ir) = w2; } }
        } else {
            bf16_t* const KN = (bf16_t*)(ws + WS_KN); bf16_t* const V = (bf16_t*)(ws + WS_V);
            f32x4 gk[2]; gk[0] = *(const f32x4*)(g_kn + cw); gk[1] = *(const f32x4*)(g_kn + cw + 4);
#pragma unroll
            for (int ai = 0; ai < 2; ++ai)
#pragma unroll
                for (int m = 0; m < 4; ++m) { const int row = rb + ai * 128 + m * 16;
                    const LAS float* d = LDS_F((rl0 + ai * 128 + m * 16) * 8); const f32x4 e0 = *(const LAS f32x4*)d, e1 = *(const LAS f32x4*)(d + 4);
                    const float s = rs[ai][m], inn = rsqrtf((e0[0] + e0[2] + e1[0] + e1[2]) * (1.f / 128.f) + EPS) * s;
                    *(u32x4*)(KN + (size_t)row * 1024 + h * 128 + cw) = pack8f(acc[ai][0][m][0] * inn * gk[0], acc[ai][0][m][1] * inn * gk[1]);
                    *(u32x4*)(V + (size_t)row * 1024 + h * 128 + cw) = pack8f(acc[ai][1][m][0] * s, acc[ai][1][m][1] * s); }
        }
    }
};
__device__ __forceinline__ void p2_qkv(Frame& F, int sample) {
    SchedP2 S{F.x, F.j, (const char*)F.ws, sample};
    EpiP2 E{F.ws, F.out, FIN(10), FIN(11), FIN(14)};
    pg::gemm_stream(F.lds, S, E);
}

struct SchedP5 {
    int x, j, vcu; const char* ws; int phase;
    __device__ __forceinline__ const char* arow(size_t base, size_t base_s, int pm, size_t rowbytes) const { return ws + (pm < 64 ? base + (size_t)pm * 256 * rowbytes : base_s); }
    __device__ __forceinline__ bool next(int i, pg::UnitG& u) const {
        int pm, pn;
        if (phase == 5) {
            const int sub = i & 3, tile = i >> 2;
            if (tile == 0) { pm = 8 * x + (j & 7); pn = j >> 3; } else if (tile == 1 && j == 0 && x < 4) { pm = 64; pn = x; } else return false;
            u.pm = pm; u.pn = pn; u.kind = K_GA + sub; u.lda = 2048; u.ldb = 2048; u.nt = 16;
            if (sub == 0) { u.A = ws + WS_XN2 + (size_t)pm * 256 * 2048; u.B = ws + WS_FWIN + (size_t)(18 + pn) * 256 * 2048; }
            else if (sub == 1) { u.A = arow(WS_ATT, WS_ATTS, pm, 2048); u.B = ws + WS_FWOBA + (size_t)pn * 256 * 2048; }
            else if (sub == 2) { u.A = ws + WS_XN2 + (size_t)pm * 256 * 2048; u.B = ws + WS_FWIN + (size_t)(22 + pn) * 256 * 2048; }
            else { u.A = ws + WS_RET + (size_t)pm * 256 * 2048; u.B = ws + WS_FWOBB + (size_t)pn * 256 * 2048; }
            return true;
        }
        if (phase == 6 || phase == 9) {
            if (i == 0) { pm = 8 * x + (j & 7); pn = j >> 3; } else if (i == 1 && j == 0 && x < 4) { pm = 64; pn = x; } else return false;
            u.pm = pm; u.pn = pn;
            if (phase == 6) { u.kind = K_OUT; u.A = ws + WS_MERGED + (size_t)pm * 256 * 2048; u.lda = 2048; u.B = ws + WS_FWOUT + (size_t)pn * 256 * 2048; u.ldb = 2048; u.nt = 16; }
            else { u.kind = K_DOWN; u.A = ws + WS_U + (size_t)pm * 256 * (FF2 * 2); u.lda = FF2 * 2; u.B = ws + WS_FWDOWN + (size_t)pn * 256 * (D_FF * 2); u.ldb = D_FF * 2; u.nt = 44; }
            return true;
        }
        if (!reg_unit(x, j, i, 22, pm, pn)) { if (i == 5 && j >= 16) { const int k = (j - 16) * 8 + x; if (k >= 22) return false; pm = 64; pn = k; } else return false; }
        u.pm = pm; u.pn = pn; u.kind = K_UP; u.A = ws + WS_X1B + (size_t)pm * 256 * 2048; u.lda = 2048; u.B = ws + WS_FWUP + (size_t)pn * 256 * 2048; u.ldb = 2048; u.nt = 16;
        return true;
    }
};
struct EpiP5 {
    unsigned char* ws; float* out; const float* xp; const float* xs; int vcu;
    __device__ __forceinline__ void operator()(pg::Acc& acc, const pg::UnitG& u, LAS unsigned char* lds, int wr, int wc, int fr, int fq) const {
        int rl0 = wr * 64 + fr, cw = wc * 32 + fq * 8; asm volatile("" : "+v"(rl0), "+v"(cw));
        const int kind = u.kind, rb = u.pm * 256 + rl0;
        if (kind >= K_GA && kind <= K_RD) {
            bf16_t* const T1 = (bf16_t*)(ws + WS_T1) + (size_t)vcu * 65536; bf16_t* const T2 = (bf16_t*)out + (size_t)vcu * 65536;
            bf16_t* const MG = (bf16_t*)(ws + WS_MERGED);
#pragma unroll
            for (int ai = 0; ai < 2; ++ai)
#pragma unroll
                for (int m = 0; m < 4; ++m)
#pragma unroll
                    for (int bj = 0; bj < 2; ++bj) { const size_t so = (size_t)(rl0 + ai * 128 + m * 16) * 256 + bj * 128 + cw;
                        f32x4 v0 = acc[ai][bj][m][0], v1 = acc[ai][bj][m][1];
                        if (kind == K_GA || kind == K_GB) {
#pragma unroll
                            for (int e = 0; e < 4; ++e) { v0[e] = 1.f / (1.f + __expf(-v0[e])); v1[e] = 1.f / (1.f + __expf(-v1[e])); }
                            *(u32x4*)((kind == K_GA ? T1 : T2) + so) = pack8f(v0, v1);
                        } else if (kind == K_AD) {
                            const u32x4 t = *(const u32x4*)(T1 + so);
                            const f32x4 g0 = {__uint_as_float(t.x << 16), __uint_as_float(t.x & 0xffff0000u), __uint_as_float(t.y << 16), __uint_as_float(t.y & 0xffff0000u)};
                            const f32x4 g1 = {__uint_as_float(t.z << 16), __uint_as_float(t.z & 0xffff0000u), __uint_as_float(t.w << 16), __uint_as_float(t.w & 0xffff0000u)};
                            *(u32x4*)(T1 + so) = pack8f(v0 * g0, v1 * g1);
                        } else {
                            const u32x4 t = *(const u32x4*)(T1 + so), q = *(const u32x4*)(T2 + so);
                            const f32x4 a0 = {__uint_as_float(t.x << 16), __uint_as_float(t.x & 0xffff0000u), __uint_as_float(t.y << 16), __uint_as_float(t.y & 0xffff0000u)};
                            const f32x4 a1 = {__uint_as_float(t.z << 16), __uint_as_float(t.z & 0xffff0000u), __uint_as_float(t.w << 16), __uint_as_float(t.w & 0xffff0000u)};
                            const f32x4 g0 = {__uint_as_float(q.x << 16), __uint_as_float(q.x & 0xffff0000u), __uint_as_float(q.y << 16), __uint_as_float(q.y & 0xffff0000u)};
                            const f32x4 g1 = {__uint_as_float(q.z << 16), __uint_as_float(q.z & 0xffff0000u), __uint_as_float(q.w << 16), __uint_as_float(q.w & 0xffff0000u)};
                            *(u32x4*)(MG + (size_t)(rb + ai * 128 + m * 16) * 1024 + u.pn * 256 + bj * 128 + cw) = pack8f(a0 + v0 * g0, a1 + v1 * g1);
                        }
                        if (bj == 1 && (m & 1)) asm volatile("" ::: "memory"); }
            if (kind != K_RD) asm volatile("s_waitcnt vmcnt(0)" ::: "memory");
        } else if (kind == K_OUT) {
            float* const slotx = (float*)(ws + WS_SLOTX1); bf16_t* const X1B = (bf16_t*)(ws + WS_X1B);
#pragma unroll
            for (int ai = 0; ai < 2; ++ai)
#pragma unroll
                for (int m = 0; m < 4; ++m) { const int row = rb + ai * 128 + m * 16; float ss = 0.f;
                    const float* xr = row < MP ? xp + (size_t)row * D_MODEL : xs + (size_t)((row < MT ? row : MP) - MP) * D_MODEL;
#pragma unroll
                    for (int bj = 0; bj < 2; ++bj) { const int c = u.pn * 256 + bj * 128 + cw;
                        const f32x4 x0 = *(const f32x4*)(xr + c), x1 = *(const f32x4*)(xr + c + 4);
                        const f32x4 v0 = acc[ai][bj][m][0] + x0, v1 = acc[ai][bj][m][1] + x1;
                        ss += (v0[0] * v0[0] + v0[1] * v0[1]) + (v0[2] * v0[2] + v0[3] * v0[3]) + (v1[0] * v1[0] + v1[1] * v1[1]) + (v1[2] * v1[2] + v1[3] * v1[3]);
                        if (row < MT) { *(f32x4*)(out + (size_t)row * D_MODEL + c) = v0; *(f32x4*)(out + (size_t)row * D_MODEL + c + 4) = v1; }
                        *(u32x4*)(X1B + (size_t)row * D_MODEL + c) = pack8f(v0, v1); }
                    ss += __shfl_xor(ss, 16); ss += __shfl_xor(ss, 32);
                    if (fq == 0) slotx[(size_t)row * 16 + u.pn * 4 + wc] = ss;
                    asm volatile("" ::: "memory"); }
        } else if (kind == K_UP) {
            const float* const slotx = (const float*)(ws + WS_SLOTX1); bf16_t* const U = (bf16_t*)(ws + WS_U);
#pragma unroll
            for (int ai = 0; ai < 2; ++ai)
#pragma unroll
                for (int m = 0; m < 4; ++m) { const int row = rb + ai * 128 + m * 16;
                    float a = 0.f;
#pragma unroll
                    for (int i = 0; i < 16; i += 4) { const f32x4 v = *(const f32x4*)(slotx + (size_t)row * 16 + i); a += (v[0] + v[1]) + (v[2] + v[3]); }
                    const float s = rsqrtf(a * (1.f / D_MODEL) + EPS);
                    *(u32x4*)(U + (size_t)row * FF2 + u.pn * 128 + cw) = pack8f(acc[ai][0][m][0] * s, acc[ai][0][m][1] * s);
                    *(u32x4*)(U + (size_t)row * FF2 + D_FF + u.pn * 128 + cw) = pack8f(acc[ai][1][m][0] * s, acc[ai][1][m][1] * s);
                    if (m & 1) asm volatile("" ::: "memory"); }
        } else {
#pragma unroll
            for (int ai = 0; ai < 2; ++ai)
#pragma unroll
                for (int m = 0; m < 4; ++m) { const int row = rb + ai * 128 + m * 16; if (row >= MT) continue;
#pragma unroll
                    for (int bj = 0; bj < 2; ++bj) { float* p = out + (size_t)row * D_MODEL + u.pn * 256 + bj * 128 + cw;
                        const f32x4 x0 = *(const f32x4*)p, x1 = *(const f32x4*)(p + 4);
                        *(f32x4*)p = x0 + acc[ai][bj][m][0]; *(f32x4*)(p + 4) = x1 + acc[ai][bj][m][1]; }
                    asm volatile("" ::: "memory"); }
        }
    }
};
__device__ __forceinline__ void p5_gemm(Frame& F, int phase) {
    SchedP5 S{F.x, F.j, F.vcu, (const char*)F.ws, phase};
    EpiP5 E{F.ws, F.out, FIN(0), FIN(1), F.vcu};
    pg::gemm_stream(F.lds, S, E);
}

namespace rt {
typedef short s16x4 __attribute__((ext_vector_type(4)));
constexpr int QST = 136, KDST = 144, VST = 272, PST = 72;
constexpr int Q_OFF = 0, QS_OFF = 17408, K_OFF = 34816, KD_OFF = 52224, V_OFF = 70656, P_OFF = 105472, ST_OFF = 114688;
constexpr int SC_TOK = 256, NSC = SEQ / SC_TOK;
__device__ __forceinline__ s16x4 trrd(const LAS bf16_t* p) { return __builtin_bit_cast(s16x4, __builtin_amdgcn_ds_read_tr16_b64_v4i16((LAS s16x4*)p)); }
__device__ __forceinline__ bf16x8 cat8(s16x4 lo, s16x4 hi) { return (bf16x8){lo[0], lo[1], lo[2], lo[3], hi[0], hi[1], hi[2], hi[3]}; }
__device__ __forceinline__ u32x4 scale8(u32x4 w, float s) {
    u32x4 o;
    o.x = cvt_pk_bf16(__uint_as_float(w.x << 16) * s, __uint_as_float(w.x & 0xffff0000u) * s); o.y = cvt_pk_bf16(__uint_as_float(w.y << 16) * s, __uint_as_float(w.y & 0xffff0000u) * s);
    o.z = cvt_pk_bf16(__uint_as_float(w.z << 16) * s, __uint_as_float(w.z & 0xffff0000u) * s); o.w = cvt_pk_bf16(__uint_as_float(w.w << 16) * s, __uint_as_float(w.w & 0xffff0000u) * s);
    return o;
}
template <bool FULL>
__device__ __forceinline__ void ret_unit(Frame& F, int h, int row0, int nch, int L, const float* Sin, float* Sout, const float* g_ret) {
    LAS unsigned char* lds = F.lds;
    const int tid = F.tid, w = F.wave, l = F.lane, fr = l & 15, g = l >> 4, tq = fr >> 2, tp = fr & 3;
    const float lg2 = log2f(1.f - exp2f(-5.f - (float)h));
    const bf16_t* RQ = (const bf16_t*)(F.ws + WS_RQ); const bf16_t* RK = (const bf16_t*)(F.ws + WS_RK); const bf16_t* RV = (const bf16_t*)(F.ws + WS_RV);
    const bf16_t* RG = (const bf16_t*)(F.ws + WS_RG); bf16_t* RET = (bf16_t*)(F.ws + WS_RET);
    LAS bf16_t* q_l = (LAS bf16_t*)(lds + Q_OFF); LAS bf16_t* qs_l = (LAS bf16_t*)(lds + QS_OFF); LAS bf16_t* k_l = (LAS bf16_t*)(lds + K_OFF);
    LAS bf16_t* kd_l = (LAS bf16_t*)(lds + KD_OFF); LAS bf16_t* v_l = (LAS bf16_t*)(lds + V_OFF); LAS bf16_t* p_l = (LAS bf16_t*)(lds + P_OFF); LAS float* st_l = (LAS float*)(lds + ST_OFF);
    f32x4 S[8][2];
#pragma unroll
    for (int db = 0; db < 8; ++db)
#pragma unroll
        for (int nb = 0; nb < 2; ++nb) {
            if (Sin) {
#pragma unroll
                for (int r = 0; r < 4; ++r) S[db][nb][r] = Sin[(size_t)(16 * db + 4 * g + r) * RET_DV + 32 * w + 16 * nb + fr]; }
            else S[db][nb] = (f32x4){0.f, 0.f, 0.f, 0.f}; }
    const float gL = exp2f(lg2 * (float)L);
    for (int c = 0; c < nch; ++c) {
        const size_t r0 = (size_t)row0 + (size_t)c * L;
        __syncthreads();
#pragma unroll
        for (int it = 0; it < 2; ++it) { const int idx = tid + 512 * it, tok = idx >> 4, c8 = idx & 15; const bool ok = tok < L;
            u32x4 kk = {0u, 0u, 0u, 0u}, qq = {0u, 0u, 0u, 0u};
            if (ok) { kk = *(const u32x4*)(RK + (r0 + tok) * 512 + h * 128 + c8 * 8); if (FULL) qq = *(const u32x4*)(RQ + (r0 + tok) * 512 + h * 128 + c8 * 8); }
            *(LAS u32x4*)(kd_l + tok * KDST + c8 * 8) = scale8(kk, exp2f(lg2 * (float)(L - 1 - tok)));
            if (FULL) { *(LAS u32x4*)(k_l + tok * QST + c8 * 8) = kk; *(LAS u32x4*)(q_l + tok * QST + c8 * 8) = qq; *(LAS u32x4*)(qs_l + tok * QST + c8 * 8) = scale8(qq, exp2f(lg2 * (float)(tok + 1))); } }
#pragma unroll
        for (int it = 0; it < 4; ++it) { const int idx = tid + 512 * it, tok = idx >> 5, c8 = idx & 31; u32x4 vv = {0u, 0u, 0u, 0u};
            if (tok < L) vv = *(const u32x4*)(RV + (r0 + tok) * 1024 + h * 256 + c8 * 8);
            *(LAS u32x4*)(v_l + tok * VST + c8 * 8) = vv; }
        __syncthreads();
        f32x4 o[4][2];
        if (FULL) {
            const int ib = w >> 1, jb0 = 2 * (w & 1);
            f32x4 p0 = {0.f, 0.f, 0.f, 0.f}, p1 = {0.f, 0.f, 0.f, 0.f};
#pragma unroll
            for (int s = 0; s < 4; ++s) { const bf16x8 a = *(const LAS bf16x8*)(q_l + (16 * ib + fr) * QST + 32 * s + 8 * g);
                const bf16x8 b0 = *(const LAS bf16x8*)(k_l + (16 * jb0 + fr) * QST + 32 * s + 8 * g), b1 = *(const LAS bf16x8*)(k_l + (16 * jb0 + 16 + fr) * QST + 32 * s + 8 * g);
                p0 = __builtin_amdgcn_mfma_f32_16x16x32_bf16(a, b0, p0, 0, 0, 0); p1 = __builtin_amdgcn_mfma_f32_16x16x32_bf16(a, b1, p1, 0, 0, 0); }
#pragma unroll
            for (int r = 0; r < 4; ++r) { const int i = 16 * ib + 4 * g + r, j0 = 16 * jb0 + fr, j1 = j0 + 16;
                const float v0 = j0 <= i ? p0[r] * exp2f(lg2 * (float)(i - j0)) : 0.f, v1 = j1 <= i ? p1[r] * exp2f(lg2 * (float)(i - j1)) : 0.f;
                p_l[i * PST + j0] = f2bf(v0); p_l[i * PST + j1] = f2bf(v1); }
            __syncthreads();
#pragma unroll
            for (int i = 0; i < 4; ++i) { o[i][0] = (f32x4){0.f, 0.f, 0.f, 0.f}; o[i][1] = (f32x4){0.f, 0.f, 0.f, 0.f}; }
        }
        bf16x8 vf[2][2];
#pragma unroll
        for (int s = 0; s < 2; ++s)
#pragma unroll
            for (int nb = 0; nb < 2; ++nb) { const LAS bf16_t* p = v_l + (32 * s + 8 * g + tq) * VST + 32 * w + 16 * nb + 4 * tp; vf[s][nb] = cat8(trrd(p), trrd(p + 4 * VST)); }
        if (FULL) {
#pragma unroll
            for (int i = 0; i < 4; ++i)
#pragma unroll
                for (int s = 0; s < 2; ++s) { const bf16x8 a = *(const LAS bf16x8*)(p_l + (16 * i + fr) * PST + 32 * s + 8 * g);
                    o[i][0] = __builtin_amdgcn_mfma_f32_16x16x32_bf16(a, vf[s][0], o[i][0], 0, 0, 0); o[i][1] = __builtin_amdgcn_mfma_f32_16x16x32_bf16(a, vf[s][1], o[i][1], 0, 0, 0); }
#pragma unroll
            for (int s = 0; s < 4; ++s) {
                bf16x8 bS[2];
#pragma unroll
                for (int nb = 0; nb < 2; ++nb) { u32x4 wv; wv.x = cvt_pk_bf16(S[2 * s][nb][0], S[2 * s][nb][1]); wv.y = cvt_pk_bf16(S[2 * s][nb][2], S[2 * s][nb][3]);
                    wv.z = cvt_pk_bf16(S[2 * s + 1][nb][0], S[2 * s + 1][nb][1]); wv.w = cvt_pk_bf16(S[2 * s + 1][nb][2], S[2 * s + 1][nb][3]); bS[nb] = __builtin_bit_cast(bf16x8, wv); }
#pragma unroll
                for (int i = 0; i < 4; ++i) { const LAS bf16_t* qp = qs_l + (16 * i + fr) * QST + 32 * s + 4 * g;
                    const s16x4 lo = *(const LAS s16x4*)qp, hi = *(const LAS s16x4*)(qp + 16); const bf16x8 a = cat8(lo, hi);
                    o[i][0] = __builtin_amdgcn_mfma_f32_16x16x32_bf16(a, bS[0], o[i][0], 0, 0, 0); o[i][1] = __builtin_amdgcn_mfma_f32_16x16x32_bf16(a, bS[1], o[i][1], 0, 0, 0); }
            }
        }
#pragma unroll
        for (int db = 0; db < 8; ++db) { S[db][0] = S[db][0] * gL; S[db][1] = S[db][1] * gL; }
#pragma unroll
        for (int s = 0; s < 2; ++s)
#pragma unroll
            for (int db = 0; db < 8; ++db) { const LAS bf16_t* p = kd_l + (32 * s + 8 * g + tq) * KDST + 16 * db + 4 * tp; const bf16x8 a = cat8(trrd(p), trrd(p + 4 * KDST));
                S[db][0] = __builtin_amdgcn_mfma_f32_16x16x32_bf16(a, vf[s][0], S[db][0], 0, 0, 0); S[db][1] = __builtin_amdgcn_mfma_f32_16x16x32_bf16(a, vf[s][1], S[db][1], 0, 0, 0); }
        if (FULL) {
#pragma unroll
            for (int i = 0; i < 4; ++i)
#pragma unroll
                for (int r = 0; r < 4; ++r) { float sm = o[i][0][r] + o[i][1][r], sq = o[i][0][r] * o[i][0][r] + o[i][1][r] * o[i][1][r];
                    sm += __shfl_xor(sm, 1); sq += __shfl_xor(sq, 1); sm += __shfl_xor(sm, 2); sq += __shfl_xor(sq, 2); sm += __shfl_xor(sm, 4); sq += __shfl_xor(sq, 4); sm += __shfl_xor(sm, 8); sq += __shfl_xor(sq, 8);
                    if (fr == 0) { LAS float* d = st_l + ((16 * i + 4 * g + r) * 8 + w) * 2; d[0] = sm; d[1] = sq; } }
            __syncthreads();
#pragma unroll
            for (int i = 0; i < 4; ++i)
#pragma unroll
                for (int r = 0; r < 4; ++r) { const int tok = 16 * i + 4 * g + r; if (tok >= L) continue;
                    const LAS f32x4* d = (const LAS f32x4*)(st_l + tok * 16); const f32x4 a0 = d[0], a1 = d[1], a2 = d[2], a3 = d[3];
                    const float sm = (a0[0] + a0[2]) + (a1[0] + a1[2]) + (a2[0] + a2[2]) + (a3[0] + a3[2]), sq = (a0[1] + a0[3]) + (a1[1] + a1[3]) + (a2[1] + a2[3]) + (a3[1] + a3[3]);
                    const float mu = sm * (1.f / 256.f), var = fmaxf(sq * (1.f / 256.f) - mu * mu, 0.f), rstd = rsqrtf(var + EPS);
#pragma unroll
                    for (int nb = 0; nb < 2; ++nb) { const int col = h * 256 + 32 * w + 16 * nb + fr; const size_t gi = (r0 + tok) * 1024 + col;
                        RET[gi] = f2bf((o[i][nb][r] - mu) * rstd * g_ret[col] * bf2f(RG[gi])); } }
        }
    }
    if (Sout) {
#pragma unroll
        for (int db = 0; db < 8; ++db)
#pragma unroll
            for (int nb = 0; nb < 2; ++nb)
#pragma unroll
                for (int r = 0; r < 4; ++r) Sout[(size_t)(16 * db + 4 * g + r) * RET_DV + 32 * w + 16 * nb + fr] = S[db][nb][r];
    }
}
}
__device__ __forceinline__ void r1_states(Frame& F) {
    const int bh = F.vcu >> 5, sc = F.vcu & 31, b = bh >> 2, h = bh & 3;
    rt::ret_unit<false>(F, h, b * SEQ + sc * rt::SC_TOK, 4, 64, nullptr, F.out + ((size_t)bh * rt::NSC + sc) * 32768, nullptr);
}
__device__ __forceinline__ void r2_scan(Frame& F) {
    float* U = F.out; const int gt = F.vcu * NTHR + F.tid;
    for (int e = gt; e < 8 * 32768; e += F.G * NTHR) { const int bh = e >> 15, idx = e & 32767, h = bh & 3;
        const float g256 = exp2f(log2f(1.f - exp2f(-5.f - (float)h)) * 256.f);
        float u[32];
#pragma unroll
        for (int sc = 0; sc < 32; ++sc) u[sc] = U[((size_t)bh * 32 + sc) * 32768 + idx];
        float carry = 0.f;
#pragma unroll
        for (int sc = 0; sc < 32; ++sc) { U[((size_t)bh * 32 + sc) * 32768 + idx] = carry; carry = g256 * carry + u[sc]; }
        F.out[O_RETP + (size_t)bh * 32768 + idx] = carry; }
}
__device__ __forceinline__ void r3_outputs(Frame& F) {
    const int bh = F.vcu >> 5, sc = F.vcu & 31, b = bh >> 2, h = bh & 3;
    rt::ret_unit<true>(F, h, b * SEQ + sc * rt::SC_TOK, 4, 64, F.out + ((size_t)bh * rt::NSC + sc) * 32768, nullptr, FIN(16));
    if (F.vcu < DEC_BATCH * RET_H) { const int sb = F.vcu >> 2, sh = F.vcu & 3;
        rt::ret_unit<true>(F, sh, MP + sb * DEC_SEQ, 1, DEC_SEQ, FIN(4) + (size_t)F.vcu * 32768, F.out + O_RETS + (size_t)F.vcu * 32768, FIN(16)); }
}

__global__ void __launch_bounds__(NTHR, 2) mk(const MArgs a) {
    extern __shared__ __attribute__((aligned(16))) unsigned char lds_raw[];
    Frame F;
    F.lds = (LAS unsigned char*)lds_raw;
    F.tid = threadIdx.x; F.lane = F.tid & 63; F.wave = __builtin_amdgcn_readfirstlane(F.tid >> 6);
    F.G = gridDim.x; F.x = blockIdx.x % 8; F.j = blockIdx.x / 8; F.vcu = F.x * (F.G / 8) + F.j;
    F.a = &a; F.out = a.out; F.ws = a.ws;
    volatile LAS unsigned* MISC = (volatile LAS unsigned*)(F.lds + MISC_OFF);
    if (F.tid < 32) MISC[F.tid] = 0u;
    __syncthreads();
    XcdBarrier bar = xcd_barrier_post((unsigned*)(a.ws + WS_CTL) + CW_BAR + a.li * XCD_BAR_WORDS, MISC + 8);
    const int lo = a.ph_lo, hi = a.ph_hi;
#define IN_(k) (lo <= (k) && (k) < hi)
#define SEAM_(k) do { if (IN_(k) && IN_((k) + 1)) xcd_barrier(bar); } while (0)
    if (IN_(0)) { p0_prologue(F); } SEAM_(0);
    if (IN_(1)) { p1_inproj(F); } SEAM_(1);
    if (IN_(2)) { r1_states(F); } SEAM_(2);
    if (IN_(3)) { r2_scan(F); } SEAM_(3);
    if (IN_(4)) { r3_outputs(F); } SEAM_(4);
    if (IN_(5)) { p2_qkv(F, 1); } SEAM_(5);
    if (IN_(7)) { p2_qkv(F, 0); } SEAM_(7);
    if (IN_(9)) { p5_gemm(F, 5); } SEAM_(9);
    if (IN_(10)) { p5_gemm(F, 6); } SEAM_(10);
    if (IN_(11)) { p5_gemm(F, 7); } SEAM_(11);
    if (IN_(13)) { p5_gemm(F, 9); }
}

__global__ void k_slotsum(const float* __restrict__ slotkv, float* __restrict__ skv) {
    const int r = blockIdx.x * blockDim.x + threadIdx.x; if (r >= MT) return;
    float b = 0.f; for (int i = 0; i < 8; ++i) b += slotkv[(size_t)r * 8 + i]; skv[r] = rsqrtf(b * (1.f / KV_LORA) + EPS);
}
__global__ void k_kvl_finish2(const bf16_t* __restrict__ kvl, const float* __restrict__ skv, float* __restrict__ dout) {
    const int r = blockIdx.x * 4 + (threadIdx.x >> 6), lane = threadIdx.x & 63; if (r >= MT) return;
    const float s = skv[r];
    float* o = r < MP ? dout + O_LATP + (size_t)r * KV_LORA : dout + O_LATS + (size_t)(r - MP) * KV_LORA;
#pragma unroll
    for (int jj = 0; jj < 8; ++jj) { const int c = jj * 64 + lane; o[c] = bf2f(kvl[(size_t)r * KV_LORA + c]) * s; }
}

static void gemm(hipStream_t s, const bf16_t* A, int lda, const bf16_t* Bt, int K, int M, int N, const Epi& E) {
    const int nb = ((M + 63) / 64) * (N / 64);
    hipLaunchKernelGGL(k_gemm, dim3(nb), dim3(256), 0, s, A, lda, Bt, K, M, N, E);
}
static Epi mkepi(int mode, bf16_t* o1, int ldo) { Epi e{}; e.mode = mode; e.o1 = o1; e.ldo = ldo; return e; }

extern "C" void kernel_launch(void* const* d_in, const int* in_sizes, int n_in, void* d_out, int out_size, void* d_ws, size_t ws_size, hipStream_t stream) {
    const float* x_p = (const float*)d_in[0]; const float* x_s = (const float*)d_in[1];
    const float* st_ret = (const float*)d_in[4]; const float* st_conv = (const float*)d_in[5];
    const float* w_in = (const float*)d_in[7]; const float* g_qlat = (const float*)d_in[8]; const float* w_qup = (const float*)d_in[9];
    const float* g_qn = (const float*)d_in[10]; const float* g_qr = (const float*)d_in[11]; const float* w_kvup = (const float*)d_in[13];
    const float* g_kn = (const float*)d_in[14]; const float* g_ret = (const float*)d_in[16]; const float* w_ob = (const float*)d_in[17];
    const float* w_out = (const float*)d_in[18]; const float* g_ffn = (const float*)d_in[19]; const float* w_up = (const float*)d_in[20]; const float* cw = (const float*)d_in[21];
    const float* cb = (const float*)d_in[22]; const float* w_down = (const float*)d_in[23]; const float* g_mix = (const float*)d_in[6];
    float* out = (float*)d_out; char* ws = (char*)d_ws;
    static int ok = 0;
    if (ok == 0) {
        ok = 1;
        if (ws_size < 256 * MiB || n_in != 24) { fprintf(stderr, "kernel_launch: bad ws/n_in: %zu %d\n", ws_size, n_in); ok = -1; }
        int dev = 0, cus = 0; hipGetDevice(&dev); hipDeviceGetAttribute(&cus, hipDeviceAttributeMultiprocessorCount, dev);
        if (cus != 256) { fprintf(stderr, "kernel_launch: built for 256 CUs, got %d\n", cus); ok = -1; }
        if (hipFuncSetAttribute((const void*)mk, hipFuncAttributeMaxDynamicSharedMemorySize, LDS_BYTES) != hipSuccess) { fprintf(stderr, "kernel_launch: hipFuncSetAttribute(mk) failed\n"); ok = -1; }
        if (hipFuncSetAttribute((const void*)k_ret, hipFuncAttributeMaxDynamicSharedMemorySize, 110 * 1024) != hipSuccess) { fprintf(stderr, "kernel_launch: hipFuncSetAttribute(k_ret) failed\n"); ok = -1; }
        (void)hipGetLastError();
    }
    if (ok < 0) return;
#define WSB(off) ((bf16_t*)(ws + (off)))
    float* SQ = (float*)(ws + WS_SQ); float* SKV = (float*)(ws + WS_SKV);
    float2* TAB32 = (float2*)(ws + WS_TAB32); float2* TAB64 = (float2*)(ws + WS_TAB64);

    auto run = [&](int lo, int hi, int li) { MArgs a{}; for (int i = 0; i < 24; ++i) a.in[i] = (const float*)d_in[i]; a.out = out; a.ws = (unsigned char*)ws; a.ph_lo = lo; a.ph_hi = hi; a.li = li;
        hipLaunchKernelGGL(mk, dim3(256), dim3(NTHR), LDS_BYTES, stream, a); };
    (void)hipMemsetAsync(ws + WS_CTL, 0, CTL_BYTES, stream);
    run(0, 2, 0);
    hipLaunchKernelGGL(k_slotsum, dim3((MT + 255) / 256), dim3(256), 0, stream, (const float*)(ws + WS_SLOTKV), SKV);
    hipLaunchKernelGGL(k_kvl_finish2, dim3(MT / 4), dim3(256), 0, stream, WSB(WS_KVL), SKV, out);
    run(2, 5, 1);
    bf16_t* Qb = (bf16_t*)out;
    run(5, 6, 1);
    hipLaunchKernelGGL(k_attn<1>, dim3(DEC_BATCH * HEADS), dim3(64), 0, stream, Qb, WSB(WS_KN), WSB(WS_PES), WSB(WS_V), WSB(WS_ATTS) - (size_t)MP * 1024, 1);
    hipLaunchKernelGGL(k_rownorm, dim3(MT / 4), dim3(256), 0, stream, x_p, x_s, WSB(WS_XN2));
    run(7, 8, 1);
    hipLaunchKernelGGL(k_attn<4>, dim3(BATCH * HEADS * 128), dim3(256), 0, stream, Qb, WSB(WS_KN), WSB(WS_KPE), WSB(WS_V), WSB(WS_ATT), 0);
    run(9, 12, 2);
    hipLaunchKernelGGL(k_convout, dim3((DEC_BATCH * 2 * FF2 + 255) / 256), dim3(256), 0, stream, WSB(WS_U), out);
    hipLaunchKernelGGL(k_halo, dim3(64 + DEC_BATCH), dim3(256), 0, stream, WSB(WS_U), st_conv, WSB(WS_HALO));
    hipLaunchKernelGGL(k_conv, dim3((64 + DEC_BATCH) * 11), dim3(256), 0, stream, WSB(WS_U), WSB(WS_HALO), cw, cb);
    run(13, 14, 1);
}
```

```cpp
#include <hip/hip_runtime.h>
#include <stdint.h>
#include <cstdio>

typedef unsigned short bf16_t;
typedef short bf16x8 __attribute__((ext_vector_type(8)));
typedef float f32x4 __attribute__((ext_vector_type(4)));
typedef float f32x2 __attribute__((ext_vector_type(2)));
typedef unsigned u32x4 __attribute__((ext_vector_type(4)));
typedef unsigned u32x2 __attribute__((ext_vector_type(2)));

constexpr int D_MODEL = 1024, BATCH = 2, SEQ = 8192, DEC_BATCH = 8, DEC_SEQ = 16, PAST = 2048;
constexpr int MP = BATCH * SEQ, MS = DEC_BATCH * DEC_SEQ, MT = MP + MS;
constexpr int MPAD = 16640;
constexpr int Q_LORA = 768, KV_LORA = 512, QK_NOPE = 128, QK_ROPE = 64, V_HEAD = 128, HEADS = 8;
constexpr int RET_H = 4, RET_DK = 128, RET_DV = 256;
constexpr int D_FF = 2816, FF2 = 2 * D_FF;
constexpr int IN_W = 6464;
constexpr int SKEYS = PAST + DEC_SEQ;
constexpr int LROWS = DEC_BATCH * SKEYS;
constexpr float EPS = 1e-6f;
constexpr int C_QLAT = 0, C_KVLAT = 768, C_KPE = 1280, C_RQ = 1344, C_RK = 1856, C_RV = 2368, C_RG = 3392, C_GA = 4416, C_GB = 5440;

constexpr size_t O_YP = 0, O_YS = 16777216, O_LATP = 16908288, O_RKP = 25296896, O_RETP = 26345472, O_CONVP = 26607616,
                 O_LATS = 26630144, O_RKS = 26695680, O_RETS = 26703872, O_CONVS = 27752448;

constexpr size_t MiB = 1u << 20, KiB = 1024;
constexpr size_t WS_CTL = 0, CTL_BYTES = 64 * KiB, WS_SQ = 64 * KiB, WS_SKV = 192 * KiB;
constexpr size_t WS_SLOTQ = 1 * MiB, WS_SLOTKV = 2 * MiB, WS_SLOTX1 = 3 * MiB;
constexpr size_t WS_TAB32 = 4 * MiB + 256 * KiB, WS_TAB64 = 6 * MiB + 256 * KiB;
constexpr size_t WS_FWUP = 10 * MiB + 512 * KiB, WS_FWDOWN = 21 * MiB + 512 * KiB, WS_FWIN = 27 * MiB, WS_FWQUP = 40 * MiB, WS_FWKVUP = 43 * MiB,
                 WS_FWOBA = 45 * MiB, WS_FWOBB = 47 * MiB, WS_FWOUT = 49 * MiB;
constexpr size_t WS_XN = 51 * MiB, WS_RET = 51 * MiB;
constexpr size_t WS_LATS = 83 * MiB + 512 * KiB, WS_PES = 99 * MiB + 768 * KiB, WS_ZQ = 102 * MiB, WS_KVL = 126 * MiB + 512 * KiB, WS_KPE = 142 * MiB + 768 * KiB;
constexpr size_t WS_RQ = 145 * MiB, WS_RK = 161 * MiB + 256 * KiB, WS_RV = 177 * MiB + 512 * KiB, WS_RG = 210 * MiB;
constexpr size_t WS_KN = 145 * MiB, WS_V = 177 * MiB + 512 * KiB, WS_ATTS = 242 * MiB + 512 * KiB, WS_XN2 = 210 * MiB, WS_ATT = 102 * MiB;
constexpr size_t WS_T1 = 166 * MiB + 512 * KiB, WS_MERGED = 134 * MiB;
constexpr size_t WS_X1B = 223 * MiB + 512 * KiB, WS_U = 27 * MiB, WS_HALO = 206 * MiB;

__device__ __forceinline__ bf16_t f2bf(float f) { unsigned u = __float_as_uint(f); u = (u + 0x7fffu + ((u >> 16) & 1u)) >> 16; return (bf16_t)u; }
__device__ __forceinline__ float bf2f(bf16_t b) { return __uint_as_float(((unsigned)b) << 16); }
__device__ __forceinline__ float wave_sum(float v) {
#pragma unroll
    for (int o = 1; o < 64; o <<= 1) v += __shfl_xor(v, o);
    return v;
}
__device__ __forceinline__ float sigmoidf_(float x) { return 1.f / (1.f + __expf(-x)); }
__device__ __forceinline__ float siluf_(float x) { return x / (1.f + __expf(-x)); }

__global__ void k_convert_w(const float* __restrict__ W, int ldw, int K, int N, const float* __restrict__ gain, bf16_t* __restrict__ Wt) {
    __shared__ float tile[32][33];
    const int nb = N / 32, kb = blockIdx.x / nb, nbi = blockIdx.x % nb;
    const int tx = threadIdx.x & 31, ty = threadIdx.x >> 5;
    for (int i = ty; i < 32; i += 8) { const int k = kb * 32 + i; tile[i][tx] = W[(size_t)k * ldw + nbi * 32 + tx] * (gain ? gain[k] : 1.f); }
    __syncthreads();
    for (int i = ty; i < 32; i += 8) { const int n = nbi * 32 + i; Wt[(size_t)n * K + kb * 32 + tx] = f2bf(tile[tx][i]); }
}
__global__ void k_tables(float2* tab32, float2* tab64) {
    const int idx = blockIdx.x * blockDim.x + threadIdx.x;
    if (idx < 8192 * 32) { const int pos = idx / 32, i = idx % 32; const double f = pow(10000.0, -(double)i / 32.0), a = (double)pos * f; tab32[idx] = make_float2((float)cos(a), (float)sin(a)); }
    if (idx < 8192 * 64) { const int pos = idx / 64, i = idx % 64; const double f = pow(10000.0, -(double)i / 64.0), a = (double)pos * f; tab64[idx] = make_float2((float)cos(a), (float)sin(a)); }
}
__global__ void k_rownorm(const float* __restrict__ xa, const float* __restrict__ xb, bf16_t* __restrict__ out) {
    const int r = blockIdx.x * 4 + (threadIdx.x >> 6), lane = threadIdx.x & 63; if (r >= MT) return;
    const float* x = r < MP ? xa + (size_t)r * D_MODEL : xb + (size_t)(r - MP) * D_MODEL;
    f32x4 v[4]; float s = 0.f;
#pragma unroll
    for (int j = 0; j < 4; ++j) { v[j] = *(const f32x4*)(x + j * 256 + lane * 4); s += v[j][0] * v[j][0] + v[j][1] * v[j][1] + v[j][2] * v[j][2] + v[j][3] * v[j][3]; }
    const float inv = rsqrtf(wave_sum(s) * (1.f / D_MODEL) + EPS);
#pragma unroll
    for (int j = 0; j < 4; ++j) { bf16_t* o = out + (size_t)r * D_MODEL + j * 256 + lane * 4;
        o[0] = f2bf(v[j][0] * inv); o[1] = f2bf(v[j][1] * inv); o[2] = f2bf(v[j][2] * inv); o[3] = f2bf(v[j][3] * inv); }
}
__global__ void k_cache(const float* __restrict__ clat, const float* __restrict__ cpe, bf16_t* __restrict__ lats, bf16_t* __restrict__ pes) {
    const size_t idx = (size_t)blockIdx.x * blockDim.x + threadIdx.x;
    const size_t nlat = (size_t)DEC_BATCH * PAST * KV_LORA, npe = (size_t)DEC_BATCH * PAST * QK_ROPE;
    if (idx < nlat) { const int c = idx % KV_LORA; const size_t rj = idx / KV_LORA; const int j = rj % PAST, b = rj / PAST; lats[((size_t)b * SKEYS + j) * KV_LORA + c] = f2bf(clat[idx]); }
    if (idx < npe) { const int c = idx % QK_ROPE; const size_t rj = idx / QK_ROPE; const int j = rj % PAST, b = rj / PAST; pes[((size_t)b * SKEYS + j) * QK_ROPE + c] = f2bf(cpe[idx]); }
}

enum { EP_BF16 = 0, EP_SILU = 1, EP_SIGM = 2, EP_ROWSCALE = 3, EP_KVSPLIT = 4, EP_MUL = 5, EP_MULADD = 6, EP_RESID = 7, EP_RESID_INPLACE = 8 };
struct Epi {
    int mode; int ldo; bf16_t* o1; bf16_t* o2; const float* rs; const bf16_t* g; const float* xa; const float* xb; float* of;
};
__device__ __forceinline__ void epi_apply(const Epi& E, int r, int c, float v) {
    switch (E.mode) {
    case EP_BF16: E.o1[(size_t)r * E.ldo + c] = f2bf(v); break;
    case EP_SILU: E.o1[(size_t)r * E.ldo + c] = f2bf(siluf_(v)); break;
    case EP_SIGM: E.o1[(size_t)r * E.ldo + c] = f2bf(sigmoidf_(v)); break;
    case EP_ROWSCALE: E.o1[(size_t)r * E.ldo + c] = f2bf(v * E.rs[r]); break;
    case EP_KVSPLIT: { const int h = c >> 8, j = c & 255; const float s = E.rs ? E.rs[r] : 1.f;
        if (j < 128) E.o1[(size_t)r * 1024 + h * 128 + j] = f2bf(v * s); else E.o2[(size_t)r * 1024 + h * 128 + (j - 128)] = f2bf(v * s); } break;
    case EP_MUL: E.o1[(size_t)r * E.ldo + c] = f2bf(v * bf2f(E.g[(size_t)r * E.ldo + c])); break;
    case EP_MULADD: { const size_t i = (size_t)r * E.ldo + c; E.o1[i] = f2bf(bf2f(E.o1[i]) + v * bf2f(E.g[i])); } break;
    case EP_RESID: { const float x = r < MP ? E.xa[(size_t)r * D_MODEL + c] : E.xb[(size_t)(r - MP) * D_MODEL + c]; E.of[(size_t)r * D_MODEL + c] = x + v; } break;
    case EP_RESID_INPLACE: { const size_t i = (size_t)r * D_MODEL + c; E.of[i] = E.of[i] + v; } break;
    }
}
__global__ void __launch_bounds__(256) k_gemm(const bf16_t* __restrict__ A, int lda, const bf16_t* __restrict__ Bt, int K, int M, int N, Epi E) {
    __shared__ bf16_t As[64][72], Bs[64][72];
    const int nbn = N / 64, bm = blockIdx.x / nbn, bn = blockIdx.x % nbn;
    const int tid = threadIdx.x, w = tid >> 6, lane = tid & 63, fr = lane & 15, fq = lane >> 4;
    f32x4 acc[4] = {};
    const int lr = tid >> 2, lc = (tid & 3) * 16;
    for (int k0 = 0; k0 < K; k0 += 64) {
        const int ar = bm * 64 + lr;
        bf16x8 a0 = {}, a1 = {};
        if (ar < M) { a0 = *(const bf16x8*)(A + (size_t)ar * lda + k0 + lc); a1 = *(const bf16x8*)(A + (size_t)ar * lda + k0 + lc + 8); }
        const bf16x8 b0 = *(const bf16x8*)(Bt + (size_t)(bn * 64 + lr) * K + k0 + lc), b1 = *(const bf16x8*)(Bt + (size_t)(bn * 64 + lr) * K + k0 + lc + 8);
        __syncthreads();
        *(bf16x8*)&As[lr][lc] = a0; *(bf16x8*)&As[lr][lc + 8] = a1; *(bf16x8*)&Bs[lr][lc] = b0; *(bf16x8*)&Bs[lr][lc + 8] = b1;
        __syncthreads();
#pragma unroll
        for (int ks = 0; ks < 2; ++ks) {
            const bf16x8 af = *(const bf16x8*)&As[w * 16 + fr][ks * 32 + fq * 8];
#pragma unroll
            for (int n = 0; n < 4; ++n) { const bf16x8 bfr = *(const bf16x8*)&Bs[n * 16 + fr][ks * 32 + fq * 8];
                acc[n] = __builtin_amdgcn_mfma_f32_16x16x32_bf16(af, bfr, acc[n], 0, 0, 0); }
        }
    }
#pragma unroll
    for (int n = 0; n < 4; ++n)
#pragma unroll
        for (int i = 0; i < 4; ++i) { const int r = bm * 64 + w * 16 + fq * 4 + i, c = bn * 64 + n * 16 + fr; if (r < M) epi_apply(E, r, c, acc[n][i]); }
}

__global__ void k_zq_finish(const bf16_t* __restrict__ zq, float* __restrict__ sq) {
    const int r = blockIdx.x * 4 + (threadIdx.x >> 6), lane = threadIdx.x & 63; if (r >= MT) return;
    float s = 0.f; for (int c = lane; c < Q_LORA; c += 64) { const float v = bf2f(zq[(size_t)r * Q_LORA + c]); s += v * v; }
    s = wave_sum(s); if (lane == 0) sq[r] = rsqrtf(s * (1.f / Q_LORA) + EPS);
}
__global__ void k_kvl_finish(const bf16_t* __restrict__ kvl, const float* __restrict__ g, float* __restrict__ skv, float* __restrict__ dout, bf16_t* __restrict__ lats) {
    const int r = blockIdx.x * 4 + (threadIdx.x >> 6), lane = threadIdx.x & 63; if (r >= MT) return;
    float v[8]; float s = 0.f;
#pragma unroll
    for (int j = 0; j < 8; ++j) { v[j] = bf2f(kvl[(size_t)r * KV_LORA + j * 64 + lane]); s += v[j] * v[j]; }
    const float inv = rsqrtf(wave_sum(s) * (1.f / KV_LORA) + EPS); if (lane == 0) skv[r] = inv;
    float* o = r < MP ? dout + O_LATP + (size_t)r * KV_LORA : dout + O_LATS + (size_t)(r - MP) * KV_LORA;
#pragma unroll
    for (int j = 0; j < 8; ++j) { const int c = j * 64 + lane; const float y = v[j] * inv * g[c]; o[c] = y;
        if (r >= MP) { const int rs = r - MP, b = rs / DEC_SEQ, t = rs % DEC_SEQ; lats[((size_t)b * SKEYS + PAST + t) * KV_LORA + c] = f2bf(y); } }
}
__global__ void k_kpe_finish(const bf16_t* __restrict__ raw, const float* __restrict__ g, const float2* __restrict__ tab32, bf16_t* __restrict__ kpe, float* __restrict__ dout, bf16_t* __restrict__ pes) {
    const int r = blockIdx.x * 4 + (threadIdx.x >> 6), lane = threadIdx.x & 63; if (r >= MT) return;
    const float v = bf2f(raw[(size_t)r * 64 + lane]); const float inv = rsqrtf(wave_sum(v * v) * (1.f / 64.f) + EPS);
    const float y = v * inv * g[lane]; const float yo = __shfl_xor(y, 32);
    const int pos = r < MP ? (r % SEQ) : PAST + ((r - MP) % DEC_SEQ);
    const float2 cs = tab32[pos * 32 + (lane & 31)];
    const float o = lane < 32 ? y * cs.x - yo * cs.y : yo * cs.y + y * cs.x;
    kpe[(size_t)r * 64 + lane] = f2bf(o);
    if (r < MP) dout[O_RKP + (size_t)r * 64 + lane] = o;
    else { const int rs = r - MP, b = rs / DEC_SEQ, t = rs % DEC_SEQ; dout[O_RKS + (size_t)rs * 64 + lane] = o; pes[((size_t)b * SKEYS + PAST + t) * 64 + lane] = f2bf(o); }
}
__global__ void k_rope_r(bf16_t* __restrict__ buf, const float2* __restrict__ tab64, float scale) {
    const int r = blockIdx.x, tid = threadIdx.x;
    const int h = tid >> 6, i = tid & 63; const int pos = r < MP ? (r % SEQ) : PAST + ((r - MP) % DEC_SEQ);
    bf16_t* p = buf + (size_t)r * 512 + h * 128; const float x1 = bf2f(p[i]), x2 = bf2f(p[i + 64]); const float2 cs = tab64[pos * 64 + i];
    p[i] = f2bf((x1 * cs.x - x2 * cs.y) * scale); p[i + 64] = f2bf((x1 * cs.y + x2 * cs.x) * scale);
}
__global__ void k_q_finish(bf16_t* __restrict__ q, const float* __restrict__ gn, const float* __restrict__ gr, const float2* __restrict__ tab32, float c2) {
    const int r = blockIdx.x * 4 + (threadIdx.x >> 6), lane = threadIdx.x & 63; if (r >= MT) return;
    const int pos = r < MP ? (r % SEQ) : PAST + ((r - MP) % DEC_SEQ);
    for (int h = 0; h < HEADS; ++h) {
        bf16_t* p = q + (size_t)r * 1536 + h * 192;
        const float a = bf2f(p[lane]), b = bf2f(p[lane + 64]), c = bf2f(p[128 + lane]);
        const float in = rsqrtf(wave_sum(a * a + b * b) * (1.f / 128.f) + EPS), ir = rsqrtf(wave_sum(c * c) * (1.f / 64.f) + EPS);
        p[lane] = f2bf(a * in * gn[lane] * c2); p[lane + 64] = f2bf(b * in * gn[lane + 64] * c2);
        const float y = c * ir * gr[lane], yo = __shfl_xor(y, 32); const float2 cs = tab32[pos * 32 + (lane & 31)];
        p[128 + lane] = f2bf((lane < 32 ? y * cs.x - yo * cs.y : yo * cs.y + y * cs.x) * c2);
    }
}
__global__ void k_kn_finish(bf16_t* __restrict__ kn, const float* __restrict__ g, int rows) {
    const int r = blockIdx.x * 4 + (threadIdx.x >> 6), lane = threadIdx.x & 63; if (r >= rows) return;
    for (int h = 0; h < HEADS; ++h) { bf16_t* p = kn + (size_t)r * 1024 + h * 128; const float a = bf2f(p[lane]), b = bf2f(p[lane + 64]);
        const float in = rsqrtf(wave_sum(a * a + b * b) * (1.f / 128.f) + EPS); p[lane] = f2bf(a * in * g[lane]); p[lane + 64] = f2bf(b * in * g[lane + 64]); }
}
__global__ void k_ret_finish(bf16_t* __restrict__ ret, const float* __restrict__ g, const bf16_t* __restrict__ gate) {
    const int r = blockIdx.x * 4 + (threadIdx.x >> 6), lane = threadIdx.x & 63; if (r >= MT) return;
    for (int h = 0; h < RET_H; ++h) { bf16_t* p = ret + (size_t)r * 1024 + h * 256; float v[4]; float s = 0.f;
#pragma unroll
        for (int j = 0; j < 4; ++j) { v[j] = bf2f(p[j * 64 + lane]); s += v[j]; }
        const float mu = wave_sum(s) * (1.f / 256.f); float q = 0.f;
#pragma unroll
        for (int j = 0; j < 4; ++j) { v[j] -= mu; q += v[j] * v[j]; }
        const float inv = rsqrtf(wave_sum(q) * (1.f / 256.f) + EPS);
#pragma unroll
        for (int j = 0; j < 4; ++j) { const int c = h * 256 + j * 64 + lane; p[j * 64 + lane] = f2bf(v[j] * inv * g[c] * bf2f(gate[(size_t)r * 1024 + c])); } }
}
__global__ void k_x1_finish(const float* __restrict__ x1, bf16_t* __restrict__ out) {
    const int r = blockIdx.x * 4 + (threadIdx.x >> 6), lane = threadIdx.x & 63; if (r >= MT) return;
    const float* x = x1 + (size_t)r * D_MODEL; f32x4 v[4]; float s = 0.f;
#pragma unroll
    for (int j = 0; j < 4; ++j) { v[j] = *(const f32x4*)(x + j * 256 + lane * 4); s += v[j][0] * v[j][0] + v[j][1] * v[j][1] + v[j][2] * v[j][2] + v[j][3] * v[j][3]; }
    const float inv = rsqrtf(wave_sum(s) * (1.f / D_MODEL) + EPS);
#pragma unroll
    for (int j = 0; j < 4; ++j) { bf16_t* o = out + (size_t)r * D_MODEL + j * 256 + lane * 4;
        o[0] = f2bf(v[j][0] * inv); o[1] = f2bf(v[j][1] * inv); o[2] = f2bf(v[j][2] * inv); o[3] = f2bf(v[j][3] * inv); }
}

template <int NW>
__global__ void __launch_bounds__(NW * 64) k_attn(const bf16_t* __restrict__ Q, const bf16_t* __restrict__ KN, const bf16_t* __restrict__ KPE, const bf16_t* __restrict__ V,
                                                 bf16_t* __restrict__ att, int sample) {
    __shared__ bf16_t Ks[64][200]; __shared__ bf16_t Vt[128][72]; __shared__ bf16_t Ps[NW][16][72];
    const int tid = threadIdx.x, w = tid >> 6, lane = tid & 63, fr = lane & 15, fq = lane >> 4;
    int b, h, qrow0, krow0, nkeys;
    if (!sample) { const int c = blockIdx.x % 128, bh = blockIdx.x / 128; h = bh % HEADS; b = bh / HEADS; qrow0 = b * SEQ + c * 64 + w * 16; krow0 = b * SEQ; nkeys = (c + 1) * 64; }
    else { h = blockIdx.x % HEADS; b = blockIdx.x / HEADS; qrow0 = MP + b * DEC_SEQ; krow0 = b * SKEYS; nkeys = SKEYS; }
    bf16x8 qf[6];
#pragma unroll
    for (int s = 0; s < 6; ++s) qf[s] = *(const bf16x8*)(Q + (size_t)(qrow0 + fr) * 1536 + h * 192 + s * 32 + fq * 8);
    f32x4 o[8] = {}; float m[4], l[4];
#pragma unroll
    for (int i = 0; i < 4; ++i) { m[i] = -1e30f; l[i] = 0.f; }
    const int ntile = (nkeys + 63) / 64;
    for (int t = 0; t < ntile; ++t) {
        __syncthreads();
        for (int idx = tid; idx < 64 * 24; idx += NW * 64) { const int key = idx / 24, ch = idx % 24; const int kg = t * 64 + key; bf16x8 v = {};
            if (kg < nkeys) { if (ch < 16) v = *(const bf16x8*)(KN + (size_t)(krow0 + kg) * 1024 + h * 128 + ch * 8); else v = *(const bf16x8*)(KPE + (size_t)(krow0 + kg) * 64 + (ch - 16) * 8); }
            *(bf16x8*)&Ks[key][ch * 8] = v; }
        for (int idx = tid; idx < 64 * 16; idx += NW * 64) { const int key = idx / 16, ch = idx % 16; const int kg = t * 64 + key; bf16x8 v = {};
            if (kg < nkeys) v = *(const bf16x8*)(V + (size_t)(krow0 + kg) * 1024 + h * 128 + ch * 8);
#pragma unroll
            for (int e = 0; e < 8; ++e) Vt[ch * 8 + e][key] = (bf16_t)v[e]; }
        __syncthreads();
        f32x4 s[4] = {};
#pragma unroll
        for (int ks = 0; ks < 6; ++ks)
#pragma unroll
            for (int n = 0; n < 4; ++n) { const bf16x8 kf = *(const bf16x8*)&Ks[n * 16 + fr][ks * 32 + fq * 8]; s[n] = __builtin_amdgcn_mfma_f32_16x16x32_bf16(qf[ks], kf, s[n], 0, 0, 0); }
#pragma unroll
        for (int n = 0; n < 4; ++n) if (t * 64 + n * 16 + fr >= nkeys) { s[n][0] = -INFINITY; s[n][1] = -INFINITY; s[n][2] = -INFINITY; s[n][3] = -INFINITY; }
        float alpha[4];
#pragma unroll
        for (int i = 0; i < 4; ++i) { float mx = fmaxf(fmaxf(s[0][i], s[1][i]), fmaxf(s[2][i], s[3][i]));
            mx = fmaxf(mx, __shfl_xor(mx, 1)); mx = fmaxf(mx, __shfl_xor(mx, 2)); mx = fmaxf(mx, __shfl_xor(mx, 4)); mx = fmaxf(mx, __shfl_xor(mx, 8));
            const float mn = fmaxf(m[i], mx); alpha[i] = exp2f(m[i] - mn); m[i] = mn; float ps = 0.f;
#pragma unroll
            for (int n = 0; n < 4; ++n) { const float p = exp2f(s[n][i] - mn); s[n][i] = p; ps += p; }
            ps += __shfl_xor(ps, 1); ps += __shfl_xor(ps, 2); ps += __shfl_xor(ps, 4); ps += __shfl_xor(ps, 8);
            l[i] = l[i] * alpha[i] + ps; }
#pragma unroll
        for (int n = 0; n < 4; ++n)
#pragma unroll
            for (int i = 0; i < 4; ++i) Ps[w][fq * 4 + i][n * 16 + fr] = f2bf(s[n][i]);
#pragma unroll
        for (int n = 0; n < 8; ++n)
#pragma unroll
            for (int i = 0; i < 4; ++i) o[n][i] *= alpha[i];
#pragma unroll
        for (int ks = 0; ks < 2; ++ks) { const bf16x8 pf = *(const bf16x8*)&Ps[w][fr][ks * 32 + fq * 8];
#pragma unroll
            for (int n = 0; n < 8; ++n) { const bf16x8 vf = *(const bf16x8*)&Vt[n * 16 + fr][ks * 32 + fq * 8]; o[n] = __builtin_amdgcn_mfma_f32_16x16x32_bf16(pf, vf, o[n], 0, 0, 0); } }
    }
#pragma unroll
    for (int i = 0; i < 4; ++i) { const float rl = 1.f / l[i]; const int r = qrow0 + fq * 4 + i;
#pragma unroll
        for (int n = 0; n < 8; ++n) att[(size_t)r * 1024 + h * 128 + n * 16 + fr] = f2bf(o[n][i] * rl); }
}

__global__ void __launch_bounds__(256) k_ret(const bf16_t* __restrict__ rq, const bf16_t* __restrict__ rk, const bf16_t* __restrict__ rv, int rowbase, int rows_per_batch, int L, int nch,
                                             const float* __restrict__ Sinit, bf16_t* __restrict__ retraw, float* __restrict__ Sout) {
    extern __shared__ float sm[];
    float* qs = sm;
    float* ks = qs + 64 * 129;
    float* Ss = ks + 64 * 129;
    float* vs = Ss + 128 * 33;
    float* sc = vs + 64 * 33;
    const int tid = threadIdx.x; const int sl = blockIdx.x % 8, h = (blockIdx.x / 8) % RET_H, b = blockIdx.x / 32;
    const float gam = 1.f - exp2f(-5.f - (float)h), lg2 = log2f(gam);
    for (int i = tid; i < 128 * 32; i += 256) { const int d = i / 32, e = i % 32; Ss[d * 33 + e] = Sinit ? Sinit[(((size_t)b * RET_H + h) * RET_DK + d) * RET_DV + sl * 32 + e] : 0.f; }
    const float gL = exp2f(lg2 * (float)L);
    for (int c = 0; c < nch; ++c) {
        const size_t r0 = (size_t)rowbase + (size_t)b * rows_per_batch + (size_t)c * L;
        __syncthreads();
        for (int i = tid; i < L * 128; i += 256) { const int j = i / 128, d = i % 128; qs[j * 129 + d] = bf2f(rq[(r0 + j) * 512 + h * 128 + d]); ks[j * 129 + d] = bf2f(rk[(r0 + j) * 512 + h * 128 + d]); }
        for (int i = tid; i < L * 32; i += 256) { const int j = i / 32, e = i % 32; vs[j * 33 + e] = bf2f(rv[(r0 + j) * 1024 + h * 256 + sl * 32 + e]); }
        __syncthreads();
        for (int p = tid; p < L * L; p += 256) { const int i = p / L, j = p % L; float s = 0.f;
            if (j <= i) { for (int d = 0; d < 128; ++d) s += qs[i * 129 + d] * ks[j * 129 + d]; s *= exp2f(lg2 * (float)(i - j)); }
            sc[i * 65 + j] = s; }
        __syncthreads();
        for (int p = tid; p < L * 32; p += 256) { const int i = p / 32, e = p % 32; float a = 0.f, cr = 0.f;
            for (int j = 0; j <= i; ++j) a += sc[i * 65 + j] * vs[j * 33 + e];
            for (int d = 0; d < 128; ++d) cr += qs[i * 129 + d] * Ss[d * 33 + e];
            retraw[(r0 + i) * 1024 + h * 256 + sl * 32 + e] = f2bf(a + cr * exp2f(lg2 * (float)(i + 1))); }
        __syncthreads();
        for (int p = tid; p < 128 * 32; p += 256) { const int d = p / 32, e = p % 32; float a = Ss[d * 33 + e] * gL;
            for (int j = 0; j < L; ++j) a += ks[j * 129 + d] * exp2f(lg2 * (float)(L - 1 - j)) * vs[j * 33 + e];
            Ss[d * 33 + e] = a; }
    }
    __syncthreads();
    for (int i = tid; i < 128 * 32; i += 256) { const int d = i / 32, e = i % 32; Sout[(((size_t)b * RET_H + h) * RET_DK + d) * RET_DV + sl * 32 + e] = Ss[d * 33 + e]; }
}

__global__ void k_halo(const bf16_t* __restrict__ U, const float* __restrict__ prev_s, bf16_t* __restrict__ halo) {
    const int ch = blockIdx.x; const int tid = threadIdx.x;
    for (int i = tid; i < 2 * FF2; i += 256) { const int k = i / FF2, n = i % FF2; float v = 0.f;
        if (ch < 64) { const int r0 = ch * 256; if ((r0 % SEQ) != 0) v = bf2f(U[(size_t)(r0 - 2 + k) * FF2 + n]); }
        else { const int b = ch - 64; v = prev_s[((size_t)b * 2 + k) * FF2 + n]; }
        halo[(size_t)ch * 2 * FF2 + i] = f2bf(v); }
}
__global__ void __launch_bounds__(256) k_conv(bf16_t* __restrict__ U, const bf16_t* __restrict__ halo, const float* __restrict__ cw, const float* __restrict__ cb) {
    const int ch = blockIdx.x / 11, strip = blockIdx.x % 11; const int n = strip * 256 + threadIdx.x;
    int r0, nr; if (ch < 64) { r0 = ch * 256; nr = 256; } else { r0 = MP + (ch - 64) * DEC_SEQ; nr = DEC_SEQ; }
    const int nv = n + D_FF;
    const float wg0 = cw[n], wg1 = cw[FF2 + n], wg2 = cw[2 * FF2 + n], bg = cb[n], wv0 = cw[nv], wv1 = cw[FF2 + nv], wv2 = cw[2 * FF2 + nv], bv = cb[nv];
    float g2 = bf2f(halo[(size_t)ch * 2 * FF2 + n]), g1 = bf2f(halo[(size_t)ch * 2 * FF2 + FF2 + n]);
    float v2 = bf2f(halo[(size_t)ch * 2 * FF2 + nv]), v1 = bf2f(halo[(size_t)ch * 2 * FF2 + FF2 + nv]);
    for (int i = 0; i < nr; ++i) { bf16_t* row = U + (size_t)(r0 + i) * FF2; const float g0 = bf2f(row[n]), v0 = bf2f(row[nv]);
        const float cg = g2 * wg0 + g1 * wg1 + g0 * wg2 + bg, cv = v2 * wv0 + v1 * wv1 + v0 * wv2 + bv;
        row[n] = f2bf(siluf_(cg) * cv); g2 = g1; g1 = g0; v2 = v1; v1 = v0; }
}
__global__ void k_convout(const bf16_t* __restrict__ U, float* __restrict__ dout) {
    const int idx = blockIdx.x * blockDim.x + threadIdx.x;
    if (idx < BATCH * 2 * FF2) { const int n = idx % FF2, k = (idx / FF2) % 2, b = idx / (2 * FF2); dout[O_CONVP + idx] = bf2f(U[(size_t)(b * SEQ + SEQ - 2 + k) * FF2 + n]); }
    if (idx < DEC_BATCH * 2 * FF2) { const int n = idx % FF2, k = (idx / FF2) % 2, b = idx / (2 * FF2); dout[O_CONVS + idx] = bf2f(U[(size_t)(MP + b * DEC_SEQ + DEC_SEQ - 2 + k) * FF2 + n]); }
}

#define LAS __attribute__((address_space(3)))
#define GAS __attribute__((address_space(1)))
constexpr int NTHR = 512;
constexpr int RING_BYTES = 131072, EPI_OFF = RING_BYTES, EPI_BYTES = 8192, MISC_OFF = EPI_OFF + EPI_BYTES, LDS_BYTES = 147456;
constexpr int CW_BAR = 1024;

__device__ __forceinline__ unsigned cvt_pk_bf16(float lo, float hi) { unsigned r; asm volatile("v_cvt_pk_bf16_f32 %0, %1, %2" : "=v"(r) : "v"(lo), "v"(hi)); return r; }
__device__ __forceinline__ u32x4 pack8f(const f32x4& a, const f32x4& b) { u32x4 w; w.x = cvt_pk_bf16(a[0], a[1]); w.y = cvt_pk_bf16(a[2], a[3]); w.z = cvt_pk_bf16(b[0], b[1]); w.w = cvt_pk_bf16(b[2], b[3]); return w; }
__device__ __forceinline__ int row_pos(int row) { return row < MP ? (row & (SEQ - 1)) : PAST + ((row - MP) & (DEC_SEQ - 1)); }

#define XB_TMO      128
#define XB_XCNT(j)  (256  + 64 * (j))
#define XB_XSUB(j)  (1280 + 64 * (j))
#define XB_XGEN(j)  (2304 + 64 * (j))
#define XB_TOP      3328
#define XB_TOPGEN   3392
#define XCD_BAR_WORDS 3456
#define XB_SPIN_CAP (1u << 18)
__device__ __forceinline__ unsigned xb_ld(unsigned* p)              { return __hip_atomic_load(p, __ATOMIC_RELAXED, __HIP_MEMORY_SCOPE_AGENT); }
__device__ __forceinline__ unsigned xb_add(unsigned* p, unsigned v) { return __hip_atomic_fetch_add(p, v, __ATOMIC_RELAXED, __HIP_MEMORY_SCOPE_AGENT); }
__device__ __forceinline__ unsigned xb_xcc_id() { return (unsigned)__builtin_amdgcn_s_getreg((3 << 11) | 20) & 0xFu; }
#define XB_SPIN(cond, bar) do { unsigned _sp = 0; while (cond) { __builtin_amdgcn_s_sleep(1); \
    if ((++_sp & 255u) == 0u) { if (xb_ld(&(bar)[XB_TMO])) break; if (_sp > XB_SPIN_CAP) { atomicAdd(&(bar)[XB_TMO], 1u); break; } } } } while (0)
struct XcdBarrier { unsigned* bar; unsigned x; volatile LAS unsigned* st; };
__device__ __forceinline__ XcdBarrier xcd_barrier_post(unsigned* bar, volatile LAS unsigned* st) {
    XcdBarrier b; b.bar = bar; b.x = xb_xcc_id(); b.st = st;
    if (threadIdx.x == 0) (void)xb_add(&bar[XB_XCNT(b.x)], 1u);
    return b;
}
__device__ __forceinline__ void xcd_barrier_complete(unsigned* bar, unsigned x, unsigned& nloc, unsigned& nx) {
    const unsigned G = gridDim.x * gridDim.y * gridDim.z;
    unsigned sum, cnt, mine, sp = 0u;
    for (;;) {
        sum = 0u; cnt = 0u; mine = 0u;
#pragma unroll
        for (unsigned j = 0; j < 16; ++j) { const unsigned c = xb_ld(&bar[XB_XCNT(j)]); sum += c; cnt += (c > 0u) ? 1u : 0u; mine = (j == x) ? c : mine; }
        if (sum == G) break;
        __builtin_amdgcn_s_sleep(1);
        if ((++sp & 255u) == 0u) { if (xb_ld(&bar[XB_TMO])) break; if (sp > XB_SPIN_CAP) { atomicAdd(&bar[XB_TMO], 1u); break; } }
    }
    nloc = mine > 0u ? mine : 1u; nx = cnt > 0u ? cnt : 1u;
}
__device__ __forceinline__ void xcd_barrier(const XcdBarrier& b) {
    asm volatile("s_waitcnt vmcnt(0)" ::: "memory");
    __syncthreads();
    if (threadIdx.x == 0) {
        unsigned* bar = b.bar;
        __builtin_amdgcn_s_waitcnt(0);
        unsigned nloc = b.st[0], nx = b.st[1];
        if (nloc == 0u) { xcd_barrier_complete(bar, b.x, nloc, nx); b.st[0] = nloc; b.st[1] = nx; }
        const unsigned old = xb_add(&bar[XB_XSUB(b.x)], 1u);
        const unsigned gen = old / nloc;
        if (old + 1u == (gen + 1u) * nloc) {
            __builtin_amdgcn_fence(__ATOMIC_RELEASE, "agent");
            asm volatile("s_waitcnt vmcnt(0)" ::: "memory");
            const unsigned og = xb_add(&bar[XB_TOP], 1u);
            const unsigned tg = og / nx;
            if (og + 1u == (tg + 1u) * nx) xb_add(&bar[XB_TOPGEN], 1u);
            else XB_SPIN(xb_ld(&bar[XB_TOPGEN]) == tg, bar);
            __builtin_amdgcn_fence(__ATOMIC_ACQUIRE, "agent");
            xb_add(&bar[XB_XGEN(b.x)], 1u);
            asm volatile("s_waitcnt vmcnt(0)" ::: "memory");
        } else {
            XB_SPIN(xb_ld(&bar[XB_XGEN(b.x)]) == gen, bar);
            __builtin_amdgcn_fence(__ATOMIC_ACQUIRE, "agent");
            asm volatile("s_waitcnt vmcnt(0)" ::: "memory");
        }
    }
    __syncthreads();
}

namespace pg {
constexpr int BK = 64, HALF = 128, HTB = HALF * BK * 2;
__host__ __device__ __forceinline__ int lds_byte(int r, int c) { const int st = (r >> 4) * 2 + (c >> 5), rr = r & 15, cc = c & 31, ob = rr * 64 + cc * 2; return st * 1024 + (ob ^ (((ob >> 9) & 1) << 5)); }
__host__ __device__ __forceinline__ void stage_rc(int b, int& R, int& C) { const int st = b / 1024, sb = b % 1024, swz = sb ^ (((sb >> 9) & 1) << 5); R = (st >> 1) * 16 + swz / 64; C = (st & 1) * 32 + (swz % 64) / 2; }
__host__ __device__ __forceinline__ int perm32(int rho) { const int n = rho >> 4, i = rho & 15; return 8 * (i >> 2) + 4 * n + (i & 3); }
struct UnitG { const char* A; const char* B; unsigned lda, ldb; int nt; int pm, pn, kind; };
typedef f32x4 Acc[2][2][4][2];

template <class Sched, class Epi>
__device__ __forceinline__ void gemm_stream(LAS unsigned char* lds, const Sched& S, const Epi& E) {
    const int tid = threadIdx.x, wid = __builtin_amdgcn_readfirstlane(tid >> 6), lane = tid & 63, wr = wid >> 2, wc = wid & 3, fr = lane & 15, fq = lane >> 4;
    unsigned Rr[2], Cc[2];
#pragma unroll
    for (int i = 0; i < 2; ++i) { int R, C; stage_rc(tid * 16 + i * 8192, R, C); Rr[i] = (unsigned)R; Cc[i] = (unsigned)C * 2u; }
    const unsigned ldsw = (unsigned)wid * 1024u;
    const int aoff = lds_byte(wr * 64 + fr, fq * 8), boff = lds_byte(wc * 32 + fr, fq * 8);
#define PG_SA(b, h) (((b) * 2 + (h)) * HTB)
#define PG_SB(b, h) ((4 + (b) * 2 + (h)) * HTB)
#define PG_STAGE(bufoff, gbase, ld) do { _Pragma("unroll") for (int _i = 0; _i < 2; ++_i) \
        __builtin_amdgcn_global_load_lds((const unsigned*)((const char*)(gbase) + (size_t)(Rr[_i] * (ld) + Cc[_i])), (LAS unsigned*)(lds + (bufoff) + ldsw + _i * 8192), 16, 0, 0); } while (0)
#define PG_LDA(dst, b, h) do { _Pragma("unroll") for (int m = 0; m < 4; ++m) _Pragma("unroll") for (int k = 0; k < 2; ++k) dst[m][k] = *(const LAS bf16x8*)(lds + PG_SA(b, h) + aoff + m * 2048 + k * 1024); } while (0)
#define PG_LDB(dst, b, h) do { _Pragma("unroll") for (int n = 0; n < 2; ++n) _Pragma("unroll") for (int k = 0; k < 2; ++k) dst[n][k] = *(const LAS bf16x8*)(lds + PG_SB(b, h) + boff + n * 2048 + k * 1024); } while (0)
#define PG_MMA(ai, bj, At, Bt) do { __builtin_amdgcn_s_setprio(1); _Pragma("unroll") for (int m = 0; m < 4; ++m) _Pragma("unroll") for (int n = 0; n < 2; ++n) _Pragma("unroll") for (int k = 0; k < 2; ++k) \
        acc[ai][bj][m][n] = __builtin_amdgcn_mfma_f32_16x16x32_bf16(Bt[n][k], At[m][k], acc[ai][bj][m][n], 0, 0, 0); __builtin_amdgcn_s_setprio(0); } while (0)
#define PG_WAIT_V(n) asm volatile("s_waitcnt vmcnt(" #n ")" ::: "memory")
#define PG_WAIT_L(n) asm volatile("s_waitcnt lgkmcnt(" #n ")" ::: "memory")
#define PG_BAR __builtin_amdgcn_s_barrier()
#define PG_SCHED __builtin_amdgcn_sched_barrier(0)
    UnitG cur, nxt; int ui = 0;
    if (!S.next(0, cur)) return;
    Acc acc;
#pragma unroll
    for (int a = 0; a < 2; ++a)
#pragma unroll
        for (int b = 0; b < 2; ++b)
#pragma unroll
            for (int m = 0; m < 4; ++m)
#pragma unroll
                for (int n = 0; n < 2; ++n) acc[a][b][m][n] = (f32x4){0.f, 0.f, 0.f, 0.f};
    bf16x8 At[4][2], B0[2][2], B1[2][2];
    const char* cA = cur.A; const char* cB = cur.B; unsigned clda = cur.lda, cldb = cur.ldb;
    PG_STAGE(PG_SB(0, 0), cB, cldb); PG_STAGE(PG_SB(0, 1), cB + (size_t)HALF * cldb, cldb); PG_STAGE(PG_SA(0, 0), cA, clda); PG_STAGE(PG_SA(0, 1), cA + (size_t)HALF * clda, clda);
    if (wr == 1) PG_BAR;
    PG_WAIT_V(2); PG_BAR;
    PG_STAGE(PG_SB(1, 0), cB + 128, cldb); PG_STAGE(PG_SA(1, 0), cA + 128, clda); PG_STAGE(PG_SB(1, 1), cB + (size_t)HALF * cldb + 128, cldb);
    PG_WAIT_V(6); PG_BAR;
    for (;;) {
        const bool has_next = S.next(ui + 1, nxt);
        const char* nA = has_next ? nxt.A : cA; const char* nB = has_next ? nxt.B : cB;
        const unsigned nlda = has_next ? nxt.lda : clda, nldb = has_next ? nxt.ldb : cldb;
        const int nt = cur.nt;
        for (int t = 0; t < nt; t += 2) {
            const bool last = (t == nt - 2);
            const char* a1 = cA + (size_t)(t + 1) * 128;
            const char* a2 = last ? nA : cA + (size_t)(t + 2) * 128; const char* b2 = last ? nB : cB + (size_t)(t + 2) * 128;
            const unsigned lda2 = last ? nlda : clda, ldb2 = last ? nldb : cldb;
            const char* a3 = a2 + 128; const char* b3 = b2 + 128;
            PG_LDB(B0, 0, 0); PG_LDB(B1, 0, 1); PG_SCHED; PG_LDA(At, 0, 0); PG_STAGE(PG_SA(1, 1), a1 + (size_t)HALF * clda, clda);
            PG_WAIT_V(8); PG_WAIT_L(0); PG_BAR; PG_MMA(0, 0, At, B0); PG_MMA(0, 1, At, B1); PG_BAR; PG_SCHED;
            PG_LDA(At, 0, 1); PG_STAGE(PG_SB(0, 0), b2, ldb2); PG_STAGE(PG_SB(0, 1), b2 + (size_t)HALF * ldb2, ldb2); PG_STAGE(PG_SA(0, 0), a2, lda2);
            PG_WAIT_V(8); PG_WAIT_L(0); PG_BAR; PG_MMA(1, 0, At, B0); PG_MMA(1, 1, At, B1); PG_BAR; PG_SCHED;
            PG_LDB(B0, 1, 0); PG_LDB(B1, 1, 1); PG_SCHED; PG_LDA(At, 1, 0); PG_STAGE(PG_SA(0, 1), a2 + (size_t)HALF * lda2, lda2);
            PG_WAIT_V(8); PG_WAIT_L(0); PG_BAR; PG_MMA(0, 0, At, B0); PG_MMA(0, 1, At, B1); PG_BAR; PG_SCHED;
            PG_LDA(At, 1, 1); PG_STAGE(PG_SB(1, 0), b3, ldb2); PG_STAGE(PG_SB(1, 1), b3 + (size_t)HALF * ldb2, ldb2); PG_STAGE(PG_SA(1, 0), a3, lda2);
            PG_WAIT_V(8); PG_WAIT_L(0); PG_BAR; PG_MMA(1, 0, At, B0); PG_MMA(1, 1, At, B1); PG_BAR; PG_SCHED;
        }
        if (wr == 0) PG_BAR;
        E(acc, cur, lds, wr, wc, fr, fq);
        if (!has_next) break;
#pragma unroll
        for (int a = 0; a < 2; ++a)
#pragma unroll
            for (int b = 0; b < 2; ++b)
#pragma unroll
                for (int m = 0; m < 4; ++m)
#pragma unroll
                    for (int n = 0; n < 2; ++n) acc[a][b][m][n] = (f32x4){0.f, 0.f, 0.f, 0.f};
        cur = nxt; cA = nA; cB = nB; clda = nlda; cldb = nldb; ++ui;
        if (wr == 1) PG_BAR;
    }
    PG_WAIT_V(0);
    PG_BAR;
#undef PG_SA
#undef PG_SB
#undef PG_STAGE
#undef PG_LDA
#undef PG_LDB
#undef PG_MMA
#undef PG_WAIT_V
#undef PG_WAIT_L
#undef PG_BAR
#undef PG_SCHED
}
}

struct MArgs { const float* in[24]; float* out; unsigned char* ws; int ph_lo, ph_hi, li, pad; };
struct Frame {
    LAS unsigned char* lds; int tid, lane, wave; int x, j, vcu, G;
    const MArgs* a; float* out; unsigned char* ws;
};
#define FIN(k) (F.a->in[k])
__device__ __forceinline__ float fwave_sum(float v) {
#pragma unroll
    for (int o = 1; o < 64; o <<= 1) v += __shfl_xor(v, o);
    return v;
}

enum { W_IN = 0, W_QUP, W_KVUP, W_OBA, W_OBB, W_OUT, W_UP, W_DOWN };
__device__ __forceinline__ int win_src(int gd) {
    const int tile = gd >> 3, g = gd & 7, bj = g >> 2, wc = g & 3;
    if (tile < 3) return C_QLAT + gd * 32;
    if (tile < 5) return C_KVLAT + (gd - 24) * 32;
    if (tile == 5) return (wc == 0) ? C_KPE + bj * 32 : -1;
    if (tile < 10) { const int base = tile < 8 ? C_RQ : C_RK, tl = tile < 8 ? tile - 6 : tile - 8; const int head = 2 * tl + (wc >> 1); return base + head * 128 + bj * 64 + (wc & 1) * 32; }
    if (tile < 14) return C_RV + (gd - 80) * 32;
    if (tile < 18) return C_RG + (gd - 112) * 32;
    if (tile < 22) return C_GA + (gd - 144) * 32;
    return C_GB + (gd - 176) * 32;
}
__device__ __forceinline__ int w_src_col(int wid, int row) {
    const int rho = row & 31, gd = row >> 5, p = pg::perm32(rho);
    const int s = row & 255, bj = s >> 7, wc = (s >> 5) & 3, t = row >> 8;
    switch (wid) {
    case W_IN: { const int b = win_src(gd); return b < 0 ? -1 : b + p; }
    case W_QUP: if (bj == 0) return t * 192 + 32 * wc + p; else { if (wc >= 2) return -1; const int n = rho >> 4, i = rho & 15; return t * 192 + 128 + 16 * wc + i + 32 * n; }
    case W_KVUP: return t * 256 + 128 * bj + 32 * wc + p;
    case W_UP: return (bj ? D_FF : 0) + 128 * t + 32 * wc + p;
    default: return gd * 32 + p;
    }
}
__device__ __forceinline__ void p0_weight_item(const float* __restrict__ W, int ldw, int K, const float* __restrict__ gain, int wid, bf16_t* __restrict__ Wt, int gd, int kb, LAS float* scr, int lane) {
    const int k0 = kb * 64; const int sc = w_src_col(wid, gd * 32 + (lane & 31));
    bf16_t* dst = Wt + (size_t)(gd * 32) * K + k0;
#pragma unroll 8
    for (int i = 0; i < 32; ++i) { const int kk = 2 * i + (lane >> 5); const float g = gain ? gain[k0 + kk] : 1.f; scr[kk * 33 + (lane & 31)] = sc < 0 ? 0.f : W[(size_t)(k0 + kk) * ldw + sc] * g; }
    asm volatile("s_waitcnt lgkmcnt(0)" ::: "memory");
    const int c = lane & 7;
#pragma unroll
    for (int jj = 0; jj < 4; ++jj) { const int n = (lane >> 3) + 8 * jj; const LAS float* s = scr + (8 * c) * 33 + n;
        u32x4 o; o.x = cvt_pk_bf16(s[0 * 33], s[1 * 33]); o.y = cvt_pk_bf16(s[2 * 33], s[3 * 33]); o.z = cvt_pk_bf16(s[4 * 33], s[5 * 33]); o.w = cvt_pk_bf16(s[6 * 33], s[7 * 33]);
        *(u32x4*)(dst + (size_t)n * K + 8 * c) = o; }
    asm volatile("s_waitcnt lgkmcnt(0)" ::: "memory");
}
__device__ __forceinline__ void p0_weights(Frame& F, LAS float* scr, int gw, int NGW, const float* W, int ldw, int K, const float* gain, int wid, size_t off, int ngroups) {
    const int nkb = K / 64; bf16_t* Wt = (bf16_t*)(F.ws + off);
    for (int it = gw; it < ngroups * nkb; it += NGW) { const int gd = it / nkb, kb = it % nkb; p0_weight_item(W, ldw, K, gain, wid, Wt, gd, kb, scr, F.lane); }
}
__device__ __forceinline__ void p0_prologue(Frame& F) {
    LAS float* scr = (LAS float*)(F.lds + F.wave * 16384);
    const int gw = F.vcu * 8 + F.wave, NGW = F.G * 8;
    p0_weights(F, scr, gw, NGW, FIN(7), IN_W, 1024, FIN(6), W_IN, WS_FWIN, 26 * 8);
    p0_weights(F, scr, gw, NGW, FIN(9), 1536, 768, FIN(8), W_QUP, WS_FWQUP, 8 * 8);
    p0_weights(F, scr, gw, NGW, FIN(13), 2048, 512, nullptr, W_KVUP, WS_FWKVUP, 8 * 8);
    p0_weights(F, scr, gw, NGW, FIN(17), 1024, 1024, nullptr, W_OBA, WS_FWOBA, 4 * 8);
    p0_weights(F, scr, gw, NGW, FIN(17) + (size_t)1024 * 1024, 1024, 1024, nullptr, W_OBB, WS_FWOBB, 4 * 8);
    p0_weights(F, scr, gw, NGW, FIN(18), 1024, 1024, nullptr, W_OUT, WS_FWOUT, 4 * 8);
    p0_weights(F, scr, gw, NGW, FIN(20), FF2, 1024, FIN(19), W_UP, WS_FWUP, 22 * 8);
    p0_weights(F, scr, gw, NGW, FIN(23), 1024, D_FF, nullptr, W_DOWN, WS_FWDOWN, 4 * 8);
    {   bf16_t* XN = (bf16_t*)(F.ws + WS_XN);
        for (int r = gw; r < MPAD; r += NGW) {
            u32x2* o8 = (u32x2*)(XN + (size_t)r * D_MODEL) + F.lane;
            if (r >= MT) { for (int jj = 0; jj < 4; ++jj) o8[64 * jj] = (u32x2){0u, 0u}; continue; }
            const float* x = r < MP ? FIN(0) + (size_t)r * D_MODEL : FIN(1) + (size_t)(r - MP) * D_MODEL;
            const f32x4* xr = (const f32x4*)x + F.lane; f32x4 v[4]; float s = 0.f;
#pragma unroll
            for (int jj = 0; jj < 4; ++jj) { v[jj] = xr[64 * jj]; s += (v[jj][0] * v[jj][0] + v[jj][1] * v[jj][1]) + (v[jj][2] * v[jj][2] + v[jj][3] * v[jj][3]); }
            const float inv = rsqrtf(fwave_sum(s) * (1.f / D_MODEL) + EPS);
#pragma unroll
            for (int jj = 0; jj < 4; ++jj) { u32x2 w; w.x = cvt_pk_bf16(v[jj][0] * inv, v[jj][1] * inv); w.y = cvt_pk_bf16(v[jj][2] * inv, v[jj][3] * inv); o8[64 * jj] = w; }
        } }
    {   bf16_t* lats = (bf16_t*)(F.ws + WS_LATS); bf16_t* pes = (bf16_t*)(F.ws + WS_PES);
        const int gt = F.vcu * NTHR + F.tid, NG = F.G * NTHR;
        for (int i = gt; i < DEC_BATCH * PAST * (KV_LORA / 4); i += NG) { const int c4 = i % (KV_LORA / 4), rj = i / (KV_LORA / 4), jr = rj % PAST, b = rj / PAST;
            const f32x4 v = *((const f32x4*)FIN(2) + i); u32x2 w; w.x = cvt_pk_bf16(v[0], v[1]); w.y = cvt_pk_bf16(v[2], v[3]);
            *(u32x2*)(lats + ((size_t)b * SKEYS + jr) * KV_LORA + c4 * 4) = w; }
        for (int i = gt; i < DEC_BATCH * PAST * (QK_ROPE / 4); i += NG) { const int c4 = i % (QK_ROPE / 4), rj = i / (QK_ROPE / 4), jr = rj % PAST, b = rj / PAST;
            const f32x4 v = *((const f32x4*)FIN(3) + i); u32x2 w; w.x = cvt_pk_bf16(v[0], v[1]); w.y = cvt_pk_bf16(v[2], v[3]);
            *(u32x2*)(pes + ((size_t)b * SKEYS + jr) * QK_ROPE + c4 * 4) = w; }
        float2* tab32 = (float2*)(F.ws + WS_TAB32); float2* tab64 = (float2*)(F.ws + WS_TAB64);
        for (int i = gt; i < 8192 * 64; i += NG) {
            { const int pos = i / 64, k = i % 64; const double f = pow(10000.0, -(double)k / 64.0), a = (double)pos * f; tab64[i] = make_float2((float)cos(a), (float)sin(a)); }
            if (i < 8192 * 32) { const int pos = i / 32, k = i % 32; const double f = pow(10000.0, -(double)k / 32.0), a = (double)pos * f; tab32[i] = make_float2((float)cos(a), (float)sin(a)); }
        } }
}

__device__ __forceinline__ bool reg_unit(int x, int j, int i, int nN, int& pm, int& pn) { const int u = j + 32 * i; if (u >= 8 * nN) return false; pm = 8 * x + (u & 7); pn = u >> 3; return true; }
#define LDS_F(off) ((LAS float*)(lds + EPI_OFF) + (off))

enum { K_QLAT = 0, K_KVLAT, K_KPE, K_RQ, K_RK, K_RV, K_RG, K_QUP, K_KVP, K_KVS, K_GA, K_AD, K_GB, K_RD, K_OUT, K_UP, K_DOWN };
struct SchedP1 {
    int x, j; const char* ws;
    __device__ __forceinline__ bool next(int i, pg::UnitG& u) const {
        int pm, pn;
        if (!reg_unit(x, j, i, 18, pm, pn)) { if (i == 4 && j >= 16) { const int k = (j - 16) * 8 + x; if (k >= 18) return false; pm = 64; pn = k; } else return false; }
        u.pm = pm; u.pn = pn; u.A = ws + WS_XN + (size_t)pm * 256 * 2048; u.B = ws + WS_FWIN + (size_t)pn * 256 * 2048; u.lda = 2048; u.ldb = 2048; u.nt = 16;
        u.kind = pn < 3 ? K_QLAT : pn < 5 ? K_KVLAT : pn == 5 ? K_KPE : pn < 8 ? K_RQ : pn < 10 ? K_RK : pn < 14 ? K_RV : K_RG;
        return true;
    }
};
struct EpiP1 {
    unsigned char* ws; float* out; const float *g_kvlat, *g_kr;
    __device__ __forceinline__ void operator()(const pg::Acc& acc, const pg::UnitG& u, LAS unsigned char* lds, int wr, int wc, int fr, int fq) const {
        bf16_t* const ZQ = (bf16_t*)(ws + WS_ZQ); bf16_t* const KVL = (bf16_t*)(ws + WS_KVL); bf16_t* const KPE = (bf16_t*)(ws + WS_KPE); bf16_t* const PES = (bf16_t*)(ws + WS_PES); bf16_t* const LATS = (bf16_t*)(ws + WS_LATS);
        bf16_t* const RQ = (bf16_t*)(ws + WS_RQ); bf16_t* const RK = (bf16_t*)(ws + WS_RK); bf16_t* const RV = (bf16_t*)(ws + WS_RV); bf16_t* const RG = (bf16_t*)(ws + WS_RG);
        float* const slotq = (float*)(ws + WS_SLOTQ); float* const slotkv = (float*)(ws + WS_SLOTKV);
        const float2* const tab32 = (const float2*)(ws + WS_TAB32); const float2* const tab64 = (const float2*)(ws + WS_TAB64);
        int rl0 = wr * 64 + fr, cw = wc * 32 + fq * 8; asm volatile("" : "+v"(rl0), "+v"(cw));
        const int kind = u.kind, rb = u.pm * 256 + rl0;
        if (kind == K_QLAT || kind == K_KVLAT) {
            const int t = kind == K_QLAT ? u.pn : u.pn - 3; const int ld = kind == K_QLAT ? Q_LORA : KV_LORA; bf16_t* dst = kind == K_QLAT ? ZQ : KVL;
            f32x4 g[2][2];
#pragma unroll
            for (int bj = 0; bj < 2; ++bj)
#pragma unroll
                for (int n = 0; n < 2; ++n) g[bj][n] = kind == K_KVLAT ? *(const f32x4*)(g_kvlat + t * 256 + bj * 128 + cw + 4 * n) : (f32x4){1.f, 1.f, 1.f, 1.f};
#pragma unroll
            for (int ai = 0; ai < 2; ++ai)
#pragma unroll
                for (int m = 0; m < 4; ++m) { const int row = rb + ai * 128 + m * 16; float ss = 0.f;
                    const bool snew = (kind == K_KVLAT) && row >= MP && row < MT;
                    const int rs = row - MP; bf16_t* lrow = LATS + ((size_t)(rs / DEC_SEQ) * SKEYS + PAST + (rs % DEC_SEQ)) * KV_LORA;
#pragma unroll
                    for (int bj = 0; bj < 2; ++bj) { const f32x4 v0 = acc[ai][bj][m][0], v1 = acc[ai][bj][m][1];
                        ss += (v0[0] * v0[0] + v0[1] * v0[1]) + (v0[2] * v0[2] + v0[3] * v0[3]) + (v1[0] * v1[0] + v1[1] * v1[1]) + (v1[2] * v1[2] + v1[3] * v1[3]);
                        const u32x4 w = pack8f(v0 * g[bj][0], v1 * g[bj][1]);
                        *(u32x4*)(dst + (size_t)row * ld + t * 256 + bj * 128 + cw) = w;
                        if (snew) *(u32x4*)(lrow + t * 256 + bj * 128 + cw) = w; }
                    ss += __shfl_xor(ss, 16); ss += __shfl_xor(ss, 32);
                    if (fq == 0) { if (kind == K_QLAT) slotq[(size_t)row * 12 + t * 4 + wc] = ss; else slotkv[(size_t)row * 8 + t * 4 + wc] = ss; } }
        } else if (kind == K_KPE) {
            if (wc != 0) return;
            const int d0 = fq * 8;
            f32x4 g1[2], g2[2];
#pragma unroll
            for (int n = 0; n < 2; ++n) { g1[n] = *(const f32x4*)(g_kr + d0 + 4 * n); g2[n] = *(const f32x4*)(g_kr + 32 + d0 + 4 * n); }
#pragma unroll
            for (int ai = 0; ai < 2; ++ai)
#pragma unroll
                for (int m = 0; m < 4; ++m) { const int row = rb + ai * 128 + m * 16; const int pos = row_pos(row < MT ? row : 0);
                    f32x4 x1[2], x2[2]; float ss = 0.f;
#pragma unroll
                    for (int n = 0; n < 2; ++n) { x1[n] = acc[ai][0][m][n]; x2[n] = acc[ai][1][m][n];
                        ss += (x1[n][0] * x1[n][0] + x1[n][1] * x1[n][1]) + (x1[n][2] * x1[n][2] + x1[n][3] * x1[n][3]) + (x2[n][0] * x2[n][0] + x2[n][1] * x2[n][1]) + (x2[n][2] * x2[n][2] + x2[n][3] * x2[n][3]); }
                    ss += __shfl_xor(ss, 16); ss += __shfl_xor(ss, 32);
                    const float inv = rsqrtf(ss * (1.f / 64.f) + EPS);
                    f32x4 o1[2], o2[2];
#pragma unroll
                    for (int n = 0; n < 2; ++n) { const f32x4 y1 = x1[n] * inv * g1[n], y2 = x2[n] * inv * g2[n];
                        const f32x4 cs0 = *(const f32x4*)(tab32 + pos * 32 + d0 + 4 * n), cs1 = *(const f32x4*)(tab32 + pos * 32 + d0 + 4 * n + 2);
                        const f32x4 c = {cs0[0], cs0[2], cs1[0], cs1[2]}, s = {cs0[1], cs0[3], cs1[1], cs1[3]};
                        o1[n] = y1 * c - y2 * s; o2[n] = y1 * s + y2 * c; }
                    *(u32x4*)(KPE + (size_t)row * 64 + d0) = pack8f(o1[0], o1[1]); *(u32x4*)(KPE + (size_t)row * 64 + 32 + d0) = pack8f(o2[0], o2[1]);
                    if (row < MT) {
                        float* o = row < MP ? out + O_RKP + (size_t)row * 64 : out + O_RKS + (size_t)(row - MP) * 64;
                        *(f32x4*)(o + d0) = o1[0]; *(f32x4*)(o + d0 + 4) = o1[1]; *(f32x4*)(o + 32 + d0) = o2[0]; *(f32x4*)(o + 32 + d0 + 4) = o2[1];
                        if (row >= MP) { const int rs = row - MP, b = rs / DEC_SEQ, tt = rs % DEC_SEQ; bf16_t* p = PES + ((size_t)b * SKEYS + PAST + tt) * 64;
                            *(u32x4*)(p + d0) = pack8f(o1[0], o1[1]); *(u32x4*)(p + 32 + d0) = pack8f(o2[0], o2[1]); } } }
        } else if (kind == K_RQ || kind == K_RK) {
            const int tl = kind == K_RQ ? u.pn - 6 : u.pn - 8; const int head = 2 * tl + (wc >> 1), i0 = 32 * (wc & 1) + fq * 8;
            bf16_t* dst = kind == K_RQ ? RQ : RK; const float sc = kind == K_RQ ? 1.0f : 0.08838834764831845f;
#pragma unroll
            for (int ai = 0; ai < 2; ++ai)
#pragma unroll
                for (int m = 0; m < 4; ++m) { const int row = rb + ai * 128 + m * 16; const int pos = row_pos(row < MT ? row : 0);
                    f32x4 o1[2], o2[2];
#pragma unroll
                    for (int n = 0; n < 2; ++n) { const f32x4 x1 = acc[ai][0][m][n], x2 = acc[ai][1][m][n];
                        const f32x4 cs0 = *(const f32x4*)(tab64 + pos * 64 + i0 + 4 * n), cs1 = *(const f32x4*)(tab64 + pos * 64 + i0 + 4 * n + 2);
                        const f32x4 c = {cs0[0], cs0[2], cs1[0], cs1[2]}, s = {cs0[1], cs0[3], cs1[1], cs1[3]};
                        o1[n] = (x1 * c - x2 * s) * sc; o2[n] = (x1 * s + x2 * c) * sc; }
                    *(u32x4*)(dst + (size_t)row * 512 + head * 128 + i0) = pack8f(o1[0], o1[1]); *(u32x4*)(dst + (size_t)row * 512 + head * 128 + 64 + i0) = pack8f(o2[0], o2[1]); }
        } else {
            const int t = kind == K_RV ? u.pn - 10 : u.pn - 14; bf16_t* dst = kind == K_RV ? RV : RG;
#pragma unroll
            for (int ai = 0; ai < 2; ++ai)
#pragma unroll
                for (int m = 0; m < 4; ++m) { const int row = rb + ai * 128 + m * 16;
#pragma unroll
                    for (int bj = 0; bj < 2; ++bj) { f32x4 v0 = acc[ai][bj][m][0], v1 = acc[ai][bj][m][1];
                        if (kind == K_RG) {
#pragma unroll
                            for (int e = 0; e < 4; ++e) { v0[e] = v0[e] / (1.f + __expf(-v0[e])); v1[e] = v1[e] / (1.f + __expf(-v1[e])); } }
                        *(u32x4*)(dst + (size_t)row * 1024 + t * 256 + bj * 128 + cw) = pack8f(v0, v1); } }
        }
    }
};
__device__ __forceinline__ void p1_inproj(Frame& F) {
    SchedP1 S{F.x, F.j, (const char*)F.ws};
    EpiP1 E{F.ws, F.out, FIN(12), FIN(15)};
    pg::gemm_stream(F.lds, S, E);
}

__device__ __forceinline__ float slot_rs(const float* slots, int n, float invn) {
    float a = 0.f; for (int i = 0; i < n; i += 4) { const f32x4 v = *(const f32x4*)(slots + i); a += (v[0] + v[1]) + (v[2] + v[3]); } return rsqrtf(a * invn + EPS);
}
struct SchedP2 {
    int x, j; const char* ws; int sample;
    __device__ __forceinline__ bool next(int i, pg::UnitG& u) const {
        int pm, pn, kind;
        if (sample) {
            if (i < 2) { reg_unit(x, j, i, 8, pm, pn); kind = K_QUP; }
            else if (i < 4) { reg_unit(x, j, i - 2, 8, pm, pn); kind = K_KVS; }
            else if (i == 4 && j < 2) { const int k = j * 8 + x; pm = 64; pn = k & 7; kind = k < 8 ? K_QUP : K_KVS; }
            else return false;
        } else { if (i >= 2) return false; reg_unit(x, j, i, 8, pm, pn); kind = K_KVP; }
        u.pm = pm; u.pn = pn; u.kind = kind;
        if (kind == K_QUP) { u.A = ws + WS_ZQ + (size_t)pm * 256 * 1536; u.lda = 1536; u.B = ws + WS_FWQUP + (size_t)pn * 256 * 1536; u.ldb = 1536; u.nt = 12; }
        else { u.A = ws + (kind == K_KVS ? WS_LATS : WS_KVL) + (size_t)pm * 256 * 1024; u.lda = 1024; u.B = ws + WS_FWKVUP + (size_t)pn * 256 * 1024; u.ldb = 1024; u.nt = 8; }
        return true;
    }
};
struct EpiP2 {
    unsigned char* ws; float* out; const float *g_qn, *g_qr, *g_kn;
    __device__ __forceinline__ void operator()(const pg::Acc& acc, const pg::UnitG& u, LAS unsigned char* lds, int wr, int wc, int fr, int fq) const {
        int rl0 = wr * 64 + fr, cw = wc * 32 + fq * 8; asm volatile("" : "+v"(rl0), "+v"(cw));
        const int kind = u.kind, h = u.pn, rb = u.pm * 256 + rl0;
        const float* const slotq = (const float*)(ws + WS_SLOTQ); const float* const slotkv = (const float*)(ws + WS_SLOTKV);
        float rs[2][4];
#pragma unroll
        for (int ai = 0; ai < 2; ++ai)
#pragma unroll
            for (int m = 0; m < 4; ++m) { const int row = rb + ai * 128 + m * 16;
                if (kind == K_QUP) rs[ai][m] = slot_rs(slotq + (size_t)row * 12, 12, 1.f / Q_LORA);
                else if (kind == K_KVP) rs[ai][m] = slot_rs(slotkv + (size_t)row * 8, 8, 1.f / KV_LORA);
                else { const int b = row / SKEYS, jj = row - b * SKEYS; rs[ai][m] = (row < LROWS && jj >= PAST) ? slot_rs(slotkv + (size_t)(MP + b * DEC_SEQ + jj - PAST) * 8, 8, 1.f / KV_LORA) : 1.f; } }
#pragma unroll
        for (int ai = 0; ai < 2; ++ai)
#pragma unroll
            for (int m = 0; m < 4; ++m) { float p0 = 0.f, p1 = 0.f; const float s2 = rs[ai][m] * rs[ai][m];
#pragma unroll
                for (int n = 0; n < 2; ++n) { const f32x4 a = acc[ai][0][m][n], b = acc[ai][1][m][n];
                    p0 += (a[0] * a[0] + a[1] * a[1]) + (a[2] * a[2] + a[3] * a[3]); p1 += (b[0] * b[0] + b[1] * b[1]) + (b[2] * b[2] + b[3] * b[3]); }
                p0 += __shfl_xor(p0, 16); p0 += __shfl_xor(p0, 32); p1 += __shfl_xor(p1, 16); p1 += __shfl_xor(p1, 32);
                if (fq == 0) { LAS float* d = LDS_F((rl0 + ai * 128 + m * 16) * 8 + wc * 2); d[0] = p0 * s2; d[1] = p1 * s2; } }
        asm volatile("s_waitcnt lgkmcnt(0)" ::: "memory"); __builtin_amdgcn_s_barrier(); asm volatile("" ::: "memory");
        if (kind == K_QUP) {
            bf16_t* const Q = (bf16_t*)out;
            const float2* const tab32 = (const float2*)(ws + WS_TAB32);
            const float C2 = 0.07216878364870323f * 1.4426950408889634f;
            f32x4 gn[2]; gn[0] = *(const f32x4*)(g_qn + cw); gn[1] = *(const f32x4*)(g_qn + cw + 4);
            const int ir = 16 * (wc & 1) + 4 * fq; const f32x4 gr1 = *(const f32x4*)(g_qr + ir), gr2 = *(const f32x4*)(g_qr + 32 + ir);
#pragma unroll
            for (int ai = 0; ai < 2; ++ai)
#pragma unroll
                for (int m = 0; m < 4; ++m) { const int row = rb + ai * 128 + m * 16; const int pos = row_pos(row < MT ? row : 0);
                    const LAS float* d = LDS_F((rl0 + ai * 128 + m * 16) * 8); const f32x4 e0 = *(const LAS f32x4*)d, e1 = *(const LAS f32x4*)(d + 4);
                    const float inn = rsqrtf((e0[0] + e0[2] + e1[0] + e1[2]) * (1.f / 128.f) + EPS) * rs[ai][m] * C2, inr = rsqrtf((e0[1] + e0[3]) * (1.f / 64.f) + EPS) * rs[ai][m];
                    bf16_t* qrow = Q + (size_t)row * 1536 + h * 192;
                    *(u32x4*)(qrow + cw) = pack8f(acc[ai][0][m][0] * inn * gn[0], acc[ai][0][m][1] * inn * gn[1]);
                    if (wc < 2) { const f32x4 y1 = acc[ai][1][m][0] * inr * gr1, y2 = acc[ai][1][m][1] * inr * gr2;
                        const f32x4 cs0 = *(const f32x4*)(tab32 + pos * 32 + ir), cs1 = *(const f32x4*)(tab32 + pos * 32 + ir + 2);
                        const f32x4 c = {cs0[0], cs0[2], cs1[0], cs1[2]}, s = {cs0[1], cs0[3], cs1[1], cs1[3]};
                        const f32x4 o1 = (y1 * c - y2 * s) * C2, o2 = (y1 * s + y2 * c) * C2;
                        u32x2 w1, w2; w1.x = cvt_pk_bf16(o1[0], o1[1]); w1.y = cvt_pk_bf16(o1[2], o1[3]); w2.x = cvt_pk_bf16(o2[0], o2[1]); w2.y = cvt_pk_bf16(o2[2], o2[3]);
                        *(u32x2*)(qrow + 128 + ir) = w1; *(u32x2*)(qrow + 160 + ir) = w2; } }
        } else {
            bf16_t* const KN = (bf16_t*)(ws + WS_KN); bf16_t* const V = (bf16_t*)(ws + WS_V);
            f32x4 gk[2]; gk[0] = *(const f32x4*)(g_kn + cw); gk[1] = *(const f32x4*)(g_kn + cw + 4);
#pragma unroll
            for (int ai = 0; ai < 2; ++ai)
#pragma unroll
                for (int m = 0; m < 4; ++m) { const int row = rb + ai * 128 + m * 16;
                    const LAS float* d = LDS_F((rl0 + ai * 128 + m * 16) * 8); const f32x4 e0 = *(const LAS f32x4*)d, e1 = *(const LAS f32x4*)(d + 4);
                    const float s = rs[ai][m], inn = rsqrtf((e0[0] + e0[2] + e1[0] + e1[2]) * (1.f / 128.f) + EPS) * s;
                    *(u32x4*)(KN + (size_t)row * 1024 + h * 128 + cw) = pack8f(acc[ai][0][m][0] * inn * gk[0], acc[ai][0][m][1] * inn * gk[1]);
                    *(u32x4*)(V + (size_t)row * 1024 + h * 128 + cw) = pack8f(acc[ai][1][m][0] * s, acc[ai][1][m][1] * s); }
        }
    }
};
__device__ __forceinline__ void p2_qkv(Frame& F, int sample) {
    SchedP2 S{F.x, F.j, (const char*)F.ws, sample};
    EpiP2 E{F.ws, F.out, FIN(10), FIN(11), FIN(14)};
    pg::gemm_stream(F.lds, S, E);
}

struct SchedP5 {
    int x, j, vcu; const char* ws; int phase;
    __device__ __forceinline__ const char* arow(size_t base, size_t base_s, int pm, size_t rowbytes) const { return ws + (pm < 64 ? base + (size_t)pm * 256 * rowbytes : base_s); }
    __device__ __forceinline__ bool next(int i, pg::UnitG& u) const {
        int pm, pn;
        if (phase == 5) {
            const int sub = i & 3, tile = i >> 2;
            if (tile == 0) { pm = 8 * x + (j & 7); pn = j >> 3; } else if (tile == 1 && j == 0 && x < 4) { pm = 64; pn = x; } else return false;
            u.pm = pm; u.pn = pn; u.kind = K_GA + sub; u.lda = 2048; u.ldb = 2048; u.nt = 16;
            if (sub == 0) { u.A = ws + WS_XN2 + (size_t)pm * 256 * 2048; u.B = ws + WS_FWIN + (size_t)(18 + pn) * 256 * 2048; }
            else if (sub == 1) { u.A = arow(WS_ATT, WS_ATTS, pm, 2048); u.B = ws + WS_FWOBA + (size_t)pn * 256 * 2048; }
            else if (sub == 2) { u.A = ws + WS_XN2 + (size_t)pm * 256 * 2048; u.B = ws + WS_FWIN + (size_t)(22 + pn) * 256 * 2048; }
            else { u.A = ws + WS_RET + (size_t)pm * 256 * 2048; u.B = ws + WS_FWOBB + (size_t)pn * 256 * 2048; }
            return true;
        }
        if (phase == 6 || phase == 9) {
            if (i == 0) { pm = 8 * x + (j & 7); pn = j >> 3; } else if (i == 1 && j == 0 && x < 4) { pm = 64; pn = x; } else return false;
            u.pm = pm; u.pn = pn;
            if (phase == 6) { u.kind = K_OUT; u.A = ws + WS_MERGED + (size_t)pm * 256 * 2048; u.lda = 2048; u.B = ws + WS_FWOUT + (size_t)pn * 256 * 2048; u.ldb = 2048; u.nt = 16; }
            else { u.kind = K_DOWN; u.A = ws + WS_U + (size_t)pm * 256 * (FF2 * 2); u.lda = FF2 * 2; u.B = ws + WS_FWDOWN + (size_t)pn * 256 * (D_FF * 2); u.ldb = D_FF * 2; u.nt = 44; }
            return true;
        }
        if (!reg_unit(x, j, i, 22, pm, pn)) { if (i == 5 && j >= 16) { const int k = (j - 16) * 8 + x; if (k >= 22) return false; pm = 64; pn = k; } else return false; }
        u.pm = pm; u.pn = pn; u.kind = K_UP; u.A = ws + WS_X1B + (size_t)pm * 256 * 2048; u.lda = 2048; u.B = ws + WS_FWUP + (size_t)pn * 256 * 2048; u.ldb = 2048; u.nt = 16;
        return true;
    }
};
struct EpiP5 {
    unsigned char* ws; float* out; const float* xp; const float* xs; int vcu;
    __device__ __forceinline__ void operator()(pg::Acc& acc, const pg::UnitG& u, LAS unsigned char* lds, int wr, int wc, int fr, int fq) const {
        int rl0 = wr * 64 + fr, cw = wc * 32 + fq * 8; asm volatile("" : "+v"(rl0), "+v"(cw));
        const int kind = u.kind, rb = u.pm * 256 + rl0;
        if (kind >= K_GA && kind <= K_RD) {
            bf16_t* const T1 = (bf16_t*)(ws + WS_T1) + (size_t)vcu * 65536; bf16_t* const T2 = (bf16_t*)out + (size_t)vcu * 65536;
            bf16_t* const MG = (bf16_t*)(ws + WS_MERGED);
#pragma unroll
            for (int ai = 0; ai < 2; ++ai)
#pragma unroll
                for (int m = 0; m < 4; ++m)
#pragma unroll
                    for (int bj = 0; bj < 2; ++bj) { const size_t so = (size_t)(rl0 + ai * 128 + m * 16) * 256 + bj * 128 + cw;
                        f32x4 v0 = acc[ai][bj][m][0], v1 = acc[ai][bj][m][1];
                        if (kind == K_GA || kind == K_GB) {
#pragma unroll
                            for (int e = 0; e < 4; ++e) { v0[e] = 1.f / (1.f + __expf(-v0[e])); v1[e] = 1.f / (1.f + __expf(-v1[e])); }
                            *(u32x4*)((kind == K_GA ? T1 : T2) + so) = pack8f(v0, v1);
                        } else if (kind == K_AD) {
                            const u32x4 t = *(const u32x4*)(T1 + so);
                            const f32x4 g0 = {__uint_as_float(t.x << 16), __uint_as_float(t.x & 0xffff0000u), __uint_as_float(t.y << 16), __uint_as_float(t.y & 0xffff0000u)};
                            const f32x4 g1 = {__uint_as_float(t.z << 16), __uint_as_float(t.z & 0xffff0000u), __uint_as_float(t.w << 16), __uint_as_float(t.w & 0xffff0000u)};
                            *(u32x4*)(T1 + so) = pack8f(v0 * g0, v1 * g1);
                        } else {
                            const u32x4 t = *(const u32x4*)(T1 + so), q = *(const u32x4*)(T2 + so);
                            const f32x4 a0 = {__uint_as_float(t.x << 16), __uint_as_float(t.x & 0xffff0000u), __uint_as_float(t.y << 16), __uint_as_float(t.y & 0xffff0000u)};
                            const f32x4 a1 = {__uint_as_float(t.z << 16), __uint_as_float(t.z & 0xffff0000u), __uint_as_float(t.w << 16), __uint_as_float(t.w & 0xffff0000u)};
                            const f32x4 g0 = {__uint_as_float(q.x << 16), __uint_as_float(q.x & 0xffff0000u), __uint_as_float(q.y << 16), __uint_as_float(q.y & 0xffff0000u)};
                            const f32x4 g1 = {__uint_as_float(q.z << 16), __uint_as_float(q.z & 0xffff0000u), __uint_as_float(q.w << 16), __uint_as_float(q.w & 0xffff0000u)};
                            *(u32x4*)(MG + (size_t)(rb + ai * 128 + m * 16) * 1024 + u.pn * 256 + bj * 128 + cw) = pack8f(a0 + v0 * g0, a1 + v1 * g1);
                        }
                        if (bj == 1 && (m & 1)) asm volatile("" ::: "memory"); }
            if (kind != K_RD) asm volatile("s_waitcnt vmcnt(0)" ::: "memory");
        } else if (kind == K_OUT) {
            float* const slotx = (float*)(ws + WS_SLOTX1); bf16_t* const X1B = (bf16_t*)(ws + WS_X1B);
#pragma unroll
            for (int ai = 0; ai < 2; ++ai)
#pragma unroll
                for (int m = 0; m < 4; ++m) { const int row = rb + ai * 128 + m * 16; float ss = 0.f;
                    const float* xr = row < MP ? xp + (size_t)row * D_MODEL : xs + (size_t)((row < MT ? row : MP) - MP) * D_MODEL;
#pragma unroll
                    for (int bj = 0; bj < 2; ++bj) { const int c = u.pn * 256 + bj * 128 + cw;
                        const f32x4 x0 = *(const f32x4*)(xr + c), x1 = *(const f32x4*)(xr + c + 4);
                        const f32x4 v0 = acc[ai][bj][m][0] + x0, v1 = acc[ai][bj][m][1] + x1;
                        ss += (v0[0] * v0[0] + v0[1] * v0[1]) + (v0[2] * v0[2] + v0[3] * v0[3]) + (v1[0] * v1[0] + v1[1] * v1[1]) + (v1[2] * v1[2] + v1[3] * v1[3]);
                        if (row < MT) { *(f32x4*)(out + (size_t)row * D_MODEL + c) = v0; *(f32x4*)(out + (size_t)row * D_MODEL + c + 4) = v1; }
                        *(u32x4*)(X1B + (size_t)row * D_MODEL + c) = pack8f(v0, v1); }
                    ss += __shfl_xor(ss, 16); ss += __shfl_xor(ss, 32);
                    if (fq == 0) slotx[(size_t)row * 16 + u.pn * 4 + wc] = ss;
                    asm volatile("" ::: "memory"); }
        } else if (kind == K_UP) {
            const float* const slotx = (const float*)(ws + WS_SLOTX1); bf16_t* const U = (bf16_t*)(ws + WS_U);
#pragma unroll
            for (int ai = 0; ai < 2; ++ai)
#pragma unroll
                for (int m = 0; m < 4; ++m) { const int row = rb + ai * 128 + m * 16;
                    float a = 0.f;
#pragma unroll
                    for (int i = 0; i < 16; i += 4) { const f32x4 v = *(const f32x4*)(slotx + (size_t)row * 16 + i); a += (v[0] + v[1]) + (v[2] + v[3]); }
                    const float s = rsqrtf(a * (1.f / D_MODEL) + EPS);
                    *(u32x4*)(U + (size_t)row * FF2 + u.pn * 128 + cw) = pack8f(acc[ai][0][m][0] * s, acc[ai][0][m][1] * s);
                    *(u32x4*)(U + (size_t)row * FF2 + D_FF + u.pn * 128 + cw) = pack8f(acc[ai][1][m][0] * s, acc[ai][1][m][1] * s);
                    if (m & 1) asm volatile("" ::: "memory"); }
        } else {
#pragma unroll
            for (int ai = 0; ai < 2; ++ai)
#pragma unroll
                for (int m = 0; m < 4; ++m) { const int row = rb + ai * 128 + m * 16; if (row >= MT) continue;
#pragma unroll
                    for (int bj = 0; bj < 2; ++bj) { float* p = out + (size_t)row * D_MODEL + u.pn * 256 + bj * 128 + cw;
                        const f32x4 x0 = *(const f32x4*)p, x1 = *(const f32x4*)(p + 4);
                        *(f32x4*)p = x0 + acc[ai][bj][m][0]; *(f32x4*)(p + 4) = x1 + acc[ai][bj][m][1]; }
                    asm volatile("" ::: "memory"); }
        }
    }
};
__device__ __forceinline__ void p5_gemm(Frame& F, int phase) {
    SchedP5 S{F.x, F.j, F.vcu, (const char*)F.ws, phase};
    EpiP5 E{F.ws, F.out, FIN(0), FIN(1), F.vcu};
    pg::gemm_stream(F.lds, S, E);
}

namespace rt {
typedef short s16x4 __attribute__((ext_vector_type(4)));
constexpr int QST = 136, KDST = 144, VST = 272, PST = 72;
constexpr int Q_OFF = 0, QS_OFF = 17408, K_OFF = 34816, KD_OFF = 52224, V_OFF = 70656, P_OFF = 105472, ST_OFF = 114688;
constexpr int SC_TOK = 256, NSC = SEQ / SC_TOK;
__device__ __forceinline__ s16x4 trrd(const LAS bf16_t* p) { return __builtin_bit_cast(s16x4, __builtin_amdgcn_ds_read_tr16_b64_v4i16((LAS s16x4*)p)); }
__device__ __forceinline__ bf16x8 cat8(s16x4 lo, s16x4 hi) { return (bf16x8){lo[0], lo[1], lo[2], lo[3], hi[0], hi[1], hi[2], hi[3]}; }
__device__ __forceinline__ u32x4 scale8(u32x4 w, float s) {
    u32x4 o;
    o.x = cvt_pk_bf16(__uint_as_float(w.x << 16) * s, __uint_as_float(w.x & 0xffff0000u) * s); o.y = cvt_pk_bf16(__uint_as_float(w.y << 16) * s, __uint_as_float(w.y & 0xffff0000u) * s);
    o.z = cvt_pk_bf16(__uint_as_float(w.z << 16) * s, __uint_as_float(w.z & 0xffff0000u) * s); o.w = cvt_pk_bf16(__uint_as_float(w.w << 16) * s, __uint_as_float(w.w & 0xffff0000u) * s);
    return o;
}
template <bool FULL>
__device__ __forceinline__ void ret_unit(Frame& F, int h, int row0, int nch, int L, const float* Sin, float* Sout, const float* g_ret) {
    LAS unsigned char* lds = F.lds;
    const int tid = F.tid, w = F.wave, l = F.lane, fr = l & 15, g = l >> 4, tq = fr >> 2, tp = fr & 3;
    const float lg2 = log2f(1.f - exp2f(-5.f - (float)h));
    const bf16_t* RQ = (const bf16_t*)(F.ws + WS_RQ); const bf16_t* RK = (const bf16_t*)(F.ws + WS_RK); const bf16_t* RV = (const bf16_t*)(F.ws + WS_RV);
    const bf16_t* RG = (const bf16_t*)(F.ws + WS_RG); bf16_t* RET = (bf16_t*)(F.ws + WS_RET);
    LAS bf16_t* q_l = (LAS bf16_t*)(lds + Q_OFF); LAS bf16_t* qs_l = (LAS bf16_t*)(lds + QS_OFF); LAS bf16_t* k_l = (LAS bf16_t*)(lds + K_OFF);
    LAS bf16_t* kd_l = (LAS bf16_t*)(lds + KD_OFF); LAS bf16_t* v_l = (LAS bf16_t*)(lds + V_OFF); LAS bf16_t* p_l = (LAS bf16_t*)(lds + P_OFF); LAS float* st_l = (LAS float*)(lds + ST_OFF);
    f32x4 S[8][2];
#pragma unroll
    for (int db = 0; db < 8; ++db)
#pragma unroll
        for (int nb = 0; nb < 2; ++nb) {
            if (Sin) {
#pragma unroll
                for (int r = 0; r < 4; ++r) S[db][nb][r] = Sin[(size_t)(16 * db + 4 * g + r) * RET_DV + 32 * w + 16 * nb + fr]; }
            else S[db][nb] = (f32x4){0.f, 0.f, 0.f, 0.f}; }
    const float gL = exp2f(lg2 * (float)L);
    for (int c = 0; c < nch; ++c) {
        const size_t r0 = (size_t)row0 + (size_t)c * L;
        __syncthreads();
#pragma unroll
        for (int it = 0; it < 2; ++it) { const int idx = tid + 512 * it, tok = idx >> 4, c8 = idx & 15; const bool ok = tok < L;
            u32x4 kk = {0u, 0u, 0u, 0u}, qq = {0u, 0u, 0u, 0u};
            if (ok) { kk = *(const u32x4*)(RK + (r0 + tok) * 512 + h * 128 + c8 * 8); if (FULL) qq = *(const u32x4*)(RQ + (r0 + tok) * 512 + h * 128 + c8 * 8); }
            *(LAS u32x4*)(kd_l + tok * KDST + c8 * 8) = scale8(kk, exp2f(lg2 * (float)(L - 1 - tok)));
            if (FULL) { *(LAS u32x4*)(k_l + tok * QST + c8 * 8) = kk; *(LAS u32x4*)(q_l + tok * QST + c8 * 8) = qq; *(LAS u32x4*)(qs_l + tok * QST + c8 * 8) = scale8(qq, exp2f(lg2 * (float)(tok + 1))); } }
#pragma unroll
        for (int it = 0; it < 4; ++it) { const int idx = tid + 512 * it, tok = idx >> 5, c8 = idx & 31; u32x4 vv = {0u, 0u, 0u, 0u};
            if (tok < L) vv = *(const u32x4*)(RV + (r0 + tok) * 1024 + h * 256 + c8 * 8);
            *(LAS u32x4*)(v_l + tok * VST + c8 * 8) = vv; }
        __syncthreads();
        f32x4 o[4][2];
        if (FULL) {
            const int ib = w >> 1, jb0 = 2 * (w & 1);
            f32x4 p0 = {0.f, 0.f, 0.f, 0.f}, p1 = {0.f, 0.f, 0.f, 0.f};
#pragma unroll
            for (int s = 0; s < 4; ++s) { const bf16x8 a = *(const LAS bf16x8*)(q_l + (16 * ib + fr) * QST + 32 * s + 8 * g);
                const bf16x8 b0 = *(const LAS bf16x8*)(k_l + (16 * jb0 + fr) * QST + 32 * s + 8 * g), b1 = *(const LAS bf16x8*)(k_l + (16 * jb0 + 16 + fr) * QST + 32 * s + 8 * g);
                p0 = __builtin_amdgcn_mfma_f32_16x16x32_bf16(a, b0, p0, 0, 0, 0); p1 = __builtin_amdgcn_mfma_f32_16x16x32_bf16(a, b1, p1, 0, 0, 0); }
#pragma unroll
            for (int r = 0; r < 4; ++r) { const int i = 16 * ib + 4 * g + r, j0 = 16 * jb0 + fr, j1 = j0 + 16;
                const float v0 = j0 <= i ? p0[r] * exp2f(lg2 * (float)(i - j0)) : 0.f, v1 = j1 <= i ? p1[r] * exp2f(lg2 * (float)(i - j1)) : 0.f;
                p_l[i * PST + j0] = f2bf(v0); p_l[i * PST + j1] = f2bf(v1); }
            __syncthreads();
#pragma unroll
            for (int i = 0; i < 4; ++i) { o[i][0] = (f32x4){0.f, 0.f, 0.f, 0.f}; o[i][1] = (f32x4){0.f, 0.f, 0.f, 0.f}; }
        }
        bf16x8 vf[2][2];
#pragma unroll
        for (int s = 0; s < 2; ++s)
#pragma unroll
            for (int nb = 0; nb < 2; ++nb) { const LAS bf16_t* p = v_l + (32 * s + 8 * g + tq) * VST + 32 * w + 16 * nb + 4 * tp; vf[s][nb] = cat8(trrd(p), trrd(p + 4 * VST)); }
        if (FULL) {
#pragma unroll
            for (int i = 0; i < 4; ++i)
#pragma unroll
                for (int s = 0; s < 2; ++s) { const bf16x8 a = *(const LAS bf16x8*)(p_l + (16 * i + fr) * PST + 32 * s + 8 * g);
                    o[i][0] = __builtin_amdgcn_mfma_f32_16x16x32_bf16(a, vf[s][0], o[i][0], 0, 0, 0); o[i][1] = __builtin_amdgcn_mfma_f32_16x16x32_bf16(a, vf[s][1], o[i][1], 0, 0, 0); }
#pragma unroll
            for (int s = 0; s < 4; ++s) {
                bf16x8 bS[2];
#pragma unroll
                for (int nb = 0; nb < 2; ++nb) { u32x4 wv; wv.x = cvt_pk_bf16(S[2 * s][nb][0], S[2 * s][nb][1]); wv.y = cvt_pk_bf16(S[2 * s][nb][2], S[2 * s][nb][3]);
                    wv.z = cvt_pk_bf16(S[2 * s + 1][nb][0], S[2 * s + 1][nb][1]); wv.w = cvt_pk_bf16(S[2 * s + 1][nb][2], S[2 * s + 1][nb][3]); bS[nb] = __builtin_bit_cast(bf16x8, wv); }
#pragma unroll
                for (int i = 0; i < 4; ++i) { const LAS bf16_t* qp = qs_l + (16 * i + fr) * QST + 32 * s + 4 * g;
                    const s16x4 lo = *(const LAS s16x4*)qp, hi = *(const LAS s16x4*)(qp + 16); const bf16x8 a = cat8(lo, hi);
                    o[i][0] = __builtin_amdgcn_mfma_f32_16x16x32_bf16(a, bS[0], o[i][0], 0, 0, 0); o[i][1] = __builtin_amdgcn_mfma_f32_16x16x32_bf16(a, bS[1], o[i][1], 0, 0, 0); }
            }
        }
#pragma unroll
        for (int db = 0; db < 8; ++db) { S[db][0] = S[db][0] * gL; S[db][1] = S[db][1] * gL; }
#pragma unroll
        for (int s = 0; s < 2; ++s)
#pragma unroll
            for (int db = 0; db < 8; ++db) { const LAS bf16_t* p = kd_l + (32 * s + 8 * g + tq) * KDST + 16 * db + 4 * tp; const bf16x8 a = cat8(trrd(p), trrd(p + 4 * KDST));
                S[db][0] = __builtin_amdgcn_mfma_f32_16x16x32_bf16(a, vf[s][0], S[db][0], 0, 0, 0); S[db][1] = __builtin_amdgcn_mfma_f32_16x16x32_bf16(a, vf[s][1], S[db][1], 0, 0, 0); }
        if (FULL) {
#pragma unroll
            for (int i = 0; i < 4; ++i)
#pragma unroll
                for (int r = 0; r < 4; ++r) { float sm = o[i][0][r] + o[i][1][r], sq = o[i][0][r] * o[i][0][r] + o[i][1][r] * o[i][1][r];
                    sm += __shfl_xor(sm, 1); sq += __shfl_xor(sq, 1); sm += __shfl_xor(sm, 2); sq += __shfl_xor(sq, 2); sm += __shfl_xor(sm, 4); sq += __shfl_xor(sq, 4); sm += __shfl_xor(sm, 8); sq += __shfl_xor(sq, 8);
                    if (fr == 0) { LAS float* d = st_l + ((16 * i + 4 * g + r) * 8 + w) * 2; d[0] = sm; d[1] = sq; } }
            __syncthreads();
#pragma unroll
            for (int i = 0; i < 4; ++i)
#pragma unroll
                for (int r = 0; r < 4; ++r) { const int tok = 16 * i + 4 * g + r; if (tok >= L) continue;
                    const LAS f32x4* d = (const LAS f32x4*)(st_l + tok * 16); const f32x4 a0 = d[0], a1 = d[1], a2 = d[2], a3 = d[3];
                    const float sm = (a0[0] + a0[2]) + (a1[0] + a1[2]) + (a2[0] + a2[2]) + (a3[0] + a3[2]), sq = (a0[1] + a0[3]) + (a1[1] + a1[3]) + (a2[1] + a2[3]) + (a3[1] + a3[3]);
                    const float mu = sm * (1.f / 256.f), var = fmaxf(sq * (1.f / 256.f) - mu * mu, 0.f), rstd = rsqrtf(var + EPS);
#pragma unroll
                    for (int nb = 0; nb < 2; ++nb) { const int col = h * 256 + 32 * w + 16 * nb + fr; const size_t gi = (r0 + tok) * 1024 + col;
                        RET[gi] = f2bf((o[i][nb][r] - mu) * rstd * g_ret[col] * bf2f(RG[gi])); } }
        }
    }
    if (Sout) {
#pragma unroll
        for (int db = 0; db < 8; ++db)
#pragma unroll
            for (int nb = 0; nb < 2; ++nb)
#pragma unroll
                for (int r = 0; r < 4; ++r) Sout[(size_t)(16 * db + 4 * g + r) * RET_DV + 32 * w + 16 * nb + fr] = S[db][nb][r];
    }
}
}
__device__ __forceinline__ void r1_states(Frame& F) {
    const int bh = F.vcu >> 5, sc = F.vcu & 31, b = bh >> 2, h = bh & 3;
    rt::ret_unit<false>(F, h, b * SEQ + sc * rt::SC_TOK, 4, 64, nullptr, F.out + ((size_t)bh * rt::NSC + sc) * 32768, nullptr);
}
__device__ __forceinline__ void r2_scan(Frame& F) {
    float* U = F.out; const int gt = F.vcu * NTHR + F.tid;
    for (int e = gt; e < 8 * 32768; e += F.G * NTHR) { const int bh = e >> 15, idx = e & 32767, h = bh & 3;
        const float g256 = exp2f(log2f(1.f - exp2f(-5.f - (float)h)) * 256.f);
        float u[32];
#pragma unroll
        for (int sc = 0; sc < 32; ++sc) u[sc] = U[((size_t)bh * 32 + sc) * 32768 + idx];
        float carry = 0.f;
#pragma unroll
        for (int sc = 0; sc < 32; ++sc) { U[((size_t)bh * 32 + sc) * 32768 + idx] = carry; carry = g256 * carry + u[sc]; }
        F.out[O_RETP + (size_t)bh * 32768 + idx] = carry; }
}
__device__ __forceinline__ void r3_outputs(Frame& F) {
    const int bh = F.vcu >> 5, sc = F.vcu & 31, b = bh >> 2, h = bh & 3;
    rt::ret_unit<true>(F, h, b * SEQ + sc * rt::SC_TOK, 4, 64, F.out + ((size_t)bh * rt::NSC + sc) * 32768, nullptr, FIN(16));
    if (F.vcu < DEC_BATCH * RET_H) { const int sb = F.vcu >> 2, sh = F.vcu & 3;
        rt::ret_unit<true>(F, sh, MP + sb * DEC_SEQ, 1, DEC_SEQ, FIN(4) + (size_t)F.vcu * 32768, F.out + O_RETS + (size_t)F.vcu * 32768, FIN(16)); }
}

namespace at {
typedef float f32x16 __attribute__((ext_vector_type(16)));
typedef short s16x4 __attribute__((ext_vector_type(4)));
constexpr int KN_ST = 272, KP_ST = 144;
constexpr int KN_B = 64 * KN_ST, KP_B = 64 * KP_ST, V_B = 16384, BUF_B = KN_B + KP_B + V_B;
constexpr int SCR_OFF = 2 * BUF_B;
constexpr float THR = 8.f;
__device__ __forceinline__ int v_st(int k, int c) { const int kk = (k & ~0xC) | ((k & 4) << 1) | ((k & 8) >> 1); return ((kk >> 3) * 4 + (c >> 5)) * 512 + ((kk & 7) * 32 + (c & 31)) * 2; }
__device__ __forceinline__ int v_rd_base(int lane) { return ((lane & 3) << 3) | (((lane >> 2) & 3) << 6) | (((lane >> 4) & 1) << 5) | (((lane >> 5) & 1) << 8); }
constexpr int v_rd_off(int d0, int ks, int half) { return d0 * 512 + ks * 4096 + half * 2048; }
__device__ __forceinline__ int crow(int r, int hi) { return (r & 3) + 8 * (r >> 2) + 4 * hi; }
#define AT_SBAR() __builtin_amdgcn_sched_barrier(0)

__device__ __forceinline__ void qkt(f32x16& p0, f32x16& p1, const LAS unsigned char* kn, const LAS unsigned char* kp, const bf16x8* qr) {
    p0 = f32x16{}; p1 = f32x16{};
#pragma unroll
    for (int d0 = 0; d0 < 8; ++d0) { const bf16x8 a0 = *(const LAS bf16x8*)(kn + d0 * 32), a1 = *(const LAS bf16x8*)(kn + d0 * 32 + 32 * KN_ST);
        p0 = __builtin_amdgcn_mfma_f32_32x32x16_bf16(a0, qr[d0], p0, 0, 0, 0); p1 = __builtin_amdgcn_mfma_f32_32x32x16_bf16(a1, qr[d0], p1, 0, 0, 0); }
#pragma unroll
    for (int d0 = 0; d0 < 4; ++d0) { const bf16x8 a0 = *(const LAS bf16x8*)(kp + d0 * 32), a1 = *(const LAS bf16x8*)(kp + d0 * 32 + 32 * KP_ST);
        p0 = __builtin_amdgcn_mfma_f32_32x32x16_bf16(a0, qr[8 + d0], p0, 0, 0, 0); p1 = __builtin_amdgcn_mfma_f32_32x32x16_bf16(a1, qr[8 + d0], p1, 0, 0, 0); }
}
__device__ __forceinline__ void pv_tile(f32x16* o, int vb0, bf16x8 pa0, bf16x8 pa1, bf16x8 pa2, bf16x8 pa3) {
#define AT_TRRD(dst, off) asm volatile("ds_read_b64_tr_b16 %0, %1 offset:%2" : "=&v"(dst) : "v"(vb0), "i"(off) : "memory")
#define AT_PV_D0(d0) do { s16x4 l0, l1, l2, l3, h0, h1, h2, h3; constexpr int b_ = v_rd_off(d0, 0, 0);   \
        AT_TRRD(l0, b_); AT_TRRD(h0, b_ + 2048); AT_TRRD(l1, b_ + 4096); AT_TRRD(h1, b_ + 6144); AT_TRRD(l2, b_ + 8192); AT_TRRD(h2, b_ + 10240); AT_TRRD(l3, b_ + 12288); AT_TRRD(h3, b_ + 14336); \
        asm volatile("s_waitcnt lgkmcnt(0)" ::: "memory"); AT_SBAR();   \
        o[d0] = __builtin_amdgcn_mfma_f32_32x32x16_bf16(pa0, (bf16x8){l0[0], l0[1], l0[2], l0[3], h0[0], h0[1], h0[2], h0[3]}, o[d0], 0, 0, 0);   \
        o[d0] = __builtin_amdgcn_mfma_f32_32x32x16_bf16(pa1, (bf16x8){l1[0], l1[1], l1[2], l1[3], h1[0], h1[1], h1[2], h1[3]}, o[d0], 0, 0, 0);   \
        o[d0] = __builtin_amdgcn_mfma_f32_32x32x16_bf16(pa2, (bf16x8){l2[0], l2[1], l2[2], l2[3], h2[0], h2[1], h2[2], h2[3]}, o[d0], 0, 0, 0);   \
        o[d0] = __builtin_amdgcn_mfma_f32_32x32x16_bf16(pa3, (bf16x8){l3[0], l3[1], l3[2], l3[3], h3[0], h3[1], h3[2], h3[3]}, o[d0], 0, 0, 0); } while (0)
    AT_PV_D0(0); AT_PV_D0(1); AT_PV_D0(2); AT_PV_D0(3);
#undef AT_PV_D0
#undef AT_TRRD
}
__device__ __forceinline__ void attn_unit(LAS unsigned char* lds, const bf16_t* Qw, const bf16_t* KN, const bf16_t* KPE, const bf16_t* V, bf16_t* Ow, int NT, int tmax_w, int nkeys, int orows) {
    const int tid = threadIdx.x, wid = __builtin_amdgcn_readfirstlane(tid >> 6), lane = tid & 63, r32 = lane & 31, hi = lane >> 5;
    bf16x8 qr[12];
#pragma unroll
    for (int d0 = 0; d0 < 12; ++d0) qr[d0] = *(const bf16x8*)(Qw + (size_t)r32 * 1536 + d0 * 16 + hi * 8);
    const int sr = tid >> 4, sc = (tid & 15) * 8, pr = tid >> 3, pc = (tid & 7) * 8;
    const int kn_w0 = sr * KN_ST + sc * 2, kn_w1 = (32 + sr) * KN_ST + sc * 2, kp_w = KN_B + pr * KP_ST + pc * 2, v_w0 = KN_B + KP_B + v_st(sr, sc), v_w1 = KN_B + KP_B + v_st(32 + sr, sc);
    const int kn_r = r32 * KN_ST + hi * 16, kp_r = KN_B + r32 * KP_ST + hi * 16;
    const int vb_base = (int)(unsigned)(uintptr_t)(lds + KN_B + KP_B) + v_rd_base(lane);
    LAS float* scr = (LAS float*)(lds + SCR_OFF) + wid * 64;
    float m_reg = -1e30f, l_reg = 0.f; f32x16 o[4] = {};
    u32x4 st_kn0, st_kn1, st_kp, st_v0, st_v1;
#define AT_LOAD(t) do { const size_t k0_ = (size_t)(t) * 64; const bool v0_ = (int)k0_ + sr < nkeys, v1_ = (int)k0_ + 32 + sr < nkeys, vp_ = (int)k0_ + pr < nkeys; const u32x4 z_ = {0u, 0u, 0u, 0u}; \
        st_kn0 = v0_ ? *(const u32x4*)(KN + (k0_ + sr) * 1024 + sc) : z_; st_kn1 = v1_ ? *(const u32x4*)(KN + (k0_ + 32 + sr) * 1024 + sc) : z_; \
        st_v0 = v0_ ? *(const u32x4*)(V + (k0_ + sr) * 1024 + sc) : z_; st_v1 = v1_ ? *(const u32x4*)(V + (k0_ + 32 + sr) * 1024 + sc) : z_; \
        st_kp = vp_ ? *(const u32x4*)(KPE + (k0_ + pr) * 64 + pc) : z_; } while (0)
#define AT_WRITE(bf) do { LAS unsigned char* b_ = lds + (bf) * BUF_B; *(LAS u32x4*)(b_ + kn_w0) = st_kn0; *(LAS u32x4*)(b_ + kn_w1) = st_kn1; *(LAS u32x4*)(b_ + kp_w) = st_kp; \
        *(LAS u32x4*)(b_ + v_w0) = st_v0; *(LAS u32x4*)(b_ + v_w1) = st_v1; } while (0)
    AT_LOAD(0); AT_WRITE(0);
    __syncthreads();
    for (int t = 0; t < NT; ++t) {
        const int bf = t & 1;
        if (t + 1 < NT) AT_LOAD(t + 1);
        if (t <= tmax_w) {
            f32x16 p0, p1;
            const LAS unsigned char* bb = lds + bf * BUF_B;
            qkt(p0, p1, bb + kn_r, bb + kp_r, qr);
            if ((t + 1) * 64 > nkeys) {
                const int kb = t * 64 + 4 * hi;
#pragma unroll
                for (int r = 0; r < 16; ++r) { const int kv = kb + (r & 3) + 8 * (r >> 2); if (kv >= nkeys) p0[r] = -INFINITY; if (kv + 32 >= nkeys) p1[r] = -INFINITY; } }
            float pmax = p0[0];
#pragma unroll
            for (int r = 1; r < 16; ++r) pmax = fmaxf(pmax, p0[r]);
#pragma unroll
            for (int r = 0; r < 16; ++r) pmax = fmaxf(pmax, p1[r]);
            { auto rr = __builtin_amdgcn_permlane32_swap(__float_as_uint(pmax), __float_as_uint(pmax), false, false); pmax = fmaxf(__uint_as_float(rr[0]), __uint_as_float(rr[1])); }
            float alpha = 1.f; bool resc = false;
            if (!__all(pmax - m_reg <= THR)) { const float mn = fmaxf(m_reg, pmax); alpha = __builtin_amdgcn_exp2f(m_reg - mn); m_reg = mn; resc = true; }
#pragma unroll
            for (int r = 0; r < 16; ++r) { p0[r] = __builtin_amdgcn_exp2f(p0[r] - m_reg); p1[r] = __builtin_amdgcn_exp2f(p1[r] - m_reg); }
            float ps = 0.f;
#pragma unroll
            for (int r = 0; r < 16; ++r) ps += p0[r] + p1[r];
            { auto rr = __builtin_amdgcn_permlane32_swap(__float_as_uint(ps), __float_as_uint(ps), false, false); ps = __uint_as_float(rr[0]) + __uint_as_float(rr[1]); }
            l_reg = l_reg * alpha + ps;
            bf16x8 pa0, pa1, pa2, pa3;
#define AT_PK4(P, B_, OUT) do { unsigned a0 = cvt_pk_bf16(P[B_ + 0], P[B_ + 1]), a1 = cvt_pk_bf16(P[B_ + 2], P[B_ + 3]); unsigned b0 = cvt_pk_bf16(P[B_ + 4], P[B_ + 5]), b1 = cvt_pk_bf16(P[B_ + 6], P[B_ + 7]); \
        auto r0 = __builtin_amdgcn_permlane32_swap(a0, b0, false, false); auto r1 = __builtin_amdgcn_permlane32_swap(a1, b1, false, false); \
        u32x4 w_ = {r0[0], r1[0], r0[1], r1[1]}; OUT = __builtin_bit_cast(bf16x8, w_); } while (0)
            AT_PK4(p0, 0, pa0); AT_PK4(p0, 8, pa1); AT_PK4(p1, 0, pa2); AT_PK4(p1, 8, pa3);
#undef AT_PK4
            if (resc) { if (hi == 0) scr[r32] = alpha; asm volatile("s_waitcnt lgkmcnt(0)" ::: "memory");
#pragma unroll
                for (int d_ = 0; d_ < 4; ++d_)
#pragma unroll
                    for (int r = 0; r < 16; ++r) o[d_][r] *= scr[crow(r, hi)]; }
            AT_SBAR();
            pv_tile(o, vb_base + bf * BUF_B, pa0, pa1, pa2, pa3);
        }
        if (t + 1 < NT) AT_WRITE(bf ^ 1);
        __syncthreads();
    }
    if (hi == 0) scr[32 + r32] = l_reg; asm volatile("s_waitcnt lgkmcnt(0)" ::: "memory");
#pragma unroll
    for (int r = 0; r < 16; ++r) { const int orow = crow(r, hi); const float rl = __builtin_amdgcn_rcpf(scr[32 + orow]);
#pragma unroll
        for (int d0 = 0; d0 < 4; ++d0) { const float v = o[d0][r] * rl; const float vn = __shfl_xor(v, 1);
            if ((r32 & 1) == 0 && orow < orows) *(unsigned*)(Ow + (size_t)orow * 1024 + d0 * 32 + r32) = cvt_pk_bf16(v, vn); } }
    __syncthreads();
#undef AT_LOAD
#undef AT_WRITE
}
#undef AT_SBAR
}
__device__ __forceinline__ void p3_attn_prompt(Frame& F) {
    const int bh = F.vcu >> 4, s = F.vcu & 15, b = bh >> 3, h = bh & 7;
    const bf16_t* Q = (const bf16_t*)F.out; const bf16_t* KN = (const bf16_t*)(F.ws + WS_KN); const bf16_t* KPE = (const bf16_t*)(F.ws + WS_KPE); const bf16_t* V = (const bf16_t*)(F.ws + WS_V); bf16_t* ATT = (bf16_t*)(F.ws + WS_ATT);
#pragma unroll 1
    for (int it = 0; it < 2; ++it) { const int qb = it == 0 ? s : 31 - s; const size_t row0 = (size_t)b * SEQ + (size_t)qb * 256 + F.wave * 32;
        at::attn_unit(F.lds, Q + row0 * 1536 + h * 192, KN + (size_t)b * SEQ * 1024 + h * 128, KPE + (size_t)b * SEQ * 64, V + (size_t)b * SEQ * 1024 + h * 128,
                      ATT + row0 * 1024 + h * 128, 4 * qb + 4, 4 * qb + (F.wave >> 1), 1 << 30, 32); }
}

__global__ void __launch_bounds__(NTHR, 2) mk(const MArgs a) {
    extern __shared__ __attribute__((aligned(16))) unsigned char lds_raw[];
    Frame F;
    F.lds = (LAS unsigned char*)lds_raw;
    F.tid = threadIdx.x; F.lane = F.tid & 63; F.wave = __builtin_amdgcn_readfirstlane(F.tid >> 6);
    F.G = gridDim.x; F.x = blockIdx.x % 8; F.j = blockIdx.x / 8; F.vcu = F.x * (F.G / 8) + F.j;
    F.a = &a; F.out = a.out; F.ws = a.ws;
    volatile LAS unsigned* MISC = (volatile LAS unsigned*)(F.lds + MISC_OFF);
    if (F.tid < 32) MISC[F.tid] = 0u;
    __syncthreads();
    XcdBarrier bar = xcd_barrier_post((unsigned*)(a.ws + WS_CTL) + CW_BAR + a.li * XCD_BAR_WORDS, MISC + 8);
    const int lo = a.ph_lo, hi = a.ph_hi;
#define IN_(k) (lo <= (k) && (k) < hi)
#define SEAM_(k) do { if (IN_(k) && IN_((k) + 1)) xcd_barrier(bar); } while (0)
    if (IN_(0)) { p0_prologue(F); } SEAM_(0);
    if (IN_(1)) { p1_inproj(F); } SEAM_(1);
    if (IN_(2)) { r1_states(F); } SEAM_(2);
    if (IN_(3)) { r2_scan(F); } SEAM_(3);
    if (IN_(4)) { r3_outputs(F); } SEAM_(4);
    if (IN_(5)) { p2_qkv(F, 1); } SEAM_(5);
    if (IN_(7)) { p2_qkv(F, 0); } SEAM_(7);
    if (IN_(8)) { p3_attn_prompt(F); } SEAM_(8);
    if (IN_(9)) { p5_gemm(F, 5); } SEAM_(9);
    if (IN_(10)) { p5_gemm(F, 6); } SEAM_(10);
    if (IN_(11)) { p5_gemm(F, 7); } SEAM_(11);
    if (IN_(13)) { p5_gemm(F, 9); }
}

__global__ void k_slotsum(const float* __restrict__ slotkv, float* __restrict__ skv) {
    const int r = blockIdx.x * blockDim.x + threadIdx.x; if (r >= MT) return;
    float b = 0.f; for (int i = 0; i < 8; ++i) b += slotkv[(size_t)r * 8 + i]; skv[r] = rsqrtf(b * (1.f / KV_LORA) + EPS);
}
__global__ void k_kvl_finish2(const bf16_t* __restrict__ kvl, const float* __restrict__ skv, float* __restrict__ dout) {
    const int r = blockIdx.x * 4 + (threadIdx.x >> 6), lane = threadIdx.x & 63; if (r >= MT) return;
    const float s = skv[r];
    float* o = r < MP ? dout + O_LATP + (size_t)r * KV_LORA : dout + O_LATS + (size_t)(r - MP) * KV_LORA;
#pragma unroll
    for (int jj = 0; jj < 8; ++jj) { const int c = jj * 64 + lane; o[c] = bf2f(kvl[(size_t)r * KV_LORA + c]) * s; }
}

static void gemm(hipStream_t s, const bf16_t* A, int lda, const bf16_t* Bt, int K, int M, int N, const Epi& E) {
    const int nb = ((M + 63) / 64) * (N / 64);
    hipLaunchKernelGGL(k_gemm, dim3(nb), dim3(256), 0, s, A, lda, Bt, K, M, N, E);
}
static Epi mkepi(int mode, bf16_t* o1, int ldo) { Epi e{}; e.mode = mode; e.o1 = o1; e.ldo = ldo; return e; }

extern "C" void kernel_launch(void* const* d_in, const int* in_sizes, int n_in, void* d_out, int out_size, void* d_ws, size_t ws_size, hipStream_t stream) {
    const float* x_p = (const float*)d_in[0]; const float* x_s = (const float*)d_in[1];
    const float* st_ret = (const float*)d_in[4]; const float* st_conv = (const float*)d_in[5];
    const float* w_in = (const float*)d_in[7]; const float* g_qlat = (const float*)d_in[8]; const float* w_qup = (const float*)d_in[9];
    const float* g_qn = (const float*)d_in[10]; const float* g_qr = (const float*)d_in[11]; const float* w_kvup = (const float*)d_in[13];
    const float* g_kn = (const float*)d_in[14]; const float* g_ret = (const float*)d_in[16]; const float* w_ob = (const float*)d_in[17];
    const float* w_out = (const float*)d_in[18]; const float* g_ffn = (const float*)d_in[19]; const float* w_up = (const float*)d_in[20]; const float* cw = (const float*)d_in[21];
    const float* cb = (const float*)d_in[22]; const float* w_down = (const float*)d_in[23]; const float* g_mix = (const float*)d_in[6];
    float* out = (float*)d_out; char* ws = (char*)d_ws;
    static int ok = 0;
    if (ok == 0) {
        ok = 1;
        if (ws_size < 256 * MiB || n_in != 24) { fprintf(stderr, "kernel_launch: bad ws/n_in: %zu %d\n", ws_size, n_in); ok = -1; }
        int dev = 0, cus = 0; hipGetDevice(&dev); hipDeviceGetAttribute(&cus, hipDeviceAttributeMultiprocessorCount, dev);
        if (cus != 256) { fprintf(stderr, "kernel_launch: built for 256 CUs, got %d\n", cus); ok = -1; }
        if (hipFuncSetAttribute((const void*)mk, hipFuncAttributeMaxDynamicSharedMemorySize, LDS_BYTES) != hipSuccess) { fprintf(stderr, "kernel_launch: hipFuncSetAttribute(mk) failed\n"); ok = -1; }
        if (hipFuncSetAttribute((const void*)k_ret, hipFuncAttributeMaxDynamicSharedMemorySize, 110 * 1024) != hipSuccess) { fprintf(stderr, "kernel_launch: hipFuncSetAttribute(k_ret) failed\n"); ok = -1; }
        (void)hipGetLastError();
    }
    if (ok < 0) return;
#define WSB(off) ((bf16_t*)(ws + (off)))
    float* SQ = (float*)(ws + WS_SQ); float* SKV = (float*)(ws + WS_SKV);
    float2* TAB32 = (float2*)(ws + WS_TAB32); float2* TAB64 = (float2*)(ws + WS_TAB64);

    auto run = [&](int lo, int hi, int li) { MArgs a{}; for (int i = 0; i < 24; ++i) a.in[i] = (const float*)d_in[i]; a.out = out; a.ws = (unsigned char*)ws; a.ph_lo = lo; a.ph_hi = hi; a.li = li;
        hipLaunchKernelGGL(mk, dim3(256), dim3(NTHR), LDS_BYTES, stream, a); };
    (void)hipMemsetAsync(ws + WS_CTL, 0, CTL_BYTES, stream);
    run(0, 2, 0);
    hipLaunchKernelGGL(k_slotsum, dim3((MT + 255) / 256), dim3(256), 0, stream, (const float*)(ws + WS_SLOTKV), SKV);
    hipLaunchKernelGGL(k_kvl_finish2, dim3(MT / 4), dim3(256), 0, stream, WSB(WS_KVL), SKV, out);
    run(2, 5, 1);
    bf16_t* Qb = (bf16_t*)out;
    run(5, 6, 1);
    hipLaunchKernelGGL(k_attn<1>, dim3(DEC_BATCH * HEADS), dim3(64), 0, stream, Qb, WSB(WS_KN), WSB(WS_PES), WSB(WS_V), WSB(WS_ATTS) - (size_t)MP * 1024, 1);
    hipLaunchKernelGGL(k_rownorm, dim3(MT / 4), dim3(256), 0, stream, x_p, x_s, WSB(WS_XN2));
    run(7, 12, 2);
    hipLaunchKernelGGL(k_convout, dim3((DEC_BATCH * 2 * FF2 + 255) / 256), dim3(256), 0, stream, WSB(WS_U), out);
    hipLaunchKernelGGL(k_halo, dim3(64 + DEC_BATCH), dim3(256), 0, stream, WSB(WS_U), st_conv, WSB(WS_HALO));
    hipLaunchKernelGGL(k_conv, dim3((64 + DEC_BATCH) * 11), dim3(256), 0, stream, WSB(WS_U), WSB(WS_HALO), cw, cb);
    run(13, 14, 1);
}
```

```cpp
#include <hip/hip_runtime.h>
#include <stdint.h>
#include <cstdio>

typedef unsigned short bf16_t;
typedef short bf16x8 __attribute__((ext_vector_type(8)));
typedef float f32x4 __attribute__((ext_vector_type(4)));
typedef float f32x2 __attribute__((ext_vector_type(2)));
typedef unsigned u32x4 __attribute__((ext_vector_type(4)));
typedef unsigned u32x2 __attribute__((ext_vector_type(2)));

constexpr int D_MODEL = 1024, BATCH = 2, SEQ = 8192, DEC_BATCH = 8, DEC_SEQ = 16, PAST = 2048;
constexpr int MP = BATCH * SEQ, MS = DEC_BATCH * DEC_SEQ, MT = MP + MS;
constexpr int MPAD = 16640;
constexpr int Q_LORA = 768, KV_LORA = 512, QK_NOPE = 128, QK_ROPE = 64, V_HEAD = 128, HEADS = 8;
constexpr int RET_H = 4, RET_DK = 128, RET_DV = 256;
constexpr int D_FF = 2816, FF2 = 2 * D_FF;
constexpr int IN_W = 6464;
constexpr int SKEYS = PAST + DEC_SEQ;
constexpr int LROWS = DEC_BATCH * SKEYS;
constexpr float EPS = 1e-6f;
constexpr int C_QLAT = 0, C_KVLAT = 768, C_KPE = 1280, C_RQ = 1344, C_RK = 1856, C_RV = 2368, C_RG = 3392, C_GA = 4416, C_GB = 5440;

constexpr size_t O_YP = 0, O_YS = 16777216, O_LATP = 16908288, O_RKP = 25296896, O_RETP = 26345472, O_CONVP = 26607616,
                 O_LATS = 26630144, O_RKS = 26695680, O_RETS = 26703872, O_CONVS = 27752448;

constexpr size_t MiB = 1u << 20, KiB = 1024;
constexpr size_t WS_CTL = 0, CTL_BYTES = 64 * KiB, WS_SQ = 64 * KiB, WS_SKV = 192 * KiB;
constexpr size_t WS_SLOTQ = 1 * MiB, WS_SLOTKV = 2 * MiB, WS_SLOTX1 = 3 * MiB;
constexpr size_t WS_TAB32 = 4 * MiB + 256 * KiB, WS_TAB64 = 6 * MiB + 256 * KiB;
constexpr size_t WS_FWUP = 10 * MiB + 512 * KiB, WS_FWDOWN = 21 * MiB + 512 * KiB, WS_FWIN = 27 * MiB, WS_FWQUP = 40 * MiB, WS_FWKVUP = 43 * MiB,
                 WS_FWOBA = 45 * MiB, WS_FWOBB = 47 * MiB, WS_FWOUT = 49 * MiB;
constexpr size_t WS_XN = 51 * MiB, WS_RET = 51 * MiB;
constexpr size_t WS_LATS = 83 * MiB + 512 * KiB, WS_PES = 99 * MiB + 768 * KiB, WS_ZQ = 102 * MiB, WS_KVL = 126 * MiB + 512 * KiB, WS_KPE = 142 * MiB + 768 * KiB;
constexpr size_t WS_RQ = 145 * MiB, WS_RK = 161 * MiB + 256 * KiB, WS_RV = 177 * MiB + 512 * KiB, WS_RG = 210 * MiB;
constexpr size_t WS_KN = 145 * MiB, WS_V = 177 * MiB + 512 * KiB, WS_ATTS = 242 * MiB + 512 * KiB, WS_XN2 = 210 * MiB, WS_ATT = 102 * MiB;
constexpr size_t WS_T1 = 166 * MiB + 512 * KiB, WS_MERGED = 134 * MiB;
constexpr size_t WS_X1B = 223 * MiB + 512 * KiB, WS_U = 27 * MiB, WS_HALO = 206 * MiB;

__device__ __forceinline__ bf16_t f2bf(float f) { unsigned u = __float_as_uint(f); u = (u + 0x7fffu + ((u >> 16) & 1u)) >> 16; return (bf16_t)u; }
__device__ __forceinline__ float bf2f(bf16_t b) { return __uint_as_float(((unsigned)b) << 16); }

#define LAS __attribute__((address_space(3)))
#define GAS __attribute__((address_space(1)))
constexpr int NTHR = 512;
constexpr int RING_BYTES = 131072, EPI_OFF = RING_BYTES, EPI_BYTES = 8192, MISC_OFF = EPI_OFF + EPI_BYTES, LDS_BYTES = 147456;
constexpr int CW_BAR = 1024;

__device__ __forceinline__ unsigned cvt_pk_bf16(float lo, float hi) { unsigned r; asm volatile("v_cvt_pk_bf16_f32 %0, %1, %2" : "=v"(r) : "v"(lo), "v"(hi)); return r; }
__device__ __forceinline__ u32x4 pack8f(const f32x4& a, const f32x4& b) { u32x4 w; w.x = cvt_pk_bf16(a[0], a[1]); w.y = cvt_pk_bf16(a[2], a[3]); w.z = cvt_pk_bf16(b[0], b[1]); w.w = cvt_pk_bf16(b[2], b[3]); return w; }
__device__ __forceinline__ int row_pos(int row) { return row < MP ? (row & (SEQ - 1)) : PAST + ((row - MP) & (DEC_SEQ - 1)); }

#define XB_TMO      128
#define XB_XCNT(j)  (256  + 64 * (j))
#define XB_XSUB(j)  (1280 + 64 * (j))
#define XB_XGEN(j)  (2304 + 64 * (j))
#define XB_TOP      3328
#define XB_TOPGEN   3392
#define XCD_BAR_WORDS 3456
#define XB_SPIN_CAP (1u << 18)
__device__ __forceinline__ unsigned xb_ld(unsigned* p)              { return __hip_atomic_load(p, __ATOMIC_RELAXED, __HIP_MEMORY_SCOPE_AGENT); }
__device__ __forceinline__ unsigned xb_add(unsigned* p, unsigned v) { return __hip_atomic_fetch_add(p, v, __ATOMIC_RELAXED, __HIP_MEMORY_SCOPE_AGENT); }
__device__ __forceinline__ unsigned xb_xcc_id() { return (unsigned)__builtin_amdgcn_s_getreg((3 << 11) | 20) & 0xFu; }
#define XB_SPIN(cond, bar) do { unsigned _sp = 0; while (cond) { __builtin_amdgcn_s_sleep(1); \
    if ((++_sp & 255u) == 0u) { if (xb_ld(&(bar)[XB_TMO])) break; if (_sp > XB_SPIN_CAP) { atomicAdd(&(bar)[XB_TMO], 1u); break; } } } } while (0)
struct XcdBarrier { unsigned* bar; unsigned x; volatile LAS unsigned* st; };
__device__ __forceinline__ XcdBarrier xcd_barrier_post(unsigned* bar, volatile LAS unsigned* st) {
    XcdBarrier b; b.bar = bar; b.x = xb_xcc_id(); b.st = st;
    if (threadIdx.x == 0) (void)xb_add(&bar[XB_XCNT(b.x)], 1u);
    return b;
}
__device__ __forceinline__ void xcd_barrier_complete(unsigned* bar, unsigned x, unsigned& nloc, unsigned& nx) {
    const unsigned G = gridDim.x * gridDim.y * gridDim.z;
    unsigned sum, cnt, mine, sp = 0u;
    for (;;) {
        sum = 0u; cnt = 0u; mine = 0u;
#pragma unroll
        for (unsigned j = 0; j < 16; ++j) { const unsigned c = xb_ld(&bar[XB_XCNT(j)]); sum += c; cnt += (c > 0u) ? 1u : 0u; mine = (j == x) ? c : mine; }
        if (sum == G) break;
        __builtin_amdgcn_s_sleep(1);
        if ((++sp & 255u) == 0u) { if (xb_ld(&bar[XB_TMO])) break; if (sp > XB_SPIN_CAP) { atomicAdd(&bar[XB_TMO], 1u); break; } }
    }
    nloc = mine > 0u ? mine : 1u; nx = cnt > 0u ? cnt : 1u;
}
__device__ __forceinline__ void xcd_barrier(const XcdBarrier& b) {
    asm volatile("s_waitcnt vmcnt(0)" ::: "memory");
    __syncthreads();
    if (threadIdx.x == 0) {
        unsigned* bar = b.bar;
        __builtin_amdgcn_s_waitcnt(0);
        unsigned nloc = b.st[0], nx = b.st[1];
        if (nloc == 0u) { xcd_barrier_complete(bar, b.x, nloc, nx); b.st[0] = nloc; b.st[1] = nx; }
        const unsigned old = xb_add(&bar[XB_XSUB(b.x)], 1u);
        const unsigned gen = old / nloc;
        if (old + 1u == (gen + 1u) * nloc) {
            __builtin_amdgcn_fence(__ATOMIC_RELEASE, "agent");
            asm volatile("s_waitcnt vmcnt(0)" ::: "memory");
            const unsigned og = xb_add(&bar[XB_TOP], 1u);
            const unsigned tg = og / nx;
            if (og + 1u == (tg + 1u) * nx) xb_add(&bar[XB_TOPGEN], 1u);
            else XB_SPIN(xb_ld(&bar[XB_TOPGEN]) == tg, bar);
            __builtin_amdgcn_fence(__ATOMIC_ACQUIRE, "agent");
            xb_add(&bar[XB_XGEN(b.x)], 1u);
            asm volatile("s_waitcnt vmcnt(0)" ::: "memory");
        } else {
            XB_SPIN(xb_ld(&bar[XB_XGEN(b.x)]) == gen, bar);
            __builtin_amdgcn_fence(__ATOMIC_ACQUIRE, "agent");
            asm volatile("s_waitcnt vmcnt(0)" ::: "memory");
        }
    }
    __syncthreads();
}

namespace pg {
constexpr int BK = 64, HALF = 128, HTB = HALF * BK * 2;
__host__ __device__ __forceinline__ int lds_byte(int r, int c) { const int st = (r >> 4) * 2 + (c >> 5), rr = r & 15, cc = c & 31, ob = rr * 64 + cc * 2; return st * 1024 + (ob ^ (((ob >> 9) & 1) << 5)); }
__host__ __device__ __forceinline__ void stage_rc(int b, int& R, int& C) { const int st = b / 1024, sb = b % 1024, swz = sb ^ (((sb >> 9) & 1) << 5); R = (st >> 1) * 16 + swz / 64; C = (st & 1) * 32 + (swz % 64) / 2; }
__host__ __device__ __forceinline__ int perm32(int rho) { const int n = rho >> 4, i = rho & 15; return 8 * (i >> 2) + 4 * n + (i & 3); }
struct UnitG { const char* A; const char* B; unsigned lda, ldb; int nt; int pm, pn, kind; };
typedef f32x4 Acc[2][2][4][2];

template <class Sched, class Epi>
__device__ __forceinline__ void gemm_stream(LAS unsigned char* lds, const Sched& S, const Epi& E) {
    const int tid = threadIdx.x, wid = __builtin_amdgcn_readfirstlane(tid >> 6), lane = tid & 63, wr = wid >> 2, wc = wid & 3, fr = lane & 15, fq = lane >> 4;
    unsigned Rr[2], Cc[2];
#pragma unroll
    for (int i = 0; i < 2; ++i) { int R, C; stage_rc(tid * 16 + i * 8192, R, C); Rr[i] = (unsigned)R; Cc[i] = (unsigned)C * 2u; }
    const unsigned ldsw = (unsigned)wid * 1024u;
    const int aoff = lds_byte(wr * 64 + fr, fq * 8), boff = lds_byte(wc * 32 + fr, fq * 8);
#define PG_SA(b, h) (((b) * 2 + (h)) * HTB)
#define PG_SB(b, h) ((4 + (b) * 2 + (h)) * HTB)
#define PG_STAGE(bufoff, gbase, ld) do { _Pragma("unroll") for (int _i = 0; _i < 2; ++_i) \
        __builtin_amdgcn_global_load_lds((const unsigned*)((const char*)(gbase) + (size_t)(Rr[_i] * (ld) + Cc[_i])), (LAS unsigned*)(lds + (bufoff) + ldsw + _i * 8192), 16, 0, 0); } while (0)
#define PG_LDA(dst, b, h) do { _Pragma("unroll") for (int m = 0; m < 4; ++m) _Pragma("unroll") for (int k = 0; k < 2; ++k) dst[m][k] = *(const LAS bf16x8*)(lds + PG_SA(b, h) + aoff + m * 2048 + k * 1024); } while (0)
#define PG_LDB(dst, b, h) do { _Pragma("unroll") for (int n = 0; n < 2; ++n) _Pragma("unroll") for (int k = 0; k < 2; ++k) dst[n][k] = *(const LAS bf16x8*)(lds + PG_SB(b, h) + boff + n * 2048 + k * 1024); } while (0)
#define PG_MMA(ai, bj, At, Bt) do { __builtin_amdgcn_s_setprio(1); _Pragma("unroll") for (int m = 0; m < 4; ++m) _Pragma("unroll") for (int n = 0; n < 2; ++n) _Pragma("unroll") for (int k = 0; k < 2; ++k) \
        acc[ai][bj][m][n] = __builtin_amdgcn_mfma_f32_16x16x32_bf16(Bt[n][k], At[m][k], acc[ai][bj][m][n], 0, 0, 0); __builtin_amdgcn_s_setprio(0); } while (0)
#define PG_WAIT_V(n) asm volatile("s_waitcnt vmcnt(" #n ")" ::: "memory")
#define PG_WAIT_L(n) asm volatile("s_waitcnt lgkmcnt(" #n ")" ::: "memory")
#define PG_BAR __builtin_amdgcn_s_barrier()
#define PG_SCHED __builtin_amdgcn_sched_barrier(0)
    UnitG cur, nxt; int ui = 0;
    if (!S.next(0, cur)) return;
    Acc acc;
#pragma unroll
    for (int a = 0; a < 2; ++a)
#pragma unroll
        for (int b = 0; b < 2; ++b)
#pragma unroll
            for (int m = 0; m < 4; ++m)
#pragma unroll
                for (int n = 0; n < 2; ++n) acc[a][b][m][n] = (f32x4){0.f, 0.f, 0.f, 0.f};
    bf16x8 At[4][2], B0[2][2], B1[2][2];
    const char* cA = cur.A; const char* cB = cur.B; unsigned clda = cur.lda, cldb = cur.ldb;
    PG_STAGE(PG_SB(0, 0), cB, cldb); PG_STAGE(PG_SB(0, 1), cB + (size_t)HALF * cldb, cldb); PG_STAGE(PG_SA(0, 0), cA, clda); PG_STAGE(PG_SA(0, 1), cA + (size_t)HALF * clda, clda);
    if (wr == 1) PG_BAR;
    PG_WAIT_V(2); PG_BAR;
    PG_STAGE(PG_SB(1, 0), cB + 128, cldb); PG_STAGE(PG_SA(1, 0), cA + 128, clda); PG_STAGE(PG_SB(1, 1), cB + (size_t)HALF * cldb + 128, cldb);
    PG_WAIT_V(6); PG_BAR;
    for (;;) {
        const bool has_next = S.next(ui + 1, nxt);
        const char* nA = has_next ? nxt.A : cA; const char* nB = has_next ? nxt.B : cB;
        const unsigned nlda = has_next ? nxt.lda : clda, nldb = has_next ? nxt.ldb : cldb;
        const int nt = cur.nt;
        for (int t = 0; t < nt; t += 2) {
            const bool last = (t == nt - 2);
            const char* a1 = cA + (size_t)(t + 1) * 128;
            const char* a2 = last ? nA : cA + (size_t)(t + 2) * 128; const char* b2 = last ? nB : cB + (size_t)(t + 2) * 128;
            const unsigned lda2 = last ? nlda : clda, ldb2 = last ? nldb : cldb;
            const char* a3 = a2 + 128; const char* b3 = b2 + 128;
            PG_LDB(B0, 0, 0); PG_LDB(B1, 0, 1); PG_SCHED; PG_LDA(At, 0, 0); PG_STAGE(PG_SA(1, 1), a1 + (size_t)HALF * clda, clda);
            PG_WAIT_V(8); PG_WAIT_L(0); PG_BAR; PG_MMA(0, 0, At, B0); PG_MMA(0, 1, At, B1); PG_BAR; PG_SCHED;
            PG_LDA(At, 0, 1); PG_STAGE(PG_SB(0, 0), b2, ldb2); PG_STAGE(PG_SB(0, 1), b2 + (size_t)HALF * ldb2, ldb2); PG_STAGE(PG_SA(0, 0), a2, lda2);
            PG_WAIT_V(8); PG_WAIT_L(0); PG_BAR; PG_MMA(1, 0, At, B0); PG_MMA(1, 1, At, B1); PG_BAR; PG_SCHED;
            PG_LDB(B0, 1, 0); PG_LDB(B1, 1, 1); PG_SCHED; PG_LDA(At, 1, 0); PG_STAGE(PG_SA(0, 1), a2 + (size_t)HALF * lda2, lda2);
            PG_WAIT_V(8); PG_WAIT_L(0); PG_BAR; PG_MMA(0, 0, At, B0); PG_MMA(0, 1, At, B1); PG_BAR; PG_SCHED;
            PG_LDA(At, 1, 1); PG_STAGE(PG_SB(1, 0), b3, ldb2); PG_STAGE(PG_SB(1, 1), b3 + (size_t)HALF * ldb2, ldb2); PG_STAGE(PG_SA(1, 0), a3, lda2);
            PG_WAIT_V(8); PG_WAIT_L(0); PG_BAR; PG_MMA(1, 0, At, B0); PG_MMA(1, 1, At, B1); PG_BAR; PG_SCHED;
        }
        if (wr == 0) PG_BAR;
        E(acc, cur, lds, wr, wc, fr, fq);
        if (!has_next) break;
#pragma unroll
        for (int a = 0; a < 2; ++a)
#pragma unroll
            for (int b = 0; b < 2; ++b)
#pragma unroll
                for (int m = 0; m < 4; ++m)
#pragma unroll
                    for (int n = 0; n < 2; ++n) acc[a][b][m][n] = (f32x4){0.f, 0.f, 0.f, 0.f};
        cur = nxt; cA = nA; cB = nB; clda = nlda; cldb = nldb; ++ui;
        if (wr == 1) PG_BAR;
    }
    PG_WAIT_V(0);
    PG_BAR;
#undef PG_SA
#undef PG_SB
#undef PG_STAGE
#undef PG_LDA
#undef PG_LDB
#undef PG_MMA
#undef PG_WAIT_V
#undef PG_WAIT_L
#undef PG_BAR
#undef PG_SCHED
}
}

struct MArgs { const float* in[24]; float* out; unsigned char* ws; int ph_lo, ph_hi, li, pad; };
struct Frame {
    LAS unsigned char* lds; int tid, lane, wave; int x, j, vcu, G;
    const MArgs* a; float* out; unsigned char* ws;
};
#define FIN(k) (F.a->in[k])
__device__ __forceinline__ float fwave_sum(float v) {
#pragma unroll
    for (int o = 1; o < 64; o <<= 1) v += __shfl_xor(v, o);
    return v;
}

enum { W_IN = 0, W_QUP, W_KVUP, W_OBA, W_OBB, W_OUT, W_UP, W_DOWN };
__device__ __forceinline__ int win_src(int gd) {
    const int tile = gd >> 3, g = gd & 7, bj = g >> 2, wc = g & 3;
    if (tile < 3) return C_QLAT + gd * 32;
    if (tile < 5) return C_KVLAT + (gd - 24) * 32;
    if (tile == 5) return (wc == 0) ? C_KPE + bj * 32 : -1;
    if (tile < 10) { const int base = tile < 8 ? C_RQ : C_RK, tl = tile < 8 ? tile - 6 : tile - 8; const int head = 2 * tl + (wc >> 1); return base + head * 128 + bj * 64 + (wc & 1) * 32; }
    if (tile < 14) return C_RV + (gd - 80) * 32;
    if (tile < 18) return C_RG + (gd - 112) * 32;
    if (tile < 22) return C_GA + (gd - 144) * 32;
    return C_GB + (gd - 176) * 32;
}
__device__ __forceinline__ int w_src_col(int wid, int row) {
    const int rho = row & 31, gd = row >> 5, p = pg::perm32(rho);
    const int s = row & 255, bj = s >> 7, wc = (s >> 5) & 3, t = row >> 8;
    switch (wid) {
    case W_IN: { const int b = win_src(gd); return b < 0 ? -1 : b + p; }
    case W_QUP: if (bj == 0) return t * 192 + 32 * wc + p; else { if (wc >= 2) return -1; const int n = rho >> 4, i = rho & 15; return t * 192 + 128 + 16 * wc + i + 32 * n; }
    case W_KVUP: return t * 256 + 128 * bj + 32 * wc + p;
    case W_UP: return (bj ? D_FF : 0) + 128 * t + 32 * wc + p;
    default: return gd * 32 + p;
    }
}
__device__ __forceinline__ void p0_weight_item(const float* __restrict__ W, int ldw, int K, const float* __restrict__ gain, int wid, bf16_t* __restrict__ Wt, int gd, int kb, LAS float* scr, int lane) {
    const int k0 = kb * 64; const int sc = w_src_col(wid, gd * 32 + (lane & 31));
    bf16_t* dst = Wt + (size_t)(gd * 32) * K + k0;
#pragma unroll 8
    for (int i = 0; i < 32; ++i) { const int kk = 2 * i + (lane >> 5); const float g = gain ? gain[k0 + kk] : 1.f; scr[kk * 33 + (lane & 31)] = sc < 0 ? 0.f : W[(size_t)(k0 + kk) * ldw + sc] * g; }
    asm volatile("s_waitcnt lgkmcnt(0)" ::: "memory");
    const int c = lane & 7;
#pragma unroll
    for (int jj = 0; jj < 4; ++jj) { const int n = (lane >> 3) + 8 * jj; const LAS float* s = scr + (8 * c) * 33 + n;
        u32x4 o; o.x = cvt_pk_bf16(s[0 * 33], s[1 * 33]); o.y = cvt_pk_bf16(s[2 * 33], s[3 * 33]); o.z = cvt_pk_bf16(s[4 * 33], s[5 * 33]); o.w = cvt_pk_bf16(s[6 * 33], s[7 * 33]);
        *(u32x4*)(dst + (size_t)n * K + 8 * c) = o; }
    asm volatile("s_waitcnt lgkmcnt(0)" ::: "memory");
}
__device__ __forceinline__ void p0_weights(Frame& F, LAS float* scr, int gw, int NGW, const float* W, int ldw, int K, const float* gain, int wid, size_t off, int ngroups) {
    const int nkb = K / 64; bf16_t* Wt = (bf16_t*)(F.ws + off);
    for (int it = gw; it < ngroups * nkb; it += NGW) { const int gd = it / nkb, kb = it % nkb; p0_weight_item(W, ldw, K, gain, wid, Wt, gd, kb, scr, F.lane); }
}
__device__ __forceinline__ void p0_prologue(Frame& F) {
    LAS float* scr = (LAS float*)(F.lds + F.wave * 16384);
    const int gw = F.vcu * 8 + F.wave, NGW = F.G * 8;
    p0_weights(F, scr, gw, NGW, FIN(7), IN_W, 1024, FIN(6), W_IN, WS_FWIN, 26 * 8);
    p0_weights(F, scr, gw, NGW, FIN(9), 1536, 768, FIN(8), W_QUP, WS_FWQUP, 8 * 8);
    p0_weights(F, scr, gw, NGW, FIN(13), 2048, 512, nullptr, W_KVUP, WS_FWKVUP, 8 * 8);
    p0_weights(F, scr, gw, NGW, FIN(17), 1024, 1024, nullptr, W_OBA, WS_FWOBA, 4 * 8);
    p0_weights(F, scr, gw, NGW, FIN(17) + (size_t)1024 * 1024, 1024, 1024, nullptr, W_OBB, WS_FWOBB, 4 * 8);
    p0_weights(F, scr, gw, NGW, FIN(18), 1024, 1024, nullptr, W_OUT, WS_FWOUT, 4 * 8);
    p0_weights(F, scr, gw, NGW, FIN(20), FF2, 1024, FIN(19), W_UP, WS_FWUP, 22 * 8);
    p0_weights(F, scr, gw, NGW, FIN(23), 1024, D_FF, nullptr, W_DOWN, WS_FWDOWN, 4 * 8);
    {   bf16_t* XN = (bf16_t*)(F.ws + WS_XN);
        for (int r = gw; r < MPAD; r += NGW) {
            u32x2* o8 = (u32x2*)(XN + (size_t)r * D_MODEL) + F.lane;
            if (r >= MT) { for (int jj = 0; jj < 4; ++jj) o8[64 * jj] = (u32x2){0u, 0u}; continue; }
            const float* x = r < MP ? FIN(0) + (size_t)r * D_MODEL : FIN(1) + (size_t)(r - MP) * D_MODEL;
            const f32x4* xr = (const f32x4*)x + F.lane; f32x4 v[4]; float s = 0.f;
#pragma unroll
            for (int jj = 0; jj < 4; ++jj) { v[jj] = xr[64 * jj]; s += (v[jj][0] * v[jj][0] + v[jj][1] * v[jj][1]) + (v[jj][2] * v[jj][2] + v[jj][3] * v[jj][3]); }
            const float inv = rsqrtf(fwave_sum(s) * (1.f / D_MODEL) + EPS);
#pragma unroll
            for (int jj = 0; jj < 4; ++jj) { u32x2 w; w.x = cvt_pk_bf16(v[jj][0] * inv, v[jj][1] * inv); w.y = cvt_pk_bf16(v[jj][2] * inv, v[jj][3] * inv); o8[64 * jj] = w; }
        } }
    {   bf16_t* lats = (bf16_t*)(F.ws + WS_LATS); bf16_t* pes = (bf16_t*)(F.ws + WS_PES);
        const int gt = F.vcu * NTHR + F.tid, NG = F.G * NTHR;
        for (int i = gt; i < DEC_BATCH * PAST * (KV_LORA / 4); i += NG) { const int c4 = i % (KV_LORA / 4), rj = i / (KV_LORA / 4), jr = rj % PAST, b = rj / PAST;
            const f32x4 v = *((const f32x4*)FIN(2) + i); u32x2 w; w.x = cvt_pk_bf16(v[0], v[1]); w.y = cvt_pk_bf16(v[2], v[3]);
            *(u32x2*)(lats + ((size_t)b * SKEYS + jr) * KV_LORA + c4 * 4) = w; }
        for (int i = gt; i < DEC_BATCH * PAST * (QK_ROPE / 4); i += NG) { const int c4 = i % (QK_ROPE / 4), rj = i / (QK_ROPE / 4), jr = rj % PAST, b = rj / PAST;
            const f32x4 v = *((const f32x4*)FIN(3) + i); u32x2 w; w.x = cvt_pk_bf16(v[0], v[1]); w.y = cvt_pk_bf16(v[2], v[3]);
            *(u32x2*)(pes + ((size_t)b * SKEYS + jr) * QK_ROPE + c4 * 4) = w; }
        float2* tab32 = (float2*)(F.ws + WS_TAB32); float2* tab64 = (float2*)(F.ws + WS_TAB64);
        for (int i = gt; i < 8192 * 64; i += NG) {
            { const int pos = i / 64, k = i % 64; const double f = pow(10000.0, -(double)k / 64.0), a = (double)pos * f; tab64[i] = make_float2((float)cos(a), (float)sin(a)); }
            if (i < 8192 * 32) { const int pos = i / 32, k = i % 32; const double f = pow(10000.0, -(double)k / 32.0), a = (double)pos * f; tab32[i] = make_float2((float)cos(a), (float)sin(a)); }
        } }
}

__device__ __forceinline__ bool reg_unit(int x, int j, int i, int nN, int& pm, int& pn) { const int u = j + 32 * i; if (u >= 8 * nN) return false; pm = 8 * x + (u & 7); pn = u >> 3; return true; }
#define LDS_F(off) ((LAS float*)(lds + EPI_OFF) + (off))

enum { K_QLAT = 0, K_KVLAT, K_KPE, K_RQ, K_RK, K_RV, K_RG, K_QUP, K_KVP, K_KVS, K_GA, K_AD, K_GB, K_RD, K_OUT, K_UP, K_DOWN };
struct SchedP1 {
    int x, j; const char* ws;
    __device__ __forceinline__ bool next(int i, pg::UnitG& u) const {
        int pm, pn;
        if (!reg_unit(x, j, i, 18, pm, pn)) { if (i == 4 && j >= 16) { const int k = (j - 16) * 8 + x; if (k >= 18) return false; pm = 64; pn = k; } else return false; }
        u.pm = pm; u.pn = pn; u.A = ws + WS_XN + (size_t)pm * 256 * 2048; u.B = ws + WS_FWIN + (size_t)pn * 256 * 2048; u.lda = 2048; u.ldb = 2048; u.nt = 16;
        u.kind = pn < 3 ? K_QLAT : pn < 5 ? K_KVLAT : pn == 5 ? K_KPE : pn < 8 ? K_RQ : pn < 10 ? K_RK : pn < 14 ? K_RV : K_RG;
        return true;
    }
};
struct EpiP1 {
    unsigned char* ws; float* out; const float *g_kvlat, *g_kr;
    __device__ __forceinline__ void operator()(const pg::Acc& acc, const pg::UnitG& u, LAS unsigned char* lds, int wr, int wc, int fr, int fq) const {
        bf16_t* const ZQ = (bf16_t*)(ws + WS_ZQ); bf16_t* const KVL = (bf16_t*)(ws + WS_KVL); bf16_t* const KPE = (bf16_t*)(ws + WS_KPE); bf16_t* const PES = (bf16_t*)(ws + WS_PES); bf16_t* const LATS = (bf16_t*)(ws + WS_LATS);
        bf16_t* const RQ = (bf16_t*)(ws + WS_RQ); bf16_t* const RK = (bf16_t*)(ws + WS_RK); bf16_t* const RV = (bf16_t*)(ws + WS_RV); bf16_t* const RG = (bf16_t*)(ws + WS_RG);
        float* const slotq = (float*)(ws + WS_SLOTQ); float* const slotkv = (float*)(ws + WS_SLOTKV);
        const float2* const tab32 = (const float2*)(ws + WS_TAB32); const float2* const tab64 = (const float2*)(ws + WS_TAB64);
        int rl0 = wr * 64 + fr, cw = wc * 32 + fq * 8; asm volatile("" : "+v"(rl0), "+v"(cw));
        const int kind = u.kind, rb = u.pm * 256 + rl0;
        if (kind == K_QLAT || kind == K_KVLAT) {
            const int t = kind == K_QLAT ? u.pn : u.pn - 3; const int ld = kind == K_QLAT ? Q_LORA : KV_LORA; bf16_t* dst = kind == K_QLAT ? ZQ : KVL;
            f32x4 g[2][2];
#pragma unroll
            for (int bj = 0; bj < 2; ++bj)
#pragma unroll
                for (int n = 0; n < 2; ++n) g[bj][n] = kind == K_KVLAT ? *(const f32x4*)(g_kvlat + t * 256 + bj * 128 + cw + 4 * n) : (f32x4){1.f, 1.f, 1.f, 1.f};
#pragma unroll
            for (int ai = 0; ai < 2; ++ai)
#pragma unroll
                for (int m = 0; m < 4; ++m) { const int row = rb + ai * 128 + m * 16; float ss = 0.f;
                    const bool snew = (kind == K_KVLAT) && row >= MP && row < MT;
                    const int rs = row - MP; bf16_t* lrow = LATS + ((size_t)(rs / DEC_SEQ) * SKEYS + PAST + (rs % DEC_SEQ)) * KV_LORA;
#pragma unroll
                    for (int bj = 0; bj < 2; ++bj) { const f32x4 v0 = acc[ai][bj][m][0], v1 = acc[ai][bj][m][1];
                        ss += (v0[0] * v0[0] + v0[1] * v0[1]) + (v0[2] * v0[2] + v0[3] * v0[3]) + (v1[0] * v1[0] + v1[1] * v1[1]) + (v1[2] * v1[2] + v1[3] * v1[3]);
                        const u32x4 w = pack8f(v0 * g[bj][0], v1 * g[bj][1]);
                        *(u32x4*)(dst + (size_t)row * ld + t * 256 + bj * 128 + cw) = w;
                        if (snew) *(u32x4*)(lrow + t * 256 + bj * 128 + cw) = w; }
                    ss += __shfl_xor(ss, 16); ss += __shfl_xor(ss, 32);
                    if (fq == 0) { if (kind == K_QLAT) slotq[(size_t)row * 12 + t * 4 + wc] = ss; else slotkv[(size_t)row * 8 + t * 4 + wc] = ss; } }
        } else if (kind == K_KPE) {
            if (wc != 0) return;
            const int d0 = fq * 8;
            f32x4 g1[2], g2[2];
#pragma unroll
            for (int n = 0; n < 2; ++n) { g1[n] = *(const f32x4*)(g_kr + d0 + 4 * n); g2[n] = *(const f32x4*)(g_kr + 32 + d0 + 4 * n); }
#pragma unroll
            for (int ai = 0; ai < 2; ++ai)
#pragma unroll
                for (int m = 0; m < 4; ++m) { const int row = rb + ai * 128 + m * 16; const int pos = row_pos(row < MT ? row : 0);
                    f32x4 x1[2], x2[2]; float ss = 0.f;
#pragma unroll
                    for (int n = 0; n < 2; ++n) { x1[n] = acc[ai][0][m][n]; x2[n] = acc[ai][1][m][n];
                        ss += (x1[n][0] * x1[n][0] + x1[n][1] * x1[n][1]) + (x1[n][2] * x1[n][2] + x1[n][3] * x1[n][3]) + (x2[n][0] * x2[n][0] + x2[n][1] * x2[n][1]) + (x2[n][2] * x2[n][2] + x2[n][3] * x2[n][3]); }
                    ss += __shfl_xor(ss, 16); ss += __shfl_xor(ss, 32);
                    const float inv = rsqrtf(ss * (1.f / 64.f) + EPS);
                    f32x4 o1[2], o2[2];
#pragma unroll
                    for (int n = 0; n < 2; ++n) { const f32x4 y1 = x1[n] * inv * g1[n], y2 = x2[n] * inv * g2[n];
                        const f32x4 cs0 = *(const f32x4*)(tab32 + pos * 32 + d0 + 4 * n), cs1 = *(const f32x4*)(tab32 + pos * 32 + d0 + 4 * n + 2);
                        const f32x4 c = {cs0[0], cs0[2], cs1[0], cs1[2]}, s = {cs0[1], cs0[3], cs1[1], cs1[3]};
                        o1[n] = y1 * c - y2 * s; o2[n] = y1 * s + y2 * c; }
                    *(u32x4*)(KPE + (size_t)row * 64 + d0) = pack8f(o1[0], o1[1]); *(u32x4*)(KPE + (size_t)row * 64 + 32 + d0) = pack8f(o2[0], o2[1]);
                    if (row < MT) {
                        float* o = row < MP ? out + O_RKP + (size_t)row * 64 : out + O_RKS + (size_t)(row - MP) * 64;
                        *(f32x4*)(o + d0) = o1[0]; *(f32x4*)(o + d0 + 4) = o1[1]; *(f32x4*)(o + 32 + d0) = o2[0]; *(f32x4*)(o + 32 + d0 + 4) = o2[1];
                        if (row >= MP) { const int rs = row - MP, b = rs / DEC_SEQ, tt = rs % DEC_SEQ; bf16_t* p = PES + ((size_t)b * SKEYS + PAST + tt) * 64;
                            *(u32x4*)(p + d0) = pack8f(o1[0], o1[1]); *(u32x4*)(p + 32 + d0) = pack8f(o2[0], o2[1]); } } }
        } else if (kind == K_RQ || kind == K_RK) {
            const int tl = kind == K_RQ ? u.pn - 6 : u.pn - 8; const int head = 2 * tl + (wc >> 1), i0 = 32 * (wc & 1) + fq * 8;
            bf16_t* dst = kind == K_RQ ? RQ : RK; const float sc = kind == K_RQ ? 1.0f : 0.08838834764831845f;
#pragma unroll
            for (int ai = 0; ai < 2; ++ai)
#pragma unroll
                for (int m = 0; m < 4; ++m) { const int row = rb + ai * 128 + m * 16; const int pos = row_pos(row < MT ? row : 0);
                    f32x4 o1[2], o2[2];
#pragma unroll
                    for (int n = 0; n < 2; ++n) { const f32x4 x1 = acc[ai][0][m][n], x2 = acc[ai][1][m][n];
                        const f32x4 cs0 = *(const f32x4*)(tab64 + pos * 64 + i0 + 4 * n), cs1 = *(const f32x4*)(tab64 + pos * 64 + i0 + 4 * n + 2);
                        const f32x4 c = {cs0[0], cs0[2], cs1[0], cs1[2]}, s = {cs0[1], cs0[3], cs1[1], cs1[3]};
                        o1[n] = (x1 * c - x2 * s) * sc; o2[n] = (x1 * s + x2 * c) * sc; }
                    *(u32x4*)(dst + (size_t)row * 512 + head * 128 + i0) = pack8f(o1[0], o1[1]); *(u32x4*)(dst + (size_t)row * 512 + head * 128 + 64 + i0) = pack8f(o2[0], o2[1]); }
        } else {
            const int t = kind == K_RV ? u.pn - 10 : u.pn - 14; bf16_t* dst = kind == K_RV ? RV : RG;
#pragma unroll
            for (int ai = 0; ai < 2; ++ai)
#pragma unroll
                for (int m = 0; m < 4; ++m) { const int row = rb + ai * 128 + m * 16;
#pragma unroll
                    for (int bj = 0; bj < 2; ++bj) { f32x4 v0 = acc[ai][bj][m][0], v1 = acc[ai][bj][m][1];
                        if (kind == K_RG) {
#pragma unroll
                            for (int e = 0; e < 4; ++e) { v0[e] = v0[e] / (1.f + __expf(-v0[e])); v1[e] = v1[e] / (1.f + __expf(-v1[e])); } }
                        *(u32x4*)(dst + (size_t)row * 1024 + t * 256 + bj * 128 + cw) = pack8f(v0, v1); } }
        }
    }
};
__device__ __forceinline__ void p1_inproj(Frame& F) {
    SchedP1 S{F.x, F.j, (const char*)F.ws};
    EpiP1 E{F.ws, F.out, FIN(12), FIN(15)};
    pg::gemm_stream(F.lds, S, E);
}

__device__ __forceinline__ float slot_rs(const float* slots, int n, float invn) {
    float a = 0.f; for (int i = 0; i < n; i += 4) { const f32x4 v = *(const f32x4*)(slots + i); a += (v[0] + v[1]) + (v[2] + v[3]); } return rsqrtf(a * invn + EPS);
}
struct SchedP2 {
    int x, j; const char* ws; int sample;
    __device__ __forceinline__ bool next(int i, pg::UnitG& u) const {
        int pm, pn, kind;
        if (sample) {
            if (i < 2) { reg_unit(x, j, i, 8, pm, pn); kind = K_QUP; }
            else if (i < 4) { reg_unit(x, j, i - 2, 8, pm, pn); kind = K_KVS; }
            else if (i == 4 && j < 2) { const int k = j * 8 + x; pm = 64; pn = k & 7; kind = k < 8 ? K_QUP : K_KVS; }
            else return false;
        } else { if (i >= 2) return false; reg_unit(x, j, i, 8, pm, pn); kind = K_KVP; }
        u.pm = pm; u.pn = pn; u.kind = kind;
        if (kind == K_QUP) { u.A = ws + WS_ZQ + (size_t)pm * 256 * 1536; u.lda = 1536; u.B = ws + WS_FWQUP + (size_t)pn * 256 * 1536; u.ldb = 1536; u.nt = 12; }
        else { u.A = ws + (kind == K_KVS ? WS_LATS : WS_KVL) + (size_t)pm * 256 * 1024; u.lda = 1024; u.B = ws + WS_FWKVUP + (size_t)pn * 256 * 1024; u.ldb = 1024; u.nt = 8; }
        return true;
    }
};
struct EpiP2 {
    unsigned char* ws; float* out; const float *g_qn, *g_qr, *g_kn;
    __device__ __forceinline__ void operator()(const pg::Acc& acc, const pg::UnitG& u, LAS unsigned char* lds, int wr, int wc, int fr, int fq) const {
        int rl0 = wr * 64 + fr, cw = wc * 32 + fq * 8; asm volatile("" : "+v"(rl0), "+v"(cw));
        const int kind = u.kind, h = u.pn, rb = u.pm * 256 + rl0;
        const float* const slotq = (const float*)(ws + WS_SLOTQ); const float* const slotkv = (const float*)(ws + WS_SLOTKV);
        float rs[2][4];
#pragma unroll
        for (int ai = 0; ai < 2; ++ai)
#pragma unroll
            for (int m = 0; m < 4; ++m) { const int row = rb + ai * 128 + m * 16;
                if (kind == K_QUP) rs[ai][m] = slot_rs(slotq + (size_t)row * 12, 12, 1.f / Q_LORA);
                else if (kind == K_KVP) rs[ai][m] = slot_rs(slotkv + (size_t)row * 8, 8, 1.f / KV_LORA);
                else { const int b = row / SKEYS, jj = row - b * SKEYS; rs[ai][m] = (row < LROWS && jj >= PAST) ? slot_rs(slotkv + (size_t)(MP + b * DEC_SEQ + jj - PAST) * 8, 8, 1.f / KV_LORA) : 1.f; } }
#pragma unroll
        for (int ai = 0; ai < 2; ++ai)
#pragma unroll
            for (int m = 0; m < 4; ++m) { float p0 = 0.f, p1 = 0.f; const float s2 = rs[ai][m] * rs[ai][m];
#pragma unroll
                for (int n = 0; n < 2; ++n) { const f32x4 a = acc[ai][0][m][n], b = acc[ai][1][m][n];
                    p0 += (a[0] * a[0] + a[1] * a[1]) + (a[2] * a[2] + a[3] * a[3]); p1 += (b[0] * b[0] + b[1] * b[1]) + (b[2] * b[2] + b[3] * b[3]); }
                p0 += __shfl_xor(p0, 16); p0 += __shfl_xor(p0, 32); p1 += __shfl_xor(p1, 16); p1 += __shfl_xor(p1, 32);
                if (fq == 0) { LAS float* d = LDS_F((rl0 + ai * 128 + m * 16) * 8 + wc * 2); d[0] = p0 * s2; d[1] = p1 * s2; } }
        asm volatile("s_waitcnt lgkmcnt(0)" ::: "memory"); __builtin_amdgcn_s_barrier(); asm volatile("" ::: "memory");
        if (kind == K_QUP) {
            bf16_t* const Q = (bf16_t*)out;
            const float2* const tab32 = (const float2*)(ws + WS_TAB32);
            const float C2 = 0.07216878364870323f * 1.4426950408889634f;
            f32x4 gn[2]; gn[0] = *(const f32x4*)(g_qn + cw); gn[1] = *(const f32x4*)(g_qn + cw + 4);
            const int ir = 16 * (wc & 1) + 4 * fq; const f32x4 gr1 = *(const f32x4*)(g_qr + ir), gr2 = *(const f32x4*)(g_qr + 32 + ir);
#pragma unroll
            for (int ai = 0; ai < 2; ++ai)
#pragma unroll
                for (int m = 0; m < 4; ++m) { const int row = rb + ai * 128 + m * 16; const int pos = row_pos(row < MT ? row : 0);
                    const LAS float* d = LDS_F((rl0 + ai * 128 + m * 16) * 8); const f32x4 e0 = *(const LAS f32x4*)d, e1 = *(const LAS f32x4*)(d + 4);
                    const float inn = rsqrtf((e0[0] + e0[2] + e1[0] + e1[2]) * (1.f / 128.f) + EPS) * rs[ai][m] * C2, inr = rsqrtf((e0[1] + e0[3]) * (1.f / 64.f) + EPS) * rs[ai][m];
                    bf16_t* qrow = Q + (size_t)row * 1536 + h * 192;
                    *(u32x4*)(qrow + cw) = pack8f(acc[ai][0][m][0] * inn * gn[0], acc[ai][0][m][1] * inn * gn[1]);
                    if (wc < 2) { const f32x4 y1 = acc[ai][1][m][0] * inr * gr1, y2 = acc[ai][1][m][1] * inr * gr2;
                        const f32x4 cs0 = *(const f32x4*)(tab32 + pos * 32 + ir), cs1 = *(const f32x4*)(tab32 + pos * 32 + ir + 2);
                        const f32x4 c = {cs0[0], cs0[2], cs1[0], cs1[2]}, s = {cs0[1], cs0[3], cs1[1], cs1[3]};
                        const f32x4 o1 = (y1 * c - y2 * s) * C2, o2 = (y1 * s + y2 * c) * C2;
                        u32x2 w1, w2; w1.x = cvt_pk_bf16(o1[0], o1[1]); w1.y = cvt_pk_bf16(o1[2], o1[3]); w2.x = cvt_pk_bf16(o2[0], o2[1]); w2.y = cvt_pk_bf16(o2[2], o2[3]);
                        *(u32x2*)(qrow + 128 + ir) = w1; *(u32x2*)(qrow + 160 + ir) = w2; } }
        } else {
            bf16_t* const KN = (bf16_t*)(ws + WS_KN); bf16_t* const V = (bf16_t*)(ws + WS_V);
            f32x4 gk[2]; gk[0] = *(const f32x4*)(g_kn + cw); gk[1] = *(const f32x4*)(g_kn + cw + 4);
#pragma unroll
            for (int ai = 0; ai < 2; ++ai)
#pragma unroll
                for (int m = 0; m < 4; ++m) { const int row = rb + ai * 128 + m * 16;
                    const LAS float* d = LDS_F((rl0 + ai * 128 + m * 16) * 8); const f32x4 e0 = *(const LAS f32x4*)d, e1 = *(const LAS f32x4*)(d + 4);
                    const float s = rs[ai][m], inn = rsqrtf((e0[0] + e0[2] + e1[0] + e1[2]) * (1.f / 128.f) + EPS) * s;
                    *(u32x4*)(KN + (size_t)row * 1024 + h * 128 + cw) = pack8f(acc[ai][0][m][0] * inn * gk[0], acc[ai][0][m][1] * inn * gk[1]);
                    *(u32x4*)(V + (size_t)row * 1024 + h * 128 + cw) = pack8f(acc[ai][1][m][0] * s, acc[ai][1][m][1] * s); }
        }
    }
};
__device__ __forceinline__ void p2_qkv(Frame& F, int sample) {
    SchedP2 S{F.x, F.j, (const char*)F.ws, sample};
    EpiP2 E{F.ws, F.out, FIN(10), FIN(11), FIN(14)};
    pg::gemm_stream(F.lds, S, E);
}

struct SchedP5 {
    int x, j, vcu; const char* ws; int phase;
    __device__ __forceinline__ const char* arow(size_t base, size_t base_s, int pm, size_t rowbytes) const { return ws + (pm < 64 ? base + (size_t)pm * 256 * rowbytes : base_s); }
    __device__ __forceinline__ bool next(int i, pg::UnitG& u) const {
        int pm, pn;
        if (phase == 5) {
            const int sub = i & 3, tile = i >> 2;
            if (tile == 0) { pm = 8 * x + (j & 7); pn = j >> 3; } else if (tile == 1 && j == 0 && x < 4) { pm = 64; pn = x; } else return false;
            u.pm = pm; u.pn = pn; u.kind = K_GA + sub; u.lda = 2048; u.ldb = 2048; u.nt = 16;
            if (sub == 0) { u.A = ws + WS_XN2 + (size_t)pm * 256 * 2048; u.B = ws + WS_FWIN + (size_t)(18 + pn) * 256 * 2048; }
            else if (sub == 1) { u.A = arow(WS_ATT, WS_ATTS, pm, 2048); u.B = ws + WS_FWOBA + (size_t)pn * 256 * 2048; }
            else if (sub == 2) { u.A = ws + WS_XN2 + (size_t)pm * 256 * 2048; u.B = ws + WS_FWIN + (size_t)(22 + pn) * 256 * 2048; }
            else { u.A = ws + WS_RET + (size_t)pm * 256 * 2048; u.B = ws + WS_FWOBB + (size_t)pn * 256 * 2048; }
            return true;
        }
        if (phase == 6 || phase == 9) {
            if (i == 0) { pm = 8 * x + (j & 7); pn = j >> 3; } else if (i == 1 && j == 0 && x < 4) { pm = 64; pn = x; } else return false;
            u.pm = pm; u.pn = pn;
            if (phase == 6) { u.kind = K_OUT; u.A = ws + WS_MERGED + (size_t)pm * 256 * 2048; u.lda = 2048; u.B = ws + WS_FWOUT + (size_t)pn * 256 * 2048; u.ldb = 2048; u.nt = 16; }
            else { u.kind = K_DOWN; u.A = ws + WS_U + (size_t)pm * 256 * (FF2 * 2); u.lda = FF2 * 2; u.B = ws + WS_FWDOWN + (size_t)pn * 256 * (D_FF * 2); u.ldb = D_FF * 2; u.nt = 44; }
            return true;
        }
        if (!reg_unit(x, j, i, 22, pm, pn)) { if (i == 5 && j >= 16) { const int k = (j - 16) * 8 + x; if (k >= 22) return false; pm = 64; pn = k; } else return false; }
        u.pm = pm; u.pn = pn; u.kind = K_UP; u.A = ws + WS_X1B + (size_t)pm * 256 * 2048; u.lda = 2048; u.B = ws + WS_FWUP + (size_t)pn * 256 * 2048; u.ldb = 2048; u.nt = 16;
        return true;
    }
};
struct EpiP5 {
    unsigned char* ws; float* out; const float* xp; const float* xs; int vcu;
    __device__ __forceinline__ void operator()(pg::Acc& acc, const pg::UnitG& u, LAS unsigned char* lds, int wr, int wc, int fr, int fq) const {
        int rl0 = wr * 64 + fr, cw = wc * 32 + fq * 8; asm volatile("" : "+v"(rl0), "+v"(cw));
        const int kind = u.kind, rb = u.pm * 256 + rl0;
        if (kind >= K_GA && kind <= K_RD) {
            bf16_t* const T1 = (bf16_t*)(ws + WS_T1) + (size_t)vcu * 65536; bf16_t* const T2 = (bf16_t*)out + (size_t)vcu * 65536;
            bf16_t* const MG = (bf16_t*)(ws + WS_MERGED);
#pragma unroll
            for (int ai = 0; ai < 2; ++ai)
#pragma unroll
                for (int m = 0; m < 4; ++m)
#pragma unroll
                    for (int bj = 0; bj < 2; ++bj) { const size_t so = (size_t)(rl0 + ai * 128 + m * 16) * 256 + bj * 128 + cw;
                        f32x4 v0 = acc[ai][bj][m][0], v1 = acc[ai][bj][m][1];
                        if (kind == K_GA || kind == K_GB) {
#pragma unroll
                            for (int e = 0; e < 4; ++e) { v0[e] = 1.f / (1.f + __expf(-v0[e])); v1[e] = 1.f / (1.f + __expf(-v1[e])); }
                            *(u32x4*)((kind == K_GA ? T1 : T2) + so) = pack8f(v0, v1);
                        } else if (kind == K_AD) {
                            const u32x4 t = *(const u32x4*)(T1 + so);
                            const f32x4 g0 = {__uint_as_float(t.x << 16), __uint_as_float(t.x & 0xffff0000u), __uint_as_float(t.y << 16), __uint_as_float(t.y & 0xffff0000u)};
                            const f32x4 g1 = {__uint_as_float(t.z << 16), __uint_as_float(t.z & 0xffff0000u), __uint_as_float(t.w << 16), __uint_as_float(t.w & 0xffff0000u)};
                            *(u32x4*)(T1 + so) = pack8f(v0 * g0, v1 * g1);
                        } else {
                            const u32x4 t = *(const u32x4*)(T1 + so), q = *(const u32x4*)(T2 + so);
                            const f32x4 a0 = {__uint_as_float(t.x << 16), __uint_as_float(t.x & 0xffff0000u), __uint_as_float(t.y << 16), __uint_as_float(t.y & 0xffff0000u)};
                            const f32x4 a1 = {__uint_as_float(t.z << 16), __uint_as_float(t.z & 0xffff0000u), __uint_as_float(t.w << 16), __uint_as_float(t.w & 0xffff0000u)};
                            const f32x4 g0 = {__uint_as_float(q.x << 16), __uint_as_float(q.x & 0xffff0000u), __uint_as_float(q.y << 16), __uint_as_float(q.y & 0xffff0000u)};
                            const f32x4 g1 = {__uint_as_float(q.z << 16), __uint_as_float(q.z & 0xffff0000u), __uint_as_float(q.w << 16), __uint_as_float(q.w & 0xffff0000u)};
                            *(u32x4*)(MG + (size_t)(rb + ai * 128 + m * 16) * 1024 + u.pn * 256 + bj * 128 + cw) = pack8f(a0 + v0 * g0, a1 + v1 * g1);
                        }
                        if (bj == 1 && (m & 1)) asm volatile("" ::: "memory"); }
            if (kind != K_RD) asm volatile("s_waitcnt vmcnt(0)" ::: "memory");
        } else if (kind == K_OUT) {
            float* const slotx = (float*)(ws + WS_SLOTX1); bf16_t* const X1B = (bf16_t*)(ws + WS_X1B);
#pragma unroll
            for (int ai = 0; ai < 2; ++ai)
#pragma unroll
                for (int m = 0; m < 4; ++m) { const int row = rb + ai * 128 + m * 16; float ss = 0.f;
                    const float* xr = row < MP ? xp + (size_t)row * D_MODEL : xs + (size_t)((row < MT ? row : MP) - MP) * D_MODEL;
#pragma unroll
                    for (int bj = 0; bj < 2; ++bj) { const int c = u.pn * 256 + bj * 128 + cw;
                        const f32x4 x0 = *(const f32x4*)(xr + c), x1 = *(const f32x4*)(xr + c + 4);
                        const f32x4 v0 = acc[ai][bj][m][0] + x0, v1 = acc[ai][bj][m][1] + x1;
                        ss += (v0[0] * v0[0] + v0[1] * v0[1]) + (v0[2] * v0[2] + v0[3] * v0[3]) + (v1[0] * v1[0] + v1[1] * v1[1]) + (v1[2] * v1[2] + v1[3] * v1[3]);
                        if (row < MT) { *(f32x4*)(out + (size_t)row * D_MODEL + c) = v0; *(f32x4*)(out + (size_t)row * D_MODEL + c + 4) = v1; }
                        *(u32x4*)(X1B + (size_t)row * D_MODEL + c) = pack8f(v0, v1); }
                    ss += __shfl_xor(ss, 16); ss += __shfl_xor(ss, 32);
                    if (fq == 0) slotx[(size_t)row * 16 + u.pn * 4 + wc] = ss;
                    asm volatile("" ::: "memory"); }
        } else if (kind == K_UP) {
            const float* const slotx = (const float*)(ws + WS_SLOTX1); bf16_t* const U = (bf16_t*)(ws + WS_U);
#pragma unroll
            for (int ai = 0; ai < 2; ++ai)
#pragma unroll
                for (int m = 0; m < 4; ++m) { const int row = rb + ai * 128 + m * 16;
                    float a = 0.f;
#pragma unroll
                    for (int i = 0; i < 16; i += 4) { const f32x4 v = *(const f32x4*)(slotx + (size_t)row * 16 + i); a += (v[0] + v[1]) + (v[2] + v[3]); }
                    const float s = rsqrtf(a * (1.f / D_MODEL) + EPS);
                    const f32x4 ug0 = acc[ai][0][m][0] * s, ug1 = acc[ai][0][m][1] * s, uv0 = acc[ai][1][m][0] * s, uv1 = acc[ai][1][m][1] * s;
                    const u32x4 wg = pack8f(ug0, ug1), wv = pack8f(uv0, uv1); const int cg = u.pn * 128 + cw, cv = D_FF + cg;
                    *(u32x4*)(U + (size_t)row * FF2 + cg) = wg; *(u32x4*)(U + (size_t)row * FF2 + cv) = wv;
                    if ((row & 255) >= 254 && row < MP - 2) { bf16_t* hp = (bf16_t*)(ws + WS_HALO) + ((size_t)((row >> 8) + 1) * 2 + (row & 1)) * FF2; *(u32x4*)(hp + cg) = wg; *(u32x4*)(hp + cv) = wv; }
                    if (row < MT) { const int tpos = row < MP ? (row & (SEQ - 1)) - (SEQ - 2) : ((row - MP) & (DEC_SEQ - 1)) - (DEC_SEQ - 2);
                        if (tpos >= 0) { float* cp = row < MP ? out + O_CONVP + ((size_t)(row >> 13) * 2 + tpos) * FF2 : out + O_CONVS + ((size_t)((row - MP) >> 4) * 2 + tpos) * FF2;
                            *(f32x4*)(cp + cg) = ug0; *(f32x4*)(cp + cg + 4) = ug1; *(f32x4*)(cp + cv) = uv0; *(f32x4*)(cp + cv + 4) = uv1; } }
                    if (m & 1) asm volatile("" ::: "memory"); }
        } else {
#pragma unroll
            for (int ai = 0; ai < 2; ++ai)
#pragma unroll
                for (int m = 0; m < 4; ++m) { const int row = rb + ai * 128 + m * 16; if (row >= MT) continue;
#pragma unroll
                    for (int bj = 0; bj < 2; ++bj) { float* p = out + (size_t)row * D_MODEL + u.pn * 256 + bj * 128 + cw;
                        const f32x4 x0 = *(const f32x4*)p, x1 = *(const f32x4*)(p + 4);
                        *(f32x4*)p = x0 + acc[ai][bj][m][0]; *(f32x4*)(p + 4) = x1 + acc[ai][bj][m][1]; }
                    asm volatile("" ::: "memory"); }
        }
    }
};
__device__ __forceinline__ void p5_gemm(Frame& F, int phase) {
    SchedP5 S{F.x, F.j, F.vcu, (const char*)F.ws, phase};
    EpiP5 E{F.ws, F.out, FIN(0), FIN(1), F.vcu};
    pg::gemm_stream(F.lds, S, E);
}

namespace rt {
typedef short s16x4 __attribute__((ext_vector_type(4)));
constexpr int QST = 136, KDST = 144, VST = 272, PST = 72;
constexpr int Q_OFF = 0, QS_OFF = 17408, K_OFF = 34816, KD_OFF = 52224, V_OFF = 70656, P_OFF = 105472, ST_OFF = 114688;
constexpr int SC_TOK = 256, NSC = SEQ / SC_TOK;
__device__ __forceinline__ s16x4 trrd(const LAS bf16_t* p) { return __builtin_bit_cast(s16x4, __builtin_amdgcn_ds_read_tr16_b64_v4i16((LAS s16x4*)p)); }
__device__ __forceinline__ bf16x8 cat8(s16x4 lo, s16x4 hi) { return (bf16x8){lo[0], lo[1], lo[2], lo[3], hi[0], hi[1], hi[2], hi[3]}; }
__device__ __forceinline__ u32x4 scale8(u32x4 w, float s) {
    u32x4 o;
    o.x = cvt_pk_bf16(__uint_as_float(w.x << 16) * s, __uint_as_float(w.x & 0xffff0000u) * s); o.y = cvt_pk_bf16(__uint_as_float(w.y << 16) * s, __uint_as_float(w.y & 0xffff0000u) * s);
    o.z = cvt_pk_bf16(__uint_as_float(w.z << 16) * s, __uint_as_float(w.z & 0xffff0000u) * s); o.w = cvt_pk_bf16(__uint_as_float(w.w << 16) * s, __uint_as_float(w.w & 0xffff0000u) * s);
    return o;
}
template <bool FULL>
__device__ __forceinline__ void ret_unit(Frame& F, int h, int row0, int nch, int L, const float* Sin, float* Sout, const float* g_ret) {
    LAS unsigned char* lds = F.lds;
    const int tid = F.tid, w = F.wave, l = F.lane, fr = l & 15, g = l >> 4, tq = fr >> 2, tp = fr & 3;
    const float lg2 = log2f(1.f - exp2f(-5.f - (float)h));
    const bf16_t* RQ = (const bf16_t*)(F.ws + WS_RQ); const bf16_t* RK = (const bf16_t*)(F.ws + WS_RK); const bf16_t* RV = (const bf16_t*)(F.ws + WS_RV);
    const bf16_t* RG = (const bf16_t*)(F.ws + WS_RG); bf16_t* RET = (bf16_t*)(F.ws + WS_RET);
    LAS bf16_t* q_l = (LAS bf16_t*)(lds + Q_OFF); LAS bf16_t* qs_l = (LAS bf16_t*)(lds + QS_OFF); LAS bf16_t* k_l = (LAS bf16_t*)(lds + K_OFF);
    LAS bf16_t* kd_l = (LAS bf16_t*)(lds + KD_OFF); LAS bf16_t* v_l = (LAS bf16_t*)(lds + V_OFF); LAS bf16_t* p_l = (LAS bf16_t*)(lds + P_OFF); LAS float* st_l = (LAS float*)(lds + ST_OFF);
    f32x4 S[8][2];
#pragma unroll
    for (int db = 0; db < 8; ++db)
#pragma unroll
        for (int nb = 0; nb < 2; ++nb) {
            if (Sin) {
#pragma unroll
                for (int r = 0; r < 4; ++r) S[db][nb][r] = Sin[(size_t)(16 * db + 4 * g + r) * RET_DV + 32 * w + 16 * nb + fr]; }
            else S[db][nb] = (f32x4){0.f, 0.f, 0.f, 0.f}; }
    const float gL = exp2f(lg2 * (float)L);
    for (int c = 0; c < nch; ++c) {
        const size_t r0 = (size_t)row0 + (size_t)c * L;
        __syncthreads();
#pragma unroll
        for (int it = 0; it < 2; ++it) { const int idx = tid + 512 * it, tok = idx >> 4, c8 = idx & 15; const bool ok = tok < L;
            u32x4 kk = {0u, 0u, 0u, 0u}, qq = {0u, 0u, 0u, 0u};
            if (ok) { kk = *(const u32x4*)(RK + (r0 + tok) * 512 + h * 128 + c8 * 8); if (FULL) qq = *(const u32x4*)(RQ + (r0 + tok) * 512 + h * 128 + c8 * 8); }
            *(LAS u32x4*)(kd_l + tok * KDST + c8 * 8) = scale8(kk, exp2f(lg2 * (float)(L - 1 - tok)));
            if (FULL) { *(LAS u32x4*)(k_l + tok * QST + c8 * 8) = kk; *(LAS u32x4*)(q_l + tok * QST + c8 * 8) = qq; *(LAS u32x4*)(qs_l + tok * QST + c8 * 8) = scale8(qq, exp2f(lg2 * (float)(tok + 1))); } }
#pragma unroll
        for (int it = 0; it < 4; ++it) { const int idx = tid + 512 * it, tok = idx >> 5, c8 = idx & 31; u32x4 vv = {0u, 0u, 0u, 0u};
            if (tok < L) vv = *(const u32x4*)(RV + (r0 + tok) * 1024 + h * 256 + c8 * 8);
            *(LAS u32x4*)(v_l + tok * VST + c8 * 8) = vv; }
        __syncthreads();
        f32x4 o[4][2];
        if (FULL) {
            const int ib = w >> 1, jb0 = 2 * (w & 1);
            f32x4 p0 = {0.f, 0.f, 0.f, 0.f}, p1 = {0.f, 0.f, 0.f, 0.f};
#pragma unroll
            for (int s = 0; s < 4; ++s) { const bf16x8 a = *(const LAS bf16x8*)(q_l + (16 * ib + fr) * QST + 32 * s + 8 * g);
                const bf16x8 b0 = *(const LAS bf16x8*)(k_l + (16 * jb0 + fr) * QST + 32 * s + 8 * g), b1 = *(const LAS bf16x8*)(k_l + (16 * jb0 + 16 + fr) * QST + 32 * s + 8 * g);
                p0 = __builtin_amdgcn_mfma_f32_16x16x32_bf16(a, b0, p0, 0, 0, 0); p1 = __builtin_amdgcn_mfma_f32_16x16x32_bf16(a, b1, p1, 0, 0, 0); }
#pragma unroll
            for (int r = 0; r < 4; ++r) { const int i = 16 * ib + 4 * g + r, j0 = 16 * jb0 + fr, j1 = j0 + 16;
                const float v0 = j0 <= i ? p0[r] * exp2f(lg2 * (float)(i - j0)) : 0.f, v1 = j1 <= i ? p1[r] * exp2f(lg2 * (float)(i - j1)) : 0.f;
                p_l[i * PST + j0] = f2bf(v0); p_l[i * PST + j1] = f2bf(v1); }
            __syncthreads();
#pragma unroll
            for (int i = 0; i < 4; ++i) { o[i][0] = (f32x4){0.f, 0.f, 0.f, 0.f}; o[i][1] = (f32x4){0.f, 0.f, 0.f, 0.f}; }
        }
        bf16x8 vf[2][2];
#pragma unroll
        for (int s = 0; s < 2; ++s)
#pragma unroll
            for (int nb = 0; nb < 2; ++nb) { const LAS bf16_t* p = v_l + (32 * s + 8 * g + tq) * VST + 32 * w + 16 * nb + 4 * tp; vf[s][nb] = cat8(trrd(p), trrd(p + 4 * VST)); }
        if (FULL) {
#pragma unroll
            for (int i = 0; i < 4; ++i)
#pragma unroll
                for (int s = 0; s < 2; ++s) { const bf16x8 a = *(const LAS bf16x8*)(p_l + (16 * i + fr) * PST + 32 * s + 8 * g);
                    o[i][0] = __builtin_amdgcn_mfma_f32_16x16x32_bf16(a, vf[s][0], o[i][0], 0, 0, 0); o[i][1] = __builtin_amdgcn_mfma_f32_16x16x32_bf16(a, vf[s][1], o[i][1], 0, 0, 0); }
#pragma unroll
            for (int s = 0; s < 4; ++s) {
                bf16x8 bS[2];
#pragma unroll
                for (int nb = 0; nb < 2; ++nb) { u32x4 wv; wv.x = cvt_pk_bf16(S[2 * s][nb][0], S[2 * s][nb][1]); wv.y = cvt_pk_bf16(S[2 * s][nb][2], S[2 * s][nb][3]);
                    wv.z = cvt_pk_bf16(S[2 * s + 1][nb][0], S[2 * s + 1][nb][1]); wv.w = cvt_pk_bf16(S[2 * s + 1][nb][2], S[2 * s + 1][nb][3]); bS[nb] = __builtin_bit_cast(bf16x8, wv); }
#pragma unroll
                for (int i = 0; i < 4; ++i) { const LAS bf16_t* qp = qs_l + (16 * i + fr) * QST + 32 * s + 4 * g;
                    const s16x4 lo = *(const LAS s16x4*)qp, hi = *(const LAS s16x4*)(qp + 16); const bf16x8 a = cat8(lo, hi);
                    o[i][0] = __builtin_amdgcn_mfma_f32_16x16x32_bf16(a, bS[0], o[i][0], 0, 0, 0); o[i][1] = __builtin_amdgcn_mfma_f32_16x16x32_bf16(a, bS[1], o[i][1], 0, 0, 0); }
            }
        }
#pragma unroll
        for (int db = 0; db < 8; ++db) { S[db][0] = S[db][0] * gL; S[db][1] = S[db][1] * gL; }
#pragma unroll
        for (int s = 0; s < 2; ++s)
#pragma unroll
            for (int db = 0; db < 8; ++db) { const LAS bf16_t* p = kd_l + (32 * s + 8 * g + tq) * KDST + 16 * db + 4 * tp; const bf16x8 a = cat8(trrd(p), trrd(p + 4 * KDST));
                S[db][0] = __builtin_amdgcn_mfma_f32_16x16x32_bf16(a, vf[s][0], S[db][0], 0, 0, 0); S[db][1] = __builtin_amdgcn_mfma_f32_16x16x32_bf16(a, vf[s][1], S[db][1], 0, 0, 0); }
        if (FULL) {
#pragma unroll
            for (int i = 0; i < 4; ++i)
#pragma unroll
                for (int r = 0; r < 4; ++r) { float sm = o[i][0][r] + o[i][1][r], sq = o[i][0][r] * o[i][0][r] + o[i][1][r] * o[i][1][r];
                    sm += __shfl_xor(sm, 1); sq += __shfl_xor(sq, 1); sm += __shfl_xor(sm, 2); sq += __shfl_xor(sq, 2); sm += __shfl_xor(sm, 4); sq += __shfl_xor(sq, 4); sm += __shfl_xor(sm, 8); sq += __shfl_xor(sq, 8);
                    if (fr == 0) { LAS float* d = st_l + ((16 * i + 4 * g + r) * 8 + w) * 2; d[0] = sm; d[1] = sq; } }
            __syncthreads();
#pragma unroll
            for (int i = 0; i < 4; ++i)
#pragma unroll
                for (int r = 0; r < 4; ++r) { const int tok = 16 * i + 4 * g + r; if (tok >= L) continue;
                    const LAS f32x4* d = (const LAS f32x4*)(st_l + tok * 16); const f32x4 a0 = d[0], a1 = d[1], a2 = d[2], a3 = d[3];
                    const float sm = (a0[0] + a0[2]) + (a1[0] + a1[2]) + (a2[0] + a2[2]) + (a3[0] + a3[2]), sq = (a0[1] + a0[3]) + (a1[1] + a1[3]) + (a2[1] + a2[3]) + (a3[1] + a3[3]);
                    const float mu = sm * (1.f / 256.f), var = fmaxf(sq * (1.f / 256.f) - mu * mu, 0.f), rstd = rsqrtf(var + EPS);
#pragma unroll
                    for (int nb = 0; nb < 2; ++nb) { const int col = h * 256 + 32 * w + 16 * nb + fr; const size_t gi = (r0 + tok) * 1024 + col;
                        RET[gi] = f2bf((o[i][nb][r] - mu) * rstd * g_ret[col] * bf2f(RG[gi])); } }
        }
    }
    if (Sout) {
#pragma unroll
        for (int db = 0; db < 8; ++db)
#pragma unroll
            for (int nb = 0; nb < 2; ++nb)
#pragma unroll
                for (int r = 0; r < 4; ++r) Sout[(size_t)(16 * db + 4 * g + r) * RET_DV + 32 * w + 16 * nb + fr] = S[db][nb][r];
    }
}
}
__device__ __forceinline__ void r1_states(Frame& F) {
    const int bh = F.vcu >> 5, sc = F.vcu & 31, b = bh >> 2, h = bh & 3;
    rt::ret_unit<false>(F, h, b * SEQ + sc * rt::SC_TOK, 4, 64, nullptr, F.out + ((size_t)bh * rt::NSC + sc) * 32768, nullptr);
}
__device__ __forceinline__ void r2_scan(Frame& F) {
    float* U = F.out; const int gt = F.vcu * NTHR + F.tid;
    for (int e = gt; e < 8 * 32768; e += F.G * NTHR) { const int bh = e >> 15, idx = e & 32767, h = bh & 3;
        const float g256 = exp2f(log2f(1.f - exp2f(-5.f - (float)h)) * 256.f);
        float u[32];
#pragma unroll
        for (int sc = 0; sc < 32; ++sc) u[sc] = U[((size_t)bh * 32 + sc) * 32768 + idx];
        float carry = 0.f;
#pragma unroll
        for (int sc = 0; sc < 32; ++sc) { U[((size_t)bh * 32 + sc) * 32768 + idx] = carry; carry = g256 * carry + u[sc]; }
        F.out[O_RETP + (size_t)bh * 32768 + idx] = carry; }
}
__device__ __forceinline__ void r3_outputs(Frame& F) {
    const int bh = F.vcu >> 5, sc = F.vcu & 31, b = bh >> 2, h = bh & 3;
    rt::ret_unit<true>(F, h, b * SEQ + sc * rt::SC_TOK, 4, 64, F.out + ((size_t)bh * rt::NSC + sc) * 32768, nullptr, FIN(16));
    if (F.vcu < DEC_BATCH * RET_H) { const int sb = F.vcu >> 2, sh = F.vcu & 3;
        rt::ret_unit<true>(F, sh, MP + sb * DEC_SEQ, 1, DEC_SEQ, FIN(4) + (size_t)F.vcu * 32768, F.out + O_RETS + (size_t)F.vcu * 32768, FIN(16)); }
}

namespace at {
typedef float f32x16 __attribute__((ext_vector_type(16)));
typedef short s16x4 __attribute__((ext_vector_type(4)));
constexpr int KN_ST = 272, KP_ST = 144;
constexpr int KN_B = 64 * KN_ST, KP_B = 64 * KP_ST, V_B = 16384, BUF_B = KN_B + KP_B + V_B;
constexpr int SCR_OFF = 2 * BUF_B;
constexpr float THR = 8.f;
__device__ __forceinline__ int v_st(int k, int c) { const int kk = (k & ~0xC) | ((k & 4) << 1) | ((k & 8) >> 1); return ((kk >> 3) * 4 + (c >> 5)) * 512 + ((kk & 7) * 32 + (c & 31)) * 2; }
__device__ __forceinline__ int v_rd_base(int lane) { return ((lane & 3) << 3) | (((lane >> 2) & 3) << 6) | (((lane >> 4) & 1) << 5) | (((lane >> 5) & 1) << 8); }
constexpr int v_rd_off(int d0, int ks, int half) { return d0 * 512 + ks * 4096 + half * 2048; }
__device__ __forceinline__ int crow(int r, int hi) { return (r & 3) + 8 * (r >> 2) + 4 * hi; }
#define AT_SBAR() __builtin_amdgcn_sched_barrier(0)

__device__ __forceinline__ void qkt(f32x16& p0, f32x16& p1, const LAS unsigned char* kn, const LAS unsigned char* kp, const bf16x8* qr) {
    p0 = f32x16{}; p1 = f32x16{};
#pragma unroll
    for (int d0 = 0; d0 < 8; ++d0) { const bf16x8 a0 = *(const LAS bf16x8*)(kn + d0 * 32), a1 = *(const LAS bf16x8*)(kn + d0 * 32 + 32 * KN_ST);
        p0 = __builtin_amdgcn_mfma_f32_32x32x16_bf16(a0, qr[d0], p0, 0, 0, 0); p1 = __builtin_amdgcn_mfma_f32_32x32x16_bf16(a1, qr[d0], p1, 0, 0, 0); }
#pragma unroll
    for (int d0 = 0; d0 < 4; ++d0) { const bf16x8 a0 = *(const LAS bf16x8*)(kp + d0 * 32), a1 = *(const LAS bf16x8*)(kp + d0 * 32 + 32 * KP_ST);
        p0 = __builtin_amdgcn_mfma_f32_32x32x16_bf16(a0, qr[8 + d0], p0, 0, 0, 0); p1 = __builtin_amdgcn_mfma_f32_32x32x16_bf16(a1, qr[8 + d0], p1, 0, 0, 0); }
}
__device__ __forceinline__ void pv_tile(f32x16* o, int vb0, bf16x8 pa0, bf16x8 pa1, bf16x8 pa2, bf16x8 pa3) {
#define AT_TRRD(dst, off) asm volatile("ds_read_b64_tr_b16 %0, %1 offset:%2" : "=&v"(dst) : "v"(vb0), "i"(off) : "memory")
#define AT_PV_D0(d0) do { s16x4 l0, l1, l2, l3, h0, h1, h2, h3; constexpr int b_ = v_rd_off(d0, 0, 0);   \
        AT_TRRD(l0, b_); AT_TRRD(h0, b_ + 2048); AT_TRRD(l1, b_ + 4096); AT_TRRD(h1, b_ + 6144); AT_TRRD(l2, b_ + 8192); AT_TRRD(h2, b_ + 10240); AT_TRRD(l3, b_ + 12288); AT_TRRD(h3, b_ + 14336); \
        asm volatile("s_waitcnt lgkmcnt(0)" ::: "memory"); AT_SBAR();   \
        o[d0] = __builtin_amdgcn_mfma_f32_32x32x16_bf16(pa0, (bf16x8){l0[0], l0[1], l0[2], l0[3], h0[0], h0[1], h0[2], h0[3]}, o[d0], 0, 0, 0);   \
        o[d0] = __builtin_amdgcn_mfma_f32_32x32x16_bf16(pa1, (bf16x8){l1[0], l1[1], l1[2], l1[3], h1[0], h1[1], h1[2], h1[3]}, o[d0], 0, 0, 0);   \
        o[d0] = __builtin_amdgcn_mfma_f32_32x32x16_bf16(pa2, (bf16x8){l2[0], l2[1], l2[2], l2[3], h2[0], h2[1], h2[2], h2[3]}, o[d0], 0, 0, 0);   \
        o[d0] = __builtin_amdgcn_mfma_f32_32x32x16_bf16(pa3, (bf16x8){l3[0], l3[1], l3[2], l3[3], h3[0], h3[1], h3[2], h3[3]}, o[d0], 0, 0, 0); } while (0)
    AT_PV_D0(0); AT_PV_D0(1); AT_PV_D0(2); AT_PV_D0(3);
#undef AT_PV_D0
#undef AT_TRRD
}
template <bool PARTIAL>
__device__ __forceinline__ void attn_unit(LAS unsigned char* lds, const bf16_t* Qw, const bf16_t* KN, const bf16_t* KPE, const bf16_t* V, bf16_t* Ow, float* Pw, int NT, int tmax_w, int nkeys, int orows, int t0, int tstride) {
    const int tid = threadIdx.x, wid = __builtin_amdgcn_readfirstlane(tid >> 6), lane = tid & 63, r32 = lane & 31, hi = lane >> 5;
    bf16x8 qr[12];
#pragma unroll
    for (int d0 = 0; d0 < 12; ++d0) qr[d0] = *(const bf16x8*)(Qw + (size_t)r32 * 1536 + d0 * 16 + hi * 8);
    const int sr = tid >> 4, sc = (tid & 15) * 8, pr = tid >> 3, pc = (tid & 7) * 8;
    const int kn_w0 = sr * KN_ST + sc * 2, kn_w1 = (32 + sr) * KN_ST + sc * 2, kp_w = KN_B + pr * KP_ST + pc * 2, v_w0 = KN_B + KP_B + v_st(sr, sc), v_w1 = KN_B + KP_B + v_st(32 + sr, sc);
    const int kn_r = r32 * KN_ST + hi * 16, kp_r = KN_B + r32 * KP_ST + hi * 16;
    const int vb_base = (int)(unsigned)(uintptr_t)(lds + KN_B + KP_B) + v_rd_base(lane);
    LAS float* scr = (LAS float*)(lds + SCR_OFF) + wid * 64;
    float m_reg = -1e30f, l_reg = 0.f; f32x16 o[4] = {};
    u32x4 st_kn0, st_kn1, st_kp, st_v0, st_v1;
#define AT_LOAD(t) do { const size_t k0_ = (size_t)(t0 + (t) * tstride) * 64; const bool v0_ = (int)k0_ + sr < nkeys, v1_ = (int)k0_ + 32 + sr < nkeys, vp_ = (int)k0_ + pr < nkeys; const u32x4 z_ = {0u, 0u, 0u, 0u}; \
        st_kn0 = v0_ ? *(const u32x4*)(KN + (k0_ + sr) * 1024 + sc) : z_; st_kn1 = v1_ ? *(const u32x4*)(KN + (k0_ + 32 + sr) * 1024 + sc) : z_; \
        st_v0 = v0_ ? *(const u32x4*)(V + (k0_ + sr) * 1024 + sc) : z_; st_v1 = v1_ ? *(const u32x4*)(V + (k0_ + 32 + sr) * 1024 + sc) : z_; \
        st_kp = vp_ ? *(const u32x4*)(KPE + (k0_ + pr) * 64 + pc) : z_; } while (0)
#define AT_WRITE(bf) do { LAS unsigned char* b_ = lds + (bf) * BUF_B; *(LAS u32x4*)(b_ + kn_w0) = st_kn0; *(LAS u32x4*)(b_ + kn_w1) = st_kn1; *(LAS u32x4*)(b_ + kp_w) = st_kp; \
        *(LAS u32x4*)(b_ + v_w0) = st_v0; *(LAS u32x4*)(b_ + v_w1) = st_v1; } while (0)
    AT_LOAD(0); AT_WRITE(0);
    __syncthreads();
    for (int t = 0; t < NT; ++t) {
        const int bf = t & 1;
        if (t + 1 < NT) AT_LOAD(t + 1);
        if (t <= tmax_w) {
            f32x16 p0, p1;
            const LAS unsigned char* bb = lds + bf * BUF_B;
            qkt(p0, p1, bb + kn_r, bb + kp_r, qr);
            if ((t0 + t * tstride + 1) * 64 > nkeys) {
                const int kb = (t0 + t * tstride) * 64 + 4 * hi;
#pragma unroll
                for (int r = 0; r < 16; ++r) { const int kv = kb + (r & 3) + 8 * (r >> 2); if (kv >= nkeys) p0[r] = -INFINITY; if (kv + 32 >= nkeys) p1[r] = -INFINITY; } }
            float pmax = p0[0];
#pragma unroll
            for (int r = 1; r < 16; ++r) pmax = fmaxf(pmax, p0[r]);
#pragma unroll
            for (int r = 0; r < 16; ++r) pmax = fmaxf(pmax, p1[r]);
            { auto rr = __builtin_amdgcn_permlane32_swap(__float_as_uint(pmax), __float_as_uint(pmax), false, false); pmax = fmaxf(__uint_as_float(rr[0]), __uint_as_float(rr[1])); }
            float alpha = 1.f; bool resc = false;
            if (!__all(pmax - m_reg <= THR)) { const float mn = fmaxf(m_reg, pmax); alpha = __builtin_amdgcn_exp2f(m_reg - mn); m_reg = mn; resc = true; }
#pragma unroll
            for (int r = 0; r < 16; ++r) { p0[r] = __builtin_amdgcn_exp2f(p0[r] - m_reg); p1[r] = __builtin_amdgcn_exp2f(p1[r] - m_reg); }
            float ps = 0.f;
#pragma unroll
            for (int r = 0; r < 16; ++r) ps += p0[r] + p1[r];
            { auto rr = __builtin_amdgcn_permlane32_swap(__float_as_uint(ps), __float_as_uint(ps), false, false); ps = __uint_as_float(rr[0]) + __uint_as_float(rr[1]); }
            l_reg = l_reg * alpha + ps;
            bf16x8 pa0, pa1, pa2, pa3;
#define AT_PK4(P, B_, OUT) do { unsigned a0 = cvt_pk_bf16(P[B_ + 0], P[B_ + 1]), a1 = cvt_pk_bf16(P[B_ + 2], P[B_ + 3]); unsigned b0 = cvt_pk_bf16(P[B_ + 4], P[B_ + 5]), b1 = cvt_pk_bf16(P[B_ + 6], P[B_ + 7]); \
        auto r0 = __builtin_amdgcn_permlane32_swap(a0, b0, false, false); auto r1 = __builtin_amdgcn_permlane32_swap(a1, b1, false, false); \
        u32x4 w_ = {r0[0], r1[0], r0[1], r1[1]}; OUT = __builtin_bit_cast(bf16x8, w_); } while (0)
            AT_PK4(p0, 0, pa0); AT_PK4(p0, 8, pa1); AT_PK4(p1, 0, pa2); AT_PK4(p1, 8, pa3);
#undef AT_PK4
            if (resc) { if (hi == 0) scr[r32] = alpha; asm volatile("s_waitcnt lgkmcnt(0)" ::: "memory");
#pragma unroll
                for (int d_ = 0; d_ < 4; ++d_)
#pragma unroll
                    for (int r = 0; r < 16; ++r) o[d_][r] *= scr[crow(r, hi)]; }
            AT_SBAR();
            pv_tile(o, vb_base + bf * BUF_B, pa0, pa1, pa2, pa3);
        }
        if (t + 1 < NT) AT_WRITE(bf ^ 1);
        __syncthreads();
    }
    if (PARTIAL) {
        if (wid == 0) {
#pragma unroll
            for (int r = 0; r < 16; ++r) { const int orow = crow(r, hi); if (orow < orows) {
#pragma unroll
                for (int d0 = 0; d0 < 4; ++d0) Pw[orow * 132 + d0 * 32 + r32] = o[d0][r]; } }
            if (hi == 0 && r32 < orows) { Pw[r32 * 132 + 128] = m_reg; Pw[r32 * 132 + 129] = l_reg; } }
        __syncthreads();
        return;
    }
    if (hi == 0) scr[32 + r32] = l_reg; asm volatile("s_waitcnt lgkmcnt(0)" ::: "memory");
#pragma unroll
    for (int r = 0; r < 16; ++r) { const int orow = crow(r, hi); const float rl = __builtin_amdgcn_rcpf(scr[32 + orow]);
#pragma unroll
        for (int d0 = 0; d0 < 4; ++d0) { const float v = o[d0][r] * rl; const float vn = __shfl_xor(v, 1);
            if ((r32 & 1) == 0 && orow < orows) *(unsigned*)(Ow + (size_t)orow * 1024 + d0 * 32 + r32) = cvt_pk_bf16(v, vn); } }
    __syncthreads();
#undef AT_LOAD
#undef AT_WRITE
}
#undef AT_SBAR
}
__device__ __forceinline__ void p3_attn_prompt(Frame& F) {
    const int bh = F.vcu >> 4, s = F.vcu & 15, b = bh >> 3, h = bh & 7;
    const bf16_t* Q = (const bf16_t*)F.out; const bf16_t* KN = (const bf16_t*)(F.ws + WS_KN); const bf16_t* KPE = (const bf16_t*)(F.ws + WS_KPE); const bf16_t* V = (const bf16_t*)(F.ws + WS_V); bf16_t* ATT = (bf16_t*)(F.ws + WS_ATT);
#pragma unroll 1
    for (int it = 0; it < 2; ++it) { const int qb = it == 0 ? s : 31 - s; const size_t row0 = (size_t)b * SEQ + (size_t)qb * 256 + F.wave * 32;
        at::attn_unit<false>(F.lds, Q + row0 * 1536 + h * 192, KN + (size_t)b * SEQ * 1024 + h * 128, KPE + (size_t)b * SEQ * 64, V + (size_t)b * SEQ * 1024 + h * 128,
                      ATT + row0 * 1024 + h * 128, nullptr, 4 * qb + 4, 4 * qb + (F.wave >> 1), 1 << 30, 32, 0, 1); }
}
__device__ __forceinline__ void xn_rows(Frame& F, bf16_t* XN) {
    const int gw = F.vcu * 8 + F.wave, NGW = F.G * 8;
    for (int r = gw; r < MPAD; r += NGW) {
        u32x2* o8 = (u32x2*)(XN + (size_t)r * D_MODEL) + F.lane;
        if (r >= MT) { for (int jj = 0; jj < 4; ++jj) o8[64 * jj] = (u32x2){0u, 0u}; continue; }
        const float* x = r < MP ? FIN(0) + (size_t)r * D_MODEL : FIN(1) + (size_t)(r - MP) * D_MODEL;
        const f32x4* xr = (const f32x4*)x + F.lane; f32x4 v[4]; float s = 0.f;
#pragma unroll
        for (int jj = 0; jj < 4; ++jj) { v[jj] = xr[64 * jj]; s += (v[jj][0] * v[jj][0] + v[jj][1] * v[jj][1]) + (v[jj][2] * v[jj][2] + v[jj][3] * v[jj][3]); }
        const float inv = rsqrtf(fwave_sum(s) * (1.f / D_MODEL) + EPS);
#pragma unroll
        for (int jj = 0; jj < 4; ++jj) { u32x2 w; w.x = cvt_pk_bf16(v[jj][0] * inv, v[jj][1] * inv); w.y = cvt_pk_bf16(v[jj][2] * inv, v[jj][3] * inv); o8[64 * jj] = w; }
    }
}
constexpr size_t WS_PART = WS_ATTS + 512 * KiB;
__device__ __forceinline__ void p3_attn_sample(Frame& F) {
    {   const int bh = F.vcu >> 2, part = F.vcu & 3, b = bh >> 3, h = bh & 7;
        const bf16_t* Q = (const bf16_t*)F.out; const bf16_t* KN = (const bf16_t*)(F.ws + WS_KN); const bf16_t* PES = (const bf16_t*)(F.ws + WS_PES); const bf16_t* V = (const bf16_t*)(F.ws + WS_V);
        const size_t row0 = (size_t)MP + (size_t)b * DEC_SEQ;
        at::attn_unit<true>(F.lds, Q + row0 * 1536 + h * 192, KN + (size_t)b * SKEYS * 1024 + h * 128, PES + (size_t)b * SKEYS * 64, V + (size_t)b * SKEYS * 1024 + h * 128,
                            nullptr, (float*)(F.ws + WS_PART) + (size_t)F.vcu * 16 * 132, part == 0 ? 9 : 8, F.wave == 0 ? 1000 : -1, SKEYS, DEC_SEQ, part, 4); }
    xn_rows(F, (bf16_t*)(F.ws + WS_XN2));
    {   const int gw = F.vcu * 8 + F.wave, NGW = F.G * 8; const bf16_t* KVL = (const bf16_t*)(F.ws + WS_KVL); const float* slotkv = (const float*)(F.ws + WS_SLOTKV);
        for (int r = gw; r < MT; r += NGW) { const float s = slot_rs(slotkv + (size_t)r * 8, 8, 1.f / KV_LORA);
            float* o = r < MP ? F.out + O_LATP + (size_t)r * KV_LORA : F.out + O_LATS + (size_t)(r - MP) * KV_LORA;
            const u32x4 w = *((const u32x4*)(KVL + (size_t)r * KV_LORA) + F.lane);
            f32x4 a = {__uint_as_float(w.x << 16), __uint_as_float(w.x & 0xffff0000u), __uint_as_float(w.y << 16), __uint_as_float(w.y & 0xffff0000u)};
            f32x4 c = {__uint_as_float(w.z << 16), __uint_as_float(w.z & 0xffff0000u), __uint_as_float(w.w << 16), __uint_as_float(w.w & 0xffff0000u)};
            *((f32x4*)o + 2 * F.lane) = a * s; *((f32x4*)o + 2 * F.lane + 1) = c * s; } }
}
__device__ __forceinline__ void attn_sample_combine(Frame& F) {
    if (F.vcu >= DEC_BATCH * HEADS) return;
    const int b = F.vcu >> 3, h = F.vcu & 7; const float* P = (const float*)(F.ws + WS_PART) + (size_t)F.vcu * 4 * 16 * 132; bf16_t* ATTS = (bf16_t*)(F.ws + WS_ATTS);
    for (int e = F.tid; e < 16 * 128; e += NTHR) { const int q = e >> 7, d = e & 127;
        float m[4], M = -1e30f;
#pragma unroll
        for (int p = 0; p < 4; ++p) { m[p] = P[(p * 16 + q) * 132 + 128]; M = fmaxf(M, m[p]); }
        float num = 0.f, den = 0.f;
#pragma unroll
        for (int p = 0; p < 4; ++p) { const float w = exp2f(m[p] - M); num += w * P[(p * 16 + q) * 132 + d]; den += w * P[(p * 16 + q) * 132 + 129]; }
        ATTS[(size_t)(b * DEC_SEQ + q) * 1024 + h * 128 + d] = f2bf(num / den); }
}
__device__ __forceinline__ void p8_conv(Frame& F) {
    bf16_t* U = (bf16_t*)(F.ws + WS_U); const bf16_t* HALO = (const bf16_t*)(F.ws + WS_HALO); const float* cw = FIN(21); const float* cb = FIN(22); const float* prev = FIN(5);
    const int half = F.tid >> 8;
    for (int unit = F.vcu; unit < 72 * 11; unit += F.G) { const int ch = unit / 11, strip = unit % 11; const int n = strip * 256 + (F.tid & 255), nv = n + D_FF;
        int r0, nr; if (ch < 64) { r0 = ch * 256 + half * 128; nr = 128; } else { r0 = MP + (ch - 64) * DEC_SEQ; nr = half == 0 ? DEC_SEQ : 0; }
        const float wg0 = cw[n], wg1 = cw[FF2 + n], wg2 = cw[2 * FF2 + n], bg = cb[n], wv0 = cw[nv], wv1 = cw[FF2 + nv], wv2 = cw[2 * FF2 + nv], bv = cb[nv];
        float g2 = 0.f, g1 = 0.f, v2 = 0.f, v1 = 0.f;
        if (ch < 64) {
            if (half == 1) { g2 = bf2f(U[(size_t)(r0 - 2) * FF2 + n]); g1 = bf2f(U[(size_t)(r0 - 1) * FF2 + n]); v2 = bf2f(U[(size_t)(r0 - 2) * FF2 + nv]); v1 = bf2f(U[(size_t)(r0 - 1) * FF2 + nv]); }
            else if ((ch & 31) != 0) { const bf16_t* hp = HALO + (size_t)ch * 2 * FF2; g2 = bf2f(hp[n]); g1 = bf2f(hp[FF2 + n]); v2 = bf2f(hp[nv]); v1 = bf2f(hp[FF2 + nv]); }
        } else { const float* pp = prev + (size_t)(ch - 64) * 2 * FF2; g2 = pp[n]; g1 = pp[FF2 + n]; v2 = pp[nv]; v1 = pp[FF2 + nv]; }
        __syncthreads();
#pragma unroll 4
        for (int i = 0; i < nr; ++i) { bf16_t* row = U + (size_t)(r0 + i) * FF2; const float g0 = bf2f(row[n]), v0 = bf2f(row[nv]);
            const float cg = g2 * wg0 + g1 * wg1 + g0 * wg2 + bg, cv = v2 * wv0 + v1 * wv1 + v0 * wv2 + bv;
            row[n] = f2bf(cg / (1.f + __expf(-cg)) * cv); g2 = g1; g1 = g0; v2 = v1; v1 = v0; }
        __syncthreads();
    }
}

__global__ void __launch_bounds__(NTHR, 2) mk(const MArgs a) {
    extern __shared__ __attribute__((aligned(16))) unsigned char lds_raw[];
    Frame F;
    F.lds = (LAS unsigned char*)lds_raw;
    F.tid = threadIdx.x; F.lane = F.tid & 63; F.wave = __builtin_amdgcn_readfirstlane(F.tid >> 6);
    F.G = gridDim.x; F.x = blockIdx.x % 8; F.j = blockIdx.x / 8; F.vcu = F.x * (F.G / 8) + F.j;
    F.a = &a; F.out = a.out; F.ws = a.ws;
    volatile LAS unsigned* MISC = (volatile LAS unsigned*)(F.lds + MISC_OFF);
    if (F.tid < 32) MISC[F.tid] = 0u;
    __syncthreads();
    XcdBarrier bar = xcd_barrier_post((unsigned*)(a.ws + WS_CTL) + CW_BAR + a.li * XCD_BAR_WORDS, MISC + 8);
    const int lo = a.ph_lo, hi = a.ph_hi;
#define IN_(k) (lo <= (k) && (k) < hi)
#define SEAM_(k) do { if (IN_(k) && IN_((k) + 1)) xcd_barrier(bar); } while (0)
    if (IN_(0)) { p0_prologue(F); } SEAM_(0);
    if (IN_(1)) { p1_inproj(F); } SEAM_(1);
    if (IN_(2)) { r1_states(F); } SEAM_(2);
    if (IN_(3)) { r2_scan(F); } SEAM_(3);
    if (IN_(4)) { r3_outputs(F); } SEAM_(4);
    if (IN_(5)) { p2_qkv(F, 1); } SEAM_(5);
    if (IN_(6)) { p3_attn_sample(F); } SEAM_(6);
    if (IN_(7)) { attn_sample_combine(F); p2_qkv(F, 0); } SEAM_(7);
    if (IN_(8)) { p3_attn_prompt(F); } SEAM_(8);
    if (IN_(9)) { p5_gemm(F, 5); } SEAM_(9);
    if (IN_(10)) { p5_gemm(F, 6); } SEAM_(10);
    if (IN_(11)) { p5_gemm(F, 7); } SEAM_(11);
    if (IN_(12)) { p8_conv(F); } SEAM_(12);
    if (IN_(13)) { p5_gemm(F, 9); }
}

extern "C" void kernel_launch(void* const* d_in, const int* in_sizes, int n_in, void* d_out, int out_size, void* d_ws, size_t ws_size, hipStream_t stream) {
    static int ok = 0;
    if (ok == 0) {
        ok = 1;
        if (ws_size < 256 * MiB || n_in != 24) { fprintf(stderr, "kernel_launch: bad ws/n_in: %zu %d\n", ws_size, n_in); ok = -1; }
        int dev = 0, cus = 0; (void)hipGetDevice(&dev); (void)hipDeviceGetAttribute(&cus, hipDeviceAttributeMultiprocessorCount, dev);
        if (cus != 256) { fprintf(stderr, "kernel_launch: built for 256 CUs, got %d\n", cus); ok = -1; }
        if (hipFuncSetAttribute((const void*)mk, hipFuncAttributeMaxDynamicSharedMemorySize, LDS_BYTES) != hipSuccess) { fprintf(stderr, "kernel_launch: hipFuncSetAttribute(mk) failed\n"); ok = -1; }
        (void)hipGetLastError();
    }
    if (ok < 0) return;
    (void)hipMemsetAsync((char*)d_ws + WS_CTL, 0, CTL_BYTES, stream);
    MArgs a{}; for (int i = 0; i < 24; ++i) a.in[i] = (const float*)d_in[i]; a.out = (float*)d_out; a.ws = (unsigned char*)d_ws; a.ph_lo = 0; a.ph_hi = 14; a.li = 0;
    hipLaunchKernelGGL(mk, dim3(256), dim3(NTHR), LDS_BYTES, stream, a);
}
```

```cpp
#include <hip/hip_runtime.h>
#include <stdint.h>
#include <cstdio>

typedef unsigned short bf16_t;
typedef short bf16x8 __attribute__((ext_vector_type(8)));
typedef float f32x4 __attribute__((ext_vector_type(4)));
typedef float f32x2 __attribute__((ext_vector_type(2)));
typedef unsigned u32x4 __attribute__((ext_vector_type(4)));
typedef unsigned u32x2 __attribute__((ext_vector_type(2)));

constexpr int D_MODEL = 1024, BATCH = 2, SEQ = 8192, DEC_BATCH = 8, DEC_SEQ = 16, PAST = 2048;
constexpr int MP = BATCH * SEQ, MS = DEC_BATCH * DEC_SEQ, MT = MP + MS;
constexpr int MPAD = 16640;
constexpr int Q_LORA = 768, KV_LORA = 512, QK_NOPE = 128, QK_ROPE = 64, V_HEAD = 128, HEADS = 8;
constexpr int RET_H = 4, RET_DK = 128, RET_DV = 256;
constexpr int D_FF = 2816, FF2 = 2 * D_FF;
constexpr int IN_W = 6464;
constexpr int SKEYS = PAST + DEC_SEQ;
constexpr int LROWS = DEC_BATCH * SKEYS;
constexpr float EPS = 1e-6f;
constexpr int C_QLAT = 0, C_KVLAT = 768, C_KPE = 1280, C_RQ = 1344, C_RK = 1856, C_RV = 2368, C_RG = 3392, C_GA = 4416, C_GB = 5440;

constexpr size_t O_YP = 0, O_YS = 16777216, O_LATP = 16908288, O_RKP = 25296896, O_RETP = 26345472, O_CONVP = 26607616,
                 O_LATS = 26630144, O_RKS = 26695680, O_RETS = 26703872, O_CONVS = 27752448;

constexpr size_t MiB = 1u << 20, KiB = 1024;
constexpr size_t WS_CTL = 0, CTL_BYTES = 64 * KiB, WS_SQ = 64 * KiB, WS_SKV = 192 * KiB;
constexpr size_t WS_SLOTQ = 1 * MiB, WS_SLOTKV = 2 * MiB, WS_SLOTX1 = 3 * MiB;
constexpr size_t WS_TAB32 = 4 * MiB + 256 * KiB, WS_TAB64 = 6 * MiB + 256 * KiB;
constexpr size_t WS_FWUP = 10 * MiB + 512 * KiB, WS_FWDOWN = 21 * MiB + 512 * KiB, WS_FWIN = 27 * MiB, WS_FWQUP = 40 * MiB, WS_FWKVUP = 43 * MiB,
                 WS_FWOBA = 45 * MiB, WS_FWOBB = 47 * MiB, WS_FWOUT = 49 * MiB;
constexpr size_t WS_XN = 51 * MiB, WS_RET = 51 * MiB;
constexpr size_t WS_LATS = 83 * MiB + 512 * KiB, WS_PES = 99 * MiB + 768 * KiB, WS_ZQ = 102 * MiB, WS_KVL = 126 * MiB + 512 * KiB, WS_KPE = 142 * MiB + 768 * KiB;
constexpr size_t WS_RQ = 145 * MiB, WS_RK = 161 * MiB + 256 * KiB, WS_RV = 177 * MiB + 512 * KiB, WS_RG = 210 * MiB;
constexpr size_t WS_KN = 145 * MiB, WS_V = 177 * MiB + 512 * KiB, WS_ATTS = 242 * MiB + 512 * KiB, WS_XN2 = 210 * MiB, WS_ATT = 102 * MiB;
constexpr size_t WS_T1 = 166 * MiB + 512 * KiB, WS_MERGED = 134 * MiB;
constexpr size_t WS_X1B = 223 * MiB + 512 * KiB, WS_U = 27 * MiB, WS_HALO = 206 * MiB;

__device__ __forceinline__ bf16_t f2bf(float f) { unsigned u = __float_as_uint(f); u = (u + 0x7fffu + ((u >> 16) & 1u)) >> 16; return (bf16_t)u; }
__device__ __forceinline__ float bf2f(bf16_t b) { return __uint_as_float(((unsigned)b) << 16); }

#define LAS __attribute__((address_space(3)))
#define GAS __attribute__((address_space(1)))
constexpr int NTHR = 512;
constexpr int RING_BYTES = 131072, EPI_OFF = RING_BYTES, EPI_BYTES = 8192, MISC_OFF = EPI_OFF + EPI_BYTES, LDS_BYTES = 147456;
constexpr int CW_BAR = 1024;

__device__ __forceinline__ unsigned cvt_pk_bf16(float lo, float hi) { unsigned r; asm volatile("v_cvt_pk_bf16_f32 %0, %1, %2" : "=v"(r) : "v"(lo), "v"(hi)); return r; }
__device__ __forceinline__ u32x4 pack8f(const f32x4& a, const f32x4& b) { u32x4 w; w.x = cvt_pk_bf16(a[0], a[1]); w.y = cvt_pk_bf16(a[2], a[3]); w.z = cvt_pk_bf16(b[0], b[1]); w.w = cvt_pk_bf16(b[2], b[3]); return w; }
__device__ __forceinline__ int row_pos(int row) { return row < MP ? (row & (SEQ - 1)) : PAST + ((row - MP) & (DEC_SEQ - 1)); }

#define XB_TMO      128
#define XB_XCNT(j)  (256  + 64 * (j))
#define XB_XSUB(j)  (1280 + 64 * (j))
#define XB_XGEN(j)  (2304 + 64 * (j))
#define XB_TOP      3328
#define XB_TOPGEN   3392
#define XCD_BAR_WORDS 3456
#define XB_SPIN_CAP (1u << 18)
__device__ __forceinline__ unsigned xb_ld(unsigned* p)              { return __hip_atomic_load(p, __ATOMIC_RELAXED, __HIP_MEMORY_SCOPE_AGENT); }
__device__ __forceinline__ unsigned xb_add(unsigned* p, unsigned v) { return __hip_atomic_fetch_add(p, v, __ATOMIC_RELAXED, __HIP_MEMORY_SCOPE_AGENT); }
__device__ __forceinline__ unsigned xb_xcc_id() { return (unsigned)__builtin_amdgcn_s_getreg((3 << 11) | 20) & 0xFu; }
#define XB_SPIN(cond, bar) do { unsigned _sp = 0; while (cond) { __builtin_amdgcn_s_sleep(1); \
    if ((++_sp & 255u) == 0u) { if (xb_ld(&(bar)[XB_TMO])) break; if (_sp > XB_SPIN_CAP) { atomicAdd(&(bar)[XB_TMO], 1u); break; } } } } while (0)
struct XcdBarrier { unsigned* bar; unsigned x; volatile LAS unsigned* st; };
__device__ __forceinline__ XcdBarrier xcd_barrier_post(unsigned* bar, volatile LAS unsigned* st) {
    XcdBarrier b; b.bar = bar; b.x = xb_xcc_id(); b.st = st;
    if (threadIdx.x == 0) (void)xb_add(&bar[XB_XCNT(b.x)], 1u);
    return b;
}
__device__ __forceinline__ void xcd_barrier_complete(unsigned* bar, unsigned x, unsigned& nloc, unsigned& nx) {
    const unsigned G = gridDim.x * gridDim.y * gridDim.z;
    unsigned sum, cnt, mine, sp = 0u;
    for (;;) {
        sum = 0u; cnt = 0u; mine = 0u;
#pragma unroll
        for (unsigned j = 0; j < 16; ++j) { const unsigned c = xb_ld(&bar[XB_XCNT(j)]); sum += c; cnt += (c > 0u) ? 1u : 0u; mine = (j == x) ? c : mine; }
        if (sum == G) break;
        __builtin_amdgcn_s_sleep(1);
        if ((++sp & 255u) == 0u) { if (xb_ld(&bar[XB_TMO])) break; if (sp > XB_SPIN_CAP) { atomicAdd(&bar[XB_TMO], 1u); break; } }
    }
    nloc = mine > 0u ? mine : 1u; nx = cnt > 0u ? cnt : 1u;
}
__device__ __forceinline__ void xcd_barrier(const XcdBarrier& b) {
    asm volatile("s_waitcnt vmcnt(0)" ::: "memory");
    __syncthreads();
    if (threadIdx.x == 0) {
        unsigned* bar = b.bar;
        __builtin_amdgcn_s_waitcnt(0);
        unsigned nloc = b.st[0], nx = b.st[1];
        if (nloc == 0u) { xcd_barrier_complete(bar, b.x, nloc, nx); b.st[0] = nloc; b.st[1] = nx; }
        const unsigned old = xb_add(&bar[XB_XSUB(b.x)], 1u);
        const unsigned gen = old / nloc;
        if (old + 1u == (gen + 1u) * nloc) {
            __builtin_amdgcn_fence(__ATOMIC_RELEASE, "agent");
            asm volatile("s_waitcnt vmcnt(0)" ::: "memory");
            const unsigned og = xb_add(&bar[XB_TOP], 1u);
            const unsigned tg = og / nx;
            if (og + 1u == (tg + 1u) * nx) xb_add(&bar[XB_TOPGEN], 1u);
            else XB_SPIN(xb_ld(&bar[XB_TOPGEN]) == tg, bar);
            __builtin_amdgcn_fence(__ATOMIC_ACQUIRE, "agent");
            xb_add(&bar[XB_XGEN(b.x)], 1u);
            asm volatile("s_waitcnt vmcnt(0)" ::: "memory");
        } else {
            XB_SPIN(xb_ld(&bar[XB_XGEN(b.x)]) == gen, bar);
            __builtin_amdgcn_fence(__ATOMIC_ACQUIRE, "agent");
            asm volatile("s_waitcnt vmcnt(0)" ::: "memory");
        }
    }
    __syncthreads();
}

namespace pg {
constexpr int BK = 64, HALF = 128, HTB = HALF * BK * 2;
__host__ __device__ __forceinline__ int lds_byte(int r, int c) { const int st = (r >> 4) * 2 + (c >> 5), rr = r & 15, cc = c & 31, ob = rr * 64 + cc * 2; return st * 1024 + (ob ^ (((ob >> 9) & 1) << 5)); }
__host__ __device__ __forceinline__ void stage_rc(int b, int& R, int& C) { const int st = b / 1024, sb = b % 1024, swz = sb ^ (((sb >> 9) & 1) << 5); R = (st >> 1) * 16 + swz / 64; C = (st & 1) * 32 + (swz % 64) / 2; }
__host__ __device__ __forceinline__ int perm32(int rho) { const int n = rho >> 4, i = rho & 15; return 8 * (i >> 2) + 4 * n + (i & 3); }
struct UnitG { const char* A; const char* B; unsigned lda, ldb; int nt; int pm, pn, kind; };
typedef f32x4 Acc[2][2][4][2];

template <class Sched, class Epi>
__device__ __forceinline__ void gemm_stream(LAS unsigned char* lds, const Sched& S, const Epi& E) {
    const int tid = threadIdx.x, wid = __builtin_amdgcn_readfirstlane(tid >> 6), lane = tid & 63, wr = wid >> 2, wc = wid & 3, fr = lane & 15, fq = lane >> 4;
    unsigned Rr[2], Cc[2];
#pragma unroll
    for (int i = 0; i < 2; ++i) { int R, C; stage_rc(tid * 16 + i * 8192, R, C); Rr[i] = (unsigned)R; Cc[i] = (unsigned)C * 2u; }
    const unsigned ldsw = (unsigned)wid * 1024u;
    const int aoff = lds_byte(wr * 64 + fr, fq * 8), boff = lds_byte(wc * 32 + fr, fq * 8);
#define PG_SA(b, h) (((b) * 2 + (h)) * HTB)
#define PG_SB(b, h) ((4 + (b) * 2 + (h)) * HTB)
#define PG_STAGE(bufoff, gbase, ld) do { _Pragma("unroll") for (int _i = 0; _i < 2; ++_i) \
        __builtin_amdgcn_global_load_lds((const unsigned*)((const char*)(gbase) + (size_t)(Rr[_i] * (ld) + Cc[_i])), (LAS unsigned*)(lds + (bufoff) + ldsw + _i * 8192), 16, 0, 0); } while (0)
#define PG_LDA(dst, b, h) do { _Pragma("unroll") for (int m = 0; m < 4; ++m) _Pragma("unroll") for (int k = 0; k < 2; ++k) dst[m][k] = *(const LAS bf16x8*)(lds + PG_SA(b, h) + aoff + m * 2048 + k * 1024); } while (0)
#define PG_LDB(dst, b, h) do { _Pragma("unroll") for (int n = 0; n < 2; ++n) _Pragma("unroll") for (int k = 0; k < 2; ++k) dst[n][k] = *(const LAS bf16x8*)(lds + PG_SB(b, h) + boff + n * 2048 + k * 1024); } while (0)
#define PG_MMA(ai, bj, At, Bt) do { __builtin_amdgcn_s_setprio(1); _Pragma("unroll") for (int m = 0; m < 4; ++m) _Pragma("unroll") for (int n = 0; n < 2; ++n) _Pragma("unroll") for (int k = 0; k < 2; ++k) \
        acc[ai][bj][m][n] = __builtin_amdgcn_mfma_f32_16x16x32_bf16(Bt[n][k], At[m][k], acc[ai][bj][m][n], 0, 0, 0); __builtin_amdgcn_s_setprio(0); } while (0)
#define PG_WAIT_V(n) asm volatile("s_waitcnt vmcnt(" #n ")" ::: "memory")
#define PG_WAIT_L(n) asm volatile("s_waitcnt lgkmcnt(" #n ")" ::: "memory")
#define PG_BAR __builtin_amdgcn_s_barrier()
#define PG_SCHED __builtin_amdgcn_sched_barrier(0)
    UnitG cur, nxt; int ui = 0;
    if (!S.next(0, cur)) return;
    Acc acc;
#pragma unroll
    for (int a = 0; a < 2; ++a)
#pragma unroll
        for (int b = 0; b < 2; ++b)
#pragma unroll
            for (int m = 0; m < 4; ++m)
#pragma unroll
                for (int n = 0; n < 2; ++n) acc[a][b][m][n] = (f32x4){0.f, 0.f, 0.f, 0.f};
    bf16x8 At[4][2], B0[2][2], B1[2][2];
    const char* cA = cur.A; const char* cB = cur.B; unsigned clda = cur.lda, cldb = cur.ldb;
    PG_STAGE(PG_SB(0, 0), cB, cldb); PG_STAGE(PG_SB(0, 1), cB + (size_t)HALF * cldb, cldb); PG_STAGE(PG_SA(0, 0), cA, clda); PG_STAGE(PG_SA(0, 1), cA + (size_t)HALF * clda, clda);
    if (wr == 1) PG_BAR;
    PG_WAIT_V(2); PG_BAR;
    PG_STAGE(PG_SB(1, 0), cB + 128, cldb); PG_STAGE(PG_SA(1, 0), cA + 128, clda); PG_STAGE(PG_SB(1, 1), cB + (size_t)HALF * cldb + 128, cldb);
    PG_WAIT_V(6); PG_BAR;
    for (;;) {
        const bool has_next = S.next(ui + 1, nxt);
        const char* nA = has_next ? nxt.A : cA; const char* nB = has_next ? nxt.B : cB;
        const unsigned nlda = has_next ? nxt.lda : clda, nldb = has_next ? nxt.ldb : cldb;
        const int nt = cur.nt;
        for (int t = 0; t < nt; t += 2) {
            const bool last = (t == nt - 2);
            const char* a1 = cA + (size_t)(t + 1) * 128;
            const char* a2 = last ? nA : cA + (size_t)(t + 2) * 128; const char* b2 = last ? nB : cB + (size_t)(t + 2) * 128;
            const unsigned lda2 = last ? nlda : clda, ldb2 = last ? nldb : cldb;
            const char* a3 = a2 + 128; const char* b3 = b2 + 128;
            PG_LDB(B0, 0, 0); PG_LDB(B1, 0, 1); PG_SCHED; PG_LDA(At, 0, 0); PG_STAGE(PG_SA(1, 1), a1 + (size_t)HALF * clda, clda);
            PG_WAIT_V(8); PG_WAIT_L(0); PG_BAR; PG_MMA(0, 0, At, B0); PG_MMA(0, 1, At, B1); PG_BAR; PG_SCHED;
            PG_LDA(At, 0, 1); PG_STAGE(PG_SB(0, 0), b2, ldb2); PG_STAGE(PG_SB(0, 1), b2 + (size_t)HALF * ldb2, ldb2); PG_STAGE(PG_SA(0, 0), a2, lda2);
            PG_WAIT_V(8); PG_WAIT_L(0); PG_BAR; PG_MMA(1, 0, At, B0); PG_MMA(1, 1, At, B1); PG_BAR; PG_SCHED;
            PG_LDB(B0, 1, 0); PG_LDB(B1, 1, 1); PG_SCHED; PG_LDA(At, 1, 0); PG_STAGE(PG_SA(0, 1), a2 + (size_t)HALF * lda2, lda2);
            PG_WAIT_V(8); PG_WAIT_L(0); PG_BAR; PG_MMA(0, 0, At, B0); PG_MMA(0, 1, At, B1); PG_BAR; PG_SCHED;
            PG_LDA(At, 1, 1); PG_STAGE(PG_SB(1, 0), b3, ldb2); PG_STAGE(PG_SB(1, 1), b3 + (size_t)HALF * ldb2, ldb2); PG_STAGE(PG_SA(1, 0), a3, lda2);
            PG_WAIT_V(8); PG_WAIT_L(0); PG_BAR; PG_MMA(1, 0, At, B0); PG_MMA(1, 1, At, B1); PG_BAR; PG_SCHED;
        }
        if (wr == 0) PG_BAR;
        E(acc, cur, lds, wr, wc, fr, fq);
        if (!has_next) break;
#pragma unroll
        for (int a = 0; a < 2; ++a)
#pragma unroll
            for (int b = 0; b < 2; ++b)
#pragma unroll
                for (int m = 0; m < 4; ++m)
#pragma unroll
                    for (int n = 0; n < 2; ++n) acc[a][b][m][n] = (f32x4){0.f, 0.f, 0.f, 0.f};
        cur = nxt; cA = nA; cB = nB; clda = nlda; cldb = nldb; ++ui;
        if (wr == 1) PG_BAR;
    }
    PG_WAIT_V(0);
    PG_BAR;
#undef PG_SA
#undef PG_SB
#undef PG_STAGE
#undef PG_LDA
#undef PG_LDB
#undef PG_MMA
#undef PG_WAIT_V
#undef PG_WAIT_L
#undef PG_BAR
#undef PG_SCHED
}
}

struct MArgs { const float* in[24]; float* out; unsigned char* ws; int ph_lo, ph_hi, li, pad; };
struct Frame {
    LAS unsigned char* lds; int tid, lane, wave; int x, j, vcu, G;
    const MArgs* a; float* out; unsigned char* ws;
};
#define FIN(k) (F.a->in[k])
__device__ __forceinline__ float fwave_sum(float v) {
#pragma unroll
    for (int o = 1; o < 64; o <<= 1) v += __shfl_xor(v, o);
    return v;
}

enum { W_IN = 0, W_QUP, W_KVUP, W_OBA, W_OBB, W_OUT, W_UP, W_DOWN };
__device__ __forceinline__ int win_src(int gd) {
    const int tile = gd >> 3, g = gd & 7, bj = g >> 2, wc = g & 3;
    if (tile < 3) return C_QLAT + gd * 32;
    if (tile < 5) return C_KVLAT + (gd - 24) * 32;
    if (tile == 5) return (wc == 0) ? C_KPE + bj * 32 : -1;
    if (tile < 10) { const int base = tile < 8 ? C_RQ : C_RK, tl = tile < 8 ? tile - 6 : tile - 8; const int head = 2 * tl + (wc >> 1); return base + head * 128 + bj * 64 + (wc & 1) * 32; }
    if (tile < 14) return C_RV + (gd - 80) * 32;
    if (tile < 18) return C_RG + (gd - 112) * 32;
    if (tile < 22) return C_GA + (gd - 144) * 32;
    return C_GB + (gd - 176) * 32;
}
__device__ __forceinline__ int w_src_col(int wid, int row) {
    const int rho = row & 31, s = row & 255, wc = (s >> 5) & 3, t = row >> 8;
    const int n = rho >> 4, i = rho & 15; return t * 192 + 128 + 16 * wc + i + 32 * n;
}
__device__ __forceinline__ int w_group_base(int wid, int gd) {
    const int g = gd & 7, bj = g >> 2, wc = g & 3, t = gd >> 3;
    switch (wid) {
    case W_IN: return win_src(gd);
    case W_QUP: return bj == 0 ? t * 192 + 32 * wc : (wc < 2 ? -2 : -1);
    case W_KVUP: return t * 256 + 128 * bj + 32 * wc;
    case W_UP: return (bj ? D_FF : 0) + 128 * t + 32 * wc;
    default: return gd * 32;
    }
}
__device__ __forceinline__ void p0_weight_item(const float* __restrict__ W, int ldw, int K, const float* __restrict__ gain, int wid, bf16_t* __restrict__ Wt, int gd, int kb, LAS float* scr, int lane) {
    const int k0 = kb * 64; const int base = w_group_base(wid, gd);
    bf16_t* dst = Wt + (size_t)(gd * 32) * K + k0;
    const int c = lane & 7;
    if (base == -1) {
#pragma unroll
        for (int jj = 0; jj < 4; ++jj) { const int n = (lane >> 3) + 8 * jj; *(u32x4*)(dst + (size_t)n * K + 8 * c) = (u32x4){0u, 0u, 0u, 0u}; }
        return;
    }
    if (base >= 0) {
#pragma unroll
        for (int i = 0; i < 8; ++i) { const int kk = (lane >> 3) + 8 * i; const float g = gain ? gain[k0 + kk] : 1.f;
            const f32x4 v = *(const f32x4*)(W + (size_t)(k0 + kk) * ldw + base + 4 * c); LAS float* d = scr + kk * 33 + 4 * c; d[0] = v[0] * g; d[1] = v[1] * g; d[2] = v[2] * g; d[3] = v[3] * g; }
    } else {
        const int sc = w_src_col(wid, gd * 32 + (lane & 31));
#pragma unroll 8
        for (int i = 0; i < 32; ++i) { const int kk = 2 * i + (lane >> 5); const float g = gain ? gain[k0 + kk] : 1.f; scr[kk * 33 + (lane & 31)] = W[(size_t)(k0 + kk) * ldw + sc] * g; }
    }
    asm volatile("s_waitcnt lgkmcnt(0)" ::: "memory");
#pragma unroll
    for (int jj = 0; jj < 4; ++jj) { const int n = (lane >> 3) + 8 * jj; const LAS float* s = scr + (8 * c) * 33 + (base >= 0 ? pg::perm32(n) : n);
        u32x4 o; o.x = cvt_pk_bf16(s[0 * 33], s[1 * 33]); o.y = cvt_pk_bf16(s[2 * 33], s[3 * 33]); o.z = cvt_pk_bf16(s[4 * 33], s[5 * 33]); o.w = cvt_pk_bf16(s[6 * 33], s[7 * 33]);
        *(u32x4*)(dst + (size_t)n * K + 8 * c) = o; }
    asm volatile("s_waitcnt lgkmcnt(0)" ::: "memory");
}
__device__ __forceinline__ void p0_weights(Frame& F, LAS float* scr, int gw, int NGW, const float* W, int ldw, int K, const float* gain, int wid, size_t off, int ngroups) {
    const int nkb = K / 64; bf16_t* Wt = (bf16_t*)(F.ws + off);
    for (int it = gw; it < ngroups * nkb; it += NGW) { const int gd = it / nkb, kb = it % nkb; p0_weight_item(W, ldw, K, gain, wid, Wt, gd, kb, scr, F.lane); }
}
__device__ __forceinline__ float2 rope_cs(int pos, double f) {
    const double a = (double)pos * f; const double n = rint(a * 0.15915494309189535); const double r = fma(-n, 6.283185307179586, a) - n * 2.4492935982947064e-16;
    const float rf = (float)r; return make_float2(cosf(rf), sinf(rf));
}
__device__ __forceinline__ void p0_prologue(Frame& F) {
    LAS float* scr = (LAS float*)(F.lds + F.wave * 16384);
    const int gw = F.vcu * 8 + F.wave, NGW = F.G * 8;
    p0_weights(F, scr, gw, NGW, FIN(7), IN_W, 1024, FIN(6), W_IN, WS_FWIN, 26 * 8);
    p0_weights(F, scr, gw, NGW, FIN(9), 1536, 768, FIN(8), W_QUP, WS_FWQUP, 8 * 8);
    p0_weights(F, scr, gw, NGW, FIN(13), 2048, 512, nullptr, W_KVUP, WS_FWKVUP, 8 * 8);
    p0_weights(F, scr, gw, NGW, FIN(17), 1024, 1024, nullptr, W_OBA, WS_FWOBA, 4 * 8);
    p0_weights(F, scr, gw, NGW, FIN(17) + (size_t)1024 * 1024, 1024, 1024, nullptr, W_OBB, WS_FWOBB, 4 * 8);
    p0_weights(F, scr, gw, NGW, FIN(18), 1024, 1024, nullptr, W_OUT, WS_FWOUT, 4 * 8);
    p0_weights(F, scr, gw, NGW, FIN(20), FF2, 1024, FIN(19), W_UP, WS_FWUP, 22 * 8);
    p0_weights(F, scr, gw, NGW, FIN(23), 1024, D_FF, nullptr, W_DOWN, WS_FWDOWN, 4 * 8);
    {   bf16_t* XN = (bf16_t*)(F.ws + WS_XN);
        for (int r = gw; r < MPAD; r += NGW) {
            u32x2* o8 = (u32x2*)(XN + (size_t)r * D_MODEL) + F.lane;
            if (r >= MT) { for (int jj = 0; jj < 4; ++jj) o8[64 * jj] = (u32x2){0u, 0u}; continue; }
            const float* x = r < MP ? FIN(0) + (size_t)r * D_MODEL : FIN(1) + (size_t)(r - MP) * D_MODEL;
            const f32x4* xr = (const f32x4*)x + F.lane; f32x4 v[4]; float s = 0.f;
#pragma unroll
            for (int jj = 0; jj < 4; ++jj) { v[jj] = xr[64 * jj]; s += (v[jj][0] * v[jj][0] + v[jj][1] * v[jj][1]) + (v[jj][2] * v[jj][2] + v[jj][3] * v[jj][3]); }
            const float inv = rsqrtf(fwave_sum(s) * (1.f / D_MODEL) + EPS);
#pragma unroll
            for (int jj = 0; jj < 4; ++jj) { u32x2 w; w.x = cvt_pk_bf16(v[jj][0] * inv, v[jj][1] * inv); w.y = cvt_pk_bf16(v[jj][2] * inv, v[jj][3] * inv); o8[64 * jj] = w; }
        } }
    {   bf16_t* lats = (bf16_t*)(F.ws + WS_LATS); bf16_t* pes = (bf16_t*)(F.ws + WS_PES);
        const int gt = F.vcu * NTHR + F.tid, NG = F.G * NTHR;
        for (int i = gt; i < DEC_BATCH * PAST * (KV_LORA / 4); i += NG) { const int c4 = i % (KV_LORA / 4), rj = i / (KV_LORA / 4), jr = rj % PAST, b = rj / PAST;
            const f32x4 v = *((const f32x4*)FIN(2) + i); u32x2 w; w.x = cvt_pk_bf16(v[0], v[1]); w.y = cvt_pk_bf16(v[2], v[3]);
            *(u32x2*)(lats + ((size_t)b * SKEYS + jr) * KV_LORA + c4 * 4) = w; }
        for (int i = gt; i < DEC_BATCH * PAST * (QK_ROPE / 4); i += NG) { const int c4 = i % (QK_ROPE / 4), rj = i / (QK_ROPE / 4), jr = rj % PAST, b = rj / PAST;
            const f32x4 v = *((const f32x4*)FIN(3) + i); u32x2 w; w.x = cvt_pk_bf16(v[0], v[1]); w.y = cvt_pk_bf16(v[2], v[3]);
            *(u32x2*)(pes + ((size_t)b * SKEYS + jr) * QK_ROPE + c4 * 4) = w; }
        float2* tab32 = (float2*)(F.ws + WS_TAB32); float2* tab64 = (float2*)(F.ws + WS_TAB64);
        {   const int k64 = gt & 63, k32 = gt & 31;
            const double f64 = exp2(-(double)k64 * (13.287712379549449 / 64.0)), f32 = exp2(-(double)k32 * (13.287712379549449 / 32.0));
            for (int i = gt; i < 8192 * 64; i += NG) { tab64[i] = rope_cs(i >> 6, f64); if (i < 8192 * 32) tab32[i] = rope_cs(i >> 5, f32); } } }
}

__device__ __forceinline__ bool reg_unit(int x, int j, int i, int nN, int& pm, int& pn) { const int u = j + 32 * i; if (u >= 8 * nN) return false; pm = 8 * x + (u & 7); pn = u >> 3; return true; }
#define LDS_F(off) ((LAS float*)(lds + EPI_OFF) + (off))

enum { K_QLAT = 0, K_KVLAT, K_KPE, K_RQ, K_RK, K_RV, K_RG, K_QUP, K_KVP, K_KVS, K_GA, K_AD, K_GB, K_RD, K_OUT, K_UP, K_DOWN };
struct SchedP1 {
    int x, j; const char* ws;
    __device__ __forceinline__ bool next(int i, pg::UnitG& u) const {
        int pm, pn;
        if (!reg_unit(x, j, i, 18, pm, pn)) { if (i == 4 && j >= 16) { const int k = (j - 16) * 8 + x; if (k >= 18) return false; pm = 64; pn = k; } else return false; }
        u.pm = pm; u.pn = pn; u.A = ws + WS_XN + (size_t)pm * 256 * 2048; u.B = ws + WS_FWIN + (size_t)pn * 256 * 2048; u.lda = 2048; u.ldb = 2048; u.nt = 16;
        u.kind = pn < 3 ? K_QLAT : pn < 5 ? K_KVLAT : pn == 5 ? K_KPE : pn < 8 ? K_RQ : pn < 10 ? K_RK : pn < 14 ? K_RV : K_RG;
        return true;
    }
};
struct EpiP1 {
    unsigned char* ws; float* out; const float *g_kvlat, *g_kr;
    __device__ __forceinline__ void operator()(const pg::Acc& acc, const pg::UnitG& u, LAS unsigned char* lds, int wr, int wc, int fr, int fq) const {
        bf16_t* const ZQ = (bf16_t*)(ws + WS_ZQ); bf16_t* const KVL = (bf16_t*)(ws + WS_KVL); bf16_t* const KPE = (bf16_t*)(ws + WS_KPE); bf16_t* const PES = (bf16_t*)(ws + WS_PES); bf16_t* const LATS = (bf16_t*)(ws + WS_LATS);
        bf16_t* const RQ = (bf16_t*)(ws + WS_RQ); bf16_t* const RK = (bf16_t*)(ws + WS_RK); bf16_t* const RV = (bf16_t*)(ws + WS_RV); bf16_t* const RG = (bf16_t*)(ws + WS_RG);
        float* const slotq = (float*)(ws + WS_SLOTQ); float* const slotkv = (float*)(ws + WS_SLOTKV);
        const float2* const tab32 = (const float2*)(ws + WS_TAB32); const float2* const tab64 = (const float2*)(ws + WS_TAB64);
        int rl0 = wr * 64 + fr, cw = wc * 32 + fq * 8; asm volatile("" : "+v"(rl0), "+v"(cw));
        const int kind = u.kind, rb = u.pm * 256 + rl0;
        if (kind == K_QLAT || kind == K_KVLAT) {
            const int t = kind == K_QLAT ? u.pn : u.pn - 3; const int ld = kind == K_QLAT ? Q_LORA : KV_LORA; bf16_t* dst = kind == K_QLAT ? ZQ : KVL;
            f32x4 g[2][2];
#pragma unroll
            for (int bj = 0; bj < 2; ++bj)
#pragma unroll
                for (int n = 0; n < 2; ++n) g[bj][n] = kind == K_KVLAT ? *(const f32x4*)(g_kvlat + t * 256 + bj * 128 + cw + 4 * n) : (f32x4){1.f, 1.f, 1.f, 1.f};
#pragma unroll
            for (int ai = 0; ai < 2; ++ai)
#pragma unroll
                for (int m = 0; m < 4; ++m) { const int row = rb + ai * 128 + m * 16; float ss = 0.f;
                    const bool snew = (kind == K_KVLAT) && row >= MP && row < MT;
                    const int rs = row - MP; bf16_t* lrow = LATS + ((size_t)(rs / DEC_SEQ) * SKEYS + PAST + (rs % DEC_SEQ)) * KV_LORA;
#pragma unroll
                    for (int bj = 0; bj < 2; ++bj) { const f32x4 v0 = acc[ai][bj][m][0], v1 = acc[ai][bj][m][1];
                        ss += (v0[0] * v0[0] + v0[1] * v0[1]) + (v0[2] * v0[2] + v0[3] * v0[3]) + (v1[0] * v1[0] + v1[1] * v1[1]) + (v1[2] * v1[2] + v1[3] * v1[3]);
                        const u32x4 w = pack8f(v0 * g[bj][0], v1 * g[bj][1]);
                        *(u32x4*)(dst + (size_t)row * ld + t * 256 + bj * 128 + cw) = w;
                        if (snew) *(u32x4*)(lrow + t * 256 + bj * 128 + cw) = w; }
                    ss += __shfl_xor(ss, 16); ss += __shfl_xor(ss, 32);
                    if (fq == 0) { if (kind == K_QLAT) slotq[(size_t)row * 12 + t * 4 + wc] = ss; else slotkv[(size_t)row * 8 + t * 4 + wc] = ss; } }
        } else if (kind == K_KPE) {
            if (wc != 0) return;
            const int d0 = fq * 8;
            f32x4 g1[2], g2[2];
#pragma unroll
            for (int n = 0; n < 2; ++n) { g1[n] = *(const f32x4*)(g_kr + d0 + 4 * n); g2[n] = *(const f32x4*)(g_kr + 32 + d0 + 4 * n); }
#pragma unroll
            for (int ai = 0; ai < 2; ++ai)
#pragma unroll
                for (int m = 0; m < 4; ++m) { const int row = rb + ai * 128 + m * 16; const int pos = row_pos(row < MT ? row : 0);
                    f32x4 x1[2], x2[2]; float ss = 0.f;
#pragma unroll
                    for (int n = 0; n < 2; ++n) { x1[n] = acc[ai][0][m][n]; x2[n] = acc[ai][1][m][n];
                        ss += (x1[n][0] * x1[n][0] + x1[n][1] * x1[n][1]) + (x1[n][2] * x1[n][2] + x1[n][3] * x1[n][3]) + (x2[n][0] * x2[n][0] + x2[n][1] * x2[n][1]) + (x2[n][2] * x2[n][2] + x2[n][3] * x2[n][3]); }
                    ss += __shfl_xor(ss, 16); ss += __shfl_xor(ss, 32);
                    const float inv = rsqrtf(ss * (1.f / 64.f) + EPS);
                    f32x4 o1[2], o2[2];
#pragma unroll
                    for (int n = 0; n < 2; ++n) { const f32x4 y1 = x1[n] * inv * g1[n], y2 = x2[n] * inv * g2[n];
                        const f32x4 cs0 = *(const f32x4*)(tab32 + pos * 32 + d0 + 4 * n), cs1 = *(const f32x4*)(tab32 + pos * 32 + d0 + 4 * n + 2);
                        const f32x4 c = {cs0[0], cs0[2], cs1[0], cs1[2]}, s = {cs0[1], cs0[3], cs1[1], cs1[3]};
                        o1[n] = y1 * c - y2 * s; o2[n] = y1 * s + y2 * c; }
                    *(u32x4*)(KPE + (size_t)row * 64 + d0) = pack8f(o1[0], o1[1]); *(u32x4*)(KPE + (size_t)row * 64 + 32 + d0) = pack8f(o2[0], o2[1]);
                    if (row < MT) {
                        float* o = row < MP ? out + O_RKP + (size_t)row * 64 : out + O_RKS + (size_t)(row - MP) * 64;
                        *(f32x4*)(o + d0) = o1[0]; *(f32x4*)(o + d0 + 4) = o1[1]; *(f32x4*)(o + 32 + d0) = o2[0]; *(f32x4*)(o + 32 + d0 + 4) = o2[1];
                        if (row >= MP) { const int rs = row - MP, b = rs / DEC_SEQ, tt = rs % DEC_SEQ; bf16_t* p = PES + ((size_t)b * SKEYS + PAST + tt) * 64;
                            *(u32x4*)(p + d0) = pack8f(o1[0], o1[1]); *(u32x4*)(p + 32 + d0) = pack8f(o2[0], o2[1]); } } }
        } else if (kind == K_RQ || kind == K_RK) {
            const int tl = kind == K_RQ ? u.pn - 6 : u.pn - 8; const int head = 2 * tl + (wc >> 1), i0 = 32 * (wc & 1) + fq * 8;
            bf16_t* dst = kind == K_RQ ? RQ : RK; const float sc = kind == K_RQ ? 1.0f : 0.08838834764831845f;
#pragma unroll
            for (int ai = 0; ai < 2; ++ai)
#pragma unroll
                for (int m = 0; m < 4; ++m) { const int row = rb + ai * 128 + m * 16; const int pos = row_pos(row < MT ? row : 0);
                    f32x4 o1[2], o2[2];
#pragma unroll
                    for (int n = 0; n < 2; ++n) { const f32x4 x1 = acc[ai][0][m][n], x2 = acc[ai][1][m][n];
                        const f32x4 cs0 = *(const f32x4*)(tab64 + pos * 64 + i0 + 4 * n), cs1 = *(const f32x4*)(tab64 + pos * 64 + i0 + 4 * n + 2);
                        const f32x4 c = {cs0[0], cs0[2], cs1[0], cs1[2]}, s = {cs0[1], cs0[3], cs1[1], cs1[3]};
                        o1[n] = (x1 * c - x2 * s) * sc; o2[n] = (x1 * s + x2 * c) * sc; }
                    *(u32x4*)(dst + (size_t)row * 512 + head * 128 + i0) = pack8f(o1[0], o1[1]); *(u32x4*)(dst + (size_t)row * 512 + head * 128 + 64 + i0) = pack8f(o2[0], o2[1]); }
        } else {
            const int t = kind == K_RV ? u.pn - 10 : u.pn - 14; bf16_t* dst = kind == K_RV ? RV : RG;
#pragma unroll
            for (int ai = 0; ai < 2; ++ai)
#pragma unroll
                for (int m = 0; m < 4; ++m) { const int row = rb + ai * 128 + m * 16;
#pragma unroll
                    for (int bj = 0; bj < 2; ++bj) { f32x4 v0 = acc[ai][bj][m][0], v1 = acc[ai][bj][m][1];
                        if (kind == K_RG) {
#pragma unroll
                            for (int e = 0; e < 4; ++e) { v0[e] = v0[e] / (1.f + __expf(-v0[e])); v1[e] = v1[e] / (1.f + __expf(-v1[e])); } }
                        *(u32x4*)(dst + (size_t)row * 1024 + t * 256 + bj * 128 + cw) = pack8f(v0, v1); } }
        }
    }
};
__device__ __forceinline__ void p1_inproj(Frame& F) {
    SchedP1 S{F.x, F.j, (const char*)F.ws};
    EpiP1 E{F.ws, F.out, FIN(12), FIN(15)};
    pg::gemm_stream(F.lds, S, E);
}

__device__ __forceinline__ float slot_rs(const float* slots, int n, float invn) {
    float a = 0.f; for (int i = 0; i < n; i += 4) { const f32x4 v = *(const f32x4*)(slots + i); a += (v[0] + v[1]) + (v[2] + v[3]); } return rsqrtf(a * invn + EPS);
}
struct SchedP2 {
    int x, j; const char* ws; int sample;
    __device__ __forceinline__ bool next(int i, pg::UnitG& u) const {
        int pm, pn, kind;
        if (sample) {
            if (i < 2) { reg_unit(x, j, i, 8, pm, pn); kind = K_QUP; }
            else if (i < 4) { reg_unit(x, j, i - 2, 8, pm, pn); kind = K_KVS; }
            else if (i == 4 && j < 2) { const int k = j * 8 + x; pm = 64; pn = k & 7; kind = k < 8 ? K_QUP : K_KVS; }
            else return false;
        } else { if (i >= 2) return false; reg_unit(x, j, i, 8, pm, pn); kind = K_KVP; }
        u.pm = pm; u.pn = pn; u.kind = kind;
        if (kind == K_QUP) { u.A = ws + WS_ZQ + (size_t)pm * 256 * 1536; u.lda = 1536; u.B = ws + WS_FWQUP + (size_t)pn * 256 * 1536; u.ldb = 1536; u.nt = 12; }
        else { u.A = ws + (kind == K_KVS ? WS_LATS : WS_KVL) + (size_t)pm * 256 * 1024; u.lda = 1024; u.B = ws + WS_FWKVUP + (size_t)pn * 256 * 1024; u.ldb = 1024; u.nt = 8; }
        return true;
    }
};
struct EpiP2 {
    unsigned char* ws; float* out; const float *g_qn, *g_qr, *g_kn;
    __device__ __forceinline__ void operator()(const pg::Acc& acc, const pg::UnitG& u, LAS unsigned char* lds, int wr, int wc, int fr, int fq) const {
        int rl0 = wr * 64 + fr, cw = wc * 32 + fq * 8; asm volatile("" : "+v"(rl0), "+v"(cw));
        const int kind = u.kind, h = u.pn, rb = u.pm * 256 + rl0;
        const float* const slotq = (const float*)(ws + WS_SLOTQ); const float* const slotkv = (const float*)(ws + WS_SLOTKV);
        float rs[2][4];
#pragma unroll
        for (int ai = 0; ai < 2; ++ai)
#pragma unroll
            for (int m = 0; m < 4; ++m) { const int row = rb + ai * 128 + m * 16;
                if (kind == K_QUP) rs[ai][m] = slot_rs(slotq + (size_t)row * 12, 12, 1.f / Q_LORA);
                else if (kind == K_KVP) rs[ai][m] = slot_rs(slotkv + (size_t)row * 8, 8, 1.f / KV_LORA);
                else { const int b = row / SKEYS, jj = row - b * SKEYS; rs[ai][m] = (row < LROWS && jj >= PAST) ? slot_rs(slotkv + (size_t)(MP + b * DEC_SEQ + jj - PAST) * 8, 8, 1.f / KV_LORA) : 1.f; } }
#pragma unroll
        for (int ai = 0; ai < 2; ++ai)
#pragma unroll
            for (int m = 0; m < 4; ++m) { float p0 = 0.f, p1 = 0.f; const float s2 = rs[ai][m] * rs[ai][m];
#pragma unroll
                for (int n = 0; n < 2; ++n) { const f32x4 a = acc[ai][0][m][n], b = acc[ai][1][m][n];
                    p0 += (a[0] * a[0] + a[1] * a[1]) + (a[2] * a[2] + a[3] * a[3]); p1 += (b[0] * b[0] + b[1] * b[1]) + (b[2] * b[2] + b[3] * b[3]); }
                p0 += __shfl_xor(p0, 16); p0 += __shfl_xor(p0, 32); p1 += __shfl_xor(p1, 16); p1 += __shfl_xor(p1, 32);
                if (fq == 0) { LAS float* d = LDS_F((rl0 + ai * 128 + m * 16) * 8 + wc * 2); d[0] = p0 * s2; d[1] = p1 * s2; } }
        asm volatile("s_waitcnt lgkmcnt(0)" ::: "memory"); __builtin_amdgcn_s_barrier(); asm volatile("" ::: "memory");
        if (kind == K_QUP) {
            bf16_t* const Q = (bf16_t*)out;
            const float2* const tab32 = (const float2*)(ws + WS_TAB32);
            const float C2 = 0.07216878364870323f * 1.4426950408889634f;
            f32x4 gn[2]; gn[0] = *(const f32x4*)(g_qn + cw); gn[1] = *(const f32x4*)(g_qn + cw + 4);
            const int ir = 16 * (wc & 1) + 4 * fq; const f32x4 gr1 = *(const f32x4*)(g_qr + ir), gr2 = *(const f32x4*)(g_qr + 32 + ir);
#pragma unroll
            for (int ai = 0; ai < 2; ++ai)
#pragma unroll
                for (int m = 0; m < 4; ++m) { const int row = rb + ai * 128 + m * 16; const int pos = row_pos(row < MT ? row : 0);
                    const LAS float* d = LDS_F((rl0 + ai * 128 + m * 16) * 8); const f32x4 e0 = *(const LAS f32x4*)d, e1 = *(const LAS f32x4*)(d + 4);
                    const float inn = rsqrtf((e0[0] + e0[2] + e1[0] + e1[2]) * (1.f / 128.f) + EPS) * rs[ai][m] * C2, inr = rsqrtf((e0[1] + e0[3]) * (1.f / 64.f) + EPS) * rs[ai][m];
                    bf16_t* qrow = Q + (size_t)row * 1536 + h * 192;
                    *(u32x4*)(qrow + cw) = pack8f(acc[ai][0][m][0] * inn * gn[0], acc[ai][0][m][1] * inn * gn[1]);
                    if (wc < 2) { const f32x4 y1 = acc[ai][1][m][0] * inr * gr1, y2 = acc[ai][1][m][1] * inr * gr2;
                        const f32x4 cs0 = *(const f32x4*)(tab32 + pos * 32 + ir), cs1 = *(const f32x4*)(tab32 + pos * 32 + ir + 2);
                        const f32x4 c = {cs0[0], cs0[2], cs1[0], cs1[2]}, s = {cs0[1], cs0[3], cs1[1], cs1[3]};
                        const f32x4 o1 = (y1 * c - y2 * s) * C2, o2 = (y1 * s + y2 * c) * C2;
                        u32x2 w1, w2; w1.x = cvt_pk_bf16(o1[0], o1[1]); w1.y = cvt_pk_bf16(o1[2], o1[3]); w2.x = cvt_pk_bf16(o2[0], o2[1]); w2.y = cvt_pk_bf16(o2[2], o2[3]);
                        *(u32x2*)(qrow + 128 + ir) = w1; *(u32x2*)(qrow + 160 + ir) = w2; } }
        } else {
            bf16_t* const KN = (bf16_t*)(ws + WS_KN); bf16_t* const V = (bf16_t*)(ws + WS_V);
            f32x4 gk[2]; gk[0] = *(const f32x4*)(g_kn + cw); gk[1] = *(const f32x4*)(g_kn + cw + 4);
#pragma unroll
            for (int ai = 0; ai < 2; ++ai)
#pragma unroll
                for (int m = 0; m < 4; ++m) { const int row = rb + ai * 128 + m * 16;
                    const LAS float* d = LDS_F((rl0 + ai * 128 + m * 16) * 8); const f32x4 e0 = *(const LAS f32x4*)d, e1 = *(const LAS f32x4*)(d + 4);
                    const float s = rs[ai][m], inn = rsqrtf((e0[0] + e0[2] + e1[0] + e1[2]) * (1.f / 128.f) + EPS) * s;
                    *(u32x4*)(KN + (size_t)row * 1024 + h * 128 + cw) = pack8f(acc[ai][0][m][0] * inn * gk[0], acc[ai][0][m][1] * inn * gk[1]);
                    *(u32x4*)(V + (size_t)row * 1024 + h * 128 + cw) = pack8f(acc[ai][1][m][0] * s, acc[ai][1][m][1] * s); }
        }
    }
};
__device__ __forceinline__ void p2_qkv(Frame& F, int sample) {
    SchedP2 S{F.x, F.j, (const char*)F.ws, sample};
    EpiP2 E{F.ws, F.out, FIN(10), FIN(11), FIN(14)};
    pg::gemm_stream(F.lds, S, E);
}

struct SchedP5 {
    int x, j, vcu; const char* ws; int phase;
    __device__ __forceinline__ const char* arow(size_t base, size_t base_s, int pm, size_t rowbytes) const { return ws + (pm < 64 ? base + (size_t)pm * 256 * rowbytes : base_s); }
    __device__ __forceinline__ bool next(int i, pg::UnitG& u) const {
        int pm, pn;
        if (phase == 5) {
            const int sub = i & 3, tile = i >> 2;
            if (tile == 0) { pm = 8 * x + (j & 7); pn = j >> 3; } else if (tile == 1 && j == 0 && x < 4) { pm = 64; pn = x; } else return false;
            u.pm = pm; u.pn = pn; u.kind = K_GA + sub; u.lda = 2048; u.ldb = 2048; u.nt = 16;
            if (sub == 0) { u.A = ws + WS_XN2 + (size_t)pm * 256 * 2048; u.B = ws + WS_FWIN + (size_t)(18 + pn) * 256 * 2048; }
            else if (sub == 1) { u.A = arow(WS_ATT, WS_ATTS, pm, 2048); u.B = ws + WS_FWOBA + (size_t)pn * 256 * 2048; }
            else if (sub == 2) { u.A = ws + WS_XN2 + (size_t)pm * 256 * 2048; u.B = ws + WS_FWIN + (size_t)(22 + pn) * 256 * 2048; }
            else { u.A = ws + WS_RET + (size_t)pm * 256 * 2048; u.B = ws + WS_FWOBB + (size_t)pn * 256 * 2048; }
            return true;
        }
        if (phase == 6 || phase == 9) {
            if (i == 0) { pm = 8 * x + (j & 7); pn = j >> 3; } else if (i == 1 && j == 0 && x < 4) { pm = 64; pn = x; } else return false;
            u.pm = pm; u.pn = pn;
            if (phase == 6) { u.kind = K_OUT; u.A = ws + WS_MERGED + (size_t)pm * 256 * 2048; u.lda = 2048; u.B = ws + WS_FWOUT + (size_t)pn * 256 * 2048; u.ldb = 2048; u.nt = 16; }
            else { u.kind = K_DOWN; u.A = ws + WS_U + (size_t)pm * 256 * (FF2 * 2); u.lda = FF2 * 2; u.B = ws + WS_FWDOWN + (size_t)pn * 256 * (D_FF * 2); u.ldb = D_FF * 2; u.nt = 44; }
            return true;
        }
        if (!reg_unit(x, j, i, 22, pm, pn)) { if (i == 5 && j >= 16) { const int k = (j - 16) * 8 + x; if (k >= 22) return false; pm = 64; pn = k; } else return false; }
        u.pm = pm; u.pn = pn; u.kind = K_UP; u.A = ws + WS_X1B + (size_t)pm * 256 * 2048; u.lda = 2048; u.B = ws + WS_FWUP + (size_t)pn * 256 * 2048; u.ldb = 2048; u.nt = 16;
        return true;
    }
};
struct EpiP5 {
    unsigned char* ws; float* out; const float* xp; const float* xs; int vcu;
    __device__ __forceinline__ void operator()(pg::Acc& acc, const pg::UnitG& u, LAS unsigned char* lds, int wr, int wc, int fr, int fq) const {
        int rl0 = wr * 64 + fr, cw = wc * 32 + fq * 8; asm volatile("" : "+v"(rl0), "+v"(cw));
        const int kind = u.kind, rb = u.pm * 256 + rl0;
        if (kind >= K_GA && kind <= K_RD) {
            bf16_t* const T1 = (bf16_t*)(ws + WS_T1) + (size_t)vcu * 65536; bf16_t* const T2 = (bf16_t*)out + (size_t)vcu * 65536;
            bf16_t* const MG = (bf16_t*)(ws + WS_MERGED);
#pragma unroll
            for (int ai = 0; ai < 2; ++ai)
#pragma unroll
                for (int m = 0; m < 4; ++m)
#pragma unroll
                    for (int bj = 0; bj < 2; ++bj) { const size_t so = (size_t)(rl0 + ai * 128 + m * 16) * 256 + bj * 128 + cw;
                        f32x4 v0 = acc[ai][bj][m][0], v1 = acc[ai][bj][m][1];
                        if (kind == K_GA || kind == K_GB) {
#pragma unroll
                            for (int e = 0; e < 4; ++e) { v0[e] = 1.f / (1.f + __expf(-v0[e])); v1[e] = 1.f / (1.f + __expf(-v1[e])); }
                            *(u32x4*)((kind == K_GA ? T1 : T2) + so) = pack8f(v0, v1);
                        } else if (kind == K_AD) {
                            const u32x4 t = *(const u32x4*)(T1 + so);
                            const f32x4 g0 = {__uint_as_float(t.x << 16), __uint_as_float(t.x & 0xffff0000u), __uint_as_float(t.y << 16), __uint_as_float(t.y & 0xffff0000u)};
                            const f32x4 g1 = {__uint_as_float(t.z << 16), __uint_as_float(t.z & 0xffff0000u), __uint_as_float(t.w << 16), __uint_as_float(t.w & 0xffff0000u)};
                            *(u32x4*)(T1 + so) = pack8f(v0 * g0, v1 * g1);
                        } else {
                            const u32x4 t = *(const u32x4*)(T1 + so), q = *(const u32x4*)(T2 + so);
                            const f32x4 a0 = {__uint_as_float(t.x << 16), __uint_as_float(t.x & 0xffff0000u), __uint_as_float(t.y << 16), __uint_as_float(t.y & 0xffff0000u)};
                            const f32x4 a1 = {__uint_as_float(t.z << 16), __uint_as_float(t.z & 0xffff0000u), __uint_as_float(t.w << 16), __uint_as_float(t.w & 0xffff0000u)};
                            const f32x4 g0 = {__uint_as_float(q.x << 16), __uint_as_float(q.x & 0xffff0000u), __uint_as_float(q.y << 16), __uint_as_float(q.y & 0xffff0000u)};
                            const f32x4 g1 = {__uint_as_float(q.z << 16), __uint_as_float(q.z & 0xffff0000u), __uint_as_float(q.w << 16), __uint_as_float(q.w & 0xffff0000u)};
                            *(u32x4*)(MG + (size_t)(rb + ai * 128 + m * 16) * 1024 + u.pn * 256 + bj * 128 + cw) = pack8f(a0 + v0 * g0, a1 + v1 * g1);
                        }
                        if (bj == 1 && (m & 1)) asm volatile("" ::: "memory"); }
            if (kind != K_RD) asm volatile("s_waitcnt vmcnt(0)" ::: "memory");
        } else if (kind == K_OUT) {
            float* const slotx = (float*)(ws + WS_SLOTX1); bf16_t* const X1B = (bf16_t*)(ws + WS_X1B);
#pragma unroll
            for (int ai = 0; ai < 2; ++ai)
#pragma unroll
                for (int m = 0; m < 4; ++m) { const int row = rb + ai * 128 + m * 16; float ss = 0.f;
                    const float* xr = row < MP ? xp + (size_t)row * D_MODEL : xs + (size_t)((row < MT ? row : MP) - MP) * D_MODEL;
#pragma unroll
                    for (int bj = 0; bj < 2; ++bj) { const int c = u.pn * 256 + bj * 128 + cw;
                        const f32x4 x0 = *(const f32x4*)(xr + c), x1 = *(const f32x4*)(xr + c + 4);
                        const f32x4 v0 = acc[ai][bj][m][0] + x0, v1 = acc[ai][bj][m][1] + x1;
                        ss += (v0[0] * v0[0] + v0[1] * v0[1]) + (v0[2] * v0[2] + v0[3] * v0[3]) + (v1[0] * v1[0] + v1[1] * v1[1]) + (v1[2] * v1[2] + v1[3] * v1[3]);
                        if (row < MT) { *(f32x4*)(out + (size_t)row * D_MODEL + c) = v0; *(f32x4*)(out + (size_t)row * D_MODEL + c + 4) = v1; }
                        *(u32x4*)(X1B + (size_t)row * D_MODEL + c) = pack8f(v0, v1); }
                    ss += __shfl_xor(ss, 16); ss += __shfl_xor(ss, 32);
                    if (fq == 0) slotx[(size_t)row * 16 + u.pn * 4 + wc] = ss;
                    asm volatile("" ::: "memory"); }
        } else if (kind == K_UP) {
            const float* const slotx = (const float*)(ws + WS_SLOTX1); bf16_t* const U = (bf16_t*)(ws + WS_U);
#pragma unroll
            for (int ai = 0; ai < 2; ++ai)
#pragma unroll
                for (int m = 0; m < 4; ++m) { const int row = rb + ai * 128 + m * 16;
                    float a = 0.f;
#pragma unroll
                    for (int i = 0; i < 16; i += 4) { const f32x4 v = *(const f32x4*)(slotx + (size_t)row * 16 + i); a += (v[0] + v[1]) + (v[2] + v[3]); }
                    const float s = rsqrtf(a * (1.f / D_MODEL) + EPS);
                    const f32x4 ug0 = acc[ai][0][m][0] * s, ug1 = acc[ai][0][m][1] * s, uv0 = acc[ai][1][m][0] * s, uv1 = acc[ai][1][m][1] * s;
                    const u32x4 wg = pack8f(ug0, ug1), wv = pack8f(uv0, uv1); const int cg = u.pn * 128 + cw, cv = D_FF + cg;
                    *(u32x4*)(U + (size_t)row * FF2 + cg) = wg; *(u32x4*)(U + (size_t)row * FF2 + cv) = wv;
                    if ((row & 255) >= 254 && row < MP - 2) { bf16_t* hp = (bf16_t*)(ws + WS_HALO) + ((size_t)((row >> 8) + 1) * 2 + (row & 1)) * FF2; *(u32x4*)(hp + cg) = wg; *(u32x4*)(hp + cv) = wv; }
                    if (row < MT) { const int tpos = row < MP ? (row & (SEQ - 1)) - (SEQ - 2) : ((row - MP) & (DEC_SEQ - 1)) - (DEC_SEQ - 2);
                        if (tpos >= 0) { float* cp = row < MP ? out + O_CONVP + ((size_t)(row >> 13) * 2 + tpos) * FF2 : out + O_CONVS + ((size_t)((row - MP) >> 4) * 2 + tpos) * FF2;
                            *(f32x4*)(cp + cg) = ug0; *(f32x4*)(cp + cg + 4) = ug1; *(f32x4*)(cp + cv) = uv0; *(f32x4*)(cp + cv + 4) = uv1; } }
                    if (m & 1) asm volatile("" ::: "memory"); }
        } else {
#pragma unroll
            for (int ai = 0; ai < 2; ++ai)
#pragma unroll
                for (int m = 0; m < 4; ++m) { const int row = rb + ai * 128 + m * 16; if (row >= MT) continue;
#pragma unroll
                    for (int bj = 0; bj < 2; ++bj) { float* p = out + (size_t)row * D_MODEL + u.pn * 256 + bj * 128 + cw;
                        const f32x4 x0 = *(const f32x4*)p, x1 = *(const f32x4*)(p + 4);
                        *(f32x4*)p = x0 + acc[ai][bj][m][0]; *(f32x4*)(p + 4) = x1 + acc[ai][bj][m][1]; }
                    asm volatile("" ::: "memory"); }
        }
    }
};
__device__ __forceinline__ void p5_gemm(Frame& F, int phase) {
    SchedP5 S{F.x, F.j, F.vcu, (const char*)F.ws, phase};
    EpiP5 E{F.ws, F.out, FIN(0), FIN(1), F.vcu};
    pg::gemm_stream(F.lds, S, E);
}

namespace rt {
typedef short s16x4 __attribute__((ext_vector_type(4)));
constexpr int QST = 136, KDST = 144, VST = 272, PST = 72;
constexpr int Q_OFF = 0, QS_OFF = 17408, K_OFF = 34816, KD_OFF = 52224, V_OFF = 70656, P_OFF = 105472, ST_OFF = 114688;
constexpr int SC_TOK = 256, NSC = SEQ / SC_TOK;
__device__ __forceinline__ s16x4 trrd(const LAS bf16_t* p) { return __builtin_bit_cast(s16x4, __builtin_amdgcn_ds_read_tr16_b64_v4i16((LAS s16x4*)p)); }
__device__ __forceinline__ bf16x8 cat8(s16x4 lo, s16x4 hi) { return (bf16x8){lo[0], lo[1], lo[2], lo[3], hi[0], hi[1], hi[2], hi[3]}; }
__device__ __forceinline__ u32x4 scale8(u32x4 w, float s) {
    u32x4 o;
    o.x = cvt_pk_bf16(__uint_as_float(w.x << 16) * s, __uint_as_float(w.x & 0xffff0000u) * s); o.y = cvt_pk_bf16(__uint_as_float(w.y << 16) * s, __uint_as_float(w.y & 0xffff0000u) * s);
    o.z = cvt_pk_bf16(__uint_as_float(w.z << 16) * s, __uint_as_float(w.z & 0xffff0000u) * s); o.w = cvt_pk_bf16(__uint_as_float(w.w << 16) * s, __uint_as_float(w.w & 0xffff0000u) * s);
    return o;
}
template <bool FULL>
__device__ __forceinline__ void ret_unit(Frame& F, int h, int row0, int nch, int L, const float* Sin, float* Sout, const float* g_ret) {
    LAS unsigned char* lds = F.lds;
    const int tid = F.tid, w = F.wave, l = F.lane, fr = l & 15, g = l >> 4, tq = fr >> 2, tp = fr & 3;
    const float lg2 = log2f(1.f - exp2f(-5.f - (float)h));
    const bf16_t* RQ = (const bf16_t*)(F.ws + WS_RQ); const bf16_t* RK = (const bf16_t*)(F.ws + WS_RK); const bf16_t* RV = (const bf16_t*)(F.ws + WS_RV);
    const bf16_t* RG = (const bf16_t*)(F.ws + WS_RG); bf16_t* RET = (bf16_t*)(F.ws + WS_RET);
    LAS bf16_t* q_l = (LAS bf16_t*)(lds + Q_OFF); LAS bf16_t* qs_l = (LAS bf16_t*)(lds + QS_OFF); LAS bf16_t* k_l = (LAS bf16_t*)(lds + K_OFF);
    LAS bf16_t* kd_l = (LAS bf16_t*)(lds + KD_OFF); LAS bf16_t* v_l = (LAS bf16_t*)(lds + V_OFF); LAS bf16_t* p_l = (LAS bf16_t*)(lds + P_OFF); LAS float* st_l = (LAS float*)(lds + ST_OFF);
    f32x4 S[8][2];
#pragma unroll
    for (int db = 0; db < 8; ++db)
#pragma unroll
        for (int nb = 0; nb < 2; ++nb) {
            if (Sin) {
#pragma unroll
                for (int r = 0; r < 4; ++r) S[db][nb][r] = Sin[(size_t)(16 * db + 4 * g + r) * RET_DV + 32 * w + 16 * nb + fr]; }
            else S[db][nb] = (f32x4){0.f, 0.f, 0.f, 0.f}; }
    const float gL = exp2f(lg2 * (float)L);
    for (int c = 0; c < nch; ++c) {
        const size_t r0 = (size_t)row0 + (size_t)c * L;
        __syncthreads();
#pragma unroll
        for (int it = 0; it < 2; ++it) { const int idx = tid + 512 * it, tok = idx >> 4, c8 = idx & 15; const bool ok = tok < L;
            u32x4 kk = {0u, 0u, 0u, 0u}, qq = {0u, 0u, 0u, 0u};
            if (ok) { kk = *(const u32x4*)(RK + (r0 + tok) * 512 + h * 128 + c8 * 8); if (FULL) qq = *(const u32x4*)(RQ + (r0 + tok) * 512 + h * 128 + c8 * 8); }
            *(LAS u32x4*)(kd_l + tok * KDST + c8 * 8) = scale8(kk, exp2f(lg2 * (float)(L - 1 - tok)));
            if (FULL) { *(LAS u32x4*)(k_l + tok * QST + c8 * 8) = kk; *(LAS u32x4*)(q_l + tok * QST + c8 * 8) = qq; *(LAS u32x4*)(qs_l + tok * QST + c8 * 8) = scale8(qq, exp2f(lg2 * (float)(tok + 1))); } }
#pragma unroll
        for (int it = 0; it < 4; ++it) { const int idx = tid + 512 * it, tok = idx >> 5, c8 = idx & 31; u32x4 vv = {0u, 0u, 0u, 0u};
            if (tok < L) vv = *(const u32x4*)(RV + (r0 + tok) * 1024 + h * 256 + c8 * 8);
            *(LAS u32x4*)(v_l + tok * VST + c8 * 8) = vv; }
        __syncthreads();
        f32x4 o[4][2];
        if (FULL) {
            const int ib = w >> 1, jb0 = 2 * (w & 1);
            f32x4 p0 = {0.f, 0.f, 0.f, 0.f}, p1 = {0.f, 0.f, 0.f, 0.f};
#pragma unroll
            for (int s = 0; s < 4; ++s) { const bf16x8 a = *(const LAS bf16x8*)(q_l + (16 * ib + fr) * QST + 32 * s + 8 * g);
                const bf16x8 b0 = *(const LAS bf16x8*)(k_l + (16 * jb0 + fr) * QST + 32 * s + 8 * g), b1 = *(const LAS bf16x8*)(k_l + (16 * jb0 + 16 + fr) * QST + 32 * s + 8 * g);
                p0 = __builtin_amdgcn_mfma_f32_16x16x32_bf16(a, b0, p0, 0, 0, 0); p1 = __builtin_amdgcn_mfma_f32_16x16x32_bf16(a, b1, p1, 0, 0, 0); }
#pragma unroll
            for (int r = 0; r < 4; ++r) { const int i = 16 * ib + 4 * g + r, j0 = 16 * jb0 + fr, j1 = j0 + 16;
                const float v0 = j0 <= i ? p0[r] * exp2f(lg2 * (float)(i - j0)) : 0.f, v1 = j1 <= i ? p1[r] * exp2f(lg2 * (float)(i - j1)) : 0.f;
                p_l[i * PST + j0] = f2bf(v0); p_l[i * PST + j1] = f2bf(v1); }
            __syncthreads();
#pragma unroll
            for (int i = 0; i < 4; ++i) { o[i][0] = (f32x4){0.f, 0.f, 0.f, 0.f}; o[i][1] = (f32x4){0.f, 0.f, 0.f, 0.f}; }
        }
        bf16x8 vf[2][2];
#pragma unroll
        for (int s = 0; s < 2; ++s)
#pragma unroll
            for (int nb = 0; nb < 2; ++nb) { const LAS bf16_t* p = v_l + (32 * s + 8 * g + tq) * VST + 32 * w + 16 * nb + 4 * tp; vf[s][nb] = cat8(trrd(p), trrd(p + 4 * VST)); }
        if (FULL) {
#pragma unroll
            for (int i = 0; i < 4; ++i)
#pragma unroll
                for (int s = 0; s < 2; ++s) { const bf16x8 a = *(const LAS bf16x8*)(p_l + (16 * i + fr) * PST + 32 * s + 8 * g);
                    o[i][0] = __builtin_amdgcn_mfma_f32_16x16x32_bf16(a, vf[s][0], o[i][0], 0, 0, 0); o[i][1] = __builtin_amdgcn_mfma_f32_16x16x32_bf16(a, vf[s][1], o[i][1], 0, 0, 0); }
#pragma unroll
            for (int s = 0; s < 4; ++s) {
                bf16x8 bS[2];
#pragma unroll
                for (int nb = 0; nb < 2; ++nb) { u32x4 wv; wv.x = cvt_pk_bf16(S[2 * s][nb][0], S[2 * s][nb][1]); wv.y = cvt_pk_bf16(S[2 * s][nb][2], S[2 * s][nb][3]);
                    wv.z = cvt_pk_bf16(S[2 * s + 1][nb][0], S[2 * s + 1][nb][1]); wv.w = cvt_pk_bf16(S[2 * s + 1][nb][2], S[2 * s + 1][nb][3]); bS[nb] = __builtin_bit_cast(bf16x8, wv); }
#pragma unroll
                for (int i = 0; i < 4; ++i) { const LAS bf16_t* qp = qs_l + (16 * i + fr) * QST + 32 * s + 4 * g;
                    const s16x4 lo = *(const LAS s16x4*)qp, hi = *(const LAS s16x4*)(qp + 16); const bf16x8 a = cat8(lo, hi);
                    o[i][0] = __builtin_amdgcn_mfma_f32_16x16x32_bf16(a, bS[0], o[i][0], 0, 0, 0); o[i][1] = __builtin_amdgcn_mfma_f32_16x16x32_bf16(a, bS[1], o[i][1], 0, 0, 0); }
            }
        }
#pragma unroll
        for (int db = 0; db < 8; ++db) { S[db][0] = S[db][0] * gL; S[db][1] = S[db][1] * gL; }
#pragma unroll
        for (int s = 0; s < 2; ++s)
#pragma unroll
            for (int db = 0; db < 8; ++db) { const LAS bf16_t* p = kd_l + (32 * s + 8 * g + tq) * KDST + 16 * db + 4 * tp; const bf16x8 a = cat8(trrd(p), trrd(p + 4 * KDST));
                S[db][0] = __builtin_amdgcn_mfma_f32_16x16x32_bf16(a, vf[s][0], S[db][0], 0, 0, 0); S[db][1] = __builtin_amdgcn_mfma_f32_16x16x32_bf16(a, vf[s][1], S[db][1], 0, 0, 0); }
        if (FULL) {
#pragma unroll
            for (int i = 0; i < 4; ++i)
#pragma unroll
                for (int r = 0; r < 4; ++r) { float sm = o[i][0][r] + o[i][1][r], sq = o[i][0][r] * o[i][0][r] + o[i][1][r] * o[i][1][r];
                    sm += __shfl_xor(sm, 1); sq += __shfl_xor(sq, 1); sm += __shfl_xor(sm, 2); sq += __shfl_xor(sq, 2); sm += __shfl_xor(sm, 4); sq += __shfl_xor(sq, 4); sm += __shfl_xor(sm, 8); sq += __shfl_xor(sq, 8);
                    if (fr == 0) { LAS float* d = st_l + ((16 * i + 4 * g + r) * 8 + w) * 2; d[0] = sm; d[1] = sq; } }
            __syncthreads();
#pragma unroll
            for (int i = 0; i < 4; ++i)
#pragma unroll
                for (int r = 0; r < 4; ++r) { const int tok = 16 * i + 4 * g + r; if (tok >= L) continue;
                    const LAS f32x4* d = (const LAS f32x4*)(st_l + tok * 16); const f32x4 a0 = d[0], a1 = d[1], a2 = d[2], a3 = d[3];
                    const float sm = (a0[0] + a0[2]) + (a1[0] + a1[2]) + (a2[0] + a2[2]) + (a3[0] + a3[2]), sq = (a0[1] + a0[3]) + (a1[1] + a1[3]) + (a2[1] + a2[3]) + (a3[1] + a3[3]);
                    const float mu = sm * (1.f / 256.f), var = fmaxf(sq * (1.f / 256.f) - mu * mu, 0.f), rstd = rsqrtf(var + EPS);
#pragma unroll
                    for (int nb = 0; nb < 2; ++nb) { const int col = h * 256 + 32 * w + 16 * nb + fr; const size_t gi = (r0 + tok) * 1024 + col;
                        RET[gi] = f2bf((o[i][nb][r] - mu) * rstd * g_ret[col] * bf2f(RG[gi])); } }
        }
    }
    if (Sout) {
#pragma unroll
        for (int db = 0; db < 8; ++db)
#pragma unroll
            for (int nb = 0; nb < 2; ++nb)
#pragma unroll
                for (int r = 0; r < 4; ++r) Sout[(size_t)(16 * db + 4 * g + r) * RET_DV + 32 * w + 16 * nb + fr] = S[db][nb][r];
    }
}
}
__device__ __forceinline__ void r1_states(Frame& F) {
    const int bh = F.vcu >> 5, sc = F.vcu & 31, b = bh >> 2, h = bh & 3;
    rt::ret_unit<false>(F, h, b * SEQ + sc * rt::SC_TOK, 4, 64, nullptr, F.out + ((size_t)bh * rt::NSC + sc) * 32768, nullptr);
}
__device__ __forceinline__ void r2_scan(Frame& F) {
    float* U = F.out; const int gt = F.vcu * NTHR + F.tid;
    for (int e = gt; e < 8 * 32768; e += F.G * NTHR) { const int bh = e >> 15, idx = e & 32767, h = bh & 3;
        const float g256 = exp2f(log2f(1.f - exp2f(-5.f - (float)h)) * 256.f);
        float u[32];
#pragma unroll
        for (int sc = 0; sc < 32; ++sc) u[sc] = U[((size_t)bh * 32 + sc) * 32768 + idx];
        float carry = 0.f;
#pragma unroll
        for (int sc = 0; sc < 32; ++sc) { U[((size_t)bh * 32 + sc) * 32768 + idx] = carry; carry = g256 * carry + u[sc]; }
        F.out[O_RETP + (size_t)bh * 32768 + idx] = carry; }
}
__device__ __forceinline__ void r3_outputs(Frame& F) {
    const int bh = F.vcu >> 5, sc = F.vcu & 31, b = bh >> 2, h = bh & 3;
    rt::ret_unit<true>(F, h, b * SEQ + sc * rt::SC_TOK, 4, 64, F.out + ((size_t)bh * rt::NSC + sc) * 32768, nullptr, FIN(16));
    if (F.vcu < DEC_BATCH * RET_H) { const int sb = F.vcu >> 2, sh = F.vcu & 3;
        rt::ret_unit<true>(F, sh, MP + sb * DEC_SEQ, 1, DEC_SEQ, FIN(4) + (size_t)F.vcu * 32768, F.out + O_RETS + (size_t)F.vcu * 32768, FIN(16)); }
}

namespace at {
typedef float f32x16 __attribute__((ext_vector_type(16)));
typedef short s16x4 __attribute__((ext_vector_type(4)));
constexpr int KN_ST = 272, KP_ST = 144;
constexpr int KN_B = 64 * KN_ST, KP_B = 64 * KP_ST, V_B = 16384, BUF_B = KN_B + KP_B + V_B;
constexpr int SCR_OFF = 2 * BUF_B;
constexpr float THR = 8.f;
__device__ __forceinline__ int v_st(int k, int c) { const int kk = (k & ~0xC) | ((k & 4) << 1) | ((k & 8) >> 1); return ((kk >> 3) * 4 + (c >> 5)) * 512 + ((kk & 7) * 32 + (c & 31)) * 2; }
__device__ __forceinline__ int v_rd_base(int lane) { return ((lane & 3) << 3) | (((lane >> 2) & 3) << 6) | (((lane >> 4) & 1) << 5) | (((lane >> 5) & 1) << 8); }
constexpr int v_rd_off(int d0, int ks, int half) { return d0 * 512 + ks * 4096 + half * 2048; }
__device__ __forceinline__ int crow(int r, int hi) { return (r & 3) + 8 * (r >> 2) + 4 * hi; }
#define AT_SBAR() __builtin_amdgcn_sched_barrier(0)

__device__ __forceinline__ void qkt(f32x16& p0, f32x16& p1, const LAS unsigned char* kn, const LAS unsigned char* kp, const bf16x8* qr) {
    p0 = f32x16{}; p1 = f32x16{};
#pragma unroll
    for (int d0 = 0; d0 < 8; ++d0) { const bf16x8 a0 = *(const LAS bf16x8*)(kn + d0 * 32), a1 = *(const LAS bf16x8*)(kn + d0 * 32 + 32 * KN_ST);
        p0 = __builtin_amdgcn_mfma_f32_32x32x16_bf16(a0, qr[d0], p0, 0, 0, 0); p1 = __builtin_amdgcn_mfma_f32_32x32x16_bf16(a1, qr[d0], p1, 0, 0, 0); }
#pragma unroll
    for (int d0 = 0; d0 < 4; ++d0) { const bf16x8 a0 = *(const LAS bf16x8*)(kp + d0 * 32), a1 = *(const LAS bf16x8*)(kp + d0 * 32 + 32 * KP_ST);
        p0 = __builtin_amdgcn_mfma_f32_32x32x16_bf16(a0, qr[8 + d0], p0, 0, 0, 0); p1 = __builtin_amdgcn_mfma_f32_32x32x16_bf16(a1, qr[8 + d0], p1, 0, 0, 0); }
}
__device__ __forceinline__ void pv_tile(f32x16* o, int vb0, bf16x8 pa0, bf16x8 pa1, bf16x8 pa2, bf16x8 pa3) {
#define AT_TRRD(dst, off) asm volatile("ds_read_b64_tr_b16 %0, %1 offset:%2" : "=&v"(dst) : "v"(vb0), "i"(off) : "memory")
#define AT_PV_D0(d0) do { s16x4 l0, l1, l2, l3, h0, h1, h2, h3; constexpr int b_ = v_rd_off(d0, 0, 0);   \
        AT_TRRD(l0, b_); AT_TRRD(h0, b_ + 2048); AT_TRRD(l1, b_ + 4096); AT_TRRD(h1, b_ + 6144); AT_TRRD(l2, b_ + 8192); AT_TRRD(h2, b_ + 10240); AT_TRRD(l3, b_ + 12288); AT_TRRD(h3, b_ + 14336); \
        asm volatile("s_waitcnt lgkmcnt(0)" ::: "memory"); AT_SBAR();   \
        o[d0] = __builtin_amdgcn_mfma_f32_32x32x16_bf16(pa0, (bf16x8){l0[0], l0[1], l0[2], l0[3], h0[0], h0[1], h0[2], h0[3]}, o[d0], 0, 0, 0);   \
        o[d0] = __builtin_amdgcn_mfma_f32_32x32x16_bf16(pa1, (bf16x8){l1[0], l1[1], l1[2], l1[3], h1[0], h1[1], h1[2], h1[3]}, o[d0], 0, 0, 0);   \
        o[d0] = __builtin_amdgcn_mfma_f32_32x32x16_bf16(pa2, (bf16x8){l2[0], l2[1], l2[2], l2[3], h2[0], h2[1], h2[2], h2[3]}, o[d0], 0, 0, 0);   \
        o[d0] = __builtin_amdgcn_mfma_f32_32x32x16_bf16(pa3, (bf16x8){l3[0], l3[1], l3[2], l3[3], h3[0], h3[1], h3[2], h3[3]}, o[d0], 0, 0, 0); } while (0)
    AT_PV_D0(0); AT_PV_D0(1); AT_PV_D0(2); AT_PV_D0(3);
#undef AT_PV_D0
#undef AT_TRRD
}
template <bool PARTIAL>
__device__ __forceinline__ void attn_unit(LAS unsigned char* lds, const bf16_t* Qw, const bf16_t* KN, const bf16_t* KPE, const bf16_t* V, bf16_t* Ow, float* Pw, int NT, int tmax_w, int nkeys, int orows, int t0, int tstride) {
    const int tid = threadIdx.x, wid = __builtin_amdgcn_readfirstlane(tid >> 6), lane = tid & 63, r32 = lane & 31, hi = lane >> 5;
    bf16x8 qr[12];
#pragma unroll
    for (int d0 = 0; d0 < 12; ++d0) qr[d0] = *(const bf16x8*)(Qw + (size_t)r32 * 1536 + d0 * 16 + hi * 8);
    const int sr = tid >> 4, sc = (tid & 15) * 8, pr = tid >> 3, pc = (tid & 7) * 8;
    const int kn_w0 = sr * KN_ST + sc * 2, kn_w1 = (32 + sr) * KN_ST + sc * 2, kp_w = KN_B + pr * KP_ST + pc * 2, v_w0 = KN_B + KP_B + v_st(sr, sc), v_w1 = KN_B + KP_B + v_st(32 + sr, sc);
    const int kn_r = r32 * KN_ST + hi * 16, kp_r = KN_B + r32 * KP_ST + hi * 16;
    const int vb_base = (int)(unsigned)(uintptr_t)(lds + KN_B + KP_B) + v_rd_base(lane);
    LAS float* scr = (LAS float*)(lds + SCR_OFF) + wid * 64;
    float m_reg = -1e30f, l_reg = 0.f; f32x16 o[4] = {};
    u32x4 st_kn0, st_kn1, st_kp, st_v0, st_v1;
#define AT_LOAD(t) do { const size_t k0_ = (size_t)(t0 + (t) * tstride) * 64; const bool v0_ = (int)k0_ + sr < nkeys, v1_ = (int)k0_ + 32 + sr < nkeys, vp_ = (int)k0_ + pr < nkeys; const u32x4 z_ = {0u, 0u, 0u, 0u}; \
        st_kn0 = v0_ ? *(const u32x4*)(KN + (k0_ + sr) * 1024 + sc) : z_; st_kn1 = v1_ ? *(const u32x4*)(KN + (k0_ + 32 + sr) * 1024 + sc) : z_; \
        st_v0 = v0_ ? *(const u32x4*)(V + (k0_ + sr) * 1024 + sc) : z_; st_v1 = v1_ ? *(const u32x4*)(V + (k0_ + 32 + sr) * 1024 + sc) : z_; \
        st_kp = vp_ ? *(const u32x4*)(KPE + (k0_ + pr) * 64 + pc) : z_; } while (0)
#define AT_WRITE(bf) do { LAS unsigned char* b_ = lds + (bf) * BUF_B; *(LAS u32x4*)(b_ + kn_w0) = st_kn0; *(LAS u32x4*)(b_ + kn_w1) = st_kn1; *(LAS u32x4*)(b_ + kp_w) = st_kp; \
        *(LAS u32x4*)(b_ + v_w0) = st_v0; *(LAS u32x4*)(b_ + v_w1) = st_v1; } while (0)
    AT_LOAD(0); AT_WRITE(0);
    __syncthreads();
    for (int t = 0; t < NT; ++t) {
        const int bf = t & 1;
        if (t + 1 < NT) AT_LOAD(t + 1);
        if (t <= tmax_w) {
            f32x16 p0, p1;
            const LAS unsigned char* bb = lds + bf * BUF_B;
            qkt(p0, p1, bb + kn_r, bb + kp_r, qr);
            if ((t0 + t * tstride + 1) * 64 > nkeys) {
                const int kb = (t0 + t * tstride) * 64 + 4 * hi;
#pragma unroll
                for (int r = 0; r < 16; ++r) { const int kv = kb + (r & 3) + 8 * (r >> 2); if (kv >= nkeys) p0[r] = -INFINITY; if (kv + 32 >= nkeys) p1[r] = -INFINITY; } }
            float pmax = p0[0];
#pragma unroll
            for (int r = 1; r < 16; ++r) pmax = fmaxf(pmax, p0[r]);
#pragma unroll
            for (int r = 0; r < 16; ++r) pmax = fmaxf(pmax, p1[r]);
            { auto rr = __builtin_amdgcn_permlane32_swap(__float_as_uint(pmax), __float_as_uint(pmax), false, false); pmax = fmaxf(__uint_as_float(rr[0]), __uint_as_float(rr[1])); }
            float alpha = 1.f; bool resc = false;
            if (!__all(pmax - m_reg <= THR)) { const float mn = fmaxf(m_reg, pmax); alpha = __builtin_amdgcn_exp2f(m_reg - mn); m_reg = mn; resc = true; }
#pragma unroll
            for (int r = 0; r < 16; ++r) { p0[r] = __builtin_amdgcn_exp2f(p0[r] - m_reg); p1[r] = __builtin_amdgcn_exp2f(p1[r] - m_reg); }
            float ps = 0.f;
#pragma unroll
            for (int r = 0; r < 16; ++r) ps += p0[r] + p1[r];
            { auto rr = __builtin_amdgcn_permlane32_swap(__float_as_uint(ps), __float_as_uint(ps), false, false); ps = __uint_as_float(rr[0]) + __uint_as_float(rr[1]); }
            l_reg = l_reg * alpha + ps;
            bf16x8 pa0, pa1, pa2, pa3;
#define AT_PK4(P, B_, OUT) do { unsigned a0 = cvt_pk_bf16(P[B_ + 0], P[B_ + 1]), a1 = cvt_pk_bf16(P[B_ + 2], P[B_ + 3]); unsigned b0 = cvt_pk_bf16(P[B_ + 4], P[B_ + 5]), b1 = cvt_pk_bf16(P[B_ + 6], P[B_ + 7]); \
        auto r0 = __builtin_amdgcn_permlane32_swap(a0, b0, false, false); auto r1 = __builtin_amdgcn_permlane32_swap(a1, b1, false, false); \
        u32x4 w_ = {r0[0], r1[0], r0[1], r1[1]}; OUT = __builtin_bit_cast(bf16x8, w_); } while (0)
            AT_PK4(p0, 0, pa0); AT_PK4(p0, 8, pa1); AT_PK4(p1, 0, pa2); AT_PK4(p1, 8, pa3);
#undef AT_PK4
            if (resc) { if (hi == 0) scr[r32] = alpha; asm volatile("s_waitcnt lgkmcnt(0)" ::: "memory");
#pragma unroll
                for (int d_ = 0; d_ < 4; ++d_)
#pragma unroll
                    for (int r = 0; r < 16; ++r) o[d_][r] *= scr[crow(r, hi)]; }
            AT_SBAR();
            pv_tile(o, vb_base + bf * BUF_B, pa0, pa1, pa2, pa3);
        }
        if (t + 1 < NT) AT_WRITE(bf ^ 1);
        __syncthreads();
    }
    if (PARTIAL) {
        if (wid == 0) {
#pragma unroll
            for (int r = 0; r < 16; ++r) { const int orow = crow(r, hi); if (orow < orows) {
#pragma unroll
                for (int d0 = 0; d0 < 4; ++d0) Pw[orow * 132 + d0 * 32 + r32] = o[d0][r]; } }
            if (hi == 0 && r32 < orows) { Pw[r32 * 132 + 128] = m_reg; Pw[r32 * 132 + 129] = l_reg; } }
        __syncthreads();
        return;
    }
    if (hi == 0) scr[32 + r32] = l_reg; asm volatile("s_waitcnt lgkmcnt(0)" ::: "memory");
#pragma unroll
    for (int r = 0; r < 16; ++r) { const int orow = crow(r, hi); const float rl = __builtin_amdgcn_rcpf(scr[32 + orow]);
#pragma unroll
        for (int d0 = 0; d0 < 4; ++d0) { const float v = o[d0][r] * rl; const float vn = __shfl_xor(v, 1);
            if ((r32 & 1) == 0 && orow < orows) *(unsigned*)(Ow + (size_t)orow * 1024 + d0 * 32 + r32) = cvt_pk_bf16(v, vn); } }
    __syncthreads();
#undef AT_LOAD
#undef AT_WRITE
}
#undef AT_SBAR
}
__device__ __forceinline__ void p3_attn_prompt(Frame& F) {
    const int bh = F.vcu >> 4, s = F.vcu & 15, b = bh >> 3, h = bh & 7;
    const bf16_t* Q = (const bf16_t*)F.out; const bf16_t* KN = (const bf16_t*)(F.ws + WS_KN); const bf16_t* KPE = (const bf16_t*)(F.ws + WS_KPE); const bf16_t* V = (const bf16_t*)(F.ws + WS_V); bf16_t* ATT = (bf16_t*)(F.ws + WS_ATT);
#pragma unroll 1
    for (int it = 0; it < 2; ++it) { const int qb = it == 0 ? s : 31 - s; const size_t row0 = (size_t)b * SEQ + (size_t)qb * 256 + F.wave * 32;
        at::attn_unit<false>(F.lds, Q + row0 * 1536 + h * 192, KN + (size_t)b * SEQ * 1024 + h * 128, KPE + (size_t)b * SEQ * 64, V + (size_t)b * SEQ * 1024 + h * 128,
                      ATT + row0 * 1024 + h * 128, nullptr, 4 * qb + 4, 4 * qb + (F.wave >> 1), 1 << 30, 32, 0, 1); }
}
__device__ __forceinline__ void xn_rows(Frame& F, bf16_t* XN) {
    const int gw = F.vcu * 8 + F.wave, NGW = F.G * 8;
    for (int r = gw; r < MPAD; r += NGW) {
        u32x2* o8 = (u32x2*)(XN + (size_t)r * D_MODEL) + F.lane;
        if (r >= MT) { for (int jj = 0; jj < 4; ++jj) o8[64 * jj] = (u32x2){0u, 0u}; continue; }
        const float* x = r < MP ? FIN(0) + (size_t)r * D_MODEL : FIN(1) + (size_t)(r - MP) * D_MODEL;
        const f32x4* xr = (const f32x4*)x + F.lane; f32x4 v[4]; float s = 0.f;
#pragma unroll
        for (int jj = 0; jj < 4; ++jj) { v[jj] = xr[64 * jj]; s += (v[jj][0] * v[jj][0] + v[jj][1] * v[jj][1]) + (v[jj][2] * v[jj][2] + v[jj][3] * v[jj][3]); }
        const float inv = rsqrtf(fwave_sum(s) * (1.f / D_MODEL) + EPS);
#pragma unroll
        for (int jj = 0; jj < 4; ++jj) { u32x2 w; w.x = cvt_pk_bf16(v[jj][0] * inv, v[jj][1] * inv); w.y = cvt_pk_bf16(v[jj][2] * inv, v[jj][3] * inv); o8[64 * jj] = w; }
    }
}
constexpr size_t WS_PART = WS_ATTS + 512 * KiB;
__device__ __forceinline__ void p3_attn_sample(Frame& F) {
    {   const int bh = F.vcu >> 2, part = F.vcu & 3, b = bh >> 3, h = bh & 7;
        const bf16_t* Q = (const bf16_t*)F.out; const bf16_t* KN = (const bf16_t*)(F.ws + WS_KN); const bf16_t* PES = (const bf16_t*)(F.ws + WS_PES); const bf16_t* V = (const bf16_t*)(F.ws + WS_V);
        const size_t row0 = (size_t)MP + (size_t)b * DEC_SEQ;
        at::attn_unit<true>(F.lds, Q + row0 * 1536 + h * 192, KN + (size_t)b * SKEYS * 1024 + h * 128, PES + (size_t)b * SKEYS * 64, V + (size_t)b * SKEYS * 1024 + h * 128,
                            nullptr, (float*)(F.ws + WS_PART) + (size_t)F.vcu * 16 * 132, part == 0 ? 9 : 8, F.wave == 0 ? 1000 : -1, SKEYS, DEC_SEQ, part, 4); }
    xn_rows(F, (bf16_t*)(F.ws + WS_XN2));
    {   const int gw = F.vcu * 8 + F.wave, NGW = F.G * 8; const bf16_t* KVL = (const bf16_t*)(F.ws + WS_KVL); const float* slotkv = (const float*)(F.ws + WS_SLOTKV);
        for (int r = gw; r < MT; r += NGW) { const float s = slot_rs(slotkv + (size_t)r * 8, 8, 1.f / KV_LORA);
            float* o = r < MP ? F.out + O_LATP + (size_t)r * KV_LORA : F.out + O_LATS + (size_t)(r - MP) * KV_LORA;
            const u32x4 w = *((const u32x4*)(KVL + (size_t)r * KV_LORA) + F.lane);
            f32x4 a = {__uint_as_float(w.x << 16), __uint_as_float(w.x & 0xffff0000u), __uint_as_float(w.y << 16), __uint_as_float(w.y & 0xffff0000u)};
            f32x4 c = {__uint_as_float(w.z << 16), __uint_as_float(w.z & 0xffff0000u), __uint_as_float(w.w << 16), __uint_as_float(w.w & 0xffff0000u)};
            *((f32x4*)o + 2 * F.lane) = a * s; *((f32x4*)o + 2 * F.lane + 1) = c * s; } }
}
__device__ __forceinline__ void attn_sample_combine(Frame& F) {
    if (F.vcu >= DEC_BATCH * HEADS) return;
    const int b = F.vcu >> 3, h = F.vcu & 7; const float* P = (const float*)(F.ws + WS_PART) + (size_t)F.vcu * 4 * 16 * 132; bf16_t* ATTS = (bf16_t*)(F.ws + WS_ATTS);
    for (int e = F.tid; e < 16 * 128; e += NTHR) { const int q = e >> 7, d = e & 127;
        float m[4], M = -1e30f;
#pragma unroll
        for (int p = 0; p < 4; ++p) { m[p] = P[(p * 16 + q) * 132 + 128]; M = fmaxf(M, m[p]); }
        float num = 0.f, den = 0.f;
#pragma unroll
        for (int p = 0; p < 4; ++p) { const float w = exp2f(m[p] - M); num += w * P[(p * 16 + q) * 132 + d]; den += w * P[(p * 16 + q) * 132 + 129]; }
        ATTS[(size_t)(b * DEC_SEQ + q) * 1024 + h * 128 + d] = f2bf(num / den); }
}
__device__ __forceinline__ void unpack8(const u32x4 w, float* f) {
    f[0] = __uint_as_float(w.x << 16); f[1] = __uint_as_float(w.x & 0xffff0000u); f[2] = __uint_as_float(w.y << 16); f[3] = __uint_as_float(w.y & 0xffff0000u);
    f[4] = __uint_as_float(w.z << 16); f[5] = __uint_as_float(w.z & 0xffff0000u); f[6] = __uint_as_float(w.w << 16); f[7] = __uint_as_float(w.w & 0xffff0000u);
}
__device__ __forceinline__ void p8_conv(Frame& F) {
    bf16_t* U = (bf16_t*)(F.ws + WS_U); const bf16_t* HALO = (const bf16_t*)(F.ws + WS_HALO); const float* cw = FIN(21); const float* cb = FIN(22); const float* prev = FIN(5);
    const int seg = F.wave, cgi = F.lane;
    for (int unit = F.vcu; unit < 72 * 6; unit += F.G) { const int ch = unit / 6, strip = unit % 6; const int n = strip * 512 + cgi * 8, nv = n + D_FF; const bool cok = n < D_FF;
        int r0, nr; if (ch < 64) { r0 = ch * 256 + seg * 32; nr = 32; } else { r0 = MP + (ch - 64) * DEC_SEQ; nr = seg == 0 ? DEC_SEQ : 0; }
        if (!cok) nr = 0;
        float wg[3][8], wv[3][8], bg[8], bv[8], g2[8], g1[8], v2[8], v1[8];
#pragma unroll
        for (int e = 0; e < 8; ++e) { g2[e] = 0.f; g1[e] = 0.f; v2[e] = 0.f; v1[e] = 0.f; }
        if (cok) {
#pragma unroll
            for (int k = 0; k < 3; ++k) { const f32x4 a0 = *(const f32x4*)(cw + k * FF2 + n), a1 = *(const f32x4*)(cw + k * FF2 + n + 4), c0 = *(const f32x4*)(cw + k * FF2 + nv), c1 = *(const f32x4*)(cw + k * FF2 + nv + 4);
#pragma unroll
                for (int e = 0; e < 4; ++e) { wg[k][e] = a0[e]; wg[k][4 + e] = a1[e]; wv[k][e] = c0[e]; wv[k][4 + e] = c1[e]; } }
            { const f32x4 a0 = *(const f32x4*)(cb + n), a1 = *(const f32x4*)(cb + n + 4), c0 = *(const f32x4*)(cb + nv), c1 = *(const f32x4*)(cb + nv + 4);
#pragma unroll
              for (int e = 0; e < 4; ++e) { bg[e] = a0[e]; bg[4 + e] = a1[e]; bv[e] = c0[e]; bv[4 + e] = c1[e]; } }
            if (ch < 64) {
                if (seg > 0) { unpack8(*(const u32x4*)(U + (size_t)(r0 - 2) * FF2 + n), g2); unpack8(*(const u32x4*)(U + (size_t)(r0 - 1) * FF2 + n), g1); unpack8(*(const u32x4*)(U + (size_t)(r0 - 2) * FF2 + nv), v2); unpack8(*(const u32x4*)(U + (size_t)(r0 - 1) * FF2 + nv), v1); }
                else if ((ch & 31) != 0) { const bf16_t* hp = HALO + (size_t)ch * 2 * FF2; unpack8(*(const u32x4*)(hp + n), g2); unpack8(*(const u32x4*)(hp + FF2 + n), g1); unpack8(*(const u32x4*)(hp + nv), v2); unpack8(*(const u32x4*)(hp + FF2 + nv), v1); }
            } else if (seg == 0) { const float* pp = prev + (size_t)(ch - 64) * 2 * FF2;
#pragma unroll
                for (int e = 0; e < 8; ++e) { g2[e] = pp[n + e]; g1[e] = pp[FF2 + n + e]; v2[e] = pp[nv + e]; v1[e] = pp[FF2 + nv + e]; } }
        }
        __syncthreads();
#pragma unroll 2
        for (int i = 0; i < nr; ++i) { bf16_t* row = U + (size_t)(r0 + i) * FF2; float g0[8], v0[8], h[8];
            unpack8(*(const u32x4*)(row + n), g0); unpack8(*(const u32x4*)(row + nv), v0);
#pragma unroll
            for (int e = 0; e < 8; ++e) { const float cg = g2[e] * wg[0][e] + g1[e] * wg[1][e] + g0[e] * wg[2][e] + bg[e], cv = v2[e] * wv[0][e] + v1[e] * wv[1][e] + v0[e] * wv[2][e] + bv[e];
                h[e] = cg * __builtin_amdgcn_rcpf(1.f + __expf(-cg)) * cv; g2[e] = g1[e]; g1[e] = g0[e]; v2[e] = v1[e]; v1[e] = v0[e]; }
            u32x4 w; w.x = cvt_pk_bf16(h[0], h[1]); w.y = cvt_pk_bf16(h[2], h[3]); w.z = cvt_pk_bf16(h[4], h[5]); w.w = cvt_pk_bf16(h[6], h[7]);
            *(u32x4*)(row + n) = w; }
        __syncthreads();
    }
}
__global__ void __launch_bounds__(NTHR, 2) mk(const MArgs a) {
    extern __shared__ __attribute__((aligned(16))) unsigned char lds_raw[];
    Frame F;
    F.lds = (LAS unsigned char*)lds_raw;
    F.tid = threadIdx.x; F.lane = F.tid & 63; F.wave = __builtin_amdgcn_readfirstlane(F.tid >> 6);
    F.G = gridDim.x; F.x = blockIdx.x % 8; F.j = blockIdx.x / 8; F.vcu = F.x * (F.G / 8) + F.j;
    F.a = &a; F.out = a.out; F.ws = a.ws;
    volatile LAS unsigned* MISC = (volatile LAS unsigned*)(F.lds + MISC_OFF);
    if (F.tid < 32) MISC[F.tid] = 0u;
    __syncthreads();
    XcdBarrier bar = xcd_barrier_post((unsigned*)(a.ws + WS_CTL) + CW_BAR + a.li * XCD_BAR_WORDS, MISC + 8);
    const int lo = a.ph_lo, hi = a.ph_hi;
#define IN_(k) (lo <= (k) && (k) < hi)
#define SEAM_(k) do { if (IN_(k) && IN_((k) + 1)) xcd_barrier(bar); } while (0)
#ifndef PROBE_LO
#define PROBE_LO -1
#define PROBE_HI -1
#define PROBE_MULT 1
#endif
#define STAMP_(k) do { if (PROBE_LO >= 0 && blockIdx.x == 0 && F.tid == 0) { const unsigned long long t_ = __builtin_amdgcn_s_memrealtime(); if ((k) == PROBE_LO) { MISC[16] = (unsigned)t_; MISC[17] = (unsigned)(t_ >> 32); } if ((k) == PROBE_HI) { MISC[18] = (unsigned)t_; MISC[19] = (unsigned)(t_ >> 32); } } } while (0)
    STAMP_(0); if (IN_(0)) { p0_prologue(F); } SEAM_(0);
    STAMP_(1); if (IN_(1)) { p1_inproj(F); } SEAM_(1);
    STAMP_(2); if (IN_(2)) { r1_states(F); } SEAM_(2);
    STAMP_(3); if (IN_(3)) { r2_scan(F); } SEAM_(3);
    STAMP_(4); if (IN_(4)) { r3_outputs(F); } SEAM_(4);
    STAMP_(5); if (IN_(5)) { p2_qkv(F, 1); } SEAM_(5);
    STAMP_(6); if (IN_(6)) { p3_attn_sample(F); } SEAM_(6);
    STAMP_(7); if (IN_(7)) { attn_sample_combine(F); p2_qkv(F, 0); } SEAM_(7);
    STAMP_(8); if (IN_(8)) { p3_attn_prompt(F); } SEAM_(8);
    STAMP_(9); if (IN_(9)) { p5_gemm(F, 5); } SEAM_(9);
    STAMP_(10); if (IN_(10)) { p5_gemm(F, 6); } SEAM_(10);
    STAMP_(11); if (IN_(11)) { p5_gemm(F, 7); } SEAM_(11);
    STAMP_(12); if (IN_(12)) { p8_conv(F); } SEAM_(12);
    STAMP_(13); if (IN_(13)) { p5_gemm(F, 9); }
    if (PROBE_LO >= 0) { __syncthreads(); STAMP_(14);
        if (blockIdx.x == 0 && F.tid == 0) { const unsigned long long t_end = __builtin_amdgcn_s_memrealtime() + (unsigned long long)PROBE_MULT * ((((unsigned long long)MISC[19] << 32) | MISC[18]) - (((unsigned long long)MISC[17] << 32) | MISC[16]));
            while (__builtin_amdgcn_s_memrealtime() < t_end) __builtin_amdgcn_s_sleep(8); } }
}

extern "C" void kernel_launch(void* const* d_in, const int* in_sizes, int n_in, void* d_out, int out_size, void* d_ws, size_t ws_size, hipStream_t stream) {
    static int ok = 0;
    if (ok == 0) {
        ok = 1;
        if (ws_size < 256 * MiB || n_in != 24) { fprintf(stderr, "kernel_launch: bad ws/n_in: %zu %d\n", ws_size, n_in); ok = -1; }
        int dev = 0, cus = 0; (void)hipGetDevice(&dev); (void)hipDeviceGetAttribute(&cus, hipDeviceAttributeMultiprocessorCount, dev);
        if (cus != 256) { fprintf(stderr, "kernel_launch: built for 256 CUs, got %d\n", cus); ok = -1; }
        if (hipFuncSetAttribute((const void*)mk, hipFuncAttributeMaxDynamicSharedMemorySize, LDS_BYTES) != hipSuccess) { fprintf(stderr, "kernel_launch: hipFuncSetAttribute(mk) failed\n"); ok = -1; }
        (void)hipGetLastError();
    }
    if (ok < 0) return;
    (void)hipMemsetAsync((char*)d_ws + WS_CTL, 0, CTL_BYTES, stream);
    MArgs a{}; for (int i = 0; i < 24; ++i) a.in[i] = (const float*)d_in[i]; a.out = (float*)d_out; a.ws = (unsigned char*)d_ws; a.ph_lo = 0; a.ph_hi = 14; a.li = 0;
    hipLaunchKernelGGL(mk, dim3(256), dim3(NTHR), LDS_BYTES, stream, a);
}
```

```cpp
#include <hip/hip_runtime.h>
#include <stdint.h>
#include <cstdio>

typedef unsigned short bf16_t;
typedef short bf16x8 __attribute__((ext_vector_type(8)));
typedef float f32x4 __attribute__((ext_vector_type(4)));
typedef float f32x2 __attribute__((ext_vector_type(2)));
typedef unsigned u32x4 __attribute__((ext_vector_type(4)));
typedef unsigned u32x2 __attribute__((ext_vector_type(2)));

constexpr int D_MODEL = 1024, BATCH = 2, SEQ = 8192, DEC_BATCH = 8, DEC_SEQ = 16, PAST = 2048;
constexpr int MP = BATCH * SEQ, MS = DEC_BATCH * DEC_SEQ, MT = MP + MS;
constexpr int MPAD = 16640;
constexpr int Q_LORA = 768, KV_LORA = 512, QK_NOPE = 128, QK_ROPE = 64, V_HEAD = 128, HEADS = 8;
constexpr int RET_H = 4, RET_DK = 128, RET_DV = 256;
constexpr int D_FF = 2816, FF2 = 2 * D_FF;
constexpr int IN_W = 6464;
constexpr int SKEYS = PAST + DEC_SEQ;
constexpr int LROWS = DEC_BATCH * SKEYS;
constexpr float EPS = 1e-6f;
constexpr int C_QLAT = 0, C_KVLAT = 768, C_KPE = 1280, C_RQ = 1344, C_RK = 1856, C_RV = 2368, C_RG = 3392, C_GA = 4416, C_GB = 5440;

constexpr size_t O_YP = 0, O_YS = 16777216, O_LATP = 16908288, O_RKP = 25296896, O_RETP = 26345472, O_CONVP = 26607616,
                 O_LATS = 26630144, O_RKS = 26695680, O_RETS = 26703872, O_CONVS = 27752448;

constexpr size_t MiB = 1u << 20, KiB = 1024;
constexpr size_t WS_CTL = 0, CTL_BYTES = 64 * KiB, WS_SQ = 64 * KiB, WS_SKV = 192 * KiB;
constexpr size_t WS_SLOTQ = 1 * MiB, WS_SLOTKV = 2 * MiB, WS_SLOTX1 = 3 * MiB;
constexpr size_t WS_TAB32 = 4 * MiB + 256 * KiB, WS_TAB64 = 6 * MiB + 256 * KiB;
constexpr size_t WS_FWUP = 10 * MiB + 512 * KiB, WS_FWDOWN = 21 * MiB + 512 * KiB, WS_FWIN = 27 * MiB, WS_FWQUP = 40 * MiB, WS_FWKVUP = 43 * MiB,
                 WS_FWOBA = 45 * MiB, WS_FWOBB = 47 * MiB, WS_FWOUT = 49 * MiB;
constexpr size_t WS_XN = 51 * MiB, WS_RET = 51 * MiB;
constexpr size_t WS_LATS = 83 * MiB + 512 * KiB, WS_PES = 99 * MiB + 768 * KiB, WS_ZQ = 102 * MiB, WS_KVL = 126 * MiB + 512 * KiB, WS_KPE = 142 * MiB + 768 * KiB;
constexpr size_t WS_RQ = 145 * MiB, WS_RK = 161 * MiB + 256 * KiB, WS_RV = 177 * MiB + 512 * KiB, WS_RG = 210 * MiB;
constexpr size_t WS_KN = 145 * MiB, WS_V = 177 * MiB + 512 * KiB, WS_ATTS = 242 * MiB + 512 * KiB, WS_XN2 = 210 * MiB, WS_ATT = 102 * MiB;
constexpr size_t WS_T1 = 166 * MiB + 512 * KiB, WS_MERGED = 134 * MiB;
constexpr size_t WS_GAS = 246 * MiB, WS_GBS = 247 * MiB;
constexpr size_t WS_X1B = 223 * MiB + 512 * KiB, WS_U = 27 * MiB, WS_HALO = 206 * MiB;

__device__ __forceinline__ bf16_t f2bf(float f) { unsigned u = __float_as_uint(f); u = (u + 0x7fffu + ((u >> 16) & 1u)) >> 16; return (bf16_t)u; }
__device__ __forceinline__ float bf2f(bf16_t b) { return __uint_as_float(((unsigned)b) << 16); }

#define LAS __attribute__((address_space(3)))
#define GAS __attribute__((address_space(1)))
constexpr int NTHR = 512;
constexpr int RING_BYTES = 131072, EPI_OFF = RING_BYTES, EPI_BYTES = 8192, MISC_OFF = EPI_OFF + EPI_BYTES, LDS_BYTES = 147456;
constexpr int CW_BAR = 1024;

__device__ __forceinline__ unsigned cvt_pk_bf16(float lo, float hi) { unsigned r; asm volatile("v_cvt_pk_bf16_f32 %0, %1, %2" : "=v"(r) : "v"(lo), "v"(hi)); return r; }
__device__ __forceinline__ u32x4 pack8f(const f32x4& a, const f32x4& b) { u32x4 w; w.x = cvt_pk_bf16(a[0], a[1]); w.y = cvt_pk_bf16(a[2], a[3]); w.z = cvt_pk_bf16(b[0], b[1]); w.w = cvt_pk_bf16(b[2], b[3]); return w; }
__device__ __forceinline__ int row_pos(int row) { return row < MP ? (row & (SEQ - 1)) : PAST + ((row - MP) & (DEC_SEQ - 1)); }

#define XB_TMO      128
#define XB_XCNT(j)  (256  + 64 * (j))
#define XB_XSUB(j)  (1280 + 64 * (j))
#define XB_XGEN(j)  (2304 + 64 * (j))
#define XB_TOP      3328
#define XB_TOPGEN   3392
#define XCD_BAR_WORDS 3456
#define XB_SPIN_CAP (1u << 18)
__device__ __forceinline__ unsigned xb_ld(unsigned* p)              { return __hip_atomic_load(p, __ATOMIC_RELAXED, __HIP_MEMORY_SCOPE_AGENT); }
__device__ __forceinline__ unsigned xb_add(unsigned* p, unsigned v) { return __hip_atomic_fetch_add(p, v, __ATOMIC_RELAXED, __HIP_MEMORY_SCOPE_AGENT); }
__device__ __forceinline__ unsigned xb_xcc_id() { return (unsigned)__builtin_amdgcn_s_getreg((3 << 11) | 20) & 0xFu; }
#define XB_SPIN(cond, bar) do { unsigned _sp = 0; while (cond) { __builtin_amdgcn_s_sleep(1); \
    if ((++_sp & 255u) == 0u) { if (xb_ld(&(bar)[XB_TMO])) break; if (_sp > XB_SPIN_CAP) { atomicAdd(&(bar)[XB_TMO], 1u); break; } } } } while (0)
struct XcdBarrier { unsigned* bar; unsigned x; volatile LAS unsigned* st; };
__device__ __forceinline__ XcdBarrier xcd_barrier_post(unsigned* bar, volatile LAS unsigned* st) {
    XcdBarrier b; b.bar = bar; b.x = xb_xcc_id(); b.st = st;
    if (threadIdx.x == 0) (void)xb_add(&bar[XB_XCNT(b.x)], 1u);
    return b;
}
__device__ __forceinline__ void xcd_barrier_complete(unsigned* bar, unsigned x, unsigned& nloc, unsigned& nx) {
    const unsigned G = gridDim.x * gridDim.y * gridDim.z;
    unsigned sum, cnt, mine, sp = 0u;
    for (;;) {
        sum = 0u; cnt = 0u; mine = 0u;
#pragma unroll
        for (unsigned j = 0; j < 16; ++j) { const unsigned c = xb_ld(&bar[XB_XCNT(j)]); sum += c; cnt += (c > 0u) ? 1u : 0u; mine = (j == x) ? c : mine; }
        if (sum == G) break;
        __builtin_amdgcn_s_sleep(1);
        if ((++sp & 255u) == 0u) { if (xb_ld(&bar[XB_TMO])) break; if (sp > XB_SPIN_CAP) { atomicAdd(&bar[XB_TMO], 1u); break; } }
    }
    nloc = mine > 0u ? mine : 1u; nx = cnt > 0u ? cnt : 1u;
}
__device__ __forceinline__ void xcd_barrier(const XcdBarrier& b) {
    asm volatile("s_waitcnt vmcnt(0)" ::: "memory");
    __syncthreads();
    if (threadIdx.x == 0) {
        unsigned* bar = b.bar;
        __builtin_amdgcn_s_waitcnt(0);
        unsigned nloc = b.st[0], nx = b.st[1];
        if (nloc == 0u) { xcd_barrier_complete(bar, b.x, nloc, nx); b.st[0] = nloc; b.st[1] = nx; }
        const unsigned old = xb_add(&bar[XB_XSUB(b.x)], 1u);
        const unsigned gen = old / nloc;
        if (old + 1u == (gen + 1u) * nloc) {
            __builtin_amdgcn_fence(__ATOMIC_RELEASE, "agent");
            asm volatile("s_waitcnt vmcnt(0)" ::: "memory");
            const unsigned og = xb_add(&bar[XB_TOP], 1u);
            const unsigned tg = og / nx;
            if (og + 1u == (tg + 1u) * nx) xb_add(&bar[XB_TOPGEN], 1u);
            else XB_SPIN(xb_ld(&bar[XB_TOPGEN]) == tg, bar);
            __builtin_amdgcn_fence(__ATOMIC_ACQUIRE, "agent");
            xb_add(&bar[XB_XGEN(b.x)], 1u);
            asm volatile("s_waitcnt vmcnt(0)" ::: "memory");
        } else {
            XB_SPIN(xb_ld(&bar[XB_XGEN(b.x)]) == gen, bar);
            __builtin_amdgcn_fence(__ATOMIC_ACQUIRE, "agent");
            asm volatile("s_waitcnt vmcnt(0)" ::: "memory");
        }
    }
    __syncthreads();
}

namespace pg {
constexpr int BK = 64, HALF = 128, HTB = HALF * BK * 2;
__host__ __device__ __forceinline__ int lds_byte(int r, int c) { const int st = (r >> 4) * 2 + (c >> 5), rr = r & 15, cc = c & 31, ob = rr * 64 + cc * 2; return st * 1024 + (ob ^ (((ob >> 9) & 1) << 5)); }
__host__ __device__ __forceinline__ void stage_rc(int b, int& R, int& C) { const int st = b / 1024, sb = b % 1024, swz = sb ^ (((sb >> 9) & 1) << 5); R = (st >> 1) * 16 + swz / 64; C = (st & 1) * 32 + (swz % 64) / 2; }
__host__ __device__ __forceinline__ int perm32(int rho) { const int n = rho >> 4, i = rho & 15; return 8 * (i >> 2) + 4 * n + (i & 3); }
struct UnitG { const char* A; const char* B; unsigned lda, ldb; int nt; int pm, pn, kind; int half; };
typedef f32x4 Acc[2][2][4][2];

template <class Sched, class Epi>
__device__ __forceinline__ void gemm_stream(LAS unsigned char* lds, const Sched& S, const Epi& E) {
    const int tid = threadIdx.x, wid = __builtin_amdgcn_readfirstlane(tid >> 6), lane = tid & 63, wr = wid >> 2, wc = wid & 3, fr = lane & 15, fq = lane >> 4;
    unsigned Rr[2], Cc[2];
#pragma unroll
    for (int i = 0; i < 2; ++i) { int R, C; stage_rc(tid * 16 + i * 8192, R, C); Rr[i] = (unsigned)R; Cc[i] = (unsigned)C * 2u; }
    const unsigned ldsw = (unsigned)wid * 1024u;
    const int aoff = lds_byte(wr * 64 + fr, fq * 8), boff = lds_byte(wc * 32 + fr, fq * 8);
#define PG_SA(b, h) (((b) * 2 + (h)) * HTB)
#define PG_SB(b, h) ((4 + (b) * 2 + (h)) * HTB)
#define PG_STAGE(bufoff, gbase, ld) do { _Pragma("unroll") for (int _i = 0; _i < 2; ++_i) \
        __builtin_amdgcn_global_load_lds((const unsigned*)((const char*)(gbase) + (size_t)(Rr[_i] * (ld) + Cc[_i])), (LAS unsigned*)(lds + (bufoff) + ldsw + _i * 8192), 16, 0, 0); } while (0)
#define PG_LDA(dst, b, h) do { _Pragma("unroll") for (int m = 0; m < 4; ++m) _Pragma("unroll") for (int k = 0; k < 2; ++k) dst[m][k] = *(const LAS bf16x8*)(lds + PG_SA(b, h) + aoff + m * 2048 + k * 1024); } while (0)
#define PG_LDB(dst, b, h) do { _Pragma("unroll") for (int n = 0; n < 2; ++n) _Pragma("unroll") for (int k = 0; k < 2; ++k) dst[n][k] = *(const LAS bf16x8*)(lds + PG_SB(b, h) + boff + n * 2048 + k * 1024); } while (0)
#define PG_MMA(ai, bj, At, Bt) do { __builtin_amdgcn_s_setprio(1); _Pragma("unroll") for (int m = 0; m < 4; ++m) _Pragma("unroll") for (int n = 0; n < 2; ++n) _Pragma("unroll") for (int k = 0; k < 2; ++k) \
        acc[ai][bj][m][n] = __builtin_amdgcn_mfma_f32_16x16x32_bf16(Bt[n][k], At[m][k], acc[ai][bj][m][n], 0, 0, 0); __builtin_amdgcn_s_setprio(0); } while (0)
#define PG_WAIT_V(n) asm volatile("s_waitcnt vmcnt(" #n ")" ::: "memory")
#define PG_WAIT_L(n) asm volatile("s_waitcnt lgkmcnt(" #n ")" ::: "memory")
#define PG_BAR __builtin_amdgcn_s_barrier()
#define PG_SCHED __builtin_amdgcn_sched_barrier(0)
    UnitG cur, nxt; int ui = 0;
    if (!S.next(0, cur)) return;
    Acc acc;
#pragma unroll
    for (int a = 0; a < 2; ++a)
#pragma unroll
        for (int b = 0; b < 2; ++b)
#pragma unroll
            for (int m = 0; m < 4; ++m)
#pragma unroll
                for (int n = 0; n < 2; ++n) acc[a][b][m][n] = (f32x4){0.f, 0.f, 0.f, 0.f};
    bf16x8 At[4][2], B0[2][2], B1[2][2];
    const char* cA = cur.A; const char* cB = cur.B; unsigned clda = cur.lda, cldb = cur.ldb;
    PG_STAGE(PG_SB(0, 0), cB, cldb); PG_STAGE(PG_SB(0, 1), cB + (size_t)HALF * cldb, cldb); PG_STAGE(PG_SA(0, 0), cA, clda); PG_STAGE(PG_SA(0, 1), cA + (size_t)HALF * clda, clda);
    if (wr == 1) PG_BAR;
    PG_WAIT_V(2); PG_BAR;
    PG_STAGE(PG_SB(1, 0), cB + 128, cldb); PG_STAGE(PG_SA(1, 0), cA + 128, clda); PG_STAGE(PG_SB(1, 1), cB + (size_t)HALF * cldb + 128, cldb);
    PG_WAIT_V(6); PG_BAR;
    for (;;) {
        const bool has_next = S.next(ui + 1, nxt);
        const char* nA = has_next ? nxt.A : cA; const char* nB = has_next ? nxt.B : cB;
        const unsigned nlda = has_next ? nxt.lda : clda, nldb = has_next ? nxt.ldb : cldb;
        const int nt = cur.nt; const bool chalf = cur.half != 0;
        for (int t = 0; t < nt; t += 2) {
            const bool last = (t == nt - 2);
            const char* a1 = cA + (size_t)(t + 1) * 128;
            const char* a2 = last ? nA : cA + (size_t)(t + 2) * 128; const char* b2 = last ? nB : cB + (size_t)(t + 2) * 128;
            const unsigned lda2 = last ? nlda : clda, ldb2 = last ? nldb : cldb;
            const char* a3 = a2 + 128; const char* b3 = b2 + 128;
            PG_LDB(B0, 0, 0); PG_LDB(B1, 0, 1); PG_SCHED; PG_LDA(At, 0, 0); PG_STAGE(PG_SA(1, 1), a1 + (size_t)HALF * clda, clda);
            PG_WAIT_V(8); PG_WAIT_L(0); PG_BAR; PG_MMA(0, 0, At, B0); PG_MMA(0, 1, At, B1); PG_BAR; PG_SCHED;
            PG_LDA(At, 0, 1); PG_STAGE(PG_SB(0, 0), b2, ldb2); PG_STAGE(PG_SB(0, 1), b2 + (size_t)HALF * ldb2, ldb2); PG_STAGE(PG_SA(0, 0), a2, lda2);
            PG_WAIT_V(8); PG_WAIT_L(0); PG_BAR; if (!chalf) { PG_MMA(1, 0, At, B0); PG_MMA(1, 1, At, B1); } PG_BAR; PG_SCHED;
            PG_LDB(B0, 1, 0); PG_LDB(B1, 1, 1); PG_SCHED; PG_LDA(At, 1, 0); PG_STAGE(PG_SA(0, 1), a2 + (size_t)HALF * lda2, lda2);
            PG_WAIT_V(8); PG_WAIT_L(0); PG_BAR; PG_MMA(0, 0, At, B0); PG_MMA(0, 1, At, B1); PG_BAR; PG_SCHED;
            PG_LDA(At, 1, 1); PG_STAGE(PG_SB(1, 0), b3, ldb2); PG_STAGE(PG_SB(1, 1), b3 + (size_t)HALF * ldb2, ldb2); PG_STAGE(PG_SA(1, 0), a3, lda2);
            PG_WAIT_V(8); PG_WAIT_L(0); PG_BAR; if (!chalf) { PG_MMA(1, 0, At, B0); PG_MMA(1, 1, At, B1); } PG_BAR; PG_SCHED;
        }
        if (wr == 0) PG_BAR;
        E(acc, cur, lds, wr, wc, fr, fq);
        if (!has_next) break;
#pragma unroll
        for (int a = 0; a < 2; ++a)
#pragma unroll
            for (int b = 0; b < 2; ++b)
#pragma unroll
                for (int m = 0; m < 4; ++m)
#pragma unroll
                    for (int n = 0; n < 2; ++n) acc[a][b][m][n] = (f32x4){0.f, 0.f, 0.f, 0.f};
        cur = nxt; cA = nA; cB = nB; clda = nlda; cldb = nldb; ++ui;
        if (wr == 1) PG_BAR;
    }
    PG_WAIT_V(0);
    PG_BAR;
#undef PG_SA
#undef PG_SB
#undef PG_STAGE
#undef PG_LDA
#undef PG_LDB
#undef PG_MMA
#undef PG_WAIT_V
#undef PG_WAIT_L
#undef PG_BAR
#undef PG_SCHED
}
}

struct MArgs { const float* in[24]; float* out; unsigned char* ws; int ph_lo, ph_hi, li, pad; };
struct Frame {
    LAS unsigned char* lds; int tid, lane, wave; int x, j, vcu, G;
    const MArgs* a; float* out; unsigned char* ws;
};
#define FIN(k) (F.a->in[k])
__device__ __forceinline__ float fwave_sum(float v) {
#pragma unroll
    for (int o = 1; o < 64; o <<= 1) v += __shfl_xor(v, o);
    return v;
}

enum { W_IN = 0, W_QUP, W_KVUP, W_OBA, W_OBB, W_OUT, W_UP, W_DOWN };
__device__ __forceinline__ int win_src(int gd) {
    const int tile = gd >> 3, g = gd & 7, bj = g >> 2, wc = g & 3;
    if (tile < 3) return C_QLAT + gd * 32;
    if (tile < 5) return C_KVLAT + (gd - 24) * 32;
    if (tile == 5) return (wc == 0) ? C_KPE + bj * 32 : -1;
    if (tile < 10) { const int base = tile < 8 ? C_RQ : C_RK, tl = tile < 8 ? tile - 6 : tile - 8; const int head = 2 * tl + (wc >> 1); return base + head * 128 + bj * 64 + (wc & 1) * 32; }
    if (tile < 14) return C_RV + (gd - 80) * 32;
    if (tile < 18) return C_RG + (gd - 112) * 32;
    if (tile < 22) return C_GA + (gd - 144) * 32;
    return C_GB + (gd - 176) * 32;
}
__device__ __forceinline__ int w_src_col(int wid, int row) {
    const int rho = row & 31, s = row & 255, wc = (s >> 5) & 3, t = row >> 8;
    const int n = rho >> 4, i = rho & 15; return t * 192 + 128 + 16 * wc + i + 32 * n;
}
__device__ __forceinline__ int w_group_base(int wid, int gd) {
    const int g = gd & 7, bj = g >> 2, wc = g & 3, t = gd >> 3;
    switch (wid) {
    case W_IN: return win_src(gd);
    case W_QUP: return bj == 0 ? t * 192 + 32 * wc : (wc < 2 ? -2 : -1);
    case W_KVUP: return t * 256 + 128 * bj + 32 * wc;
    case W_UP: return (bj ? D_FF : 0) + 128 * t + 32 * wc;
    default: return gd * 32;
    }
}
__device__ __forceinline__ void p0_weight_item(const float* __restrict__ W, int ldw, int K, const float* __restrict__ gain, int wid, bf16_t* __restrict__ Wt, int gd, int kb, LAS float* scr, int lane) {
    const int k0 = kb * 64; const int base = w_group_base(wid, gd);
    bf16_t* dst = Wt + (size_t)(gd * 32) * K + k0;
    const int c = lane & 7;
    if (base == -1) {
#pragma unroll
        for (int jj = 0; jj < 4; ++jj) { const int n = (lane >> 3) + 8 * jj; *(u32x4*)(dst + (size_t)n * K + 8 * c) = (u32x4){0u, 0u, 0u, 0u}; }
        return;
    }
    if (base >= 0) {
#pragma unroll
        for (int i = 0; i < 8; ++i) { const int kk = (lane >> 3) + 8 * i; const float g = gain ? gain[k0 + kk] : 1.f;
            const f32x4 v = *(const f32x4*)(W + (size_t)(k0 + kk) * ldw + base + 4 * c); LAS float* d = scr + kk * 33 + 4 * c; d[0] = v[0] * g; d[1] = v[1] * g; d[2] = v[2] * g; d[3] = v[3] * g; }
    } else {
        const int sc = w_src_col(wid, gd * 32 + (lane & 31));
#pragma unroll 8
        for (int i = 0; i < 32; ++i) { const int kk = 2 * i + (lane >> 5); const float g = gain ? gain[k0 + kk] : 1.f; scr[kk * 33 + (lane & 31)] = W[(size_t)(k0 + kk) * ldw + sc] * g; }
    }
    asm volatile("s_waitcnt lgkmcnt(0)" ::: "memory");
#pragma unroll
    for (int jj = 0; jj < 4; ++jj) { const int n = (lane >> 3) + 8 * jj; const LAS float* s = scr + (8 * c) * 33 + (base >= 0 ? pg::perm32(n) : n);
        u32x4 o; o.x = cvt_pk_bf16(s[0 * 33], s[1 * 33]); o.y = cvt_pk_bf16(s[2 * 33], s[3 * 33]); o.z = cvt_pk_bf16(s[4 * 33], s[5 * 33]); o.w = cvt_pk_bf16(s[6 * 33], s[7 * 33]);
        *(u32x4*)(dst + (size_t)n * K + 8 * c) = o; }
    asm volatile("s_waitcnt lgkmcnt(0)" ::: "memory");
}
__device__ __forceinline__ void p0_weights(Frame& F, LAS float* scr, int gw, int NGW, const float* W, int ldw, int K, const float* gain, int wid, size_t off, int ngroups) {
    const int nkb = K / 64; bf16_t* Wt = (bf16_t*)(F.ws + off);
    for (int it = gw; it < ngroups * nkb; it += NGW) { const int gd = it / nkb, kb = it % nkb; p0_weight_item(W, ldw, K, gain, wid, Wt, gd, kb, scr, F.lane); }
}
__device__ __forceinline__ float2 rope_cs(int pos, double f) {
    const double a = (double)pos * f; const double n = rint(a * 0.15915494309189535); const double r = fma(-n, 6.283185307179586, a) - n * 2.4492935982947064e-16;
    const float rf = (float)r; return make_float2(cosf(rf), sinf(rf));
}
__device__ __forceinline__ void p0_prologue(Frame& F) {
    LAS float* scr = (LAS float*)(F.lds + F.wave * 16384);
    const int gw = F.vcu * 8 + F.wave, NGW = F.G * 8;
    p0_weights(F, scr, gw, NGW, FIN(7), IN_W, 1024, FIN(6), W_IN, WS_FWIN, 26 * 8);
    p0_weights(F, scr, gw, NGW, FIN(9), 1536, 768, FIN(8), W_QUP, WS_FWQUP, 8 * 8);
    p0_weights(F, scr, gw, NGW, FIN(13), 2048, 512, nullptr, W_KVUP, WS_FWKVUP, 8 * 8);
    p0_weights(F, scr, gw, NGW, FIN(17), 1024, 1024, nullptr, W_OBA, WS_FWOBA, 4 * 8);
    p0_weights(F, scr, gw, NGW, FIN(17) + (size_t)1024 * 1024, 1024, 1024, nullptr, W_OBB, WS_FWOBB, 4 * 8);
    p0_weights(F, scr, gw, NGW, FIN(18), 1024, 1024, nullptr, W_OUT, WS_FWOUT, 4 * 8);
    p0_weights(F, scr, gw, NGW, FIN(20), FF2, 1024, FIN(19), W_UP, WS_FWUP, 22 * 8);
    p0_weights(F, scr, gw, NGW, FIN(23), 1024, D_FF, nullptr, W_DOWN, WS_FWDOWN, 4 * 8);
    {   bf16_t* XN = (bf16_t*)(F.ws + WS_XN);
        for (int r = gw; r < MPAD; r += NGW) {
            u32x2* o8 = (u32x2*)(XN + (size_t)r * D_MODEL) + F.lane;
            if (r >= MT) { for (int jj = 0; jj < 4; ++jj) o8[64 * jj] = (u32x2){0u, 0u}; continue; }
            const float* x = r < MP ? FIN(0) + (size_t)r * D_MODEL : FIN(1) + (size_t)(r - MP) * D_MODEL;
            const f32x4* xr = (const f32x4*)x + F.lane; f32x4 v[4]; float s = 0.f;
#pragma unroll
            for (int jj = 0; jj < 4; ++jj) { v[jj] = xr[64 * jj]; s += (v[jj][0] * v[jj][0] + v[jj][1] * v[jj][1]) + (v[jj][2] * v[jj][2] + v[jj][3] * v[jj][3]); }
            const float inv = rsqrtf(fwave_sum(s) * (1.f / D_MODEL) + EPS);
#pragma unroll
            for (int jj = 0; jj < 4; ++jj) { u32x2 w; w.x = cvt_pk_bf16(v[jj][0] * inv, v[jj][1] * inv); w.y = cvt_pk_bf16(v[jj][2] * inv, v[jj][3] * inv); o8[64 * jj] = w; }
        } }
    {   bf16_t* lats = (bf16_t*)(F.ws + WS_LATS); bf16_t* pes = (bf16_t*)(F.ws + WS_PES);
        const int gt = F.vcu * NTHR + F.tid, NG = F.G * NTHR;
        for (int i = gt; i < DEC_BATCH * PAST * (KV_LORA / 4); i += NG) { const int c4 = i % (KV_LORA / 4), rj = i / (KV_LORA / 4), jr = rj % PAST, b = rj / PAST;
            const f32x4 v = *((const f32x4*)FIN(2) + i); u32x2 w; w.x = cvt_pk_bf16(v[0], v[1]); w.y = cvt_pk_bf16(v[2], v[3]);
            *(u32x2*)(lats + ((size_t)b * SKEYS + jr) * KV_LORA + c4 * 4) = w; }
        for (int i = gt; i < DEC_BATCH * PAST * (QK_ROPE / 4); i += NG) { const int c4 = i % (QK_ROPE / 4), rj = i / (QK_ROPE / 4), jr = rj % PAST, b = rj / PAST;
            const f32x4 v = *((const f32x4*)FIN(3) + i); u32x2 w; w.x = cvt_pk_bf16(v[0], v[1]); w.y = cvt_pk_bf16(v[2], v[3]);
            *(u32x2*)(pes + ((size_t)b * SKEYS + jr) * QK_ROPE + c4 * 4) = w; }
        float2* tab32 = (float2*)(F.ws + WS_TAB32); float2* tab64 = (float2*)(F.ws + WS_TAB64);
        {   const int k64 = gt & 63, k32 = gt & 31;
            const double f64 = exp2(-(double)k64 * (13.287712379549449 / 64.0)), f32 = exp2(-(double)k32 * (13.287712379549449 / 32.0));
            for (int i = gt; i < 8192 * 64; i += NG) { tab64[i] = rope_cs(i >> 6, f64); if (i < 8192 * 32) tab32[i] = rope_cs(i >> 5, f32); } } }
}

__device__ __forceinline__ bool reg_unit(int x, int j, int i, int nN, int& pm, int& pn) { const int u = j + 32 * i; if (u >= 8 * nN) return false; pm = 8 * x + (u & 7); pn = u >> 3; return true; }
#define LDS_F(off) ((LAS float*)(lds + EPI_OFF) + (off))

enum { K_QLAT = 0, K_KVLAT, K_KPE, K_RQ, K_RK, K_RV, K_RG, K_GS, K_QUP, K_KVP, K_KVS, K_GA, K_AD, K_GB, K_RD, K_OUT, K_UP, K_DOWN };
struct SchedP1 {
    int x, j; const char* ws;
    __device__ __forceinline__ bool next(int i, pg::UnitG& u) const {
        int pm, pn;
        if (!reg_unit(x, j, i, 18, pm, pn)) { if (i == 4 && j >= 16) { const int k = (j - 16) * 8 + x; if (k >= 26) return false; pm = 64; pn = k; } else return false; }
        u.pm = pm; u.pn = pn; u.A = ws + WS_XN + (size_t)pm * 256 * 2048; u.B = ws + WS_FWIN + (size_t)pn * 256 * 2048; u.lda = 2048; u.ldb = 2048; u.nt = 16; u.half = pm == 64;
        u.kind = pn < 3 ? K_QLAT : pn < 5 ? K_KVLAT : pn == 5 ? K_KPE : pn < 8 ? K_RQ : pn < 10 ? K_RK : pn < 14 ? K_RV : pn < 18 ? K_RG : K_GS;
        return true;
    }
};
struct EpiP1 {
    unsigned char* ws; float* out; const float *g_kvlat, *g_kr;
    __device__ __forceinline__ void operator()(const pg::Acc& acc, const pg::UnitG& u, LAS unsigned char* lds, int wr, int wc, int fr, int fq) const {
        bf16_t* const ZQ = (bf16_t*)(ws + WS_ZQ); bf16_t* const KVL = (bf16_t*)(ws + WS_KVL); bf16_t* const KPE = (bf16_t*)(ws + WS_KPE); bf16_t* const PES = (bf16_t*)(ws + WS_PES); bf16_t* const LATS = (bf16_t*)(ws + WS_LATS);
        bf16_t* const RQ = (bf16_t*)(ws + WS_RQ); bf16_t* const RK = (bf16_t*)(ws + WS_RK); bf16_t* const RV = (bf16_t*)(ws + WS_RV); bf16_t* const RG = (bf16_t*)(ws + WS_RG);
        float* const slotq = (float*)(ws + WS_SLOTQ); float* const slotkv = (float*)(ws + WS_SLOTKV);
        const float2* const tab32 = (const float2*)(ws + WS_TAB32); const float2* const tab64 = (const float2*)(ws + WS_TAB64);
        int rl0 = wr * 64 + fr, cw = wc * 32 + fq * 8; asm volatile("" : "+v"(rl0), "+v"(cw));
        const int kind = u.kind, rb = u.pm * 256 + rl0;
        if (kind == K_QLAT || kind == K_KVLAT) {
            const int t = kind == K_QLAT ? u.pn : u.pn - 3; const int ld = kind == K_QLAT ? Q_LORA : KV_LORA; bf16_t* dst = kind == K_QLAT ? ZQ : KVL;
            f32x4 g[2][2];
#pragma unroll
            for (int bj = 0; bj < 2; ++bj)
#pragma unroll
                for (int n = 0; n < 2; ++n) g[bj][n] = kind == K_KVLAT ? *(const f32x4*)(g_kvlat + t * 256 + bj * 128 + cw + 4 * n) : (f32x4){1.f, 1.f, 1.f, 1.f};
#pragma unroll
            for (int ai = 0; ai < 2; ++ai)
#pragma unroll
                for (int m = 0; m < 4; ++m) { const int row = rb + ai * 128 + m * 16; float ss = 0.f;
                    const bool snew = (kind == K_KVLAT) && row >= MP && row < MT;
                    const int rs = row - MP; bf16_t* lrow = LATS + ((size_t)(rs / DEC_SEQ) * SKEYS + PAST + (rs % DEC_SEQ)) * KV_LORA;
#pragma unroll
                    for (int bj = 0; bj < 2; ++bj) { const f32x4 v0 = acc[ai][bj][m][0], v1 = acc[ai][bj][m][1];
                        ss += (v0[0] * v0[0] + v0[1] * v0[1]) + (v0[2] * v0[2] + v0[3] * v0[3]) + (v1[0] * v1[0] + v1[1] * v1[1]) + (v1[2] * v1[2] + v1[3] * v1[3]);
                        const u32x4 w = pack8f(v0 * g[bj][0], v1 * g[bj][1]);
                        *(u32x4*)(dst + (size_t)row * ld + t * 256 + bj * 128 + cw) = w;
                        if (snew) *(u32x4*)(lrow + t * 256 + bj * 128 + cw) = w; }
                    ss += __shfl_xor(ss, 16); ss += __shfl_xor(ss, 32);
                    if (fq == 0) { if (kind == K_QLAT) slotq[(size_t)row * 12 + t * 4 + wc] = ss; else slotkv[(size_t)row * 8 + t * 4 + wc] = ss; } }
        } else if (kind == K_KPE) {
            if (wc != 0) return;
            const int d0 = fq * 8;
            f32x4 g1[2], g2[2];
#pragma unroll
            for (int n = 0; n < 2; ++n) { g1[n] = *(const f32x4*)(g_kr + d0 + 4 * n); g2[n] = *(const f32x4*)(g_kr + 32 + d0 + 4 * n); }
#pragma unroll
            for (int ai = 0; ai < 2; ++ai)
#pragma unroll
                for (int m = 0; m < 4; ++m) { const int row = rb + ai * 128 + m * 16; const int pos = row_pos(row < MT ? row : 0);
                    f32x4 x1[2], x2[2]; float ss = 0.f;
#pragma unroll
                    for (int n = 0; n < 2; ++n) { x1[n] = acc[ai][0][m][n]; x2[n] = acc[ai][1][m][n];
                        ss += (x1[n][0] * x1[n][0] + x1[n][1] * x1[n][1]) + (x1[n][2] * x1[n][2] + x1[n][3] * x1[n][3]) + (x2[n][0] * x2[n][0] + x2[n][1] * x2[n][1]) + (x2[n][2] * x2[n][2] + x2[n][3] * x2[n][3]); }
                    ss += __shfl_xor(ss, 16); ss += __shfl_xor(ss, 32);
                    const float inv = rsqrtf(ss * (1.f / 64.f) + EPS);
                    f32x4 o1[2], o2[2];
#pragma unroll
                    for (int n = 0; n < 2; ++n) { const f32x4 y1 = x1[n] * inv * g1[n], y2 = x2[n] * inv * g2[n];
                        const f32x4 cs0 = *(const f32x4*)(tab32 + pos * 32 + d0 + 4 * n), cs1 = *(const f32x4*)(tab32 + pos * 32 + d0 + 4 * n + 2);
                        const f32x4 c = {cs0[0], cs0[2], cs1[0], cs1[2]}, s = {cs0[1], cs0[3], cs1[1], cs1[3]};
                        o1[n] = y1 * c - y2 * s; o2[n] = y1 * s + y2 * c; }
                    *(u32x4*)(KPE + (size_t)row * 64 + d0) = pack8f(o1[0], o1[1]); *(u32x4*)(KPE + (size_t)row * 64 + 32 + d0) = pack8f(o2[0], o2[1]);
                    if (row < MT) {
                        float* o = row < MP ? out + O_RKP + (size_t)row * 64 : out + O_RKS + (size_t)(row - MP) * 64;
                        *(f32x4*)(o + d0) = o1[0]; *(f32x4*)(o + d0 + 4) = o1[1]; *(f32x4*)(o + 32 + d0) = o2[0]; *(f32x4*)(o + 32 + d0 + 4) = o2[1];
                        if (row >= MP) { const int rs = row - MP, b = rs / DEC_SEQ, tt = rs % DEC_SEQ; bf16_t* p = PES + ((size_t)b * SKEYS + PAST + tt) * 64;
                            *(u32x4*)(p + d0) = pack8f(o1[0], o1[1]); *(u32x4*)(p + 32 + d0) = pack8f(o2[0], o2[1]); } } }
        } else if (kind == K_RQ || kind == K_RK) {
            const int tl = kind == K_RQ ? u.pn - 6 : u.pn - 8; const int head = 2 * tl + (wc >> 1), i0 = 32 * (wc & 1) + fq * 8;
            bf16_t* dst = kind == K_RQ ? RQ : RK; const float sc = kind == K_RQ ? 1.0f : 0.08838834764831845f;
#pragma unroll
            for (int ai = 0; ai < 2; ++ai)
#pragma unroll
                for (int m = 0; m < 4; ++m) { const int row = rb + ai * 128 + m * 16; const int pos = row_pos(row < MT ? row : 0);
                    f32x4 o1[2], o2[2];
#pragma unroll
                    for (int n = 0; n < 2; ++n) { const f32x4 x1 = acc[ai][0][m][n], x2 = acc[ai][1][m][n];
                        const f32x4 cs0 = *(const f32x4*)(tab64 + pos * 64 + i0 + 4 * n), cs1 = *(const f32x4*)(tab64 + pos * 64 + i0 + 4 * n + 2);
                        const f32x4 c = {cs0[0], cs0[2], cs1[0], cs1[2]}, s = {cs0[1], cs0[3], cs1[1], cs1[3]};
                        o1[n] = (x1 * c - x2 * s) * sc; o2[n] = (x1 * s + x2 * c) * sc; }
                    *(u32x4*)(dst + (size_t)row * 512 + head * 128 + i0) = pack8f(o1[0], o1[1]); *(u32x4*)(dst + (size_t)row * 512 + head * 128 + 64 + i0) = pack8f(o2[0], o2[1]); }
        } else if (kind == K_GS) {
            bf16_t* dst = (bf16_t*)(ws + (u.pn < 22 ? WS_GAS : WS_GBS)); const int t = u.pn < 22 ? u.pn - 18 : u.pn - 22;
#pragma unroll
            for (int m = 0; m < 4; ++m) { const int rl = rl0 + m * 16;
#pragma unroll
                for (int bj = 0; bj < 2; ++bj) { f32x4 v0 = acc[0][bj][m][0], v1 = acc[0][bj][m][1];
#pragma unroll
                    for (int e = 0; e < 4; ++e) { v0[e] = 1.f / (1.f + __expf(-v0[e])); v1[e] = 1.f / (1.f + __expf(-v1[e])); }
                    *(u32x4*)(dst + (size_t)rl * 1024 + t * 256 + bj * 128 + cw) = pack8f(v0, v1); } }
        } else {
            const int t = kind == K_RV ? u.pn - 10 : u.pn - 14; bf16_t* dst = kind == K_RV ? RV : RG;
#pragma unroll
            for (int ai = 0; ai < 2; ++ai)
#pragma unroll
                for (int m = 0; m < 4; ++m) { const int row = rb + ai * 128 + m * 16;
#pragma unroll
                    for (int bj = 0; bj < 2; ++bj) { f32x4 v0 = acc[ai][bj][m][0], v1 = acc[ai][bj][m][1];
                        if (kind == K_RG) {
#pragma unroll
                            for (int e = 0; e < 4; ++e) { v0[e] = v0[e] / (1.f + __expf(-v0[e])); v1[e] = v1[e] / (1.f + __expf(-v1[e])); } }
                        *(u32x4*)(dst + (size_t)row * 1024 + t * 256 + bj * 128 + cw) = pack8f(v0, v1); } }
        }
    }
};
__device__ __forceinline__ void p1_inproj(Frame& F) {
    SchedP1 S{F.x, F.j, (const char*)F.ws};
    EpiP1 E{F.ws, F.out, FIN(12), FIN(15)};
    pg::gemm_stream(F.lds, S, E);
}

__device__ __forceinline__ float slot_rs(const float* slots, int n, float invn) {
    float a = 0.f; for (int i = 0; i < n; i += 4) { const f32x4 v = *(const f32x4*)(slots + i); a += (v[0] + v[1]) + (v[2] + v[3]); } return rsqrtf(a * invn + EPS);
}
struct SchedP2 {
    int x, j; const char* ws; int sample;
    __device__ __forceinline__ bool next(int i, pg::UnitG& u) const {
        int pm, pn, kind;
        if (sample) {
            if (i < 2) { reg_unit(x, j, i, 8, pm, pn); kind = K_QUP; }
            else if (i < 4) { reg_unit(x, j, i - 2, 8, pm, pn); kind = K_KVS; }
            else if (i == 4 && j < 2) { const int k = j * 8 + x; pm = 64; pn = k & 7; kind = k < 8 ? K_QUP : K_KVS; }
            else return false;
        } else { if (i >= 2) return false; reg_unit(x, j, i, 8, pm, pn); kind = K_KVP; }
        u.pm = pm; u.pn = pn; u.kind = kind; u.half = pm == 64;
        if (kind == K_QUP) { u.A = ws + WS_ZQ + (size_t)pm * 256 * 1536; u.lda = 1536; u.B = ws + WS_FWQUP + (size_t)pn * 256 * 1536; u.ldb = 1536; u.nt = 12; }
        else { u.A = ws + (kind == K_KVS ? WS_LATS : WS_KVL) + (size_t)pm * 256 * 1024; u.lda = 1024; u.B = ws + WS_FWKVUP + (size_t)pn * 256 * 1024; u.ldb = 1024; u.nt = 8; }
        return true;
    }
};
struct EpiP2 {
    unsigned char* ws; float* out; const float *g_qn, *g_qr, *g_kn;
    __device__ __forceinline__ void operator()(const pg::Acc& acc, const pg::UnitG& u, LAS unsigned char* lds, int wr, int wc, int fr, int fq) const {
        int rl0 = wr * 64 + fr, cw = wc * 32 + fq * 8; asm volatile("" : "+v"(rl0), "+v"(cw));
        const int kind = u.kind, h = u.pn, rb = u.pm * 256 + rl0;
        const float* const slotq = (const float*)(ws + WS_SLOTQ); const float* const slotkv = (const float*)(ws + WS_SLOTKV);
        float rs[2][4];
#pragma unroll
        for (int ai = 0; ai < 2; ++ai)
#pragma unroll
            for (int m = 0; m < 4; ++m) { const int row = rb + ai * 128 + m * 16;
                if (kind == K_QUP) rs[ai][m] = slot_rs(slotq + (size_t)row * 12, 12, 1.f / Q_LORA);
                else if (kind == K_KVP) rs[ai][m] = slot_rs(slotkv + (size_t)row * 8, 8, 1.f / KV_LORA);
                else { const int b = row / SKEYS, jj = row - b * SKEYS; rs[ai][m] = (row < LROWS && jj >= PAST) ? slot_rs(slotkv + (size_t)(MP + b * DEC_SEQ + jj - PAST) * 8, 8, 1.f / KV_LORA) : 1.f; } }
#pragma unroll
        for (int ai = 0; ai < 2; ++ai)
#pragma unroll
            for (int m = 0; m < 4; ++m) { float p0 = 0.f, p1 = 0.f; const float s2 = rs[ai][m] * rs[ai][m];
#pragma unroll
                for (int n = 0; n < 2; ++n) { const f32x4 a = acc[ai][0][m][n], b = acc[ai][1][m][n];
                    p0 += (a[0] * a[0] + a[1] * a[1]) + (a[2] * a[2] + a[3] * a[3]); p1 += (b[0] * b[0] + b[1] * b[1]) + (b[2] * b[2] + b[3] * b[3]); }
                p0 += __shfl_xor(p0, 16); p0 += __shfl_xor(p0, 32); p1 += __shfl_xor(p1, 16); p1 += __shfl_xor(p1, 32);
                if (fq == 0) { LAS float* d = LDS_F((rl0 + ai * 128 + m * 16) * 8 + wc * 2); d[0] = p0 * s2; d[1] = p1 * s2; } }
        asm volatile("s_waitcnt lgkmcnt(0)" ::: "memory"); __builtin_amdgcn_s_barrier(); asm volatile("" ::: "memory");
        if (kind == K_QUP) {
            bf16_t* const Q = (bf16_t*)out;
            const float2* const tab32 = (const float2*)(ws + WS_TAB32);
            const float C2 = 0.07216878364870323f * 1.4426950408889634f;
            f32x4 gn[2]; gn[0] = *(const f32x4*)(g_qn + cw); gn[1] = *(const f32x4*)(g_qn + cw + 4);
            const int ir = 16 * (wc & 1) + 4 * fq; const f32x4 gr1 = *(const f32x4*)(g_qr + ir), gr2 = *(const f32x4*)(g_qr + 32 + ir);
#pragma unroll
            for (int ai = 0; ai < 2; ++ai)
#pragma unroll
                for (int m = 0; m < 4; ++m) { const int row = rb + ai * 128 + m * 16; const int pos = row_pos(row < MT ? row : 0);
                    const LAS float* d = LDS_F((rl0 + ai * 128 + m * 16) * 8); const f32x4 e0 = *(const LAS f32x4*)d, e1 = *(const LAS f32x4*)(d + 4);
                    const float inn = rsqrtf((e0[0] + e0[2] + e1[0] + e1[2]) * (1.f / 128.f) + EPS) * rs[ai][m] * C2, inr = rsqrtf((e0[1] + e0[3]) * (1.f / 64.f) + EPS) * rs[ai][m];
                    bf16_t* qrow = Q + (size_t)row * 1536 + h * 192;
                    *(u32x4*)(qrow + cw) = pack8f(acc[ai][0][m][0] * inn * gn[0], acc[ai][0][m][1] * inn * gn[1]);
                    if (wc < 2) { const f32x4 y1 = acc[ai][1][m][0] * inr * gr1, y2 = acc[ai][1][m][1] * inr * gr2;
                        const f32x4 cs0 = *(const f32x4*)(tab32 + pos * 32 + ir), cs1 = *(const f32x4*)(tab32 + pos * 32 + ir + 2);
                        const f32x4 c = {cs0[0], cs0[2], cs1[0], cs1[2]}, s = {cs0[1], cs0[3], cs1[1], cs1[3]};
                        const f32x4 o1 = (y1 * c - y2 * s) * C2, o2 = (y1 * s + y2 * c) * C2;
                        u32x2 w1, w2; w1.x = cvt_pk_bf16(o1[0], o1[1]); w1.y = cvt_pk_bf16(o1[2], o1[3]); w2.x = cvt_pk_bf16(o2[0], o2[1]); w2.y = cvt_pk_bf16(o2[2], o2[3]);
                        *(u32x2*)(qrow + 128 + ir) = w1; *(u32x2*)(qrow + 160 + ir) = w2; } }
        } else {
            bf16_t* const KN = (bf16_t*)(ws + WS_KN); bf16_t* const V = (bf16_t*)(ws + WS_V);
            f32x4 gk[2]; gk[0] = *(const f32x4*)(g_kn + cw); gk[1] = *(const f32x4*)(g_kn + cw + 4);
#pragma unroll
            for (int ai = 0; ai < 2; ++ai)
#pragma unroll
                for (int m = 0; m < 4; ++m) { const int row = rb + ai * 128 + m * 16;
                    const LAS float* d = LDS_F((rl0 + ai * 128 + m * 16) * 8); const f32x4 e0 = *(const LAS f32x4*)d, e1 = *(const LAS f32x4*)(d + 4);
                    const float s = rs[ai][m], inn = rsqrtf((e0[0] + e0[2] + e1[0] + e1[2]) * (1.f / 128.f) + EPS) * s;
                    *(u32x4*)(KN + (size_t)row * 1024 + h * 128 + cw) = pack8f(acc[ai][0][m][0] * inn * gk[0], acc[ai][0][m][1] * inn * gk[1]);
                    *(u32x4*)(V + (size_t)row * 1024 + h * 128 + cw) = pack8f(acc[ai][1][m][0] * s, acc[ai][1][m][1] * s); }
        }
    }
};
__device__ __forceinline__ void p2_qkv(Frame& F, int sample) {
    SchedP2 S{F.x, F.j, (const char*)F.ws, sample};
    EpiP2 E{F.ws, F.out, FIN(10), FIN(11), FIN(14)};
    pg::gemm_stream(F.lds, S, E);
}

struct SchedP5 {
    int x, j, vcu; const char* ws; int phase;
    __device__ __forceinline__ const char* arow(size_t base, size_t base_s, int pm, size_t rowbytes) const { return ws + (pm < 64 ? base + (size_t)pm * 256 * rowbytes : base_s); }
    __device__ __forceinline__ bool next(int i, pg::UnitG& u) const {
        int pm, pn;
        if (phase == 5) {
            int sub;
            if (i < 4) { sub = i; pm = 8 * x + (j & 7); pn = j >> 3; } else if (i < 6 && j == 0 && x < 4) { sub = i == 4 ? 1 : 3; pm = 64; pn = x; } else return false;
            u.pm = pm; u.pn = pn; u.kind = K_GA + sub; u.lda = 2048; u.ldb = 2048; u.nt = 16; u.half = pm == 64;
            if (sub == 0) { u.A = ws + WS_XN2 + (size_t)pm * 256 * 2048; u.B = ws + WS_FWIN + (size_t)(18 + pn) * 256 * 2048; }
            else if (sub == 1) { u.A = arow(WS_ATT, WS_ATTS, pm, 2048); u.B = ws + WS_FWOBA + (size_t)pn * 256 * 2048; }
            else if (sub == 2) { u.A = ws + WS_XN2 + (size_t)pm * 256 * 2048; u.B = ws + WS_FWIN + (size_t)(22 + pn) * 256 * 2048; }
            else { u.A = ws + WS_RET + (size_t)pm * 256 * 2048; u.B = ws + WS_FWOBB + (size_t)pn * 256 * 2048; }
            return true;
        }
        if (phase == 6 || phase == 9) {
            if (i == 0) { pm = 8 * x + (j & 7); pn = j >> 3; } else if (i == 1 && j == 0 && x < 4) { pm = 64; pn = x; } else return false;
            u.pm = pm; u.pn = pn; u.half = pm == 64;
            if (phase == 6) { u.kind = K_OUT; u.A = ws + WS_MERGED + (size_t)pm * 256 * 2048; u.lda = 2048; u.B = ws + WS_FWOUT + (size_t)pn * 256 * 2048; u.ldb = 2048; u.nt = 16; }
            else { u.kind = K_DOWN; u.A = ws + WS_U + (size_t)pm * 256 * (FF2 * 2); u.lda = FF2 * 2; u.B = ws + WS_FWDOWN + (size_t)pn * 256 * (D_FF * 2); u.ldb = D_FF * 2; u.nt = 44; }
            return true;
        }
        if (!reg_unit(x, j, i, 22, pm, pn)) { if (i == 5 && j >= 16) { const int k = (j - 16) * 8 + x; if (k >= 22) return false; pm = 64; pn = k; } else return false; }
        u.half = pm == 64; u.pm = pm; u.pn = pn; u.kind = K_UP; u.A = ws + WS_X1B + (size_t)pm * 256 * 2048; u.lda = 2048; u.B = ws + WS_FWUP + (size_t)pn * 256 * 2048; u.ldb = 2048; u.nt = 16;
        return true;
    }
};
struct EpiP5 {
    unsigned char* ws; float* out; const float* xp; const float* xs; int vcu;
    __device__ __forceinline__ void operator()(pg::Acc& acc, const pg::UnitG& u, LAS unsigned char* lds, int wr, int wc, int fr, int fq) const {
        int rl0 = wr * 64 + fr, cw = wc * 32 + fq * 8; asm volatile("" : "+v"(rl0), "+v"(cw));
        const int kind = u.kind, rb = u.pm * 256 + rl0;
        if (kind >= K_GA && kind <= K_RD) {
            bf16_t* const T1 = (bf16_t*)(ws + WS_T1) + (size_t)vcu * 65536; bf16_t* const T2 = (bf16_t*)out + (size_t)vcu * 65536;
            bf16_t* const MG = (bf16_t*)(ws + WS_MERGED);
#pragma unroll
            for (int ai = 0; ai < 2; ++ai)
#pragma unroll
                for (int m = 0; m < 4; ++m)
#pragma unroll
                    for (int bj = 0; bj < 2; ++bj) { const size_t so = (size_t)(rl0 + ai * 128 + m * 16) * 256 + bj * 128 + cw;
                        f32x4 v0 = acc[ai][bj][m][0], v1 = acc[ai][bj][m][1];
                        if (kind == K_GA || kind == K_GB) {
#pragma unroll
                            for (int e = 0; e < 4; ++e) { v0[e] = 1.f / (1.f + __expf(-v0[e])); v1[e] = 1.f / (1.f + __expf(-v1[e])); }
                            *(u32x4*)((kind == K_GA ? T1 : T2) + so) = pack8f(v0, v1);
                        } else if (kind == K_AD) {
                            const u32x4 t = u.pm == 64 ? *(const u32x4*)((const bf16_t*)(ws + WS_GAS) + (size_t)(rl0 + ai * 128 + m * 16) * 1024 + u.pn * 256 + bj * 128 + cw) : *(const u32x4*)(T1 + so);
                            const f32x4 g0 = {__uint_as_float(t.x << 16), __uint_as_float(t.x & 0xffff0000u), __uint_as_float(t.y << 16), __uint_as_float(t.y & 0xffff0000u)};
                            const f32x4 g1 = {__uint_as_float(t.z << 16), __uint_as_float(t.z & 0xffff0000u), __uint_as_float(t.w << 16), __uint_as_float(t.w & 0xffff0000u)};
                            *(u32x4*)(T1 + so) = pack8f(v0 * g0, v1 * g1);
                        } else {
                            const u32x4 t = *(const u32x4*)(T1 + so), q = u.pm == 64 ? *(const u32x4*)((const bf16_t*)(ws + WS_GBS) + (size_t)(rl0 + ai * 128 + m * 16) * 1024 + u.pn * 256 + bj * 128 + cw) : *(const u32x4*)(T2 + so);
                            const f32x4 a0 = {__uint_as_float(t.x << 16), __uint_as_float(t.x & 0xffff0000u), __uint_as_float(t.y << 16), __uint_as_float(t.y & 0xffff0000u)};
                            const f32x4 a1 = {__uint_as_float(t.z << 16), __uint_as_float(t.z & 0xffff0000u), __uint_as_float(t.w << 16), __uint_as_float(t.w & 0xffff0000u)};
                            const f32x4 g0 = {__uint_as_float(q.x << 16), __uint_as_float(q.x & 0xffff0000u), __uint_as_float(q.y << 16), __uint_as_float(q.y & 0xffff0000u)};
                            const f32x4 g1 = {__uint_as_float(q.z << 16), __uint_as_float(q.z & 0xffff0000u), __uint_as_float(q.w << 16), __uint_as_float(q.w & 0xffff0000u)};
                            *(u32x4*)(MG + (size_t)(rb + ai * 128 + m * 16) * 1024 + u.pn * 256 + bj * 128 + cw) = pack8f(a0 + v0 * g0, a1 + v1 * g1);
                        }
                        if (bj == 1 && (m & 1)) asm volatile("" ::: "memory"); }
            if (kind != K_RD) asm volatile("s_waitcnt vmcnt(0)" ::: "memory");
        } else if (kind == K_OUT) {
            float* const slotx = (float*)(ws + WS_SLOTX1); bf16_t* const X1B = (bf16_t*)(ws + WS_X1B);
#pragma unroll
            for (int ai = 0; ai < 2; ++ai)
#pragma unroll
                for (int m = 0; m < 4; ++m) { const int row = rb + ai * 128 + m * 16; float ss = 0.f;
                    const float* xr = row < MP ? xp + (size_t)row * D_MODEL : xs + (size_t)((row < MT ? row : MP) - MP) * D_MODEL;
#pragma unroll
                    for (int bj = 0; bj < 2; ++bj) { const int c = u.pn * 256 + bj * 128 + cw;
                        const f32x4 x0 = *(const f32x4*)(xr + c), x1 = *(const f32x4*)(xr + c + 4);
                        const f32x4 v0 = acc[ai][bj][m][0] + x0, v1 = acc[ai][bj][m][1] + x1;
                        ss += (v0[0] * v0[0] + v0[1] * v0[1]) + (v0[2] * v0[2] + v0[3] * v0[3]) + (v1[0] * v1[0] + v1[1] * v1[1]) + (v1[2] * v1[2] + v1[3] * v1[3]);
                        if (row < MT) { *(f32x4*)(out + (size_t)row * D_MODEL + c) = v0; *(f32x4*)(out + (size_t)row * D_MODEL + c + 4) = v1; }
                        *(u32x4*)(X1B + (size_t)row * D_MODEL + c) = pack8f(v0, v1); }
                    ss += __shfl_xor(ss, 16); ss += __shfl_xor(ss, 32);
                    if (fq == 0) slotx[(size_t)row * 16 + u.pn * 4 + wc] = ss;
                    asm volatile("" ::: "memory"); }
        } else if (kind == K_UP) {
            const float* const slotx = (const float*)(ws + WS_SLOTX1); bf16_t* const U = (bf16_t*)(ws + WS_U);
#pragma unroll
            for (int ai = 0; ai < 2; ++ai)
#pragma unroll
                for (int m = 0; m < 4; ++m) { const int row = rb + ai * 128 + m * 16;
                    float a = 0.f;
#pragma unroll
                    for (int i = 0; i < 16; i += 4) { const f32x4 v = *(const f32x4*)(slotx + (size_t)row * 16 + i); a += (v[0] + v[1]) + (v[2] + v[3]); }
                    const float s = rsqrtf(a * (1.f / D_MODEL) + EPS);
                    const f32x4 ug0 = acc[ai][0][m][0] * s, ug1 = acc[ai][0][m][1] * s, uv0 = acc[ai][1][m][0] * s, uv1 = acc[ai][1][m][1] * s;
                    const u32x4 wg = pack8f(ug0, ug1), wv = pack8f(uv0, uv1); const int cg = u.pn * 128 + cw, cv = D_FF + cg;
                    *(u32x4*)(U + (size_t)row * FF2 + cg) = wg; *(u32x4*)(U + (size_t)row * FF2 + cv) = wv;
                    if ((row & 255) >= 254 && row < MP - 2) { bf16_t* hp = (bf16_t*)(ws + WS_HALO) + ((size_t)((row >> 8) + 1) * 2 + (row & 1)) * FF2; *(u32x4*)(hp + cg) = wg; *(u32x4*)(hp + cv) = wv; }
                    if (row < MT) { const int tpos = row < MP ? (row & (SEQ - 1)) - (SEQ - 2) : ((row - MP) & (DEC_SEQ - 1)) - (DEC_SEQ - 2);
                        if (tpos >= 0) { float* cp = row < MP ? out + O_CONVP + ((size_t)(row >> 13) * 2 + tpos) * FF2 : out + O_CONVS + ((size_t)((row - MP) >> 4) * 2 + tpos) * FF2;
                            *(f32x4*)(cp + cg) = ug0; *(f32x4*)(cp + cg + 4) = ug1; *(f32x4*)(cp + cv) = uv0; *(f32x4*)(cp + cv + 4) = uv1; } }
                    if (m & 1) asm volatile("" ::: "memory"); }
        } else {
#pragma unroll
            for (int ai = 0; ai < 2; ++ai)
#pragma unroll
                for (int m = 0; m < 4; ++m) { const int row = rb + ai * 128 + m * 16; if (row >= MT) continue;
#pragma unroll
                    for (int bj = 0; bj < 2; ++bj) { float* p = out + (size_t)row * D_MODEL + u.pn * 256 + bj * 128 + cw;
                        const f32x4 x0 = *(const f32x4*)p, x1 = *(const f32x4*)(p + 4);
                        *(f32x4*)p = x0 + acc[ai][bj][m][0]; *(f32x4*)(p + 4) = x1 + acc[ai][bj][m][1]; }
                    asm volatile("" ::: "memory"); }
        }
    }
};
__device__ __forceinline__ void p5_gemm(Frame& F, int phase) {
    SchedP5 S{F.x, F.j, F.vcu, (const char*)F.ws, phase};
    EpiP5 E{F.ws, F.out, FIN(0), FIN(1), F.vcu};
    pg::gemm_stream(F.lds, S, E);
}

namespace rt {
typedef short s16x4 __attribute__((ext_vector_type(4)));
constexpr int QST = 136, KDST = 144, VST = 272, PST = 72;
constexpr int Q_OFF = 0, QS_OFF = 17408, K_OFF = 34816, KD_OFF = 52224, V_OFF = 70656, P_OFF = 105472, ST_OFF = 114688;
constexpr int SC_TOK = 256, NSC = SEQ / SC_TOK;
__device__ __forceinline__ s16x4 trrd(const LAS bf16_t* p) { return __builtin_bit_cast(s16x4, __builtin_amdgcn_ds_read_tr16_b64_v4i16((LAS s16x4*)p)); }
__device__ __forceinline__ bf16x8 cat8(s16x4 lo, s16x4 hi) { return (bf16x8){lo[0], lo[1], lo[2], lo[3], hi[0], hi[1], hi[2], hi[3]}; }
__device__ __forceinline__ u32x4 scale8(u32x4 w, float s) {
    u32x4 o;
    o.x = cvt_pk_bf16(__uint_as_float(w.x << 16) * s, __uint_as_float(w.x & 0xffff0000u) * s); o.y = cvt_pk_bf16(__uint_as_float(w.y << 16) * s, __uint_as_float(w.y & 0xffff0000u) * s);
    o.z = cvt_pk_bf16(__uint_as_float(w.z << 16) * s, __uint_as_float(w.z & 0xffff0000u) * s); o.w = cvt_pk_bf16(__uint_as_float(w.w << 16) * s, __uint_as_float(w.w & 0xffff0000u) * s);
    return o;
}
template <bool FULL>
__device__ __forceinline__ void ret_unit(Frame& F, int h, int row0, int nch, int L, const float* Sin, float* Sout, const float* g_ret) {
    LAS unsigned char* lds = F.lds;
    const int tid = F.tid, w = F.wave, l = F.lane, fr = l & 15, g = l >> 4, tq = fr >> 2, tp = fr & 3;
    const float lg2 = log2f(1.f - exp2f(-5.f - (float)h));
    const bf16_t* RQ = (const bf16_t*)(F.ws + WS_RQ); const bf16_t* RK = (const bf16_t*)(F.ws + WS_RK); const bf16_t* RV = (const bf16_t*)(F.ws + WS_RV);
    const bf16_t* RG = (const bf16_t*)(F.ws + WS_RG); bf16_t* RET = (bf16_t*)(F.ws + WS_RET);
    LAS bf16_t* q_l = (LAS bf16_t*)(lds + Q_OFF); LAS bf16_t* qs_l = (LAS bf16_t*)(lds + QS_OFF); LAS bf16_t* k_l = (LAS bf16_t*)(lds + K_OFF);
    LAS bf16_t* kd_l = (LAS bf16_t*)(lds + KD_OFF); LAS bf16_t* v_l = (LAS bf16_t*)(lds + V_OFF); LAS bf16_t* p_l = (LAS bf16_t*)(lds + P_OFF); LAS float* st_l = (LAS float*)(lds + ST_OFF);
    f32x4 S[8][2];
#pragma unroll
    for (int db = 0; db < 8; ++db)
#pragma unroll
        for (int nb = 0; nb < 2; ++nb) {
            if (Sin) {
#pragma unroll
                for (int r = 0; r < 4; ++r) S[db][nb][r] = Sin[(size_t)(16 * db + 4 * g + r) * RET_DV + 32 * w + 16 * nb + fr]; }
            else S[db][nb] = (f32x4){0.f, 0.f, 0.f, 0.f}; }
    const float gL = exp2f(lg2 * (float)L);
    for (int c = 0; c < nch; ++c) {
        const size_t r0 = (size_t)row0 + (size_t)c * L;
        __syncthreads();
#pragma unroll
        for (int it = 0; it < 2; ++it) { const int idx = tid + 512 * it, tok = idx >> 4, c8 = idx & 15; const bool ok = tok < L;
            u32x4 kk = {0u, 0u, 0u, 0u}, qq = {0u, 0u, 0u, 0u};
            if (ok) { kk = *(const u32x4*)(RK + (r0 + tok) * 512 + h * 128 + c8 * 8); if (FULL) qq = *(const u32x4*)(RQ + (r0 + tok) * 512 + h * 128 + c8 * 8); }
            *(LAS u32x4*)(kd_l + tok * KDST + c8 * 8) = scale8(kk, exp2f(lg2 * (float)(L - 1 - tok)));
            if (FULL) { *(LAS u32x4*)(k_l + tok * QST + c8 * 8) = kk; *(LAS u32x4*)(q_l + tok * QST + c8 * 8) = qq; *(LAS u32x4*)(qs_l + tok * QST + c8 * 8) = scale8(qq, exp2f(lg2 * (float)(tok + 1))); } }
#pragma unroll
        for (int it = 0; it < 4; ++it) { const int idx = tid + 512 * it, tok = idx >> 5, c8 = idx & 31; u32x4 vv = {0u, 0u, 0u, 0u};
            if (tok < L) vv = *(const u32x4*)(RV + (r0 + tok) * 1024 + h * 256 + c8 * 8);
            *(LAS u32x4*)(v_l + tok * VST + c8 * 8) = vv; }
        __syncthreads();
        f32x4 o[4][2];
        if (FULL) {
            const int ib = w >> 1, jb0 = 2 * (w & 1);
            f32x4 p0 = {0.f, 0.f, 0.f, 0.f}, p1 = {0.f, 0.f, 0.f, 0.f};
#pragma unroll
            for (int s = 0; s < 4; ++s) { const bf16x8 a = *(const LAS bf16x8*)(q_l + (16 * ib + fr) * QST + 32 * s + 8 * g);
                const bf16x8 b0 = *(const LAS bf16x8*)(k_l + (16 * jb0 + fr) * QST + 32 * s + 8 * g), b1 = *(const LAS bf16x8*)(k_l + (16 * jb0 + 16 + fr) * QST + 32 * s + 8 * g);
                p0 = __builtin_amdgcn_mfma_f32_16x16x32_bf16(a, b0, p0, 0, 0, 0); p1 = __builtin_amdgcn_mfma_f32_16x16x32_bf16(a, b1, p1, 0, 0, 0); }
#pragma unroll
            for (int r = 0; r < 4; ++r) { const int i = 16 * ib + 4 * g + r, j0 = 16 * jb0 + fr, j1 = j0 + 16;
                const float v0 = j0 <= i ? p0[r] * exp2f(lg2 * (float)(i - j0)) : 0.f, v1 = j1 <= i ? p1[r] * exp2f(lg2 * (float)(i - j1)) : 0.f;
                p_l[i * PST + j0] = f2bf(v0); p_l[i * PST + j1] = f2bf(v1); }
            __syncthreads();
#pragma unroll
            for (int i = 0; i < 4; ++i) { o[i][0] = (f32x4){0.f, 0.f, 0.f, 0.f}; o[i][1] = (f32x4){0.f, 0.f, 0.f, 0.f}; }
        }
        bf16x8 vf[2][2];
#pragma unroll
        for (int s = 0; s < 2; ++s)
#pragma unroll
            for (int nb = 0; nb < 2; ++nb) { const LAS bf16_t* p = v_l + (32 * s + 8 * g + tq) * VST + 32 * w + 16 * nb + 4 * tp; vf[s][nb] = cat8(trrd(p), trrd(p + 4 * VST)); }
        if (FULL) {
#pragma unroll
            for (int i = 0; i < 4; ++i)
#pragma unroll
                for (int s = 0; s < 2; ++s) { const bf16x8 a = *(const LAS bf16x8*)(p_l + (16 * i + fr) * PST + 32 * s + 8 * g);
                    o[i][0] = __builtin_amdgcn_mfma_f32_16x16x32_bf16(a, vf[s][0], o[i][0], 0, 0, 0); o[i][1] = __builtin_amdgcn_mfma_f32_16x16x32_bf16(a, vf[s][1], o[i][1], 0, 0, 0); }
#pragma unroll
            for (int s = 0; s < 4; ++s) {
                bf16x8 bS[2];
#pragma unroll
                for (int nb = 0; nb < 2; ++nb) { u32x4 wv; wv.x = cvt_pk_bf16(S[2 * s][nb][0], S[2 * s][nb][1]); wv.y = cvt_pk_bf16(S[2 * s][nb][2], S[2 * s][nb][3]);
                    wv.z = cvt_pk_bf16(S[2 * s + 1][nb][0], S[2 * s + 1][nb][1]); wv.w = cvt_pk_bf16(S[2 * s + 1][nb][2], S[2 * s + 1][nb][3]); bS[nb] = __builtin_bit_cast(bf16x8, wv); }
#pragma unroll
                for (int i = 0; i < 4; ++i) { const LAS bf16_t* qp = qs_l + (16 * i + fr) * QST + 32 * s + 4 * g;
                    const s16x4 lo = *(const LAS s16x4*)qp, hi = *(const LAS s16x4*)(qp + 16); const bf16x8 a = cat8(lo, hi);
                    o[i][0] = __builtin_amdgcn_mfma_f32_16x16x32_bf16(a, bS[0], o[i][0], 0, 0, 0); o[i][1] = __builtin_amdgcn_mfma_f32_16x16x32_bf16(a, bS[1], o[i][1], 0, 0, 0); }
            }
        }
#pragma unroll
        for (int db = 0; db < 8; ++db) { S[db][0] = S[db][0] * gL; S[db][1] = S[db][1] * gL; }
#pragma unroll
        for (int s = 0; s < 2; ++s)
#pragma unroll
            for (int db = 0; db < 8; ++db) { const LAS bf16_t* p = kd_l + (32 * s + 8 * g + tq) * KDST + 16 * db + 4 * tp; const bf16x8 a = cat8(trrd(p), trrd(p + 4 * KDST));
                S[db][0] = __builtin_amdgcn_mfma_f32_16x16x32_bf16(a, vf[s][0], S[db][0], 0, 0, 0); S[db][1] = __builtin_amdgcn_mfma_f32_16x16x32_bf16(a, vf[s][1], S[db][1], 0, 0, 0); }
        if (FULL) {
#pragma unroll
            for (int i = 0; i < 4; ++i)
#pragma unroll
                for (int r = 0; r < 4; ++r) { float sm = o[i][0][r] + o[i][1][r], sq = o[i][0][r] * o[i][0][r] + o[i][1][r] * o[i][1][r];
                    sm += __shfl_xor(sm, 1); sq += __shfl_xor(sq, 1); sm += __shfl_xor(sm, 2); sq += __shfl_xor(sq, 2); sm += __shfl_xor(sm, 4); sq += __shfl_xor(sq, 4); sm += __shfl_xor(sm, 8); sq += __shfl_xor(sq, 8);
                    if (fr == 0) { LAS float* d = st_l + ((16 * i + 4 * g + r) * 8 + w) * 2; d[0] = sm; d[1] = sq; } }
            __syncthreads();
#pragma unroll
            for (int i = 0; i < 4; ++i)
#pragma unroll
                for (int r = 0; r < 4; ++r) { const int tok = 16 * i + 4 * g + r; if (tok >= L) continue;
                    const LAS f32x4* d = (const LAS f32x4*)(st_l + tok * 16); const f32x4 a0 = d[0], a1 = d[1], a2 = d[2], a3 = d[3];
                    const float sm = (a0[0] + a0[2]) + (a1[0] + a1[2]) + (a2[0] + a2[2]) + (a3[0] + a3[2]), sq = (a0[1] + a0[3]) + (a1[1] + a1[3]) + (a2[1] + a2[3]) + (a3[1] + a3[3]);
                    const float mu = sm * (1.f / 256.f), var = fmaxf(sq * (1.f / 256.f) - mu * mu, 0.f), rstd = rsqrtf(var + EPS);
#pragma unroll
                    for (int nb = 0; nb < 2; ++nb) { const int col = h * 256 + 32 * w + 16 * nb + fr; const size_t gi = (r0 + tok) * 1024 + col;
                        RET[gi] = f2bf((o[i][nb][r] - mu) * rstd * g_ret[col] * bf2f(RG[gi])); } }
        }
    }
    if (Sout) {
#pragma unroll
        for (int db = 0; db < 8; ++db)
#pragma unroll
            for (int nb = 0; nb < 2; ++nb)
#pragma unroll
                for (int r = 0; r < 4; ++r) Sout[(size_t)(16 * db + 4 * g + r) * RET_DV + 32 * w + 16 * nb + fr] = S[db][nb][r];
    }
}
}
__device__ __forceinline__ void r1_states(Frame& F) {
    const int bh = F.vcu >> 5, sc = F.vcu & 31, b = bh >> 2, h = bh & 3;
    rt::ret_unit<false>(F, h, b * SEQ + sc * rt::SC_TOK, 4, 64, nullptr, F.out + ((size_t)bh * rt::NSC + sc) * 32768, nullptr);
}
__device__ __forceinline__ void r2_scan(Frame& F) {
    float* U = F.out; const int gt = F.vcu * NTHR + F.tid;
    for (int e = gt; e < 8 * 32768; e += F.G * NTHR) { const int bh = e >> 15, idx = e & 32767, h = bh & 3;
        const float g256 = exp2f(log2f(1.f - exp2f(-5.f - (float)h)) * 256.f);
        float u[32];
#pragma unroll
        for (int sc = 0; sc < 32; ++sc) u[sc] = U[((size_t)bh * 32 + sc) * 32768 + idx];
        float carry = 0.f;
#pragma unroll
        for (int sc = 0; sc < 32; ++sc) { U[((size_t)bh * 32 + sc) * 32768 + idx] = carry; carry = g256 * carry + u[sc]; }
        F.out[O_RETP + (size_t)bh * 32768 + idx] = carry; }
}
__device__ __forceinline__ void r3_outputs(Frame& F) {
    const int bh = F.vcu >> 5, sc = F.vcu & 31, b = bh >> 2, h = bh & 3;
    rt::ret_unit<true>(F, h, b * SEQ + sc * rt::SC_TOK, 4, 64, F.out + ((size_t)bh * rt::NSC + sc) * 32768, nullptr, FIN(16));
    if (F.vcu < DEC_BATCH * RET_H) { const int sb = F.vcu >> 2, sh = F.vcu & 3;
        rt::ret_unit<true>(F, sh, MP + sb * DEC_SEQ, 1, DEC_SEQ, FIN(4) + (size_t)F.vcu * 32768, F.out + O_RETS + (size_t)F.vcu * 32768, FIN(16)); }
}

namespace at {
typedef float f32x16 __attribute__((ext_vector_type(16)));
typedef short s16x4 __attribute__((ext_vector_type(4)));
constexpr int KN_ST = 272, KP_ST = 144;
constexpr int KN_B = 64 * KN_ST, KP_B = 64 * KP_ST, V_B = 16384, BUF_B = KN_B + KP_B + V_B;
constexpr int SCR_OFF = 2 * BUF_B;
constexpr float THR = 8.f;
__device__ __forceinline__ int v_st(int k, int c) { const int kk = (k & ~0xC) | ((k & 4) << 1) | ((k & 8) >> 1); return ((kk >> 3) * 4 + (c >> 5)) * 512 + ((kk & 7) * 32 + (c & 31)) * 2; }
__device__ __forceinline__ int v_rd_base(int lane) { return ((lane & 3) << 3) | (((lane >> 2) & 3) << 6) | (((lane >> 4) & 1) << 5) | (((lane >> 5) & 1) << 8); }
constexpr int v_rd_off(int d0, int ks, int half) { return d0 * 512 + ks * 4096 + half * 2048; }
__device__ __forceinline__ int crow(int r, int hi) { return (r & 3) + 8 * (r >> 2) + 4 * hi; }
#define AT_SBAR() __builtin_amdgcn_sched_barrier(0)

__device__ __forceinline__ void qkt(f32x16& p0, f32x16& p1, const LAS unsigned char* kn, const LAS unsigned char* kp, const bf16x8* qr) {
    p0 = f32x16{}; p1 = f32x16{};
#pragma unroll
    for (int d0 = 0; d0 < 8; ++d0) { const bf16x8 a0 = *(const LAS bf16x8*)(kn + d0 * 32), a1 = *(const LAS bf16x8*)(kn + d0 * 32 + 32 * KN_ST);
        p0 = __builtin_amdgcn_mfma_f32_32x32x16_bf16(a0, qr[d0], p0, 0, 0, 0); p1 = __builtin_amdgcn_mfma_f32_32x32x16_bf16(a1, qr[d0], p1, 0, 0, 0); }
#pragma unroll
    for (int d0 = 0; d0 < 4; ++d0) { const bf16x8 a0 = *(const LAS bf16x8*)(kp + d0 * 32), a1 = *(const LAS bf16x8*)(kp + d0 * 32 + 32 * KP_ST);
        p0 = __builtin_amdgcn_mfma_f32_32x32x16_bf16(a0, qr[8 + d0], p0, 0, 0, 0); p1 = __builtin_amdgcn_mfma_f32_32x32x16_bf16(a1, qr[8 + d0], p1, 0, 0, 0); }
}
__device__ __forceinline__ void pv_tile(f32x16* o, int vb0, bf16x8 pa0, bf16x8 pa1, bf16x8 pa2, bf16x8 pa3) {
#define AT_TRRD(dst, off) asm volatile("ds_read_b64_tr_b16 %0, %1 offset:%2" : "=&v"(dst) : "v"(vb0), "i"(off) : "memory")
#define AT_PV_D0(d0) do { s16x4 l0, l1, l2, l3, h0, h1, h2, h3; constexpr int b_ = v_rd_off(d0, 0, 0);   \
        AT_TRRD(l0, b_); AT_TRRD(h0, b_ + 2048); AT_TRRD(l1, b_ + 4096); AT_TRRD(h1, b_ + 6144); AT_TRRD(l2, b_ + 8192); AT_TRRD(h2, b_ + 10240); AT_TRRD(l3, b_ + 12288); AT_TRRD(h3, b_ + 14336); \
        asm volatile("s_waitcnt lgkmcnt(0)" ::: "memory"); AT_SBAR();   \
        o[d0] = __builtin_amdgcn_mfma_f32_32x32x16_bf16(pa0, (bf16x8){l0[0], l0[1], l0[2], l0[3], h0[0], h0[1], h0[2], h0[3]}, o[d0], 0, 0, 0);   \
        o[d0] = __builtin_amdgcn_mfma_f32_32x32x16_bf16(pa1, (bf16x8){l1[0], l1[1], l1[2], l1[3], h1[0], h1[1], h1[2], h1[3]}, o[d0], 0, 0, 0);   \
        o[d0] = __builtin_amdgcn_mfma_f32_32x32x16_bf16(pa2, (bf16x8){l2[0], l2[1], l2[2], l2[3], h2[0], h2[1], h2[2], h2[3]}, o[d0], 0, 0, 0);   \
        o[d0] = __builtin_amdgcn_mfma_f32_32x32x16_bf16(pa3, (bf16x8){l3[0], l3[1], l3[2], l3[3], h3[0], h3[1], h3[2], h3[3]}, o[d0], 0, 0, 0); } while (0)
    AT_PV_D0(0); AT_PV_D0(1); AT_PV_D0(2); AT_PV_D0(3);
#undef AT_PV_D0
#undef AT_TRRD
}
template <bool PARTIAL>
__device__ __forceinline__ void attn_unit(LAS unsigned char* lds, const bf16_t* Qw, const bf16_t* KN, const bf16_t* KPE, const bf16_t* V, bf16_t* Ow, float* Pw, int NT, int tmax_w, int nkeys, int orows, int t0, int tstride) {
    const int tid = threadIdx.x, wid = __builtin_amdgcn_readfirstlane(tid >> 6), lane = tid & 63, r32 = lane & 31, hi = lane >> 5;
    bf16x8 qr[12];
#pragma unroll
    for (int d0 = 0; d0 < 12; ++d0) qr[d0] = *(const bf16x8*)(Qw + (size_t)r32 * 1536 + d0 * 16 + hi * 8);
    const int sr = tid >> 4, sc = (tid & 15) * 8, pr = tid >> 3, pc = (tid & 7) * 8;
    const int kn_w0 = sr * KN_ST + sc * 2, kn_w1 = (32 + sr) * KN_ST + sc * 2, kp_w = KN_B + pr * KP_ST + pc * 2, v_w0 = KN_B + KP_B + v_st(sr, sc), v_w1 = KN_B + KP_B + v_st(32 + sr, sc);
    const int kn_r = r32 * KN_ST + hi * 16, kp_r = KN_B + r32 * KP_ST + hi * 16;
    const int vb_base = (int)(unsigned)(uintptr_t)(lds + KN_B + KP_B) + v_rd_base(lane);
    LAS float* scr = (LAS float*)(lds + SCR_OFF) + wid * 64;
    float m_reg = -1e30f, l_reg = 0.f; f32x16 o[4] = {};
    u32x4 st_kn0, st_kn1, st_kp, st_v0, st_v1;
#define AT_LOAD(t) do { const size_t k0_ = (size_t)(t0 + (t) * tstride) * 64; const bool v0_ = (int)k0_ + sr < nkeys, v1_ = (int)k0_ + 32 + sr < nkeys, vp_ = (int)k0_ + pr < nkeys; const u32x4 z_ = {0u, 0u, 0u, 0u}; \
        st_kn0 = v0_ ? *(const u32x4*)(KN + (k0_ + sr) * 1024 + sc) : z_; st_kn1 = v1_ ? *(const u32x4*)(KN + (k0_ + 32 + sr) * 1024 + sc) : z_; \
        st_v0 = v0_ ? *(const u32x4*)(V + (k0_ + sr) * 1024 + sc) : z_; st_v1 = v1_ ? *(const u32x4*)(V + (k0_ + 32 + sr) * 1024 + sc) : z_; \
        st_kp = vp_ ? *(const u32x4*)(KPE + (k0_ + pr) * 64 + pc) : z_; } while (0)
#define AT_WRITE(bf) do { LAS unsigned char* b_ = lds + (bf) * BUF_B; *(LAS u32x4*)(b_ + kn_w0) = st_kn0; *(LAS u32x4*)(b_ + kn_w1) = st_kn1; *(LAS u32x4*)(b_ + kp_w) = st_kp; \
        *(LAS u32x4*)(b_ + v_w0) = st_v0; *(LAS u32x4*)(b_ + v_w1) = st_v1; } while (0)
    AT_LOAD(0); AT_WRITE(0);
    __syncthreads();
    for (int t = 0; t < NT; ++t) {
        const int bf = t & 1;
        if (t + 1 < NT) AT_LOAD(t + 1);
        if (t <= tmax_w) {
            f32x16 p0, p1;
            const LAS unsigned char* bb = lds + bf * BUF_B;
            qkt(p0, p1, bb + kn_r, bb + kp_r, qr);
            if ((t0 + t * tstride + 1) * 64 > nkeys) {
                const int kb = (t0 + t * tstride) * 64 + 4 * hi;
#pragma unroll
                for (int r = 0; r < 16; ++r) { const int kv = kb + (r & 3) + 8 * (r >> 2); if (kv >= nkeys) p0[r] = -INFINITY; if (kv + 32 >= nkeys) p1[r] = -INFINITY; } }
            float pmax = p0[0];
#pragma unroll
            for (int r = 1; r < 16; ++r) pmax = fmaxf(pmax, p0[r]);
#pragma unroll
            for (int r = 0; r < 16; ++r) pmax = fmaxf(pmax, p1[r]);
            { auto rr = __builtin_amdgcn_permlane32_swap(__float_as_uint(pmax), __float_as_uint(pmax), false, false); pmax = fmaxf(__uint_as_float(rr[0]), __uint_as_float(rr[1])); }
            float alpha = 1.f; bool resc = false;
            if (!__all(pmax - m_reg <= THR)) { const float mn = fmaxf(m_reg, pmax); alpha = __builtin_amdgcn_exp2f(m_reg - mn); m_reg = mn; resc = true; }
#pragma unroll
            for (int r = 0; r < 16; ++r) { p0[r] = __builtin_amdgcn_exp2f(p0[r] - m_reg); p1[r] = __builtin_amdgcn_exp2f(p1[r] - m_reg); }
            float ps = 0.f;
#pragma unroll
            for (int r = 0; r < 16; ++r) ps += p0[r] + p1[r];
            { auto rr = __builtin_amdgcn_permlane32_swap(__float_as_uint(ps), __float_as_uint(ps), false, false); ps = __uint_as_float(rr[0]) + __uint_as_float(rr[1]); }
            l_reg = l_reg * alpha + ps;
            bf16x8 pa0, pa1, pa2, pa3;
#define AT_PK4(P, B_, OUT) do { unsigned a0 = cvt_pk_bf16(P[B_ + 0], P[B_ + 1]), a1 = cvt_pk_bf16(P[B_ + 2], P[B_ + 3]); unsigned b0 = cvt_pk_bf16(P[B_ + 4], P[B_ + 5]), b1 = cvt_pk_bf16(P[B_ + 6], P[B_ + 7]); \
        auto r0 = __builtin_amdgcn_permlane32_swap(a0, b0, false, false); auto r1 = __builtin_amdgcn_permlane32_swap(a1, b1, false, false); \
        u32x4 w_ = {r0[0], r1[0], r0[1], r1[1]}; OUT = __builtin_bit_cast(bf16x8, w_); } while (0)
            AT_PK4(p0, 0, pa0); AT_PK4(p0, 8, pa1); AT_PK4(p1, 0, pa2); AT_PK4(p1, 8, pa3);
#undef AT_PK4
            if (resc) { if (hi == 0) scr[r32] = alpha; asm volatile("s_waitcnt lgkmcnt(0)" ::: "memory");
#pragma unroll
                for (int d_ = 0; d_ < 4; ++d_)
#pragma unroll
                    for (int r = 0; r < 16; ++r) o[d_][r] *= scr[crow(r, hi)]; }
            AT_SBAR();
            pv_tile(o, vb_base + bf * BUF_B, pa0, pa1, pa2, pa3);
        }
        if (t + 1 < NT) AT_WRITE(bf ^ 1);
        __syncthreads();
    }
    if (PARTIAL) {
        if (wid == 0) {
#pragma unroll
            for (int r = 0; r < 16; ++r) { const int orow = crow(r, hi); if (orow < orows) {
#pragma unroll
                for (int d0 = 0; d0 < 4; ++d0) Pw[orow * 132 + d0 * 32 + r32] = o[d0][r]; } }
            if (hi == 0 && r32 < orows) { Pw[r32 * 132 + 128] = m_reg; Pw[r32 * 132 + 129] = l_reg; } }
        __syncthreads();
        return;
    }
    if (hi == 0) scr[32 + r32] = l_reg; asm volatile("s_waitcnt lgkmcnt(0)" ::: "memory");
#pragma unroll
    for (int r = 0; r < 16; ++r) { const int orow = crow(r, hi); const float rl = __builtin_amdgcn_rcpf(scr[32 + orow]);
#pragma unroll
        for (int d0 = 0; d0 < 4; ++d0) { const float v = o[d0][r] * rl; const float vn = __shfl_xor(v, 1);
            if ((r32 & 1) == 0 && orow < orows) *(unsigned*)(Ow + (size_t)orow * 1024 + d0 * 32 + r32) = cvt_pk_bf16(v, vn); } }
    __syncthreads();
#undef AT_LOAD
#undef AT_WRITE
}
#undef AT_SBAR
}
__device__ __forceinline__ void p3_attn_prompt(Frame& F) {
    const int bh = F.vcu >> 4, s = F.vcu & 15, b = bh >> 3, h = bh & 7;
    const bf16_t* Q = (const bf16_t*)F.out; const bf16_t* KN = (const bf16_t*)(F.ws + WS_KN); const bf16_t* KPE = (const bf16_t*)(F.ws + WS_KPE); const bf16_t* V = (const bf16_t*)(F.ws + WS_V); bf16_t* ATT = (bf16_t*)(F.ws + WS_ATT);
#pragma unroll 1
    for (int it = 0; it < 2; ++it) { const int qb = it == 0 ? s : 31 - s; const size_t row0 = (size_t)b * SEQ + (size_t)qb * 256 + F.wave * 32;
        at::attn_unit<false>(F.lds, Q + row0 * 1536 + h * 192, KN + (size_t)b * SEQ * 1024 + h * 128, KPE + (size_t)b * SEQ * 64, V + (size_t)b * SEQ * 1024 + h * 128,
                      ATT + row0 * 1024 + h * 128, nullptr, 4 * qb + 4, 4 * qb + (F.wave >> 1), 1 << 30, 32, 0, 1); }
}
__device__ __forceinline__ void xn_rows(Frame& F, bf16_t* XN) {
    const int gw = F.vcu * 8 + F.wave, NGW = F.G * 8;
    for (int r = gw; r < MPAD; r += NGW) {
        u32x2* o8 = (u32x2*)(XN + (size_t)r * D_MODEL) + F.lane;
        if (r >= MT) { for (int jj = 0; jj < 4; ++jj) o8[64 * jj] = (u32x2){0u, 0u}; continue; }
        const float* x = r < MP ? FIN(0) + (size_t)r * D_MODEL : FIN(1) + (size_t)(r - MP) * D_MODEL;
        const f32x4* xr = (const f32x4*)x + F.lane; f32x4 v[4]; float s = 0.f;
#pragma unroll
        for (int jj = 0; jj < 4; ++jj) { v[jj] = xr[64 * jj]; s += (v[jj][0] * v[jj][0] + v[jj][1] * v[jj][1]) + (v[jj][2] * v[jj][2] + v[jj][3] * v[jj][3]); }
        const float inv = rsqrtf(fwave_sum(s) * (1.f / D_MODEL) + EPS);
#pragma unroll
        for (int jj = 0; jj < 4; ++jj) { u32x2 w; w.x = cvt_pk_bf16(v[jj][0] * inv, v[jj][1] * inv); w.y = cvt_pk_bf16(v[jj][2] * inv, v[jj][3] * inv); o8[64 * jj] = w; }
    }
}
constexpr size_t WS_PART = WS_ATTS + 512 * KiB;
__device__ __forceinline__ void p3_attn_sample(Frame& F) {
    {   const int bh = F.vcu >> 2, part = F.vcu & 3, b = bh >> 3, h = bh & 7;
        const bf16_t* Q = (const bf16_t*)F.out; const bf16_t* KN = (const bf16_t*)(F.ws + WS_KN); const bf16_t* PES = (const bf16_t*)(F.ws + WS_PES); const bf16_t* V = (const bf16_t*)(F.ws + WS_V);
        const size_t row0 = (size_t)MP + (size_t)b * DEC_SEQ;
        at::attn_unit<true>(F.lds, Q + row0 * 1536 + h * 192, KN + (size_t)b * SKEYS * 1024 + h * 128, PES + (size_t)b * SKEYS * 64, V + (size_t)b * SKEYS * 1024 + h * 128,
                            nullptr, (float*)(F.ws + WS_PART) + (size_t)F.vcu * 16 * 132, part == 0 ? 9 : 8, F.wave == 0 ? 1000 : -1, SKEYS, DEC_SEQ, part, 4); }
    xn_rows(F, (bf16_t*)(F.ws + WS_XN2));
    {   const int gw = F.vcu * 8 + F.wave, NGW = F.G * 8; const bf16_t* KVL = (const bf16_t*)(F.ws + WS_KVL); const float* slotkv = (const float*)(F.ws + WS_SLOTKV);
        for (int r = gw; r < MT; r += NGW) { const float s = slot_rs(slotkv + (size_t)r * 8, 8, 1.f / KV_LORA);
            float* o = r < MP ? F.out + O_LATP + (size_t)r * KV_LORA : F.out + O_LATS + (size_t)(r - MP) * KV_LORA;
            const u32x4 w = *((const u32x4*)(KVL + (size_t)r * KV_LORA) + F.lane);
            f32x4 a = {__uint_as_float(w.x << 16), __uint_as_float(w.x & 0xffff0000u), __uint_as_float(w.y << 16), __uint_as_float(w.y & 0xffff0000u)};
            f32x4 c = {__uint_as_float(w.z << 16), __uint_as_float(w.z & 0xffff0000u), __uint_as_float(w.w << 16), __uint_as_float(w.w & 0xffff0000u)};
            *((f32x4*)o + 2 * F.lane) = a * s; *((f32x4*)o + 2 * F.lane + 1) = c * s; } }
}
__device__ __forceinline__ void attn_sample_combine(Frame& F) {
    if (F.vcu >= DEC_BATCH * HEADS) return;
    const int b = F.vcu >> 3, h = F.vcu & 7; const float* P = (const float*)(F.ws + WS_PART) + (size_t)F.vcu * 4 * 16 * 132; bf16_t* ATTS = (bf16_t*)(F.ws + WS_ATTS);
    for (int e = F.tid; e < 16 * 128; e += NTHR) { const int q = e >> 7, d = e & 127;
        float m[4], M = -1e30f;
#pragma unroll
        for (int p = 0; p < 4; ++p) { m[p] = P[(p * 16 + q) * 132 + 128]; M = fmaxf(M, m[p]); }
        float num = 0.f, den = 0.f;
#pragma unroll
        for (int p = 0; p < 4; ++p) { const float w = exp2f(m[p] - M); num += w * P[(p * 16 + q) * 132 + d]; den += w * P[(p * 16 + q) * 132 + 129]; }
        ATTS[(size_t)(b * DEC_SEQ + q) * 1024 + h * 128 + d] = f2bf(num / den); }
}
__device__ __forceinline__ void unpack8(const u32x4 w, float* f) {
    f[0] = __uint_as_float(w.x << 16); f[1] = __uint_as_float(w.x & 0xffff0000u); f[2] = __uint_as_float(w.y << 16); f[3] = __uint_as_float(w.y & 0xffff0000u);
    f[4] = __uint_as_float(w.z << 16); f[5] = __uint_as_float(w.z & 0xffff0000u); f[6] = __uint_as_float(w.w << 16); f[7] = __uint_as_float(w.w & 0xffff0000u);
}
__device__ __forceinline__ void p8_conv(Frame& F) {
    bf16_t* U = (bf16_t*)(F.ws + WS_U); const bf16_t* HALO = (const bf16_t*)(F.ws + WS_HALO); const float* cw = FIN(21); const float* cb = FIN(22); const float* prev = FIN(5);
    const int seg = F.wave, cgi = F.lane;
    for (int unit = F.vcu; unit < 72 * 6; unit += F.G) { const int ch = unit / 6, strip = unit % 6; const int n = strip * 512 + cgi * 8, nv = n + D_FF; const bool cok = n < D_FF;
        int r0, nr; if (ch < 64) { r0 = ch * 256 + seg * 32; nr = 32; } else { r0 = MP + (ch - 64) * DEC_SEQ; nr = seg == 0 ? DEC_SEQ : 0; }
        if (!cok) nr = 0;
        float wg[3][8], wv[3][8], bg[8], bv[8], g2[8], g1[8], v2[8], v1[8];
#pragma unroll
        for (int e = 0; e < 8; ++e) { g2[e] = 0.f; g1[e] = 0.f; v2[e] = 0.f; v1[e] = 0.f; }
        if (cok) {
#pragma unroll
            for (int k = 0; k < 3; ++k) { const f32x4 a0 = *(const f32x4*)(cw + k * FF2 + n), a1 = *(const f32x4*)(cw + k * FF2 + n + 4), c0 = *(const f32x4*)(cw + k * FF2 + nv), c1 = *(const f32x4*)(cw + k * FF2 + nv + 4);
#pragma unroll
                for (int e = 0; e < 4; ++e) { wg[k][e] = a0[e]; wg[k][4 + e] = a1[e]; wv[k][e] = c0[e]; wv[k][4 + e] = c1[e]; } }
            { const f32x4 a0 = *(const f32x4*)(cb + n), a1 = *(const f32x4*)(cb + n + 4), c0 = *(const f32x4*)(cb + nv), c1 = *(const f32x4*)(cb + nv + 4);
#pragma unroll
              for (int e = 0; e < 4; ++e) { bg[e] = a0[e]; bg[4 + e] = a1[e]; bv[e] = c0[e]; bv[4 + e] = c1[e]; } }
            if (ch < 64) {
                if (seg > 0) { unpack8(*(const u32x4*)(U + (size_t)(r0 - 2) * FF2 + n), g2); unpack8(*(const u32x4*)(U + (size_t)(r0 - 1) * FF2 + n), g1); unpack8(*(const u32x4*)(U + (size_t)(r0 - 2) * FF2 + nv), v2); unpack8(*(const u32x4*)(U + (size_t)(r0 - 1) * FF2 + nv), v1); }
                else if ((ch & 31) != 0) { const bf16_t* hp = HALO + (size_t)ch * 2 * FF2; unpack8(*(const u32x4*)(hp + n), g2); unpack8(*(const u32x4*)(hp + FF2 + n), g1); unpack8(*(const u32x4*)(hp + nv), v2); unpack8(*(const u32x4*)(hp + FF2 + nv), v1); }
            } else if (seg == 0) { const float* pp = prev + (size_t)(ch - 64) * 2 * FF2;
#pragma unroll
                for (int e = 0; e < 8; ++e) { g2[e] = pp[n + e]; g1[e] = pp[FF2 + n + e]; v2[e] = pp[nv + e]; v1[e] = pp[FF2 + nv + e]; } }
        }
        __syncthreads();
#pragma unroll 2
        for (int i = 0; i < nr; ++i) { bf16_t* row = U + (size_t)(r0 + i) * FF2; float g0[8], v0[8], h[8];
            unpack8(*(const u32x4*)(row + n), g0); unpack8(*(const u32x4*)(row + nv), v0);
#pragma unroll
            for (int e = 0; e < 8; ++e) { const float cg = g2[e] * wg[0][e] + g1[e] * wg[1][e] + g0[e] * wg[2][e] + bg[e], cv = v2[e] * wv[0][e] + v1[e] * wv[1][e] + v0[e] * wv[2][e] + bv[e];
                h[e] = cg * __builtin_amdgcn_rcpf(1.f + __expf(-cg)) * cv; g2[e] = g1[e]; g1[e] = g0[e]; v2[e] = v1[e]; v1[e] = v0[e]; }
            u32x4 w; w.x = cvt_pk_bf16(h[0], h[1]); w.y = cvt_pk_bf16(h[2], h[3]); w.z = cvt_pk_bf16(h[4], h[5]); w.w = cvt_pk_bf16(h[6], h[7]);
            *(u32x4*)(row + n) = w; }
        __syncthreads();
    }
}
__global__ void __launch_bounds__(NTHR, 2) mk(const MArgs a) {
    extern __shared__ __attribute__((aligned(16))) unsigned char lds_raw[];
    Frame F;
    F.lds = (LAS unsigned char*)lds_raw;
    F.tid = threadIdx.x; F.lane = F.tid & 63; F.wave = __builtin_amdgcn_readfirstlane(F.tid >> 6);
    F.G = gridDim.x; F.x = blockIdx.x % 8; F.j = blockIdx.x / 8; F.vcu = F.x * (F.G / 8) + F.j;
    F.a = &a; F.out = a.out; F.ws = a.ws;
    volatile LAS unsigned* MISC = (volatile LAS unsigned*)(F.lds + MISC_OFF);
    if (F.tid < 32) MISC[F.tid] = 0u;
    __syncthreads();
    XcdBarrier bar = xcd_barrier_post((unsigned*)(a.ws + WS_CTL) + CW_BAR + a.li * XCD_BAR_WORDS, MISC + 8);
    const int lo = a.ph_lo, hi = a.ph_hi;
#define IN_(k) (lo <= (k) && (k) < hi)
#define SEAM_(k) do { if (IN_(k) && IN_((k) + 1)) xcd_barrier(bar); } while (0)
#ifndef PROBE_LO
#define PROBE_LO -1
#define PROBE_HI -1
#define PROBE_MULT 1
#endif
#define STAMP_(k) do { if (PROBE_LO >= 0 && blockIdx.x == 0 && F.tid == 0) { const unsigned long long t_ = __builtin_amdgcn_s_memrealtime(); if ((k) == PROBE_LO) { MISC[16] = (unsigned)t_; MISC[17] = (unsigned)(t_ >> 32); } if ((k) == PROBE_HI) { MISC[18] = (unsigned)t_; MISC[19] = (unsigned)(t_ >> 32); } } } while (0)
    STAMP_(0); if (IN_(0)) { p0_prologue(F); } SEAM_(0);
    STAMP_(1); if (IN_(1)) { p1_inproj(F); } SEAM_(1);
    STAMP_(2); if (IN_(2)) { r1_states(F); } SEAM_(2);
    STAMP_(3); if (IN_(3)) { r2_scan(F); } SEAM_(3);
    STAMP_(4); if (IN_(4)) { r3_outputs(F); } SEAM_(4);
    STAMP_(5); if (IN_(5)) { p2_qkv(F, 1); } SEAM_(5);
    STAMP_(6); if (IN_(6)) { p3_attn_sample(F); } SEAM_(6);
    STAMP_(7); if (IN_(7)) { attn_sample_combine(F); p2_qkv(F, 0); } SEAM_(7);
    STAMP_(8); if (IN_(8)) { p3_attn_prompt(F); } SEAM_(8);
    STAMP_(9); if (IN_(9)) { p5_gemm(F, 5); } SEAM_(9);
    STAMP_(10); if (IN_(10)) { p5_gemm(F, 6); } SEAM_(10);
    STAMP_(11); if (IN_(11)) { p5_gemm(F, 7); } SEAM_(11);
    STAMP_(12); if (IN_(12)) { p8_conv(F); } SEAM_(12);
    STAMP_(13); if (IN_(13)) { p5_gemm(F, 9); }
    if (PROBE_LO >= 0) { __syncthreads(); STAMP_(14);
        if (blockIdx.x == 0 && F.tid == 0) { const unsigned long long t_end = __builtin_amdgcn_s_memrealtime() + (unsigned long long)PROBE_MULT * ((((unsigned long long)MISC[19] << 32) | MISC[18]) - (((unsigned long long)MISC[17] << 32) | MISC[16]));
            while (__builtin_amdgcn_s_memrealtime() < t_end) __builtin_amdgcn_s_sleep(8); } }
}

extern "C" void kernel_launch(void* const* d_in, const int* in_sizes, int n_in, void* d_out, int out_size, void* d_ws, size_t ws_size, hipStream_t stream) {
    static int ok = 0;
    if (ok == 0) {
        ok = 1;
        if (ws_size < 256 * MiB || n_in != 24) { fprintf(stderr, "kernel_launch: bad ws/n_in: %zu %d\n", ws_size, n_in); ok = -1; }
        int dev = 0, cus = 0; (void)hipGetDevice(&dev); (void)hipDeviceGetAttribute(&cus, hipDeviceAttributeMultiprocessorCount, dev);
        if (cus != 256) { fprintf(stderr, "kernel_launch: built for 256 CUs, got %d\n", cus); ok = -1; }
        if (hipFuncSetAttribute((const void*)mk, hipFuncAttributeMaxDynamicSharedMemorySize, LDS_BYTES) != hipSuccess) { fprintf(stderr, "kernel_launch: hipFuncSetAttribute(mk) failed\n"); ok = -1; }
        (void)hipGetLastError();
    }
    if (ok < 0) return;
    (void)hipMemsetAsync((char*)d_ws + WS_CTL, 0, CTL_BYTES, stream);
    MArgs a{}; for (int i = 0; i < 24; ++i) a.in[i] = (const float*)d_in[i]; a.out = (float*)d_out; a.ws = (unsigned char*)d_ws; a.ph_lo = 0; a.ph_hi = 14; a.li = 0;
    hipLaunchKernelGGL(mk, dim3(256), dim3(NTHR), LDS_BYTES, stream, a);
}
```

```cpp
#include <hip/hip_runtime.h>
#include <stdint.h>
#include <cstdio>

typedef unsigned short bf16_t;
typedef short bf16x8 __attribute__((ext_vector_type(8)));
typedef float f32x4 __attribute__((ext_vector_type(4)));
typedef float f32x2 __attribute__((ext_vector_type(2)));
typedef unsigned u32x4 __attribute__((ext_vector_type(4)));
typedef unsigned u32x2 __attribute__((ext_vector_type(2)));

constexpr int D_MODEL = 1024, BATCH = 2, SEQ = 8192, DEC_BATCH = 8, DEC_SEQ = 16, PAST = 2048;
constexpr int MP = BATCH * SEQ, MS = DEC_BATCH * DEC_SEQ, MT = MP + MS;
constexpr int MPAD = 16640;
constexpr int Q_LORA = 768, KV_LORA = 512, QK_NOPE = 128, QK_ROPE = 64, V_HEAD = 128, HEADS = 8;
constexpr int RET_H = 4, RET_DK = 128, RET_DV = 256;
constexpr int D_FF = 2816, FF2 = 2 * D_FF;
constexpr int IN_W = 6464;
constexpr int SKEYS = PAST + DEC_SEQ;
constexpr int LROWS = DEC_BATCH * SKEYS;
constexpr float EPS = 1e-6f;
constexpr int C_QLAT = 0, C_KVLAT = 768, C_KPE = 1280, C_RQ = 1344, C_RK = 1856, C_RV = 2368, C_RG = 3392, C_GA = 4416, C_GB = 5440;

constexpr size_t O_YP = 0, O_YS = 16777216, O_LATP = 16908288, O_RKP = 25296896, O_RETP = 26345472, O_CONVP = 26607616,
                 O_LATS = 26630144, O_RKS = 26695680, O_RETS = 26703872, O_CONVS = 27752448;

constexpr size_t MiB = 1u << 20, KiB = 1024;
constexpr size_t WS_CTL = 0, CTL_BYTES = 64 * KiB, WS_SQ = 64 * KiB, WS_SKV = 192 * KiB;
constexpr size_t WS_SLOTQ = 1 * MiB, WS_SLOTKV = 2 * MiB, WS_SLOTX1 = 3 * MiB;
constexpr size_t WS_TAB32 = 4 * MiB + 256 * KiB, WS_TAB64 = 6 * MiB + 256 * KiB;
constexpr size_t WS_FWUP = 10 * MiB + 512 * KiB, WS_FWDOWN = 21 * MiB + 512 * KiB, WS_FWIN = 27 * MiB, WS_FWQUP = 40 * MiB, WS_FWKVUP = 43 * MiB,
                 WS_FWOBA = 45 * MiB, WS_FWOBB = 47 * MiB, WS_FWOUT = 49 * MiB;
constexpr size_t WS_XN = 51 * MiB, WS_RET = 51 * MiB;
constexpr size_t WS_LATS = 83 * MiB + 512 * KiB, WS_PES = 99 * MiB + 768 * KiB, WS_ZQ = 102 * MiB, WS_KVL = 126 * MiB + 512 * KiB, WS_KPE = 142 * MiB + 768 * KiB;
constexpr size_t WS_RQ = 145 * MiB, WS_RK = 161 * MiB + 256 * KiB, WS_RV = 177 * MiB + 512 * KiB, WS_RG = 210 * MiB;
constexpr size_t WS_KN = 145 * MiB, WS_V = 177 * MiB + 512 * KiB, WS_ATTS = 242 * MiB + 512 * KiB, WS_XN2 = 210 * MiB, WS_ATT = 102 * MiB;
constexpr size_t WS_T1 = 166 * MiB + 512 * KiB, WS_MERGED = 134 * MiB;
constexpr size_t WS_GAS = 246 * MiB, WS_GBS = 247 * MiB;
constexpr size_t WS_X1B = 223 * MiB + 512 * KiB, WS_U = 27 * MiB, WS_HALO = 206 * MiB;

__device__ __forceinline__ bf16_t f2bf(float f) { unsigned u = __float_as_uint(f); u = (u + 0x7fffu + ((u >> 16) & 1u)) >> 16; return (bf16_t)u; }
__device__ __forceinline__ float bf2f(bf16_t b) { return __uint_as_float(((unsigned)b) << 16); }

#define LAS __attribute__((address_space(3)))
#define GAS __attribute__((address_space(1)))
constexpr int NTHR = 512;
constexpr int RING_BYTES = 131072, EPI_OFF = RING_BYTES, EPI_BYTES = 8192, MISC_OFF = EPI_OFF + EPI_BYTES, LDS_BYTES = 147456;
constexpr int CW_BAR = 1024;

__device__ __forceinline__ unsigned cvt_pk_bf16(float lo, float hi) { unsigned r; asm volatile("v_cvt_pk_bf16_f32 %0, %1, %2" : "=v"(r) : "v"(lo), "v"(hi)); return r; }
__device__ __forceinline__ u32x4 pack8f(const f32x4& a, const f32x4& b) { u32x4 w; w.x = cvt_pk_bf16(a[0], a[1]); w.y = cvt_pk_bf16(a[2], a[3]); w.z = cvt_pk_bf16(b[0], b[1]); w.w = cvt_pk_bf16(b[2], b[3]); return w; }
__device__ __forceinline__ int row_pos(int row) { return row < MP ? (row & (SEQ - 1)) : PAST + ((row - MP) & (DEC_SEQ - 1)); }

#define XB_TMO      128
#define XB_XCNT(j)  (256  + 64 * (j))
#define XB_XSUB(j)  (1280 + 64 * (j))
#define XB_XGEN(j)  (2304 + 64 * (j))
#define XB_TOP      3328
#define XB_TOPGEN   3392
#define XCD_BAR_WORDS 3456
#define XB_SPIN_CAP (1u << 18)
__device__ __forceinline__ unsigned xb_ld(unsigned* p)              { return __hip_atomic_load(p, __ATOMIC_RELAXED, __HIP_MEMORY_SCOPE_AGENT); }
__device__ __forceinline__ unsigned xb_add(unsigned* p, unsigned v) { return __hip_atomic_fetch_add(p, v, __ATOMIC_RELAXED, __HIP_MEMORY_SCOPE_AGENT); }
__device__ __forceinline__ unsigned xb_xcc_id() { return (unsigned)__builtin_amdgcn_s_getreg((3 << 11) | 20) & 0xFu; }
#define XB_SPIN(cond, bar) do { unsigned _sp = 0; while (cond) { __builtin_amdgcn_s_sleep(1); \
    if ((++_sp & 255u) == 0u) { if (xb_ld(&(bar)[XB_TMO])) break; if (_sp > XB_SPIN_CAP) { atomicAdd(&(bar)[XB_TMO], 1u); break; } } } } while (0)
struct XcdBarrier { unsigned* bar; unsigned x; volatile LAS unsigned* st; };
__device__ __forceinline__ XcdBarrier xcd_barrier_post(unsigned* bar, volatile LAS unsigned* st) {
    XcdBarrier b; b.bar = bar; b.x = xb_xcc_id(); b.st = st;
    if (threadIdx.x == 0) (void)xb_add(&bar[XB_XCNT(b.x)], 1u);
    return b;
}
__device__ __forceinline__ void xcd_barrier_complete(unsigned* bar, unsigned x, unsigned& nloc, unsigned& nx) {
    const unsigned G = gridDim.x * gridDim.y * gridDim.z;
    unsigned sum, cnt, mine, sp = 0u;
    for (;;) {
        sum = 0u; cnt = 0u; mine = 0u;
#pragma unroll
        for (unsigned j = 0; j < 16; ++j) { const unsigned c = xb_ld(&bar[XB_XCNT(j)]); sum += c; cnt += (c > 0u) ? 1u : 0u; mine = (j == x) ? c : mine; }
        if (sum == G) break;
        __builtin_amdgcn_s_sleep(1);
        if ((++sp & 255u) == 0u) { if (xb_ld(&bar[XB_TMO])) break; if (sp > XB_SPIN_CAP) { atomicAdd(&bar[XB_TMO], 1u); break; } }
    }
    nloc = mine > 0u ? mine : 1u; nx = cnt > 0u ? cnt : 1u;
}
__device__ __forceinline__ void xcd_barrier(const XcdBarrier& b) {
    asm volatile("s_waitcnt vmcnt(0)" ::: "memory");
    __syncthreads();
    if (threadIdx.x == 0) {
        unsigned* bar = b.bar;
        __builtin_amdgcn_s_waitcnt(0);
        unsigned nloc = b.st[0], nx = b.st[1];
        if (nloc == 0u) { xcd_barrier_complete(bar, b.x, nloc, nx); b.st[0] = nloc; b.st[1] = nx; }
        const unsigned old = xb_add(&bar[XB_XSUB(b.x)], 1u);
        const unsigned gen = old / nloc;
        if (old + 1u == (gen + 1u) * nloc) {
            __builtin_amdgcn_fence(__ATOMIC_RELEASE, "agent");
            asm volatile("s_waitcnt vmcnt(0)" ::: "memory");
            const unsigned og = xb_add(&bar[XB_TOP], 1u);
            const unsigned tg = og / nx;
            if (og + 1u == (tg + 1u) * nx) xb_add(&bar[XB_TOPGEN], 1u);
            else XB_SPIN(xb_ld(&bar[XB_TOPGEN]) == tg, bar);
            __builtin_amdgcn_fence(__ATOMIC_ACQUIRE, "agent");
            xb_add(&bar[XB_XGEN(b.x)], 1u);
            asm volatile("s_waitcnt vmcnt(0)" ::: "memory");
        } else {
            XB_SPIN(xb_ld(&bar[XB_XGEN(b.x)]) == gen, bar);
            __builtin_amdgcn_fence(__ATOMIC_ACQUIRE, "agent");
            asm volatile("s_waitcnt vmcnt(0)" ::: "memory");
        }
    }
    __syncthreads();
}

namespace pg {
constexpr int BK = 64, HALF = 128, HTB = HALF * BK * 2;
__host__ __device__ __forceinline__ int lds_byte(int r, int c) { const int st = (r >> 4) * 2 + (c >> 5), rr = r & 15, cc = c & 31, ob = rr * 64 + cc * 2; return st * 1024 + (ob ^ (((ob >> 9) & 1) << 5)); }
__host__ __device__ __forceinline__ void stage_rc(int b, int& R, int& C) { const int st = b / 1024, sb = b % 1024, swz = sb ^ (((sb >> 9) & 1) << 5); R = (st >> 1) * 16 + swz / 64; C = (st & 1) * 32 + (swz % 64) / 2; }
__host__ __device__ __forceinline__ int perm32(int rho) { const int n = rho >> 4, i = rho & 15; return 8 * (i >> 2) + 4 * n + (i & 3); }
struct UnitG { const char* A; const char* B; unsigned lda, ldb; int nt; int pm, pn, kind; int half; };
typedef f32x4 Acc[2][2][4][2];

template <class Sched, class Epi>
__device__ __forceinline__ void gemm_stream(LAS unsigned char* lds, const Sched& S, const Epi& E) {
    const int tid = threadIdx.x, wid = __builtin_amdgcn_readfirstlane(tid >> 6), lane = tid & 63, wr = wid >> 2, wc = wid & 3, fr = lane & 15, fq = lane >> 4;
    unsigned Rr[2], Cc[2];
#pragma unroll
    for (int i = 0; i < 2; ++i) { int R, C; stage_rc(tid * 16 + i * 8192, R, C); Rr[i] = (unsigned)R; Cc[i] = (unsigned)C * 2u; }
    const unsigned ldsw = (unsigned)wid * 1024u;
    const int aoff = lds_byte(wr * 64 + fr, fq * 8), boff = lds_byte(wc * 32 + fr, fq * 8);
#define PG_SA(b, h) (((b) * 2 + (h)) * HTB)
#define PG_SB(b, h) ((4 + (b) * 2 + (h)) * HTB)
#define PG_STAGE(bufoff, gbase, ld) do { _Pragma("unroll") for (int _i = 0; _i < 2; ++_i) \
        __builtin_amdgcn_global_load_lds((const unsigned*)((const char*)(gbase) + (size_t)(Rr[_i] * (ld) + Cc[_i])), (LAS unsigned*)(lds + (bufoff) + ldsw + _i * 8192), 16, 0, 0); } while (0)
#define PG_LDA(dst, b, h) do { _Pragma("unroll") for (int m = 0; m < 4; ++m) _Pragma("unroll") for (int k = 0; k < 2; ++k) dst[m][k] = *(const LAS bf16x8*)(lds + PG_SA(b, h) + aoff + m * 2048 + k * 1024); } while (0)
#define PG_LDB(dst, b, h) do { _Pragma("unroll") for (int n = 0; n < 2; ++n) _Pragma("unroll") for (int k = 0; k < 2; ++k) dst[n][k] = *(const LAS bf16x8*)(lds + PG_SB(b, h) + boff + n * 2048 + k * 1024); } while (0)
#define PG_MMA(ai, bj, At, Bt) do { __builtin_amdgcn_s_setprio(1); _Pragma("unroll") for (int m = 0; m < 4; ++m) _Pragma("unroll") for (int n = 0; n < 2; ++n) _Pragma("unroll") for (int k = 0; k < 2; ++k) \
        acc[ai][bj][m][n] = __builtin_amdgcn_mfma_f32_16x16x32_bf16(Bt[n][k], At[m][k], acc[ai][bj][m][n], 0, 0, 0); __builtin_amdgcn_s_setprio(0); } while (0)
#define PG_WAIT_V(n) asm volatile("s_waitcnt vmcnt(" #n ")" ::: "memory")
#define PG_WAIT_L(n) asm volatile("s_waitcnt lgkmcnt(" #n ")" ::: "memory")
#define PG_BAR __builtin_amdgcn_s_barrier()
#define PG_SCHED __builtin_amdgcn_sched_barrier(0)
    UnitG cur, nxt; int ui = 0;
    if (!S.next(0, cur)) return;
    Acc acc;
#pragma unroll
    for (int a = 0; a < 2; ++a)
#pragma unroll
        for (int b = 0; b < 2; ++b)
#pragma unroll
            for (int m = 0; m < 4; ++m)
#pragma unroll
                for (int n = 0; n < 2; ++n) acc[a][b][m][n] = (f32x4){0.f, 0.f, 0.f, 0.f};
    bf16x8 At[4][2], B0[2][2], B1[2][2];
    const char* cA = cur.A; const char* cB = cur.B; unsigned clda = cur.lda, cldb = cur.ldb;
    PG_STAGE(PG_SB(0, 0), cB, cldb); PG_STAGE(PG_SB(0, 1), cB + (size_t)HALF * cldb, cldb); PG_STAGE(PG_SA(0, 0), cA, clda); PG_STAGE(PG_SA(0, 1), cA + (size_t)HALF * clda, clda);
    if (wr == 1) PG_BAR;
    PG_WAIT_V(2); PG_BAR;
    PG_STAGE(PG_SB(1, 0), cB + 128, cldb); PG_STAGE(PG_SA(1, 0), cA + 128, clda); PG_STAGE(PG_SB(1, 1), cB + (size_t)HALF * cldb + 128, cldb);
    PG_WAIT_V(6); PG_BAR;
    for (;;) {
        const bool has_next = S.next(ui + 1, nxt);
        const char* nA = has_next ? nxt.A : cA; const char* nB = has_next ? nxt.B : cB;
        const unsigned nlda = has_next ? nxt.lda : clda, nldb = has_next ? nxt.ldb : cldb;
        const int nt = cur.nt; const bool chalf = cur.half != 0;
        for (int t = 0; t < nt; t += 2) {
            const bool last = (t == nt - 2);
            const char* a1 = cA + (size_t)(t + 1) * 128;
            const char* a2 = last ? nA : cA + (size_t)(t + 2) * 128; const char* b2 = last ? nB : cB + (size_t)(t + 2) * 128;
            const unsigned lda2 = last ? nlda : clda, ldb2 = last ? nldb : cldb;
            const char* a3 = a2 + 128; const char* b3 = b2 + 128;
            PG_LDB(B0, 0, 0); PG_LDB(B1, 0, 1); PG_SCHED; PG_LDA(At, 0, 0); PG_STAGE(PG_SA(1, 1), a1 + (size_t)HALF * clda, clda);
            PG_WAIT_V(8); PG_WAIT_L(0); PG_BAR; PG_MMA(0, 0, At, B0); PG_MMA(0, 1, At, B1); PG_BAR; PG_SCHED;
            PG_LDA(At, 0, 1); PG_STAGE(PG_SB(0, 0), b2, ldb2); PG_STAGE(PG_SB(0, 1), b2 + (size_t)HALF * ldb2, ldb2); PG_STAGE(PG_SA(0, 0), a2, lda2);
            PG_WAIT_V(8); PG_WAIT_L(0); PG_BAR; if (!chalf) { PG_MMA(1, 0, At, B0); PG_MMA(1, 1, At, B1); } PG_BAR; PG_SCHED;
            PG_LDB(B0, 1, 0); PG_LDB(B1, 1, 1); PG_SCHED; PG_LDA(At, 1, 0); PG_STAGE(PG_SA(0, 1), a2 + (size_t)HALF * lda2, lda2);
            PG_WAIT_V(8); PG_WAIT_L(0); PG_BAR; PG_MMA(0, 0, At, B0); PG_MMA(0, 1, At, B1); PG_BAR; PG_SCHED;
            PG_LDA(At, 1, 1); PG_STAGE(PG_SB(1, 0), b3, ldb2); PG_STAGE(PG_SB(1, 1), b3 + (size_t)HALF * ldb2, ldb2); PG_STAGE(PG_SA(1, 0), a3, lda2);
            PG_WAIT_V(8); PG_WAIT_L(0); PG_BAR; if (!chalf) { PG_MMA(1, 0, At, B0); PG_MMA(1, 1, At, B1); } PG_BAR; PG_SCHED;
        }
        if (wr == 0) PG_BAR;
        E(acc, cur, lds, wr, wc, fr, fq);
        if (!has_next) break;
#pragma unroll
        for (int a = 0; a < 2; ++a)
#pragma unroll
            for (int b = 0; b < 2; ++b)
#pragma unroll
                for (int m = 0; m < 4; ++m)
#pragma unroll
                    for (int n = 0; n < 2; ++n) acc[a][b][m][n] = (f32x4){0.f, 0.f, 0.f, 0.f};
        cur = nxt; cA = nA; cB = nB; clda = nlda; cldb = nldb; ++ui;
        if (wr == 1) PG_BAR;
    }
    PG_WAIT_V(0);
    PG_BAR;
#undef PG_SA
#undef PG_SB
#undef PG_STAGE
#undef PG_LDA
#undef PG_LDB
#undef PG_MMA
#undef PG_WAIT_V
#undef PG_WAIT_L
#undef PG_BAR
#undef PG_SCHED
}
}

struct MArgs { const float* in[24]; float* out; unsigned char* ws; int ph_lo, ph_hi, li, pad; };
struct Frame {
    LAS unsigned char* lds; int tid, lane, wave; int x, j, vcu, G;
    const MArgs* a; float* out; unsigned char* ws;
};
#define FIN(k) (F.a->in[k])
__device__ __forceinline__ float fwave_sum(float v) {
#pragma unroll
    for (int o = 1; o < 64; o <<= 1) v += __shfl_xor(v, o);
    return v;
}

enum { W_IN = 0, W_QUP, W_KVUP, W_OBA, W_OBB, W_OUT, W_UP, W_DOWN };
__device__ __forceinline__ int win_src(int gd) {
    const int tile = gd >> 3, g = gd & 7, bj = g >> 2, wc = g & 3;
    if (tile < 3) return C_QLAT + gd * 32;
    if (tile < 5) return C_KVLAT + (gd - 24) * 32;
    if (tile == 5) return (wc == 0) ? C_KPE + bj * 32 : -1;
    if (tile < 10) { const int base = tile < 8 ? C_RQ : C_RK, tl = tile < 8 ? tile - 6 : tile - 8; const int head = 2 * tl + (wc >> 1); return base + head * 128 + bj * 64 + (wc & 1) * 32; }
    if (tile < 14) return C_RV + (gd - 80) * 32;
    if (tile < 18) return C_RG + (gd - 112) * 32;
    if (tile < 22) return C_GA + (gd - 144) * 32;
    return C_GB + (gd - 176) * 32;
}
__device__ __forceinline__ int w_src_col(int wid, int row) {
    const int rho = row & 31, s = row & 255, wc = (s >> 5) & 3, t = row >> 8;
    const int n = rho >> 4, i = rho & 15; return t * 192 + 128 + 16 * wc + i + 32 * n;
}
__device__ __forceinline__ int w_group_base(int wid, int gd) {
    const int g = gd & 7, bj = g >> 2, wc = g & 3, t = gd >> 3;
    switch (wid) {
    case W_IN: return win_src(gd);
    case W_QUP: return bj == 0 ? t * 192 + 32 * wc : (wc < 2 ? -2 : -1);
    case W_KVUP: return t * 256 + 128 * bj + 32 * wc;
    case W_UP: return (bj ? D_FF : 0) + 128 * t + 32 * wc;
    default: return gd * 32;
    }
}
struct WItemRegs { f32x4 v[8]; float g[8]; };
__device__ __forceinline__ void p0_item_load(WItemRegs& R, const float* __restrict__ W, int ldw, const float* __restrict__ gain, int base, int kb, int lane) {
    const int k0 = kb * 64, c = lane & 7;
    if (base >= 0) {
#pragma unroll
        for (int i = 0; i < 8; ++i) { const int kk = (lane >> 3) + 8 * i; R.g[i] = gain ? gain[k0 + kk] : 1.f; R.v[i] = *(const f32x4*)(W + (size_t)(k0 + kk) * ldw + base + 4 * c); } }
}
__device__ __forceinline__ void p0_item_finish(const WItemRegs& R, const float* __restrict__ W, int ldw, int K, const float* __restrict__ gain, int wid, int base, bf16_t* __restrict__ Wt, int gd, int kb, LAS float* scr, int lane) {
    const int k0 = kb * 64, c = lane & 7;
    bf16_t* dst = Wt + (size_t)(gd * 32) * K + k0;
    if (base == -1) {
#pragma unroll
        for (int jj = 0; jj < 4; ++jj) { const int n = (lane >> 3) + 8 * jj; *(u32x4*)(dst + (size_t)n * K + 8 * c) = (u32x4){0u, 0u, 0u, 0u}; }
        return;
    }
    if (base >= 0) {
#pragma unroll
        for (int i = 0; i < 8; ++i) { const int kk = (lane >> 3) + 8 * i; LAS float* d = scr + kk * 33 + 4 * c; const float g = R.g[i]; d[0] = R.v[i][0] * g; d[1] = R.v[i][1] * g; d[2] = R.v[i][2] * g; d[3] = R.v[i][3] * g; }
    } else {
        const int sc = w_src_col(wid, gd * 32 + (lane & 31));
#pragma unroll 8
        for (int i = 0; i < 32; ++i) { const int kk = 2 * i + (lane >> 5); const float g = gain ? gain[k0 + kk] : 1.f; scr[kk * 33 + (lane & 31)] = W[(size_t)(k0 + kk) * ldw + sc] * g; }
    }
    asm volatile("s_waitcnt lgkmcnt(0)" ::: "memory");
#pragma unroll
    for (int jj = 0; jj < 4; ++jj) { const int n = (lane >> 3) + 8 * jj; const LAS float* s = scr + (8 * c) * 33 + (base >= 0 ? pg::perm32(n) : n);
        u32x4 o; o.x = cvt_pk_bf16(s[0 * 33], s[1 * 33]); o.y = cvt_pk_bf16(s[2 * 33], s[3 * 33]); o.z = cvt_pk_bf16(s[4 * 33], s[5 * 33]); o.w = cvt_pk_bf16(s[6 * 33], s[7 * 33]);
        *(u32x4*)(dst + (size_t)n * K + 8 * c) = o; }
    asm volatile("s_waitcnt lgkmcnt(0)" ::: "memory");
}
__device__ __forceinline__ void p0_weights(Frame& F, LAS float* scr, int gw, int NGW, const float* W, int ldw, int K, const float* gain, int wid, size_t off, int ngroups) {
    const int nkb = K / 64, total = ngroups * nkb; bf16_t* Wt = (bf16_t*)(F.ws + off);
    for (int it = gw; it < total; it += 2 * NGW) {
        const int itB = it + NGW; const bool hasB = itB < total;
        const int gdA = it / nkb, kbA = it % nkb, baseA = w_group_base(wid, gdA);
        const int gdB = hasB ? itB / nkb : 0, kbB = hasB ? itB % nkb : 0, baseB = hasB ? w_group_base(wid, gdB) : -1;
        WItemRegs RA, RB;
        p0_item_load(RA, W, ldw, gain, baseA, kbA, F.lane);
        p0_item_load(RB, W, ldw, gain, baseB, kbB, F.lane);
        p0_item_finish(RA, W, ldw, K, gain, wid, baseA, Wt, gdA, kbA, scr, F.lane);
        if (hasB) p0_item_finish(RB, W, ldw, K, gain, wid, baseB, Wt, gdB, kbB, scr, F.lane);
    }
}
__device__ __forceinline__ float2 rope_cs(int pos, double f) {
    const double a = (double)pos * f; const double n = rint(a * 0.15915494309189535); const double r = fma(-n, 6.283185307179586, a) - n * 2.4492935982947064e-16;
    const float rf = (float)r; return make_float2(cosf(rf), sinf(rf));
}
__device__ __forceinline__ void p0_prologue(Frame& F) {
    LAS float* scr = (LAS float*)(F.lds + F.wave * 16384);
    const int gw = F.vcu * 8 + F.wave, NGW = F.G * 8;
    p0_weights(F, scr, gw, NGW, FIN(7), IN_W, 1024, FIN(6), W_IN, WS_FWIN, 26 * 8);
    p0_weights(F, scr, gw, NGW, FIN(9), 1536, 768, FIN(8), W_QUP, WS_FWQUP, 8 * 8);
    p0_weights(F, scr, gw, NGW, FIN(13), 2048, 512, nullptr, W_KVUP, WS_FWKVUP, 8 * 8);
    p0_weights(F, scr, gw, NGW, FIN(17), 1024, 1024, nullptr, W_OBA, WS_FWOBA, 4 * 8);
    p0_weights(F, scr, gw, NGW, FIN(17) + (size_t)1024 * 1024, 1024, 1024, nullptr, W_OBB, WS_FWOBB, 4 * 8);
    p0_weights(F, scr, gw, NGW, FIN(18), 1024, 1024, nullptr, W_OUT, WS_FWOUT, 4 * 8);
    p0_weights(F, scr, gw, NGW, FIN(20), FF2, 1024, FIN(19), W_UP, WS_FWUP, 22 * 8);
    p0_weights(F, scr, gw, NGW, FIN(23), 1024, D_FF, nullptr, W_DOWN, WS_FWDOWN, 4 * 8);
    {   bf16_t* XN = (bf16_t*)(F.ws + WS_XN);
        for (int r = gw; r < MPAD; r += 2 * NGW) {
            const int r2 = r + NGW; f32x4 v[2][4];
#pragma unroll
            for (int q = 0; q < 2; ++q) { const int rr = q ? r2 : r; if (rr < MT) { const float* x = rr < MP ? FIN(0) + (size_t)rr * D_MODEL : FIN(1) + (size_t)(rr - MP) * D_MODEL; const f32x4* xr = (const f32x4*)x + F.lane;
#pragma unroll
                    for (int jj = 0; jj < 4; ++jj) v[q][jj] = xr[64 * jj]; } else {
#pragma unroll
                    for (int jj = 0; jj < 4; ++jj) v[q][jj] = (f32x4){0.f, 0.f, 0.f, 0.f}; } }
#pragma unroll
            for (int q = 0; q < 2; ++q) { const int rr = q ? r2 : r; if (rr >= MPAD) continue; float s = 0.f;
#pragma unroll
                for (int jj = 0; jj < 4; ++jj) s += (v[q][jj][0] * v[q][jj][0] + v[q][jj][1] * v[q][jj][1]) + (v[q][jj][2] * v[q][jj][2] + v[q][jj][3] * v[q][jj][3]);
                const float inv = rsqrtf(fwave_sum(s) * (1.f / D_MODEL) + EPS); u32x2* o8 = (u32x2*)(XN + (size_t)rr * D_MODEL) + F.lane;
#pragma unroll
                for (int jj = 0; jj < 4; ++jj) { u32x2 w; w.x = cvt_pk_bf16(v[q][jj][0] * inv, v[q][jj][1] * inv); w.y = cvt_pk_bf16(v[q][jj][2] * inv, v[q][jj][3] * inv); o8[64 * jj] = w; } }
        } }
    {   bf16_t* lats = (bf16_t*)(F.ws + WS_LATS); bf16_t* pes = (bf16_t*)(F.ws + WS_PES);
        const int gt = F.vcu * NTHR + F.tid, NG = F.G * NTHR;
        for (int i0 = gt; i0 < DEC_BATCH * PAST * (KV_LORA / 4); i0 += 4 * NG) { f32x4 v[4];
#pragma unroll
            for (int q = 0; q < 4; ++q) v[q] = *((const f32x4*)FIN(2) + i0 + q * NG);
#pragma unroll
            for (int q = 0; q < 4; ++q) { const int i = i0 + q * NG, c4 = i % (KV_LORA / 4), rj = i / (KV_LORA / 4), jr = rj % PAST, b = rj / PAST; u32x2 w; w.x = cvt_pk_bf16(v[q][0], v[q][1]); w.y = cvt_pk_bf16(v[q][2], v[q][3]);
                *(u32x2*)(lats + ((size_t)b * SKEYS + jr) * KV_LORA + c4 * 4) = w; } }
        for (int i = gt; i < DEC_BATCH * PAST * (QK_ROPE / 4); i += NG) { const int c4 = i % (QK_ROPE / 4), rj = i / (QK_ROPE / 4), jr = rj % PAST, b = rj / PAST;
            const f32x4 v = *((const f32x4*)FIN(3) + i); u32x2 w; w.x = cvt_pk_bf16(v[0], v[1]); w.y = cvt_pk_bf16(v[2], v[3]);
            *(u32x2*)(pes + ((size_t)b * SKEYS + jr) * QK_ROPE + c4 * 4) = w; }
        float2* tab32 = (float2*)(F.ws + WS_TAB32); float2* tab64 = (float2*)(F.ws + WS_TAB64);
        {   const int k64 = gt & 63, k32 = gt & 31;
            const double f64 = exp2(-(double)k64 * (13.287712379549449 / 64.0)), f32 = exp2(-(double)k32 * (13.287712379549449 / 32.0));
            for (int i = gt; i < 8192 * 64; i += NG) { tab64[i] = rope_cs(i >> 6, f64); if (i < 8192 * 32) tab32[i] = rope_cs(i >> 5, f32); } } }
}

__device__ __forceinline__ bool reg_unit(int x, int j, int i, int nN, int& pm, int& pn) { const int u = j + 32 * i; if (u >= 8 * nN) return false; pm = 8 * x + (u & 7); pn = u >> 3; return true; }
#define LDS_F(off) ((LAS float*)(lds + EPI_OFF) + (off))

enum { K_QLAT = 0, K_KVLAT, K_KPE, K_RQ, K_RK, K_RV, K_RG, K_GS, K_QUP, K_KVP, K_KVS, K_GA, K_AD, K_GB, K_RD, K_OUT, K_UP, K_DOWN };
struct SchedP1 {
    int x, j; const char* ws;
    __device__ __forceinline__ bool next(int i, pg::UnitG& u) const {
        int pm, pn;
        if (!reg_unit(x, j, i, 18, pm, pn)) { if (i == 4 && j >= 16) { const int k = (j - 16) * 8 + x; if (k >= 26) return false; pm = 64; pn = k; } else return false; }
        u.pm = pm; u.pn = pn; u.A = ws + WS_XN + (size_t)pm * 256 * 2048; u.B = ws + WS_FWIN + (size_t)pn * 256 * 2048; u.lda = 2048; u.ldb = 2048; u.nt = 16; u.half = pm == 64;
        u.kind = pn < 3 ? K_QLAT : pn < 5 ? K_KVLAT : pn == 5 ? K_KPE : pn < 8 ? K_RQ : pn < 10 ? K_RK : pn < 14 ? K_RV : pn < 18 ? K_RG : K_GS;
        return true;
    }
};
struct EpiP1 {
    unsigned char* ws; float* out; const float *g_kvlat, *g_kr;
    __device__ __forceinline__ void operator()(const pg::Acc& acc, const pg::UnitG& u, LAS unsigned char* lds, int wr, int wc, int fr, int fq) const {
        bf16_t* const ZQ = (bf16_t*)(ws + WS_ZQ); bf16_t* const KVL = (bf16_t*)(ws + WS_KVL); bf16_t* const KPE = (bf16_t*)(ws + WS_KPE); bf16_t* const PES = (bf16_t*)(ws + WS_PES); bf16_t* const LATS = (bf16_t*)(ws + WS_LATS);
        bf16_t* const RQ = (bf16_t*)(ws + WS_RQ); bf16_t* const RK = (bf16_t*)(ws + WS_RK); bf16_t* const RV = (bf16_t*)(ws + WS_RV); bf16_t* const RG = (bf16_t*)(ws + WS_RG);
        float* const slotq = (float*)(ws + WS_SLOTQ); float* const slotkv = (float*)(ws + WS_SLOTKV);
        const float2* const tab32 = (const float2*)(ws + WS_TAB32); const float2* const tab64 = (const float2*)(ws + WS_TAB64);
        int rl0 = wr * 64 + fr, cw = wc * 32 + fq * 8; asm volatile("" : "+v"(rl0), "+v"(cw));
        const int kind = u.kind, rb = u.pm * 256 + rl0;
        if (kind == K_QLAT || kind == K_KVLAT) {
            const int t = kind == K_QLAT ? u.pn : u.pn - 3; const int ld = kind == K_QLAT ? Q_LORA : KV_LORA; bf16_t* dst = kind == K_QLAT ? ZQ : KVL;
            f32x4 g[2][2];
#pragma unroll
            for (int bj = 0; bj < 2; ++bj)
#pragma unroll
                for (int n = 0; n < 2; ++n) g[bj][n] = kind == K_KVLAT ? *(const f32x4*)(g_kvlat + t * 256 + bj * 128 + cw + 4 * n) : (f32x4){1.f, 1.f, 1.f, 1.f};
#pragma unroll
            for (int ai = 0; ai < 2; ++ai)
#pragma unroll
                for (int m = 0; m < 4; ++m) { const int row = rb + ai * 128 + m * 16; float ss = 0.f;
                    const bool snew = (kind == K_KVLAT) && row >= MP && row < MT;
                    const int rs = row - MP; bf16_t* lrow = LATS + ((size_t)(rs / DEC_SEQ) * SKEYS + PAST + (rs % DEC_SEQ)) * KV_LORA;
#pragma unroll
                    for (int bj = 0; bj < 2; ++bj) { const f32x4 v0 = acc[ai][bj][m][0], v1 = acc[ai][bj][m][1];
                        ss += (v0[0] * v0[0] + v0[1] * v0[1]) + (v0[2] * v0[2] + v0[3] * v0[3]) + (v1[0] * v1[0] + v1[1] * v1[1]) + (v1[2] * v1[2] + v1[3] * v1[3]);
                        const u32x4 w = pack8f(v0 * g[bj][0], v1 * g[bj][1]);
                        *(u32x4*)(dst + (size_t)row * ld + t * 256 + bj * 128 + cw) = w;
                        if (snew) *(u32x4*)(lrow + t * 256 + bj * 128 + cw) = w; }
                    ss += __shfl_xor(ss, 16); ss += __shfl_xor(ss, 32);
                    if (fq == 0) { if (kind == K_QLAT) slotq[(size_t)row * 12 + t * 4 + wc] = ss; else slotkv[(size_t)row * 8 + t * 4 + wc] = ss; } }
        } else if (kind == K_KPE) {
            if (wc != 0) return;
            const int d0 = fq * 8;
            f32x4 g1[2], g2[2];
#pragma unroll
            for (int n = 0; n < 2; ++n) { g1[n] = *(const f32x4*)(g_kr + d0 + 4 * n); g2[n] = *(const f32x4*)(g_kr + 32 + d0 + 4 * n); }
#pragma unroll
            for (int ai = 0; ai < 2; ++ai)
#pragma unroll
                for (int m = 0; m < 4; ++m) { const int row = rb + ai * 128 + m * 16; const int pos = row_pos(row < MT ? row : 0);
                    f32x4 x1[2], x2[2]; float ss = 0.f;
#pragma unroll
                    for (int n = 0; n < 2; ++n) { x1[n] = acc[ai][0][m][n]; x2[n] = acc[ai][1][m][n];
                        ss += (x1[n][0] * x1[n][0] + x1[n][1] * x1[n][1]) + (x1[n][2] * x1[n][2] + x1[n][3] * x1[n][3]) + (x2[n][0] * x2[n][0] + x2[n][1] * x2[n][1]) + (x2[n][2] * x2[n][2] + x2[n][3] * x2[n][3]); }
                    ss += __shfl_xor(ss, 16); ss += __shfl_xor(ss, 32);
                    const float inv = rsqrtf(ss * (1.f / 64.f) + EPS);
                    f32x4 o1[2], o2[2];
#pragma unroll
                    for (int n = 0; n < 2; ++n) { const f32x4 y1 = x1[n] * inv * g1[n], y2 = x2[n] * inv * g2[n];
                        const f32x4 cs0 = *(const f32x4*)(tab32 + pos * 32 + d0 + 4 * n), cs1 = *(const f32x4*)(tab32 + pos * 32 + d0 + 4 * n + 2);
                        const f32x4 c = {cs0[0], cs0[2], cs1[0], cs1[2]}, s = {cs0[1], cs0[3], cs1[1], cs1[3]};
                        o1[n] = y1 * c - y2 * s; o2[n] = y1 * s + y2 * c; }
                    *(u32x4*)(KPE + (size_t)row * 64 + d0) = pack8f(o1[0], o1[1]); *(u32x4*)(KPE + (size_t)row * 64 + 32 + d0) = pack8f(o2[0], o2[1]);
                    if (row < MT) {
                        float* o = row < MP ? out + O_RKP + (size_t)row * 64 : out + O_RKS + (size_t)(row - MP) * 64;
                        *(f32x4*)(o + d0) = o1[0]; *(f32x4*)(o + d0 + 4) = o1[1]; *(f32x4*)(o + 32 + d0) = o2[0]; *(f32x4*)(o + 32 + d0 + 4) = o2[1];
                        if (row >= MP) { const int rs = row - MP, b = rs / DEC_SEQ, tt = rs % DEC_SEQ; bf16_t* p = PES + ((size_t)b * SKEYS + PAST + tt) * 64;
                            *(u32x4*)(p + d0) = pack8f(o1[0], o1[1]); *(u32x4*)(p + 32 + d0) = pack8f(o2[0], o2[1]); } } }
        } else if (kind == K_RQ || kind == K_RK) {
            const int tl = kind == K_RQ ? u.pn - 6 : u.pn - 8; const int head = 2 * tl + (wc >> 1), i0 = 32 * (wc & 1) + fq * 8;
            bf16_t* dst = kind == K_RQ ? RQ : RK; const float sc = kind == K_RQ ? 1.0f : 0.08838834764831845f;
#pragma unroll
            for (int ai = 0; ai < 2; ++ai)
#pragma unroll
                for (int m = 0; m < 4; ++m) { const int row = rb + ai * 128 + m * 16; const int pos = row_pos(row < MT ? row : 0);
                    f32x4 o1[2], o2[2];
#pragma unroll
                    for (int n = 0; n < 2; ++n) { const f32x4 x1 = acc[ai][0][m][n], x2 = acc[ai][1][m][n];
                        const f32x4 cs0 = *(const f32x4*)(tab64 + pos * 64 + i0 + 4 * n), cs1 = *(const f32x4*)(tab64 + pos * 64 + i0 + 4 * n + 2);
                        const f32x4 c = {cs0[0], cs0[2], cs1[0], cs1[2]}, s = {cs0[1], cs0[3], cs1[1], cs1[3]};
                        o1[n] = (x1 * c - x2 * s) * sc; o2[n] = (x1 * s + x2 * c) * sc; }
                    *(u32x4*)(dst + (size_t)row * 512 + head * 128 + i0) = pack8f(o1[0], o1[1]); *(u32x4*)(dst + (size_t)row * 512 + head * 128 + 64 + i0) = pack8f(o2[0], o2[1]); }
        } else if (kind == K_GS) {
            bf16_t* dst = (bf16_t*)(ws + (u.pn < 22 ? WS_GAS : WS_GBS)); const int t = u.pn < 22 ? u.pn - 18 : u.pn - 22;
#pragma unroll
            for (int m = 0; m < 4; ++m) { const int rl = rl0 + m * 16;
#pragma unroll
                for (int bj = 0; bj < 2; ++bj) { f32x4 v0 = acc[0][bj][m][0], v1 = acc[0][bj][m][1];
#pragma unroll
                    for (int e = 0; e < 4; ++e) { v0[e] = 1.f / (1.f + __expf(-v0[e])); v1[e] = 1.f / (1.f + __expf(-v1[e])); }
                    *(u32x4*)(dst + (size_t)rl * 1024 + t * 256 + bj * 128 + cw) = pack8f(v0, v1); } }
        } else {
            const int t = kind == K_RV ? u.pn - 10 : u.pn - 14; bf16_t* dst = kind == K_RV ? RV : RG;
#pragma unroll
            for (int ai = 0; ai < 2; ++ai)
#pragma unroll
                for (int m = 0; m < 4; ++m) { const int row = rb + ai * 128 + m * 16;
#pragma unroll
                    for (int bj = 0; bj < 2; ++bj) { f32x4 v0 = acc[ai][bj][m][0], v1 = acc[ai][bj][m][1];
                        if (kind == K_RG) {
#pragma unroll
                            for (int e = 0; e < 4; ++e) { v0[e] = v0[e] / (1.f + __expf(-v0[e])); v1[e] = v1[e] / (1.f + __expf(-v1[e])); } }
                        *(u32x4*)(dst + (size_t)row * 1024 + t * 256 + bj * 128 + cw) = pack8f(v0, v1); } }
        }
    }
};
__device__ __forceinline__ void p1_inproj(Frame& F) {
    SchedP1 S{F.x, F.j, (const char*)F.ws};
    EpiP1 E{F.ws, F.out, FIN(12), FIN(15)};
    pg::gemm_stream(F.lds, S, E);
}

__device__ __forceinline__ float slot_rs(const float* slots, int n, float invn) {
    float a = 0.f; for (int i = 0; i < n; i += 4) { const f32x4 v = *(const f32x4*)(slots + i); a += (v[0] + v[1]) + (v[2] + v[3]); } return rsqrtf(a * invn + EPS);
}
struct SchedP2 {
    int x, j; const char* ws; int sample;
    __device__ __forceinline__ bool next(int i, pg::UnitG& u) const {
        int pm, pn, kind;
        if (sample) {
            if (i < 2) { reg_unit(x, j, i, 8, pm, pn); kind = K_QUP; }
            else if (i < 4) { reg_unit(x, j, i - 2, 8, pm, pn); kind = K_KVS; }
            else if (i == 4 && j < 2) { const int k = j * 8 + x; pm = 64; pn = k & 7; kind = k < 8 ? K_QUP : K_KVS; }
            else return false;
        } else { if (i >= 2) return false; reg_unit(x, j, i, 8, pm, pn); kind = K_KVP; }
        u.pm = pm; u.pn = pn; u.kind = kind; u.half = pm == 64;
        if (kind == K_QUP) { u.A = ws + WS_ZQ + (size_t)pm * 256 * 1536; u.lda = 1536; u.B = ws + WS_FWQUP + (size_t)pn * 256 * 1536; u.ldb = 1536; u.nt = 12; }
        else { u.A = ws + (kind == K_KVS ? WS_LATS : WS_KVL) + (size_t)pm * 256 * 1024; u.lda = 1024; u.B = ws + WS_FWKVUP + (size_t)pn * 256 * 1024; u.ldb = 1024; u.nt = 8; }
        return true;
    }
};
struct EpiP2 {
    unsigned char* ws; float* out; const float *g_qn, *g_qr, *g_kn;
    __device__ __forceinline__ void operator()(const pg::Acc& acc, const pg::UnitG& u, LAS unsigned char* lds, int wr, int wc, int fr, int fq) const {
        int rl0 = wr * 64 + fr, cw = wc * 32 + fq * 8; asm volatile("" : "+v"(rl0), "+v"(cw));
        const int kind = u.kind, h = u.pn, rb = u.pm * 256 + rl0;
        const float* const slotq = (const float*)(ws + WS_SLOTQ); const float* const slotkv = (const float*)(ws + WS_SLOTKV);
        float rs[2][4];
#pragma unroll
        for (int ai = 0; ai < 2; ++ai)
#pragma unroll
            for (int m = 0; m < 4; ++m) { const int row = rb + ai * 128 + m * 16;
                if (kind == K_QUP) rs[ai][m] = slot_rs(slotq + (size_t)row * 12, 12, 1.f / Q_LORA);
                else if (kind == K_KVP) rs[ai][m] = slot_rs(slotkv + (size_t)row * 8, 8, 1.f / KV_LORA);
                else { const int b = row / SKEYS, jj = row - b * SKEYS; rs[ai][m] = (row < LROWS && jj >= PAST) ? slot_rs(slotkv + (size_t)(MP + b * DEC_SEQ + jj - PAST) * 8, 8, 1.f / KV_LORA) : 1.f; } }
#pragma unroll
        for (int ai = 0; ai < 2; ++ai)
#pragma unroll
            for (int m = 0; m < 4; ++m) { float p0 = 0.f, p1 = 0.f; const float s2 = rs[ai][m] * rs[ai][m];
#pragma unroll
                for (int n = 0; n < 2; ++n) { const f32x4 a = acc[ai][0][m][n], b = acc[ai][1][m][n];
                    p0 += (a[0] * a[0] + a[1] * a[1]) + (a[2] * a[2] + a[3] * a[3]); p1 += (b[0] * b[0] + b[1] * b[1]) + (b[2] * b[2] + b[3] * b[3]); }
                p0 += __shfl_xor(p0, 16); p0 += __shfl_xor(p0, 32); p1 += __shfl_xor(p1, 16); p1 += __shfl_xor(p1, 32);
                if (fq == 0) { LAS float* d = LDS_F((rl0 + ai * 128 + m * 16) * 8 + wc * 2); d[0] = p0 * s2; d[1] = p1 * s2; } }
        asm volatile("s_waitcnt lgkmcnt(0)" ::: "memory"); __builtin_amdgcn_s_barrier(); asm volatile("" ::: "memory");
        if (kind == K_QUP) {
            bf16_t* const Q = (bf16_t*)out;
            const float2* const tab32 = (const float2*)(ws + WS_TAB32);
            const float C2 = 0.07216878364870323f * 1.4426950408889634f;
            f32x4 gn[2]; gn[0] = *(const f32x4*)(g_qn + cw); gn[1] = *(const f32x4*)(g_qn + cw + 4);
            const int ir = 16 * (wc & 1) + 4 * fq; const f32x4 gr1 = *(const f32x4*)(g_qr + ir), gr2 = *(const f32x4*)(g_qr + 32 + ir);
#pragma unroll
            for (int ai = 0; ai < 2; ++ai)
#pragma unroll
                for (int m = 0; m < 4; ++m) { const int row = rb + ai * 128 + m * 16; const int pos = row_pos(row < MT ? row : 0);
                    const LAS float* d = LDS_F((rl0 + ai * 128 + m * 16) * 8); const f32x4 e0 = *(const LAS f32x4*)d, e1 = *(const LAS f32x4*)(d + 4);
                    const float inn = rsqrtf((e0[0] + e0[2] + e1[0] + e1[2]) * (1.f / 128.f) + EPS) * rs[ai][m] * C2, inr = rsqrtf((e0[1] + e0[3]) * (1.f / 64.f) + EPS) * rs[ai][m];
                    bf16_t* qrow = Q + (size_t)row * 1536 + h * 192;
                    *(u32x4*)(qrow + cw) = pack8f(acc[ai][0][m][0] * inn * gn[0], acc[ai][0][m][1] * inn * gn[1]);
                    if (wc < 2) { const f32x4 y1 = acc[ai][1][m][0] * inr * gr1, y2 = acc[ai][1][m][1] * inr * gr2;
                        const f32x4 cs0 = *(const f32x4*)(tab32 + pos * 32 + ir), cs1 = *(const f32x4*)(tab32 + pos * 32 + ir + 2);
                        const f32x4 c = {cs0[0], cs0[2], cs1[0], cs1[2]}, s = {cs0[1], cs0[3], cs1[1], cs1[3]};
                        const f32x4 o1 = (y1 * c - y2 * s) * C2, o2 = (y1 * s + y2 * c) * C2;
                        u32x2 w1, w2; w1.x = cvt_pk_bf16(o1[0], o1[1]); w1.y = cvt_pk_bf16(o1[2], o1[3]); w2.x = cvt_pk_bf16(o2[0], o2[1]); w2.y = cvt_pk_bf16(o2[2], o2[3]);
                        *(u32x2*)(qrow + 128 + ir) = w1; *(u32x2*)(qrow + 160 + ir) = w2; } }
        } else {
            bf16_t* const KN = (bf16_t*)(ws + WS_KN); bf16_t* const V = (bf16_t*)(ws + WS_V);
            f32x4 gk[2]; gk[0] = *(const f32x4*)(g_kn + cw); gk[1] = *(const f32x4*)(g_kn + cw + 4);
#pragma unroll
            for (int ai = 0; ai < 2; ++ai)
#pragma unroll
                for (int m = 0; m < 4; ++m) { const int row = rb + ai * 128 + m * 16;
                    const LAS float* d = LDS_F((rl0 + ai * 128 + m * 16) * 8); const f32x4 e0 = *(const LAS f32x4*)d, e1 = *(const LAS f32x4*)(d + 4);
                    const float s = rs[ai][m], inn = rsqrtf((e0[0] + e0[2] + e1[0] + e1[2]) * (1.f / 128.f) + EPS) * s;
                    *(u32x4*)(KN + (size_t)row * 1024 + h * 128 + cw) = pack8f(acc[ai][0][m][0] * inn * gk[0], acc[ai][0][m][1] * inn * gk[1]);
                    *(u32x4*)(V + (size_t)row * 1024 + h * 128 + cw) = pack8f(acc[ai][1][m][0] * s, acc[ai][1][m][1] * s); }
        }
    }
};
__device__ __forceinline__ void p2_qkv(Frame& F, int sample) {
    SchedP2 S{F.x, F.j, (const char*)F.ws, sample};
    EpiP2 E{F.ws, F.out, FIN(10), FIN(11), FIN(14)};
    pg::gemm_stream(F.lds, S, E);
}

struct SchedP5 {
    int x, j, vcu; const char* ws; int phase;
    __device__ __forceinline__ const char* arow(size_t base, size_t base_s, int pm, size_t rowbytes) const { return ws + (pm < 64 ? base + (size_t)pm * 256 * rowbytes : base_s); }
    __device__ __forceinline__ bool next(int i, pg::UnitG& u) const {
        int pm, pn;
        if (phase == 5) {
            int sub;
            if (i < 4) { sub = i; pm = 8 * x + (j & 7); pn = j >> 3; } else if (i < 6 && j == 0 && x < 4) { sub = i == 4 ? 1 : 3; pm = 64; pn = x; } else return false;
            u.pm = pm; u.pn = pn; u.kind = K_GA + sub; u.lda = 2048; u.ldb = 2048; u.nt = 16; u.half = pm == 64;
            if (sub == 0) { u.A = ws + WS_XN2 + (size_t)pm * 256 * 2048; u.B = ws + WS_FWIN + (size_t)(18 + pn) * 256 * 2048; }
            else if (sub == 1) { u.A = arow(WS_ATT, WS_ATTS, pm, 2048); u.B = ws + WS_FWOBA + (size_t)pn * 256 * 2048; }
            else if (sub == 2) { u.A = ws + WS_XN2 + (size_t)pm * 256 * 2048; u.B = ws + WS_FWIN + (size_t)(22 + pn) * 256 * 2048; }
            else { u.A = ws + WS_RET + (size_t)pm * 256 * 2048; u.B = ws + WS_FWOBB + (size_t)pn * 256 * 2048; }
            return true;
        }
        if (phase == 6 || phase == 9) {
            if (i == 0) { pm = 8 * x + (j & 7); pn = j >> 3; } else if (i == 1 && j == 0 && x < 4) { pm = 64; pn = x; } else return false;
            u.pm = pm; u.pn = pn; u.half = pm == 64;
            if (phase == 6) { u.kind = K_OUT; u.A = ws + WS_MERGED + (size_t)pm * 256 * 2048; u.lda = 2048; u.B = ws + WS_FWOUT + (size_t)pn * 256 * 2048; u.ldb = 2048; u.nt = 16; }
            else { u.kind = K_DOWN; u.A = ws + WS_U + (size_t)pm * 256 * (FF2 * 2); u.lda = FF2 * 2; u.B = ws + WS_FWDOWN + (size_t)pn * 256 * (D_FF * 2); u.ldb = D_FF * 2; u.nt = 44; }
            return true;
        }
        if (!reg_unit(x, j, i, 22, pm, pn)) { if (i == 5 && j >= 16) { const int k = (j - 16) * 8 + x; if (k >= 22) return false; pm = 64; pn = k; } else return false; }
        u.half = pm == 64; u.pm = pm; u.pn = pn; u.kind = K_UP; u.A = ws + WS_X1B + (size_t)pm * 256 * 2048; u.lda = 2048; u.B = ws + WS_FWUP + (size_t)pn * 256 * 2048; u.ldb = 2048; u.nt = 16;
        return true;
    }
};
struct EpiP5 {
    unsigned char* ws; float* out; const float* xp; const float* xs; int vcu;
    __device__ __forceinline__ void operator()(pg::Acc& acc, const pg::UnitG& u, LAS unsigned char* lds, int wr, int wc, int fr, int fq) const {
        int rl0 = wr * 64 + fr, cw = wc * 32 + fq * 8; asm volatile("" : "+v"(rl0), "+v"(cw));
        const int kind = u.kind, rb = u.pm * 256 + rl0;
        if (kind >= K_GA && kind <= K_RD) {
            bf16_t* const T1 = (bf16_t*)(ws + WS_T1) + (size_t)vcu * 65536; bf16_t* const T2 = (bf16_t*)out + (size_t)vcu * 65536;
            bf16_t* const MG = (bf16_t*)(ws + WS_MERGED);
#pragma unroll
            for (int ai = 0; ai < 2; ++ai)
#pragma unroll
                for (int m = 0; m < 4; ++m)
#pragma unroll
                    for (int bj = 0; bj < 2; ++bj) { const size_t so = (size_t)(rl0 + ai * 128 + m * 16) * 256 + bj * 128 + cw;
                        f32x4 v0 = acc[ai][bj][m][0], v1 = acc[ai][bj][m][1];
                        if (kind == K_GA || kind == K_GB) {
#pragma unroll
                            for (int e = 0; e < 4; ++e) { v0[e] = 1.f / (1.f + __expf(-v0[e])); v1[e] = 1.f / (1.f + __expf(-v1[e])); }
                            *(u32x4*)((kind == K_GA ? T1 : T2) + so) = pack8f(v0, v1);
                        } else if (kind == K_AD) {
                            const u32x4 t = u.pm == 64 ? *(const u32x4*)((const bf16_t*)(ws + WS_GAS) + (size_t)(rl0 + ai * 128 + m * 16) * 1024 + u.pn * 256 + bj * 128 + cw) : *(const u32x4*)(T1 + so);
                            const f32x4 g0 = {__uint_as_float(t.x << 16), __uint_as_float(t.x & 0xffff0000u), __uint_as_float(t.y << 16), __uint_as_float(t.y & 0xffff0000u)};
                            const f32x4 g1 = {__uint_as_float(t.z << 16), __uint_as_float(t.z & 0xffff0000u), __uint_as_float(t.w << 16), __uint_as_float(t.w & 0xffff0000u)};
                            *(u32x4*)(T1 + so) = pack8f(v0 * g0, v1 * g1);
                        } else {
                            const u32x4 t = *(const u32x4*)(T1 + so), q = u.pm == 64 ? *(const u32x4*)((const bf16_t*)(ws + WS_GBS) + (size_t)(rl0 + ai * 128 + m * 16) * 1024 + u.pn * 256 + bj * 128 + cw) : *(const u32x4*)(T2 + so);
                            const f32x4 a0 = {__uint_as_float(t.x << 16), __uint_as_float(t.x & 0xffff0000u), __uint_as_float(t.y << 16), __uint_as_float(t.y & 0xffff0000u)};
                            const f32x4 a1 = {__uint_as_float(t.z << 16), __uint_as_float(t.z & 0xffff0000u), __uint_as_float(t.w << 16), __uint_as_float(t.w & 0xffff0000u)};
                            const f32x4 g0 = {__uint_as_float(q.x << 16), __uint_as_float(q.x & 0xffff0000u), __uint_as_float(q.y << 16), __uint_as_float(q.y & 0xffff0000u)};
                            const f32x4 g1 = {__uint_as_float(q.z << 16), __uint_as_float(q.z & 0xffff0000u), __uint_as_float(q.w << 16), __uint_as_float(q.w & 0xffff0000u)};
                            *(u32x4*)(MG + (size_t)(rb + ai * 128 + m * 16) * 1024 + u.pn * 256 + bj * 128 + cw) = pack8f(a0 + v0 * g0, a1 + v1 * g1);
                        }
                        if (bj == 1 && (m & 1)) asm volatile("" ::: "memory"); }
        } else if (kind == K_OUT) {
            float* const slotx = (float*)(ws + WS_SLOTX1); bf16_t* const X1B = (bf16_t*)(ws + WS_X1B);
#pragma unroll
            for (int ai = 0; ai < 2; ++ai)
#pragma unroll
                for (int m = 0; m < 4; ++m) { const int row = rb + ai * 128 + m * 16; float ss = 0.f;
                    const float* xr = row < MP ? xp + (size_t)row * D_MODEL : xs + (size_t)((row < MT ? row : MP) - MP) * D_MODEL;
#pragma unroll
                    for (int bj = 0; bj < 2; ++bj) { const int c = u.pn * 256 + bj * 128 + cw;
                        const f32x4 x0 = *(const f32x4*)(xr + c), x1 = *(const f32x4*)(xr + c + 4);
                        const f32x4 v0 = acc[ai][bj][m][0] + x0, v1 = acc[ai][bj][m][1] + x1;
                        ss += (v0[0] * v0[0] + v0[1] * v0[1]) + (v0[2] * v0[2] + v0[3] * v0[3]) + (v1[0] * v1[0] + v1[1] * v1[1]) + (v1[2] * v1[2] + v1[3] * v1[3]);
                        if (row < MT) { *(f32x4*)(out + (size_t)row * D_MODEL + c) = v0; *(f32x4*)(out + (size_t)row * D_MODEL + c + 4) = v1; }
                        *(u32x4*)(X1B + (size_t)row * D_MODEL + c) = pack8f(v0, v1); }
                    ss += __shfl_xor(ss, 16); ss += __shfl_xor(ss, 32);
                    if (fq == 0) slotx[(size_t)row * 16 + u.pn * 4 + wc] = ss;
                    asm volatile("" ::: "memory"); }
        } else if (kind == K_UP) {
            const float* const slotx = (const float*)(ws + WS_SLOTX1); bf16_t* const U = (bf16_t*)(ws + WS_U);
#pragma unroll
            for (int ai = 0; ai < 2; ++ai)
#pragma unroll
                for (int m = 0; m < 4; ++m) { const int row = rb + ai * 128 + m * 16;
                    float a = 0.f;
#pragma unroll
                    for (int i = 0; i < 16; i += 4) { const f32x4 v = *(const f32x4*)(slotx + (size_t)row * 16 + i); a += (v[0] + v[1]) + (v[2] + v[3]); }
                    const float s = rsqrtf(a * (1.f / D_MODEL) + EPS);
                    const f32x4 ug0 = acc[ai][0][m][0] * s, ug1 = acc[ai][0][m][1] * s, uv0 = acc[ai][1][m][0] * s, uv1 = acc[ai][1][m][1] * s;
                    const u32x4 wg = pack8f(ug0, ug1), wv = pack8f(uv0, uv1); const int cg = u.pn * 128 + cw, cv = D_FF + cg;
                    *(u32x4*)(U + (size_t)row * FF2 + cg) = wg; *(u32x4*)(U + (size_t)row * FF2 + cv) = wv;
                    if ((row & 255) >= 254 && row < MP - 2) { bf16_t* hp = (bf16_t*)(ws + WS_HALO) + ((size_t)((row >> 8) + 1) * 2 + (row & 1)) * FF2; *(u32x4*)(hp + cg) = wg; *(u32x4*)(hp + cv) = wv; }
                    if (row < MT) { const int tpos = row < MP ? (row & (SEQ - 1)) - (SEQ - 2) : ((row - MP) & (DEC_SEQ - 1)) - (DEC_SEQ - 2);
                        if (tpos >= 0) { float* cp = row < MP ? out + O_CONVP + ((size_t)(row >> 13) * 2 + tpos) * FF2 : out + O_CONVS + ((size_t)((row - MP) >> 4) * 2 + tpos) * FF2;
                            *(f32x4*)(cp + cg) = ug0; *(f32x4*)(cp + cg + 4) = ug1; *(f32x4*)(cp + cv) = uv0; *(f32x4*)(cp + cv + 4) = uv1; } }
                    if (m & 1) asm volatile("" ::: "memory"); }
        } else {
#pragma unroll
            for (int ai = 0; ai < 2; ++ai)
#pragma unroll
                for (int m = 0; m < 4; ++m) { const int row = rb + ai * 128 + m * 16; if (row >= MT) continue;
#pragma unroll
                    for (int bj = 0; bj < 2; ++bj) { float* p = out + (size_t)row * D_MODEL + u.pn * 256 + bj * 128 + cw;
                        const f32x4 x0 = *(const f32x4*)p, x1 = *(const f32x4*)(p + 4);
                        *(f32x4*)p = x0 + acc[ai][bj][m][0]; *(f32x4*)(p + 4) = x1 + acc[ai][bj][m][1]; }
                    asm volatile("" ::: "memory"); }
        }
    }
};
__device__ __forceinline__ void p5_gemm(Frame& F, int phase) {
    SchedP5 S{F.x, F.j, F.vcu, (const char*)F.ws, phase};
    EpiP5 E{F.ws, F.out, FIN(0), FIN(1), F.vcu};
    pg::gemm_stream(F.lds, S, E);
}

namespace rt {
typedef short s16x4 __attribute__((ext_vector_type(4)));
constexpr int QST = 136, KDST = 144, VST = 272, PST = 72;
constexpr int Q_OFF = 0, QS_OFF = 17408, K_OFF = 34816, KD_OFF = 52224, V_OFF = 70656, P_OFF = 105472, ST_OFF = 114688;
constexpr int SC_TOK = 256, NSC = SEQ / SC_TOK;
__device__ __forceinline__ s16x4 trrd(const LAS bf16_t* p) { return __builtin_bit_cast(s16x4, __builtin_amdgcn_ds_read_tr16_b64_v4i16((LAS s16x4*)p)); }
__device__ __forceinline__ bf16x8 cat8(s16x4 lo, s16x4 hi) { return (bf16x8){lo[0], lo[1], lo[2], lo[3], hi[0], hi[1], hi[2], hi[3]}; }
__device__ __forceinline__ u32x4 scale8(u32x4 w, float s) {
    u32x4 o;
    o.x = cvt_pk_bf16(__uint_as_float(w.x << 16) * s, __uint_as_float(w.x & 0xffff0000u) * s); o.y = cvt_pk_bf16(__uint_as_float(w.y << 16) * s, __uint_as_float(w.y & 0xffff0000u) * s);
    o.z = cvt_pk_bf16(__uint_as_float(w.z << 16) * s, __uint_as_float(w.z & 0xffff0000u) * s); o.w = cvt_pk_bf16(__uint_as_float(w.w << 16) * s, __uint_as_float(w.w & 0xffff0000u) * s);
    return o;
}
template <bool FULL>
__device__ __forceinline__ void ret_unit(Frame& F, int h, int row0, int nch, int L, const float* Sin, float* Sout, const float* g_ret) {
    LAS unsigned char* lds = F.lds;
    const int tid = F.tid, w = F.wave, l = F.lane, fr = l & 15, g = l >> 4, tq = fr >> 2, tp = fr & 3;
    const float lg2 = log2f(1.f - exp2f(-5.f - (float)h));
    const bf16_t* RQ = (const bf16_t*)(F.ws + WS_RQ); const bf16_t* RK = (const bf16_t*)(F.ws + WS_RK); const bf16_t* RV = (const bf16_t*)(F.ws + WS_RV);
    const bf16_t* RG = (const bf16_t*)(F.ws + WS_RG); bf16_t* RET = (bf16_t*)(F.ws + WS_RET);
    LAS bf16_t* q_l = (LAS bf16_t*)(lds + Q_OFF); LAS bf16_t* qs_l = (LAS bf16_t*)(lds + QS_OFF); LAS bf16_t* k_l = (LAS bf16_t*)(lds + K_OFF);
    LAS bf16_t* kd_l = (LAS bf16_t*)(lds + KD_OFF); LAS bf16_t* v_l = (LAS bf16_t*)(lds + V_OFF); LAS bf16_t* p_l = (LAS bf16_t*)(lds + P_OFF); LAS float* st_l = (LAS float*)(lds + ST_OFF);
    f32x4 S[8][2];
#pragma unroll
    for (int db = 0; db < 8; ++db)
#pragma unroll
        for (int nb = 0; nb < 2; ++nb) {
            if (Sin) {
#pragma unroll
                for (int r = 0; r < 4; ++r) S[db][nb][r] = Sin[(size_t)(16 * db + 4 * g + r) * RET_DV + 32 * w + 16 * nb + fr]; }
            else S[db][nb] = (f32x4){0.f, 0.f, 0.f, 0.f}; }
    const float gL = exp2f(lg2 * (float)L);
    for (int c = 0; c < nch; ++c) {
        const size_t r0 = (size_t)row0 + (size_t)c * L;
        __syncthreads();
#pragma unroll
        for (int it = 0; it < 2; ++it) { const int idx = tid + 512 * it, tok = idx >> 4, c8 = idx & 15; const bool ok = tok < L;
            u32x4 kk = {0u, 0u, 0u, 0u}, qq = {0u, 0u, 0u, 0u};
            if (ok) { kk = *(const u32x4*)(RK + (r0 + tok) * 512 + h * 128 + c8 * 8); if (FULL) qq = *(const u32x4*)(RQ + (r0 + tok) * 512 + h * 128 + c8 * 8); }
            *(LAS u32x4*)(kd_l + tok * KDST + c8 * 8) = scale8(kk, exp2f(lg2 * (float)(L - 1 - tok)));
            if (FULL) { *(LAS u32x4*)(k_l + tok * QST + c8 * 8) = kk; *(LAS u32x4*)(q_l + tok * QST + c8 * 8) = qq; *(LAS u32x4*)(qs_l + tok * QST + c8 * 8) = scale8(qq, exp2f(lg2 * (float)(tok + 1))); } }
#pragma unroll
        for (int it = 0; it < 4; ++it) { const int idx = tid + 512 * it, tok = idx >> 5, c8 = idx & 31; u32x4 vv = {0u, 0u, 0u, 0u};
            if (tok < L) vv = *(const u32x4*)(RV + (r0 + tok) * 1024 + h * 256 + c8 * 8);
            *(LAS u32x4*)(v_l + tok * VST + c8 * 8) = vv; }
        __syncthreads();
        f32x4 o[4][2];
        if (FULL) {
            const int ib = w >> 1, jb0 = 2 * (w & 1);
            f32x4 p0 = {0.f, 0.f, 0.f, 0.f}, p1 = {0.f, 0.f, 0.f, 0.f};
#pragma unroll
            for (int s = 0; s < 4; ++s) { const bf16x8 a = *(const LAS bf16x8*)(q_l + (16 * ib + fr) * QST + 32 * s + 8 * g);
                const bf16x8 b0 = *(const LAS bf16x8*)(k_l + (16 * jb0 + fr) * QST + 32 * s + 8 * g), b1 = *(const LAS bf16x8*)(k_l + (16 * jb0 + 16 + fr) * QST + 32 * s + 8 * g);
                p0 = __builtin_amdgcn_mfma_f32_16x16x32_bf16(a, b0, p0, 0, 0, 0); p1 = __builtin_amdgcn_mfma_f32_16x16x32_bf16(a, b1, p1, 0, 0, 0); }
#pragma unroll
            for (int r = 0; r < 4; ++r) { const int i = 16 * ib + 4 * g + r, j0 = 16 * jb0 + fr, j1 = j0 + 16;
                const float v0 = j0 <= i ? p0[r] * exp2f(lg2 * (float)(i - j0)) : 0.f, v1 = j1 <= i ? p1[r] * exp2f(lg2 * (float)(i - j1)) : 0.f;
                p_l[i * PST + j0] = f2bf(v0); p_l[i * PST + j1] = f2bf(v1); }
            __syncthreads();
#pragma unroll
            for (int i = 0; i < 4; ++i) { o[i][0] = (f32x4){0.f, 0.f, 0.f, 0.f}; o[i][1] = (f32x4){0.f, 0.f, 0.f, 0.f}; }
        }
        bf16x8 vf[2][2];
#pragma unroll
        for (int s = 0; s < 2; ++s)
#pragma unroll
            for (int nb = 0; nb < 2; ++nb) { const LAS bf16_t* p = v_l + (32 * s + 8 * g + tq) * VST + 32 * w + 16 * nb + 4 * tp; vf[s][nb] = cat8(trrd(p), trrd(p + 4 * VST)); }
        if (FULL) {
#pragma unroll
            for (int i = 0; i < 4; ++i)
#pragma unroll
                for (int s = 0; s < 2; ++s) { const bf16x8 a = *(const LAS bf16x8*)(p_l + (16 * i + fr) * PST + 32 * s + 8 * g);
                    o[i][0] = __builtin_amdgcn_mfma_f32_16x16x32_bf16(a, vf[s][0], o[i][0], 0, 0, 0); o[i][1] = __builtin_amdgcn_mfma_f32_16x16x32_bf16(a, vf[s][1], o[i][1], 0, 0, 0); }
#pragma unroll
            for (int s = 0; s < 4; ++s) {
                bf16x8 bS[2];
#pragma unroll
                for (int nb = 0; nb < 2; ++nb) { u32x4 wv; wv.x = cvt_pk_bf16(S[2 * s][nb][0], S[2 * s][nb][1]); wv.y = cvt_pk_bf16(S[2 * s][nb][2], S[2 * s][nb][3]);
                    wv.z = cvt_pk_bf16(S[2 * s + 1][nb][0], S[2 * s + 1][nb][1]); wv.w = cvt_pk_bf16(S[2 * s + 1][nb][2], S[2 * s + 1][nb][3]); bS[nb] = __builtin_bit_cast(bf16x8, wv); }
#pragma unroll
                for (int i = 0; i < 4; ++i) { const LAS bf16_t* qp = qs_l + (16 * i + fr) * QST + 32 * s + 4 * g;
                    const s16x4 lo = *(const LAS s16x4*)qp, hi = *(const LAS s16x4*)(qp + 16); const bf16x8 a = cat8(lo, hi);
                    o[i][0] = __builtin_amdgcn_mfma_f32_16x16x32_bf16(a, bS[0], o[i][0], 0, 0, 0); o[i][1] = __builtin_amdgcn_mfma_f32_16x16x32_bf16(a, bS[1], o[i][1], 0, 0, 0); }
            }
        }
#pragma unroll
        for (int db = 0; db < 8; ++db) { S[db][0] = S[db][0] * gL; S[db][1] = S[db][1] * gL; }
#pragma unroll
        for (int s = 0; s < 2; ++s)
#pragma unroll
            for (int db = 0; db < 8; ++db) { const LAS bf16_t* p = kd_l + (32 * s + 8 * g + tq) * KDST + 16 * db + 4 * tp; const bf16x8 a = cat8(trrd(p), trrd(p + 4 * KDST));
                S[db][0] = __builtin_amdgcn_mfma_f32_16x16x32_bf16(a, vf[s][0], S[db][0], 0, 0, 0); S[db][1] = __builtin_amdgcn_mfma_f32_16x16x32_bf16(a, vf[s][1], S[db][1], 0, 0, 0); }
        if (FULL) {
#pragma unroll
            for (int i = 0; i < 4; ++i)
#pragma unroll
                for (int r = 0; r < 4; ++r) { float sm = o[i][0][r] + o[i][1][r], sq = o[i][0][r] * o[i][0][r] + o[i][1][r] * o[i][1][r];
                    sm += __shfl_xor(sm, 1); sq += __shfl_xor(sq, 1); sm += __shfl_xor(sm, 2); sq += __shfl_xor(sq, 2); sm += __shfl_xor(sm, 4); sq += __shfl_xor(sq, 4); sm += __shfl_xor(sm, 8); sq += __shfl_xor(sq, 8);
                    if (fr == 0) { LAS float* d = st_l + ((16 * i + 4 * g + r) * 8 + w) * 2; d[0] = sm; d[1] = sq; } }
            __syncthreads();
#pragma unroll
            for (int i = 0; i < 4; ++i)
#pragma unroll
                for (int r = 0; r < 4; ++r) { const int tok = 16 * i + 4 * g + r; if (tok >= L) continue;
                    const LAS f32x4* d = (const LAS f32x4*)(st_l + tok * 16); const f32x4 a0 = d[0], a1 = d[1], a2 = d[2], a3 = d[3];
                    const float sm = (a0[0] + a0[2]) + (a1[0] + a1[2]) + (a2[0] + a2[2]) + (a3[0] + a3[2]), sq = (a0[1] + a0[3]) + (a1[1] + a1[3]) + (a2[1] + a2[3]) + (a3[1] + a3[3]);
                    const float mu = sm * (1.f / 256.f), var = fmaxf(sq * (1.f / 256.f) - mu * mu, 0.f), rstd = rsqrtf(var + EPS);
#pragma unroll
                    for (int nb = 0; nb < 2; ++nb) { const int col = h * 256 + 32 * w + 16 * nb + fr; const size_t gi = (r0 + tok) * 1024 + col;
                        RET[gi] = f2bf((o[i][nb][r] - mu) * rstd * g_ret[col] * bf2f(RG[gi])); } }
        }
    }
    if (Sout) {
#pragma unroll
        for (int db = 0; db < 8; ++db)
#pragma unroll
            for (int nb = 0; nb < 2; ++nb)
#pragma unroll
                for (int r = 0; r < 4; ++r) Sout[(size_t)(16 * db + 4 * g + r) * RET_DV + 32 * w + 16 * nb + fr] = S[db][nb][r];
    }
}
}
__device__ __forceinline__ void r1_states(Frame& F) {
    const int bh = F.vcu >> 5, sc = F.vcu & 31, b = bh >> 2, h = bh & 3;
    rt::ret_unit<false>(F, h, b * SEQ + sc * rt::SC_TOK, 4, 64, nullptr, F.out + ((size_t)bh * rt::NSC + sc) * 32768, nullptr);
}
__device__ __forceinline__ void r2_scan(Frame& F) {
    float* U = F.out; const int gt = F.vcu * NTHR + F.tid;
    for (int e = gt; e < 8 * 32768; e += F.G * NTHR) { const int bh = e >> 15, idx = e & 32767, h = bh & 3;
        const float g256 = exp2f(log2f(1.f - exp2f(-5.f - (float)h)) * 256.f);
        float u[32];
#pragma unroll
        for (int sc = 0; sc < 32; ++sc) u[sc] = U[((size_t)bh * 32 + sc) * 32768 + idx];
        float carry = 0.f;
#pragma unroll
        for (int sc = 0; sc < 32; ++sc) { U[((size_t)bh * 32 + sc) * 32768 + idx] = carry; carry = g256 * carry + u[sc]; }
        F.out[O_RETP + (size_t)bh * 32768 + idx] = carry; }
}
__device__ __forceinline__ void r3_outputs(Frame& F) {
    const int bh = F.vcu >> 5, sc = F.vcu & 31, b = bh >> 2, h = bh & 3;
    rt::ret_unit<true>(F, h, b * SEQ + sc * rt::SC_TOK, 4, 64, F.out + ((size_t)bh * rt::NSC + sc) * 32768, nullptr, FIN(16));
    if (F.vcu < DEC_BATCH * RET_H) { const int sb = F.vcu >> 2, sh = F.vcu & 3;
        rt::ret_unit<true>(F, sh, MP + sb * DEC_SEQ, 1, DEC_SEQ, FIN(4) + (size_t)F.vcu * 32768, F.out + O_RETS + (size_t)F.vcu * 32768, FIN(16)); }
}

namespace at {
typedef float f32x16 __attribute__((ext_vector_type(16)));
typedef short s16x4 __attribute__((ext_vector_type(4)));
constexpr int KN_ST = 272, KP_ST = 144;
constexpr int KN_B = 64 * KN_ST, KP_B = 64 * KP_ST, V_B = 16384, BUF_B = KN_B + KP_B + V_B;
constexpr int SCR_OFF = 2 * BUF_B;
constexpr float THR = 8.f;
__device__ __forceinline__ int v_st(int k, int c) { const int kk = (k & ~0xC) | ((k & 4) << 1) | ((k & 8) >> 1); return ((kk >> 3) * 4 + (c >> 5)) * 512 + ((kk & 7) * 32 + (c & 31)) * 2; }
__device__ __forceinline__ int v_rd_base(int lane) { return ((lane & 3) << 3) | (((lane >> 2) & 3) << 6) | (((lane >> 4) & 1) << 5) | (((lane >> 5) & 1) << 8); }
constexpr int v_rd_off(int d0, int ks, int half) { return d0 * 512 + ks * 4096 + half * 2048; }
__device__ __forceinline__ int crow(int r, int hi) { return (r & 3) + 8 * (r >> 2) + 4 * hi; }
#define AT_SBAR() __builtin_amdgcn_sched_barrier(0)

__device__ __forceinline__ void qkt(f32x16& p0, f32x16& p1, const LAS unsigned char* kn, const LAS unsigned char* kp, const bf16x8* qr) {
    p0 = f32x16{}; p1 = f32x16{};
#pragma unroll
    for (int d0 = 0; d0 < 8; ++d0) { const bf16x8 a0 = *(const LAS bf16x8*)(kn + d0 * 32), a1 = *(const LAS bf16x8*)(kn + d0 * 32 + 32 * KN_ST);
        p0 = __builtin_amdgcn_mfma_f32_32x32x16_bf16(a0, qr[d0], p0, 0, 0, 0); p1 = __builtin_amdgcn_mfma_f32_32x32x16_bf16(a1, qr[d0], p1, 0, 0, 0); }
#pragma unroll
    for (int d0 = 0; d0 < 4; ++d0) { const bf16x8 a0 = *(const LAS bf16x8*)(kp + d0 * 32), a1 = *(const LAS bf16x8*)(kp + d0 * 32 + 32 * KP_ST);
        p0 = __builtin_amdgcn_mfma_f32_32x32x16_bf16(a0, qr[8 + d0], p0, 0, 0, 0); p1 = __builtin_amdgcn_mfma_f32_32x32x16_bf16(a1, qr[8 + d0], p1, 0, 0, 0); }
}
__device__ __forceinline__ void pv_tile(f32x16* o, int vb0, bf16x8 pa0, bf16x8 pa1, bf16x8 pa2, bf16x8 pa3) {
#define AT_TRRD(dst, off) asm volatile("ds_read_b64_tr_b16 %0, %1 offset:%2" : "=&v"(dst) : "v"(vb0), "i"(off) : "memory")
#define AT_PV_D0(d0) do { s16x4 l0, l1, l2, l3, h0, h1, h2, h3; constexpr int b_ = v_rd_off(d0, 0, 0);   \
        AT_TRRD(l0, b_); AT_TRRD(h0, b_ + 2048); AT_TRRD(l1, b_ + 4096); AT_TRRD(h1, b_ + 6144); AT_TRRD(l2, b_ + 8192); AT_TRRD(h2, b_ + 10240); AT_TRRD(l3, b_ + 12288); AT_TRRD(h3, b_ + 14336); \
        asm volatile("s_waitcnt lgkmcnt(0)" ::: "memory"); AT_SBAR();   \
        o[d0] = __builtin_amdgcn_mfma_f32_32x32x16_bf16(pa0, (bf16x8){l0[0], l0[1], l0[2], l0[3], h0[0], h0[1], h0[2], h0[3]}, o[d0], 0, 0, 0);   \
        o[d0] = __builtin_amdgcn_mfma_f32_32x32x16_bf16(pa1, (bf16x8){l1[0], l1[1], l1[2], l1[3], h1[0], h1[1], h1[2], h1[3]}, o[d0], 0, 0, 0);   \
        o[d0] = __builtin_amdgcn_mfma_f32_32x32x16_bf16(pa2, (bf16x8){l2[0], l2[1], l2[2], l2[3], h2[0], h2[1], h2[2], h2[3]}, o[d0], 0, 0, 0);   \
        o[d0] = __builtin_amdgcn_mfma_f32_32x32x16_bf16(pa3, (bf16x8){l3[0], l3[1], l3[2], l3[3], h3[0], h3[1], h3[2], h3[3]}, o[d0], 0, 0, 0); } while (0)
    AT_PV_D0(0); AT_PV_D0(1); AT_PV_D0(2); AT_PV_D0(3);
#undef AT_PV_D0
#undef AT_TRRD
}
template <bool PARTIAL>
__device__ __forceinline__ void attn_unit(LAS unsigned char* lds, const bf16_t* Qw, const bf16_t* KN, const bf16_t* KPE, const bf16_t* V, bf16_t* Ow, float* Pw, int NT, int tmax_w, int nkeys, int orows, int t0, int tstride) {
    const int tid = threadIdx.x, wid = __builtin_amdgcn_readfirstlane(tid >> 6), lane = tid & 63, r32 = lane & 31, hi = lane >> 5;
    bf16x8 qr[12];
#pragma unroll
    for (int d0 = 0; d0 < 12; ++d0) qr[d0] = *(const bf16x8*)(Qw + (size_t)r32 * 1536 + d0 * 16 + hi * 8);
    const int sr = tid >> 4, sc = (tid & 15) * 8, pr = tid >> 3, pc = (tid & 7) * 8;
    const int kn_w0 = sr * KN_ST + sc * 2, kn_w1 = (32 + sr) * KN_ST + sc * 2, kp_w = KN_B + pr * KP_ST + pc * 2, v_w0 = KN_B + KP_B + v_st(sr, sc), v_w1 = KN_B + KP_B + v_st(32 + sr, sc);
    const int kn_r = r32 * KN_ST + hi * 16, kp_r = KN_B + r32 * KP_ST + hi * 16;
    const int vb_base = (int)(unsigned)(uintptr_t)(lds + KN_B + KP_B) + v_rd_base(lane);
    LAS float* scr = (LAS float*)(lds + SCR_OFF) + wid * 64;
    float m_reg = -1e30f, l_reg = 0.f; f32x16 o[4] = {};
    u32x4 st_kn0, st_kn1, st_kp, st_v0, st_v1;
#define AT_LOAD(t) do { const size_t k0_ = (size_t)(t0 + (t) * tstride) * 64; const bool v0_ = (int)k0_ + sr < nkeys, v1_ = (int)k0_ + 32 + sr < nkeys, vp_ = (int)k0_ + pr < nkeys; const u32x4 z_ = {0u, 0u, 0u, 0u}; \
        st_kn0 = v0_ ? *(const u32x4*)(KN + (k0_ + sr) * 1024 + sc) : z_; st_kn1 = v1_ ? *(const u32x4*)(KN + (k0_ + 32 + sr) * 1024 + sc) : z_; \
        st_v0 = v0_ ? *(const u32x4*)(V + (k0_ + sr) * 1024 + sc) : z_; st_v1 = v1_ ? *(const u32x4*)(V + (k0_ + 32 + sr) * 1024 + sc) : z_; \
        st_kp = vp_ ? *(const u32x4*)(KPE + (k0_ + pr) * 64 + pc) : z_; } while (0)
#define AT_WRITE(bf) do { LAS unsigned char* b_ = lds + (bf) * BUF_B; *(LAS u32x4*)(b_ + kn_w0) = st_kn0; *(LAS u32x4*)(b_ + kn_w1) = st_kn1; *(LAS u32x4*)(b_ + kp_w) = st_kp; \
        *(LAS u32x4*)(b_ + v_w0) = st_v0; *(LAS u32x4*)(b_ + v_w1) = st_v1; } while (0)
    AT_LOAD(0); AT_WRITE(0);
    __syncthreads();
    for (int t = 0; t < NT; ++t) {
        const int bf = t & 1;
        if (t + 1 < NT) AT_LOAD(t + 1);
        if (t <= tmax_w) {
            f32x16 p0, p1;
            const LAS unsigned char* bb = lds + bf * BUF_B;
            qkt(p0, p1, bb + kn_r, bb + kp_r, qr);
            if ((t0 + t * tstride + 1) * 64 > nkeys) {
                const int kb = (t0 + t * tstride) * 64 + 4 * hi;
#pragma unroll
                for (int r = 0; r < 16; ++r) { const int kv = kb + (r & 3) + 8 * (r >> 2); if (kv >= nkeys) p0[r] = -INFINITY; if (kv + 32 >= nkeys) p1[r] = -INFINITY; } }
            float pmax = p0[0];
#pragma unroll
            for (int r = 1; r < 16; ++r) pmax = fmaxf(pmax, p0[r]);
#pragma unroll
            for (int r = 0; r < 16; ++r) pmax = fmaxf(pmax, p1[r]);
            { auto rr = __builtin_amdgcn_permlane32_swap(__float_as_uint(pmax), __float_as_uint(pmax), false, false); pmax = fmaxf(__uint_as_float(rr[0]), __uint_as_float(rr[1])); }
            float alpha = 1.f; bool resc = false;
            if (!__all(pmax - m_reg <= THR)) { const float mn = fmaxf(m_reg, pmax); alpha = __builtin_amdgcn_exp2f(m_reg - mn); m_reg = mn; resc = true; }
#pragma unroll
            for (int r = 0; r < 16; ++r) { p0[r] = __builtin_amdgcn_exp2f(p0[r] - m_reg); p1[r] = __builtin_amdgcn_exp2f(p1[r] - m_reg); }
            float ps = 0.f;
#pragma unroll
            for (int r = 0; r < 16; ++r) ps += p0[r] + p1[r];
            { auto rr = __builtin_amdgcn_permlane32_swap(__float_as_uint(ps), __float_as_uint(ps), false, false); ps = __uint_as_float(rr[0]) + __uint_as_float(rr[1]); }
            l_reg = l_reg * alpha + ps;
            bf16x8 pa0, pa1, pa2, pa3;
#define AT_PK4(P, B_, OUT) do { unsigned a0 = cvt_pk_bf16(P[B_ + 0], P[B_ + 1]), a1 = cvt_pk_bf16(P[B_ + 2], P[B_ + 3]); unsigned b0 = cvt_pk_bf16(P[B_ + 4], P[B_ + 5]), b1 = cvt_pk_bf16(P[B_ + 6], P[B_ + 7]); \
        auto r0 = __builtin_amdgcn_permlane32_swap(a0, b0, false, false); auto r1 = __builtin_amdgcn_permlane32_swap(a1, b1, false, false); \
        u32x4 w_ = {r0[0], r1[0], r0[1], r1[1]}; OUT = __builtin_bit_cast(bf16x8, w_); } while (0)
            AT_PK4(p0, 0, pa0); AT_PK4(p0, 8, pa1); AT_PK4(p1, 0, pa2); AT_PK4(p1, 8, pa3);
#undef AT_PK4
            if (resc) { if (hi == 0) scr[r32] = alpha; asm volatile("s_waitcnt lgkmcnt(0)" ::: "memory");
#pragma unroll
                for (int d_ = 0; d_ < 4; ++d_)
#pragma unroll
                    for (int r = 0; r < 16; ++r) o[d_][r] *= scr[crow(r, hi)]; }
            AT_SBAR();
            pv_tile(o, vb_base + bf * BUF_B, pa0, pa1, pa2, pa3);
        }
        if (t + 1 < NT) AT_WRITE(bf ^ 1);
        __syncthreads();
    }
    if (PARTIAL) {
        if (wid == 0) {
#pragma unroll
            for (int r = 0; r < 16; ++r) { const int orow = crow(r, hi); if (orow < orows) {
#pragma unroll
                for (int d0 = 0; d0 < 4; ++d0) Pw[orow * 132 + d0 * 32 + r32] = o[d0][r]; } }
            if (hi == 0 && r32 < orows) { Pw[r32 * 132 + 128] = m_reg; Pw[r32 * 132 + 129] = l_reg; } }
        __syncthreads();
        return;
    }
    if (hi == 0) scr[32 + r32] = l_reg; asm volatile("s_waitcnt lgkmcnt(0)" ::: "memory");
#pragma unroll
    for (int r = 0; r < 16; ++r) { const int orow = crow(r, hi); const float rl = __builtin_amdgcn_rcpf(scr[32 + orow]);
#pragma unroll
        for (int d0 = 0; d0 < 4; ++d0) { const float v = o[d0][r] * rl; const float vn = __shfl_xor(v, 1);
            if ((r32 & 1) == 0 && orow < orows) *(unsigned*)(Ow + (size_t)orow * 1024 + d0 * 32 + r32) = cvt_pk_bf16(v, vn); } }
    __syncthreads();
#undef AT_LOAD
#undef AT_WRITE
}
#undef AT_SBAR
}
__device__ __forceinline__ void p3_attn_prompt(Frame& F) {
    const int bh = F.vcu >> 4, s = F.vcu & 15, b = bh >> 3, h = bh & 7;
    const bf16_t* Q = (const bf16_t*)F.out; const bf16_t* KN = (const bf16_t*)(F.ws + WS_KN); const bf16_t* KPE = (const bf16_t*)(F.ws + WS_KPE); const bf16_t* V = (const bf16_t*)(F.ws + WS_V); bf16_t* ATT = (bf16_t*)(F.ws + WS_ATT);
#pragma unroll 1
    for (int it = 0; it < 2; ++it) { const int qb = it == 0 ? s : 31 - s; const size_t row0 = (size_t)b * SEQ + (size_t)qb * 256 + F.wave * 32;
        at::attn_unit<false>(F.lds, Q + row0 * 1536 + h * 192, KN + (size_t)b * SEQ * 1024 + h * 128, KPE + (size_t)b * SEQ * 64, V + (size_t)b * SEQ * 1024 + h * 128,
                      ATT + row0 * 1024 + h * 128, nullptr, 4 * qb + 4, 4 * qb + (F.wave >> 1), 1 << 30, 32, 0, 1); }
}
__device__ __forceinline__ void xn_rows(Frame& F, bf16_t* XN) {
    const int gw = F.vcu * 8 + F.wave, NGW = F.G * 8;
    for (int r = gw; r < MPAD; r += NGW) {
        u32x2* o8 = (u32x2*)(XN + (size_t)r * D_MODEL) + F.lane;
        if (r >= MT) { for (int jj = 0; jj < 4; ++jj) o8[64 * jj] = (u32x2){0u, 0u}; continue; }
        const float* x = r < MP ? FIN(0) + (size_t)r * D_MODEL : FIN(1) + (size_t)(r - MP) * D_MODEL;
        const f32x4* xr = (const f32x4*)x + F.lane; f32x4 v[4]; float s = 0.f;
#pragma unroll
        for (int jj = 0; jj < 4; ++jj) { v[jj] = xr[64 * jj]; s += (v[jj][0] * v[jj][0] + v[jj][1] * v[jj][1]) + (v[jj][2] * v[jj][2] + v[jj][3] * v[jj][3]); }
        const float inv = rsqrtf(fwave_sum(s) * (1.f / D_MODEL) + EPS);
#pragma unroll
        for (int jj = 0; jj < 4; ++jj) { u32x2 w; w.x = cvt_pk_bf16(v[jj][0] * inv, v[jj][1] * inv); w.y = cvt_pk_bf16(v[jj][2] * inv, v[jj][3] * inv); o8[64 * jj] = w; }
    }
}
constexpr size_t WS_PART = WS_ATTS + 512 * KiB;
__device__ __forceinline__ void p3_attn_sample(Frame& F) {
    {   const int bh = F.vcu >> 2, part = F.vcu & 3, b = bh >> 3, h = bh & 7;
        const bf16_t* Q = (const bf16_t*)F.out; const bf16_t* KN = (const bf16_t*)(F.ws + WS_KN); const bf16_t* PES = (const bf16_t*)(F.ws + WS_PES); const bf16_t* V = (const bf16_t*)(F.ws + WS_V);
        const size_t row0 = (size_t)MP + (size_t)b * DEC_SEQ;
        at::attn_unit<true>(F.lds, Q + row0 * 1536 + h * 192, KN + (size_t)b * SKEYS * 1024 + h * 128, PES + (size_t)b * SKEYS * 64, V + (size_t)b * SKEYS * 1024 + h * 128,
                            nullptr, (float*)(F.ws + WS_PART) + (size_t)F.vcu * 16 * 132, part == 0 ? 9 : 8, F.wave == 0 ? 1000 : -1, SKEYS, DEC_SEQ, part, 4); }
    xn_rows(F, (bf16_t*)(F.ws + WS_XN2));
    {   const int gw = F.vcu * 8 + F.wave, NGW = F.G * 8; const bf16_t* KVL = (const bf16_t*)(F.ws + WS_KVL); const float* slotkv = (const float*)(F.ws + WS_SLOTKV);
        for (int r = gw; r < MT; r += NGW) { const float s = slot_rs(slotkv + (size_t)r * 8, 8, 1.f / KV_LORA);
            float* o = r < MP ? F.out + O_LATP + (size_t)r * KV_LORA : F.out + O_LATS + (size_t)(r - MP) * KV_LORA;
            const u32x4 w = *((const u32x4*)(KVL + (size_t)r * KV_LORA) + F.lane);
            f32x4 a = {__uint_as_float(w.x << 16), __uint_as_float(w.x & 0xffff0000u), __uint_as_float(w.y << 16), __uint_as_float(w.y & 0xffff0000u)};
            f32x4 c = {__uint_as_float(w.z << 16), __uint_as_float(w.z & 0xffff0000u), __uint_as_float(w.w << 16), __uint_as_float(w.w & 0xffff0000u)};
            *((f32x4*)o + 2 * F.lane) = a * s; *((f32x4*)o + 2 * F.lane + 1) = c * s; } }
}
__device__ __forceinline__ void attn_sample_combine(Frame& F) {
    if (F.vcu >= DEC_BATCH * HEADS) return;
    const int b = F.vcu >> 3, h = F.vcu & 7; const float* P = (const float*)(F.ws + WS_PART) + (size_t)F.vcu * 4 * 16 * 132; bf16_t* ATTS = (bf16_t*)(F.ws + WS_ATTS);
    for (int e = F.tid; e < 16 * 128; e += NTHR) { const int q = e >> 7, d = e & 127;
        float m[4], M = -1e30f;
#pragma unroll
        for (int p = 0; p < 4; ++p) { m[p] = P[(p * 16 + q) * 132 + 128]; M = fmaxf(M, m[p]); }
        float num = 0.f, den = 0.f;
#pragma unroll
        for (int p = 0; p < 4; ++p) { const float w = exp2f(m[p] - M); num += w * P[(p * 16 + q) * 132 + d]; den += w * P[(p * 16 + q) * 132 + 129]; }
        ATTS[(size_t)(b * DEC_SEQ + q) * 1024 + h * 128 + d] = f2bf(num / den); }
}
__device__ __forceinline__ void unpack8(const u32x4 w, float* f) {
    f[0] = __uint_as_float(w.x << 16); f[1] = __uint_as_float(w.x & 0xffff0000u); f[2] = __uint_as_float(w.y << 16); f[3] = __uint_as_float(w.y & 0xffff0000u);
    f[4] = __uint_as_float(w.z << 16); f[5] = __uint_as_float(w.z & 0xffff0000u); f[6] = __uint_as_float(w.w << 16); f[7] = __uint_as_float(w.w & 0xffff0000u);
}
__device__ __forceinline__ void p8_conv(Frame& F) {
    bf16_t* U = (bf16_t*)(F.ws + WS_U); const bf16_t* HALO = (const bf16_t*)(F.ws + WS_HALO); const float* cw = FIN(21); const float* cb = FIN(22); const float* prev = FIN(5);
    const int seg = F.wave, cgi = F.lane;
    for (int unit = F.vcu; unit < 72 * 6; unit += F.G) { const int ch = unit / 6, strip = unit % 6; const int n = strip * 512 + cgi * 8, nv = n + D_FF; const bool cok = n < D_FF;
        int r0, nr; if (ch < 64) { r0 = ch * 256 + seg * 32; nr = 32; } else { r0 = MP + (ch - 64) * DEC_SEQ; nr = seg == 0 ? DEC_SEQ : 0; }
        if (!cok) nr = 0;
        float wg[3][8], wv[3][8], bg[8], bv[8], g2[8], g1[8], v2[8], v1[8];
#pragma unroll
        for (int e = 0; e < 8; ++e) { g2[e] = 0.f; g1[e] = 0.f; v2[e] = 0.f; v1[e] = 0.f; }
        if (cok) {
#pragma unroll
            for (int k = 0; k < 3; ++k) { const f32x4 a0 = *(const f32x4*)(cw + k * FF2 + n), a1 = *(const f32x4*)(cw + k * FF2 + n + 4), c0 = *(const f32x4*)(cw + k * FF2 + nv), c1 = *(const f32x4*)(cw + k * FF2 + nv + 4);
#pragma unroll
                for (int e = 0; e < 4; ++e) { wg[k][e] = a0[e]; wg[k][4 + e] = a1[e]; wv[k][e] = c0[e]; wv[k][4 + e] = c1[e]; } }
            { const f32x4 a0 = *(const f32x4*)(cb + n), a1 = *(const f32x4*)(cb + n + 4), c0 = *(const f32x4*)(cb + nv), c1 = *(const f32x4*)(cb + nv + 4);
#pragma unroll
              for (int e = 0; e < 4; ++e) { bg[e] = a0[e]; bg[4 + e] = a1[e]; bv[e] = c0[e]; bv[4 + e] = c1[e]; } }
            if (ch < 64) {
                if (seg > 0) { unpack8(*(const u32x4*)(U + (size_t)(r0 - 2) * FF2 + n), g2); unpack8(*(const u32x4*)(U + (size_t)(r0 - 1) * FF2 + n), g1); unpack8(*(const u32x4*)(U + (size_t)(r0 - 2) * FF2 + nv), v2); unpack8(*(const u32x4*)(U + (size_t)(r0 - 1) * FF2 + nv), v1); }
                else if ((ch & 31) != 0) { const bf16_t* hp = HALO + (size_t)ch * 2 * FF2; unpack8(*(const u32x4*)(hp + n), g2); unpack8(*(const u32x4*)(hp + FF2 + n), g1); unpack8(*(const u32x4*)(hp + nv), v2); unpack8(*(const u32x4*)(hp + FF2 + nv), v1); }
            } else if (seg == 0) { const float* pp = prev + (size_t)(ch - 64) * 2 * FF2;
#pragma unroll
                for (int e = 0; e < 8; ++e) { g2[e] = pp[n + e]; g1[e] = pp[FF2 + n + e]; v2[e] = pp[nv + e]; v1[e] = pp[FF2 + nv + e]; } }
        }
        __syncthreads();
#pragma unroll 2
        for (int i = 0; i < nr; ++i) { bf16_t* row = U + (size_t)(r0 + i) * FF2; float g0[8], v0[8], h[8];
            unpack8(*(const u32x4*)(row + n), g0); unpack8(*(const u32x4*)(row + nv), v0);
#pragma unroll
            for (int e = 0; e < 8; ++e) { const float cg = g2[e] * wg[0][e] + g1[e] * wg[1][e] + g0[e] * wg[2][e] + bg[e], cv = v2[e] * wv[0][e] + v1[e] * wv[1][e] + v0[e] * wv[2][e] + bv[e];
                h[e] = cg * __builtin_amdgcn_rcpf(1.f + __expf(-cg)) * cv; g2[e] = g1[e]; g1[e] = g0[e]; v2[e] = v1[e]; v1[e] = v0[e]; }
            u32x4 w; w.x = cvt_pk_bf16(h[0], h[1]); w.y = cvt_pk_bf16(h[2], h[3]); w.z = cvt_pk_bf16(h[4], h[5]); w.w = cvt_pk_bf16(h[6], h[7]);
            *(u32x4*)(row + n) = w; }
        __syncthreads();
    }
}
__global__ void __launch_bounds__(NTHR, 2) mk(const MArgs a) {
    extern __shared__ __attribute__((aligned(16))) unsigned char lds_raw[];
    Frame F;
    F.lds = (LAS unsigned char*)lds_raw;
    F.tid = threadIdx.x; F.lane = F.tid & 63; F.wave = __builtin_amdgcn_readfirstlane(F.tid >> 6);
    F.G = gridDim.x; F.x = blockIdx.x % 8; F.j = blockIdx.x / 8; F.vcu = F.x * (F.G / 8) + F.j;
    F.a = &a; F.out = a.out; F.ws = a.ws;
    volatile LAS unsigned* MISC = (volatile LAS unsigned*)(F.lds + MISC_OFF);
    if (F.tid < 32) MISC[F.tid] = 0u;
    __syncthreads();
    XcdBarrier bar = xcd_barrier_post((unsigned*)(a.ws + WS_CTL) + CW_BAR + a.li * XCD_BAR_WORDS, MISC + 8);
    const int lo = a.ph_lo, hi = a.ph_hi;
#define IN_(k) (lo <= (k) && (k) < hi)
#define SEAM_(k) do { if (IN_(k) && IN_((k) + 1)) xcd_barrier(bar); } while (0)
#ifndef PROBE_LO
#define PROBE_LO -1
#define PROBE_HI -1
#define PROBE_MULT 1
#endif
#define STAMP_(k) do { if (PROBE_LO >= 0 && blockIdx.x == 0 && F.tid == 0) { const unsigned long long t_ = __builtin_amdgcn_s_memrealtime(); if ((k) == PROBE_LO) { MISC[16] = (unsigned)t_; MISC[17] = (unsigned)(t_ >> 32); } if ((k) == PROBE_HI) { MISC[18] = (unsigned)t_; MISC[19] = (unsigned)(t_ >> 32); } } } while (0)
    STAMP_(0); if (IN_(0)) { p0_prologue(F); } SEAM_(0);
    STAMP_(1); if (IN_(1)) { p1_inproj(F); } SEAM_(1);
    STAMP_(2); if (IN_(2)) { r1_states(F); } SEAM_(2);
    STAMP_(3); if (IN_(3)) { r2_scan(F); } SEAM_(3);
    STAMP_(4); if (IN_(4)) { r3_outputs(F); } SEAM_(4);
    STAMP_(5); if (IN_(5)) { p2_qkv(F, 1); } SEAM_(5);
    STAMP_(6); if (IN_(6)) { p3_attn_sample(F); } SEAM_(6);
    STAMP_(7); if (IN_(7)) { attn_sample_combine(F); p2_qkv(F, 0); } SEAM_(7);
    STAMP_(8); if (IN_(8)) { p3_attn_prompt(F); } SEAM_(8);
    STAMP_(9); if (IN_(9)) { p5_gemm(F, 5); } SEAM_(9);
    STAMP_(10); if (IN_(10)) { p5_gemm(F, 6); } SEAM_(10);
    STAMP_(11); if (IN_(11)) { p5_gemm(F, 7); } SEAM_(11);
    STAMP_(12); if (IN_(12)) { p8_conv(F); } SEAM_(12);
    STAMP_(13); if (IN_(13)) { p5_gemm(F, 9); }
    if (PROBE_LO >= 0) { __syncthreads(); STAMP_(14);
        if (blockIdx.x == 0 && F.tid == 0) { const unsigned long long t_end = __builtin_amdgcn_s_memrealtime() + (unsigned long long)PROBE_MULT * ((((unsigned long long)MISC[19] << 32) | MISC[18]) - (((unsigned long long)MISC[17] << 32) | MISC[16]));
            while (__builtin_amdgcn_s_memrealtime() < t_end) __builtin_amdgcn_s_sleep(8); } }
}

extern "C" void kernel_launch(void* const* d_in, const int* in_sizes, int n_in, void* d_out, int out_size, void* d_ws, size_t ws_size, hipStream_t stream) {
    static int ok = 0;
    if (ok == 0) {
        ok = 1;
        if (ws_size < 256 * MiB || n_in != 24) { fprintf(stderr, "kernel_launch: bad ws/n_in: %zu %d\n", ws_size, n_in); ok = -1; }
        int dev = 0, cus = 0; (void)hipGetDevice(&dev); (void)hipDeviceGetAttribute(&cus, hipDeviceAttributeMultiprocessorCount, dev);
        if (cus != 256) { fprintf(stderr, "kernel_launch: built for 256 CUs, got %d\n", cus); ok = -1; }
        if (hipFuncSetAttribute((const void*)mk, hipFuncAttributeMaxDynamicSharedMemorySize, LDS_BYTES) != hipSuccess) { fprintf(stderr, "kernel_launch: hipFuncSetAttribute(mk) failed\n"); ok = -1; }
        (void)hipGetLastError();
    }
    if (ok < 0) return;
    (void)hipMemsetAsync((char*)d_ws + WS_CTL, 0, CTL_BYTES, stream);
    MArgs a{}; for (int i = 0; i < 24; ++i) a.in[i] = (const float*)d_in[i]; a.out = (float*)d_out; a.ws = (unsigned char*)d_ws; a.ph_lo = 0; a.ph_hi = 14; a.li = 0;
    hipLaunchKernelGGL(mk, dim3(256), dim3(NTHR), LDS_BYTES, stream, a);
}
```

```cpp
#include <hip/hip_runtime.h>
#include <stdint.h>
#include <cstdio>

typedef unsigned short bf16_t;
typedef short bf16x8 __attribute__((ext_vector_type(8)));
typedef float f32x4 __attribute__((ext_vector_type(4)));
typedef float f32x2 __attribute__((ext_vector_type(2)));
typedef unsigned u32x4 __attribute__((ext_vector_type(4)));
typedef unsigned u32x2 __attribute__((ext_vector_type(2)));

constexpr int D_MODEL = 1024, BATCH = 2, SEQ = 8192, DEC_BATCH = 8, DEC_SEQ = 16, PAST = 2048;
constexpr int MP = BATCH * SEQ, MS = DEC_BATCH * DEC_SEQ, MT = MP + MS;
constexpr int MPAD = 16640;
constexpr int Q_LORA = 768, KV_LORA = 512, QK_NOPE = 128, QK_ROPE = 64, V_HEAD = 128, HEADS = 8;
constexpr int RET_H = 4, RET_DK = 128, RET_DV = 256;
constexpr int D_FF = 2816, FF2 = 2 * D_FF;
constexpr int IN_W = 6464;
constexpr int SKEYS = PAST + DEC_SEQ;
constexpr int LROWS = DEC_BATCH * SKEYS;
constexpr float EPS = 1e-6f;
constexpr int C_QLAT = 0, C_KVLAT = 768, C_KPE = 1280, C_RQ = 1344, C_RK = 1856, C_RV = 2368, C_RG = 3392, C_GA = 4416, C_GB = 5440;

constexpr size_t O_YP = 0, O_YS = 16777216, O_LATP = 16908288, O_RKP = 25296896, O_RETP = 26345472, O_CONVP = 26607616,
                 O_LATS = 26630144, O_RKS = 26695680, O_RETS = 26703872, O_CONVS = 27752448;

constexpr size_t MiB = 1u << 20, KiB = 1024;
constexpr size_t WS_CTL = 0, CTL_BYTES = 64 * KiB, WS_SQ = 64 * KiB, WS_SKV = 192 * KiB;
constexpr size_t WS_SLOTQ = 1 * MiB, WS_SLOTKV = 2 * MiB, WS_SLOTX1 = 3 * MiB;
constexpr size_t WS_TAB32 = 4 * MiB + 256 * KiB, WS_TAB64 = 6 * MiB + 256 * KiB;
constexpr size_t WS_FWUP = 10 * MiB + 512 * KiB, WS_FWDOWN = 21 * MiB + 512 * KiB, WS_FWIN = 27 * MiB, WS_FWQUP = 40 * MiB, WS_FWKVUP = 43 * MiB,
                 WS_FWOBA = 45 * MiB, WS_FWOBB = 47 * MiB, WS_FWOUT = 49 * MiB;
constexpr size_t WS_XN = 51 * MiB, WS_RET = 51 * MiB;
constexpr size_t WS_LATS = 83 * MiB + 512 * KiB, WS_PES = 99 * MiB + 768 * KiB, WS_ZQ = 102 * MiB, WS_KVL = 126 * MiB + 512 * KiB, WS_KPE = 142 * MiB + 768 * KiB;
constexpr size_t WS_RQ = 145 * MiB, WS_RK = 161 * MiB + 256 * KiB, WS_RV = 177 * MiB + 512 * KiB, WS_RG = 210 * MiB;
constexpr size_t WS_KN = 145 * MiB, WS_V = 177 * MiB + 512 * KiB, WS_ATTS = 242 * MiB + 512 * KiB, WS_XN2 = 210 * MiB, WS_ATT = 102 * MiB;
constexpr size_t WS_T1 = 166 * MiB + 512 * KiB, WS_MERGED = 134 * MiB;
constexpr size_t WS_GAS = 246 * MiB, WS_GBS = 247 * MiB;
constexpr size_t WS_X1B = 223 * MiB + 512 * KiB, WS_U = 27 * MiB, WS_HALO = 206 * MiB;

__device__ __forceinline__ bf16_t f2bf(float f) { unsigned u = __float_as_uint(f); u = (u + 0x7fffu + ((u >> 16) & 1u)) >> 16; return (bf16_t)u; }
__device__ __forceinline__ float bf2f(bf16_t b) { return __uint_as_float(((unsigned)b) << 16); }

#define LAS __attribute__((address_space(3)))
#define GAS __attribute__((address_space(1)))
constexpr int NTHR = 512;
constexpr int RING_BYTES = 131072, EPI_OFF = RING_BYTES, EPI_BYTES = 8192, MISC_OFF = EPI_OFF + EPI_BYTES, LDS_BYTES = 147456;
constexpr int CW_BAR = 1024;

__device__ __forceinline__ unsigned cvt_pk_bf16(float lo, float hi) { unsigned r; asm volatile("v_cvt_pk_bf16_f32 %0, %1, %2" : "=v"(r) : "v"(lo), "v"(hi)); return r; }
__device__ __forceinline__ u32x4 pack8f(const f32x4& a, const f32x4& b) { u32x4 w; w.x = cvt_pk_bf16(a[0], a[1]); w.y = cvt_pk_bf16(a[2], a[3]); w.z = cvt_pk_bf16(b[0], b[1]); w.w = cvt_pk_bf16(b[2], b[3]); return w; }
__device__ __forceinline__ int row_pos(int row) { return row < MP ? (row & (SEQ - 1)) : PAST + ((row - MP) & (DEC_SEQ - 1)); }

#define XB_TMO      128
#define XB_XCNT(j)  (256  + 64 * (j))
#define XB_XSUB(j)  (1280 + 64 * (j))
#define XB_XGEN(j)  (2304 + 64 * (j))
#define XB_TOP      3328
#define XB_TOPGEN   3392
#define XCD_BAR_WORDS 3456
#define XB_SPIN_CAP (1u << 18)
__device__ __forceinline__ unsigned xb_ld(unsigned* p)              { return __hip_atomic_load(p, __ATOMIC_RELAXED, __HIP_MEMORY_SCOPE_AGENT); }
__device__ __forceinline__ unsigned xb_add(unsigned* p, unsigned v) { return __hip_atomic_fetch_add(p, v, __ATOMIC_RELAXED, __HIP_MEMORY_SCOPE_AGENT); }
__device__ __forceinline__ unsigned xb_xcc_id() { return (unsigned)__builtin_amdgcn_s_getreg((3 << 11) | 20) & 0xFu; }
#define XB_SPIN(cond, bar) do { unsigned _sp = 0; while (cond) { __builtin_amdgcn_s_sleep(1); \
    if ((++_sp & 255u) == 0u) { if (xb_ld(&(bar)[XB_TMO])) break; if (_sp > XB_SPIN_CAP) { atomicAdd(&(bar)[XB_TMO], 1u); break; } } } } while (0)
struct XcdBarrier { unsigned* bar; unsigned x; volatile LAS unsigned* st; };
__device__ __forceinline__ XcdBarrier xcd_barrier_post(unsigned* bar, volatile LAS unsigned* st) {
    XcdBarrier b; b.bar = bar; b.x = xb_xcc_id(); b.st = st;
    if (threadIdx.x == 0) (void)xb_add(&bar[XB_XCNT(b.x)], 1u);
    return b;
}
__device__ __forceinline__ void xcd_barrier_complete(unsigned* bar, unsigned x, unsigned& nloc, unsigned& nx) {
    const unsigned G = gridDim.x * gridDim.y * gridDim.z;
    unsigned sum, cnt, mine, sp = 0u;
    for (;;) {
        sum = 0u; cnt = 0u; mine = 0u;
#pragma unroll
        for (unsigned j = 0; j < 16; ++j) { const unsigned c = xb_ld(&bar[XB_XCNT(j)]); sum += c; cnt += (c > 0u) ? 1u : 0u; mine = (j == x) ? c : mine; }
        if (sum == G) break;
        __builtin_amdgcn_s_sleep(1);
        if ((++sp & 255u) == 0u) { if (xb_ld(&bar[XB_TMO])) break; if (sp > XB_SPIN_CAP) { atomicAdd(&bar[XB_TMO], 1u); break; } }
    }
    nloc = mine > 0u ? mine : 1u; nx = cnt > 0u ? cnt : 1u;
}
__device__ __forceinline__ void xcd_barrier(const XcdBarrier& b) {
    asm volatile("s_waitcnt vmcnt(0)" ::: "memory");
    __syncthreads();
    if (threadIdx.x == 0) {
        unsigned* bar = b.bar;
        __builtin_amdgcn_s_waitcnt(0);
        unsigned nloc = b.st[0], nx = b.st[1];
        if (nloc == 0u) { xcd_barrier_complete(bar, b.x, nloc, nx); b.st[0] = nloc; b.st[1] = nx; }
        const unsigned old = xb_add(&bar[XB_XSUB(b.x)], 1u);
        const unsigned gen = old / nloc;
        if (old + 1u == (gen + 1u) * nloc) {
            __builtin_amdgcn_fence(__ATOMIC_RELEASE, "agent");
            asm volatile("s_waitcnt vmcnt(0)" ::: "memory");
            const unsigned og = xb_add(&bar[XB_TOP], 1u);
            const unsigned tg = og / nx;
            if (og + 1u == (tg + 1u) * nx) xb_add(&bar[XB_TOPGEN], 1u);
            else XB_SPIN(xb_ld(&bar[XB_TOPGEN]) == tg, bar);
            __builtin_amdgcn_fence(__ATOMIC_ACQUIRE, "agent");
            xb_add(&bar[XB_XGEN(b.x)], 1u);
            asm volatile("s_waitcnt vmcnt(0)" ::: "memory");
        } else {
            XB_SPIN(xb_ld(&bar[XB_XGEN(b.x)]) == gen, bar);
            __builtin_amdgcn_fence(__ATOMIC_ACQUIRE, "agent");
            asm volatile("s_waitcnt vmcnt(0)" ::: "memory");
        }
    }
    __syncthreads();
}

namespace pg {
constexpr int BK = 64, HALF = 128, HTB = HALF * BK * 2;
__host__ __device__ __forceinline__ int lds_byte(int r, int c) { const int st = (r >> 4) * 2 + (c >> 5), rr = r & 15, cc = c & 31, ob = rr * 64 + cc * 2; return st * 1024 + (ob ^ (((ob >> 9) & 1) << 5)); }
__host__ __device__ __forceinline__ void stage_rc(int b, int& R, int& C) { const int st = b / 1024, sb = b % 1024, swz = sb ^ (((sb >> 9) & 1) << 5); R = (st >> 1) * 16 + swz / 64; C = (st & 1) * 32 + (swz % 64) / 2; }
__host__ __device__ __forceinline__ int perm32(int rho) { const int n = rho >> 4, i = rho & 15; return 8 * (i >> 2) + 4 * n + (i & 3); }
struct UnitG { const char* A; const char* B; unsigned lda, ldb; int nt; int pm, pn, kind; int half; };
typedef f32x4 Acc[2][2][4][2];

template <class Sched, class Epi>
__device__ __forceinline__ void gemm_stream(LAS unsigned char* lds, const Sched& S, const Epi& E) {
    const int tid = threadIdx.x, wid = __builtin_amdgcn_readfirstlane(tid >> 6), lane = tid & 63, wr = wid >> 2, wc = wid & 3, fr = lane & 15, fq = lane >> 4;
    unsigned Rr[2], Cc[2];
#pragma unroll
    for (int i = 0; i < 2; ++i) { int R, C; stage_rc(tid * 16 + i * 8192, R, C); Rr[i] = (unsigned)R; Cc[i] = (unsigned)C * 2u; }
    const unsigned ldsw = (unsigned)wid * 1024u;
    const int aoff = lds_byte(wr * 64 + fr, fq * 8), boff = lds_byte(wc * 32 + fr, fq * 8);
#define PG_SA(b, h) (((b) * 2 + (h)) * HTB)
#define PG_SB(b, h) ((4 + (b) * 2 + (h)) * HTB)
#define PG_STAGE(bufoff, gbase, ld) do { _Pragma("unroll") for (int _i = 0; _i < 2; ++_i) \
        __builtin_amdgcn_global_load_lds((const unsigned*)((const char*)(gbase) + (size_t)(Rr[_i] * (ld) + Cc[_i])), (LAS unsigned*)(lds + (bufoff) + ldsw + _i * 8192), 16, 0, 0); } while (0)
#define PG_LDA(dst, b, h) do { _Pragma("unroll") for (int m = 0; m < 4; ++m) _Pragma("unroll") for (int k = 0; k < 2; ++k) dst[m][k] = *(const LAS bf16x8*)(lds + PG_SA(b, h) + aoff + m * 2048 + k * 1024); } while (0)
#define PG_LDB(dst, b, h) do { _Pragma("unroll") for (int n = 0; n < 2; ++n) _Pragma("unroll") for (int k = 0; k < 2; ++k) dst[n][k] = *(const LAS bf16x8*)(lds + PG_SB(b, h) + boff + n * 2048 + k * 1024); } while (0)
#define PG_MMA(ai, bj, At, Bt) do { __builtin_amdgcn_s_setprio(1); _Pragma("unroll") for (int m = 0; m < 4; ++m) _Pragma("unroll") for (int n = 0; n < 2; ++n) _Pragma("unroll") for (int k = 0; k < 2; ++k) \
        acc[ai][bj][m][n] = __builtin_amdgcn_mfma_f32_16x16x32_bf16(Bt[n][k], At[m][k], acc[ai][bj][m][n], 0, 0, 0); __builtin_amdgcn_s_setprio(0); } while (0)
#define PG_WAIT_V(n) asm volatile("s_waitcnt vmcnt(" #n ")" ::: "memory")
#define PG_WAIT_L(n) asm volatile("s_waitcnt lgkmcnt(" #n ")" ::: "memory")
#define PG_BAR __builtin_amdgcn_s_barrier()
#define PG_SCHED __builtin_amdgcn_sched_barrier(0)
    UnitG cur, nxt; int ui = 0;
    if (!S.next(0, cur)) return;
    Acc acc;
#pragma unroll
    for (int a = 0; a < 2; ++a)
#pragma unroll
        for (int b = 0; b < 2; ++b)
#pragma unroll
            for (int m = 0; m < 4; ++m)
#pragma unroll
                for (int n = 0; n < 2; ++n) acc[a][b][m][n] = (f32x4){0.f, 0.f, 0.f, 0.f};
    bf16x8 At[4][2], B0[2][2], B1[2][2];
    const char* cA = cur.A; const char* cB = cur.B; unsigned clda = cur.lda, cldb = cur.ldb;
    PG_STAGE(PG_SB(0, 0), cB, cldb); PG_STAGE(PG_SB(0, 1), cB + (size_t)HALF * cldb, cldb); PG_STAGE(PG_SA(0, 0), cA, clda); PG_STAGE(PG_SA(0, 1), cA + (size_t)HALF * clda, clda);
    if (wr == 1) PG_BAR;
    PG_WAIT_V(2); PG_BAR;
    PG_STAGE(PG_SB(1, 0), cB + 128, cldb); PG_STAGE(PG_SA(1, 0), cA + 128, clda); PG_STAGE(PG_SB(1, 1), cB + (size_t)HALF * cldb + 128, cldb);
    PG_WAIT_V(6); PG_BAR;
    for (;;) {
        const bool has_next = S.next(ui + 1, nxt);
        const char* nA = has_next ? nxt.A : cA; const char* nB = has_next ? nxt.B : cB;
        const unsigned nlda = has_next ? nxt.lda : clda, nldb = has_next ? nxt.ldb : cldb;
        const int nt = cur.nt; const bool chalf = cur.half != 0;
        for (int t = 0; t < nt; t += 2) {
            const bool last = (t == nt - 2);
            const char* a1 = cA + (size_t)(t + 1) * 128;
            const char* a2 = last ? nA : cA + (size_t)(t + 2) * 128; const char* b2 = last ? nB : cB + (size_t)(t + 2) * 128;
            const unsigned lda2 = last ? nlda : clda, ldb2 = last ? nldb : cldb;
            const char* a3 = a2 + 128; const char* b3 = b2 + 128;
            PG_LDB(B0, 0, 0); PG_LDB(B1, 0, 1); PG_SCHED; PG_LDA(At, 0, 0); PG_STAGE(PG_SA(1, 1), a1 + (size_t)HALF * clda, clda);
            PG_WAIT_V(8); PG_WAIT_L(0); PG_BAR; PG_MMA(0, 0, At, B0); PG_MMA(0, 1, At, B1); PG_BAR; PG_SCHED;
            PG_LDA(At, 0, 1); PG_STAGE(PG_SB(0, 0), b2, ldb2); PG_STAGE(PG_SB(0, 1), b2 + (size_t)HALF * ldb2, ldb2); PG_STAGE(PG_SA(0, 0), a2, lda2);
            PG_WAIT_V(8); PG_WAIT_L(0); PG_BAR; if (!chalf) { PG_MMA(1, 0, At, B0); PG_MMA(1, 1, At, B1); } PG_BAR; PG_SCHED;
            PG_LDB(B0, 1, 0); PG_LDB(B1, 1, 1); PG_SCHED; PG_LDA(At, 1, 0); PG_STAGE(PG_SA(0, 1), a2 + (size_t)HALF * lda2, lda2);
            PG_WAIT_V(8); PG_WAIT_L(0); PG_BAR; PG_MMA(0, 0, At, B0); PG_MMA(0, 1, At, B1); PG_BAR; PG_SCHED;
            PG_LDA(At, 1, 1); PG_STAGE(PG_SB(1, 0), b3, ldb2); PG_STAGE(PG_SB(1, 1), b3 + (size_t)HALF * ldb2, ldb2); PG_STAGE(PG_SA(1, 0), a3, lda2);
            PG_WAIT_V(8); PG_WAIT_L(0); PG_BAR; if (!chalf) { PG_MMA(1, 0, At, B0); PG_MMA(1, 1, At, B1); } PG_BAR; PG_SCHED;
        }
        if (wr == 0) PG_BAR;
        E(acc, cur, lds, wr, wc, fr, fq);
        if (!has_next) break;
#pragma unroll
        for (int a = 0; a < 2; ++a)
#pragma unroll
            for (int b = 0; b < 2; ++b)
#pragma unroll
                for (int m = 0; m < 4; ++m)
#pragma unroll
                    for (int n = 0; n < 2; ++n) acc[a][b][m][n] = (f32x4){0.f, 0.f, 0.f, 0.f};
        cur = nxt; cA = nA; cB = nB; clda = nlda; cldb = nldb; ++ui;
        if (wr == 1) PG_BAR;
    }
    PG_WAIT_V(0);
    PG_BAR;
#undef PG_SA
#undef PG_SB
#undef PG_STAGE
#undef PG_LDA
#undef PG_LDB
#undef PG_MMA
#undef PG_WAIT_V
#undef PG_WAIT_L
#undef PG_BAR
#undef PG_SCHED
}
}

struct MArgs { const float* in[24]; float* out; unsigned char* ws; int ph_lo, ph_hi, li, pad; };
struct Frame {
    LAS unsigned char* lds; int tid, lane, wave; int x, j, vcu, G;
    const MArgs* a; float* out; unsigned char* ws;
};
#define FIN(k) (F.a->in[k])
__device__ __forceinline__ float fwave_sum(float v) {
#pragma unroll
    for (int o = 1; o < 64; o <<= 1) v += __shfl_xor(v, o);
    return v;
}

#ifndef PROBE_LO
#define PROBE_LO -1
#define PROBE_HI -1
#define PROBE_MULT 1
#endif
__device__ __forceinline__ void probe_stamp(Frame& F, int k) {
    if (PROBE_LO >= 0 && blockIdx.x == 0 && F.tid == 0) { volatile LAS unsigned* M = (volatile LAS unsigned*)(F.lds + MISC_OFF); const unsigned long long t_ = __builtin_amdgcn_s_memrealtime();
        if (k == PROBE_LO) { M[16] = (unsigned)t_; M[17] = (unsigned)(t_ >> 32); } if (k == PROBE_HI) { M[18] = (unsigned)t_; M[19] = (unsigned)(t_ >> 32); } }
}
enum { W_IN = 0, W_QUP, W_KVUP, W_OBA, W_OBB, W_OUT, W_UP, W_DOWN };
__device__ __forceinline__ int win_src(int gd) {
    const int tile = gd >> 3, g = gd & 7, bj = g >> 2, wc = g & 3;
    if (tile < 3) return C_QLAT + gd * 32;
    if (tile < 5) return C_KVLAT + (gd - 24) * 32;
    if (tile == 5) return (wc == 0) ? C_KPE + bj * 32 : -1;
    if (tile < 10) { const int base = tile < 8 ? C_RQ : C_RK, tl = tile < 8 ? tile - 6 : tile - 8; const int head = 2 * tl + (wc >> 1); return base + head * 128 + bj * 64 + (wc & 1) * 32; }
    if (tile < 14) return C_RV + (gd - 80) * 32;
    if (tile < 18) return C_RG + (gd - 112) * 32;
    if (tile < 22) return C_GA + (gd - 144) * 32;
    return C_GB + (gd - 176) * 32;
}
__device__ __forceinline__ int w_src_col(int wid, int row) {
    const int rho = row & 31, s = row & 255, wc = (s >> 5) & 3, t = row >> 8;
    const int n = rho >> 4, i = rho & 15; return t * 192 + 128 + 16 * wc + i + 32 * n;
}
__device__ __forceinline__ int w_group_base(int wid, int gd) {
    const int g = gd & 7, bj = g >> 2, wc = g & 3, t = gd >> 3;
    switch (wid) {
    case W_IN: return win_src(gd);
    case W_QUP: return bj == 0 ? t * 192 + 32 * wc : (wc < 2 ? -2 : -1);
    case W_KVUP: return t * 256 + 128 * bj + 32 * wc;
    case W_UP: return (bj ? D_FF : 0) + 128 * t + 32 * wc;
    default: return gd * 32;
    }
}
struct WItemRegs { f32x4 v[8]; float g[8]; };
__device__ __forceinline__ void p0_item_load(WItemRegs& R, const float* __restrict__ W, int ldw, const float* __restrict__ gain, int base, int kb, int lane) {
    const int k0 = kb * 64, c = lane & 7;
    if (base >= 0) {
#pragma unroll
        for (int i = 0; i < 8; ++i) { const int kk = (lane >> 3) + 8 * i; R.g[i] = gain ? gain[k0 + kk] : 1.f; R.v[i] = *(const f32x4*)(W + (size_t)(k0 + kk) * ldw + base + 4 * c); } }
}
__device__ __forceinline__ void p0_item_finish(const WItemRegs& R, const float* __restrict__ W, int ldw, int K, const float* __restrict__ gain, int wid, int base, bf16_t* __restrict__ Wt, int gd, int kb, LAS float* scr, int lane) {
    const int k0 = kb * 64, c = lane & 7;
    bf16_t* dst = Wt + (size_t)(gd * 32) * K + k0;
    if (base == -1) {
#pragma unroll
        for (int jj = 0; jj < 4; ++jj) { const int n = (lane >> 3) + 8 * jj; *(u32x4*)(dst + (size_t)n * K + 8 * c) = (u32x4){0u, 0u, 0u, 0u}; }
        return;
    }
    if (base >= 0) {
#pragma unroll
        for (int i = 0; i < 8; ++i) { const int kk = (lane >> 3) + 8 * i; LAS float* d = scr + kk * 33 + 4 * c; const float g = R.g[i]; d[0] = R.v[i][0] * g; d[1] = R.v[i][1] * g; d[2] = R.v[i][2] * g; d[3] = R.v[i][3] * g; }
    } else {
        const int sc = w_src_col(wid, gd * 32 + (lane & 31));
#pragma unroll 8
        for (int i = 0; i < 32; ++i) { const int kk = 2 * i + (lane >> 5); const float g = gain ? gain[k0 + kk] : 1.f; scr[kk * 33 + (lane & 31)] = W[(size_t)(k0 + kk) * ldw + sc] * g; }
    }
    asm volatile("s_waitcnt lgkmcnt(0)" ::: "memory");
#pragma unroll
    for (int jj = 0; jj < 4; ++jj) { const int n = (lane >> 3) + 8 * jj; const LAS float* s = scr + (8 * c) * 33 + (base >= 0 ? pg::perm32(n) : n);
        u32x4 o; o.x = cvt_pk_bf16(s[0 * 33], s[1 * 33]); o.y = cvt_pk_bf16(s[2 * 33], s[3 * 33]); o.z = cvt_pk_bf16(s[4 * 33], s[5 * 33]); o.w = cvt_pk_bf16(s[6 * 33], s[7 * 33]);
        *(u32x4*)(dst + (size_t)n * K + 8 * c) = o; }
    asm volatile("s_waitcnt lgkmcnt(0)" ::: "memory");
}
struct WDesc { const float* W; const float* gain; int ldw, K, wid, ngroups, local; size_t off; };
__device__ __forceinline__ bool w_decode(Frame& F, int it, WDesc& d) {
    if (it < 3328) { d = WDesc{FIN(7), FIN(6), IN_W, 1024, W_IN, 208, it, WS_FWIN}; return true; } it -= 3328;
    if (it < 768) { d = WDesc{FIN(9), FIN(8), 1536, 768, W_QUP, 64, it, WS_FWQUP}; return true; } it -= 768;
    if (it < 512) { d = WDesc{FIN(13), nullptr, 2048, 512, W_KVUP, 64, it, WS_FWKVUP}; return true; } it -= 512;
    if (it < 512) { d = WDesc{FIN(17), nullptr, 1024, 1024, W_OBA, 32, it, WS_FWOBA}; return true; } it -= 512;
    if (it < 512) { d = WDesc{FIN(17) + (size_t)1024 * 1024, nullptr, 1024, 1024, W_OBB, 32, it, WS_FWOBB}; return true; } it -= 512;
    if (it < 512) { d = WDesc{FIN(18), nullptr, 1024, 1024, W_OUT, 32, it, WS_FWOUT}; return true; } it -= 512;
    if (it < 2816) { d = WDesc{FIN(20), FIN(19), FF2, 1024, W_UP, 176, it, WS_FWUP}; return true; } it -= 2816;
    if (it < 1408) { d = WDesc{FIN(23), nullptr, 1024, D_FF, W_DOWN, 32, it, WS_FWDOWN}; return true; }
    return false;
}
__device__ __forceinline__ void p0_all_weights(Frame& F, LAS float* scr, int gw, int NGW) {
    for (int it = gw; it < 10368; it += 2 * NGW) {
        WDesc dA, dB; w_decode(F, it, dA); const bool hasB = w_decode(F, it + NGW, dB);
        const int gdA = dA.local % dA.ngroups, kbA = dA.local / dA.ngroups, baseA = w_group_base(dA.wid, gdA);
        const int gdB = hasB ? dB.local % dB.ngroups : 0, kbB = hasB ? dB.local / dB.ngroups : 0, baseB = hasB ? w_group_base(dB.wid, gdB) : -1;
        WItemRegs RA, RB;
        p0_item_load(RA, dA.W, dA.ldw, dA.gain, baseA, kbA, F.lane);
        if (hasB) p0_item_load(RB, dB.W, dB.ldw, dB.gain, baseB, kbB, F.lane);
        p0_item_finish(RA, dA.W, dA.ldw, dA.K, dA.gain, dA.wid, baseA, (bf16_t*)(F.ws + dA.off), gdA, kbA, scr, F.lane);
        if (hasB) p0_item_finish(RB, dB.W, dB.ldw, dB.K, dB.gain, dB.wid, baseB, (bf16_t*)(F.ws + dB.off), gdB, kbB, scr, F.lane);
    }
}
__device__ __forceinline__ float2 rope_cs(int pos, double f) {
    const double t = (double)pos * f * 0.15915494309189535; const float rev = (float)(t - rint(t));
    return make_float2(__builtin_amdgcn_cosf(rev), __builtin_amdgcn_sinf(rev));
}
__device__ __forceinline__ void p0_prologue(Frame& F) {
    LAS float* scr = (LAS float*)(F.lds + F.wave * 16384);
    const int gw = F.vcu * 8 + F.wave, NGW = F.G * 8;
    probe_stamp(F, 20);
    p0_all_weights(F, scr, gw, NGW);
    probe_stamp(F, 21);
    {   bf16_t* XN = (bf16_t*)(F.ws + WS_XN);
        for (int r = gw; r < MPAD; r += 2 * NGW) {
            const int r2 = r + NGW; f32x4 v[2][4];
#pragma unroll
            for (int q = 0; q < 2; ++q) { const int rr = q ? r2 : r; if (rr < MT) { const float* x = rr < MP ? FIN(0) + (size_t)rr * D_MODEL : FIN(1) + (size_t)(rr - MP) * D_MODEL; const f32x4* xr = (const f32x4*)x + F.lane;
#pragma unroll
                    for (int jj = 0; jj < 4; ++jj) v[q][jj] = xr[64 * jj]; } else {
#pragma unroll
                    for (int jj = 0; jj < 4; ++jj) v[q][jj] = (f32x4){0.f, 0.f, 0.f, 0.f}; } }
#pragma unroll
            for (int q = 0; q < 2; ++q) { const int rr = q ? r2 : r; if (rr >= MPAD) continue; float s = 0.f;
#pragma unroll
                for (int jj = 0; jj < 4; ++jj) s += (v[q][jj][0] * v[q][jj][0] + v[q][jj][1] * v[q][jj][1]) + (v[q][jj][2] * v[q][jj][2] + v[q][jj][3] * v[q][jj][3]);
                const float inv = rsqrtf(fwave_sum(s) * (1.f / D_MODEL) + EPS); u32x2* o8 = (u32x2*)(XN + (size_t)rr * D_MODEL) + F.lane;
#pragma unroll
                for (int jj = 0; jj < 4; ++jj) { u32x2 w; w.x = cvt_pk_bf16(v[q][jj][0] * inv, v[q][jj][1] * inv); w.y = cvt_pk_bf16(v[q][jj][2] * inv, v[q][jj][3] * inv); o8[64 * jj] = w; } }
        } }
    probe_stamp(F, 22);
    {   bf16_t* lats = (bf16_t*)(F.ws + WS_LATS); bf16_t* pes = (bf16_t*)(F.ws + WS_PES);
        const int gt = F.vcu * NTHR + F.tid, NG = F.G * NTHR;
        for (int i0 = gt; i0 < DEC_BATCH * PAST * (KV_LORA / 4); i0 += 4 * NG) { f32x4 v[4];
#pragma unroll
            for (int q = 0; q < 4; ++q) v[q] = *((const f32x4*)FIN(2) + i0 + q * NG);
#pragma unroll
            for (int q = 0; q < 4; ++q) { const int i = i0 + q * NG, c4 = i % (KV_LORA / 4), rj = i / (KV_LORA / 4), jr = rj % PAST, b = rj / PAST; u32x2 w; w.x = cvt_pk_bf16(v[q][0], v[q][1]); w.y = cvt_pk_bf16(v[q][2], v[q][3]);
                *(u32x2*)(lats + ((size_t)b * SKEYS + jr) * KV_LORA + c4 * 4) = w; } }
        for (int i = gt; i < DEC_BATCH * PAST * (QK_ROPE / 4); i += NG) { const int c4 = i % (QK_ROPE / 4), rj = i / (QK_ROPE / 4), jr = rj % PAST, b = rj / PAST;
            const f32x4 v = *((const f32x4*)FIN(3) + i); u32x2 w; w.x = cvt_pk_bf16(v[0], v[1]); w.y = cvt_pk_bf16(v[2], v[3]);
            *(u32x2*)(pes + ((size_t)b * SKEYS + jr) * QK_ROPE + c4 * 4) = w; }
        probe_stamp(F, 23);
        float2* tab32 = (float2*)(F.ws + WS_TAB32); float2* tab64 = (float2*)(F.ws + WS_TAB64);
        {   const int k64 = gt & 63, k32 = gt & 31;
            const double f64 = exp2(-(double)k64 * (13.287712379549449 / 64.0)), f32 = exp2(-(double)k32 * (13.287712379549449 / 32.0));
            for (int i = gt; i < 8192 * 64; i += NG) { tab64[i] = rope_cs(i >> 6, f64); if (i < 8192 * 32) tab32[i] = rope_cs(i >> 5, f32); } } }
}

__device__ __forceinline__ bool reg_unit(int x, int j, int i, int nN, int& pm, int& pn) { const int u = j + 32 * i; if (u >= 8 * nN) return false; pm = 8 * x + (u & 7); pn = u >> 3; return true; }
#define LDS_F(off) ((LAS float*)(lds + EPI_OFF) + (off))

enum { K_QLAT = 0, K_KVLAT, K_KPE, K_RQ, K_RK, K_RV, K_RG, K_GS, K_QUP, K_KVP, K_KVS, K_GA, K_AD, K_GB, K_RD, K_OUT, K_UP, K_DOWN };
struct SchedP1 {
    int x, j; const char* ws;
    __device__ __forceinline__ bool next(int i, pg::UnitG& u) const {
        int pm, pn;
        if (!reg_unit(x, j, i, 18, pm, pn)) { if (i == 4 && j >= 16) { const int k = (j - 16) * 8 + x; if (k >= 26) return false; pm = 64; pn = k; } else return false; }
        u.pm = pm; u.pn = pn; u.A = ws + WS_XN + (size_t)pm * 256 * 2048; u.B = ws + WS_FWIN + (size_t)pn * 256 * 2048; u.lda = 2048; u.ldb = 2048; u.nt = 16; u.half = pm == 64;
        u.kind = pn < 3 ? K_QLAT : pn < 5 ? K_KVLAT : pn == 5 ? K_KPE : pn < 8 ? K_RQ : pn < 10 ? K_RK : pn < 14 ? K_RV : pn < 18 ? K_RG : K_GS;
        return true;
    }
};
struct EpiP1 {
    unsigned char* ws; float* out; const float *g_kvlat, *g_kr;
    __device__ __forceinline__ void operator()(const pg::Acc& acc, const pg::UnitG& u, LAS unsigned char* lds, int wr, int wc, int fr, int fq) const {
        bf16_t* const ZQ = (bf16_t*)(ws + WS_ZQ); bf16_t* const KVL = (bf16_t*)(ws + WS_KVL); bf16_t* const KPE = (bf16_t*)(ws + WS_KPE); bf16_t* const PES = (bf16_t*)(ws + WS_PES); bf16_t* const LATS = (bf16_t*)(ws + WS_LATS);
        bf16_t* const RQ = (bf16_t*)(ws + WS_RQ); bf16_t* const RK = (bf16_t*)(ws + WS_RK); bf16_t* const RV = (bf16_t*)(ws + WS_RV); bf16_t* const RG = (bf16_t*)(ws + WS_RG);
        float* const slotq = (float*)(ws + WS_SLOTQ); float* const slotkv = (float*)(ws + WS_SLOTKV);
        const float2* const tab32 = (const float2*)(ws + WS_TAB32); const float2* const tab64 = (const float2*)(ws + WS_TAB64);
        int rl0 = wr * 64 + fr, cw = wc * 32 + fq * 8; asm volatile("" : "+v"(rl0), "+v"(cw));
        const int kind = u.kind, rb = u.pm * 256 + rl0;
        if (kind == K_QLAT || kind == K_KVLAT) {
            const int t = kind == K_QLAT ? u.pn : u.pn - 3; const int ld = kind == K_QLAT ? Q_LORA : KV_LORA; bf16_t* dst = kind == K_QLAT ? ZQ : KVL;
            f32x4 g[2][2];
#pragma unroll
            for (int bj = 0; bj < 2; ++bj)
#pragma unroll
                for (int n = 0; n < 2; ++n) g[bj][n] = kind == K_KVLAT ? *(const f32x4*)(g_kvlat + t * 256 + bj * 128 + cw + 4 * n) : (f32x4){1.f, 1.f, 1.f, 1.f};
#pragma unroll
            for (int ai = 0; ai < 2; ++ai)
#pragma unroll
                for (int m = 0; m < 4; ++m) { const int row = rb + ai * 128 + m * 16; float ss = 0.f;
                    const bool snew = (kind == K_KVLAT) && row >= MP && row < MT;
                    const int rs = row - MP; bf16_t* lrow = LATS + ((size_t)(rs / DEC_SEQ) * SKEYS + PAST + (rs % DEC_SEQ)) * KV_LORA;
#pragma unroll
                    for (int bj = 0; bj < 2; ++bj) { const f32x4 v0 = acc[ai][bj][m][0], v1 = acc[ai][bj][m][1];
                        ss += (v0[0] * v0[0] + v0[1] * v0[1]) + (v0[2] * v0[2] + v0[3] * v0[3]) + (v1[0] * v1[0] + v1[1] * v1[1]) + (v1[2] * v1[2] + v1[3] * v1[3]);
                        const u32x4 w = pack8f(v0 * g[bj][0], v1 * g[bj][1]);
                        *(u32x4*)(dst + (size_t)row * ld + t * 256 + bj * 128 + cw) = w;
                        if (snew) *(u32x4*)(lrow + t * 256 + bj * 128 + cw) = w; }
                    ss += __shfl_xor(ss, 16); ss += __shfl_xor(ss, 32);
                    if (fq == 0) { if (kind == K_QLAT) slotq[(size_t)row * 12 + t * 4 + wc] = ss; else slotkv[(size_t)row * 8 + t * 4 + wc] = ss; } }
        } else if (kind == K_KPE) {
            if (wc != 0) return;
            const int d0 = fq * 8;
            f32x4 g1[2], g2[2];
#pragma unroll
            for (int n = 0; n < 2; ++n) { g1[n] = *(const f32x4*)(g_kr + d0 + 4 * n); g2[n] = *(const f32x4*)(g_kr + 32 + d0 + 4 * n); }
#pragma unroll
            for (int ai = 0; ai < 2; ++ai)
#pragma unroll
                for (int m = 0; m < 4; ++m) { const int row = rb + ai * 128 + m * 16; const int pos = row_pos(row < MT ? row : 0);
                    f32x4 x1[2], x2[2]; float ss = 0.f;
#pragma unroll
                    for (int n = 0; n < 2; ++n) { x1[n] = acc[ai][0][m][n]; x2[n] = acc[ai][1][m][n];
                        ss += (x1[n][0] * x1[n][0] + x1[n][1] * x1[n][1]) + (x1[n][2] * x1[n][2] + x1[n][3] * x1[n][3]) + (x2[n][0] * x2[n][0] + x2[n][1] * x2[n][1]) + (x2[n][2] * x2[n][2] + x2[n][3] * x2[n][3]); }
                    ss += __shfl_xor(ss, 16); ss += __shfl_xor(ss, 32);
                    const float inv = rsqrtf(ss * (1.f / 64.f) + EPS);
                    f32x4 o1[2], o2[2];
#pragma unroll
                    for (int n = 0; n < 2; ++n) { const f32x4 y1 = x1[n] * inv * g1[n], y2 = x2[n] * inv * g2[n];
                        const f32x4 cs0 = *(const f32x4*)(tab32 + pos * 32 + d0 + 4 * n), cs1 = *(const f32x4*)(tab32 + pos * 32 + d0 + 4 * n + 2);
                        const f32x4 c = {cs0[0], cs0[2], cs1[0], cs1[2]}, s = {cs0[1], cs0[3], cs1[1], cs1[3]};
                        o1[n] = y1 * c - y2 * s; o2[n] = y1 * s + y2 * c; }
                    *(u32x4*)(KPE + (size_t)row * 64 + d0) = pack8f(o1[0], o1[1]); *(u32x4*)(KPE + (size_t)row * 64 + 32 + d0) = pack8f(o2[0], o2[1]);
                    if (row < MT) {
                        float* o = row < MP ? out + O_RKP + (size_t)row * 64 : out + O_RKS + (size_t)(row - MP) * 64;
                        *(f32x4*)(o + d0) = o1[0]; *(f32x4*)(o + d0 + 4) = o1[1]; *(f32x4*)(o + 32 + d0) = o2[0]; *(f32x4*)(o + 32 + d0 + 4) = o2[1];
                        if (row >= MP) { const int rs = row - MP, b = rs / DEC_SEQ, tt = rs % DEC_SEQ; bf16_t* p = PES + ((size_t)b * SKEYS + PAST + tt) * 64;
                            *(u32x4*)(p + d0) = pack8f(o1[0], o1[1]); *(u32x4*)(p + 32 + d0) = pack8f(o2[0], o2[1]); } } }
        } else if (kind == K_RQ || kind == K_RK) {
            const int tl = kind == K_RQ ? u.pn - 6 : u.pn - 8; const int head = 2 * tl + (wc >> 1), i0 = 32 * (wc & 1) + fq * 8;
            bf16_t* dst = kind == K_RQ ? RQ : RK; const float sc = kind == K_RQ ? 1.0f : 0.08838834764831845f;
#pragma unroll
            for (int ai = 0; ai < 2; ++ai)
#pragma unroll
                for (int m = 0; m < 4; ++m) { const int row = rb + ai * 128 + m * 16; const int pos = row_pos(row < MT ? row : 0);
                    f32x4 o1[2], o2[2];
#pragma unroll
                    for (int n = 0; n < 2; ++n) { const f32x4 x1 = acc[ai][0][m][n], x2 = acc[ai][1][m][n];
                        const f32x4 cs0 = *(const f32x4*)(tab64 + pos * 64 + i0 + 4 * n), cs1 = *(const f32x4*)(tab64 + pos * 64 + i0 + 4 * n + 2);
                        const f32x4 c = {cs0[0], cs0[2], cs1[0], cs1[2]}, s = {cs0[1], cs0[3], cs1[1], cs1[3]};
                        o1[n] = (x1 * c - x2 * s) * sc; o2[n] = (x1 * s + x2 * c) * sc; }
                    *(u32x4*)(dst + (size_t)row * 512 + head * 128 + i0) = pack8f(o1[0], o1[1]); *(u32x4*)(dst + (size_t)row * 512 + head * 128 + 64 + i0) = pack8f(o2[0], o2[1]); }
        } else if (kind == K_GS) {
            bf16_t* dst = (bf16_t*)(ws + (u.pn < 22 ? WS_GAS : WS_GBS)); const int t = u.pn < 22 ? u.pn - 18 : u.pn - 22;
#pragma unroll
            for (int m = 0; m < 4; ++m) { const int rl = rl0 + m * 16;
#pragma unroll
                for (int bj = 0; bj < 2; ++bj) { f32x4 v0 = acc[0][bj][m][0], v1 = acc[0][bj][m][1];
#pragma unroll
                    for (int e = 0; e < 4; ++e) { v0[e] = 1.f / (1.f + __expf(-v0[e])); v1[e] = 1.f / (1.f + __expf(-v1[e])); }
                    *(u32x4*)(dst + (size_t)rl * 1024 + t * 256 + bj * 128 + cw) = pack8f(v0, v1); } }
        } else {
            const int t = kind == K_RV ? u.pn - 10 : u.pn - 14; bf16_t* dst = kind == K_RV ? RV : RG;
#pragma unroll
            for (int ai = 0; ai < 2; ++ai)
#pragma unroll
                for (int m = 0; m < 4; ++m) { const int row = rb + ai * 128 + m * 16;
#pragma unroll
                    for (int bj = 0; bj < 2; ++bj) { f32x4 v0 = acc[ai][bj][m][0], v1 = acc[ai][bj][m][1];
                        if (kind == K_RG) {
#pragma unroll
                            for (int e = 0; e < 4; ++e) { v0[e] = v0[e] / (1.f + __expf(-v0[e])); v1[e] = v1[e] / (1.f + __expf(-v1[e])); } }
                        *(u32x4*)(dst + (size_t)row * 1024 + t * 256 + bj * 128 + cw) = pack8f(v0, v1); } }
        }
    }
};
__device__ __forceinline__ void p1_inproj(Frame& F) {
    SchedP1 S{F.x, F.j, (const char*)F.ws};
    EpiP1 E{F.ws, F.out, FIN(12), FIN(15)};
    pg::gemm_stream(F.lds, S, E);
}

__device__ __forceinline__ float slot_rs(const float* slots, int n, float invn) {
    float a = 0.f; for (int i = 0; i < n; i += 4) { const f32x4 v = *(const f32x4*)(slots + i); a += (v[0] + v[1]) + (v[2] + v[3]); } return rsqrtf(a * invn + EPS);
}
struct SchedP2 {
    int x, j; const char* ws; int sample;
    __device__ __forceinline__ bool next(int i, pg::UnitG& u) const {
        int pm, pn, kind;
        if (sample) {
            if (i < 2) { reg_unit(x, j, i, 8, pm, pn); kind = K_QUP; }
            else if (i < 4) { reg_unit(x, j, i - 2, 8, pm, pn); kind = K_KVS; }
            else if (i == 4 && j < 2) { const int k = j * 8 + x; pm = 64; pn = k & 7; kind = k < 8 ? K_QUP : K_KVS; }
            else return false;
        } else { if (i >= 2) return false; reg_unit(x, j, i, 8, pm, pn); kind = K_KVP; }
        u.pm = pm; u.pn = pn; u.kind = kind; u.half = pm == 64;
        if (kind == K_QUP) { u.A = ws + WS_ZQ + (size_t)pm * 256 * 1536; u.lda = 1536; u.B = ws + WS_FWQUP + (size_t)pn * 256 * 1536; u.ldb = 1536; u.nt = 12; }
        else { u.A = ws + (kind == K_KVS ? WS_LATS : WS_KVL) + (size_t)pm * 256 * 1024; u.lda = 1024; u.B = ws + WS_FWKVUP + (size_t)pn * 256 * 1024; u.ldb = 1024; u.nt = 8; }
        return true;
    }
};
struct EpiP2 {
    unsigned char* ws; float* out; const float *g_qn, *g_qr, *g_kn;
    __device__ __forceinline__ void operator()(const pg::Acc& acc, const pg::UnitG& u, LAS unsigned char* lds, int wr, int wc, int fr, int fq) const {
        int rl0 = wr * 64 + fr, cw = wc * 32 + fq * 8; asm volatile("" : "+v"(rl0), "+v"(cw));
        const int kind = u.kind, h = u.pn, rb = u.pm * 256 + rl0;
        const float* const slotq = (const float*)(ws + WS_SLOTQ); const float* const slotkv = (const float*)(ws + WS_SLOTKV);
        float rs[2][4];
#pragma unroll
        for (int ai = 0; ai < 2; ++ai)
#pragma unroll
            for (int m = 0; m < 4; ++m) { const int row = rb + ai * 128 + m * 16;
                if (kind == K_QUP) rs[ai][m] = slot_rs(slotq + (size_t)row * 12, 12, 1.f / Q_LORA);
                else if (kind == K_KVP) rs[ai][m] = slot_rs(slotkv + (size_t)row * 8, 8, 1.f / KV_LORA);
                else { const int b = row / SKEYS, jj = row - b * SKEYS; rs[ai][m] = (row < LROWS && jj >= PAST) ? slot_rs(slotkv + (size_t)(MP + b * DEC_SEQ + jj - PAST) * 8, 8, 1.f / KV_LORA) : 1.f; } }
#pragma unroll
        for (int ai = 0; ai < 2; ++ai)
#pragma unroll
            for (int m = 0; m < 4; ++m) { float p0 = 0.f, p1 = 0.f; const float s2 = rs[ai][m] * rs[ai][m];
#pragma unroll
                for (int n = 0; n < 2; ++n) { const f32x4 a = acc[ai][0][m][n], b = acc[ai][1][m][n];
                    p0 += (a[0] * a[0] + a[1] * a[1]) + (a[2] * a[2] + a[3] * a[3]); p1 += (b[0] * b[0] + b[1] * b[1]) + (b[2] * b[2] + b[3] * b[3]); }
                p0 += __shfl_xor(p0, 16); p0 += __shfl_xor(p0, 32); p1 += __shfl_xor(p1, 16); p1 += __shfl_xor(p1, 32);
                if (fq == 0) { LAS float* d = LDS_F((rl0 + ai * 128 + m * 16) * 8 + wc * 2); d[0] = p0 * s2; d[1] = p1 * s2; } }
        asm volatile("s_waitcnt lgkmcnt(0)" ::: "memory"); __builtin_amdgcn_s_barrier(); asm volatile("" ::: "memory");
        if (kind == K_QUP) {
            bf16_t* const Q = (bf16_t*)out;
            const float2* const tab32 = (const float2*)(ws + WS_TAB32);
            const float C2 = 0.07216878364870323f * 1.4426950408889634f;
            f32x4 gn[2]; gn[0] = *(const f32x4*)(g_qn + cw); gn[1] = *(const f32x4*)(g_qn + cw + 4);
            const int ir = 16 * (wc & 1) + 4 * fq; const f32x4 gr1 = *(const f32x4*)(g_qr + ir), gr2 = *(const f32x4*)(g_qr + 32 + ir);
#pragma unroll
            for (int ai = 0; ai < 2; ++ai)
#pragma unroll
                for (int m = 0; m < 4; ++m) { const int row = rb + ai * 128 + m * 16; const int pos = row_pos(row < MT ? row : 0);
                    const LAS float* d = LDS_F((rl0 + ai * 128 + m * 16) * 8); const f32x4 e0 = *(const LAS f32x4*)d, e1 = *(const LAS f32x4*)(d + 4);
                    const float inn = rsqrtf((e0[0] + e0[2] + e1[0] + e1[2]) * (1.f / 128.f) + EPS) * rs[ai][m] * C2, inr = rsqrtf((e0[1] + e0[3]) * (1.f / 64.f) + EPS) * rs[ai][m];
                    bf16_t* qrow = Q + (size_t)row * 1536 + h * 192;
                    *(u32x4*)(qrow + cw) = pack8f(acc[ai][0][m][0] * inn * gn[0], acc[ai][0][m][1] * inn * gn[1]);
                    if (wc < 2) { const f32x4 y1 = acc[ai][1][m][0] * inr * gr1, y2 = acc[ai][1][m][1] * inr * gr2;
                        const f32x4 cs0 = *(const f32x4*)(tab32 + pos * 32 + ir), cs1 = *(const f32x4*)(tab32 + pos * 32 + ir + 2);
                        const f32x4 c = {cs0[0], cs0[2], cs1[0], cs1[2]}, s = {cs0[1], cs0[3], cs1[1], cs1[3]};
                        const f32x4 o1 = (y1 * c - y2 * s) * C2, o2 = (y1 * s + y2 * c) * C2;
                        u32x2 w1, w2; w1.x = cvt_pk_bf16(o1[0], o1[1]); w1.y = cvt_pk_bf16(o1[2], o1[3]); w2.x = cvt_pk_bf16(o2[0], o2[1]); w2.y = cvt_pk_bf16(o2[2], o2[3]);
                        *(u32x2*)(qrow + 128 + ir) = w1; *(u32x2*)(qrow + 160 + ir) = w2; } }
        } else {
            bf16_t* const KN = (bf16_t*)(ws + WS_KN); bf16_t* const V = (bf16_t*)(ws + WS_V);
            f32x4 gk[2]; gk[0] = *(const f32x4*)(g_kn + cw); gk[1] = *(const f32x4*)(g_kn + cw + 4);
#pragma unroll
            for (int ai = 0; ai < 2; ++ai)
#pragma unroll
                for (int m = 0; m < 4; ++m) { const int row = rb + ai * 128 + m * 16;
                    const LAS float* d = LDS_F((rl0 + ai * 128 + m * 16) * 8); const f32x4 e0 = *(const LAS f32x4*)d, e1 = *(const LAS f32x4*)(d + 4);
                    const float s = rs[ai][m], inn = rsqrtf((e0[0] + e0[2] + e1[0] + e1[2]) * (1.f / 128.f) + EPS) * s;
                    *(u32x4*)(KN + (size_t)row * 1024 + h * 128 + cw) = pack8f(acc[ai][0][m][0] * inn * gk[0], acc[ai][0][m][1] * inn * gk[1]);
                    *(u32x4*)(V + (size_t)row * 1024 + h * 128 + cw) = pack8f(acc[ai][1][m][0] * s, acc[ai][1][m][1] * s); }
        }
    }
};
__device__ __forceinline__ void p2_qkv(Frame& F, int sample) {
    SchedP2 S{F.x, F.j, (const char*)F.ws, sample};
    EpiP2 E{F.ws, F.out, FIN(10), FIN(11), FIN(14)};
    pg::gemm_stream(F.lds, S, E);
}

struct SchedP5 {
    int x, j, vcu; const char* ws; int phase;
    __device__ __forceinline__ const char* arow(size_t base, size_t base_s, int pm, size_t rowbytes) const { return ws + (pm < 64 ? base + (size_t)pm * 256 * rowbytes : base_s); }
    __device__ __forceinline__ bool next(int i, pg::UnitG& u) const {
        int pm, pn;
        if (phase == 5) {
            int sub;
            if (i < 4) { sub = i; pm = 8 * x + (j & 7); pn = j >> 3; } else if (i < 6 && j == 0 && x < 4) { sub = i == 4 ? 1 : 3; pm = 64; pn = x; } else return false;
            u.pm = pm; u.pn = pn; u.kind = K_GA + sub; u.lda = 2048; u.ldb = 2048; u.nt = 16; u.half = pm == 64;
            if (sub == 0) { u.A = ws + WS_XN2 + (size_t)pm * 256 * 2048; u.B = ws + WS_FWIN + (size_t)(18 + pn) * 256 * 2048; }
            else if (sub == 1) { u.A = arow(WS_ATT, WS_ATTS, pm, 2048); u.B = ws + WS_FWOBA + (size_t)pn * 256 * 2048; }
            else if (sub == 2) { u.A = ws + WS_XN2 + (size_t)pm * 256 * 2048; u.B = ws + WS_FWIN + (size_t)(22 + pn) * 256 * 2048; }
            else { u.A = ws + WS_RET + (size_t)pm * 256 * 2048; u.B = ws + WS_FWOBB + (size_t)pn * 256 * 2048; }
            return true;
        }
        if (phase == 6 || phase == 9) {
            if (i == 0) { pm = 8 * x + (j & 7); pn = j >> 3; } else if (i == 1 && j == 0 && x < 4) { pm = 64; pn = x; } else return false;
            u.pm = pm; u.pn = pn; u.half = pm == 64;
            if (phase == 6) { u.kind = K_OUT; u.A = ws + WS_MERGED + (size_t)pm * 256 * 2048; u.lda = 2048; u.B = ws + WS_FWOUT + (size_t)pn * 256 * 2048; u.ldb = 2048; u.nt = 16; }
            else { u.kind = K_DOWN; u.A = ws + WS_U + (size_t)pm * 256 * (FF2 * 2); u.lda = FF2 * 2; u.B = ws + WS_FWDOWN + (size_t)pn * 256 * (D_FF * 2); u.ldb = D_FF * 2; u.nt = 44; }
            return true;
        }
        if (!reg_unit(x, j, i, 22, pm, pn)) { if (i == 5 && j >= 16) { const int k = (j - 16) * 8 + x; if (k >= 22) return false; pm = 64; pn = k; } else return false; }
        u.half = pm == 64; u.pm = pm; u.pn = pn; u.kind = K_UP; u.A = ws + WS_X1B + (size_t)pm * 256 * 2048; u.lda = 2048; u.B = ws + WS_FWUP + (size_t)pn * 256 * 2048; u.ldb = 2048; u.nt = 16;
        return true;
    }
};
struct EpiP5 {
    unsigned char* ws; float* out; const float* xp; const float* xs; int vcu;
    __device__ __forceinline__ void operator()(pg::Acc& acc, const pg::UnitG& u, LAS unsigned char* lds, int wr, int wc, int fr, int fq) const {
        int rl0 = wr * 64 + fr, cw = wc * 32 + fq * 8; asm volatile("" : "+v"(rl0), "+v"(cw));
        const int kind = u.kind, rb = u.pm * 256 + rl0;
        if (kind >= K_GA && kind <= K_RD) {
            bf16_t* const T1 = (bf16_t*)(ws + WS_T1) + (size_t)vcu * 65536; bf16_t* const T2 = (bf16_t*)out + (size_t)vcu * 65536;
            bf16_t* const MG = (bf16_t*)(ws + WS_MERGED);
#pragma unroll
            for (int ai = 0; ai < 2; ++ai)
#pragma unroll
                for (int m = 0; m < 4; ++m)
#pragma unroll
                    for (int bj = 0; bj < 2; ++bj) { const size_t so = (size_t)(rl0 + ai * 128 + m * 16) * 256 + bj * 128 + cw;
                        f32x4 v0 = acc[ai][bj][m][0], v1 = acc[ai][bj][m][1];
                        if (kind == K_GA || kind == K_GB) {
#pragma unroll
                            for (int e = 0; e < 4; ++e) { v0[e] = 1.f / (1.f + __expf(-v0[e])); v1[e] = 1.f / (1.f + __expf(-v1[e])); }
                            *(u32x4*)((kind == K_GA ? T1 : T2) + so) = pack8f(v0, v1);
                        } else if (kind == K_AD) {
                            const u32x4 t = u.pm == 64 ? *(const u32x4*)((const bf16_t*)(ws + WS_GAS) + (size_t)(rl0 + ai * 128 + m * 16) * 1024 + u.pn * 256 + bj * 128 + cw) : *(const u32x4*)(T1 + so);
                            const f32x4 g0 = {__uint_as_float(t.x << 16), __uint_as_float(t.x & 0xffff0000u), __uint_as_float(t.y << 16), __uint_as_float(t.y & 0xffff0000u)};
                            const f32x4 g1 = {__uint_as_float(t.z << 16), __uint_as_float(t.z & 0xffff0000u), __uint_as_float(t.w << 16), __uint_as_float(t.w & 0xffff0000u)};
                            *(u32x4*)(T1 + so) = pack8f(v0 * g0, v1 * g1);
                        } else {
                            const u32x4 t = *(const u32x4*)(T1 + so), q = u.pm == 64 ? *(const u32x4*)((const bf16_t*)(ws + WS_GBS) + (size_t)(rl0 + ai * 128 + m * 16) * 1024 + u.pn * 256 + bj * 128 + cw) : *(const u32x4*)(T2 + so);
                            const f32x4 a0 = {__uint_as_float(t.x << 16), __uint_as_float(t.x & 0xffff0000u), __uint_as_float(t.y << 16), __uint_as_float(t.y & 0xffff0000u)};
                            const f32x4 a1 = {__uint_as_float(t.z << 16), __uint_as_float(t.z & 0xffff0000u), __uint_as_float(t.w << 16), __uint_as_float(t.w & 0xffff0000u)};
                            const f32x4 g0 = {__uint_as_float(q.x << 16), __uint_as_float(q.x & 0xffff0000u), __uint_as_float(q.y << 16), __uint_as_float(q.y & 0xffff0000u)};
                            const f32x4 g1 = {__uint_as_float(q.z << 16), __uint_as_float(q.z & 0xffff0000u), __uint_as_float(q.w << 16), __uint_as_float(q.w & 0xffff0000u)};
                            *(u32x4*)(MG + (size_t)(rb + ai * 128 + m * 16) * 1024 + u.pn * 256 + bj * 128 + cw) = pack8f(a0 + v0 * g0, a1 + v1 * g1);
                        }
                        if (bj == 1 && (m & 1)) asm volatile("" ::: "memory"); }
        } else if (kind == K_OUT) {
            float* const slotx = (float*)(ws + WS_SLOTX1); bf16_t* const X1B = (bf16_t*)(ws + WS_X1B);
#pragma unroll
            for (int ai = 0; ai < 2; ++ai)
#pragma unroll
                for (int m = 0; m < 4; ++m) { const int row = rb + ai * 128 + m * 16; float ss = 0.f;
                    const float* xr = row < MP ? xp + (size_t)row * D_MODEL : xs + (size_t)((row < MT ? row : MP) - MP) * D_MODEL;
#pragma unroll
                    for (int bj = 0; bj < 2; ++bj) { const int c = u.pn * 256 + bj * 128 + cw;
                        const f32x4 x0 = *(const f32x4*)(xr + c), x1 = *(const f32x4*)(xr + c + 4);
                        const f32x4 v0 = acc[ai][bj][m][0] + x0, v1 = acc[ai][bj][m][1] + x1;
                        ss += (v0[0] * v0[0] + v0[1] * v0[1]) + (v0[2] * v0[2] + v0[3] * v0[3]) + (v1[0] * v1[0] + v1[1] * v1[1]) + (v1[2] * v1[2] + v1[3] * v1[3]);
                        if (row < MT) { *(f32x4*)(out + (size_t)row * D_MODEL + c) = v0; *(f32x4*)(out + (size_t)row * D_MODEL + c + 4) = v1; }
                        *(u32x4*)(X1B + (size_t)row * D_MODEL + c) = pack8f(v0, v1); }
                    ss += __shfl_xor(ss, 16); ss += __shfl_xor(ss, 32);
                    if (fq == 0) slotx[(size_t)row * 16 + u.pn * 4 + wc] = ss;
                    asm volatile("" ::: "memory"); }
        } else if (kind == K_UP) {
            const float* const slotx = (const float*)(ws + WS_SLOTX1); bf16_t* const U = (bf16_t*)(ws + WS_U);
#pragma unroll
            for (int ai = 0; ai < 2; ++ai)
#pragma unroll
                for (int m = 0; m < 4; ++m) { const int row = rb + ai * 128 + m * 16;
                    float a = 0.f;
#pragma unroll
                    for (int i = 0; i < 16; i += 4) { const f32x4 v = *(const f32x4*)(slotx + (size_t)row * 16 + i); a += (v[0] + v[1]) + (v[2] + v[3]); }
                    const float s = rsqrtf(a * (1.f / D_MODEL) + EPS);
                    const f32x4 ug0 = acc[ai][0][m][0] * s, ug1 = acc[ai][0][m][1] * s, uv0 = acc[ai][1][m][0] * s, uv1 = acc[ai][1][m][1] * s;
                    const u32x4 wg = pack8f(ug0, ug1), wv = pack8f(uv0, uv1); const int cg = u.pn * 128 + cw, cv = D_FF + cg;
                    *(u32x4*)(U + (size_t)row * FF2 + cg) = wg; *(u32x4*)(U + (size_t)row * FF2 + cv) = wv;
                    if ((row & 255) >= 254 && row < MP - 2) { bf16_t* hp = (bf16_t*)(ws + WS_HALO) + ((size_t)((row >> 8) + 1) * 2 + (row & 1)) * FF2; *(u32x4*)(hp + cg) = wg; *(u32x4*)(hp + cv) = wv; }
                    if (row < MT) { const int tpos = row < MP ? (row & (SEQ - 1)) - (SEQ - 2) : ((row - MP) & (DEC_SEQ - 1)) - (DEC_SEQ - 2);
                        if (tpos >= 0) { float* cp = row < MP ? out + O_CONVP + ((size_t)(row >> 13) * 2 + tpos) * FF2 : out + O_CONVS + ((size_t)((row - MP) >> 4) * 2 + tpos) * FF2;
                            *(f32x4*)(cp + cg) = ug0; *(f32x4*)(cp + cg + 4) = ug1; *(f32x4*)(cp + cv) = uv0; *(f32x4*)(cp + cv + 4) = uv1; } }
                    if (m & 1) asm volatile("" ::: "memory"); }
        } else {
#pragma unroll
            for (int ai = 0; ai < 2; ++ai)
#pragma unroll
                for (int m = 0; m < 4; ++m) { const int row = rb + ai * 128 + m * 16; if (row >= MT) continue;
#pragma unroll
                    for (int bj = 0; bj < 2; ++bj) { float* p = out + (size_t)row * D_MODEL + u.pn * 256 + bj * 128 + cw;
                        const f32x4 x0 = *(const f32x4*)p, x1 = *(const f32x4*)(p + 4);
                        *(f32x4*)p = x0 + acc[ai][bj][m][0]; *(f32x4*)(p + 4) = x1 + acc[ai][bj][m][1]; }
                    asm volatile("" ::: "memory"); }
        }
    }
};
__device__ __forceinline__ void p5_gemm(Frame& F, int phase) {
    SchedP5 S{F.x, F.j, F.vcu, (const char*)F.ws, phase};
    EpiP5 E{F.ws, F.out, FIN(0), FIN(1), F.vcu};
    pg::gemm_stream(F.lds, S, E);
}

namespace rt {
typedef short s16x4 __attribute__((ext_vector_type(4)));
constexpr int QST = 136, KDST = 144, VST = 272, PST = 72;
constexpr int Q_OFF = 0, QS_OFF = 17408, K_OFF = 34816, KD_OFF = 52224, V_OFF = 70656, P_OFF = 105472, ST_OFF = 114688;
constexpr int SC_TOK = 256, NSC = SEQ / SC_TOK;
__device__ __forceinline__ s16x4 trrd(const LAS bf16_t* p) { return __builtin_bit_cast(s16x4, __builtin_amdgcn_ds_read_tr16_b64_v4i16((LAS s16x4*)p)); }
__device__ __forceinline__ bf16x8 cat8(s16x4 lo, s16x4 hi) { return (bf16x8){lo[0], lo[1], lo[2], lo[3], hi[0], hi[1], hi[2], hi[3]}; }
__device__ __forceinline__ u32x4 scale8(u32x4 w, float s) {
    u32x4 o;
    o.x = cvt_pk_bf16(__uint_as_float(w.x << 16) * s, __uint_as_float(w.x & 0xffff0000u) * s); o.y = cvt_pk_bf16(__uint_as_float(w.y << 16) * s, __uint_as_float(w.y & 0xffff0000u) * s);
    o.z = cvt_pk_bf16(__uint_as_float(w.z << 16) * s, __uint_as_float(w.z & 0xffff0000u) * s); o.w = cvt_pk_bf16(__uint_as_float(w.w << 16) * s, __uint_as_float(w.w & 0xffff0000u) * s);
    return o;
}
template <bool FULL>
__device__ __forceinline__ void ret_unit(Frame& F, int h, int row0, int nch, int L, const float* Sin, float* Sout, const float* g_ret) {
    LAS unsigned char* lds = F.lds;
    const int tid = F.tid, w = F.wave, l = F.lane, fr = l & 15, g = l >> 4, tq = fr >> 2, tp = fr & 3;
    const float lg2 = log2f(1.f - exp2f(-5.f - (float)h));
    const bf16_t* RQ = (const bf16_t*)(F.ws + WS_RQ); const bf16_t* RK = (const bf16_t*)(F.ws + WS_RK); const bf16_t* RV = (const bf16_t*)(F.ws + WS_RV);
    const bf16_t* RG = (const bf16_t*)(F.ws + WS_RG); bf16_t* RET = (bf16_t*)(F.ws + WS_RET);
    LAS bf16_t* q_l = (LAS bf16_t*)(lds + Q_OFF); LAS bf16_t* qs_l = (LAS bf16_t*)(lds + QS_OFF); LAS bf16_t* k_l = (LAS bf16_t*)(lds + K_OFF);
    LAS bf16_t* kd_l = (LAS bf16_t*)(lds + KD_OFF); LAS bf16_t* v_l = (LAS bf16_t*)(lds + V_OFF); LAS bf16_t* p_l = (LAS bf16_t*)(lds + P_OFF); LAS float* st_l = (LAS float*)(lds + ST_OFF);
    f32x4 S[8][2];
#pragma unroll
    for (int db = 0; db < 8; ++db)
#pragma unroll
        for (int nb = 0; nb < 2; ++nb) {
            if (Sin) {
#pragma unroll
                for (int r = 0; r < 4; ++r) S[db][nb][r] = Sin[(size_t)(16 * db + 4 * g + r) * RET_DV + 32 * w + 16 * nb + fr]; }
            else S[db][nb] = (f32x4){0.f, 0.f, 0.f, 0.f}; }
    const float gL = exp2f(lg2 * (float)L);
    for (int c = 0; c < nch; ++c) {
        const size_t r0 = (size_t)row0 + (size_t)c * L;
        __syncthreads();
#pragma unroll
        for (int it = 0; it < 2; ++it) { const int idx = tid + 512 * it, tok = idx >> 4, c8 = idx & 15; const bool ok = tok < L;
            u32x4 kk = {0u, 0u, 0u, 0u}, qq = {0u, 0u, 0u, 0u};
            if (ok) { kk = *(const u32x4*)(RK + (r0 + tok) * 512 + h * 128 + c8 * 8); if (FULL) qq = *(const u32x4*)(RQ + (r0 + tok) * 512 + h * 128 + c8 * 8); }
            *(LAS u32x4*)(kd_l + tok * KDST + c8 * 8) = scale8(kk, exp2f(lg2 * (float)(L - 1 - tok)));
            if (FULL) { *(LAS u32x4*)(k_l + tok * QST + c8 * 8) = kk; *(LAS u32x4*)(q_l + tok * QST + c8 * 8) = qq; *(LAS u32x4*)(qs_l + tok * QST + c8 * 8) = scale8(qq, exp2f(lg2 * (float)(tok + 1))); } }
#pragma unroll
        for (int it = 0; it < 4; ++it) { const int idx = tid + 512 * it, tok = idx >> 5, c8 = idx & 31; u32x4 vv = {0u, 0u, 0u, 0u};
            if (tok < L) vv = *(const u32x4*)(RV + (r0 + tok) * 1024 + h * 256 + c8 * 8);
            *(LAS u32x4*)(v_l + tok * VST + c8 * 8) = vv; }
        __syncthreads();
        f32x4 o[4][2];
        if (FULL) {
            const int ib = w >> 1, jb0 = 2 * (w & 1);
            f32x4 p0 = {0.f, 0.f, 0.f, 0.f}, p1 = {0.f, 0.f, 0.f, 0.f};
#pragma unroll
            for (int s = 0; s < 4; ++s) { const bf16x8 a = *(const LAS bf16x8*)(q_l + (16 * ib + fr) * QST + 32 * s + 8 * g);
                const bf16x8 b0 = *(const LAS bf16x8*)(k_l + (16 * jb0 + fr) * QST + 32 * s + 8 * g), b1 = *(const LAS bf16x8*)(k_l + (16 * jb0 + 16 + fr) * QST + 32 * s + 8 * g);
                p0 = __builtin_amdgcn_mfma_f32_16x16x32_bf16(a, b0, p0, 0, 0, 0); p1 = __builtin_amdgcn_mfma_f32_16x16x32_bf16(a, b1, p1, 0, 0, 0); }
#pragma unroll
            for (int r = 0; r < 4; ++r) { const int i = 16 * ib + 4 * g + r, j0 = 16 * jb0 + fr, j1 = j0 + 16;
                const float v0 = j0 <= i ? p0[r] * exp2f(lg2 * (float)(i - j0)) : 0.f, v1 = j1 <= i ? p1[r] * exp2f(lg2 * (float)(i - j1)) : 0.f;
                p_l[i * PST + j0] = f2bf(v0); p_l[i * PST + j1] = f2bf(v1); }
            __syncthreads();
#pragma unroll
            for (int i = 0; i < 4; ++i) { o[i][0] = (f32x4){0.f, 0.f, 0.f, 0.f}; o[i][1] = (f32x4){0.f, 0.f, 0.f, 0.f}; }
        }
        bf16x8 vf[2][2];
#pragma unroll
        for (int s = 0; s < 2; ++s)
#pragma unroll
            for (int nb = 0; nb < 2; ++nb) { const LAS bf16_t* p = v_l + (32 * s + 8 * g + tq) * VST + 32 * w + 16 * nb + 4 * tp; vf[s][nb] = cat8(trrd(p), trrd(p + 4 * VST)); }
        if (FULL) {
#pragma unroll
            for (int i = 0; i < 4; ++i)
#pragma unroll
                for (int s = 0; s < 2; ++s) { const bf16x8 a = *(const LAS bf16x8*)(p_l + (16 * i + fr) * PST + 32 * s + 8 * g);
                    o[i][0] = __builtin_amdgcn_mfma_f32_16x16x32_bf16(a, vf[s][0], o[i][0], 0, 0, 0); o[i][1] = __builtin_amdgcn_mfma_f32_16x16x32_bf16(a, vf[s][1], o[i][1], 0, 0, 0); }
#pragma unroll
            for (int s = 0; s < 4; ++s) {
                bf16x8 bS[2];
#pragma unroll
                for (int nb = 0; nb < 2; ++nb) { u32x4 wv; wv.x = cvt_pk_bf16(S[2 * s][nb][0], S[2 * s][nb][1]); wv.y = cvt_pk_bf16(S[2 * s][nb][2], S[2 * s][nb][3]);
                    wv.z = cvt_pk_bf16(S[2 * s + 1][nb][0], S[2 * s + 1][nb][1]); wv.w = cvt_pk_bf16(S[2 * s + 1][nb][2], S[2 * s + 1][nb][3]); bS[nb] = __builtin_bit_cast(bf16x8, wv); }
#pragma unroll
                for (int i = 0; i < 4; ++i) { const LAS bf16_t* qp = qs_l + (16 * i + fr) * QST + 32 * s + 4 * g;
                    const s16x4 lo = *(const LAS s16x4*)qp, hi = *(const LAS s16x4*)(qp + 16); const bf16x8 a = cat8(lo, hi);
                    o[i][0] = __builtin_amdgcn_mfma_f32_16x16x32_bf16(a, bS[0], o[i][0], 0, 0, 0); o[i][1] = __builtin_amdgcn_mfma_f32_16x16x32_bf16(a, bS[1], o[i][1], 0, 0, 0); }
            }
        }
#pragma unroll
        for (int db = 0; db < 8; ++db) { S[db][0] = S[db][0] * gL; S[db][1] = S[db][1] * gL; }
#pragma unroll
        for (int s = 0; s < 2; ++s)
#pragma unroll
            for (int db = 0; db < 8; ++db) { const LAS bf16_t* p = kd_l + (32 * s + 8 * g + tq) * KDST + 16 * db + 4 * tp; const bf16x8 a = cat8(trrd(p), trrd(p + 4 * KDST));
                S[db][0] = __builtin_amdgcn_mfma_f32_16x16x32_bf16(a, vf[s][0], S[db][0], 0, 0, 0); S[db][1] = __builtin_amdgcn_mfma_f32_16x16x32_bf16(a, vf[s][1], S[db][1], 0, 0, 0); }
        if (FULL) {
#pragma unroll
            for (int i = 0; i < 4; ++i)
#pragma unroll
                for (int r = 0; r < 4; ++r) { float sm = o[i][0][r] + o[i][1][r], sq = o[i][0][r] * o[i][0][r] + o[i][1][r] * o[i][1][r];
                    sm += __shfl_xor(sm, 1); sq += __shfl_xor(sq, 1); sm += __shfl_xor(sm, 2); sq += __shfl_xor(sq, 2); sm += __shfl_xor(sm, 4); sq += __shfl_xor(sq, 4); sm += __shfl_xor(sm, 8); sq += __shfl_xor(sq, 8);
                    if (fr == 0) { LAS float* d = st_l + ((16 * i + 4 * g + r) * 8 + w) * 2; d[0] = sm; d[1] = sq; } }
            __syncthreads();
#pragma unroll
            for (int i = 0; i < 4; ++i)
#pragma unroll
                for (int r = 0; r < 4; ++r) { const int tok = 16 * i + 4 * g + r; if (tok >= L) continue;
                    const LAS f32x4* d = (const LAS f32x4*)(st_l + tok * 16); const f32x4 a0 = d[0], a1 = d[1], a2 = d[2], a3 = d[3];
                    const float sm = (a0[0] + a0[2]) + (a1[0] + a1[2]) + (a2[0] + a2[2]) + (a3[0] + a3[2]), sq = (a0[1] + a0[3]) + (a1[1] + a1[3]) + (a2[1] + a2[3]) + (a3[1] + a3[3]);
                    const float mu = sm * (1.f / 256.f), var = fmaxf(sq * (1.f / 256.f) - mu * mu, 0.f), rstd = rsqrtf(var + EPS);
#pragma unroll
                    for (int nb = 0; nb < 2; ++nb) { const int col = h * 256 + 32 * w + 16 * nb + fr; const size_t gi = (r0 + tok) * 1024 + col;
                        RET[gi] = f2bf((o[i][nb][r] - mu) * rstd * g_ret[col] * bf2f(RG[gi])); } }
        }
    }
    if (Sout) {
#pragma unroll
        for (int db = 0; db < 8; ++db)
#pragma unroll
            for (int nb = 0; nb < 2; ++nb)
#pragma unroll
                for (int r = 0; r < 4; ++r) Sout[(size_t)(16 * db + 4 * g + r) * RET_DV + 32 * w + 16 * nb + fr] = S[db][nb][r];
    }
}
}
__device__ __forceinline__ void r1_states(Frame& F) {
    const int bh = F.vcu >> 5, sc = F.vcu & 31, b = bh >> 2, h = bh & 3;
    rt::ret_unit<false>(F, h, b * SEQ + sc * rt::SC_TOK, 4, 64, nullptr, F.out + ((size_t)bh * rt::NSC + sc) * 32768, nullptr);
}
__device__ __forceinline__ void r2_scan(Frame& F) {
    float* U = F.out; const int gt = F.vcu * NTHR + F.tid;
    for (int e = gt; e < 8 * 32768; e += F.G * NTHR) { const int bh = e >> 15, idx = e & 32767, h = bh & 3;
        const float g256 = exp2f(log2f(1.f - exp2f(-5.f - (float)h)) * 256.f);
        float u[32];
#pragma unroll
        for (int sc = 0; sc < 32; ++sc) u[sc] = U[((size_t)bh * 32 + sc) * 32768 + idx];
        float carry = 0.f;
#pragma unroll
        for (int sc = 0; sc < 32; ++sc) { U[((size_t)bh * 32 + sc) * 32768 + idx] = carry; carry = g256 * carry + u[sc]; }
        F.out[O_RETP + (size_t)bh * 32768 + idx] = carry; }
}
__device__ __forceinline__ void r3_outputs(Frame& F) {
    const int bh = F.vcu >> 5, sc = F.vcu & 31, b = bh >> 2, h = bh & 3;
    rt::ret_unit<true>(F, h, b * SEQ + sc * rt::SC_TOK, 4, 64, F.out + ((size_t)bh * rt::NSC + sc) * 32768, nullptr, FIN(16));
    if (F.vcu < DEC_BATCH * RET_H) { const int sb = F.vcu >> 2, sh = F.vcu & 3;
        rt::ret_unit<true>(F, sh, MP + sb * DEC_SEQ, 1, DEC_SEQ, FIN(4) + (size_t)F.vcu * 32768, F.out + O_RETS + (size_t)F.vcu * 32768, FIN(16)); }
}

namespace at {
typedef float f32x16 __attribute__((ext_vector_type(16)));
typedef short s16x4 __attribute__((ext_vector_type(4)));
constexpr int KN_ST = 272, KP_ST = 144;
constexpr int KN_B = 64 * KN_ST, KP_B = 64 * KP_ST, V_B = 16384, BUF_B = KN_B + KP_B + V_B;
constexpr int SCR_OFF = 2 * BUF_B;
constexpr float THR = 8.f;
__device__ __forceinline__ int v_st(int k, int c) { const int kk = (k & ~0xC) | ((k & 4) << 1) | ((k & 8) >> 1); return ((kk >> 3) * 4 + (c >> 5)) * 512 + ((kk & 7) * 32 + (c & 31)) * 2; }
__device__ __forceinline__ int v_rd_base(int lane) { return ((lane & 3) << 3) | (((lane >> 2) & 3) << 6) | (((lane >> 4) & 1) << 5) | (((lane >> 5) & 1) << 8); }
constexpr int v_rd_off(int d0, int ks, int half) { return d0 * 512 + ks * 4096 + half * 2048; }
__device__ __forceinline__ int crow(int r, int hi) { return (r & 3) + 8 * (r >> 2) + 4 * hi; }
#define AT_SBAR() __builtin_amdgcn_sched_barrier(0)

__device__ __forceinline__ void qkt(f32x16& p0, f32x16& p1, const LAS unsigned char* kn, const LAS unsigned char* kp, const bf16x8* qr) {
    p0 = f32x16{}; p1 = f32x16{};
#pragma unroll
    for (int d0 = 0; d0 < 8; ++d0) { const bf16x8 a0 = *(const LAS bf16x8*)(kn + d0 * 32), a1 = *(const LAS bf16x8*)(kn + d0 * 32 + 32 * KN_ST);
        p0 = __builtin_amdgcn_mfma_f32_32x32x16_bf16(a0, qr[d0], p0, 0, 0, 0); p1 = __builtin_amdgcn_mfma_f32_32x32x16_bf16(a1, qr[d0], p1, 0, 0, 0); }
#pragma unroll
    for (int d0 = 0; d0 < 4; ++d0) { const bf16x8 a0 = *(const LAS bf16x8*)(kp + d0 * 32), a1 = *(const LAS bf16x8*)(kp + d0 * 32 + 32 * KP_ST);
        p0 = __builtin_amdgcn_mfma_f32_32x32x16_bf16(a0, qr[8 + d0], p0, 0, 0, 0); p1 = __builtin_amdgcn_mfma_f32_32x32x16_bf16(a1, qr[8 + d0], p1, 0, 0, 0); }
}
__device__ __forceinline__ void pv_tile(f32x16* o, int vb0, bf16x8 pa0, bf16x8 pa1, bf16x8 pa2, bf16x8 pa3) {
#define AT_TRRD(dst, off) asm volatile("ds_read_b64_tr_b16 %0, %1 offset:%2" : "=&v"(dst) : "v"(vb0), "i"(off) : "memory")
#define AT_PV_D0(d0) do { s16x4 l0, l1, l2, l3, h0, h1, h2, h3; constexpr int b_ = v_rd_off(d0, 0, 0);   \
        AT_TRRD(l0, b_); AT_TRRD(h0, b_ + 2048); AT_TRRD(l1, b_ + 4096); AT_TRRD(h1, b_ + 6144); AT_TRRD(l2, b_ + 8192); AT_TRRD(h2, b_ + 10240); AT_TRRD(l3, b_ + 12288); AT_TRRD(h3, b_ + 14336); \
        asm volatile("s_waitcnt lgkmcnt(0)" ::: "memory"); AT_SBAR();   \
        o[d0] = __builtin_amdgcn_mfma_f32_32x32x16_bf16(pa0, (bf16x8){l0[0], l0[1], l0[2], l0[3], h0[0], h0[1], h0[2], h0[3]}, o[d0], 0, 0, 0);   \
        o[d0] = __builtin_amdgcn_mfma_f32_32x32x16_bf16(pa1, (bf16x8){l1[0], l1[1], l1[2], l1[3], h1[0], h1[1], h1[2], h1[3]}, o[d0], 0, 0, 0);   \
        o[d0] = __builtin_amdgcn_mfma_f32_32x32x16_bf16(pa2, (bf16x8){l2[0], l2[1], l2[2], l2[3], h2[0], h2[1], h2[2], h2[3]}, o[d0], 0, 0, 0);   \
        o[d0] = __builtin_amdgcn_mfma_f32_32x32x16_bf16(pa3, (bf16x8){l3[0], l3[1], l3[2], l3[3], h3[0], h3[1], h3[2], h3[3]}, o[d0], 0, 0, 0); } while (0)
    AT_PV_D0(0); AT_PV_D0(1); AT_PV_D0(2); AT_PV_D0(3);
#undef AT_PV_D0
#undef AT_TRRD
}
template <bool PARTIAL>
__device__ __forceinline__ void attn_unit(LAS unsigned char* lds, const bf16_t* Qw, const bf16_t* KN, const bf16_t* KPE, const bf16_t* V, bf16_t* Ow, float* Pw, int NT, int tmax_w, int nkeys, int orows, int t0, int tstride) {
    const int tid = threadIdx.x, wid = __builtin_amdgcn_readfirstlane(tid >> 6), lane = tid & 63, r32 = lane & 31, hi = lane >> 5;
    bf16x8 qr[12];
#pragma unroll
    for (int d0 = 0; d0 < 12; ++d0) qr[d0] = *(const bf16x8*)(Qw + (size_t)r32 * 1536 + d0 * 16 + hi * 8);
    const int sr = tid >> 4, sc = (tid & 15) * 8, pr = tid >> 3, pc = (tid & 7) * 8;
    const int kn_w0 = sr * KN_ST + sc * 2, kn_w1 = (32 + sr) * KN_ST + sc * 2, kp_w = KN_B + pr * KP_ST + pc * 2, v_w0 = KN_B + KP_B + v_st(sr, sc), v_w1 = KN_B + KP_B + v_st(32 + sr, sc);
    const int kn_r = r32 * KN_ST + hi * 16, kp_r = KN_B + r32 * KP_ST + hi * 16;
    const int vb_base = (int)(unsigned)(uintptr_t)(lds + KN_B + KP_B) + v_rd_base(lane);
    LAS float* scr = (LAS float*)(lds + SCR_OFF) + wid * 64;
    float m_reg = -1e30f, l_reg = 0.f; f32x16 o[4] = {};
    u32x4 st_kn0, st_kn1, st_kp, st_v0, st_v1;
#define AT_LOAD(t) do { const size_t k0_ = (size_t)(t0 + (t) * tstride) * 64; const bool v0_ = (int)k0_ + sr < nkeys, v1_ = (int)k0_ + 32 + sr < nkeys, vp_ = (int)k0_ + pr < nkeys; const u32x4 z_ = {0u, 0u, 0u, 0u}; \
        st_kn0 = v0_ ? *(const u32x4*)(KN + (k0_ + sr) * 1024 + sc) : z_; st_kn1 = v1_ ? *(const u32x4*)(KN + (k0_ + 32 + sr) * 1024 + sc) : z_; \
        st_v0 = v0_ ? *(const u32x4*)(V + (k0_ + sr) * 1024 + sc) : z_; st_v1 = v1_ ? *(const u32x4*)(V + (k0_ + 32 + sr) * 1024 + sc) : z_; \
        st_kp = vp_ ? *(const u32x4*)(KPE + (k0_ + pr) * 64 + pc) : z_; } while (0)
#define AT_WRITE(bf) do { LAS unsigned char* b_ = lds + (bf) * BUF_B; *(LAS u32x4*)(b_ + kn_w0) = st_kn0; *(LAS u32x4*)(b_ + kn_w1) = st_kn1; *(LAS u32x4*)(b_ + kp_w) = st_kp; \
        *(LAS u32x4*)(b_ + v_w0) = st_v0; *(LAS u32x4*)(b_ + v_w1) = st_v1; } while (0)
    AT_LOAD(0); AT_WRITE(0);
    __syncthreads();
    for (int t = 0; t < NT; ++t) {
        const int bf = t & 1;
        if (t + 1 < NT) AT_LOAD(t + 1);
        if (t <= tmax_w) {
            f32x16 p0, p1;
            const LAS unsigned char* bb = lds + bf * BUF_B;
            qkt(p0, p1, bb + kn_r, bb + kp_r, qr);
            if ((t0 + t * tstride + 1) * 64 > nkeys) {
                const int kb = (t0 + t * tstride) * 64 + 4 * hi;
#pragma unroll
                for (int r = 0; r < 16; ++r) { const int kv = kb + (r & 3) + 8 * (r >> 2); if (kv >= nkeys) p0[r] = -INFINITY; if (kv + 32 >= nkeys) p1[r] = -INFINITY; } }
            float pmax = p0[0];
#pragma unroll
            for (int r = 1; r < 16; ++r) pmax = fmaxf(pmax, p0[r]);
#pragma unroll
            for (int r = 0; r < 16; ++r) pmax = fmaxf(pmax, p1[r]);
            { auto rr = __builtin_amdgcn_permlane32_swap(__float_as_uint(pmax), __float_as_uint(pmax), false, false); pmax = fmaxf(__uint_as_float(rr[0]), __uint_as_float(rr[1])); }
            float alpha = 1.f; bool resc = false;
            if (!__all(pmax - m_reg <= THR)) { const float mn = fmaxf(m_reg, pmax); alpha = __builtin_amdgcn_exp2f(m_reg - mn); m_reg = mn; resc = true; }
#pragma unroll
            for (int r = 0; r < 16; ++r) { p0[r] = __builtin_amdgcn_exp2f(p0[r] - m_reg); p1[r] = __builtin_amdgcn_exp2f(p1[r] - m_reg); }
            float ps = 0.f;
#pragma unroll
            for (int r = 0; r < 16; ++r) ps += p0[r] + p1[r];
            { auto rr = __builtin_amdgcn_permlane32_swap(__float_as_uint(ps), __float_as_uint(ps), false, false); ps = __uint_as_float(rr[0]) + __uint_as_float(rr[1]); }
            l_reg = l_reg * alpha + ps;
            bf16x8 pa0, pa1, pa2, pa3;
#define AT_PK4(P, B_, OUT) do { unsigned a0 = cvt_pk_bf16(P[B_ + 0], P[B_ + 1]), a1 = cvt_pk_bf16(P[B_ + 2], P[B_ + 3]); unsigned b0 = cvt_pk_bf16(P[B_ + 4], P[B_ + 5]), b1 = cvt_pk_bf16(P[B_ + 6], P[B_ + 7]); \
        auto r0 = __builtin_amdgcn_permlane32_swap(a0, b0, false, false); auto r1 = __builtin_amdgcn_permlane32_swap(a1, b1, false, false); \
        u32x4 w_ = {r0[0], r1[0], r0[1], r1[1]}; OUT = __builtin_bit_cast(bf16x8, w_); } while (0)
            AT_PK4(p0, 0, pa0); AT_PK4(p0, 8, pa1); AT_PK4(p1, 0, pa2); AT_PK4(p1, 8, pa3);
#undef AT_PK4
            if (resc) { if (hi == 0) scr[r32] = alpha; asm volatile("s_waitcnt lgkmcnt(0)" ::: "memory");
#pragma unroll
                for (int d_ = 0; d_ < 4; ++d_)
#pragma unroll
                    for (int r = 0; r < 16; ++r) o[d_][r] *= scr[crow(r, hi)]; }
            AT_SBAR();
            pv_tile(o, vb_base + bf * BUF_B, pa0, pa1, pa2, pa3);
        }
        if (t + 1 < NT) AT_WRITE(bf ^ 1);
        __syncthreads();
    }
    if (PARTIAL) {
        if (wid == 0) {
#pragma unroll
            for (int r = 0; r < 16; ++r) { const int orow = crow(r, hi); if (orow < orows) {
#pragma unroll
                for (int d0 = 0; d0 < 4; ++d0) Pw[orow * 132 + d0 * 32 + r32] = o[d0][r]; } }
            if (hi == 0 && r32 < orows) { Pw[r32 * 132 + 128] = m_reg; Pw[r32 * 132 + 129] = l_reg; } }
        __syncthreads();
        return;
    }
    if (hi == 0) scr[32 + r32] = l_reg; asm volatile("s_waitcnt lgkmcnt(0)" ::: "memory");
#pragma unroll
    for (int r = 0; r < 16; ++r) { const int orow = crow(r, hi); const float rl = __builtin_amdgcn_rcpf(scr[32 + orow]);
#pragma unroll
        for (int d0 = 0; d0 < 4; ++d0) { const float v = o[d0][r] * rl; const float vn = __shfl_xor(v, 1);
            if ((r32 & 1) == 0 && orow < orows) *(unsigned*)(Ow + (size_t)orow * 1024 + d0 * 32 + r32) = cvt_pk_bf16(v, vn); } }
    __syncthreads();
#undef AT_LOAD
#undef AT_WRITE
}
#undef AT_SBAR
}
__device__ __forceinline__ void p3_attn_prompt(Frame& F) {
    const int bh = F.vcu >> 4, s = F.vcu & 15, b = bh >> 3, h = bh & 7;
    const bf16_t* Q = (const bf16_t*)F.out; const bf16_t* KN = (const bf16_t*)(F.ws + WS_KN); const bf16_t* KPE = (const bf16_t*)(F.ws + WS_KPE); const bf16_t* V = (const bf16_t*)(F.ws + WS_V); bf16_t* ATT = (bf16_t*)(F.ws + WS_ATT);
#pragma unroll 1
    for (int it = 0; it < 2; ++it) { const int qb = it == 0 ? s : 31 - s; const size_t row0 = (size_t)b * SEQ + (size_t)qb * 256 + F.wave * 32;
        at::attn_unit<false>(F.lds, Q + row0 * 1536 + h * 192, KN + (size_t)b * SEQ * 1024 + h * 128, KPE + (size_t)b * SEQ * 64, V + (size_t)b * SEQ * 1024 + h * 128,
                      ATT + row0 * 1024 + h * 128, nullptr, 4 * qb + 4, 4 * qb + (F.wave >> 1), 1 << 30, 32, 0, 1); }
}
__device__ __forceinline__ void xn_rows(Frame& F, bf16_t* XN) {
    const int gw = F.vcu * 8 + F.wave, NGW = F.G * 8;
    for (int r = gw; r < MPAD; r += NGW) {
        u32x2* o8 = (u32x2*)(XN + (size_t)r * D_MODEL) + F.lane;
        if (r >= MT) { for (int jj = 0; jj < 4; ++jj) o8[64 * jj] = (u32x2){0u, 0u}; continue; }
        const float* x = r < MP ? FIN(0) + (size_t)r * D_MODEL : FIN(1) + (size_t)(r - MP) * D_MODEL;
        const f32x4* xr = (const f32x4*)x + F.lane; f32x4 v[4]; float s = 0.f;
#pragma unroll
        for (int jj = 0; jj < 4; ++jj) { v[jj] = xr[64 * jj]; s += (v[jj][0] * v[jj][0] + v[jj][1] * v[jj][1]) + (v[jj][2] * v[jj][2] + v[jj][3] * v[jj][3]); }
        const float inv = rsqrtf(fwave_sum(s) * (1.f / D_MODEL) + EPS);
#pragma unroll
        for (int jj = 0; jj < 4; ++jj) { u32x2 w; w.x = cvt_pk_bf16(v[jj][0] * inv, v[jj][1] * inv); w.y = cvt_pk_bf16(v[jj][2] * inv, v[jj][3] * inv); o8[64 * jj] = w; }
    }
}
constexpr size_t WS_PART = WS_ATTS + 512 * KiB;
__device__ __forceinline__ void p3_attn_sample(Frame& F) {
    {   const int bh = F.vcu >> 2, part = F.vcu & 3, b = bh >> 3, h = bh & 7;
        const bf16_t* Q = (const bf16_t*)F.out; const bf16_t* KN = (const bf16_t*)(F.ws + WS_KN); const bf16_t* PES = (const bf16_t*)(F.ws + WS_PES); const bf16_t* V = (const bf16_t*)(F.ws + WS_V);
        const size_t row0 = (size_t)MP + (size_t)b * DEC_SEQ;
        at::attn_unit<true>(F.lds, Q + row0 * 1536 + h * 192, KN + (size_t)b * SKEYS * 1024 + h * 128, PES + (size_t)b * SKEYS * 64, V + (size_t)b * SKEYS * 1024 + h * 128,
                            nullptr, (float*)(F.ws + WS_PART) + (size_t)F.vcu * 16 * 132, part == 0 ? 9 : 8, F.wave == 0 ? 1000 : -1, SKEYS, DEC_SEQ, part, 4); }
    xn_rows(F, (bf16_t*)(F.ws + WS_XN2));
    {   const int gw = F.vcu * 8 + F.wave, NGW = F.G * 8; const bf16_t* KVL = (const bf16_t*)(F.ws + WS_KVL); const float* slotkv = (const float*)(F.ws + WS_SLOTKV);
        for (int r = gw; r < MT; r += NGW) { const float s = slot_rs(slotkv + (size_t)r * 8, 8, 1.f / KV_LORA);
            float* o = r < MP ? F.out + O_LATP + (size_t)r * KV_LORA : F.out + O_LATS + (size_t)(r - MP) * KV_LORA;
            const u32x4 w = *((const u32x4*)(KVL + (size_t)r * KV_LORA) + F.lane);
            f32x4 a = {__uint_as_float(w.x << 16), __uint_as_float(w.x & 0xffff0000u), __uint_as_float(w.y << 16), __uint_as_float(w.y & 0xffff0000u)};
            f32x4 c = {__uint_as_float(w.z << 16), __uint_as_float(w.z & 0xffff0000u), __uint_as_float(w.w << 16), __uint_as_float(w.w & 0xffff0000u)};
            *((f32x4*)o + 2 * F.lane) = a * s; *((f32x4*)o + 2 * F.lane + 1) = c * s; } }
}
__device__ __forceinline__ void attn_sample_combine(Frame& F) {
    if (F.vcu >= DEC_BATCH * HEADS) return;
    const int b = F.vcu >> 3, h = F.vcu & 7; const float* P = (const float*)(F.ws + WS_PART) + (size_t)F.vcu * 4 * 16 * 132; bf16_t* ATTS = (bf16_t*)(F.ws + WS_ATTS);
    for (int e = F.tid; e < 16 * 128; e += NTHR) { const int q = e >> 7, d = e & 127;
        float m[4], M = -1e30f;
#pragma unroll
        for (int p = 0; p < 4; ++p) { m[p] = P[(p * 16 + q) * 132 + 128]; M = fmaxf(M, m[p]); }
        float num = 0.f, den = 0.f;
#pragma unroll
        for (int p = 0; p < 4; ++p) { const float w = exp2f(m[p] - M); num += w * P[(p * 16 + q) * 132 + d]; den += w * P[(p * 16 + q) * 132 + 129]; }
        ATTS[(size_t)(b * DEC_SEQ + q) * 1024 + h * 128 + d] = f2bf(num / den); }
}
__device__ __forceinline__ void unpack8(const u32x4 w, float* f) {
    f[0] = __uint_as_float(w.x << 16); f[1] = __uint_as_float(w.x & 0xffff0000u); f[2] = __uint_as_float(w.y << 16); f[3] = __uint_as_float(w.y & 0xffff0000u);
    f[4] = __uint_as_float(w.z << 16); f[5] = __uint_as_float(w.z & 0xffff0000u); f[6] = __uint_as_float(w.w << 16); f[7] = __uint_as_float(w.w & 0xffff0000u);
}
__device__ __forceinline__ void p8_conv(Frame& F) {
    bf16_t* U = (bf16_t*)(F.ws + WS_U); const bf16_t* HALO = (const bf16_t*)(F.ws + WS_HALO); const float* cw = FIN(21); const float* cb = FIN(22); const float* prev = FIN(5);
    const int seg = F.wave, cgi = F.lane;
    for (int unit = F.vcu; unit < 72 * 6; unit += F.G) { const int ch = unit / 6, strip = unit % 6; const int n = strip * 512 + cgi * 8, nv = n + D_FF; const bool cok = n < D_FF;
        int r0, nr; if (ch < 64) { r0 = ch * 256 + seg * 32; nr = 32; } else { r0 = MP + (ch - 64) * DEC_SEQ; nr = seg == 0 ? DEC_SEQ : 0; }
        if (!cok) nr = 0;
        float wg[3][8], wv[3][8], bg[8], bv[8], g2[8], g1[8], v2[8], v1[8];
#pragma unroll
        for (int e = 0; e < 8; ++e) { g2[e] = 0.f; g1[e] = 0.f; v2[e] = 0.f; v1[e] = 0.f; }
        if (cok) {
#pragma unroll
            for (int k = 0; k < 3; ++k) { const f32x4 a0 = *(const f32x4*)(cw + k * FF2 + n), a1 = *(const f32x4*)(cw + k * FF2 + n + 4), c0 = *(const f32x4*)(cw + k * FF2 + nv), c1 = *(const f32x4*)(cw + k * FF2 + nv + 4);
#pragma unroll
                for (int e = 0; e < 4; ++e) { wg[k][e] = a0[e]; wg[k][4 + e] = a1[e]; wv[k][e] = c0[e]; wv[k][4 + e] = c1[e]; } }
            { const f32x4 a0 = *(const f32x4*)(cb + n), a1 = *(const f32x4*)(cb + n + 4), c0 = *(const f32x4*)(cb + nv), c1 = *(const f32x4*)(cb + nv + 4);
#pragma unroll
              for (int e = 0; e < 4; ++e) { bg[e] = a0[e]; bg[4 + e] = a1[e]; bv[e] = c0[e]; bv[4 + e] = c1[e]; } }
            if (ch < 64) {
                if (seg > 0) { unpack8(*(const u32x4*)(U + (size_t)(r0 - 2) * FF2 + n), g2); unpack8(*(const u32x4*)(U + (size_t)(r0 - 1) * FF2 + n), g1); unpack8(*(const u32x4*)(U + (size_t)(r0 - 2) * FF2 + nv), v2); unpack8(*(const u32x4*)(U + (size_t)(r0 - 1) * FF2 + nv), v1); }
                else if ((ch & 31) != 0) { const bf16_t* hp = HALO + (size_t)ch * 2 * FF2; unpack8(*(const u32x4*)(hp + n), g2); unpack8(*(const u32x4*)(hp + FF2 + n), g1); unpack8(*(const u32x4*)(hp + nv), v2); unpack8(*(const u32x4*)(hp + FF2 + nv), v1); }
            } else if (seg == 0) { const float* pp = prev + (size_t)(ch - 64) * 2 * FF2;
#pragma unroll
                for (int e = 0; e < 8; ++e) { g2[e] = pp[n + e]; g1[e] = pp[FF2 + n + e]; v2[e] = pp[nv + e]; v1[e] = pp[FF2 + nv + e]; } }
        }
        __syncthreads();
#pragma unroll 2
        for (int i = 0; i < nr; ++i) { bf16_t* row = U + (size_t)(r0 + i) * FF2; float g0[8], v0[8], h[8];
            unpack8(*(const u32x4*)(row + n), g0); unpack8(*(const u32x4*)(row + nv), v0);
#pragma unroll
            for (int e = 0; e < 8; ++e) { const float cg = g2[e] * wg[0][e] + g1[e] * wg[1][e] + g0[e] * wg[2][e] + bg[e], cv = v2[e] * wv[0][e] + v1[e] * wv[1][e] + v0[e] * wv[2][e] + bv[e];
                h[e] = cg * __builtin_amdgcn_rcpf(1.f + __expf(-cg)) * cv; g2[e] = g1[e]; g1[e] = g0[e]; v2[e] = v1[e]; v1[e] = v0[e]; }
            u32x4 w; w.x = cvt_pk_bf16(h[0], h[1]); w.y = cvt_pk_bf16(h[2], h[3]); w.z = cvt_pk_bf16(h[4], h[5]); w.w = cvt_pk_bf16(h[6], h[7]);
            *(u32x4*)(row + n) = w; }
        __syncthreads();
    }
}
__global__ void __launch_bounds__(NTHR, 2) mk(const MArgs a) {
    extern __shared__ __attribute__((aligned(16))) unsigned char lds_raw[];
    Frame F;
    F.lds = (LAS unsigned char*)lds_raw;
    F.tid = threadIdx.x; F.lane = F.tid & 63; F.wave = __builtin_amdgcn_readfirstlane(F.tid >> 6);
    F.G = gridDim.x; F.x = blockIdx.x % 8; F.j = blockIdx.x / 8; F.vcu = F.x * (F.G / 8) + F.j;
    F.a = &a; F.out = a.out; F.ws = a.ws;
    volatile LAS unsigned* MISC = (volatile LAS unsigned*)(F.lds + MISC_OFF);
    if (F.tid < 32) MISC[F.tid] = 0u;
    __syncthreads();
    XcdBarrier bar = xcd_barrier_post((unsigned*)(a.ws + WS_CTL) + CW_BAR + a.li * XCD_BAR_WORDS, MISC + 8);
    const int lo = a.ph_lo, hi = a.ph_hi;
#define IN_(k) (lo <= (k) && (k) < hi)
#define SEAM_(k) do { if (IN_(k) && IN_((k) + 1)) xcd_barrier(bar); } while (0)
#define STAMP_(k) probe_stamp(F, (k))
    STAMP_(0); if (IN_(0)) { p0_prologue(F); } SEAM_(0);
    STAMP_(1); if (IN_(1)) { p1_inproj(F); } SEAM_(1);
    STAMP_(2); if (IN_(2)) { r1_states(F); } SEAM_(2);
    STAMP_(3); if (IN_(3)) { r2_scan(F); } SEAM_(3);
    STAMP_(4); if (IN_(4)) { r3_outputs(F); } SEAM_(4);
    STAMP_(5); if (IN_(5)) { p2_qkv(F, 1); } SEAM_(5);
    STAMP_(6); if (IN_(6)) { p3_attn_sample(F); } SEAM_(6);
    STAMP_(7); if (IN_(7)) { attn_sample_combine(F); p2_qkv(F, 0); } SEAM_(7);
    STAMP_(8); if (IN_(8)) { p3_attn_prompt(F); } SEAM_(8);
    STAMP_(9); if (IN_(9)) { p5_gemm(F, 5); } SEAM_(9);
    STAMP_(10); if (IN_(10)) { p5_gemm(F, 6); } SEAM_(10);
    STAMP_(11); if (IN_(11)) { p5_gemm(F, 7); } SEAM_(11);
    STAMP_(12); if (IN_(12)) { p8_conv(F); } SEAM_(12);
    STAMP_(13); if (IN_(13)) { p5_gemm(F, 9); }
    if (PROBE_LO >= 0) { __syncthreads(); STAMP_(14);
        if (blockIdx.x == 0 && F.tid == 0) { const unsigned long long t_end = __builtin_amdgcn_s_memrealtime() + (unsigned long long)PROBE_MULT * ((((unsigned long long)MISC[19] << 32) | MISC[18]) - (((unsigned long long)MISC[17] << 32) | MISC[16]));
            while (__builtin_amdgcn_s_memrealtime() < t_end) __builtin_amdgcn_s_sleep(8); } }
}

extern "C" void kernel_launch(void* const* d_in, const int* in_sizes, int n_in, void* d_out, int out_size, void* d_ws, size_t ws_size, hipStream_t stream) {
    static int ok = 0;
    if (ok == 0) {
        ok = 1;
        if (ws_size < 256 * MiB || n_in != 24) { fprintf(stderr, "kernel_launch: bad ws/n_in: %zu %d\n", ws_size, n_in); ok = -1; }
        int dev = 0, cus = 0; (void)hipGetDevice(&dev); (void)hipDeviceGetAttribute(&cus, hipDeviceAttributeMultiprocessorCount, dev);
        if (cus != 256) { fprintf(stderr, "kernel_launch: built for 256 CUs, got %d\n", cus); ok = -1; }
        if (hipFuncSetAttribute((const void*)mk, hipFuncAttributeMaxDynamicSharedMemorySize, LDS_BYTES) != hipSuccess) { fprintf(stderr, "kernel_launch: hipFuncSetAttribute(mk) failed\n"); ok = -1; }
        (void)hipGetLastError();
    }
    if (ok < 0) return;
    (void)hipMemsetAsync((char*)d_ws + WS_CTL, 0, CTL_BYTES, stream);
    MArgs a{}; for (int i = 0; i < 24; ++i) a.in[i] = (const float*)d_in[i]; a.out = (float*)d_out; a.ws = (unsigned char*)d_ws; a.ph_lo = 0; a.ph_hi = 14; a.li = 0;
    hipLaunchKernelGGL(mk, dim3(256), dim3(NTHR), LDS_BYTES, stream, a);
}
```

```cpp
#include <hip/hip_runtime.h>
#include <stdint.h>
#include <cstdio>

typedef unsigned short bf16_t;
typedef short bf16x8 __attribute__((ext_vector_type(8)));
typedef float f32x4 __attribute__((ext_vector_type(4)));
typedef float f32x2 __attribute__((ext_vector_type(2)));
typedef unsigned u32x4 __attribute__((ext_vector_type(4)));
typedef unsigned u32x2 __attribute__((ext_vector_type(2)));

constexpr int D_MODEL = 1024, BATCH = 2, SEQ = 8192, DEC_BATCH = 8, DEC_SEQ = 16, PAST = 2048;
constexpr int MP = BATCH * SEQ, MS = DEC_BATCH * DEC_SEQ, MT = MP + MS;
constexpr int MPAD = 16640;
constexpr int Q_LORA = 768, KV_LORA = 512, QK_NOPE = 128, QK_ROPE = 64, V_HEAD = 128, HEADS = 8;
constexpr int RET_H = 4, RET_DK = 128, RET_DV = 256;
constexpr int D_FF = 2816, FF2 = 2 * D_FF;
constexpr int IN_W = 6464;
constexpr int SKEYS = PAST + DEC_SEQ;
constexpr int LROWS = DEC_BATCH * SKEYS;
constexpr float EPS = 1e-6f;
constexpr int C_QLAT = 0, C_KVLAT = 768, C_KPE = 1280, C_RQ = 1344, C_RK = 1856, C_RV = 2368, C_RG = 3392, C_GA = 4416, C_GB = 5440;

constexpr size_t O_YP = 0, O_YS = 16777216, O_LATP = 16908288, O_RKP = 25296896, O_RETP = 26345472, O_CONVP = 26607616,
                 O_LATS = 26630144, O_RKS = 26695680, O_RETS = 26703872, O_CONVS = 27752448;

constexpr size_t MiB = 1u << 20, KiB = 1024;
constexpr size_t WS_CTL = 0, CTL_BYTES = 64 * KiB, WS_SQ = 64 * KiB, WS_SKV = 192 * KiB;
constexpr size_t WS_SLOTQ = 1 * MiB, WS_SLOTKV = 2 * MiB, WS_SLOTX1 = 3 * MiB;
constexpr size_t WS_TAB32 = 4 * MiB + 256 * KiB, WS_TAB64 = 6 * MiB + 256 * KiB;
constexpr size_t WS_FWUP = 10 * MiB + 512 * KiB, WS_FWDOWN = 21 * MiB + 512 * KiB, WS_FWIN = 27 * MiB, WS_FWQUP = 40 * MiB, WS_FWKVUP = 43 * MiB,
                 WS_FWOBA = 45 * MiB, WS_FWOBB = 47 * MiB, WS_FWOUT = 49 * MiB;
constexpr size_t WS_XN = 51 * MiB, WS_RET = 51 * MiB;
constexpr size_t WS_LATS = 83 * MiB + 512 * KiB, WS_PES = 99 * MiB + 768 * KiB, WS_ZQ = 102 * MiB, WS_KVL = 126 * MiB + 512 * KiB, WS_KPE = 142 * MiB + 768 * KiB;
constexpr size_t WS_RQ = 145 * MiB, WS_RK = 161 * MiB + 256 * KiB, WS_RV = 177 * MiB + 512 * KiB, WS_RG = 210 * MiB;
constexpr size_t WS_KN = 145 * MiB, WS_V = 177 * MiB + 512 * KiB, WS_ATTS = 242 * MiB + 512 * KiB, WS_XN2 = 210 * MiB, WS_ATT = 102 * MiB;
constexpr size_t WS_T1 = 166 * MiB + 512 * KiB, WS_MERGED = 134 * MiB;
constexpr size_t WS_GAS = 246 * MiB, WS_GBS = 247 * MiB;
constexpr size_t WS_X1B = 223 * MiB + 512 * KiB, WS_U = 27 * MiB, WS_HALO = 206 * MiB;

__device__ __forceinline__ bf16_t f2bf(float f) { unsigned u = __float_as_uint(f); u = (u + 0x7fffu + ((u >> 16) & 1u)) >> 16; return (bf16_t)u; }
__device__ __forceinline__ float bf2f(bf16_t b) { return __uint_as_float(((unsigned)b) << 16); }

#define LAS __attribute__((address_space(3)))
#define GAS __attribute__((address_space(1)))
constexpr int NTHR = 512;
constexpr int RING_BYTES = 131072, EPI_OFF = RING_BYTES, EPI_BYTES = 8192, LDS_BYTES = 163840, MISC_OFF = LDS_BYTES - 256;
constexpr int CW_BAR = 1024;

__device__ __forceinline__ unsigned cvt_pk_bf16(float lo, float hi) { unsigned r; asm volatile("v_cvt_pk_bf16_f32 %0, %1, %2" : "=v"(r) : "v"(lo), "v"(hi)); return r; }
__device__ __forceinline__ u32x4 pack8f(const f32x4& a, const f32x4& b) { u32x4 w; w.x = cvt_pk_bf16(a[0], a[1]); w.y = cvt_pk_bf16(a[2], a[3]); w.z = cvt_pk_bf16(b[0], b[1]); w.w = cvt_pk_bf16(b[2], b[3]); return w; }
__device__ __forceinline__ int row_pos(int row) { return row < MP ? (row & (SEQ - 1)) : PAST + ((row - MP) & (DEC_SEQ - 1)); }

#define XB_TMO      128
#define XB_XCNT(j)  (256  + 64 * (j))
#define XB_XSUB(j)  (1280 + 64 * (j))
#define XB_XGEN(j)  (2304 + 64 * (j))
#define XB_TOP      3328
#define XB_TOPGEN   3392
#define XCD_BAR_WORDS 3456
#define XB_SPIN_CAP (1u << 18)
__device__ __forceinline__ unsigned xb_ld(unsigned* p)              { return __hip_atomic_load(p, __ATOMIC_RELAXED, __HIP_MEMORY_SCOPE_AGENT); }
__device__ __forceinline__ unsigned xb_add(unsigned* p, unsigned v) { return __hip_atomic_fetch_add(p, v, __ATOMIC_RELAXED, __HIP_MEMORY_SCOPE_AGENT); }
__device__ __forceinline__ unsigned xb_xcc_id() { return (unsigned)__builtin_amdgcn_s_getreg((3 << 11) | 20) & 0xFu; }
#define XB_SPIN(cond, bar) do { unsigned _sp = 0; while (cond) { __builtin_amdgcn_s_sleep(1); \
    if ((++_sp & 255u) == 0u) { if (xb_ld(&(bar)[XB_TMO])) break; if (_sp > XB_SPIN_CAP) { atomicAdd(&(bar)[XB_TMO], 1u); break; } } } } while (0)
struct XcdBarrier { unsigned* bar; unsigned x; volatile LAS unsigned* st; };
__device__ __forceinline__ XcdBarrier xcd_barrier_post(unsigned* bar, volatile LAS unsigned* st) {
    XcdBarrier b; b.bar = bar; b.x = xb_xcc_id(); b.st = st;
    if (threadIdx.x == 0) (void)xb_add(&bar[XB_XCNT(b.x)], 1u);
    return b;
}
__device__ __forceinline__ void xcd_barrier_complete(unsigned* bar, unsigned x, unsigned& nloc, unsigned& nx) {
    const unsigned G = gridDim.x * gridDim.y * gridDim.z;
    unsigned sum, cnt, mine, sp = 0u;
    for (;;) {
        sum = 0u; cnt = 0u; mine = 0u;
#pragma unroll
        for (unsigned j = 0; j < 16; ++j) { const unsigned c = xb_ld(&bar[XB_XCNT(j)]); sum += c; cnt += (c > 0u) ? 1u : 0u; mine = (j == x) ? c : mine; }
        if (sum == G) break;
        __builtin_amdgcn_s_sleep(1);
        if ((++sp & 255u) == 0u) { if (xb_ld(&bar[XB_TMO])) break; if (sp > XB_SPIN_CAP) { atomicAdd(&bar[XB_TMO], 1u); break; } }
    }
    nloc = mine > 0u ? mine : 1u; nx = cnt > 0u ? cnt : 1u;
}
__device__ __forceinline__ void xcd_barrier(const XcdBarrier& b) {
    asm volatile("s_waitcnt vmcnt(0)" ::: "memory");
    __syncthreads();
    if (threadIdx.x == 0) {
        unsigned* bar = b.bar;
        __builtin_amdgcn_s_waitcnt(0);
        unsigned nloc = b.st[0], nx = b.st[1];
        if (nloc == 0u) { xcd_barrier_complete(bar, b.x, nloc, nx); b.st[0] = nloc; b.st[1] = nx; }
        const unsigned old = xb_add(&bar[XB_XSUB(b.x)], 1u);
        const unsigned gen = old / nloc;
        if (old + 1u == (gen + 1u) * nloc) {
            __builtin_amdgcn_fence(__ATOMIC_RELEASE, "agent");
            asm volatile("s_waitcnt vmcnt(0)" ::: "memory");
            const unsigned og = xb_add(&bar[XB_TOP], 1u);
            const unsigned tg = og / nx;
            if (og + 1u == (tg + 1u) * nx) xb_add(&bar[XB_TOPGEN], 1u);
            else XB_SPIN(xb_ld(&bar[XB_TOPGEN]) == tg, bar);
            __builtin_amdgcn_fence(__ATOMIC_ACQUIRE, "agent");
            xb_add(&bar[XB_XGEN(b.x)], 1u);
            asm volatile("s_waitcnt vmcnt(0)" ::: "memory");
        } else {
            XB_SPIN(xb_ld(&bar[XB_XGEN(b.x)]) == gen, bar);
            __builtin_amdgcn_fence(__ATOMIC_ACQUIRE, "agent");
            asm volatile("s_waitcnt vmcnt(0)" ::: "memory");
        }
    }
    __syncthreads();
}

namespace pg {
constexpr int BK = 64, HALF = 128, HTB = HALF * BK * 2;
__host__ __device__ __forceinline__ int lds_byte(int r, int c) { const int st = (r >> 4) * 2 + (c >> 5), rr = r & 15, cc = c & 31, ob = rr * 64 + cc * 2; return st * 1024 + (ob ^ (((ob >> 9) & 1) << 5)); }
__host__ __device__ __forceinline__ void stage_rc(int b, int& R, int& C) { const int st = b / 1024, sb = b % 1024, swz = sb ^ (((sb >> 9) & 1) << 5); R = (st >> 1) * 16 + swz / 64; C = (st & 1) * 32 + (swz % 64) / 2; }
__host__ __device__ __forceinline__ int perm32(int rho) { const int n = rho >> 4, i = rho & 15; return 8 * (i >> 2) + 4 * n + (i & 3); }
struct UnitG { const char* A; const char* B; unsigned lda, ldb; int nt; int pm, pn, kind; int half; };
typedef f32x4 Acc[2][2][4][2];

template <class Sched, class Epi>
__device__ __forceinline__ void gemm_stream(LAS unsigned char* lds, const Sched& S, const Epi& E) {
    const int tid = threadIdx.x, wid = __builtin_amdgcn_readfirstlane(tid >> 6), lane = tid & 63, wr = wid >> 2, wc = wid & 3, fr = lane & 15, fq = lane >> 4;
    unsigned Rr[2], Cc[2];
#pragma unroll
    for (int i = 0; i < 2; ++i) { int R, C; stage_rc(tid * 16 + i * 8192, R, C); Rr[i] = (unsigned)R; Cc[i] = (unsigned)C * 2u; }
    const unsigned ldsw = (unsigned)wid * 1024u;
    const int aoff = lds_byte(wr * 64 + fr, fq * 8), boff = lds_byte(wc * 32 + fr, fq * 8);
#define PG_SA(b, h) (((b) * 2 + (h)) * HTB)
#define PG_SB(b, h) ((4 + (b) * 2 + (h)) * HTB)
#define PG_STAGE(bufoff, gbase, ld) do { _Pragma("unroll") for (int _i = 0; _i < 2; ++_i) \
        __builtin_amdgcn_global_load_lds((const unsigned*)((const char*)(gbase) + (size_t)(Rr[_i] * (ld) + Cc[_i])), (LAS unsigned*)(lds + (bufoff) + ldsw + _i * 8192), 16, 0, 0); } while (0)
#define PG_LDA(dst, b, h) do { _Pragma("unroll") for (int m = 0; m < 4; ++m) _Pragma("unroll") for (int k = 0; k < 2; ++k) dst[m][k] = *(const LAS bf16x8*)(lds + PG_SA(b, h) + aoff + m * 2048 + k * 1024); } while (0)
#define PG_LDB(dst, b, h) do { _Pragma("unroll") for (int n = 0; n < 2; ++n) _Pragma("unroll") for (int k = 0; k < 2; ++k) dst[n][k] = *(const LAS bf16x8*)(lds + PG_SB(b, h) + boff + n * 2048 + k * 1024); } while (0)
#define PG_MMA(ai, bj, At, Bt) do { __builtin_amdgcn_s_setprio(1); _Pragma("unroll") for (int m = 0; m < 4; ++m) _Pragma("unroll") for (int n = 0; n < 2; ++n) _Pragma("unroll") for (int k = 0; k < 2; ++k) \
        acc[ai][bj][m][n] = __builtin_amdgcn_mfma_f32_16x16x32_bf16(Bt[n][k], At[m][k], acc[ai][bj][m][n], 0, 0, 0); __builtin_amdgcn_s_setprio(0); } while (0)
#define PG_WAIT_V(n) asm volatile("s_waitcnt vmcnt(" #n ")" ::: "memory")
#define PG_WAIT_L(n) asm volatile("s_waitcnt lgkmcnt(" #n ")" ::: "memory")
#define PG_BAR __builtin_amdgcn_s_barrier()
#define PG_SCHED __builtin_amdgcn_sched_barrier(0)
    UnitG cur, nxt; int ui = 0;
    if (!S.next(0, cur)) return;
    Acc acc;
#pragma unroll
    for (int a = 0; a < 2; ++a)
#pragma unroll
        for (int b = 0; b < 2; ++b)
#pragma unroll
            for (int m = 0; m < 4; ++m)
#pragma unroll
                for (int n = 0; n < 2; ++n) acc[a][b][m][n] = (f32x4){0.f, 0.f, 0.f, 0.f};
    bf16x8 At[4][2], B0[2][2], B1[2][2];
    const char* cA = cur.A; const char* cB = cur.B; unsigned clda = cur.lda, cldb = cur.ldb;
    PG_STAGE(PG_SB(0, 0), cB, cldb); PG_STAGE(PG_SB(0, 1), cB + (size_t)HALF * cldb, cldb); PG_STAGE(PG_SA(0, 0), cA, clda); PG_STAGE(PG_SA(0, 1), cA + (size_t)HALF * clda, clda);
    if (wr == 1) PG_BAR;
    PG_WAIT_V(2); PG_BAR;
    PG_STAGE(PG_SB(1, 0), cB + 128, cldb); PG_STAGE(PG_SA(1, 0), cA + 128, clda); PG_STAGE(PG_SB(1, 1), cB + (size_t)HALF * cldb + 128, cldb);
    PG_WAIT_V(6); PG_BAR;
    for (;;) {
        const bool has_next = S.next(ui + 1, nxt);
        const char* nA = has_next ? nxt.A : cA; const char* nB = has_next ? nxt.B : cB;
        const unsigned nlda = has_next ? nxt.lda : clda, nldb = has_next ? nxt.ldb : cldb;
        const int nt = cur.nt; const bool chalf = cur.half != 0;
        for (int t = 0; t < nt; t += 2) {
            const bool last = (t == nt - 2);
            const char* a1 = cA + (size_t)(t + 1) * 128;
            const char* a2 = last ? nA : cA + (size_t)(t + 2) * 128; const char* b2 = last ? nB : cB + (size_t)(t + 2) * 128;
            const unsigned lda2 = last ? nlda : clda, ldb2 = last ? nldb : cldb;
            const char* a3 = a2 + 128; const char* b3 = b2 + 128;
            PG_LDB(B0, 0, 0); PG_LDB(B1, 0, 1); PG_SCHED; PG_LDA(At, 0, 0); PG_STAGE(PG_SA(1, 1), a1 + (size_t)HALF * clda, clda);
            PG_WAIT_V(8); PG_WAIT_L(0); PG_BAR; PG_MMA(0, 0, At, B0); PG_MMA(0, 1, At, B1); PG_BAR; PG_SCHED;
            PG_LDA(At, 0, 1); PG_STAGE(PG_SB(0, 0), b2, ldb2); PG_STAGE(PG_SB(0, 1), b2 + (size_t)HALF * ldb2, ldb2); PG_STAGE(PG_SA(0, 0), a2, lda2);
            PG_WAIT_V(8); PG_WAIT_L(0); PG_BAR; if (!chalf) { PG_MMA(1, 0, At, B0); PG_MMA(1, 1, At, B1); } PG_BAR; PG_SCHED;
            PG_LDB(B0, 1, 0); PG_LDB(B1, 1, 1); PG_SCHED; PG_LDA(At, 1, 0); PG_STAGE(PG_SA(0, 1), a2 + (size_t)HALF * lda2, lda2);
            PG_WAIT_V(8); PG_WAIT_L(0); PG_BAR; PG_MMA(0, 0, At, B0); PG_MMA(0, 1, At, B1); PG_BAR; PG_SCHED;
            PG_LDA(At, 1, 1); PG_STAGE(PG_SB(1, 0), b3, ldb2); PG_STAGE(PG_SB(1, 1), b3 + (size_t)HALF * ldb2, ldb2); PG_STAGE(PG_SA(1, 0), a3, lda2);
            PG_WAIT_V(8); PG_WAIT_L(0); PG_BAR; if (!chalf) { PG_MMA(1, 0, At, B0); PG_MMA(1, 1, At, B1); } PG_BAR; PG_SCHED;
        }
        if (wr == 0) PG_BAR;
        E(acc, cur, lds, wr, wc, fr, fq);
        if (!has_next) break;
#pragma unroll
        for (int a = 0; a < 2; ++a)
#pragma unroll
            for (int b = 0; b < 2; ++b)
#pragma unroll
                for (int m = 0; m < 4; ++m)
#pragma unroll
                    for (int n = 0; n < 2; ++n) acc[a][b][m][n] = (f32x4){0.f, 0.f, 0.f, 0.f};
        cur = nxt; cA = nA; cB = nB; clda = nlda; cldb = nldb; ++ui;
        if (wr == 1) PG_BAR;
    }
    PG_WAIT_V(0);
    PG_BAR;
#undef PG_SA
#undef PG_SB
#undef PG_STAGE
#undef PG_LDA
#undef PG_LDB
#undef PG_MMA
#undef PG_WAIT_V
#undef PG_WAIT_L
#undef PG_BAR
#undef PG_SCHED
}
}

struct MArgs { const float* in[24]; float* out; unsigned char* ws; int ph_lo, ph_hi, li, pad; };
struct Frame {
    LAS unsigned char* lds; int tid, lane, wave; int x, j, vcu, G;
    const MArgs* a; float* out; unsigned char* ws;
};
#define FIN(k) (F.a->in[k])
__device__ __forceinline__ float fwave_sum(float v) {
#pragma unroll
    for (int o = 1; o < 64; o <<= 1) v += __shfl_xor(v, o);
    return v;
}

#ifndef PROBE_LO
#define PROBE_LO -1
#define PROBE_HI -1
#define PROBE_MULT 1
#endif
__device__ __forceinline__ void probe_stamp(Frame& F, int k) {
    if (PROBE_LO >= 0 && blockIdx.x == 0 && F.tid == 0) { volatile LAS unsigned* M = (volatile LAS unsigned*)(F.lds + MISC_OFF); const unsigned long long t_ = __builtin_amdgcn_s_memrealtime();
        if (k == PROBE_LO) { M[16] = (unsigned)t_; M[17] = (unsigned)(t_ >> 32); } if (k == PROBE_HI) { M[18] = (unsigned)t_; M[19] = (unsigned)(t_ >> 32); } }
}
enum { W_IN = 0, W_QUP, W_KVUP, W_OBA, W_OBB, W_OUT, W_UP, W_DOWN };
__device__ __forceinline__ int win_src(int gd) {
    const int tile = gd >> 3, g = gd & 7, bj = g >> 2, wc = g & 3;
    if (tile < 3) return C_QLAT + gd * 32;
    if (tile < 5) return C_KVLAT + (gd - 24) * 32;
    if (tile == 5) return (wc == 0) ? C_KPE + bj * 32 : -1;
    if (tile < 10) { const int base = tile < 8 ? C_RQ : C_RK, tl = tile < 8 ? tile - 6 : tile - 8; const int head = 2 * tl + (wc >> 1); return base + head * 128 + bj * 64 + (wc & 1) * 32; }
    if (tile < 14) return C_RV + (gd - 80) * 32;
    if (tile < 18) return C_RG + (gd - 112) * 32;
    if (tile < 22) return C_GA + (gd - 144) * 32;
    return C_GB + (gd - 176) * 32;
}
__device__ __forceinline__ int w_src_col(int wid, int row) {
    const int rho = row & 31, s = row & 255, wc = (s >> 5) & 3, t = row >> 8;
    const int n = rho >> 4, i = rho & 15; return t * 192 + 128 + 16 * wc + i + 32 * n;
}
__device__ __forceinline__ int w_group_base(int wid, int gd) {
    const int g = gd & 7, bj = g >> 2, wc = g & 3, t = gd >> 3;
    switch (wid) {
    case W_IN: return win_src(gd);
    case W_QUP: return bj == 0 ? t * 192 + 32 * wc : (wc < 2 ? -2 : -1);
    case W_KVUP: return t * 256 + 128 * bj + 32 * wc;
    case W_UP: return (bj ? D_FF : 0) + 128 * t + 32 * wc;
    default: return gd * 32;
    }
}
struct WItemRegs { f32x4 v[8]; float g[8]; };
__device__ __forceinline__ void p0_item_load(WItemRegs& R, const float* __restrict__ W, int ldw, const float* __restrict__ gain, int base, int kb, int lane) {
    const int k0 = kb * 64, c = lane & 7;
    if (base >= 0) {
#pragma unroll
        for (int i = 0; i < 8; ++i) { const int kk = (lane >> 3) + 8 * i; R.g[i] = gain ? gain[k0 + kk] : 1.f; R.v[i] = *(const f32x4*)(W + (size_t)(k0 + kk) * ldw + base + 4 * c); } }
}
__device__ __forceinline__ void p0_item_finish(const WItemRegs& R, const float* __restrict__ W, int ldw, int K, const float* __restrict__ gain, int wid, int base, bf16_t* __restrict__ Wt, int gd, int kb, LAS float* scr, int lane) {
    const int k0 = kb * 64, c = lane & 7;
    bf16_t* dst = Wt + (size_t)(gd * 32) * K + k0;
    if (base == -1) {
#pragma unroll
        for (int jj = 0; jj < 4; ++jj) { const int n = (lane >> 3) + 8 * jj; *(u32x4*)(dst + (size_t)n * K + 8 * c) = (u32x4){0u, 0u, 0u, 0u}; }
        return;
    }
    if (base >= 0) {
#pragma unroll
        for (int i = 0; i < 8; ++i) { const int kk = (lane >> 3) + 8 * i; LAS float* d = scr + kk * 33 + 4 * c; const float g = R.g[i]; d[0] = R.v[i][0] * g; d[1] = R.v[i][1] * g; d[2] = R.v[i][2] * g; d[3] = R.v[i][3] * g; }
    } else {
        const int sc = w_src_col(wid, gd * 32 + (lane & 31));
#pragma unroll 8
        for (int i = 0; i < 32; ++i) { const int kk = 2 * i + (lane >> 5); const float g = gain ? gain[k0 + kk] : 1.f; scr[kk * 33 + (lane & 31)] = W[(size_t)(k0 + kk) * ldw + sc] * g; }
    }
    asm volatile("s_waitcnt lgkmcnt(0)" ::: "memory");
#pragma unroll
    for (int jj = 0; jj < 4; ++jj) { const int n = (lane >> 3) + 8 * jj; const LAS float* s = scr + (8 * c) * 33 + (base >= 0 ? pg::perm32(n) : n);
        u32x4 o; o.x = cvt_pk_bf16(s[0 * 33], s[1 * 33]); o.y = cvt_pk_bf16(s[2 * 33], s[3 * 33]); o.z = cvt_pk_bf16(s[4 * 33], s[5 * 33]); o.w = cvt_pk_bf16(s[6 * 33], s[7 * 33]);
        *(u32x4*)(dst + (size_t)n * K + 8 * c) = o; }
    asm volatile("s_waitcnt lgkmcnt(0)" ::: "memory");
}
struct WDesc { const float* W; const float* gain; int ldw, K, wid, ngroups, local; size_t off; };
__device__ __forceinline__ bool w_decode(Frame& F, int it, WDesc& d) {
    if (it < 3328) { d = WDesc{FIN(7), FIN(6), IN_W, 1024, W_IN, 208, it, WS_FWIN}; return true; } it -= 3328;
    if (it < 768) { d = WDesc{FIN(9), FIN(8), 1536, 768, W_QUP, 64, it, WS_FWQUP}; return true; } it -= 768;
    if (it < 512) { d = WDesc{FIN(13), nullptr, 2048, 512, W_KVUP, 64, it, WS_FWKVUP}; return true; } it -= 512;
    if (it < 512) { d = WDesc{FIN(17), nullptr, 1024, 1024, W_OBA, 32, it, WS_FWOBA}; return true; } it -= 512;
    if (it < 512) { d = WDesc{FIN(17) + (size_t)1024 * 1024, nullptr, 1024, 1024, W_OBB, 32, it, WS_FWOBB}; return true; } it -= 512;
    if (it < 512) { d = WDesc{FIN(18), nullptr, 1024, 1024, W_OUT, 32, it, WS_FWOUT}; return true; } it -= 512;
    if (it < 2816) { d = WDesc{FIN(20), FIN(19), FF2, 1024, W_UP, 176, it, WS_FWUP}; return true; } it -= 2816;
    if (it < 1408) { d = WDesc{FIN(23), nullptr, 1024, D_FF, W_DOWN, 32, it, WS_FWDOWN}; return true; }
    return false;
}
__device__ __forceinline__ void p0_all_weights(Frame& F, LAS float* scr, int gw, int NGW) {
    for (int it = gw; it < 10368; it += 2 * NGW) {
        WDesc dA, dB; w_decode(F, it, dA); const bool hasB = w_decode(F, it + NGW, dB);
        const int gdA = dA.local % dA.ngroups, kbA = dA.local / dA.ngroups, baseA = w_group_base(dA.wid, gdA);
        const int gdB = hasB ? dB.local % dB.ngroups : 0, kbB = hasB ? dB.local / dB.ngroups : 0, baseB = hasB ? w_group_base(dB.wid, gdB) : -1;
        WItemRegs RA, RB;
        p0_item_load(RA, dA.W, dA.ldw, dA.gain, baseA, kbA, F.lane);
        if (hasB) p0_item_load(RB, dB.W, dB.ldw, dB.gain, baseB, kbB, F.lane);
        p0_item_finish(RA, dA.W, dA.ldw, dA.K, dA.gain, dA.wid, baseA, (bf16_t*)(F.ws + dA.off), gdA, kbA, scr, F.lane);
        if (hasB) p0_item_finish(RB, dB.W, dB.ldw, dB.K, dB.gain, dB.wid, baseB, (bf16_t*)(F.ws + dB.off), gdB, kbB, scr, F.lane);
    }
}
__device__ __forceinline__ float2 rope_cs(int pos, double f) {
    const double t = (double)pos * f * 0.15915494309189535; const float rev = (float)(t - rint(t));
    return make_float2(__builtin_amdgcn_cosf(rev), __builtin_amdgcn_sinf(rev));
}
__device__ __forceinline__ void p0_prologue(Frame& F) {
    LAS float* scr = (LAS float*)(F.lds + F.wave * 16384);
    const int gw = F.vcu * 8 + F.wave, NGW = F.G * 8;
    probe_stamp(F, 20);
    p0_all_weights(F, scr, gw, NGW);
    probe_stamp(F, 21);
    {   bf16_t* XN = (bf16_t*)(F.ws + WS_XN);
        for (int r = gw; r < MPAD; r += 2 * NGW) {
            const int r2 = r + NGW; f32x4 v[2][4];
#pragma unroll
            for (int q = 0; q < 2; ++q) { const int rr = q ? r2 : r; if (rr < MT) { const float* x = rr < MP ? FIN(0) + (size_t)rr * D_MODEL : FIN(1) + (size_t)(rr - MP) * D_MODEL; const f32x4* xr = (const f32x4*)x + F.lane;
#pragma unroll
                    for (int jj = 0; jj < 4; ++jj) v[q][jj] = xr[64 * jj]; } else {
#pragma unroll
                    for (int jj = 0; jj < 4; ++jj) v[q][jj] = (f32x4){0.f, 0.f, 0.f, 0.f}; } }
#pragma unroll
            for (int q = 0; q < 2; ++q) { const int rr = q ? r2 : r; if (rr >= MPAD) continue; float s = 0.f;
#pragma unroll
                for (int jj = 0; jj < 4; ++jj) s += (v[q][jj][0] * v[q][jj][0] + v[q][jj][1] * v[q][jj][1]) + (v[q][jj][2] * v[q][jj][2] + v[q][jj][3] * v[q][jj][3]);
                const float inv = rsqrtf(fwave_sum(s) * (1.f / D_MODEL) + EPS); u32x2* o8 = (u32x2*)(XN + (size_t)rr * D_MODEL) + F.lane;
#pragma unroll
                for (int jj = 0; jj < 4; ++jj) { u32x2 w; w.x = cvt_pk_bf16(v[q][jj][0] * inv, v[q][jj][1] * inv); w.y = cvt_pk_bf16(v[q][jj][2] * inv, v[q][jj][3] * inv); o8[64 * jj] = w; } }
        } }
    probe_stamp(F, 22);
    {   bf16_t* lats = (bf16_t*)(F.ws + WS_LATS); bf16_t* pes = (bf16_t*)(F.ws + WS_PES);
        const int gt = F.vcu * NTHR + F.tid, NG = F.G * NTHR;
        for (int i0 = gt; i0 < DEC_BATCH * PAST * (KV_LORA / 4); i0 += 4 * NG) { f32x4 v[4];
#pragma unroll
            for (int q = 0; q < 4; ++q) v[q] = *((const f32x4*)FIN(2) + i0 + q * NG);
#pragma unroll
            for (int q = 0; q < 4; ++q) { const int i = i0 + q * NG, c4 = i % (KV_LORA / 4), rj = i / (KV_LORA / 4), jr = rj % PAST, b = rj / PAST; u32x2 w; w.x = cvt_pk_bf16(v[q][0], v[q][1]); w.y = cvt_pk_bf16(v[q][2], v[q][3]);
                *(u32x2*)(lats + ((size_t)b * SKEYS + jr) * KV_LORA + c4 * 4) = w; } }
        for (int i = gt; i < DEC_BATCH * PAST * (QK_ROPE / 4); i += NG) { const int c4 = i % (QK_ROPE / 4), rj = i / (QK_ROPE / 4), jr = rj % PAST, b = rj / PAST;
            const f32x4 v = *((const f32x4*)FIN(3) + i); u32x2 w; w.x = cvt_pk_bf16(v[0], v[1]); w.y = cvt_pk_bf16(v[2], v[3]);
            *(u32x2*)(pes + ((size_t)b * SKEYS + jr) * QK_ROPE + c4 * 4) = w; }
        probe_stamp(F, 23);
        float2* tab32 = (float2*)(F.ws + WS_TAB32); float2* tab64 = (float2*)(F.ws + WS_TAB64);
        {   const int k64 = gt & 63, k32 = gt & 31;
            const double f64 = exp2(-(double)k64 * (13.287712379549449 / 64.0)), f32 = exp2(-(double)k32 * (13.287712379549449 / 32.0));
            for (int i = gt; i < 8192 * 64; i += NG) { tab64[i] = rope_cs(i >> 6, f64); if (i < 8192 * 32) tab32[i] = rope_cs(i >> 5, f32); } } }
}

__device__ __forceinline__ bool reg_unit(int x, int j, int i, int nN, int& pm, int& pn) { const int u = j + 32 * i; if (u >= 8 * nN) return false; pm = 8 * x + (u & 7); pn = u >> 3; return true; }
#define LDS_F(off) ((LAS float*)(lds + EPI_OFF) + (off))

enum { K_QLAT = 0, K_KVLAT, K_KPE, K_RQ, K_RK, K_RV, K_RG, K_GS, K_QUP, K_KVP, K_KVS, K_GA, K_AD, K_GB, K_RD, K_OUT, K_UP, K_DOWN };
struct SchedP1 {
    int x, j; const char* ws;
    __device__ __forceinline__ bool next(int i, pg::UnitG& u) const {
        int pm, pn;
        if (!reg_unit(x, j, i, 18, pm, pn)) { if (i == 4 && j >= 16) { const int k = (j - 16) * 8 + x; if (k >= 26) return false; pm = 64; pn = k; } else return false; }
        u.pm = pm; u.pn = pn; u.A = ws + WS_XN + (size_t)pm * 256 * 2048; u.B = ws + WS_FWIN + (size_t)pn * 256 * 2048; u.lda = 2048; u.ldb = 2048; u.nt = 16; u.half = pm == 64;
        u.kind = pn < 3 ? K_QLAT : pn < 5 ? K_KVLAT : pn == 5 ? K_KPE : pn < 8 ? K_RQ : pn < 10 ? K_RK : pn < 14 ? K_RV : pn < 18 ? K_RG : K_GS;
        return true;
    }
};
struct EpiP1 {
    unsigned char* ws; float* out; const float *g_kvlat, *g_kr;
    __device__ __forceinline__ void operator()(const pg::Acc& acc, const pg::UnitG& u, LAS unsigned char* lds, int wr, int wc, int fr, int fq) const {
        bf16_t* const ZQ = (bf16_t*)(ws + WS_ZQ); bf16_t* const KVL = (bf16_t*)(ws + WS_KVL); bf16_t* const KPE = (bf16_t*)(ws + WS_KPE); bf16_t* const PES = (bf16_t*)(ws + WS_PES); bf16_t* const LATS = (bf16_t*)(ws + WS_LATS);
        bf16_t* const RQ = (bf16_t*)(ws + WS_RQ); bf16_t* const RK = (bf16_t*)(ws + WS_RK); bf16_t* const RV = (bf16_t*)(ws + WS_RV); bf16_t* const RG = (bf16_t*)(ws + WS_RG);
        float* const slotq = (float*)(ws + WS_SLOTQ); float* const slotkv = (float*)(ws + WS_SLOTKV);
        const float2* const tab32 = (const float2*)(ws + WS_TAB32); const float2* const tab64 = (const float2*)(ws + WS_TAB64);
        int rl0 = wr * 64 + fr, cw = wc * 32 + fq * 8; asm volatile("" : "+v"(rl0), "+v"(cw));
        const int kind = u.kind, rb = u.pm * 256 + rl0;
        if (kind == K_QLAT || kind == K_KVLAT) {
            const int t = kind == K_QLAT ? u.pn : u.pn - 3; const int ld = kind == K_QLAT ? Q_LORA : KV_LORA; bf16_t* dst = kind == K_QLAT ? ZQ : KVL;
            f32x4 g[2][2];
#pragma unroll
            for (int bj = 0; bj < 2; ++bj)
#pragma unroll
                for (int n = 0; n < 2; ++n) g[bj][n] = kind == K_KVLAT ? *(const f32x4*)(g_kvlat + t * 256 + bj * 128 + cw + 4 * n) : (f32x4){1.f, 1.f, 1.f, 1.f};
#pragma unroll
            for (int ai = 0; ai < 2; ++ai)
#pragma unroll
                for (int m = 0; m < 4; ++m) { const int row = rb + ai * 128 + m * 16; float ss = 0.f;
                    const bool snew = (kind == K_KVLAT) && row >= MP && row < MT;
                    const int rs = row - MP; bf16_t* lrow = LATS + ((size_t)(rs / DEC_SEQ) * SKEYS + PAST + (rs % DEC_SEQ)) * KV_LORA;
#pragma unroll
                    for (int bj = 0; bj < 2; ++bj) { const f32x4 v0 = acc[ai][bj][m][0], v1 = acc[ai][bj][m][1];
                        ss += (v0[0] * v0[0] + v0[1] * v0[1]) + (v0[2] * v0[2] + v0[3] * v0[3]) + (v1[0] * v1[0] + v1[1] * v1[1]) + (v1[2] * v1[2] + v1[3] * v1[3]);
                        const u32x4 w = pack8f(v0 * g[bj][0], v1 * g[bj][1]);
                        *(u32x4*)(dst + (size_t)row * ld + t * 256 + bj * 128 + cw) = w;
                        if (snew) *(u32x4*)(lrow + t * 256 + bj * 128 + cw) = w; }
                    ss += __shfl_xor(ss, 16); ss += __shfl_xor(ss, 32);
                    if (fq == 0) { if (kind == K_QLAT) slotq[(size_t)row * 12 + t * 4 + wc] = ss; else slotkv[(size_t)row * 8 + t * 4 + wc] = ss; } }
        } else if (kind == K_KPE) {
            if (wc != 0) return;
            const int d0 = fq * 8;
            f32x4 g1[2], g2[2];
#pragma unroll
            for (int n = 0; n < 2; ++n) { g1[n] = *(const f32x4*)(g_kr + d0 + 4 * n); g2[n] = *(const f32x4*)(g_kr + 32 + d0 + 4 * n); }
#pragma unroll
            for (int ai = 0; ai < 2; ++ai)
#pragma unroll
                for (int m = 0; m < 4; ++m) { const int row = rb + ai * 128 + m * 16; const int pos = row_pos(row < MT ? row : 0);
                    f32x4 x1[2], x2[2]; float ss = 0.f;
#pragma unroll
                    for (int n = 0; n < 2; ++n) { x1[n] = acc[ai][0][m][n]; x2[n] = acc[ai][1][m][n];
                        ss += (x1[n][0] * x1[n][0] + x1[n][1] * x1[n][1]) + (x1[n][2] * x1[n][2] + x1[n][3] * x1[n][3]) + (x2[n][0] * x2[n][0] + x2[n][1] * x2[n][1]) + (x2[n][2] * x2[n][2] + x2[n][3] * x2[n][3]); }
                    ss += __shfl_xor(ss, 16); ss += __shfl_xor(ss, 32);
                    const float inv = rsqrtf(ss * (1.f / 64.f) + EPS);
                    f32x4 o1[2], o2[2];
#pragma unroll
                    for (int n = 0; n < 2; ++n) { const f32x4 y1 = x1[n] * inv * g1[n], y2 = x2[n] * inv * g2[n];
                        const f32x4 cs0 = *(const f32x4*)(tab32 + pos * 32 + d0 + 4 * n), cs1 = *(const f32x4*)(tab32 + pos * 32 + d0 + 4 * n + 2);
                        const f32x4 c = {cs0[0], cs0[2], cs1[0], cs1[2]}, s = {cs0[1], cs0[3], cs1[1], cs1[3]};
                        o1[n] = y1 * c - y2 * s; o2[n] = y1 * s + y2 * c; }
                    *(u32x4*)(KPE + (size_t)row * 64 + d0) = pack8f(o1[0], o1[1]); *(u32x4*)(KPE + (size_t)row * 64 + 32 + d0) = pack8f(o2[0], o2[1]);
                    if (row < MT) {
                        float* o = row < MP ? out + O_RKP + (size_t)row * 64 : out + O_RKS + (size_t)(row - MP) * 64;
                        *(f32x4*)(o + d0) = o1[0]; *(f32x4*)(o + d0 + 4) = o1[1]; *(f32x4*)(o + 32 + d0) = o2[0]; *(f32x4*)(o + 32 + d0 + 4) = o2[1];
                        if (row >= MP) { const int rs = row - MP, b = rs / DEC_SEQ, tt = rs % DEC_SEQ; bf16_t* p = PES + ((size_t)b * SKEYS + PAST + tt) * 64;
                            *(u32x4*)(p + d0) = pack8f(o1[0], o1[1]); *(u32x4*)(p + 32 + d0) = pack8f(o2[0], o2[1]); } } }
        } else if (kind == K_RQ || kind == K_RK) {
            const int tl = kind == K_RQ ? u.pn - 6 : u.pn - 8; const int head = 2 * tl + (wc >> 1), i0 = 32 * (wc & 1) + fq * 8;
            bf16_t* dst = kind == K_RQ ? RQ : RK; const float sc = kind == K_RQ ? 1.0f : 0.08838834764831845f;
#pragma unroll
            for (int ai = 0; ai < 2; ++ai)
#pragma unroll
                for (int m = 0; m < 4; ++m) { const int row = rb + ai * 128 + m * 16; const int pos = row_pos(row < MT ? row : 0);
                    f32x4 o1[2], o2[2];
#pragma unroll
                    for (int n = 0; n < 2; ++n) { const f32x4 x1 = acc[ai][0][m][n], x2 = acc[ai][1][m][n];
                        const f32x4 cs0 = *(const f32x4*)(tab64 + pos * 64 + i0 + 4 * n), cs1 = *(const f32x4*)(tab64 + pos * 64 + i0 + 4 * n + 2);
                        const f32x4 c = {cs0[0], cs0[2], cs1[0], cs1[2]}, s = {cs0[1], cs0[3], cs1[1], cs1[3]};
                        o1[n] = (x1 * c - x2 * s) * sc; o2[n] = (x1 * s + x2 * c) * sc; }
                    *(u32x4*)(dst + (size_t)row * 512 + head * 128 + i0) = pack8f(o1[0], o1[1]); *(u32x4*)(dst + (size_t)row * 512 + head * 128 + 64 + i0) = pack8f(o2[0], o2[1]); }
        } else if (kind == K_GS) {
            bf16_t* dst = (bf16_t*)(ws + (u.pn < 22 ? WS_GAS : WS_GBS)); const int t = u.pn < 22 ? u.pn - 18 : u.pn - 22;
#pragma unroll
            for (int m = 0; m < 4; ++m) { const int rl = rl0 + m * 16;
#pragma unroll
                for (int bj = 0; bj < 2; ++bj) { f32x4 v0 = acc[0][bj][m][0], v1 = acc[0][bj][m][1];
#pragma unroll
                    for (int e = 0; e < 4; ++e) { v0[e] = 1.f / (1.f + __expf(-v0[e])); v1[e] = 1.f / (1.f + __expf(-v1[e])); }
                    *(u32x4*)(dst + (size_t)rl * 1024 + t * 256 + bj * 128 + cw) = pack8f(v0, v1); } }
        } else {
            const int t = kind == K_RV ? u.pn - 10 : u.pn - 14; bf16_t* dst = kind == K_RV ? RV : RG;
#pragma unroll
            for (int ai = 0; ai < 2; ++ai)
#pragma unroll
                for (int m = 0; m < 4; ++m) { const int row = rb + ai * 128 + m * 16;
#pragma unroll
                    for (int bj = 0; bj < 2; ++bj) { f32x4 v0 = acc[ai][bj][m][0], v1 = acc[ai][bj][m][1];
                        if (kind == K_RG) {
#pragma unroll
                            for (int e = 0; e < 4; ++e) { v0[e] = v0[e] / (1.f + __expf(-v0[e])); v1[e] = v1[e] / (1.f + __expf(-v1[e])); } }
                        *(u32x4*)(dst + (size_t)row * 1024 + t * 256 + bj * 128 + cw) = pack8f(v0, v1); } }
        }
    }
};
__device__ __forceinline__ void p1_inproj(Frame& F) {
    SchedP1 S{F.x, F.j, (const char*)F.ws};
    EpiP1 E{F.ws, F.out, FIN(12), FIN(15)};
    pg::gemm_stream(F.lds, S, E);
}

__device__ __forceinline__ float slot_rs(const float* slots, int n, float invn) {
    float a = 0.f; for (int i = 0; i < n; i += 4) { const f32x4 v = *(const f32x4*)(slots + i); a += (v[0] + v[1]) + (v[2] + v[3]); } return rsqrtf(a * invn + EPS);
}
struct SchedP2 {
    int x, j; const char* ws; int sample;
    __device__ __forceinline__ bool next(int i, pg::UnitG& u) const {
        int pm, pn, kind;
        if (sample) {
            if (i < 2) { reg_unit(x, j, i, 8, pm, pn); kind = K_QUP; }
            else if (i < 4) { reg_unit(x, j, i - 2, 8, pm, pn); kind = K_KVS; }
            else if (i == 4 && j < 2) { const int k = j * 8 + x; pm = 64; pn = k & 7; kind = k < 8 ? K_QUP : K_KVS; }
            else return false;
        } else { if (i >= 2) return false; reg_unit(x, j, i, 8, pm, pn); kind = K_KVP; }
        u.pm = pm; u.pn = pn; u.kind = kind; u.half = pm == 64;
        if (kind == K_QUP) { u.A = ws + WS_ZQ + (size_t)pm * 256 * 1536; u.lda = 1536; u.B = ws + WS_FWQUP + (size_t)pn * 256 * 1536; u.ldb = 1536; u.nt = 12; }
        else { u.A = ws + (kind == K_KVS ? WS_LATS : WS_KVL) + (size_t)pm * 256 * 1024; u.lda = 1024; u.B = ws + WS_FWKVUP + (size_t)pn * 256 * 1024; u.ldb = 1024; u.nt = 8; }
        return true;
    }
};
struct EpiP2 {
    unsigned char* ws; float* out; const float *g_qn, *g_qr, *g_kn;
    __device__ __forceinline__ void operator()(const pg::Acc& acc, const pg::UnitG& u, LAS unsigned char* lds, int wr, int wc, int fr, int fq) const {
        int rl0 = wr * 64 + fr, cw = wc * 32 + fq * 8; asm volatile("" : "+v"(rl0), "+v"(cw));
        const int kind = u.kind, h = u.pn, rb = u.pm * 256 + rl0;
        const float* const slotq = (const float*)(ws + WS_SLOTQ); const float* const slotkv = (const float*)(ws + WS_SLOTKV);
        float rs[2][4];
#pragma unroll
        for (int ai = 0; ai < 2; ++ai)
#pragma unroll
            for (int m = 0; m < 4; ++m) { const int row = rb + ai * 128 + m * 16;
                if (kind == K_QUP) rs[ai][m] = slot_rs(slotq + (size_t)row * 12, 12, 1.f / Q_LORA);
                else if (kind == K_KVP) rs[ai][m] = slot_rs(slotkv + (size_t)row * 8, 8, 1.f / KV_LORA);
                else { const int b = row / SKEYS, jj = row - b * SKEYS; rs[ai][m] = (row < LROWS && jj >= PAST) ? slot_rs(slotkv + (size_t)(MP + b * DEC_SEQ + jj - PAST) * 8, 8, 1.f / KV_LORA) : 1.f; } }
#pragma unroll
        for (int ai = 0; ai < 2; ++ai)
#pragma unroll
            for (int m = 0; m < 4; ++m) { float p0 = 0.f, p1 = 0.f; const float s2 = rs[ai][m] * rs[ai][m];
#pragma unroll
                for (int n = 0; n < 2; ++n) { const f32x4 a = acc[ai][0][m][n], b = acc[ai][1][m][n];
                    p0 += (a[0] * a[0] + a[1] * a[1]) + (a[2] * a[2] + a[3] * a[3]); p1 += (b[0] * b[0] + b[1] * b[1]) + (b[2] * b[2] + b[3] * b[3]); }
                p0 += __shfl_xor(p0, 16); p0 += __shfl_xor(p0, 32); p1 += __shfl_xor(p1, 16); p1 += __shfl_xor(p1, 32);
                if (fq == 0) { LAS float* d = LDS_F((rl0 + ai * 128 + m * 16) * 8 + wc * 2); d[0] = p0 * s2; d[1] = p1 * s2; } }
        asm volatile("s_waitcnt lgkmcnt(0)" ::: "memory"); __builtin_amdgcn_s_barrier(); asm volatile("" ::: "memory");
        if (kind == K_QUP) {
            bf16_t* const Q = (bf16_t*)out;
            const float2* const tab32 = (const float2*)(ws + WS_TAB32);
            const float C2 = 0.07216878364870323f * 1.4426950408889634f;
            f32x4 gn[2]; gn[0] = *(const f32x4*)(g_qn + cw); gn[1] = *(const f32x4*)(g_qn + cw + 4);
            const int ir = 16 * (wc & 1) + 4 * fq; const f32x4 gr1 = *(const f32x4*)(g_qr + ir), gr2 = *(const f32x4*)(g_qr + 32 + ir);
#pragma unroll
            for (int ai = 0; ai < 2; ++ai)
#pragma unroll
                for (int m = 0; m < 4; ++m) { const int row = rb + ai * 128 + m * 16; const int pos = row_pos(row < MT ? row : 0);
                    const LAS float* d = LDS_F((rl0 + ai * 128 + m * 16) * 8); const f32x4 e0 = *(const LAS f32x4*)d, e1 = *(const LAS f32x4*)(d + 4);
                    const float inn = rsqrtf((e0[0] + e0[2] + e1[0] + e1[2]) * (1.f / 128.f) + EPS) * rs[ai][m] * C2, inr = rsqrtf((e0[1] + e0[3]) * (1.f / 64.f) + EPS) * rs[ai][m];
                    bf16_t* qrow = Q + (size_t)row * 1536 + h * 192;
                    *(u32x4*)(qrow + cw) = pack8f(acc[ai][0][m][0] * inn * gn[0], acc[ai][0][m][1] * inn * gn[1]);
                    if (wc < 2) { const f32x4 y1 = acc[ai][1][m][0] * inr * gr1, y2 = acc[ai][1][m][1] * inr * gr2;
                        const f32x4 cs0 = *(const f32x4*)(tab32 + pos * 32 + ir), cs1 = *(const f32x4*)(tab32 + pos * 32 + ir + 2);
                        const f32x4 c = {cs0[0], cs0[2], cs1[0], cs1[2]}, s = {cs0[1], cs0[3], cs1[1], cs1[3]};
                        const f32x4 o1 = (y1 * c - y2 * s) * C2, o2 = (y1 * s + y2 * c) * C2;
                        u32x2 w1, w2; w1.x = cvt_pk_bf16(o1[0], o1[1]); w1.y = cvt_pk_bf16(o1[2], o1[3]); w2.x = cvt_pk_bf16(o2[0], o2[1]); w2.y = cvt_pk_bf16(o2[2], o2[3]);
                        *(u32x2*)(qrow + 128 + ir) = w1; *(u32x2*)(qrow + 160 + ir) = w2; } }
        } else {
            bf16_t* const KN = (bf16_t*)(ws + WS_KN); bf16_t* const V = (bf16_t*)(ws + WS_V);
            f32x4 gk[2]; gk[0] = *(const f32x4*)(g_kn + cw); gk[1] = *(const f32x4*)(g_kn + cw + 4);
#pragma unroll
            for (int ai = 0; ai < 2; ++ai)
#pragma unroll
                for (int m = 0; m < 4; ++m) { const int row = rb + ai * 128 + m * 16;
                    const LAS float* d = LDS_F((rl0 + ai * 128 + m * 16) * 8); const f32x4 e0 = *(const LAS f32x4*)d, e1 = *(const LAS f32x4*)(d + 4);
                    const float s = rs[ai][m], inn = rsqrtf((e0[0] + e0[2] + e1[0] + e1[2]) * (1.f / 128.f) + EPS) * s;
                    *(u32x4*)(KN + (size_t)row * 1024 + h * 128 + cw) = pack8f(acc[ai][0][m][0] * inn * gk[0], acc[ai][0][m][1] * inn * gk[1]);
                    *(u32x4*)(V + (size_t)row * 1024 + h * 128 + cw) = pack8f(acc[ai][1][m][0] * s, acc[ai][1][m][1] * s); }
        }
    }
};
__device__ __forceinline__ void p2_qkv(Frame& F, int sample) {
    SchedP2 S{F.x, F.j, (const char*)F.ws, sample};
    EpiP2 E{F.ws, F.out, FIN(10), FIN(11), FIN(14)};
    pg::gemm_stream(F.lds, S, E);
}

struct SchedP5 {
    int x, j, vcu; const char* ws; int phase;
    __device__ __forceinline__ const char* arow(size_t base, size_t base_s, int pm, size_t rowbytes) const { return ws + (pm < 64 ? base + (size_t)pm * 256 * rowbytes : base_s); }
    __device__ __forceinline__ bool next(int i, pg::UnitG& u) const {
        int pm, pn;
        if (phase == 5) {
            int sub;
            if (i < 4) { sub = i; pm = 8 * x + (j & 7); pn = j >> 3; } else if (i < 6 && j == 0 && x < 4) { sub = i == 4 ? 1 : 3; pm = 64; pn = x; } else return false;
            u.pm = pm; u.pn = pn; u.kind = K_GA + sub; u.lda = 2048; u.ldb = 2048; u.nt = 16; u.half = pm == 64;
            if (sub == 0) { u.A = ws + WS_XN2 + (size_t)pm * 256 * 2048; u.B = ws + WS_FWIN + (size_t)(18 + pn) * 256 * 2048; }
            else if (sub == 1) { u.A = arow(WS_ATT, WS_ATTS, pm, 2048); u.B = ws + WS_FWOBA + (size_t)pn * 256 * 2048; }
            else if (sub == 2) { u.A = ws + WS_XN2 + (size_t)pm * 256 * 2048; u.B = ws + WS_FWIN + (size_t)(22 + pn) * 256 * 2048; }
            else { u.A = ws + WS_RET + (size_t)pm * 256 * 2048; u.B = ws + WS_FWOBB + (size_t)pn * 256 * 2048; }
            return true;
        }
        if (phase == 6 || phase == 9) {
            if (i == 0) { pm = 8 * x + (j & 7); pn = j >> 3; } else if (i == 1 && j == 0 && x < 4) { pm = 64; pn = x; } else return false;
            u.pm = pm; u.pn = pn; u.half = pm == 64;
            if (phase == 6) { u.kind = K_OUT; u.A = ws + WS_MERGED + (size_t)pm * 256 * 2048; u.lda = 2048; u.B = ws + WS_FWOUT + (size_t)pn * 256 * 2048; u.ldb = 2048; u.nt = 16; }
            else { u.kind = K_DOWN; u.A = ws + WS_U + (size_t)pm * 256 * (FF2 * 2); u.lda = FF2 * 2; u.B = ws + WS_FWDOWN + (size_t)pn * 256 * (D_FF * 2); u.ldb = D_FF * 2; u.nt = 44; }
            return true;
        }
        if (!reg_unit(x, j, i, 22, pm, pn)) { if (i == 5 && j >= 16) { const int k = (j - 16) * 8 + x; if (k >= 22) return false; pm = 64; pn = k; } else return false; }
        u.half = pm == 64; u.pm = pm; u.pn = pn; u.kind = K_UP; u.A = ws + WS_X1B + (size_t)pm * 256 * 2048; u.lda = 2048; u.B = ws + WS_FWUP + (size_t)pn * 256 * 2048; u.ldb = 2048; u.nt = 16;
        return true;
    }
};
struct EpiP5 {
    unsigned char* ws; float* out; const float* xp; const float* xs; int vcu;
    __device__ __forceinline__ void operator()(pg::Acc& acc, const pg::UnitG& u, LAS unsigned char* lds, int wr, int wc, int fr, int fq) const {
        int rl0 = wr * 64 + fr, cw = wc * 32 + fq * 8; asm volatile("" : "+v"(rl0), "+v"(cw));
        const int kind = u.kind, rb = u.pm * 256 + rl0;
        if (kind >= K_GA && kind <= K_RD) {
            bf16_t* const T1 = (bf16_t*)(ws + WS_T1) + (size_t)vcu * 65536; bf16_t* const T2 = (bf16_t*)out + (size_t)vcu * 65536;
            bf16_t* const MG = (bf16_t*)(ws + WS_MERGED);
#pragma unroll
            for (int ai = 0; ai < 2; ++ai)
#pragma unroll
                for (int m = 0; m < 4; ++m)
#pragma unroll
                    for (int bj = 0; bj < 2; ++bj) { const size_t so = (size_t)(rl0 + ai * 128 + m * 16) * 256 + bj * 128 + cw;
                        f32x4 v0 = acc[ai][bj][m][0], v1 = acc[ai][bj][m][1];
                        if (kind == K_GA || kind == K_GB) {
#pragma unroll
                            for (int e = 0; e < 4; ++e) { v0[e] = 1.f / (1.f + __expf(-v0[e])); v1[e] = 1.f / (1.f + __expf(-v1[e])); }
                            *(u32x4*)((kind == K_GA ? T1 : T2) + so) = pack8f(v0, v1);
                        } else if (kind == K_AD) {
                            const u32x4 t = u.pm == 64 ? *(const u32x4*)((const bf16_t*)(ws + WS_GAS) + (size_t)(rl0 + ai * 128 + m * 16) * 1024 + u.pn * 256 + bj * 128 + cw) : *(const u32x4*)(T1 + so);
                            const f32x4 g0 = {__uint_as_float(t.x << 16), __uint_as_float(t.x & 0xffff0000u), __uint_as_float(t.y << 16), __uint_as_float(t.y & 0xffff0000u)};
                            const f32x4 g1 = {__uint_as_float(t.z << 16), __uint_as_float(t.z & 0xffff0000u), __uint_as_float(t.w << 16), __uint_as_float(t.w & 0xffff0000u)};
                            *(u32x4*)(T1 + so) = pack8f(v0 * g0, v1 * g1);
                        } else {
                            const u32x4 t = *(const u32x4*)(T1 + so), q = u.pm == 64 ? *(const u32x4*)((const bf16_t*)(ws + WS_GBS) + (size_t)(rl0 + ai * 128 + m * 16) * 1024 + u.pn * 256 + bj * 128 + cw) : *(const u32x4*)(T2 + so);
                            const f32x4 a0 = {__uint_as_float(t.x << 16), __uint_as_float(t.x & 0xffff0000u), __uint_as_float(t.y << 16), __uint_as_float(t.y & 0xffff0000u)};
                            const f32x4 a1 = {__uint_as_float(t.z << 16), __uint_as_float(t.z & 0xffff0000u), __uint_as_float(t.w << 16), __uint_as_float(t.w & 0xffff0000u)};
                            const f32x4 g0 = {__uint_as_float(q.x << 16), __uint_as_float(q.x & 0xffff0000u), __uint_as_float(q.y << 16), __uint_as_float(q.y & 0xffff0000u)};
                            const f32x4 g1 = {__uint_as_float(q.z << 16), __uint_as_float(q.z & 0xffff0000u), __uint_as_float(q.w << 16), __uint_as_float(q.w & 0xffff0000u)};
                            *(u32x4*)(MG + (size_t)(rb + ai * 128 + m * 16) * 1024 + u.pn * 256 + bj * 128 + cw) = pack8f(a0 + v0 * g0, a1 + v1 * g1);
                        }
                        if (bj == 1 && (m & 1)) asm volatile("" ::: "memory"); }
        } else if (kind == K_OUT) {
            float* const slotx = (float*)(ws + WS_SLOTX1); bf16_t* const X1B = (bf16_t*)(ws + WS_X1B);
#pragma unroll
            for (int ai = 0; ai < 2; ++ai)
#pragma unroll
                for (int m = 0; m < 4; ++m) { const int row = rb + ai * 128 + m * 16; float ss = 0.f;
                    const float* xr = row < MP ? xp + (size_t)row * D_MODEL : xs + (size_t)((row < MT ? row : MP) - MP) * D_MODEL;
#pragma unroll
                    for (int bj = 0; bj < 2; ++bj) { const int c = u.pn * 256 + bj * 128 + cw;
                        const f32x4 x0 = *(const f32x4*)(xr + c), x1 = *(const f32x4*)(xr + c + 4);
                        const f32x4 v0 = acc[ai][bj][m][0] + x0, v1 = acc[ai][bj][m][1] + x1;
                        ss += (v0[0] * v0[0] + v0[1] * v0[1]) + (v0[2] * v0[2] + v0[3] * v0[3]) + (v1[0] * v1[0] + v1[1] * v1[1]) + (v1[2] * v1[2] + v1[3] * v1[3]);
                        if (row < MT) { *(f32x4*)(out + (size_t)row * D_MODEL + c) = v0; *(f32x4*)(out + (size_t)row * D_MODEL + c + 4) = v1; }
                        *(u32x4*)(X1B + (size_t)row * D_MODEL + c) = pack8f(v0, v1); }
                    ss += __shfl_xor(ss, 16); ss += __shfl_xor(ss, 32);
                    if (fq == 0) slotx[(size_t)row * 16 + u.pn * 4 + wc] = ss;
                    asm volatile("" ::: "memory"); }
        } else if (kind == K_UP) {
            const float* const slotx = (const float*)(ws + WS_SLOTX1); bf16_t* const U = (bf16_t*)(ws + WS_U);
#pragma unroll
            for (int ai = 0; ai < 2; ++ai)
#pragma unroll
                for (int m = 0; m < 4; ++m) { const int row = rb + ai * 128 + m * 16;
                    float a = 0.f;
#pragma unroll
                    for (int i = 0; i < 16; i += 4) { const f32x4 v = *(const f32x4*)(slotx + (size_t)row * 16 + i); a += (v[0] + v[1]) + (v[2] + v[3]); }
                    const float s = rsqrtf(a * (1.f / D_MODEL) + EPS);
                    const f32x4 ug0 = acc[ai][0][m][0] * s, ug1 = acc[ai][0][m][1] * s, uv0 = acc[ai][1][m][0] * s, uv1 = acc[ai][1][m][1] * s;
                    const u32x4 wg = pack8f(ug0, ug1), wv = pack8f(uv0, uv1); const int cg = u.pn * 128 + cw, cv = D_FF + cg;
                    *(u32x4*)(U + (size_t)row * FF2 + cg) = wg; *(u32x4*)(U + (size_t)row * FF2 + cv) = wv;
                    if ((row & 255) >= 254 && row < MP - 2) { bf16_t* hp = (bf16_t*)(ws + WS_HALO) + ((size_t)((row >> 8) + 1) * 2 + (row & 1)) * FF2; *(u32x4*)(hp + cg) = wg; *(u32x4*)(hp + cv) = wv; }
                    if (row < MT) { const int tpos = row < MP ? (row & (SEQ - 1)) - (SEQ - 2) : ((row - MP) & (DEC_SEQ - 1)) - (DEC_SEQ - 2);
                        if (tpos >= 0) { float* cp = row < MP ? out + O_CONVP + ((size_t)(row >> 13) * 2 + tpos) * FF2 : out + O_CONVS + ((size_t)((row - MP) >> 4) * 2 + tpos) * FF2;
                            *(f32x4*)(cp + cg) = ug0; *(f32x4*)(cp + cg + 4) = ug1; *(f32x4*)(cp + cv) = uv0; *(f32x4*)(cp + cv + 4) = uv1; } }
                    if (m & 1) asm volatile("" ::: "memory"); }
        } else {
#pragma unroll
            for (int ai = 0; ai < 2; ++ai)
#pragma unroll
                for (int m = 0; m < 4; ++m) { const int row = rb + ai * 128 + m * 16; if (row >= MT) continue;
#pragma unroll
                    for (int bj = 0; bj < 2; ++bj) { float* p = out + (size_t)row * D_MODEL + u.pn * 256 + bj * 128 + cw;
                        const f32x4 x0 = *(const f32x4*)p, x1 = *(const f32x4*)(p + 4);
                        *(f32x4*)p = x0 + acc[ai][bj][m][0]; *(f32x4*)(p + 4) = x1 + acc[ai][bj][m][1]; }
                    asm volatile("" ::: "memory"); }
        }
    }
};
__device__ __forceinline__ void p5_gemm(Frame& F, int phase) {
    SchedP5 S{F.x, F.j, F.vcu, (const char*)F.ws, phase};
    EpiP5 E{F.ws, F.out, FIN(0), FIN(1), F.vcu};
    pg::gemm_stream(F.lds, S, E);
}

namespace rt {
typedef short s16x4 __attribute__((ext_vector_type(4)));
constexpr int QST = 136, KDST = 144, VST = 272, PST = 72;
constexpr int Q_OFF = 0, QS_OFF = 17408, K_OFF = 34816, KD_OFF = 52224, V_OFF = 70656, P_OFF = 105472, ST_OFF = 114688, RG_OFF = 118784;
constexpr int SC_TOK = 256, NSC = SEQ / SC_TOK;
__device__ __forceinline__ s16x4 trrd(const LAS bf16_t* p) { return __builtin_bit_cast(s16x4, __builtin_amdgcn_ds_read_tr16_b64_v4i16((LAS s16x4*)p)); }
__device__ __forceinline__ bf16x8 cat8(s16x4 lo, s16x4 hi) { return (bf16x8){lo[0], lo[1], lo[2], lo[3], hi[0], hi[1], hi[2], hi[3]}; }
__device__ __forceinline__ u32x4 scale8(u32x4 w, float s) {
    u32x4 o;
    o.x = cvt_pk_bf16(__uint_as_float(w.x << 16) * s, __uint_as_float(w.x & 0xffff0000u) * s); o.y = cvt_pk_bf16(__uint_as_float(w.y << 16) * s, __uint_as_float(w.y & 0xffff0000u) * s);
    o.z = cvt_pk_bf16(__uint_as_float(w.z << 16) * s, __uint_as_float(w.z & 0xffff0000u) * s); o.w = cvt_pk_bf16(__uint_as_float(w.w << 16) * s, __uint_as_float(w.w & 0xffff0000u) * s);
    return o;
}
__device__ __forceinline__ float row16_sum(float v) {
    v += __builtin_bit_cast(float, __builtin_amdgcn_update_dpp(0, __builtin_bit_cast(int, v), 0xB1, 0xf, 0xf, true));
    v += __builtin_bit_cast(float, __builtin_amdgcn_update_dpp(0, __builtin_bit_cast(int, v), 0x4E, 0xf, 0xf, true));
    v += __builtin_bit_cast(float, __builtin_amdgcn_update_dpp(0, __builtin_bit_cast(int, v), 0x141, 0xf, 0xf, true));
    v += __builtin_bit_cast(float, __builtin_amdgcn_update_dpp(0, __builtin_bit_cast(int, v), 0x140, 0xf, 0xf, true));
    return v;
}
template <bool FULL>
__device__ __forceinline__ void ret_unit(Frame& F, int h, int row0, int nch, int L, const float* Sin, float* Sout, const float* g_ret) {
    LAS unsigned char* lds = F.lds;
    const int tid = F.tid, w = F.wave, l = F.lane, fr = l & 15, g = l >> 4, tq = fr >> 2, tp = fr & 3;
    const float lg2 = log2f(1.f - exp2f(-5.f - (float)h));
    const bf16_t* RQ = (const bf16_t*)(F.ws + WS_RQ); const bf16_t* RK = (const bf16_t*)(F.ws + WS_RK); const bf16_t* RV = (const bf16_t*)(F.ws + WS_RV);
    const bf16_t* RG = (const bf16_t*)(F.ws + WS_RG); bf16_t* RET = (bf16_t*)(F.ws + WS_RET);
    LAS bf16_t* q_l = (LAS bf16_t*)(lds + Q_OFF); LAS bf16_t* qs_l = (LAS bf16_t*)(lds + QS_OFF); LAS bf16_t* k_l = (LAS bf16_t*)(lds + K_OFF);
    LAS bf16_t* kd_l = (LAS bf16_t*)(lds + KD_OFF); LAS bf16_t* v_l = (LAS bf16_t*)(lds + V_OFF); LAS bf16_t* p_l = (LAS bf16_t*)(lds + P_OFF); LAS float* st_l = (LAS float*)(lds + ST_OFF);
    LAS bf16_t* g_l = (LAS bf16_t*)(lds + RG_OFF);
    f32x4 S[8][2];
#pragma unroll
    for (int db = 0; db < 8; ++db)
#pragma unroll
        for (int nb = 0; nb < 2; ++nb) {
            if (Sin) { int so = (16 * db + 4 * g) * RET_DV + 32 * w + 16 * nb + fr; asm volatile("" : "+v"(so));
#pragma unroll
                for (int r = 0; r < 4; ++r) S[db][nb][r] = Sin[so + r * RET_DV]; }
            else S[db][nb] = (f32x4){0.f, 0.f, 0.f, 0.f}; }
    const float gL = exp2f(lg2 * (float)L);
    float gr[2]; if (FULL) { gr[0] = g_ret[h * 256 + 32 * w + fr]; gr[1] = g_ret[h * 256 + 32 * w + 16 + fr]; }
    for (int c = 0; c < nch; ++c) {
        const size_t r0 = (size_t)row0 + (size_t)c * L;
        __syncthreads();
        {   u32x4 pk[2], pq[2], pv[4], pgt[4]; const u32x4 z_ = {0u, 0u, 0u, 0u};
#pragma unroll
            for (int it = 0; it < 2; ++it) { const int idx = tid + 512 * it, tok = idx >> 4, c8 = idx & 15; const bool ok = tok < L;
                pk[it] = ok ? *(const u32x4*)(RK + (r0 + tok) * 512 + h * 128 + c8 * 8) : z_; if (FULL) pq[it] = ok ? *(const u32x4*)(RQ + (r0 + tok) * 512 + h * 128 + c8 * 8) : z_; }
#pragma unroll
            for (int it = 0; it < 4; ++it) { const int idx = tid + 512 * it, tok = idx >> 5, c8 = idx & 31; const bool ok = tok < L;
                pv[it] = ok ? *(const u32x4*)(RV + (r0 + tok) * 1024 + h * 256 + c8 * 8) : z_; if (FULL) pgt[it] = ok ? *(const u32x4*)(RG + (r0 + tok) * 1024 + h * 256 + c8 * 8) : z_; }
#pragma unroll
            for (int it = 0; it < 2; ++it) { const int idx = tid + 512 * it, tok = idx >> 4, c8 = idx & 15;
                *(LAS u32x4*)(kd_l + tok * KDST + c8 * 8) = scale8(pk[it], exp2f(lg2 * (float)(L - 1 - tok)));
                if (FULL) { *(LAS u32x4*)(k_l + tok * QST + c8 * 8) = pk[it]; *(LAS u32x4*)(q_l + tok * QST + c8 * 8) = pq[it]; *(LAS u32x4*)(qs_l + tok * QST + c8 * 8) = scale8(pq[it], exp2f(lg2 * (float)(tok + 1))); } }
#pragma unroll
            for (int it = 0; it < 4; ++it) { const int idx = tid + 512 * it, tok = idx >> 5, c8 = idx & 31;
                *(LAS u32x4*)(v_l + tok * VST + c8 * 8) = pv[it]; if (FULL) *(LAS u32x4*)(g_l + tok * VST + c8 * 8) = pgt[it]; } }
        __syncthreads();
        f32x4 o[4][2];
        if (FULL) {
            const int ib = w >> 1, jb0 = 2 * (w & 1);
            f32x4 p0 = {0.f, 0.f, 0.f, 0.f}, p1 = {0.f, 0.f, 0.f, 0.f};
#pragma unroll
            for (int s = 0; s < 4; ++s) { const bf16x8 a = *(const LAS bf16x8*)(q_l + (16 * ib + fr) * QST + 32 * s + 8 * g);
                const bf16x8 b0 = *(const LAS bf16x8*)(k_l + (16 * jb0 + fr) * QST + 32 * s + 8 * g), b1 = *(const LAS bf16x8*)(k_l + (16 * jb0 + 16 + fr) * QST + 32 * s + 8 * g);
                p0 = __builtin_amdgcn_mfma_f32_16x16x32_bf16(a, b0, p0, 0, 0, 0); p1 = __builtin_amdgcn_mfma_f32_16x16x32_bf16(a, b1, p1, 0, 0, 0); }
#pragma unroll
            for (int r = 0; r < 4; ++r) { const int i = 16 * ib + 4 * g + r, j0 = 16 * jb0 + fr, j1 = j0 + 16;
                const float v0 = j0 <= i ? p0[r] * exp2f(lg2 * (float)(i - j0)) : 0.f, v1 = j1 <= i ? p1[r] * exp2f(lg2 * (float)(i - j1)) : 0.f;
                p_l[i * PST + j0] = f2bf(v0); p_l[i * PST + j1] = f2bf(v1); }
            __syncthreads();
#pragma unroll
            for (int i = 0; i < 4; ++i) { o[i][0] = (f32x4){0.f, 0.f, 0.f, 0.f}; o[i][1] = (f32x4){0.f, 0.f, 0.f, 0.f}; }
        }
        bf16x8 vf[2][2];
#pragma unroll
        for (int s = 0; s < 2; ++s)
#pragma unroll
            for (int nb = 0; nb < 2; ++nb) { const LAS bf16_t* pp = v_l + (32 * s + 8 * g + tq) * VST + 32 * w + 16 * nb + 4 * tp; vf[s][nb] = cat8(trrd(pp), trrd(pp + 4 * VST)); }
        if (FULL) {
#pragma unroll
            for (int i = 0; i < 4; ++i)
#pragma unroll
                for (int s = 0; s < 2; ++s) { const bf16x8 a = *(const LAS bf16x8*)(p_l + (16 * i + fr) * PST + 32 * s + 8 * g);
                    o[i][0] = __builtin_amdgcn_mfma_f32_16x16x32_bf16(a, vf[s][0], o[i][0], 0, 0, 0); o[i][1] = __builtin_amdgcn_mfma_f32_16x16x32_bf16(a, vf[s][1], o[i][1], 0, 0, 0); }
#pragma unroll
            for (int s = 0; s < 4; ++s) {
                bf16x8 bS[2];
#pragma unroll
                for (int nb = 0; nb < 2; ++nb) { u32x4 wv; wv.x = cvt_pk_bf16(S[2 * s][nb][0], S[2 * s][nb][1]); wv.y = cvt_pk_bf16(S[2 * s][nb][2], S[2 * s][nb][3]);
                    wv.z = cvt_pk_bf16(S[2 * s + 1][nb][0], S[2 * s + 1][nb][1]); wv.w = cvt_pk_bf16(S[2 * s + 1][nb][2], S[2 * s + 1][nb][3]); bS[nb] = __builtin_bit_cast(bf16x8, wv); }
#pragma unroll
                for (int i = 0; i < 4; ++i) { const LAS bf16_t* qp = qs_l + (16 * i + fr) * QST + 32 * s + 4 * g;
                    const s16x4 lo = *(const LAS s16x4*)qp, hi = *(const LAS s16x4*)(qp + 16); const bf16x8 a = cat8(lo, hi);
                    o[i][0] = __builtin_amdgcn_mfma_f32_16x16x32_bf16(a, bS[0], o[i][0], 0, 0, 0); o[i][1] = __builtin_amdgcn_mfma_f32_16x16x32_bf16(a, bS[1], o[i][1], 0, 0, 0); }
            }
        }
#pragma unroll
        for (int db = 0; db < 8; ++db) { S[db][0] = S[db][0] * gL; S[db][1] = S[db][1] * gL; }
#pragma unroll
        for (int s = 0; s < 2; ++s)
#pragma unroll
            for (int db = 0; db < 8; ++db) { const LAS bf16_t* pp = kd_l + (32 * s + 8 * g + tq) * KDST + 16 * db + 4 * tp; const bf16x8 a = cat8(trrd(pp), trrd(pp + 4 * KDST));
                S[db][0] = __builtin_amdgcn_mfma_f32_16x16x32_bf16(a, vf[s][0], S[db][0], 0, 0, 0); S[db][1] = __builtin_amdgcn_mfma_f32_16x16x32_bf16(a, vf[s][1], S[db][1], 0, 0, 0); }
        if (FULL) {
#pragma unroll
            for (int i = 0; i < 4; ++i)
#pragma unroll
                for (int r = 0; r < 4; ++r) { float sm = o[i][0][r] + o[i][1][r], sq = o[i][0][r] * o[i][0][r] + o[i][1][r] * o[i][1][r];
                    sm = row16_sum(sm); sq = row16_sum(sq);
                    if (fr == 0) { LAS float* d = st_l + ((16 * i + 4 * g + r) * 8 + w) * 2; d[0] = sm; d[1] = sq; } }
            __syncthreads();
#pragma unroll
            for (int i = 0; i < 4; ++i)
#pragma unroll
                for (int r = 0; r < 4; ++r) { const int tok = 16 * i + 4 * g + r;
                    const LAS f32x4* d = (const LAS f32x4*)(st_l + tok * 16); const f32x4 a0 = d[0], a1 = d[1], a2 = d[2], a3 = d[3];
                    const float sm = (a0[0] + a0[2]) + (a1[0] + a1[2]) + (a2[0] + a2[2]) + (a3[0] + a3[2]), sq = (a0[1] + a0[3]) + (a1[1] + a1[3]) + (a2[1] + a2[3]) + (a3[1] + a3[3]);
                    const float mu = sm * (1.f / 256.f), var = fmaxf(sq * (1.f / 256.f) - mu * mu, 0.f), rstd = rsqrtf(var + EPS);
#pragma unroll
                    for (int nb = 0; nb < 2; ++nb) { LAS bf16_t* ge = g_l + tok * VST + 32 * w + 16 * nb + fr; *ge = f2bf((o[i][nb][r] - mu) * rstd * gr[nb] * bf2f(*ge)); } }
            __syncthreads();
#pragma unroll
            for (int it = 0; it < 4; ++it) { const int idx = tid + 512 * it, tok = idx >> 5, c8 = idx & 31;
                if (tok < L) *(u32x4*)(RET + (r0 + tok) * 1024 + h * 256 + c8 * 8) = *(const LAS u32x4*)(g_l + tok * VST + c8 * 8); }
        }
    }
    if (Sout) {
#pragma unroll
        for (int db = 0; db < 8; ++db)
#pragma unroll
            for (int nb = 0; nb < 2; ++nb) { int so = (16 * db + 4 * g) * RET_DV + 32 * w + 16 * nb + fr; asm volatile("" : "+v"(so));
#pragma unroll
                for (int r = 0; r < 4; ++r) Sout[so + r * RET_DV] = S[db][nb][r]; }
    }
}
}
__device__ __forceinline__ void r1_states(Frame& F) {
    const int bh = F.vcu >> 5, sc = F.vcu & 31, b = bh >> 2, h = bh & 3;
    rt::ret_unit<false>(F, h, b * SEQ + sc * rt::SC_TOK, 4, 64, nullptr, F.out + ((size_t)bh * rt::NSC + sc) * 32768, nullptr);
}
__device__ __forceinline__ void r2_scan(Frame& F) {
    float* U = F.out; const int gt = F.vcu * NTHR + F.tid;
    for (int e = gt; e < 8 * 32768; e += F.G * NTHR) { const int bh = e >> 15, idx = e & 32767, h = bh & 3;
        const float g256 = exp2f(log2f(1.f - exp2f(-5.f - (float)h)) * 256.f);
        float u[32];
#pragma unroll
        for (int sc = 0; sc < 32; ++sc) u[sc] = U[((size_t)bh * 32 + sc) * 32768 + idx];
        float carry = 0.f;
#pragma unroll
        for (int sc = 0; sc < 32; ++sc) { U[((size_t)bh * 32 + sc) * 32768 + idx] = carry; carry = g256 * carry + u[sc]; }
        F.out[O_RETP + (size_t)bh * 32768 + idx] = carry; }
}
__device__ __forceinline__ void r3_outputs(Frame& F) {
    const int bh = F.vcu >> 5, sc = F.vcu & 31, b = bh >> 2, h = bh & 3;
    rt::ret_unit<true>(F, h, b * SEQ + sc * rt::SC_TOK, 4, 64, F.out + ((size_t)bh * rt::NSC + sc) * 32768, nullptr, FIN(16));
    if (F.vcu < DEC_BATCH * RET_H) { const int sb = F.vcu >> 2, sh = F.vcu & 3;
        rt::ret_unit<true>(F, sh, MP + sb * DEC_SEQ, 1, DEC_SEQ, FIN(4) + (size_t)F.vcu * 32768, F.out + O_RETS + (size_t)F.vcu * 32768, FIN(16)); }
}

namespace at {
typedef float f32x16 __attribute__((ext_vector_type(16)));
typedef short s16x4 __attribute__((ext_vector_type(4)));
constexpr int KN_ST = 272, KP_ST = 144;
constexpr int KN_B = 64 * KN_ST, KP_B = 64 * KP_ST, V_B = 16384, BUF_B = KN_B + KP_B + V_B;
constexpr int SCR_OFF = 2 * BUF_B;
constexpr float THR = 8.f;
__device__ __forceinline__ int v_st(int k, int c) { const int kk = (k & ~0xC) | ((k & 4) << 1) | ((k & 8) >> 1); return ((kk >> 3) * 4 + (c >> 5)) * 512 + ((kk & 7) * 32 + (c & 31)) * 2; }
__device__ __forceinline__ int v_rd_base(int lane) { return ((lane & 3) << 3) | (((lane >> 2) & 3) << 6) | (((lane >> 4) & 1) << 5) | (((lane >> 5) & 1) << 8); }
constexpr int v_rd_off(int d0, int ks, int half) { return d0 * 512 + ks * 4096 + half * 2048; }
__device__ __forceinline__ int crow(int r, int hi) { return (r & 3) + 8 * (r >> 2) + 4 * hi; }
#define AT_SBAR() __builtin_amdgcn_sched_barrier(0)

__device__ __forceinline__ void qkt(f32x16& p0, f32x16& p1, const LAS unsigned char* kn, const LAS unsigned char* kp, const bf16x8* qr) {
    p0 = f32x16{}; p1 = f32x16{};
#pragma unroll
    for (int d0 = 0; d0 < 8; ++d0) { const bf16x8 a0 = *(const LAS bf16x8*)(kn + d0 * 32), a1 = *(const LAS bf16x8*)(kn + d0 * 32 + 32 * KN_ST);
        p0 = __builtin_amdgcn_mfma_f32_32x32x16_bf16(a0, qr[d0], p0, 0, 0, 0); p1 = __builtin_amdgcn_mfma_f32_32x32x16_bf16(a1, qr[d0], p1, 0, 0, 0); }
#pragma unroll
    for (int d0 = 0; d0 < 4; ++d0) { const bf16x8 a0 = *(const LAS bf16x8*)(kp + d0 * 32), a1 = *(const LAS bf16x8*)(kp + d0 * 32 + 32 * KP_ST);
        p0 = __builtin_amdgcn_mfma_f32_32x32x16_bf16(a0, qr[8 + d0], p0, 0, 0, 0); p1 = __builtin_amdgcn_mfma_f32_32x32x16_bf16(a1, qr[8 + d0], p1, 0, 0, 0); }
}
__device__ __forceinline__ void pv_tile(f32x16* o, int vb0, bf16x8 pa0, bf16x8 pa1, bf16x8 pa2, bf16x8 pa3) {
#define AT_TRRD(dst, off) asm volatile("ds_read_b64_tr_b16 %0, %1 offset:%2" : "=&v"(dst) : "v"(vb0), "i"(off) : "memory")
#define AT_PV_D0(d0) do { s16x4 l0, l1, l2, l3, h0, h1, h2, h3; constexpr int b_ = v_rd_off(d0, 0, 0);   \
        AT_TRRD(l0, b_); AT_TRRD(h0, b_ + 2048); AT_TRRD(l1, b_ + 4096); AT_TRRD(h1, b_ + 6144); AT_TRRD(l2, b_ + 8192); AT_TRRD(h2, b_ + 10240); AT_TRRD(l3, b_ + 12288); AT_TRRD(h3, b_ + 14336); \
        asm volatile("s_waitcnt lgkmcnt(0)" ::: "memory"); AT_SBAR();   \
        o[d0] = __builtin_amdgcn_mfma_f32_32x32x16_bf16(pa0, (bf16x8){l0[0], l0[1], l0[2], l0[3], h0[0], h0[1], h0[2], h0[3]}, o[d0], 0, 0, 0);   \
        o[d0] = __builtin_amdgcn_mfma_f32_32x32x16_bf16(pa1, (bf16x8){l1[0], l1[1], l1[2], l1[3], h1[0], h1[1], h1[2], h1[3]}, o[d0], 0, 0, 0);   \
        o[d0] = __builtin_amdgcn_mfma_f32_32x32x16_bf16(pa2, (bf16x8){l2[0], l2[1], l2[2], l2[3], h2[0], h2[1], h2[2], h2[3]}, o[d0], 0, 0, 0);   \
        o[d0] = __builtin_amdgcn_mfma_f32_32x32x16_bf16(pa3, (bf16x8){l3[0], l3[1], l3[2], l3[3], h3[0], h3[1], h3[2], h3[3]}, o[d0], 0, 0, 0); } while (0)
    AT_PV_D0(0); AT_PV_D0(1); AT_PV_D0(2); AT_PV_D0(3);
#undef AT_PV_D0
#undef AT_TRRD
}
template <bool PARTIAL>
__device__ __forceinline__ void attn_unit(LAS unsigned char* lds, const bf16_t* Qw, const bf16_t* KN, const bf16_t* KPE, const bf16_t* V, bf16_t* Ow, float* Pw, int NT, int tmax_w, int nkeys, int orows, int t0, int tstride) {
    const int tid = threadIdx.x, wid = __builtin_amdgcn_readfirstlane(tid >> 6), lane = tid & 63, r32 = lane & 31, hi = lane >> 5;
    bf16x8 qr[12];
#pragma unroll
    for (int d0 = 0; d0 < 12; ++d0) qr[d0] = *(const bf16x8*)(Qw + (size_t)r32 * 1536 + d0 * 16 + hi * 8);
    const int sr = tid >> 4, sc = (tid & 15) * 8, pr = tid >> 3, pc = (tid & 7) * 8;
    const int kn_w0 = sr * KN_ST + sc * 2, kn_w1 = (32 + sr) * KN_ST + sc * 2, kp_w = KN_B + pr * KP_ST + pc * 2, v_w0 = KN_B + KP_B + v_st(sr, sc), v_w1 = KN_B + KP_B + v_st(32 + sr, sc);
    const int kn_r = r32 * KN_ST + hi * 16, kp_r = KN_B + r32 * KP_ST + hi * 16;
    const int vb_base = (int)(unsigned)(uintptr_t)(lds + KN_B + KP_B) + v_rd_base(lane);
    LAS float* scr = (LAS float*)(lds + SCR_OFF) + wid * 64;
    float m_reg = -1e30f, l_reg = 0.f; f32x16 o[4] = {};
    u32x4 st_kn0, st_kn1, st_kp, st_v0, st_v1;
#define AT_LOAD(t) do { const size_t k0_ = (size_t)(t0 + (t) * tstride) * 64; const bool v0_ = (int)k0_ + sr < nkeys, v1_ = (int)k0_ + 32 + sr < nkeys, vp_ = (int)k0_ + pr < nkeys; const u32x4 z_ = {0u, 0u, 0u, 0u}; \
        st_kn0 = v0_ ? *(const u32x4*)(KN + (k0_ + sr) * 1024 + sc) : z_; st_kn1 = v1_ ? *(const u32x4*)(KN + (k0_ + 32 + sr) * 1024 + sc) : z_; \
        st_v0 = v0_ ? *(const u32x4*)(V + (k0_ + sr) * 1024 + sc) : z_; st_v1 = v1_ ? *(const u32x4*)(V + (k0_ + 32 + sr) * 1024 + sc) : z_; \
        st_kp = vp_ ? *(const u32x4*)(KPE + (k0_ + pr) * 64 + pc) : z_; } while (0)
#define AT_WRITE(bf) do { LAS unsigned char* b_ = lds + (bf) * BUF_B; *(LAS u32x4*)(b_ + kn_w0) = st_kn0; *(LAS u32x4*)(b_ + kn_w1) = st_kn1; *(LAS u32x4*)(b_ + kp_w) = st_kp; \
        *(LAS u32x4*)(b_ + v_w0) = st_v0; *(LAS u32x4*)(b_ + v_w1) = st_v1; } while (0)
    AT_LOAD(0); AT_WRITE(0);
    __syncthreads();
    for (int t = 0; t < NT; ++t) {
        const int bf = t & 1;
        if (t + 1 < NT) AT_LOAD(t + 1);
        if (t <= tmax_w) {
            f32x16 p0, p1;
            const LAS unsigned char* bb = lds + bf * BUF_B;
            qkt(p0, p1, bb + kn_r, bb + kp_r, qr);
            if ((t0 + t * tstride + 1) * 64 > nkeys) {
                const int kb = (t0 + t * tstride) * 64 + 4 * hi;
#pragma unroll
                for (int r = 0; r < 16; ++r) { const int kv = kb + (r & 3) + 8 * (r >> 2); if (kv >= nkeys) p0[r] = -INFINITY; if (kv + 32 >= nkeys) p1[r] = -INFINITY; } }
            float pmax = p0[0];
#pragma unroll
            for (int r = 1; r < 16; ++r) pmax = fmaxf(pmax, p0[r]);
#pragma unroll
            for (int r = 0; r < 16; ++r) pmax = fmaxf(pmax, p1[r]);
            { auto rr = __builtin_amdgcn_permlane32_swap(__float_as_uint(pmax), __float_as_uint(pmax), false, false); pmax = fmaxf(__uint_as_float(rr[0]), __uint_as_float(rr[1])); }
            float alpha = 1.f; bool resc = false;
            if (!__all(pmax - m_reg <= THR)) { const float mn = fmaxf(m_reg, pmax); alpha = __builtin_amdgcn_exp2f(m_reg - mn); m_reg = mn; resc = true; }
#pragma unroll
            for (int r = 0; r < 16; ++r) { p0[r] = __builtin_amdgcn_exp2f(p0[r] - m_reg); p1[r] = __builtin_amdgcn_exp2f(p1[r] - m_reg); }
            float ps = 0.f;
#pragma unroll
            for (int r = 0; r < 16; ++r) ps += p0[r] + p1[r];
            { auto rr = __builtin_amdgcn_permlane32_swap(__float_as_uint(ps), __float_as_uint(ps), false, false); ps = __uint_as_float(rr[0]) + __uint_as_float(rr[1]); }
            l_reg = l_reg * alpha + ps;
            bf16x8 pa0, pa1, pa2, pa3;
#define AT_PK4(P, B_, OUT) do { unsigned a0 = cvt_pk_bf16(P[B_ + 0], P[B_ + 1]), a1 = cvt_pk_bf16(P[B_ + 2], P[B_ + 3]); unsigned b0 = cvt_pk_bf16(P[B_ + 4], P[B_ + 5]), b1 = cvt_pk_bf16(P[B_ + 6], P[B_ + 7]); \
        auto r0 = __builtin_amdgcn_permlane32_swap(a0, b0, false, false); auto r1 = __builtin_amdgcn_permlane32_swap(a1, b1, false, false); \
        u32x4 w_ = {r0[0], r1[0], r0[1], r1[1]}; OUT = __builtin_bit_cast(bf16x8, w_); } while (0)
            AT_PK4(p0, 0, pa0); AT_PK4(p0, 8, pa1); AT_PK4(p1, 0, pa2); AT_PK4(p1, 8, pa3);
#undef AT_PK4
            if (resc) { if (hi == 0) scr[r32] = alpha; asm volatile("s_waitcnt lgkmcnt(0)" ::: "memory");
#pragma unroll
                for (int d_ = 0; d_ < 4; ++d_)
#pragma unroll
                    for (int r = 0; r < 16; ++r) o[d_][r] *= scr[crow(r, hi)]; }
            AT_SBAR();
            pv_tile(o, vb_base + bf * BUF_B, pa0, pa1, pa2, pa3);
        }
        if (t + 1 < NT) AT_WRITE(bf ^ 1);
        __syncthreads();
    }
    if (PARTIAL) {
        if (wid == 0) {
#pragma unroll
            for (int r = 0; r < 16; ++r) { const int orow = crow(r, hi); if (orow < orows) {
#pragma unroll
                for (int d0 = 0; d0 < 4; ++d0) Pw[orow * 132 + d0 * 32 + r32] = o[d0][r]; } }
            if (hi == 0 && r32 < orows) { Pw[r32 * 132 + 128] = m_reg; Pw[r32 * 132 + 129] = l_reg; } }
        __syncthreads();
        return;
    }
    if (hi == 0) scr[32 + r32] = l_reg; asm volatile("s_waitcnt lgkmcnt(0)" ::: "memory");
#pragma unroll
    for (int r = 0; r < 16; ++r) { const int orow = crow(r, hi); const float rl = __builtin_amdgcn_rcpf(scr[32 + orow]);
#pragma unroll
        for (int d0 = 0; d0 < 4; ++d0) { const float v = o[d0][r] * rl; const float vn = __shfl_xor(v, 1);
            if ((r32 & 1) == 0 && orow < orows) *(unsigned*)(Ow + (size_t)orow * 1024 + d0 * 32 + r32) = cvt_pk_bf16(v, vn); } }
    __syncthreads();
#undef AT_LOAD
#undef AT_WRITE
}
#undef AT_SBAR
}
__device__ __forceinline__ void p3_attn_prompt(Frame& F) {
    const int bh = F.vcu >> 4, s = F.vcu & 15, b = bh >> 3, h = bh & 7;
    const bf16_t* Q = (const bf16_t*)F.out; const bf16_t* KN = (const bf16_t*)(F.ws + WS_KN); const bf16_t* KPE = (const bf16_t*)(F.ws + WS_KPE); const bf16_t* V = (const bf16_t*)(F.ws + WS_V); bf16_t* ATT = (bf16_t*)(F.ws + WS_ATT);
#pragma unroll 1
    for (int it = 0; it < 2; ++it) { const int qb = it == 0 ? s : 31 - s; const size_t row0 = (size_t)b * SEQ + (size_t)qb * 256 + F.wave * 32;
        at::attn_unit<false>(F.lds, Q + row0 * 1536 + h * 192, KN + (size_t)b * SEQ * 1024 + h * 128, KPE + (size_t)b * SEQ * 64, V + (size_t)b * SEQ * 1024 + h * 128,
                      ATT + row0 * 1024 + h * 128, nullptr, 4 * qb + 4, 4 * qb + (F.wave >> 1), 1 << 30, 32, 0, 1); }
}
__device__ __forceinline__ void xn_rows(Frame& F, bf16_t* XN) {
    const int gw = F.vcu * 8 + F.wave, NGW = F.G * 8;
    for (int r = gw; r < MPAD; r += NGW) {
        u32x2* o8 = (u32x2*)(XN + (size_t)r * D_MODEL) + F.lane;
        if (r >= MT) { for (int jj = 0; jj < 4; ++jj) o8[64 * jj] = (u32x2){0u, 0u}; continue; }
        const float* x = r < MP ? FIN(0) + (size_t)r * D_MODEL : FIN(1) + (size_t)(r - MP) * D_MODEL;
        const f32x4* xr = (const f32x4*)x + F.lane; f32x4 v[4]; float s = 0.f;
#pragma unroll
        for (int jj = 0; jj < 4; ++jj) { v[jj] = xr[64 * jj]; s += (v[jj][0] * v[jj][0] + v[jj][1] * v[jj][1]) + (v[jj][2] * v[jj][2] + v[jj][3] * v[jj][3]); }
        const float inv = rsqrtf(fwave_sum(s) * (1.f / D_MODEL) + EPS);
#pragma unroll
        for (int jj = 0; jj < 4; ++jj) { u32x2 w; w.x = cvt_pk_bf16(v[jj][0] * inv, v[jj][1] * inv); w.y = cvt_pk_bf16(v[jj][2] * inv, v[jj][3] * inv); o8[64 * jj] = w; }
    }
}
constexpr size_t WS_PART = WS_ATTS + 512 * KiB;
__device__ __forceinline__ void p3_attn_sample(Frame& F) {
    {   const int bh = F.vcu >> 2, part = F.vcu & 3, b = bh >> 3, h = bh & 7;
        const bf16_t* Q = (const bf16_t*)F.out; const bf16_t* KN = (const bf16_t*)(F.ws + WS_KN); const bf16_t* PES = (const bf16_t*)(F.ws + WS_PES); const bf16_t* V = (const bf16_t*)(F.ws + WS_V);
        const size_t row0 = (size_t)MP + (size_t)b * DEC_SEQ;
        at::attn_unit<true>(F.lds, Q + row0 * 1536 + h * 192, KN + (size_t)b * SKEYS * 1024 + h * 128, PES + (size_t)b * SKEYS * 64, V + (size_t)b * SKEYS * 1024 + h * 128,
                            nullptr, (float*)(F.ws + WS_PART) + (size_t)F.vcu * 16 * 132, part == 0 ? 9 : 8, F.wave == 0 ? 1000 : -1, SKEYS, DEC_SEQ, part, 4); }
    xn_rows(F, (bf16_t*)(F.ws + WS_XN2));
    {   const int gw = F.vcu * 8 + F.wave, NGW = F.G * 8; const bf16_t* KVL = (const bf16_t*)(F.ws + WS_KVL); const float* slotkv = (const float*)(F.ws + WS_SLOTKV);
        for (int r = gw; r < MT; r += NGW) { const float s = slot_rs(slotkv + (size_t)r * 8, 8, 1.f / KV_LORA);
            float* o = r < MP ? F.out + O_LATP + (size_t)r * KV_LORA : F.out + O_LATS + (size_t)(r - MP) * KV_LORA;
            const u32x4 w = *((const u32x4*)(KVL + (size_t)r * KV_LORA) + F.lane);
            f32x4 a = {__uint_as_float(w.x << 16), __uint_as_float(w.x & 0xffff0000u), __uint_as_float(w.y << 16), __uint_as_float(w.y & 0xffff0000u)};
            f32x4 c = {__uint_as_float(w.z << 16), __uint_as_float(w.z & 0xffff0000u), __uint_as_float(w.w << 16), __uint_as_float(w.w & 0xffff0000u)};
            *((f32x4*)o + 2 * F.lane) = a * s; *((f32x4*)o + 2 * F.lane + 1) = c * s; } }
}
__device__ __forceinline__ void attn_sample_combine(Frame& F) {
    if (F.vcu >= DEC_BATCH * HEADS) return;
    const int b = F.vcu >> 3, h = F.vcu & 7; const float* P = (const float*)(F.ws + WS_PART) + (size_t)F.vcu * 4 * 16 * 132; bf16_t* ATTS = (bf16_t*)(F.ws + WS_ATTS);
    for (int e = F.tid; e < 16 * 128; e += NTHR) { const int q = e >> 7, d = e & 127;
        float m[4], M = -1e30f;
#pragma unroll
        for (int p = 0; p < 4; ++p) { m[p] = P[(p * 16 + q) * 132 + 128]; M = fmaxf(M, m[p]); }
        float num = 0.f, den = 0.f;
#pragma unroll
        for (int p = 0; p < 4; ++p) { const float w = exp2f(m[p] - M); num += w * P[(p * 16 + q) * 132 + d]; den += w * P[(p * 16 + q) * 132 + 129]; }
        ATTS[(size_t)(b * DEC_SEQ + q) * 1024 + h * 128 + d] = f2bf(num / den); }
}
__device__ __forceinline__ void unpack8(const u32x4 w, float* f) {
    f[0] = __uint_as_float(w.x << 16); f[1] = __uint_as_float(w.x & 0xffff0000u); f[2] = __uint_as_float(w.y << 16); f[3] = __uint_as_float(w.y & 0xffff0000u);
    f[4] = __uint_as_float(w.z << 16); f[5] = __uint_as_float(w.z & 0xffff0000u); f[6] = __uint_as_float(w.w << 16); f[7] = __uint_as_float(w.w & 0xffff0000u);
}
__device__ __forceinline__ void p8_conv(Frame& F) {
    bf16_t* U = (bf16_t*)(F.ws + WS_U); const bf16_t* HALO = (const bf16_t*)(F.ws + WS_HALO); const float* cw = FIN(21); const float* cb = FIN(22); const float* prev = FIN(5);
    const int seg = F.wave, cgi = F.lane;
    for (int unit = F.vcu; unit < 72 * 6; unit += F.G) { const int ch = unit / 6, strip = unit % 6; const int n = strip * 512 + cgi * 8, nv = n + D_FF; const bool cok = n < D_FF;
        int r0, nr; if (ch < 64) { r0 = ch * 256 + seg * 32; nr = 32; } else { r0 = MP + (ch - 64) * DEC_SEQ; nr = seg == 0 ? DEC_SEQ : 0; }
        if (!cok) nr = 0;
        float wg[3][8], wv[3][8], bg[8], bv[8], g2[8], g1[8], v2[8], v1[8];
#pragma unroll
        for (int e = 0; e < 8; ++e) { g2[e] = 0.f; g1[e] = 0.f; v2[e] = 0.f; v1[e] = 0.f; }
        if (cok) {
#pragma unroll
            for (int k = 0; k < 3; ++k) { const f32x4 a0 = *(const f32x4*)(cw + k * FF2 + n), a1 = *(const f32x4*)(cw + k * FF2 + n + 4), c0 = *(const f32x4*)(cw + k * FF2 + nv), c1 = *(const f32x4*)(cw + k * FF2 + nv + 4);
#pragma unroll
                for (int e = 0; e < 4; ++e) { wg[k][e] = a0[e]; wg[k][4 + e] = a1[e]; wv[k][e] = c0[e]; wv[k][4 + e] = c1[e]; } }
            { const f32x4 a0 = *(const f32x4*)(cb + n), a1 = *(const f32x4*)(cb + n + 4), c0 = *(const f32x4*)(cb + nv), c1 = *(const f32x4*)(cb + nv + 4);
#pragma unroll
              for (int e = 0; e < 4; ++e) { bg[e] = a0[e]; bg[4 + e] = a1[e]; bv[e] = c0[e]; bv[4 + e] = c1[e]; } }
            if (ch < 64) {
                if (seg > 0) { unpack8(*(const u32x4*)(U + (size_t)(r0 - 2) * FF2 + n), g2); unpack8(*(const u32x4*)(U + (size_t)(r0 - 1) * FF2 + n), g1); unpack8(*(const u32x4*)(U + (size_t)(r0 - 2) * FF2 + nv), v2); unpack8(*(const u32x4*)(U + (size_t)(r0 - 1) * FF2 + nv), v1); }
                else if ((ch & 31) != 0) { const bf16_t* hp = HALO + (size_t)ch * 2 * FF2; unpack8(*(const u32x4*)(hp + n), g2); unpack8(*(const u32x4*)(hp + FF2 + n), g1); unpack8(*(const u32x4*)(hp + nv), v2); unpack8(*(const u32x4*)(hp + FF2 + nv), v1); }
            } else if (seg == 0) { const float* pp = prev + (size_t)(ch - 64) * 2 * FF2;
#pragma unroll
                for (int e = 0; e < 8; ++e) { g2[e] = pp[n + e]; g1[e] = pp[FF2 + n + e]; v2[e] = pp[nv + e]; v1[e] = pp[FF2 + nv + e]; } }
        }
        __syncthreads();
#pragma unroll 2
        for (int i = 0; i < nr; ++i) { bf16_t* row = U + (size_t)(r0 + i) * FF2; float g0[8], v0[8], h[8];
            unpack8(*(const u32x4*)(row + n), g0); unpack8(*(const u32x4*)(row + nv), v0);
#pragma unroll
            for (int e = 0; e < 8; ++e) { const float cg = g2[e] * wg[0][e] + g1[e] * wg[1][e] + g0[e] * wg[2][e] + bg[e], cv = v2[e] * wv[0][e] + v1[e] * wv[1][e] + v0[e] * wv[2][e] + bv[e];
                h[e] = cg * __builtin_amdgcn_rcpf(1.f + __expf(-cg)) * cv; g2[e] = g1[e]; g1[e] = g0[e]; v2[e] = v1[e]; v1[e] = v0[e]; }
            u32x4 w; w.x = cvt_pk_bf16(h[0], h[1]); w.y = cvt_pk_bf16(h[2], h[3]); w.z = cvt_pk_bf16(h[4], h[5]); w.w = cvt_pk_bf16(h[6], h[7]);
            *(u32x4*)(row + n) = w; }
        __syncthreads();
    }
}
__global__ void __launch_bounds__(NTHR, 2) mk(const MArgs a) {
    extern __shared__ __attribute__((aligned(16))) unsigned char lds_raw[];
    Frame F;
    F.lds = (LAS unsigned char*)lds_raw;
    F.tid = threadIdx.x; F.lane = F.tid & 63; F.wave = __builtin_amdgcn_readfirstlane(F.tid >> 6);
    F.G = gridDim.x; F.x = blockIdx.x % 8; F.j = blockIdx.x / 8; F.vcu = F.x * (F.G / 8) + F.j;
    F.a = &a; F.out = a.out; F.ws = a.ws;
    volatile LAS unsigned* MISC = (volatile LAS unsigned*)(F.lds + MISC_OFF);
    if (F.tid < 32) MISC[F.tid] = 0u;
    __syncthreads();
    XcdBarrier bar = xcd_barrier_post((unsigned*)(a.ws + WS_CTL) + CW_BAR + a.li * XCD_BAR_WORDS, MISC + 8);
    const int lo = a.ph_lo, hi = a.ph_hi;
#define IN_(k) (lo <= (k) && (k) < hi)
#define SEAM_(k) do { if (IN_(k) && IN_((k) + 1)) xcd_barrier(bar); } while (0)
#define STAMP_(k) probe_stamp(F, (k))
    STAMP_(0); if (IN_(0)) { p0_prologue(F); } SEAM_(0);
    STAMP_(1); if (IN_(1)) { p1_inproj(F); } SEAM_(1);
    STAMP_(2); if (IN_(2)) { r1_states(F); } SEAM_(2);
    STAMP_(3); if (IN_(3)) { r2_scan(F); } SEAM_(3);
    STAMP_(4); if (IN_(4)) { r3_outputs(F); } SEAM_(4);
    STAMP_(5); if (IN_(5)) { p2_qkv(F, 1); } SEAM_(5);
    STAMP_(6); if (IN_(6)) { p3_attn_sample(F); } SEAM_(6);
    STAMP_(7); if (IN_(7)) { attn_sample_combine(F); p2_qkv(F, 0); } SEAM_(7);
    STAMP_(8); if (IN_(8)) { p3_attn_prompt(F); } SEAM_(8);
    STAMP_(9); if (IN_(9)) { p5_gemm(F, 5); } SEAM_(9);
    STAMP_(10); if (IN_(10)) { p5_gemm(F, 6); } SEAM_(10);
    STAMP_(11); if (IN_(11)) { p5_gemm(F, 7); } SEAM_(11);
    STAMP_(12); if (IN_(12)) { p8_conv(F); } SEAM_(12);
    STAMP_(13); if (IN_(13)) { p5_gemm(F, 9); }
    if (PROBE_LO >= 0) { __syncthreads(); STAMP_(14);
        if (blockIdx.x == 0 && F.tid == 0) { const unsigned long long t_end = __builtin_amdgcn_s_memrealtime() + (unsigned long long)PROBE_MULT * ((((unsigned long long)MISC[19] << 32) | MISC[18]) - (((unsigned long long)MISC[17] << 32) | MISC[16]));
            while (__builtin_amdgcn_s_memrealtime() < t_end) __builtin_amdgcn_s_sleep(8); } }
}

extern "C" void kernel_launch(void* const* d_in, const int* in_sizes, int n_in, void* d_out, int out_size, void* d_ws, size_t ws_size, hipStream_t stream) {
    static int ok = 0;
    if (ok == 0) {
        ok = 1;
        if (ws_size < 256 * MiB || n_in != 24) { fprintf(stderr, "kernel_launch: bad ws/n_in: %zu %d\n", ws_size, n_in); ok = -1; }
        int dev = 0, cus = 0; (void)hipGetDevice(&dev); (void)hipDeviceGetAttribute(&cus, hipDeviceAttributeMultiprocessorCount, dev);
        if (cus != 256) { fprintf(stderr, "kernel_launch: built for 256 CUs, got %d\n", cus); ok = -1; }
        if (hipFuncSetAttribute((const void*)mk, hipFuncAttributeMaxDynamicSharedMemorySize, LDS_BYTES) != hipSuccess) { fprintf(stderr, "kernel_launch: hipFuncSetAttribute(mk) failed\n"); ok = -1; }
        (void)hipGetLastError();
    }
    if (ok < 0) return;
    (void)hipMemsetAsync((char*)d_ws + WS_CTL, 0, CTL_BYTES, stream);
    MArgs a{}; for (int i = 0; i < 24; ++i) a.in[i] = (const float*)d_in[i]; a.out = (float*)d_out; a.ws = (unsigned char*)d_ws; a.ph_lo = 0; a.ph_hi = 14; a.li = 0;
    hipLaunchKernelGGL(mk, dim3(256), dim3(NTHR), LDS_BYTES, stream, a);
}
```

```cpp
#include <hip/hip_runtime.h>
#include <stdint.h>
#include <cstdio>

typedef unsigned short bf16_t;
typedef short bf16x8 __attribute__((ext_vector_type(8)));
typedef float f32x4 __attribute__((ext_vector_type(4)));
typedef float f32x2 __attribute__((ext_vector_type(2)));
typedef unsigned u32x4 __attribute__((ext_vector_type(4)));
typedef unsigned u32x2 __attribute__((ext_vector_type(2)));

constexpr int D_MODEL = 1024, BATCH = 2, SEQ = 8192, DEC_BATCH = 8, DEC_SEQ = 16, PAST = 2048;
constexpr int MP = BATCH * SEQ, MS = DEC_BATCH * DEC_SEQ, MT = MP + MS;
constexpr int MPAD = 16640;
constexpr int Q_LORA = 768, KV_LORA = 512, QK_NOPE = 128, QK_ROPE = 64, V_HEAD = 128, HEADS = 8;
constexpr int RET_H = 4, RET_DK = 128, RET_DV = 256;
constexpr int D_FF = 2816, FF2 = 2 * D_FF;
constexpr int IN_W = 6464;
constexpr int SKEYS = PAST + DEC_SEQ;
constexpr int LROWS = DEC_BATCH * SKEYS;
constexpr float EPS = 1e-6f;
constexpr int C_QLAT = 0, C_KVLAT = 768, C_KPE = 1280, C_RQ = 1344, C_RK = 1856, C_RV = 2368, C_RG = 3392, C_GA = 4416, C_GB = 5440;

constexpr size_t O_YP = 0, O_YS = 16777216, O_LATP = 16908288, O_RKP = 25296896, O_RETP = 26345472, O_CONVP = 26607616,
                 O_LATS = 26630144, O_RKS = 26695680, O_RETS = 26703872, O_CONVS = 27752448;

constexpr size_t MiB = 1u << 20, KiB = 1024;
constexpr size_t WS_CTL = 0, CTL_BYTES = 64 * KiB, WS_SSQS = 64 * KiB;
constexpr size_t WS_SLOTQ = 1 * MiB, WS_SLOTKV = 2 * MiB, WS_SLOTX1 = 3 * MiB;
constexpr size_t WS_TAB32 = 4 * MiB + 256 * KiB, WS_TAB64 = 6 * MiB + 256 * KiB;
constexpr size_t WS_FWUP = 10 * MiB + 512 * KiB, WS_FWDOWN = 21 * MiB + 512 * KiB, WS_FWIN = 27 * MiB, WS_FWQUP = 40 * MiB, WS_FWKVUP = 43 * MiB,
                 WS_FWOBA = 45 * MiB, WS_FWOBB = 47 * MiB, WS_FWOUT = 49 * MiB;
constexpr size_t WS_XN = 51 * MiB, WS_RET = 51 * MiB;
constexpr size_t WS_LATS = 83 * MiB + 512 * KiB, WS_PES = 99 * MiB + 768 * KiB, WS_ZQ = 102 * MiB, WS_KVL = 126 * MiB + 512 * KiB, WS_KPE = 142 * MiB + 768 * KiB;
constexpr size_t WS_RQ = 145 * MiB, WS_RK = 161 * MiB + 256 * KiB, WS_RV = 177 * MiB + 512 * KiB, WS_RG = 210 * MiB;
constexpr size_t WS_KN = 145 * MiB, WS_V = 177 * MiB + 512 * KiB, WS_ATTS = 242 * MiB + 512 * KiB, WS_XN2 = 210 * MiB, WS_ATT = 102 * MiB;
constexpr size_t WS_T1 = 166 * MiB + 512 * KiB, WS_MERGED = 134 * MiB;
constexpr size_t WS_GAS = 246 * MiB, WS_GBS = 247 * MiB;
constexpr size_t WS_X1B = 223 * MiB + 512 * KiB, WS_U = 27 * MiB, WS_HALO = 206 * MiB;

__device__ __forceinline__ bf16_t f2bf(float f) { unsigned u = __float_as_uint(f); u = (u + 0x7fffu + ((u >> 16) & 1u)) >> 16; return (bf16_t)u; }
__device__ __forceinline__ float bf2f(bf16_t b) { return __uint_as_float(((unsigned)b) << 16); }

#define LAS __attribute__((address_space(3)))
#define GAS __attribute__((address_space(1)))
constexpr int NTHR = 512;
constexpr int RING_BYTES = 131072, EPI_OFF = RING_BYTES, EPI_BYTES = 8192, LDS_BYTES = 163840, MISC_OFF = LDS_BYTES - 256;
constexpr int CW_BAR = 1024;

__device__ __forceinline__ unsigned cvt_pk_bf16(float lo, float hi) { unsigned r; asm volatile("v_cvt_pk_bf16_f32 %0, %1, %2" : "=v"(r) : "v"(lo), "v"(hi)); return r; }
__device__ __forceinline__ u32x4 pack8f(const f32x4& a, const f32x4& b) { u32x4 w; w.x = cvt_pk_bf16(a[0], a[1]); w.y = cvt_pk_bf16(a[2], a[3]); w.z = cvt_pk_bf16(b[0], b[1]); w.w = cvt_pk_bf16(b[2], b[3]); return w; }
__device__ __forceinline__ int row_pos(int row) { return row < MP ? (row & (SEQ - 1)) : PAST + ((row - MP) & (DEC_SEQ - 1)); }

#define XB_TMO      128
#define XB_XCNT(j)  (256  + 64 * (j))
#define XB_XSUB(j)  (1280 + 64 * (j))
#define XB_XGEN(j)  (2304 + 64 * (j))
#define XB_TOP      3328
#define XB_TOPGEN   3392
#define XCD_BAR_WORDS 3456
#define XB_SPIN_CAP (1u << 18)
__device__ __forceinline__ unsigned xb_ld(unsigned* p)              { return __hip_atomic_load(p, __ATOMIC_RELAXED, __HIP_MEMORY_SCOPE_AGENT); }
__device__ __forceinline__ unsigned xb_add(unsigned* p, unsigned v) { return __hip_atomic_fetch_add(p, v, __ATOMIC_RELAXED, __HIP_MEMORY_SCOPE_AGENT); }
__device__ __forceinline__ unsigned xb_xcc_id() { return (unsigned)__builtin_amdgcn_s_getreg((3 << 11) | 20) & 0xFu; }
#define XB_SPIN(cond, bar) do { unsigned _sp = 0; while (cond) { __builtin_amdgcn_s_sleep(1); \
    if ((++_sp & 255u) == 0u) { if (xb_ld(&(bar)[XB_TMO])) break; if (_sp > XB_SPIN_CAP) { atomicAdd(&(bar)[XB_TMO], 1u); break; } } } } while (0)
struct XcdBarrier { unsigned* bar; unsigned x; volatile LAS unsigned* st; };
__device__ __forceinline__ XcdBarrier xcd_barrier_post(unsigned* bar, volatile LAS unsigned* st) {
    XcdBarrier b; b.bar = bar; b.x = xb_xcc_id(); b.st = st;
    if (threadIdx.x == 0) (void)xb_add(&bar[XB_XCNT(b.x)], 1u);
    return b;
}
__device__ __forceinline__ void xcd_barrier_complete(unsigned* bar, unsigned x, unsigned& nloc, unsigned& nx) {
    const unsigned G = gridDim.x * gridDim.y * gridDim.z;
    unsigned sum, cnt, mine, sp = 0u;
    for (;;) {
        sum = 0u; cnt = 0u; mine = 0u;
#pragma unroll
        for (unsigned j = 0; j < 16; ++j) { const unsigned c = xb_ld(&bar[XB_XCNT(j)]); sum += c; cnt += (c > 0u) ? 1u : 0u; mine = (j == x) ? c : mine; }
        if (sum == G) break;
        __builtin_amdgcn_s_sleep(1);
        if ((++sp & 255u) == 0u) { if (xb_ld(&bar[XB_TMO])) break; if (sp > XB_SPIN_CAP) { atomicAdd(&bar[XB_TMO], 1u); break; } }
    }
    nloc = mine > 0u ? mine : 1u; nx = cnt > 0u ? cnt : 1u;
}
__device__ __forceinline__ void xcd_barrier(const XcdBarrier& b) {
    asm volatile("s_waitcnt vmcnt(0)" ::: "memory");
    __syncthreads();
    if (threadIdx.x == 0) {
        unsigned* bar = b.bar;
        __builtin_amdgcn_s_waitcnt(0);
        unsigned nloc = b.st[0], nx = b.st[1];
        if (nloc == 0u) { xcd_barrier_complete(bar, b.x, nloc, nx); b.st[0] = nloc; b.st[1] = nx; }
        const unsigned old = xb_add(&bar[XB_XSUB(b.x)], 1u);
        const unsigned gen = old / nloc;
        if (old + 1u == (gen + 1u) * nloc) {
            __builtin_amdgcn_fence(__ATOMIC_RELEASE, "agent");
            asm volatile("s_waitcnt vmcnt(0)" ::: "memory");
            const unsigned og = xb_add(&bar[XB_TOP], 1u);
            const unsigned tg = og / nx;
            if (og + 1u == (tg + 1u) * nx) xb_add(&bar[XB_TOPGEN], 1u);
            else XB_SPIN(xb_ld(&bar[XB_TOPGEN]) == tg, bar);
            __builtin_amdgcn_fence(__ATOMIC_ACQUIRE, "agent");
            xb_add(&bar[XB_XGEN(b.x)], 1u);
            asm volatile("s_waitcnt vmcnt(0)" ::: "memory");
        } else {
            XB_SPIN(xb_ld(&bar[XB_XGEN(b.x)]) == gen, bar);
            __builtin_amdgcn_fence(__ATOMIC_ACQUIRE, "agent");
            asm volatile("s_waitcnt vmcnt(0)" ::: "memory");
        }
    }
    __syncthreads();
}

namespace pg {
constexpr int BK = 64, HALF = 128, HTB = HALF * BK * 2;
__host__ __device__ __forceinline__ int lds_byte(int r, int c) { const int st = (r >> 4) * 2 + (c >> 5), rr = r & 15, cc = c & 31, ob = rr * 64 + cc * 2; return st * 1024 + (ob ^ (((ob >> 9) & 1) << 5)); }
__host__ __device__ __forceinline__ void stage_rc(int b, int& R, int& C) { const int st = b / 1024, sb = b % 1024, swz = sb ^ (((sb >> 9) & 1) << 5); R = (st >> 1) * 16 + swz / 64; C = (st & 1) * 32 + (swz % 64) / 2; }
__host__ __device__ __forceinline__ int perm32(int rho) { const int n = rho >> 4, i = rho & 15; return 8 * (i >> 2) + 4 * n + (i & 3); }
struct UnitG { const char* A; const char* B; unsigned lda, ldb; int nt; int pm, pn, kind; int half; };
typedef f32x4 Acc[2][2][4][2];

template <class Sched, class Epi>
__device__ __forceinline__ void gemm_stream(LAS unsigned char* lds, const Sched& S, const Epi& E) {
    const int tid = threadIdx.x, wid = __builtin_amdgcn_readfirstlane(tid >> 6), lane = tid & 63, wr = wid >> 2, wc = wid & 3, fr = lane & 15, fq = lane >> 4;
    unsigned Rr[2], Cc[2];
#pragma unroll
    for (int i = 0; i < 2; ++i) { int R, C; stage_rc(tid * 16 + i * 8192, R, C); Rr[i] = (unsigned)R; Cc[i] = (unsigned)C * 2u; }
    const unsigned ldsw = (unsigned)wid * 1024u;
    const int aoff = lds_byte(wr * 64 + fr, fq * 8), boff = lds_byte(wc * 32 + fr, fq * 8);
#define PG_SA(b, h) (((b) * 2 + (h)) * HTB)
#define PG_SB(b, h) ((4 + (b) * 2 + (h)) * HTB)
#define PG_STAGE(bufoff, gbase, ld) do { _Pragma("unroll") for (int _i = 0; _i < 2; ++_i) \
        __builtin_amdgcn_global_load_lds((const unsigned*)((const char*)(gbase) + (size_t)(Rr[_i] * (ld) + Cc[_i])), (LAS unsigned*)(lds + (bufoff) + ldsw + _i * 8192), 16, 0, 0); } while (0)
#define PG_LDA(dst, b, h) do { _Pragma("unroll") for (int m = 0; m < 4; ++m) _Pragma("unroll") for (int k = 0; k < 2; ++k) dst[m][k] = *(const LAS bf16x8*)(lds + PG_SA(b, h) + aoff + m * 2048 + k * 1024); } while (0)
#define PG_LDB(dst, b, h) do { _Pragma("unroll") for (int n = 0; n < 2; ++n) _Pragma("unroll") for (int k = 0; k < 2; ++k) dst[n][k] = *(const LAS bf16x8*)(lds + PG_SB(b, h) + boff + n * 2048 + k * 1024); } while (0)
#define PG_MMA(ai, bj, At, Bt) do { __builtin_amdgcn_s_setprio(1); _Pragma("unroll") for (int m = 0; m < 4; ++m) _Pragma("unroll") for (int n = 0; n < 2; ++n) _Pragma("unroll") for (int k = 0; k < 2; ++k) \
        acc[ai][bj][m][n] = __builtin_amdgcn_mfma_f32_16x16x32_bf16(Bt[n][k], At[m][k], acc[ai][bj][m][n], 0, 0, 0); __builtin_amdgcn_s_setprio(0); } while (0)
#define PG_WAIT_V(n) asm volatile("s_waitcnt vmcnt(" #n ")" ::: "memory")
#define PG_WAIT_L(n) asm volatile("s_waitcnt lgkmcnt(" #n ")" ::: "memory")
#define PG_BAR __builtin_amdgcn_s_barrier()
#define PG_SCHED __builtin_amdgcn_sched_barrier(0)
    UnitG cur, nxt; int ui = 0;
    if (!S.next(0, cur)) return;
    Acc acc;
#pragma unroll
    for (int a = 0; a < 2; ++a)
#pragma unroll
        for (int b = 0; b < 2; ++b)
#pragma unroll
            for (int m = 0; m < 4; ++m)
#pragma unroll
                for (int n = 0; n < 2; ++n) acc[a][b][m][n] = (f32x4){0.f, 0.f, 0.f, 0.f};
    bf16x8 At[4][2], B0[2][2], B1[2][2];
    const char* cA = cur.A; const char* cB = cur.B; unsigned clda = cur.lda, cldb = cur.ldb;
    PG_STAGE(PG_SB(0, 0), cB, cldb); PG_STAGE(PG_SB(0, 1), cB + (size_t)HALF * cldb, cldb); PG_STAGE(PG_SA(0, 0), cA, clda); PG_STAGE(PG_SA(0, 1), cA + (size_t)HALF * clda, clda);
    if (wr == 1) PG_BAR;
    PG_WAIT_V(2); PG_BAR;
    PG_STAGE(PG_SB(1, 0), cB + 128, cldb); PG_STAGE(PG_SA(1, 0), cA + 128, clda); PG_STAGE(PG_SB(1, 1), cB + (size_t)HALF * cldb + 128, cldb);
    PG_WAIT_V(6); PG_BAR;
    for (;;) {
        const bool has_next = S.next(ui + 1, nxt);
        const char* nA = has_next ? nxt.A : cA; const char* nB = has_next ? nxt.B : cB;
        const unsigned nlda = has_next ? nxt.lda : clda, nldb = has_next ? nxt.ldb : cldb;
        const int nt = cur.nt; const bool chalf = cur.half != 0;
        for (int t = 0; t < nt; t += 2) {
            const bool last = (t == nt - 2);
            const char* a1 = cA + (size_t)(t + 1) * 128;
            const char* a2 = last ? nA : cA + (size_t)(t + 2) * 128; const char* b2 = last ? nB : cB + (size_t)(t + 2) * 128;
            const unsigned lda2 = last ? nlda : clda, ldb2 = last ? nldb : cldb;
            const char* a3 = a2 + 128; const char* b3 = b2 + 128;
            PG_LDB(B0, 0, 0); PG_LDB(B1, 0, 1); PG_SCHED; PG_LDA(At, 0, 0); PG_STAGE(PG_SA(1, 1), a1 + (size_t)HALF * clda, clda);
            PG_WAIT_V(8); PG_WAIT_L(0); PG_BAR; PG_MMA(0, 0, At, B0); PG_MMA(0, 1, At, B1); PG_BAR; PG_SCHED;
            PG_LDA(At, 0, 1); PG_STAGE(PG_SB(0, 0), b2, ldb2); PG_STAGE(PG_SB(0, 1), b2 + (size_t)HALF * ldb2, ldb2); PG_STAGE(PG_SA(0, 0), a2, lda2);
            PG_WAIT_V(8); PG_WAIT_L(0); PG_BAR; if (!chalf) { PG_MMA(1, 0, At, B0); PG_MMA(1, 1, At, B1); } PG_BAR; PG_SCHED;
            PG_LDB(B0, 1, 0); PG_LDB(B1, 1, 1); PG_SCHED; PG_LDA(At, 1, 0); PG_STAGE(PG_SA(0, 1), a2 + (size_t)HALF * lda2, lda2);
            PG_WAIT_V(8); PG_WAIT_L(0); PG_BAR; PG_MMA(0, 0, At, B0); PG_MMA(0, 1, At, B1); PG_BAR; PG_SCHED;
            PG_LDA(At, 1, 1); PG_STAGE(PG_SB(1, 0), b3, ldb2); PG_STAGE(PG_SB(1, 1), b3 + (size_t)HALF * ldb2, ldb2); PG_STAGE(PG_SA(1, 0), a3, lda2);
            PG_WAIT_V(8); PG_WAIT_L(0); PG_BAR; if (!chalf) { PG_MMA(1, 0, At, B0); PG_MMA(1, 1, At, B1); } PG_BAR; PG_SCHED;
        }
        if (wr == 0) PG_BAR;
        E(acc, cur, lds, wr, wc, fr, fq);
        if (!has_next) break;
#pragma unroll
        for (int a = 0; a < 2; ++a)
#pragma unroll
            for (int b = 0; b < 2; ++b)
#pragma unroll
                for (int m = 0; m < 4; ++m)
#pragma unroll
                    for (int n = 0; n < 2; ++n) acc[a][b][m][n] = (f32x4){0.f, 0.f, 0.f, 0.f};
        cur = nxt; cA = nA; cB = nB; clda = nlda; cldb = nldb; ++ui;
        if (wr == 1) PG_BAR;
    }
    PG_WAIT_V(0);
    PG_BAR;
#undef PG_SA
#undef PG_SB
#undef PG_STAGE
#undef PG_LDA
#undef PG_LDB
#undef PG_MMA
#undef PG_WAIT_V
#undef PG_WAIT_L
#undef PG_BAR
#undef PG_SCHED
}
}

struct MArgs { const float* in[24]; float* out; unsigned char* ws; int ph_lo, ph_hi, li, pad; };
struct Frame {
    LAS unsigned char* lds; int tid, lane, wave; int x, j, vcu, G;
    const MArgs* a; float* out; unsigned char* ws;
};
#define FIN(k) (F.a->in[k])
__device__ __forceinline__ float fwave_sum(float v) {
#pragma unroll
    for (int o = 1; o < 64; o <<= 1) v += __shfl_xor(v, o);
    return v;
}

#ifndef PROBE_LO
#define PROBE_LO -1
#define PROBE_HI -1
#define PROBE_MULT 1
#endif
__device__ __forceinline__ void probe_stamp(Frame& F, int k) {
    if (PROBE_LO >= 0 && blockIdx.x == 0 && F.tid == 0) { volatile LAS unsigned* M = (volatile LAS unsigned*)(F.lds + MISC_OFF); const unsigned long long t_ = __builtin_amdgcn_s_memrealtime();
        if (k == PROBE_LO) { M[16] = (unsigned)t_; M[17] = (unsigned)(t_ >> 32); } if (k == PROBE_HI) { M[18] = (unsigned)t_; M[19] = (unsigned)(t_ >> 32); } }
}
enum { W_IN = 0, W_QUP, W_KVUP, W_OBA, W_OBB, W_OUT, W_UP, W_DOWN };
__device__ __forceinline__ int win_src(int gd) {
    const int tile = gd >> 3, g = gd & 7, bj = g >> 2, wc = g & 3;
    if (tile < 3) return C_QLAT + gd * 32;
    if (tile < 5) return C_KVLAT + (gd - 24) * 32;
    if (tile == 5) return (wc == 0) ? C_KPE + bj * 32 : -1;
    if (tile < 10) { const int base = tile < 8 ? C_RQ : C_RK, tl = tile < 8 ? tile - 6 : tile - 8; const int head = 2 * tl + (wc >> 1); return base + head * 128 + bj * 64 + (wc & 1) * 32; }
    if (tile < 14) return C_RV + (gd - 80) * 32;
    if (tile < 18) return C_RG + (gd - 112) * 32;
    if (tile < 22) return C_GA + (gd - 144) * 32;
    return C_GB + (gd - 176) * 32;
}
__device__ __forceinline__ int w_src_col(int wid, int row) {
    const int rho = row & 31, s = row & 255, wc = (s >> 5) & 3, t = row >> 8;
    const int n = rho >> 4, i = rho & 15; return t * 192 + 128 + 16 * wc + i + 32 * n;
}
__device__ __forceinline__ int w_group_base(int wid, int gd) {
    const int g = gd & 7, bj = g >> 2, wc = g & 3, t = gd >> 3;
    switch (wid) {
    case W_IN: return win_src(gd);
    case W_QUP: return bj == 0 ? t * 192 + 32 * wc : (wc < 2 ? -2 : -1);
    case W_KVUP: return t * 256 + 128 * bj + 32 * wc;
    case W_UP: return (bj ? D_FF : 0) + 128 * t + 32 * wc;
    default: return gd * 32;
    }
}
struct WItemRegs { f32x4 v[8]; float g[8]; };
__device__ __forceinline__ void p0_item_load(WItemRegs& R, const float* __restrict__ W, int ldw, const float* __restrict__ gain, int base, int kb, int lane) {
    const int k0 = kb * 64, c = lane & 7;
    if (base >= 0) {
#pragma unroll
        for (int i = 0; i < 8; ++i) { const int kk = (lane >> 3) + 8 * i; R.g[i] = gain ? gain[k0 + kk] : 1.f; R.v[i] = *(const f32x4*)(W + (size_t)(k0 + kk) * ldw + base + 4 * c); } }
}
__device__ __forceinline__ void p0_item_finish(const WItemRegs& R, const float* __restrict__ W, int ldw, int K, const float* __restrict__ gain, int wid, int base, bf16_t* __restrict__ Wt, int gd, int kb, LAS float* scr, int lane) {
    const int k0 = kb * 64, c = lane & 7;
    bf16_t* dst = Wt + (size_t)(gd * 32) * K + k0;
    if (base == -1) {
#pragma unroll
        for (int jj = 0; jj < 4; ++jj) { const int n = (lane >> 3) + 8 * jj; *(u32x4*)(dst + (size_t)n * K + 8 * c) = (u32x4){0u, 0u, 0u, 0u}; }
        return;
    }
    if (base >= 0) {
#pragma unroll
        for (int i = 0; i < 8; ++i) { const int kk = (lane >> 3) + 8 * i; LAS float* d = scr + kk * 33 + 4 * c; const float g = R.g[i]; d[0] = R.v[i][0] * g; d[1] = R.v[i][1] * g; d[2] = R.v[i][2] * g; d[3] = R.v[i][3] * g; }
    } else {
        const int sc = w_src_col(wid, gd * 32 + (lane & 31));
#pragma unroll 8
        for (int i = 0; i < 32; ++i) { const int kk = 2 * i + (lane >> 5); const float g = gain ? gain[k0 + kk] : 1.f; scr[kk * 33 + (lane & 31)] = W[(size_t)(k0 + kk) * ldw + sc] * g; }
    }
    asm volatile("s_waitcnt lgkmcnt(0)" ::: "memory");
#pragma unroll
    for (int jj = 0; jj < 4; ++jj) { const int n = (lane >> 3) + 8 * jj; const LAS float* s = scr + (8 * c) * 33 + (base >= 0 ? pg::perm32(n) : n);
        u32x4 o; o.x = cvt_pk_bf16(s[0 * 33], s[1 * 33]); o.y = cvt_pk_bf16(s[2 * 33], s[3 * 33]); o.z = cvt_pk_bf16(s[4 * 33], s[5 * 33]); o.w = cvt_pk_bf16(s[6 * 33], s[7 * 33]);
        *(u32x4*)(dst + (size_t)n * K + 8 * c) = o; }
    asm volatile("s_waitcnt lgkmcnt(0)" ::: "memory");
}
struct WDesc { const float* W; const float* gain; int ldw, K, wid, ngroups, local; size_t off; };
__device__ __forceinline__ bool w_decode(Frame& F, int it, WDesc& d) {
    if (it < 3328) { d = WDesc{FIN(7), FIN(6), IN_W, 1024, W_IN, 208, it, WS_FWIN}; return true; } it -= 3328;
    if (it < 768) { d = WDesc{FIN(9), FIN(8), 1536, 768, W_QUP, 64, it, WS_FWQUP}; return true; } it -= 768;
    if (it < 512) { d = WDesc{FIN(13), nullptr, 2048, 512, W_KVUP, 64, it, WS_FWKVUP}; return true; } it -= 512;
    if (it < 512) { d = WDesc{FIN(17), nullptr, 1024, 1024, W_OBA, 32, it, WS_FWOBA}; return true; } it -= 512;
    if (it < 512) { d = WDesc{FIN(17) + (size_t)1024 * 1024, nullptr, 1024, 1024, W_OBB, 32, it, WS_FWOBB}; return true; } it -= 512;
    if (it < 512) { d = WDesc{FIN(18), nullptr, 1024, 1024, W_OUT, 32, it, WS_FWOUT}; return true; } it -= 512;
    if (it < 2816) { d = WDesc{FIN(20), FIN(19), FF2, 1024, W_UP, 176, it, WS_FWUP}; return true; } it -= 2816;
    if (it < 1408) { d = WDesc{FIN(23), nullptr, 1024, D_FF, W_DOWN, 32, it, WS_FWDOWN}; return true; }
    return false;
}
__device__ __forceinline__ void p0_all_weights(Frame& F, LAS float* scr, int gw, int NGW) {
    for (int it = gw; it < 10368; it += 2 * NGW) {
        WDesc dA, dB; w_decode(F, it, dA); const bool hasB = w_decode(F, it + NGW, dB);
        const int gdA = dA.local % dA.ngroups, kbA = dA.local / dA.ngroups, baseA = w_group_base(dA.wid, gdA);
        const int gdB = hasB ? dB.local % dB.ngroups : 0, kbB = hasB ? dB.local / dB.ngroups : 0, baseB = hasB ? w_group_base(dB.wid, gdB) : -1;
        WItemRegs RA, RB;
        p0_item_load(RA, dA.W, dA.ldw, dA.gain, baseA, kbA, F.lane);
        if (hasB) p0_item_load(RB, dB.W, dB.ldw, dB.gain, baseB, kbB, F.lane);
        p0_item_finish(RA, dA.W, dA.ldw, dA.K, dA.gain, dA.wid, baseA, (bf16_t*)(F.ws + dA.off), gdA, kbA, scr, F.lane);
        if (hasB) p0_item_finish(RB, dB.W, dB.ldw, dB.K, dB.gain, dB.wid, baseB, (bf16_t*)(F.ws + dB.off), gdB, kbB, scr, F.lane);
    }
}
__device__ __forceinline__ float2 rope_cs(int pos, double f) {
    const double t = (double)pos * f * 0.15915494309189535; const float rev = (float)(t - rint(t));
    return make_float2(__builtin_amdgcn_cosf(rev), __builtin_amdgcn_sinf(rev));
}
__device__ __forceinline__ void p0_prologue(Frame& F) {
    LAS float* scr = (LAS float*)(F.lds + F.wave * 16384);
    const int gw = F.vcu * 8 + F.wave, NGW = F.G * 8;
    if (F.vcu == 0 && F.tid < 128) ((float*)(F.ws + WS_SSQS))[F.tid] = 0.f;
    probe_stamp(F, 20);
    p0_all_weights(F, scr, gw, NGW);
    probe_stamp(F, 21);
    {   bf16_t* XN = (bf16_t*)(F.ws + WS_XN);
        for (int r = gw; r < MPAD; r += 2 * NGW) {
            const int r2 = r + NGW; f32x4 v[2][4];
#pragma unroll
            for (int q = 0; q < 2; ++q) { const int rr = q ? r2 : r; if (rr < MT) { const float* x = rr < MP ? FIN(0) + (size_t)rr * D_MODEL : FIN(1) + (size_t)(rr - MP) * D_MODEL; const f32x4* xr = (const f32x4*)x + F.lane;
#pragma unroll
                    for (int jj = 0; jj < 4; ++jj) v[q][jj] = xr[64 * jj]; } else {
#pragma unroll
                    for (int jj = 0; jj < 4; ++jj) v[q][jj] = (f32x4){0.f, 0.f, 0.f, 0.f}; } }
#pragma unroll
            for (int q = 0; q < 2; ++q) { const int rr = q ? r2 : r; if (rr >= MPAD) continue; float s = 0.f;
#pragma unroll
                for (int jj = 0; jj < 4; ++jj) s += (v[q][jj][0] * v[q][jj][0] + v[q][jj][1] * v[q][jj][1]) + (v[q][jj][2] * v[q][jj][2] + v[q][jj][3] * v[q][jj][3]);
                const float inv = rsqrtf(fwave_sum(s) * (1.f / D_MODEL) + EPS); u32x2* o8 = (u32x2*)(XN + (size_t)rr * D_MODEL) + F.lane;
#pragma unroll
                for (int jj = 0; jj < 4; ++jj) { u32x2 w; w.x = cvt_pk_bf16(v[q][jj][0] * inv, v[q][jj][1] * inv); w.y = cvt_pk_bf16(v[q][jj][2] * inv, v[q][jj][3] * inv); o8[64 * jj] = w; } }
        } }
    probe_stamp(F, 22);
    {   bf16_t* lats = (bf16_t*)(F.ws + WS_LATS); bf16_t* pes = (bf16_t*)(F.ws + WS_PES);
        const int gt = F.vcu * NTHR + F.tid, NG = F.G * NTHR;
        for (int i0 = gt; i0 < DEC_BATCH * PAST * (KV_LORA / 4); i0 += 4 * NG) { f32x4 v[4];
#pragma unroll
            for (int q = 0; q < 4; ++q) v[q] = *((const f32x4*)FIN(2) + i0 + q * NG);
#pragma unroll
            for (int q = 0; q < 4; ++q) { const int i = i0 + q * NG, c4 = i % (KV_LORA / 4), rj = i / (KV_LORA / 4), jr = rj % PAST, b = rj / PAST; u32x2 w; w.x = cvt_pk_bf16(v[q][0], v[q][1]); w.y = cvt_pk_bf16(v[q][2], v[q][3]);
                *(u32x2*)(lats + ((size_t)b * SKEYS + jr) * KV_LORA + c4 * 4) = w; } }
        for (int i = gt; i < DEC_BATCH * PAST * (QK_ROPE / 4); i += NG) { const int c4 = i % (QK_ROPE / 4), rj = i / (QK_ROPE / 4), jr = rj % PAST, b = rj / PAST;
            const f32x4 v = *((const f32x4*)FIN(3) + i); u32x2 w; w.x = cvt_pk_bf16(v[0], v[1]); w.y = cvt_pk_bf16(v[2], v[3]);
            *(u32x2*)(pes + ((size_t)b * SKEYS + jr) * QK_ROPE + c4 * 4) = w; }
        probe_stamp(F, 23);
        float2* tab32 = (float2*)(F.ws + WS_TAB32); float2* tab64 = (float2*)(F.ws + WS_TAB64);
        {   const int k64 = gt & 63, k32 = gt & 31;
            const double f64 = exp2(-(double)k64 * (13.287712379549449 / 64.0)), f32 = exp2(-(double)k32 * (13.287712379549449 / 32.0));
            for (int i = gt; i < 8192 * 64; i += NG) { tab64[i] = rope_cs(i >> 6, f64); if (i < 8192 * 32) tab32[i] = rope_cs(i >> 5, f32); } } }
}

__device__ __forceinline__ bool reg_unit(int x, int j, int i, int nN, int& pm, int& pn) { const int u = j + 32 * i; if (u >= 8 * nN) return false; pm = 8 * x + (u & 7); pn = u >> 3; return true; }
#define LDS_F(off) ((LAS float*)(lds + EPI_OFF) + (off))

enum { K_QLAT = 0, K_KVLAT, K_KPE, K_RQ, K_RK, K_RV, K_RG, K_GS, K_QUP, K_KVP, K_KVS, K_GA, K_AD, K_GB, K_RD, K_OUT, K_UP, K_DOWN };
struct SchedP1 {
    int x, j; const char* ws;
    __device__ __forceinline__ bool next(int i, pg::UnitG& u) const {
        int pm, pn;
        if (!reg_unit(x, j, i, 18, pm, pn)) { if (i == 4 && j >= 16) { const int k = (j - 16) * 8 + x; if (k >= 26) return false; pm = 64; pn = k; } else return false; }
        u.pm = pm; u.pn = pn; u.A = ws + WS_XN + (size_t)pm * 256 * 2048; u.B = ws + WS_FWIN + (size_t)pn * 256 * 2048; u.lda = 2048; u.ldb = 2048; u.nt = 16; u.half = pm == 64;
        u.kind = pn < 3 ? K_QLAT : pn < 5 ? K_KVLAT : pn == 5 ? K_KPE : pn < 8 ? K_RQ : pn < 10 ? K_RK : pn < 14 ? K_RV : pn < 18 ? K_RG : K_GS;
        return true;
    }
};
struct EpiP1 {
    unsigned char* ws; float* out; const float *g_kvlat, *g_kr;
    __device__ __forceinline__ void operator()(const pg::Acc& acc, const pg::UnitG& u, LAS unsigned char* lds, int wr, int wc, int fr, int fq) const {
        bf16_t* const ZQ = (bf16_t*)(ws + WS_ZQ); bf16_t* const KVL = (bf16_t*)(ws + WS_KVL); bf16_t* const KPE = (bf16_t*)(ws + WS_KPE); bf16_t* const PES = (bf16_t*)(ws + WS_PES); bf16_t* const LATS = (bf16_t*)(ws + WS_LATS);
        bf16_t* const RQ = (bf16_t*)(ws + WS_RQ); bf16_t* const RK = (bf16_t*)(ws + WS_RK); bf16_t* const RV = (bf16_t*)(ws + WS_RV); bf16_t* const RG = (bf16_t*)(ws + WS_RG);
        float* const slotq = (float*)(ws + WS_SLOTQ); float* const slotkv = (float*)(ws + WS_SLOTKV);
        const float2* const tab32 = (const float2*)(ws + WS_TAB32); const float2* const tab64 = (const float2*)(ws + WS_TAB64);
        int rl0 = wr * 64 + fr, cw = wc * 32 + fq * 8; asm volatile("" : "+v"(rl0), "+v"(cw));
        const int kind = u.kind, rb = u.pm * 256 + rl0;
        if (kind == K_QLAT || kind == K_KVLAT) {
            const int t = kind == K_QLAT ? u.pn : u.pn - 3; const int ld = kind == K_QLAT ? Q_LORA : KV_LORA; bf16_t* dst = kind == K_QLAT ? ZQ : KVL;
            f32x4 g[2][2];
#pragma unroll
            for (int bj = 0; bj < 2; ++bj)
#pragma unroll
                for (int n = 0; n < 2; ++n) g[bj][n] = kind == K_KVLAT ? *(const f32x4*)(g_kvlat + t * 256 + bj * 128 + cw + 4 * n) : (f32x4){1.f, 1.f, 1.f, 1.f};
#pragma unroll
            for (int ai = 0; ai < 2; ++ai)
#pragma unroll
                for (int m = 0; m < 4; ++m) { const int row = rb + ai * 128 + m * 16; float ss = 0.f;
                    const bool snew = (kind == K_KVLAT) && row >= MP && row < MT;
                    const int rs = row - MP; bf16_t* lrow = LATS + ((size_t)(rs / DEC_SEQ) * SKEYS + PAST + (rs % DEC_SEQ)) * KV_LORA;
#pragma unroll
                    for (int bj = 0; bj < 2; ++bj) { const f32x4 v0 = acc[ai][bj][m][0], v1 = acc[ai][bj][m][1];
                        ss += (v0[0] * v0[0] + v0[1] * v0[1]) + (v0[2] * v0[2] + v0[3] * v0[3]) + (v1[0] * v1[0] + v1[1] * v1[1]) + (v1[2] * v1[2] + v1[3] * v1[3]);
                        const u32x4 w = pack8f(v0 * g[bj][0], v1 * g[bj][1]);
                        *(u32x4*)(dst + (size_t)row * ld + t * 256 + bj * 128 + cw) = w;
                        if (snew) *(u32x4*)(lrow + t * 256 + bj * 128 + cw) = w; }
                    ss += __shfl_xor(ss, 16); ss += __shfl_xor(ss, 32);
                    if (fq == 0) { if (kind == K_QLAT) slotq[(size_t)row * 12 + t * 4 + wc] = ss; else slotkv[(size_t)row * 8 + t * 4 + wc] = ss; } }
        } else if (kind == K_KPE) {
            if (wc != 0) return;
            const int d0 = fq * 8;
            f32x4 g1[2], g2[2];
#pragma unroll
            for (int n = 0; n < 2; ++n) { g1[n] = *(const f32x4*)(g_kr + d0 + 4 * n); g2[n] = *(const f32x4*)(g_kr + 32 + d0 + 4 * n); }
#pragma unroll
            for (int ai = 0; ai < 2; ++ai)
#pragma unroll
                for (int m = 0; m < 4; ++m) { const int row = rb + ai * 128 + m * 16; const int pos = row_pos(row < MT ? row : 0);
                    f32x4 x1[2], x2[2]; float ss = 0.f;
#pragma unroll
                    for (int n = 0; n < 2; ++n) { x1[n] = acc[ai][0][m][n]; x2[n] = acc[ai][1][m][n];
                        ss += (x1[n][0] * x1[n][0] + x1[n][1] * x1[n][1]) + (x1[n][2] * x1[n][2] + x1[n][3] * x1[n][3]) + (x2[n][0] * x2[n][0] + x2[n][1] * x2[n][1]) + (x2[n][2] * x2[n][2] + x2[n][3] * x2[n][3]); }
                    ss += __shfl_xor(ss, 16); ss += __shfl_xor(ss, 32);
                    const float inv = rsqrtf(ss * (1.f / 64.f) + EPS);
                    f32x4 o1[2], o2[2];
#pragma unroll
                    for (int n = 0; n < 2; ++n) { const f32x4 y1 = x1[n] * inv * g1[n], y2 = x2[n] * inv * g2[n];
                        const f32x4 cs0 = *(const f32x4*)(tab32 + pos * 32 + d0 + 4 * n), cs1 = *(const f32x4*)(tab32 + pos * 32 + d0 + 4 * n + 2);
                        const f32x4 c = {cs0[0], cs0[2], cs1[0], cs1[2]}, s = {cs0[1], cs0[3], cs1[1], cs1[3]};
                        o1[n] = y1 * c - y2 * s; o2[n] = y1 * s + y2 * c; }
                    *(u32x4*)(KPE + (size_t)row * 64 + d0) = pack8f(o1[0], o1[1]); *(u32x4*)(KPE + (size_t)row * 64 + 32 + d0) = pack8f(o2[0], o2[1]);
                    if (row < MT) {
                        float* o = row < MP ? out + O_RKP + (size_t)row * 64 : out + O_RKS + (size_t)(row - MP) * 64;
                        *(f32x4*)(o + d0) = o1[0]; *(f32x4*)(o + d0 + 4) = o1[1]; *(f32x4*)(o + 32 + d0) = o2[0]; *(f32x4*)(o + 32 + d0 + 4) = o2[1];
                        if (row >= MP) { const int rs = row - MP, b = rs / DEC_SEQ, tt = rs % DEC_SEQ; bf16_t* p = PES + ((size_t)b * SKEYS + PAST + tt) * 64;
                            *(u32x4*)(p + d0) = pack8f(o1[0], o1[1]); *(u32x4*)(p + 32 + d0) = pack8f(o2[0], o2[1]); } } }
        } else if (kind == K_RQ || kind == K_RK) {
            const int tl = kind == K_RQ ? u.pn - 6 : u.pn - 8; const int head = 2 * tl + (wc >> 1), i0 = 32 * (wc & 1) + fq * 8;
            bf16_t* dst = kind == K_RQ ? RQ : RK; const float sc = kind == K_RQ ? 1.0f : 0.08838834764831845f;
#pragma unroll
            for (int ai = 0; ai < 2; ++ai)
#pragma unroll
                for (int m = 0; m < 4; ++m) { const int row = rb + ai * 128 + m * 16; const int pos = row_pos(row < MT ? row : 0);
                    f32x4 o1[2], o2[2];
#pragma unroll
                    for (int n = 0; n < 2; ++n) { const f32x4 x1 = acc[ai][0][m][n], x2 = acc[ai][1][m][n];
                        const f32x4 cs0 = *(const f32x4*)(tab64 + pos * 64 + i0 + 4 * n), cs1 = *(const f32x4*)(tab64 + pos * 64 + i0 + 4 * n + 2);
                        const f32x4 c = {cs0[0], cs0[2], cs1[0], cs1[2]}, s = {cs0[1], cs0[3], cs1[1], cs1[3]};
                        o1[n] = (x1 * c - x2 * s) * sc; o2[n] = (x1 * s + x2 * c) * sc; }
                    *(u32x4*)(dst + (size_t)row * 512 + head * 128 + i0) = pack8f(o1[0], o1[1]); *(u32x4*)(dst + (size_t)row * 512 + head * 128 + 64 + i0) = pack8f(o2[0], o2[1]); }
        } else if (kind == K_GS) {
            bf16_t* dst = (bf16_t*)(ws + (u.pn < 22 ? WS_GAS : WS_GBS)); const int t = u.pn < 22 ? u.pn - 18 : u.pn - 22;
#pragma unroll
            for (int m = 0; m < 4; ++m) { const int rl = rl0 + m * 16;
#pragma unroll
                for (int bj = 0; bj < 2; ++bj) { f32x4 v0 = acc[0][bj][m][0], v1 = acc[0][bj][m][1];
#pragma unroll
                    for (int e = 0; e < 4; ++e) { v0[e] = 1.f / (1.f + __expf(-v0[e])); v1[e] = 1.f / (1.f + __expf(-v1[e])); }
                    *(u32x4*)(dst + (size_t)rl * 1024 + t * 256 + bj * 128 + cw) = pack8f(v0, v1); } }
        } else {
            const int t = kind == K_RV ? u.pn - 10 : u.pn - 14; bf16_t* dst = kind == K_RV ? RV : RG;
#pragma unroll
            for (int ai = 0; ai < 2; ++ai)
#pragma unroll
                for (int m = 0; m < 4; ++m) { const int row = rb + ai * 128 + m * 16;
#pragma unroll
                    for (int bj = 0; bj < 2; ++bj) { f32x4 v0 = acc[ai][bj][m][0], v1 = acc[ai][bj][m][1];
                        if (kind == K_RG) {
#pragma unroll
                            for (int e = 0; e < 4; ++e) { v0[e] = v0[e] / (1.f + __expf(-v0[e])); v1[e] = v1[e] / (1.f + __expf(-v1[e])); } }
                        *(u32x4*)(dst + (size_t)row * 1024 + t * 256 + bj * 128 + cw) = pack8f(v0, v1); } }
        }
    }
};
__device__ __forceinline__ void p1_inproj(Frame& F) {
    SchedP1 S{F.x, F.j, (const char*)F.ws};
    EpiP1 E{F.ws, F.out, FIN(12), FIN(15)};
    pg::gemm_stream(F.lds, S, E);
}

__device__ __forceinline__ float slot_rs(const float* slots, int n, float invn) {
    float a = 0.f; for (int i = 0; i < n; i += 4) { const f32x4 v = *(const f32x4*)(slots + i); a += (v[0] + v[1]) + (v[2] + v[3]); } return rsqrtf(a * invn + EPS);
}
struct SchedP2 {
    int x, j; const char* ws; int sample;
    __device__ __forceinline__ bool next(int i, pg::UnitG& u) const {
        int pm, pn, kind;
        if (sample) {
            if (i < 2) { reg_unit(x, j, i, 8, pm, pn); kind = K_QUP; }
            else if (i < 4) { reg_unit(x, j, i - 2, 8, pm, pn); kind = K_KVS; }
            else if (i == 4 && j < 2) { const int k = j * 8 + x; pm = 64; pn = k & 7; kind = k < 8 ? K_QUP : K_KVS; }
            else return false;
        } else { if (i >= 2) return false; reg_unit(x, j, i, 8, pm, pn); kind = K_KVP; }
        u.pm = pm; u.pn = pn; u.kind = kind; u.half = pm == 64;
        if (kind == K_QUP) { u.A = ws + WS_ZQ + (size_t)pm * 256 * 1536; u.lda = 1536; u.B = ws + WS_FWQUP + (size_t)pn * 256 * 1536; u.ldb = 1536; u.nt = 12; }
        else { u.A = ws + (kind == K_KVS ? WS_LATS : WS_KVL) + (size_t)pm * 256 * 1024; u.lda = 1024; u.B = ws + WS_FWKVUP + (size_t)pn * 256 * 1024; u.ldb = 1024; u.nt = 8; }
        return true;
    }
};
struct EpiP2 {
    unsigned char* ws; float* out; const float *g_qn, *g_qr, *g_kn;
    __device__ __forceinline__ void operator()(const pg::Acc& acc, const pg::UnitG& u, LAS unsigned char* lds, int wr, int wc, int fr, int fq) const {
        int rl0 = wr * 64 + fr, cw = wc * 32 + fq * 8; asm volatile("" : "+v"(rl0), "+v"(cw));
        const int kind = u.kind, h = u.pn, rb = u.pm * 256 + rl0;
        const float* const slotq = (const float*)(ws + WS_SLOTQ); const float* const slotkv = (const float*)(ws + WS_SLOTKV);
        float rs[2][4];
#pragma unroll
        for (int ai = 0; ai < 2; ++ai)
#pragma unroll
            for (int m = 0; m < 4; ++m) { const int row = rb + ai * 128 + m * 16;
                if (kind == K_QUP) rs[ai][m] = slot_rs(slotq + (size_t)row * 12, 12, 1.f / Q_LORA);
                else if (kind == K_KVP) rs[ai][m] = slot_rs(slotkv + (size_t)row * 8, 8, 1.f / KV_LORA);
                else { const int b = row / SKEYS, jj = row - b * SKEYS; rs[ai][m] = (row < LROWS && jj >= PAST) ? slot_rs(slotkv + (size_t)(MP + b * DEC_SEQ + jj - PAST) * 8, 8, 1.f / KV_LORA) : 1.f; } }
#pragma unroll
        for (int ai = 0; ai < 2; ++ai)
#pragma unroll
            for (int m = 0; m < 4; ++m) { float p0 = 0.f, p1 = 0.f; const float s2 = rs[ai][m] * rs[ai][m];
#pragma unroll
                for (int n = 0; n < 2; ++n) { const f32x4 a = acc[ai][0][m][n], b = acc[ai][1][m][n];
                    p0 += (a[0] * a[0] + a[1] * a[1]) + (a[2] * a[2] + a[3] * a[3]); p1 += (b[0] * b[0] + b[1] * b[1]) + (b[2] * b[2] + b[3] * b[3]); }
                p0 += __shfl_xor(p0, 16); p0 += __shfl_xor(p0, 32); p1 += __shfl_xor(p1, 16); p1 += __shfl_xor(p1, 32);
                if (fq == 0) { LAS float* d = LDS_F((rl0 + ai * 128 + m * 16) * 8 + wc * 2); d[0] = p0 * s2; d[1] = p1 * s2; } }
        asm volatile("s_waitcnt lgkmcnt(0)" ::: "memory"); __builtin_amdgcn_s_barrier(); asm volatile("" ::: "memory");
        if (kind == K_QUP) {
            bf16_t* const Q = (bf16_t*)out;
            const float2* const tab32 = (const float2*)(ws + WS_TAB32);
            const float C2 = 0.07216878364870323f * 1.4426950408889634f;
            f32x4 gn[2]; gn[0] = *(const f32x4*)(g_qn + cw); gn[1] = *(const f32x4*)(g_qn + cw + 4);
            const int ir = 16 * (wc & 1) + 4 * fq; const f32x4 gr1 = *(const f32x4*)(g_qr + ir), gr2 = *(const f32x4*)(g_qr + 32 + ir);
#pragma unroll
            for (int ai = 0; ai < 2; ++ai)
#pragma unroll
                for (int m = 0; m < 4; ++m) { const int row = rb + ai * 128 + m * 16; const int pos = row_pos(row < MT ? row : 0);
                    const LAS float* d = LDS_F((rl0 + ai * 128 + m * 16) * 8); const f32x4 e0 = *(const LAS f32x4*)d, e1 = *(const LAS f32x4*)(d + 4);
                    const float inn = rsqrtf((e0[0] + e0[2] + e1[0] + e1[2]) * (1.f / 128.f) + EPS) * rs[ai][m] * C2, inr = rsqrtf((e0[1] + e0[3]) * (1.f / 64.f) + EPS) * rs[ai][m];
                    bf16_t* qrow = Q + (size_t)row * 1536 + h * 192;
                    *(u32x4*)(qrow + cw) = pack8f(acc[ai][0][m][0] * inn * gn[0], acc[ai][0][m][1] * inn * gn[1]);
                    if (wc < 2) { const f32x4 y1 = acc[ai][1][m][0] * inr * gr1, y2 = acc[ai][1][m][1] * inr * gr2;
                        const f32x4 cs0 = *(const f32x4*)(tab32 + pos * 32 + ir), cs1 = *(const f32x4*)(tab32 + pos * 32 + ir + 2);
                        const f32x4 c = {cs0[0], cs0[2], cs1[0], cs1[2]}, s = {cs0[1], cs0[3], cs1[1], cs1[3]};
                        const f32x4 o1 = (y1 * c - y2 * s) * C2, o2 = (y1 * s + y2 * c) * C2;
                        u32x2 w1, w2; w1.x = cvt_pk_bf16(o1[0], o1[1]); w1.y = cvt_pk_bf16(o1[2], o1[3]); w2.x = cvt_pk_bf16(o2[0], o2[1]); w2.y = cvt_pk_bf16(o2[2], o2[3]);
                        *(u32x2*)(qrow + 128 + ir) = w1; *(u32x2*)(qrow + 160 + ir) = w2; } }
        } else {
            bf16_t* const KN = (bf16_t*)(ws + WS_KN); bf16_t* const V = (bf16_t*)(ws + WS_V);
            f32x4 gk[2]; gk[0] = *(const f32x4*)(g_kn + cw); gk[1] = *(const f32x4*)(g_kn + cw + 4);
#pragma unroll
            for (int ai = 0; ai < 2; ++ai)
#pragma unroll
                for (int m = 0; m < 4; ++m) { const int row = rb + ai * 128 + m * 16;
                    const LAS float* d = LDS_F((rl0 + ai * 128 + m * 16) * 8); const f32x4 e0 = *(const LAS f32x4*)d, e1 = *(const LAS f32x4*)(d + 4);
                    const float s = rs[ai][m], inn = rsqrtf((e0[0] + e0[2] + e1[0] + e1[2]) * (1.f / 128.f) + EPS) * s;
                    *(u32x4*)(KN + (size_t)row * 1024 + h * 128 + cw) = pack8f(acc[ai][0][m][0] * inn * gk[0], acc[ai][0][m][1] * inn * gk[1]);
                    *(u32x4*)(V + (size_t)row * 1024 + h * 128 + cw) = pack8f(acc[ai][1][m][0] * s, acc[ai][1][m][1] * s); }
        }
    }
};
__device__ __forceinline__ void p2_qkv(Frame& F, int sample) {
    SchedP2 S{F.x, F.j, (const char*)F.ws, sample};
    EpiP2 E{F.ws, F.out, FIN(10), FIN(11), FIN(14)};
    pg::gemm_stream(F.lds, S, E);
}

struct SchedP5 {
    int x, j, vcu; const char* ws; int phase;
    __device__ __forceinline__ const char* arow(size_t base, size_t base_s, int pm, size_t rowbytes) const { return ws + (pm < 64 ? base + (size_t)pm * 256 * rowbytes : base_s); }
    __device__ __forceinline__ bool next(int i, pg::UnitG& u) const {
        int pm, pn;
        if (phase == 5) {
            int sub;
            if (i < 4) { sub = i; pm = 8 * x + (j & 7); pn = j >> 3; } else return false;
            u.pm = pm; u.pn = pn; u.kind = K_GA + sub; u.lda = 2048; u.ldb = 2048; u.nt = 16; u.half = pm == 64;
            if (sub == 0) { u.A = ws + WS_XN2 + (size_t)pm * 256 * 2048; u.B = ws + WS_FWIN + (size_t)(18 + pn) * 256 * 2048; }
            else if (sub == 1) { u.A = arow(WS_ATT, WS_ATTS, pm, 2048); u.B = ws + WS_FWOBA + (size_t)pn * 256 * 2048; }
            else if (sub == 2) { u.A = ws + WS_XN2 + (size_t)pm * 256 * 2048; u.B = ws + WS_FWIN + (size_t)(22 + pn) * 256 * 2048; }
            else { u.A = ws + WS_RET + (size_t)pm * 256 * 2048; u.B = ws + WS_FWOBB + (size_t)pn * 256 * 2048; }
            return true;
        }
        if (phase == 6 || phase == 9) {
            if (i == 0) { pm = 8 * x + (j & 7); pn = j >> 3; } else return false;
            u.pm = pm; u.pn = pn; u.half = pm == 64;
            if (phase == 6) { u.kind = K_OUT; u.A = ws + WS_MERGED + (size_t)pm * 256 * 2048; u.lda = 2048; u.B = ws + WS_FWOUT + (size_t)pn * 256 * 2048; u.ldb = 2048; u.nt = 16; }
            else { u.kind = K_DOWN; u.A = ws + WS_U + (size_t)pm * 256 * (FF2 * 2); u.lda = FF2 * 2; u.B = ws + WS_FWDOWN + (size_t)pn * 256 * (D_FF * 2); u.ldb = D_FF * 2; u.nt = 44; }
            return true;
        }
        if (!reg_unit(x, j, i, 22, pm, pn)) return false;
        u.half = pm == 64; u.pm = pm; u.pn = pn; u.kind = K_UP; u.A = ws + WS_X1B + (size_t)pm * 256 * 2048; u.lda = 2048; u.B = ws + WS_FWUP + (size_t)pn * 256 * 2048; u.ldb = 2048; u.nt = 16;
        return true;
    }
};
struct EpiP5 {
    unsigned char* ws; float* out; const float* xp; const float* xs; int vcu;
    __device__ __forceinline__ void operator()(pg::Acc& acc, const pg::UnitG& u, LAS unsigned char* lds, int wr, int wc, int fr, int fq) const {
        int rl0 = wr * 64 + fr, cw = wc * 32 + fq * 8; asm volatile("" : "+v"(rl0), "+v"(cw));
        const int kind = u.kind, rb = u.pm * 256 + rl0;
        if (kind >= K_GA && kind <= K_RD) {
            bf16_t* const T1 = (bf16_t*)(ws + WS_T1) + (size_t)vcu * 65536; bf16_t* const T2 = (bf16_t*)out + (size_t)vcu * 65536;
            bf16_t* const MG = (bf16_t*)(ws + WS_MERGED);
#pragma unroll
            for (int ai = 0; ai < 2; ++ai)
#pragma unroll
                for (int m = 0; m < 4; ++m)
#pragma unroll
                    for (int bj = 0; bj < 2; ++bj) { const size_t so = (size_t)(rl0 + ai * 128 + m * 16) * 256 + bj * 128 + cw;
                        f32x4 v0 = acc[ai][bj][m][0], v1 = acc[ai][bj][m][1];
                        if (kind == K_GA || kind == K_GB) {
#pragma unroll
                            for (int e = 0; e < 4; ++e) { v0[e] = 1.f / (1.f + __expf(-v0[e])); v1[e] = 1.f / (1.f + __expf(-v1[e])); }
                            *(u32x4*)((kind == K_GA ? T1 : T2) + so) = pack8f(v0, v1);
                        } else if (kind == K_AD) {
                            const u32x4 t = u.pm == 64 ? *(const u32x4*)((const bf16_t*)(ws + WS_GAS) + (size_t)(rl0 + ai * 128 + m * 16) * 1024 + u.pn * 256 + bj * 128 + cw) : *(const u32x4*)(T1 + so);
                            const f32x4 g0 = {__uint_as_float(t.x << 16), __uint_as_float(t.x & 0xffff0000u), __uint_as_float(t.y << 16), __uint_as_float(t.y & 0xffff0000u)};
                            const f32x4 g1 = {__uint_as_float(t.z << 16), __uint_as_float(t.z & 0xffff0000u), __uint_as_float(t.w << 16), __uint_as_float(t.w & 0xffff0000u)};
                            *(u32x4*)(T1 + so) = pack8f(v0 * g0, v1 * g1);
                        } else {
                            const u32x4 t = *(const u32x4*)(T1 + so), q = u.pm == 64 ? *(const u32x4*)((const bf16_t*)(ws + WS_GBS) + (size_t)(rl0 + ai * 128 + m * 16) * 1024 + u.pn * 256 + bj * 128 + cw) : *(const u32x4*)(T2 + so);
                            const f32x4 a0 = {__uint_as_float(t.x << 16), __uint_as_float(t.x & 0xffff0000u), __uint_as_float(t.y << 16), __uint_as_float(t.y & 0xffff0000u)};
                            const f32x4 a1 = {__uint_as_float(t.z << 16), __uint_as_float(t.z & 0xffff0000u), __uint_as_float(t.w << 16), __uint_as_float(t.w & 0xffff0000u)};
                            const f32x4 g0 = {__uint_as_float(q.x << 16), __uint_as_float(q.x & 0xffff0000u), __uint_as_float(q.y << 16), __uint_as_float(q.y & 0xffff0000u)};
                            const f32x4 g1 = {__uint_as_float(q.z << 16), __uint_as_float(q.z & 0xffff0000u), __uint_as_float(q.w << 16), __uint_as_float(q.w & 0xffff0000u)};
                            *(u32x4*)(MG + (size_t)(rb + ai * 128 + m * 16) * 1024 + u.pn * 256 + bj * 128 + cw) = pack8f(a0 + v0 * g0, a1 + v1 * g1);
                        }
                        if (bj == 1 && (m & 1)) asm volatile("" ::: "memory"); }
        } else if (kind == K_OUT) {
            float* const slotx = (float*)(ws + WS_SLOTX1); bf16_t* const X1B = (bf16_t*)(ws + WS_X1B);
#pragma unroll
            for (int ai = 0; ai < 2; ++ai)
#pragma unroll
                for (int m = 0; m < 4; ++m) { const int row = rb + ai * 128 + m * 16; float ss = 0.f;
                    const float* xr = row < MP ? xp + (size_t)row * D_MODEL : xs + (size_t)((row < MT ? row : MP) - MP) * D_MODEL;
#pragma unroll
                    for (int bj = 0; bj < 2; ++bj) { const int c = u.pn * 256 + bj * 128 + cw;
                        const f32x4 x0 = *(const f32x4*)(xr + c), x1 = *(const f32x4*)(xr + c + 4);
                        const f32x4 v0 = acc[ai][bj][m][0] + x0, v1 = acc[ai][bj][m][1] + x1;
                        ss += (v0[0] * v0[0] + v0[1] * v0[1]) + (v0[2] * v0[2] + v0[3] * v0[3]) + (v1[0] * v1[0] + v1[1] * v1[1]) + (v1[2] * v1[2] + v1[3] * v1[3]);
                        if (row < MT) { *(f32x4*)(out + (size_t)row * D_MODEL + c) = v0; *(f32x4*)(out + (size_t)row * D_MODEL + c + 4) = v1; }
                        *(u32x4*)(X1B + (size_t)row * D_MODEL + c) = pack8f(v0, v1); }
                    ss += __shfl_xor(ss, 16); ss += __shfl_xor(ss, 32);
                    if (fq == 0) slotx[(size_t)row * 16 + u.pn * 4 + wc] = ss;
                    asm volatile("" ::: "memory"); }
        } else if (kind == K_UP) {
            const float* const slotx = (const float*)(ws + WS_SLOTX1); bf16_t* const U = (bf16_t*)(ws + WS_U);
#pragma unroll
            for (int ai = 0; ai < 2; ++ai)
#pragma unroll
                for (int m = 0; m < 4; ++m) { const int row = rb + ai * 128 + m * 16;
                    float a = 0.f;
#pragma unroll
                    for (int i = 0; i < 16; i += 4) { const f32x4 v = *(const f32x4*)(slotx + (size_t)row * 16 + i); a += (v[0] + v[1]) + (v[2] + v[3]); }
                    const float s = rsqrtf(a * (1.f / D_MODEL) + EPS);
                    const f32x4 ug0 = acc[ai][0][m][0] * s, ug1 = acc[ai][0][m][1] * s, uv0 = acc[ai][1][m][0] * s, uv1 = acc[ai][1][m][1] * s;
                    const u32x4 wg = pack8f(ug0, ug1), wv = pack8f(uv0, uv1); const int cg = u.pn * 128 + cw, cv = D_FF + cg;
                    *(u32x4*)(U + (size_t)row * FF2 + cg) = wg; *(u32x4*)(U + (size_t)row * FF2 + cv) = wv;
                    if ((row & 255) >= 254 && row < MP - 2) { bf16_t* hp = (bf16_t*)(ws + WS_HALO) + ((size_t)((row >> 8) + 1) * 2 + (row & 1)) * FF2; *(u32x4*)(hp + cg) = wg; *(u32x4*)(hp + cv) = wv; }
                    if (row < MT) { const int tpos = row < MP ? (row & (SEQ - 1)) - (SEQ - 2) : ((row - MP) & (DEC_SEQ - 1)) - (DEC_SEQ - 2);
                        if (tpos >= 0) { float* cp = row < MP ? out + O_CONVP + ((size_t)(row >> 13) * 2 + tpos) * FF2 : out + O_CONVS + ((size_t)((row - MP) >> 4) * 2 + tpos) * FF2;
                            *(f32x4*)(cp + cg) = ug0; *(f32x4*)(cp + cg + 4) = ug1; *(f32x4*)(cp + cv) = uv0; *(f32x4*)(cp + cv + 4) = uv1; } }
                    if (m & 1) asm volatile("" ::: "memory"); }
        } else {
#pragma unroll
            for (int ai = 0; ai < 2; ++ai)
#pragma unroll
                for (int m = 0; m < 4; ++m) { const int row = rb + ai * 128 + m * 16; if (row >= MT) continue;
#pragma unroll
                    for (int bj = 0; bj < 2; ++bj) { float* p = out + (size_t)row * D_MODEL + u.pn * 256 + bj * 128 + cw;
                        const f32x4 x0 = *(const f32x4*)p, x1 = *(const f32x4*)(p + 4);
                        *(f32x4*)p = x0 + acc[ai][bj][m][0]; *(f32x4*)(p + 4) = x1 + acc[ai][bj][m][1]; }
                    asm volatile("" ::: "memory"); }
        }
    }
};
__device__ __forceinline__ void p5_gemm(Frame& F, int phase) {
    SchedP5 S{F.x, F.j, F.vcu, (const char*)F.ws, phase};
    EpiP5 E{F.ws, F.out, FIN(0), FIN(1), F.vcu};
    pg::gemm_stream(F.lds, S, E);
}

namespace rt {
typedef short s16x4 __attribute__((ext_vector_type(4)));
constexpr int QST = 136, KDST = 144, VST = 272, PST = 72;
constexpr int Q_OFF = 0, QS_OFF = 17408, K_OFF = 34816, KD_OFF = 52224, V_OFF = 70656, P_OFF = 105472, ST_OFF = 114688, RG_OFF = 118784;
constexpr int SC_TOK = 256, NSC = SEQ / SC_TOK;
__device__ __forceinline__ s16x4 trrd(const LAS bf16_t* p) { return __builtin_bit_cast(s16x4, __builtin_amdgcn_ds_read_tr16_b64_v4i16((LAS s16x4*)p)); }
__device__ __forceinline__ bf16x8 cat8(s16x4 lo, s16x4 hi) { return (bf16x8){lo[0], lo[1], lo[2], lo[3], hi[0], hi[1], hi[2], hi[3]}; }
__device__ __forceinline__ u32x4 scale8(u32x4 w, float s) {
    u32x4 o;
    o.x = cvt_pk_bf16(__uint_as_float(w.x << 16) * s, __uint_as_float(w.x & 0xffff0000u) * s); o.y = cvt_pk_bf16(__uint_as_float(w.y << 16) * s, __uint_as_float(w.y & 0xffff0000u) * s);
    o.z = cvt_pk_bf16(__uint_as_float(w.z << 16) * s, __uint_as_float(w.z & 0xffff0000u) * s); o.w = cvt_pk_bf16(__uint_as_float(w.w << 16) * s, __uint_as_float(w.w & 0xffff0000u) * s);
    return o;
}
__device__ __forceinline__ float row16_sum(float v) {
    v += __builtin_bit_cast(float, __builtin_amdgcn_update_dpp(0, __builtin_bit_cast(int, v), 0xB1, 0xf, 0xf, true));
    v += __builtin_bit_cast(float, __builtin_amdgcn_update_dpp(0, __builtin_bit_cast(int, v), 0x4E, 0xf, 0xf, true));
    v += __builtin_bit_cast(float, __builtin_amdgcn_update_dpp(0, __builtin_bit_cast(int, v), 0x141, 0xf, 0xf, true));
    v += __builtin_bit_cast(float, __builtin_amdgcn_update_dpp(0, __builtin_bit_cast(int, v), 0x140, 0xf, 0xf, true));
    return v;
}
template <bool FULL>
__device__ __forceinline__ void ret_unit(Frame& F, int h, int row0, int nch, int L, const float* Sin, float* Sout, const float* g_ret) {
    LAS unsigned char* lds = F.lds;
    const int tid = F.tid, w = F.wave, l = F.lane, fr = l & 15, g = l >> 4, tq = fr >> 2, tp = fr & 3;
    const float lg2 = log2f(1.f - exp2f(-5.f - (float)h));
    const bf16_t* RQ = (const bf16_t*)(F.ws + WS_RQ); const bf16_t* RK = (const bf16_t*)(F.ws + WS_RK); const bf16_t* RV = (const bf16_t*)(F.ws + WS_RV);
    const bf16_t* RG = (const bf16_t*)(F.ws + WS_RG); bf16_t* RET = (bf16_t*)(F.ws + WS_RET);
    LAS bf16_t* q_l = (LAS bf16_t*)(lds + Q_OFF); LAS bf16_t* qs_l = (LAS bf16_t*)(lds + QS_OFF); LAS bf16_t* k_l = (LAS bf16_t*)(lds + K_OFF);
    LAS bf16_t* kd_l = (LAS bf16_t*)(lds + KD_OFF); LAS bf16_t* v_l = (LAS bf16_t*)(lds + V_OFF); LAS bf16_t* p_l = (LAS bf16_t*)(lds + P_OFF); LAS float* st_l = (LAS float*)(lds + ST_OFF);
    LAS bf16_t* g_l = (LAS bf16_t*)(lds + RG_OFF);
    f32x4 S[8][2];
#pragma unroll
    for (int db = 0; db < 8; ++db)
#pragma unroll
        for (int nb = 0; nb < 2; ++nb) {
            if (Sin) { int so = (16 * db + 4 * g) * RET_DV + 32 * w + 16 * nb + fr; asm volatile("" : "+v"(so));
#pragma unroll
                for (int r = 0; r < 4; ++r) S[db][nb][r] = Sin[so + r * RET_DV]; }
            else S[db][nb] = (f32x4){0.f, 0.f, 0.f, 0.f}; }
    const float gL = exp2f(lg2 * (float)L);
    float gr[2]; if (FULL) { gr[0] = g_ret[h * 256 + 32 * w + fr]; gr[1] = g_ret[h * 256 + 32 * w + 16 + fr]; }
    for (int c = 0; c < nch; ++c) {
        const size_t r0 = (size_t)row0 + (size_t)c * L;
        __syncthreads();
        {   u32x4 pk[2], pq[2], pv[4], pgt[4]; const u32x4 z_ = {0u, 0u, 0u, 0u};
#pragma unroll
            for (int it = 0; it < 2; ++it) { const int idx = tid + 512 * it, tok = idx >> 4, c8 = idx & 15; const bool ok = tok < L;
                pk[it] = ok ? *(const u32x4*)(RK + (r0 + tok) * 512 + h * 128 + c8 * 8) : z_; if (FULL) pq[it] = ok ? *(const u32x4*)(RQ + (r0 + tok) * 512 + h * 128 + c8 * 8) : z_; }
#pragma unroll
            for (int it = 0; it < 4; ++it) { const int idx = tid + 512 * it, tok = idx >> 5, c8 = idx & 31; const bool ok = tok < L;
                pv[it] = ok ? *(const u32x4*)(RV + (r0 + tok) * 1024 + h * 256 + c8 * 8) : z_; if (FULL) pgt[it] = ok ? *(const u32x4*)(RG + (r0 + tok) * 1024 + h * 256 + c8 * 8) : z_; }
#pragma unroll
            for (int it = 0; it < 2; ++it) { const int idx = tid + 512 * it, tok = idx >> 4, c8 = idx & 15;
                *(LAS u32x4*)(kd_l + tok * KDST + c8 * 8) = scale8(pk[it], exp2f(lg2 * (float)(L - 1 - tok)));
                if (FULL) { *(LAS u32x4*)(k_l + tok * QST + c8 * 8) = pk[it]; *(LAS u32x4*)(q_l + tok * QST + c8 * 8) = pq[it]; *(LAS u32x4*)(qs_l + tok * QST + c8 * 8) = scale8(pq[it], exp2f(lg2 * (float)(tok + 1))); } }
#pragma unroll
            for (int it = 0; it < 4; ++it) { const int idx = tid + 512 * it, tok = idx >> 5, c8 = idx & 31;
                *(LAS u32x4*)(v_l + tok * VST + c8 * 8) = pv[it]; if (FULL) *(LAS u32x4*)(g_l + tok * VST + c8 * 8) = pgt[it]; } }
        __syncthreads();
        f32x4 o[4][2];
        if (FULL) {
            const int ib = w >> 1, jb0 = 2 * (w & 1);
            f32x4 p0 = {0.f, 0.f, 0.f, 0.f}, p1 = {0.f, 0.f, 0.f, 0.f};
#pragma unroll
            for (int s = 0; s < 4; ++s) { const bf16x8 a = *(const LAS bf16x8*)(q_l + (16 * ib + fr) * QST + 32 * s + 8 * g);
                const bf16x8 b0 = *(const LAS bf16x8*)(k_l + (16 * jb0 + fr) * QST + 32 * s + 8 * g), b1 = *(const LAS bf16x8*)(k_l + (16 * jb0 + 16 + fr) * QST + 32 * s + 8 * g);
                p0 = __builtin_amdgcn_mfma_f32_16x16x32_bf16(a, b0, p0, 0, 0, 0); p1 = __builtin_amdgcn_mfma_f32_16x16x32_bf16(a, b1, p1, 0, 0, 0); }
#pragma unroll
            for (int r = 0; r < 4; ++r) { const int i = 16 * ib + 4 * g + r, j0 = 16 * jb0 + fr, j1 = j0 + 16;
                const float v0 = j0 <= i ? p0[r] * exp2f(lg2 * (float)(i - j0)) : 0.f, v1 = j1 <= i ? p1[r] * exp2f(lg2 * (float)(i - j1)) : 0.f;
                p_l[i * PST + j0] = f2bf(v0); p_l[i * PST + j1] = f2bf(v1); }
            __syncthreads();
#pragma unroll
            for (int i = 0; i < 4; ++i) { o[i][0] = (f32x4){0.f, 0.f, 0.f, 0.f}; o[i][1] = (f32x4){0.f, 0.f, 0.f, 0.f}; }
        }
        bf16x8 vf[2][2];
#pragma unroll
        for (int s = 0; s < 2; ++s)
#pragma unroll
            for (int nb = 0; nb < 2; ++nb) { const LAS bf16_t* pp = v_l + (32 * s + 8 * g + tq) * VST + 32 * w + 16 * nb + 4 * tp; vf[s][nb] = cat8(trrd(pp), trrd(pp + 4 * VST)); }
        if (FULL) {
#pragma unroll
            for (int i = 0; i < 4; ++i)
#pragma unroll
                for (int s = 0; s < 2; ++s) { const bf16x8 a = *(const LAS bf16x8*)(p_l + (16 * i + fr) * PST + 32 * s + 8 * g);
                    o[i][0] = __builtin_amdgcn_mfma_f32_16x16x32_bf16(a, vf[s][0], o[i][0], 0, 0, 0); o[i][1] = __builtin_amdgcn_mfma_f32_16x16x32_bf16(a, vf[s][1], o[i][1], 0, 0, 0); }
#pragma unroll
            for (int s = 0; s < 4; ++s) {
                bf16x8 bS[2];
#pragma unroll
                for (int nb = 0; nb < 2; ++nb) { u32x4 wv; wv.x = cvt_pk_bf16(S[2 * s][nb][0], S[2 * s][nb][1]); wv.y = cvt_pk_bf16(S[2 * s][nb][2], S[2 * s][nb][3]);
                    wv.z = cvt_pk_bf16(S[2 * s + 1][nb][0], S[2 * s + 1][nb][1]); wv.w = cvt_pk_bf16(S[2 * s + 1][nb][2], S[2 * s + 1][nb][3]); bS[nb] = __builtin_bit_cast(bf16x8, wv); }
#pragma unroll
                for (int i = 0; i < 4; ++i) { const LAS bf16_t* qp = qs_l + (16 * i + fr) * QST + 32 * s + 4 * g;
                    const s16x4 lo = *(const LAS s16x4*)qp, hi = *(const LAS s16x4*)(qp + 16); const bf16x8 a = cat8(lo, hi);
                    o[i][0] = __builtin_amdgcn_mfma_f32_16x16x32_bf16(a, bS[0], o[i][0], 0, 0, 0); o[i][1] = __builtin_amdgcn_mfma_f32_16x16x32_bf16(a, bS[1], o[i][1], 0, 0, 0); }
            }
        }
#pragma unroll
        for (int db = 0; db < 8; ++db) { S[db][0] = S[db][0] * gL; S[db][1] = S[db][1] * gL; }
#pragma unroll
        for (int s = 0; s < 2; ++s)
#pragma unroll
            for (int db = 0; db < 8; ++db) { const LAS bf16_t* pp = kd_l + (32 * s + 8 * g + tq) * KDST + 16 * db + 4 * tp; const bf16x8 a = cat8(trrd(pp), trrd(pp + 4 * KDST));
                S[db][0] = __builtin_amdgcn_mfma_f32_16x16x32_bf16(a, vf[s][0], S[db][0], 0, 0, 0); S[db][1] = __builtin_amdgcn_mfma_f32_16x16x32_bf16(a, vf[s][1], S[db][1], 0, 0, 0); }
        if (FULL) {
#pragma unroll
            for (int i = 0; i < 4; ++i)
#pragma unroll
                for (int r = 0; r < 4; ++r) { float sm = o[i][0][r] + o[i][1][r], sq = o[i][0][r] * o[i][0][r] + o[i][1][r] * o[i][1][r];
                    sm = row16_sum(sm); sq = row16_sum(sq);
                    if (fr == 0) { LAS float* d = st_l + ((16 * i + 4 * g + r) * 8 + w) * 2; d[0] = sm; d[1] = sq; } }
            __syncthreads();
#pragma unroll
            for (int i = 0; i < 4; ++i)
#pragma unroll
                for (int r = 0; r < 4; ++r) { const int tok = 16 * i + 4 * g + r;
                    const LAS f32x4* d = (const LAS f32x4*)(st_l + tok * 16); const f32x4 a0 = d[0], a1 = d[1], a2 = d[2], a3 = d[3];
                    const float sm = (a0[0] + a0[2]) + (a1[0] + a1[2]) + (a2[0] + a2[2]) + (a3[0] + a3[2]), sq = (a0[1] + a0[3]) + (a1[1] + a1[3]) + (a2[1] + a2[3]) + (a3[1] + a3[3]);
                    const float mu = sm * (1.f / 256.f), var = fmaxf(sq * (1.f / 256.f) - mu * mu, 0.f), rstd = rsqrtf(var + EPS);
#pragma unroll
                    for (int nb = 0; nb < 2; ++nb) { LAS bf16_t* ge = g_l + tok * VST + 32 * w + 16 * nb + fr; *ge = f2bf((o[i][nb][r] - mu) * rstd * gr[nb] * bf2f(*ge)); } }
            __syncthreads();
#pragma unroll
            for (int it = 0; it < 4; ++it) { const int idx = tid + 512 * it, tok = idx >> 5, c8 = idx & 31;
                if (tok < L) *(u32x4*)(RET + (r0 + tok) * 1024 + h * 256 + c8 * 8) = *(const LAS u32x4*)(g_l + tok * VST + c8 * 8); }
        }
    }
    if (Sout) {
#pragma unroll
        for (int db = 0; db < 8; ++db)
#pragma unroll
            for (int nb = 0; nb < 2; ++nb) { int so = (16 * db + 4 * g) * RET_DV + 32 * w + 16 * nb + fr; asm volatile("" : "+v"(so));
#pragma unroll
                for (int r = 0; r < 4; ++r) Sout[so + r * RET_DV] = S[db][nb][r]; }
    }
}
}
__device__ __forceinline__ void r1_states(Frame& F) {
    const int bh = F.vcu >> 5, sc = F.vcu & 31, b = bh >> 2, h = bh & 3;
    rt::ret_unit<false>(F, h, b * SEQ + sc * rt::SC_TOK, 4, 64, nullptr, F.out + ((size_t)bh * rt::NSC + sc) * 32768, nullptr);
}
__device__ __forceinline__ void r2_scan(Frame& F) {
    float* U = F.out; const int gt = F.vcu * NTHR + F.tid;
    for (int e = gt; e < 8 * 32768; e += F.G * NTHR) { const int bh = e >> 15, idx = e & 32767, h = bh & 3;
        const float g256 = exp2f(log2f(1.f - exp2f(-5.f - (float)h)) * 256.f);
        float u[32];
#pragma unroll
        for (int sc = 0; sc < 32; ++sc) u[sc] = U[((size_t)bh * 32 + sc) * 32768 + idx];
        float carry = 0.f;
#pragma unroll
        for (int sc = 0; sc < 32; ++sc) { U[((size_t)bh * 32 + sc) * 32768 + idx] = carry; carry = g256 * carry + u[sc]; }
        F.out[O_RETP + (size_t)bh * 32768 + idx] = carry; }
}
__device__ __forceinline__ void r3_outputs(Frame& F) {
    const int bh = F.vcu >> 5, sc = F.vcu & 31, b = bh >> 2, h = bh & 3;
    rt::ret_unit<true>(F, h, b * SEQ + sc * rt::SC_TOK, 4, 64, F.out + ((size_t)bh * rt::NSC + sc) * 32768, nullptr, FIN(16));
    if (F.vcu < DEC_BATCH * RET_H) { const int sb = F.vcu >> 2, sh = F.vcu & 3;
        rt::ret_unit<true>(F, sh, MP + sb * DEC_SEQ, 1, DEC_SEQ, FIN(4) + (size_t)F.vcu * 32768, F.out + O_RETS + (size_t)F.vcu * 32768, FIN(16)); }
}

namespace at {
typedef float f32x16 __attribute__((ext_vector_type(16)));
typedef short s16x4 __attribute__((ext_vector_type(4)));
constexpr int KN_ST = 272, KP_ST = 144;
constexpr int KN_B = 64 * KN_ST, KP_B = 64 * KP_ST, V_B = 16384, BUF_B = KN_B + KP_B + V_B;
constexpr int SCR_OFF = 2 * BUF_B;
constexpr float THR = 8.f;
__device__ __forceinline__ int v_st(int k, int c) { const int kk = (k & ~0xC) | ((k & 4) << 1) | ((k & 8) >> 1); return ((kk >> 3) * 4 + (c >> 5)) * 512 + ((kk & 7) * 32 + (c & 31)) * 2; }
__device__ __forceinline__ int v_rd_base(int lane) { return ((lane & 3) << 3) | (((lane >> 2) & 3) << 6) | (((lane >> 4) & 1) << 5) | (((lane >> 5) & 1) << 8); }
constexpr int v_rd_off(int d0, int ks, int half) { return d0 * 512 + ks * 4096 + half * 2048; }
__device__ __forceinline__ int crow(int r, int hi) { return (r & 3) + 8 * (r >> 2) + 4 * hi; }
#define AT_SBAR() __builtin_amdgcn_sched_barrier(0)

__device__ __forceinline__ void qkt(f32x16& p0, f32x16& p1, const LAS unsigned char* kn, const LAS unsigned char* kp, const bf16x8* qr) {
    p0 = f32x16{}; p1 = f32x16{};
#pragma unroll
    for (int d0 = 0; d0 < 8; ++d0) { const bf16x8 a0 = *(const LAS bf16x8*)(kn + d0 * 32), a1 = *(const LAS bf16x8*)(kn + d0 * 32 + 32 * KN_ST);
        p0 = __builtin_amdgcn_mfma_f32_32x32x16_bf16(a0, qr[d0], p0, 0, 0, 0); p1 = __builtin_amdgcn_mfma_f32_32x32x16_bf16(a1, qr[d0], p1, 0, 0, 0); }
#pragma unroll
    for (int d0 = 0; d0 < 4; ++d0) { const bf16x8 a0 = *(const LAS bf16x8*)(kp + d0 * 32), a1 = *(const LAS bf16x8*)(kp + d0 * 32 + 32 * KP_ST);
        p0 = __builtin_amdgcn_mfma_f32_32x32x16_bf16(a0, qr[8 + d0], p0, 0, 0, 0); p1 = __builtin_amdgcn_mfma_f32_32x32x16_bf16(a1, qr[8 + d0], p1, 0, 0, 0); }
}
__device__ __forceinline__ void pv_tile(f32x16* o, int vb0, bf16x8 pa0, bf16x8 pa1, bf16x8 pa2, bf16x8 pa3) {
#define AT_TRRD(dst, off) asm volatile("ds_read_b64_tr_b16 %0, %1 offset:%2" : "=&v"(dst) : "v"(vb0), "i"(off) : "memory")
#define AT_PV_D0(d0) do { s16x4 l0, l1, l2, l3, h0, h1, h2, h3; constexpr int b_ = v_rd_off(d0, 0, 0);   \
        AT_TRRD(l0, b_); AT_TRRD(h0, b_ + 2048); AT_TRRD(l1, b_ + 4096); AT_TRRD(h1, b_ + 6144); AT_TRRD(l2, b_ + 8192); AT_TRRD(h2, b_ + 10240); AT_TRRD(l3, b_ + 12288); AT_TRRD(h3, b_ + 14336); \
        asm volatile("s_waitcnt lgkmcnt(0)" ::: "memory"); AT_SBAR();   \
        o[d0] = __builtin_amdgcn_mfma_f32_32x32x16_bf16(pa0, (bf16x8){l0[0], l0[1], l0[2], l0[3], h0[0], h0[1], h0[2], h0[3]}, o[d0], 0, 0, 0);   \
        o[d0] = __builtin_amdgcn_mfma_f32_32x32x16_bf16(pa1, (bf16x8){l1[0], l1[1], l1[2], l1[3], h1[0], h1[1], h1[2], h1[3]}, o[d0], 0, 0, 0);   \
        o[d0] = __builtin_amdgcn_mfma_f32_32x32x16_bf16(pa2, (bf16x8){l2[0], l2[1], l2[2], l2[3], h2[0], h2[1], h2[2], h2[3]}, o[d0], 0, 0, 0);   \
        o[d0] = __builtin_amdgcn_mfma_f32_32x32x16_bf16(pa3, (bf16x8){l3[0], l3[1], l3[2], l3[3], h3[0], h3[1], h3[2], h3[3]}, o[d0], 0, 0, 0); } while (0)
    AT_PV_D0(0); AT_PV_D0(1); AT_PV_D0(2); AT_PV_D0(3);
#undef AT_PV_D0
#undef AT_TRRD
}
template <bool PARTIAL>
__device__ __forceinline__ void attn_unit(LAS unsigned char* lds, const bf16_t* Qw, const bf16_t* KN, const bf16_t* KPE, const bf16_t* V, bf16_t* Ow, float* Pw, int NT, int tmax_w, int nkeys, int orows, int t0, int tstride) {
    const int tid = threadIdx.x, wid = __builtin_amdgcn_readfirstlane(tid >> 6), lane = tid & 63, r32 = lane & 31, hi = lane >> 5;
    bf16x8 qr[12];
#pragma unroll
    for (int d0 = 0; d0 < 12; ++d0) qr[d0] = *(const bf16x8*)(Qw + (size_t)r32 * 1536 + d0 * 16 + hi * 8);
    const int sr = tid >> 4, sc = (tid & 15) * 8, pr = tid >> 3, pc = (tid & 7) * 8;
    const int kn_w0 = sr * KN_ST + sc * 2, kn_w1 = (32 + sr) * KN_ST + sc * 2, kp_w = KN_B + pr * KP_ST + pc * 2, v_w0 = KN_B + KP_B + v_st(sr, sc), v_w1 = KN_B + KP_B + v_st(32 + sr, sc);
    const int kn_r = r32 * KN_ST + hi * 16, kp_r = KN_B + r32 * KP_ST + hi * 16;
    const int vb_base = (int)(unsigned)(uintptr_t)(lds + KN_B + KP_B) + v_rd_base(lane);
    LAS float* scr = (LAS float*)(lds + SCR_OFF) + wid * 64;
    float m_reg = -1e30f, l_reg = 0.f; f32x16 o[4] = {};
    u32x4 st_kn0, st_kn1, st_kp, st_v0, st_v1;
#define AT_LOAD(t) do { const size_t k0_ = (size_t)(t0 + (t) * tstride) * 64; const bool v0_ = (int)k0_ + sr < nkeys, v1_ = (int)k0_ + 32 + sr < nkeys, vp_ = (int)k0_ + pr < nkeys; const u32x4 z_ = {0u, 0u, 0u, 0u}; \
        st_kn0 = v0_ ? *(const u32x4*)(KN + (k0_ + sr) * 1024 + sc) : z_; st_kn1 = v1_ ? *(const u32x4*)(KN + (k0_ + 32 + sr) * 1024 + sc) : z_; \
        st_v0 = v0_ ? *(const u32x4*)(V + (k0_ + sr) * 1024 + sc) : z_; st_v1 = v1_ ? *(const u32x4*)(V + (k0_ + 32 + sr) * 1024 + sc) : z_; \
        st_kp = vp_ ? *(const u32x4*)(KPE + (k0_ + pr) * 64 + pc) : z_; } while (0)
#define AT_WRITE(bf) do { LAS unsigned char* b_ = lds + (bf) * BUF_B; *(LAS u32x4*)(b_ + kn_w0) = st_kn0; *(LAS u32x4*)(b_ + kn_w1) = st_kn1; *(LAS u32x4*)(b_ + kp_w) = st_kp; \
        *(LAS u32x4*)(b_ + v_w0) = st_v0; *(LAS u32x4*)(b_ + v_w1) = st_v1; } while (0)
    AT_LOAD(0); AT_WRITE(0);
    __syncthreads();
    for (int t = 0; t < NT; ++t) {
        const int bf = t & 1;
        if (t + 1 < NT) AT_LOAD(t + 1);
        if (t <= tmax_w) {
            f32x16 p0, p1;
            const LAS unsigned char* bb = lds + bf * BUF_B;
            qkt(p0, p1, bb + kn_r, bb + kp_r, qr);
            if ((t0 + t * tstride + 1) * 64 > nkeys) {
                const int kb = (t0 + t * tstride) * 64 + 4 * hi;
#pragma unroll
                for (int r = 0; r < 16; ++r) { const int kv = kb + (r & 3) + 8 * (r >> 2); if (kv >= nkeys) p0[r] = -INFINITY; if (kv + 32 >= nkeys) p1[r] = -INFINITY; } }
            float pmax = p0[0];
#pragma unroll
            for (int r = 1; r < 16; ++r) pmax = fmaxf(pmax, p0[r]);
#pragma unroll
            for (int r = 0; r < 16; ++r) pmax = fmaxf(pmax, p1[r]);
            { auto rr = __builtin_amdgcn_permlane32_swap(__float_as_uint(pmax), __float_as_uint(pmax), false, false); pmax = fmaxf(__uint_as_float(rr[0]), __uint_as_float(rr[1])); }
            float alpha = 1.f; bool resc = false;
            if (!__all(pmax - m_reg <= THR)) { const float mn = fmaxf(m_reg, pmax); alpha = __builtin_amdgcn_exp2f(m_reg - mn); m_reg = mn; resc = true; }
#pragma unroll
            for (int r = 0; r < 16; ++r) { p0[r] = __builtin_amdgcn_exp2f(p0[r] - m_reg); p1[r] = __builtin_amdgcn_exp2f(p1[r] - m_reg); }
            float ps = 0.f;
#pragma unroll
            for (int r = 0; r < 16; ++r) ps += p0[r] + p1[r];
            { auto rr = __builtin_amdgcn_permlane32_swap(__float_as_uint(ps), __float_as_uint(ps), false, false); ps = __uint_as_float(rr[0]) + __uint_as_float(rr[1]); }
            l_reg = l_reg * alpha + ps;
            bf16x8 pa0, pa1, pa2, pa3;
#define AT_PK4(P, B_, OUT) do { unsigned a0 = cvt_pk_bf16(P[B_ + 0], P[B_ + 1]), a1 = cvt_pk_bf16(P[B_ + 2], P[B_ + 3]); unsigned b0 = cvt_pk_bf16(P[B_ + 4], P[B_ + 5]), b1 = cvt_pk_bf16(P[B_ + 6], P[B_ + 7]); \
        auto r0 = __builtin_amdgcn_permlane32_swap(a0, b0, false, false); auto r1 = __builtin_amdgcn_permlane32_swap(a1, b1, false, false); \
        u32x4 w_ = {r0[0], r1[0], r0[1], r1[1]}; OUT = __builtin_bit_cast(bf16x8, w_); } while (0)
            AT_PK4(p0, 0, pa0); AT_PK4(p0, 8, pa1); AT_PK4(p1, 0, pa2); AT_PK4(p1, 8, pa3);
#undef AT_PK4
            if (resc) { if (hi == 0) scr[r32] = alpha; asm volatile("s_waitcnt lgkmcnt(0)" ::: "memory");
#pragma unroll
                for (int d_ = 0; d_ < 4; ++d_)
#pragma unroll
                    for (int r = 0; r < 16; ++r) o[d_][r] *= scr[crow(r, hi)]; }
            AT_SBAR();
            pv_tile(o, vb_base + bf * BUF_B, pa0, pa1, pa2, pa3);
        }
        if (t + 1 < NT) AT_WRITE(bf ^ 1);
        __syncthreads();
    }
    if (PARTIAL) {
        if (wid == 0) {
#pragma unroll
            for (int r = 0; r < 16; ++r) { const int orow = crow(r, hi); if (orow < orows) {
#pragma unroll
                for (int d0 = 0; d0 < 4; ++d0) Pw[orow * 132 + d0 * 32 + r32] = o[d0][r]; } }
            if (hi == 0 && r32 < orows) { Pw[r32 * 132 + 128] = m_reg; Pw[r32 * 132 + 129] = l_reg; } }
        __syncthreads();
        return;
    }
    if (hi == 0) scr[32 + r32] = l_reg; asm volatile("s_waitcnt lgkmcnt(0)" ::: "memory");
#pragma unroll
    for (int r = 0; r < 16; ++r) { const int orow = crow(r, hi); const float rl = __builtin_amdgcn_rcpf(scr[32 + orow]);
#pragma unroll
        for (int d0 = 0; d0 < 4; ++d0) { const float v = o[d0][r] * rl; const float vn = __shfl_xor(v, 1);
            if ((r32 & 1) == 0 && orow < orows) *(unsigned*)(Ow + (size_t)orow * 1024 + d0 * 32 + r32) = cvt_pk_bf16(v, vn); } }
    __syncthreads();
#undef AT_LOAD
#undef AT_WRITE
}
#undef AT_SBAR
}
__device__ __forceinline__ void p3_attn_prompt(Frame& F) {
    const int bh = F.vcu >> 4, s = F.vcu & 15, b = bh >> 3, h = bh & 7;
    const bf16_t* Q = (const bf16_t*)F.out; const bf16_t* KN = (const bf16_t*)(F.ws + WS_KN); const bf16_t* KPE = (const bf16_t*)(F.ws + WS_KPE); const bf16_t* V = (const bf16_t*)(F.ws + WS_V); bf16_t* ATT = (bf16_t*)(F.ws + WS_ATT);
#pragma unroll 1
    for (int it = 0; it < 2; ++it) { const int qb = it == 0 ? s : 31 - s; const size_t row0 = (size_t)b * SEQ + (size_t)qb * 256 + F.wave * 32;
        at::attn_unit<false>(F.lds, Q + row0 * 1536 + h * 192, KN + (size_t)b * SEQ * 1024 + h * 128, KPE + (size_t)b * SEQ * 64, V + (size_t)b * SEQ * 1024 + h * 128,
                      ATT + row0 * 1024 + h * 128, nullptr, 4 * qb + 4, 4 * qb + (F.wave >> 1), 1 << 30, 32, 0, 1); }
}
__device__ __forceinline__ void xn_rows(Frame& F, bf16_t* XN) {
    const int gw = F.vcu * 8 + F.wave, NGW = F.G * 8;
    for (int r = gw; r < MPAD; r += NGW) {
        u32x2* o8 = (u32x2*)(XN + (size_t)r * D_MODEL) + F.lane;
        if (r >= MT) { for (int jj = 0; jj < 4; ++jj) o8[64 * jj] = (u32x2){0u, 0u}; continue; }
        const float* x = r < MP ? FIN(0) + (size_t)r * D_MODEL : FIN(1) + (size_t)(r - MP) * D_MODEL;
        const f32x4* xr = (const f32x4*)x + F.lane; f32x4 v[4]; float s = 0.f;
#pragma unroll
        for (int jj = 0; jj < 4; ++jj) { v[jj] = xr[64 * jj]; s += (v[jj][0] * v[jj][0] + v[jj][1] * v[jj][1]) + (v[jj][2] * v[jj][2] + v[jj][3] * v[jj][3]); }
        const float inv = rsqrtf(fwave_sum(s) * (1.f / D_MODEL) + EPS);
#pragma unroll
        for (int jj = 0; jj < 4; ++jj) { u32x2 w; w.x = cvt_pk_bf16(v[jj][0] * inv, v[jj][1] * inv); w.y = cvt_pk_bf16(v[jj][2] * inv, v[jj][3] * inv); o8[64 * jj] = w; }
    }
}
constexpr size_t WS_PART = WS_ATTS + 512 * KiB;
__device__ __forceinline__ void p3_attn_sample(Frame& F) {
    {   const int bh = F.vcu >> 2, part = F.vcu & 3, b = bh >> 3, h = bh & 7;
        const bf16_t* Q = (const bf16_t*)F.out; const bf16_t* KN = (const bf16_t*)(F.ws + WS_KN); const bf16_t* PES = (const bf16_t*)(F.ws + WS_PES); const bf16_t* V = (const bf16_t*)(F.ws + WS_V);
        const size_t row0 = (size_t)MP + (size_t)b * DEC_SEQ;
        at::attn_unit<true>(F.lds, Q + row0 * 1536 + h * 192, KN + (size_t)b * SKEYS * 1024 + h * 128, PES + (size_t)b * SKEYS * 64, V + (size_t)b * SKEYS * 1024 + h * 128,
                            nullptr, (float*)(F.ws + WS_PART) + (size_t)F.vcu * 16 * 132, part == 0 ? 9 : 8, F.wave == 0 ? 1000 : -1, SKEYS, DEC_SEQ, part, 4); }
    xn_rows(F, (bf16_t*)(F.ws + WS_XN2));
    {   const int gw = F.vcu * 8 + F.wave, NGW = F.G * 8; const bf16_t* KVL = (const bf16_t*)(F.ws + WS_KVL); const float* slotkv = (const float*)(F.ws + WS_SLOTKV);
        for (int r = gw; r < MT; r += NGW) { const float s = slot_rs(slotkv + (size_t)r * 8, 8, 1.f / KV_LORA);
            float* o = r < MP ? F.out + O_LATP + (size_t)r * KV_LORA : F.out + O_LATS + (size_t)(r - MP) * KV_LORA;
            const u32x4 w = *((const u32x4*)(KVL + (size_t)r * KV_LORA) + F.lane);
            f32x4 a = {__uint_as_float(w.x << 16), __uint_as_float(w.x & 0xffff0000u), __uint_as_float(w.y << 16), __uint_as_float(w.y & 0xffff0000u)};
            f32x4 c = {__uint_as_float(w.z << 16), __uint_as_float(w.z & 0xffff0000u), __uint_as_float(w.w << 16), __uint_as_float(w.w & 0xffff0000u)};
            *((f32x4*)o + 2 * F.lane) = a * s; *((f32x4*)o + 2 * F.lane + 1) = c * s; } }
}
__device__ __forceinline__ void attn_sample_combine(Frame& F) {
    if (F.vcu >= DEC_BATCH * HEADS) return;
    const int b = F.vcu >> 3, h = F.vcu & 7; const float* P = (const float*)(F.ws + WS_PART) + (size_t)F.vcu * 4 * 16 * 132; bf16_t* ATTS = (bf16_t*)(F.ws + WS_ATTS);
    for (int e = F.tid; e < 16 * 128; e += NTHR) { const int q = e >> 7, d = e & 127;
        float m[4], M = -1e30f;
#pragma unroll
        for (int p = 0; p < 4; ++p) { m[p] = P[(p * 16 + q) * 132 + 128]; M = fmaxf(M, m[p]); }
        float num = 0.f, den = 0.f;
#pragma unroll
        for (int p = 0; p < 4; ++p) { const float w = exp2f(m[p] - M); num += w * P[(p * 16 + q) * 132 + d]; den += w * P[(p * 16 + q) * 132 + 129]; }
        ATTS[(size_t)(b * DEC_SEQ + q) * 1024 + h * 128 + d] = f2bf(num / den); }
}
__device__ __forceinline__ void unpack8(const u32x4 w, float* f) {
    f[0] = __uint_as_float(w.x << 16); f[1] = __uint_as_float(w.x & 0xffff0000u); f[2] = __uint_as_float(w.y << 16); f[3] = __uint_as_float(w.y & 0xffff0000u);
    f[4] = __uint_as_float(w.z << 16); f[5] = __uint_as_float(w.z & 0xffff0000u); f[6] = __uint_as_float(w.w << 16); f[7] = __uint_as_float(w.w & 0xffff0000u);
}
__device__ __forceinline__ void p8_conv(Frame& F) {
    bf16_t* U = (bf16_t*)(F.ws + WS_U); const bf16_t* HALO = (const bf16_t*)(F.ws + WS_HALO); const float* cw = FIN(21); const float* cb = FIN(22); const float* prev = FIN(5);
    const int seg = F.wave, cgi = F.lane;
    for (int unit = F.vcu; unit < 72 * 6; unit += F.G) { const int ch = unit / 6, strip = unit % 6; const int n = strip * 512 + cgi * 8, nv = n + D_FF; const bool cok = n < D_FF;
        int r0, nr; if (ch < 64) { r0 = ch * 256 + seg * 32; nr = 32; } else { r0 = MP + (ch - 64) * DEC_SEQ; nr = seg == 0 ? DEC_SEQ : 0; }
        if (!cok) nr = 0;
        float wg[3][8], wv[3][8], bg[8], bv[8], g2[8], g1[8], v2[8], v1[8];
#pragma unroll
        for (int e = 0; e < 8; ++e) { g2[e] = 0.f; g1[e] = 0.f; v2[e] = 0.f; v1[e] = 0.f; }
        if (cok) {
#pragma unroll
            for (int k = 0; k < 3; ++k) { const f32x4 a0 = *(const f32x4*)(cw + k * FF2 + n), a1 = *(const f32x4*)(cw + k * FF2 + n + 4), c0 = *(const f32x4*)(cw + k * FF2 + nv), c1 = *(const f32x4*)(cw + k * FF2 + nv + 4);
#pragma unroll
                for (int e = 0; e < 4; ++e) { wg[k][e] = a0[e]; wg[k][4 + e] = a1[e]; wv[k][e] = c0[e]; wv[k][4 + e] = c1[e]; } }
            { const f32x4 a0 = *(const f32x4*)(cb + n), a1 = *(const f32x4*)(cb + n + 4), c0 = *(const f32x4*)(cb + nv), c1 = *(const f32x4*)(cb + nv + 4);
#pragma unroll
              for (int e = 0; e < 4; ++e) { bg[e] = a0[e]; bg[4 + e] = a1[e]; bv[e] = c0[e]; bv[4 + e] = c1[e]; } }
            if (ch < 64) {
                if (seg > 0) { unpack8(*(const u32x4*)(U + (size_t)(r0 - 2) * FF2 + n), g2); unpack8(*(const u32x4*)(U + (size_t)(r0 - 1) * FF2 + n), g1); unpack8(*(const u32x4*)(U + (size_t)(r0 - 2) * FF2 + nv), v2); unpack8(*(const u32x4*)(U + (size_t)(r0 - 1) * FF2 + nv), v1); }
                else if ((ch & 31) != 0) { const bf16_t* hp = HALO + (size_t)ch * 2 * FF2; unpack8(*(const u32x4*)(hp + n), g2); unpack8(*(const u32x4*)(hp + FF2 + n), g1); unpack8(*(const u32x4*)(hp + nv), v2); unpack8(*(const u32x4*)(hp + FF2 + nv), v1); }
            } else if (seg == 0) { const float* pp = prev + (size_t)(ch - 64) * 2 * FF2;
#pragma unroll
                for (int e = 0; e < 8; ++e) { g2[e] = pp[n + e]; g1[e] = pp[FF2 + n + e]; v2[e] = pp[nv + e]; v1[e] = pp[FF2 + nv + e]; } }
        }
        __syncthreads();
#pragma unroll 2
        for (int i = 0; i < nr; ++i) { bf16_t* row = U + (size_t)(r0 + i) * FF2; float g0[8], v0[8], h[8];
            unpack8(*(const u32x4*)(row + n), g0); unpack8(*(const u32x4*)(row + nv), v0);
#pragma unroll
            for (int e = 0; e < 8; ++e) { const float cg = g2[e] * wg[0][e] + g1[e] * wg[1][e] + g0[e] * wg[2][e] + bg[e], cv = v2[e] * wv[0][e] + v1[e] * wv[1][e] + v0[e] * wv[2][e] + bv[e];
                h[e] = cg * __builtin_amdgcn_rcpf(1.f + __expf(-cg)) * cv; g2[e] = g1[e]; g1[e] = g0[e]; v2[e] = v1[e]; v1[e] = v0[e]; }
            u32x4 w; w.x = cvt_pk_bf16(h[0], h[1]); w.y = cvt_pk_bf16(h[2], h[3]); w.z = cvt_pk_bf16(h[4], h[5]); w.w = cvt_pk_bf16(h[6], h[7]);
            *(u32x4*)(row + n) = w; }
        __syncthreads();
    }
}
namespace sk {
__device__ __forceinline__ int wrow(int c) { const int c5 = c & 31; return (c & ~31) + 16 * ((c5 >> 2) & 1) + 4 * (c5 >> 3) + (c5 & 3); }
__device__ __forceinline__ f32x4 mm(const bf16_t* __restrict__ Ap, const bf16_t* __restrict__ Bp, int K) {
    f32x4 acc = {0.f, 0.f, 0.f, 0.f};
#pragma unroll 8
    for (int s = 0; s < K; s += 32) acc = __builtin_amdgcn_mfma_f32_16x16x32_bf16(*(const bf16x8*)(Ap + s), *(const bf16x8*)(Bp + s), acc, 0, 0, 0);
    return acc;
}
}
__device__ __forceinline__ void sk_merge(Frame& F, int su) {
    const int w = F.wave, fr = F.lane & 15, g = F.lane >> 4, c = 16 * su + fr, wr_ = sk::wrow(c);
    const bf16_t* ATTS = (const bf16_t*)(F.ws + WS_ATTS); const bf16_t* RET = (const bf16_t*)(F.ws + WS_RET) + (size_t)MP * 1024;
    const f32x4 aA = sk::mm(ATTS + (size_t)(16 * w + fr) * 1024 + 8 * g, (const bf16_t*)(F.ws + WS_FWOBA) + (size_t)wr_ * 1024 + 8 * g, 1024);
    const f32x4 aR = sk::mm(RET + (size_t)(16 * w + fr) * 1024 + 8 * g, (const bf16_t*)(F.ws + WS_FWOBB) + (size_t)wr_ * 1024 + 8 * g, 1024);
    const bf16_t* gas_ = (const bf16_t*)(F.ws + WS_GAS); const bf16_t* gbs_ = (const bf16_t*)(F.ws + WS_GBS); bf16_t* MG = (bf16_t*)(F.ws + WS_MERGED) + (size_t)MP * 1024;
#pragma unroll
    for (int r = 0; r < 4; ++r) { const size_t i = (size_t)(16 * w + 4 * g + r) * 1024 + c; MG[i] = f2bf(bf2f(gas_[i]) * aA[r] + bf2f(gbs_[i]) * aR[r]); }
}
__device__ __forceinline__ void sk_out(Frame& F, int su) {
    const int w = F.wave, fr = F.lane & 15, g = F.lane >> 4, c = 16 * su + fr;
    const bf16_t* MG = (const bf16_t*)(F.ws + WS_MERGED) + (size_t)MP * 1024;
    const f32x4 a = sk::mm(MG + (size_t)(16 * w + fr) * 1024 + 8 * g, (const bf16_t*)(F.ws + WS_FWOUT) + (size_t)sk::wrow(c) * 1024 + 8 * g, 1024);
    bf16_t* X1B = (bf16_t*)(F.ws + WS_X1B) + (size_t)MP * 1024; float* ssq = (float*)(F.ws + WS_SSQS); const float* xs = FIN(1);
#pragma unroll
    for (int r = 0; r < 4; ++r) { const int row = 16 * w + 4 * g + r; const size_t i = (size_t)row * 1024 + c; const float v = xs[i] + a[r];
        F.out[O_YS + i] = v; X1B[i] = f2bf(v); const float q = rt::row16_sum(v * v); if (fr == 0) atomicAdd(ssq + row, q); }
}
__device__ __forceinline__ void sk_up(Frame& F, int su) {
    const int w = F.wave, fr = F.lane & 15, g = F.lane >> 4, c = 16 * su + fr;
    const int cc = c < D_FF ? c : c - D_FF, drow = (cc >> 7) * 256 + (c < D_FF ? 0 : 128) + sk::wrow(cc & 127);
    const bf16_t* X1B = (const bf16_t*)(F.ws + WS_X1B) + (size_t)MP * 1024;
    const f32x4 a = sk::mm(X1B + (size_t)(16 * w + fr) * 1024 + 8 * g, (const bf16_t*)(F.ws + WS_FWUP) + (size_t)drow * 1024 + 8 * g, 1024);
    bf16_t* U = (bf16_t*)(F.ws + WS_U) + (size_t)MP * FF2; const float* ssq = (const float*)(F.ws + WS_SSQS);
#pragma unroll
    for (int r = 0; r < 4; ++r) { const int row = 16 * w + 4 * g + r; const float u = a[r] * rsqrtf(ssq[row] * (1.f / D_MODEL) + EPS);
        U[(size_t)row * FF2 + c] = f2bf(u); const int t = row & (DEC_SEQ - 1); if (t >= DEC_SEQ - 2) F.out[O_CONVS + ((size_t)(row >> 4) * 2 + (t - (DEC_SEQ - 2))) * FF2 + c] = u; }
}
__device__ __forceinline__ void sk_down(Frame& F, int su) {
    const int w = F.wave, fr = F.lane & 15, g = F.lane >> 4, c = 16 * su + fr;
    const bf16_t* U = (const bf16_t*)(F.ws + WS_U) + (size_t)MP * FF2;
    const f32x4 a = sk::mm(U + (size_t)(16 * w + fr) * FF2 + 8 * g, (const bf16_t*)(F.ws + WS_FWDOWN) + (size_t)sk::wrow(c) * D_FF + 8 * g, D_FF);
#pragma unroll
    for (int r = 0; r < 4; ++r) { const size_t i = (size_t)(16 * w + 4 * g + r) * 1024 + c; F.out[O_YS + i] += a[r]; }
}
__global__ void __launch_bounds__(NTHR, 2) mk(const MArgs a) {
    extern __shared__ __attribute__((aligned(16))) unsigned char lds_raw[];
    Frame F;
    F.lds = (LAS unsigned char*)lds_raw;
    F.tid = threadIdx.x; F.lane = F.tid & 63; F.wave = __builtin_amdgcn_readfirstlane(F.tid >> 6);
    F.G = gridDim.x; F.x = blockIdx.x % 8; F.j = blockIdx.x / 8; F.vcu = F.x * (F.G / 8) + F.j;
    F.a = &a; F.out = a.out; F.ws = a.ws;
    volatile LAS unsigned* MISC = (volatile LAS unsigned*)(F.lds + MISC_OFF);
    if (F.tid < 32) MISC[F.tid] = 0u;
    __syncthreads();
    XcdBarrier bar = xcd_barrier_post((unsigned*)(a.ws + WS_CTL) + CW_BAR + a.li * XCD_BAR_WORDS, MISC + 8);
    const int lo = a.ph_lo, hi = a.ph_hi;
#define IN_(k) (lo <= (k) && (k) < hi)
#define SEAM_(k) do { if (IN_(k) && IN_((k) + 1)) xcd_barrier(bar); } while (0)
#define STAMP_(k) probe_stamp(F, (k))
    STAMP_(0); if (IN_(0)) { p0_prologue(F); } SEAM_(0);
    STAMP_(1); if (IN_(1)) { p1_inproj(F); } SEAM_(1);
    STAMP_(2); if (IN_(2)) { r1_states(F); } SEAM_(2);
    STAMP_(3); if (IN_(3)) { r2_scan(F); } SEAM_(3);
    STAMP_(4); if (IN_(4)) { r3_outputs(F); } SEAM_(4);
    STAMP_(5); if (IN_(5)) { p2_qkv(F, 1); } SEAM_(5);
    STAMP_(6); if (IN_(6)) { p3_attn_sample(F); } SEAM_(6);
    STAMP_(7); if (IN_(7)) { attn_sample_combine(F); p2_qkv(F, 0); } SEAM_(7);
    STAMP_(8); if (IN_(8)) { p3_attn_prompt(F); } SEAM_(8);
    STAMP_(9); if (IN_(9)) { p5_gemm(F, 5); if (F.vcu < 64) sk_merge(F, F.vcu); } SEAM_(9);
    STAMP_(10); if (IN_(10)) { p5_gemm(F, 6); if (F.vcu < 64) sk_out(F, F.vcu); } SEAM_(10);
    STAMP_(11); if (IN_(11)) { p5_gemm(F, 7); if (F.j >= 16) { for (int su = F.x * 16 + (F.j - 16); su < FF2 / 16; su += 128) sk_up(F, su); } } SEAM_(11);
    STAMP_(12); if (IN_(12)) { p8_conv(F); } SEAM_(12);
    STAMP_(13); if (IN_(13)) { p5_gemm(F, 9); if (F.vcu < 64) sk_down(F, F.vcu); }
    if (PROBE_LO >= 0) { __syncthreads(); STAMP_(14);
        if (blockIdx.x == 0 && F.tid == 0) { const unsigned long long t_end = __builtin_amdgcn_s_memrealtime() + (unsigned long long)PROBE_MULT * ((((unsigned long long)MISC[19] << 32) | MISC[18]) - (((unsigned long long)MISC[17] << 32) | MISC[16]));
            while (__builtin_amdgcn_s_memrealtime() < t_end) __builtin_amdgcn_s_sleep(8); } }
}

extern "C" void kernel_launch(void* const* d_in, const int* in_sizes, int n_in, void* d_out, int out_size, void* d_ws, size_t ws_size, hipStream_t stream) {
    static int ok = 0;
    if (ok == 0) {
        ok = 1;
        if (ws_size < 256 * MiB || n_in != 24) { fprintf(stderr, "kernel_launch: bad ws/n_in: %zu %d\n", ws_size, n_in); ok = -1; }
        int dev = 0, cus = 0; (void)hipGetDevice(&dev); (void)hipDeviceGetAttribute(&cus, hipDeviceAttributeMultiprocessorCount, dev);
        if (cus != 256) { fprintf(stderr, "kernel_launch: built for 256 CUs, got %d\n", cus); ok = -1; }
        if (hipFuncSetAttribute((const void*)mk, hipFuncAttributeMaxDynamicSharedMemorySize, LDS_BYTES) != hipSuccess) { fprintf(stderr, "kernel_launch: hipFuncSetAttribute(mk) failed\n"); ok = -1; }
        (void)hipGetLastError();
    }
    if (ok < 0) return;
    (void)hipMemsetAsync((char*)d_ws + WS_CTL, 0, CTL_BYTES, stream);
    MArgs a{}; for (int i = 0; i < 24; ++i) a.in[i] = (const float*)d_in[i]; a.out = (float*)d_out; a.ws = (unsigned char*)d_ws; a.ph_lo = 0; a.ph_hi = 14; a.li = 0;
    hipLaunchKernelGGL(mk, dim3(256), dim3(NTHR), LDS_BYTES, stream, a);
}
```

```cpp
#include <hip/hip_runtime.h>
#include <stdint.h>
#include <cstdio>

typedef unsigned short bf16_t;
typedef short bf16x8 __attribute__((ext_vector_type(8)));
typedef float f32x4 __attribute__((ext_vector_type(4)));
typedef float f32x2 __attribute__((ext_vector_type(2)));
typedef unsigned u32x4 __attribute__((ext_vector_type(4)));
typedef unsigned u32x2 __attribute__((ext_vector_type(2)));

constexpr int D_MODEL = 1024, BATCH = 2, SEQ = 8192, DEC_BATCH = 8, DEC_SEQ = 16, PAST = 2048;
constexpr int MP = BATCH * SEQ, MS = DEC_BATCH * DEC_SEQ, MT = MP + MS;
constexpr int MPAD = 16640;
constexpr int Q_LORA = 768, KV_LORA = 512, QK_NOPE = 128, QK_ROPE = 64, V_HEAD = 128, HEADS = 8;
constexpr int RET_H = 4, RET_DK = 128, RET_DV = 256;
constexpr int D_FF = 2816, FF2 = 2 * D_FF;
constexpr int IN_W = 6464;
constexpr int SKEYS = PAST + DEC_SEQ;
constexpr int LROWS = DEC_BATCH * SKEYS;
constexpr float EPS = 1e-6f;
constexpr int C_QLAT = 0, C_KVLAT = 768, C_KPE = 1280, C_RQ = 1344, C_RK = 1856, C_RV = 2368, C_RG = 3392, C_GA = 4416, C_GB = 5440;

constexpr size_t O_YP = 0, O_YS = 16777216, O_LATP = 16908288, O_RKP = 25296896, O_RETP = 26345472, O_CONVP = 26607616,
                 O_LATS = 26630144, O_RKS = 26695680, O_RETS = 26703872, O_CONVS = 27752448;

constexpr size_t MiB = 1u << 20, KiB = 1024;
constexpr size_t WS_CTL = 0, CTL_BYTES = 64 * KiB, WS_SSQS = 64 * KiB;
constexpr size_t WS_SLOTQ = 1 * MiB, WS_SLOTKV = 2 * MiB, WS_SLOTX1 = 3 * MiB;
constexpr size_t WS_TAB32 = 4 * MiB + 256 * KiB, WS_TAB64 = 6 * MiB + 256 * KiB;
constexpr size_t WS_FWUP = 10 * MiB + 512 * KiB, WS_FWDOWN = 21 * MiB + 512 * KiB, WS_FWIN = 27 * MiB, WS_FWQUP = 40 * MiB, WS_FWKVUP = 43 * MiB,
                 WS_FWOBA = 45 * MiB, WS_FWOBB = 47 * MiB, WS_FWOUT = 49 * MiB;
constexpr size_t WS_XN = 51 * MiB, WS_RET = 51 * MiB;
constexpr size_t WS_LATS = 83 * MiB + 512 * KiB, WS_PES = 99 * MiB + 768 * KiB, WS_ZQ = 102 * MiB, WS_KVL = 126 * MiB + 512 * KiB, WS_KPE = 142 * MiB + 768 * KiB;
constexpr size_t WS_RQ = 145 * MiB, WS_RK = 161 * MiB + 256 * KiB, WS_RV = 177 * MiB + 512 * KiB, WS_RG = 210 * MiB;
constexpr size_t WS_KN = 145 * MiB, WS_V = 177 * MiB + 512 * KiB, WS_ATTS = 242 * MiB + 512 * KiB, WS_XN2 = 210 * MiB, WS_ATT = 102 * MiB;
constexpr size_t WS_T1 = 166 * MiB + 512 * KiB, WS_MERGED = 134 * MiB;
constexpr size_t WS_GAS = 246 * MiB, WS_GBS = 247 * MiB;
constexpr size_t WS_X1B = 223 * MiB + 512 * KiB, WS_U = 27 * MiB, WS_HALO = 206 * MiB;

__device__ __forceinline__ bf16_t f2bf(float f) { unsigned u = __float_as_uint(f); u = (u + 0x7fffu + ((u >> 16) & 1u)) >> 16; return (bf16_t)u; }
__device__ __forceinline__ float bf2f(bf16_t b) { return __uint_as_float(((unsigned)b) << 16); }

#define LAS __attribute__((address_space(3)))
#define GAS __attribute__((address_space(1)))
constexpr int NTHR = 512;
constexpr int RING_BYTES = 131072, EPI_OFF = RING_BYTES, EPI_BYTES = 8192, LDS_BYTES = 163840, MISC_OFF = LDS_BYTES - 256;
constexpr int CW_BAR = 1024;

__device__ __forceinline__ unsigned cvt_pk_bf16(float lo, float hi) { unsigned r; asm volatile("v_cvt_pk_bf16_f32 %0, %1, %2" : "=v"(r) : "v"(lo), "v"(hi)); return r; }
__device__ __forceinline__ u32x4 pack8f(const f32x4& a, const f32x4& b) { u32x4 w; w.x = cvt_pk_bf16(a[0], a[1]); w.y = cvt_pk_bf16(a[2], a[3]); w.z = cvt_pk_bf16(b[0], b[1]); w.w = cvt_pk_bf16(b[2], b[3]); return w; }
__device__ __forceinline__ int row_pos(int row) { return row < MP ? (row & (SEQ - 1)) : PAST + ((row - MP) & (DEC_SEQ - 1)); }

#define XB_TMO      128
#define XB_XCNT(j)  (256  + 64 * (j))
#define XB_XSUB(j)  (1280 + 64 * (j))
#define XB_XGEN(j)  (2304 + 64 * (j))
#define XB_TOP      3328
#define XB_TOPGEN   3392
#define XCD_BAR_WORDS 3456
#define XB_SPIN_CAP (1u << 18)
__device__ __forceinline__ unsigned xb_ld(unsigned* p)              { return __hip_atomic_load(p, __ATOMIC_RELAXED, __HIP_MEMORY_SCOPE_AGENT); }
__device__ __forceinline__ unsigned xb_add(unsigned* p, unsigned v) { return __hip_atomic_fetch_add(p, v, __ATOMIC_RELAXED, __HIP_MEMORY_SCOPE_AGENT); }
__device__ __forceinline__ unsigned xb_xcc_id() { return (unsigned)__builtin_amdgcn_s_getreg((3 << 11) | 20) & 0xFu; }
#define XB_SPIN(cond, bar) do { unsigned _sp = 0; while (cond) { __builtin_amdgcn_s_sleep(1); \
    if ((++_sp & 255u) == 0u) { if (xb_ld(&(bar)[XB_TMO])) break; if (_sp > XB_SPIN_CAP) { atomicAdd(&(bar)[XB_TMO], 1u); break; } } } } while (0)
struct XcdBarrier { unsigned* bar; unsigned x; volatile LAS unsigned* st; };
__device__ __forceinline__ XcdBarrier xcd_barrier_post(unsigned* bar, volatile LAS unsigned* st) {
    XcdBarrier b; b.bar = bar; b.x = xb_xcc_id(); b.st = st;
    if (threadIdx.x == 0) (void)xb_add(&bar[XB_XCNT(b.x)], 1u);
    return b;
}
__device__ __forceinline__ void xcd_barrier_complete(unsigned* bar, unsigned x, unsigned& nloc, unsigned& nx) {
    const unsigned G = gridDim.x * gridDim.y * gridDim.z;
    unsigned sum, cnt, mine, sp = 0u;
    for (;;) {
        sum = 0u; cnt = 0u; mine = 0u;
#pragma unroll
        for (unsigned j = 0; j < 16; ++j) { const unsigned c = xb_ld(&bar[XB_XCNT(j)]); sum += c; cnt += (c > 0u) ? 1u : 0u; mine = (j == x) ? c : mine; }
        if (sum == G) break;
        __builtin_amdgcn_s_sleep(1);
        if ((++sp & 255u) == 0u) { if (xb_ld(&bar[XB_TMO])) break; if (sp > XB_SPIN_CAP) { atomicAdd(&bar[XB_TMO], 1u); break; } }
    }
    nloc = mine > 0u ? mine : 1u; nx = cnt > 0u ? cnt : 1u;
}
__device__ __forceinline__ void xcd_barrier(const XcdBarrier& b) {
    asm volatile("s_waitcnt vmcnt(0)" ::: "memory");
    __syncthreads();
    if (threadIdx.x == 0) {
        unsigned* bar = b.bar;
        __builtin_amdgcn_s_waitcnt(0);
        unsigned nloc = b.st[0], nx = b.st[1];
        if (nloc == 0u) { xcd_barrier_complete(bar, b.x, nloc, nx); b.st[0] = nloc; b.st[1] = nx; }
        const unsigned old = xb_add(&bar[XB_XSUB(b.x)], 1u);
        const unsigned gen = old / nloc;
        if (old + 1u == (gen + 1u) * nloc) {
            __builtin_amdgcn_fence(__ATOMIC_RELEASE, "agent");
            asm volatile("s_waitcnt vmcnt(0)" ::: "memory");
            const unsigned og = xb_add(&bar[XB_TOP], 1u);
            const unsigned tg = og / nx;
            if (og + 1u == (tg + 1u) * nx) xb_add(&bar[XB_TOPGEN], 1u);
            else XB_SPIN(xb_ld(&bar[XB_TOPGEN]) == tg, bar);
            __builtin_amdgcn_fence(__ATOMIC_ACQUIRE, "agent");
            xb_add(&bar[XB_XGEN(b.x)], 1u);
            asm volatile("s_waitcnt vmcnt(0)" ::: "memory");
        } else {
            XB_SPIN(xb_ld(&bar[XB_XGEN(b.x)]) == gen, bar);
            __builtin_amdgcn_fence(__ATOMIC_ACQUIRE, "agent");
            asm volatile("s_waitcnt vmcnt(0)" ::: "memory");
        }
    }
    __syncthreads();
}

namespace pg {
constexpr int BK = 64, HALF = 128, HTB = HALF * BK * 2;
__host__ __device__ __forceinline__ int lds_byte(int r, int c) { const int st = (r >> 4) * 2 + (c >> 5), rr = r & 15, cc = c & 31, ob = rr * 64 + cc * 2; return st * 1024 + (ob ^ (((ob >> 9) & 1) << 5)); }
__host__ __device__ __forceinline__ void stage_rc(int b, int& R, int& C) { const int st = b / 1024, sb = b % 1024, swz = sb ^ (((sb >> 9) & 1) << 5); R = (st >> 1) * 16 + swz / 64; C = (st & 1) * 32 + (swz % 64) / 2; }
__host__ __device__ __forceinline__ int perm32(int rho) { const int n = rho >> 4, i = rho & 15; return 8 * (i >> 2) + 4 * n + (i & 3); }
struct UnitG { const char* A; const char* B; unsigned lda, ldb; int nt; int pm, pn, kind; int half; };
typedef f32x4 Acc[2][2][4][2];

template <class Sched, class Epi>
__device__ __forceinline__ void gemm_stream(LAS unsigned char* lds, const Sched& S, const Epi& E) {
    const int tid = threadIdx.x, wid = __builtin_amdgcn_readfirstlane(tid >> 6), lane = tid & 63, wr = wid >> 2, wc = wid & 3, fr = lane & 15, fq = lane >> 4;
    unsigned Rr[2], Cc[2];
#pragma unroll
    for (int i = 0; i < 2; ++i) { int R, C; stage_rc(tid * 16 + i * 8192, R, C); Rr[i] = (unsigned)R; Cc[i] = (unsigned)C * 2u; }
    const unsigned ldsw = (unsigned)wid * 1024u;
    const int aoff = lds_byte(wr * 64 + fr, fq * 8), boff = lds_byte(wc * 32 + fr, fq * 8);
#define PG_SA(b, h) (((b) * 2 + (h)) * HTB)
#define PG_SB(b, h) ((4 + (b) * 2 + (h)) * HTB)
#define PG_STAGE(bufoff, gbase, ld) do { _Pragma("unroll") for (int _i = 0; _i < 2; ++_i) \
        __builtin_amdgcn_global_load_lds((const unsigned*)((const char*)(gbase) + (size_t)(Rr[_i] * (ld) + Cc[_i])), (LAS unsigned*)(lds + (bufoff) + ldsw + _i * 8192), 16, 0, 0); } while (0)
#define PG_LDA(dst, b, h) do { _Pragma("unroll") for (int m = 0; m < 4; ++m) _Pragma("unroll") for (int k = 0; k < 2; ++k) dst[m][k] = *(const LAS bf16x8*)(lds + PG_SA(b, h) + aoff + m * 2048 + k * 1024); } while (0)
#define PG_LDB(dst, b, h) do { _Pragma("unroll") for (int n = 0; n < 2; ++n) _Pragma("unroll") for (int k = 0; k < 2; ++k) dst[n][k] = *(const LAS bf16x8*)(lds + PG_SB(b, h) + boff + n * 2048 + k * 1024); } while (0)
#define PG_MMA(ai, bj, At, Bt) do { __builtin_amdgcn_s_setprio(1); _Pragma("unroll") for (int m = 0; m < 4; ++m) _Pragma("unroll") for (int n = 0; n < 2; ++n) _Pragma("unroll") for (int k = 0; k < 2; ++k) \
        acc[ai][bj][m][n] = __builtin_amdgcn_mfma_f32_16x16x32_bf16(Bt[n][k], At[m][k], acc[ai][bj][m][n], 0, 0, 0); __builtin_amdgcn_s_setprio(0); } while (0)
#define PG_WAIT_V(n) asm volatile("s_waitcnt vmcnt(" #n ")" ::: "memory")
#define PG_WAIT_L(n) asm volatile("s_waitcnt lgkmcnt(" #n ")" ::: "memory")
#define PG_BAR __builtin_amdgcn_s_barrier()
#define PG_SCHED __builtin_amdgcn_sched_barrier(0)
    UnitG cur, nxt; int ui = 0;
    if (!S.next(0, cur)) return;
    Acc acc;
#pragma unroll
    for (int a = 0; a < 2; ++a)
#pragma unroll
        for (int b = 0; b < 2; ++b)
#pragma unroll
            for (int m = 0; m < 4; ++m)
#pragma unroll
                for (int n = 0; n < 2; ++n) acc[a][b][m][n] = (f32x4){0.f, 0.f, 0.f, 0.f};
    bf16x8 At[4][2], B0[2][2], B1[2][2];
    const char* cA = cur.A; const char* cB = cur.B; unsigned clda = cur.lda, cldb = cur.ldb;
    PG_STAGE(PG_SB(0, 0), cB, cldb); PG_STAGE(PG_SB(0, 1), cB + (size_t)HALF * cldb, cldb); PG_STAGE(PG_SA(0, 0), cA, clda); PG_STAGE(PG_SA(0, 1), cA + (size_t)HALF * clda, clda);
    if (wr == 1) PG_BAR;
    PG_WAIT_V(2); PG_BAR;
    PG_STAGE(PG_SB(1, 0), cB + 128, cldb); PG_STAGE(PG_SA(1, 0), cA + 128, clda); PG_STAGE(PG_SB(1, 1), cB + (size_t)HALF * cldb + 128, cldb);
    PG_WAIT_V(6); PG_BAR;
    for (;;) {
        const bool has_next = S.next(ui + 1, nxt);
        const char* nA = has_next ? nxt.A : cA; const char* nB = has_next ? nxt.B : cB;
        const unsigned nlda = has_next ? nxt.lda : clda, nldb = has_next ? nxt.ldb : cldb;
        const int nt = cur.nt; const bool chalf = cur.half != 0;
        for (int t = 0; t < nt; t += 2) {
            const bool last = (t == nt - 2);
            const char* a1 = cA + (size_t)(t + 1) * 128;
            const char* a2 = last ? nA : cA + (size_t)(t + 2) * 128; const char* b2 = last ? nB : cB + (size_t)(t + 2) * 128;
            const unsigned lda2 = last ? nlda : clda, ldb2 = last ? nldb : cldb;
            const char* a3 = a2 + 128; const char* b3 = b2 + 128;
            PG_LDB(B0, 0, 0); PG_LDB(B1, 0, 1); PG_SCHED; PG_LDA(At, 0, 0); PG_STAGE(PG_SA(1, 1), a1 + (size_t)HALF * clda, clda);
            PG_WAIT_V(8); PG_WAIT_L(0); PG_BAR; PG_MMA(0, 0, At, B0); PG_MMA(0, 1, At, B1); PG_BAR; PG_SCHED;
            PG_LDA(At, 0, 1); PG_STAGE(PG_SB(0, 0), b2, ldb2); PG_STAGE(PG_SB(0, 1), b2 + (size_t)HALF * ldb2, ldb2); PG_STAGE(PG_SA(0, 0), a2, lda2);
            PG_WAIT_V(8); PG_WAIT_L(0); PG_BAR; if (!chalf) { PG_MMA(1, 0, At, B0); PG_MMA(1, 1, At, B1); } PG_BAR; PG_SCHED;
            PG_LDB(B0, 1, 0); PG_LDB(B1, 1, 1); PG_SCHED; PG_LDA(At, 1, 0); PG_STAGE(PG_SA(0, 1), a2 + (size_t)HALF * lda2, lda2);
            PG_WAIT_V(8); PG_WAIT_L(0); PG_BAR; PG_MMA(0, 0, At, B0); PG_MMA(0, 1, At, B1); PG_BAR; PG_SCHED;
            PG_LDA(At, 1, 1); PG_STAGE(PG_SB(1, 0), b3, ldb2); PG_STAGE(PG_SB(1, 1), b3 + (size_t)HALF * ldb2, ldb2); PG_STAGE(PG_SA(1, 0), a3, lda2);
            PG_WAIT_V(8); PG_WAIT_L(0); PG_BAR; if (!chalf) { PG_MMA(1, 0, At, B0); PG_MMA(1, 1, At, B1); } PG_BAR; PG_SCHED;
        }
        if (wr == 0) PG_BAR;
        E(acc, cur, lds, wr, wc, fr, fq);
        if (!has_next) break;
#pragma unroll
        for (int a = 0; a < 2; ++a)
#pragma unroll
            for (int b = 0; b < 2; ++b)
#pragma unroll
                for (int m = 0; m < 4; ++m)
#pragma unroll
                    for (int n = 0; n < 2; ++n) acc[a][b][m][n] = (f32x4){0.f, 0.f, 0.f, 0.f};
        cur = nxt; cA = nA; cB = nB; clda = nlda; cldb = nldb; ++ui;
        if (wr == 1) PG_BAR;
    }
    PG_WAIT_V(0);
    PG_BAR;
#undef PG_SA
#undef PG_SB
#undef PG_STAGE
#undef PG_LDA
#undef PG_LDB
#undef PG_MMA
#undef PG_WAIT_V
#undef PG_WAIT_L
#undef PG_BAR
#undef PG_SCHED
}
}

struct MArgs { const float* in[24]; float* out; unsigned char* ws; int ph_lo, ph_hi, li, pad; };
struct Frame {
    LAS unsigned char* lds; int tid, lane, wave; int x, j, vcu, G;
    const MArgs* a; float* out; unsigned char* ws;
};
#define FIN(k) (F.a->in[k])
__device__ __forceinline__ float fwave_sum(float v) {
#pragma unroll
    for (int o = 1; o < 64; o <<= 1) v += __shfl_xor(v, o);
    return v;
}

#ifndef PROBE_LO
#define PROBE_LO -1
#define PROBE_HI -1
#define PROBE_MULT 1
#endif
__device__ __forceinline__ void probe_stamp(Frame& F, int k) {
    if (PROBE_LO >= 0 && blockIdx.x == 0 && F.tid == 0) { volatile LAS unsigned* M = (volatile LAS unsigned*)(F.lds + MISC_OFF); const unsigned long long t_ = __builtin_amdgcn_s_memrealtime();
        if (k == PROBE_LO) { M[16] = (unsigned)t_; M[17] = (unsigned)(t_ >> 32); } if (k == PROBE_HI) { M[18] = (unsigned)t_; M[19] = (unsigned)(t_ >> 32); } }
}
enum { W_IN = 0, W_QUP, W_KVUP, W_OBA, W_OBB, W_OUT, W_UP, W_DOWN };
__device__ __forceinline__ int win_src(int gd) {
    const int tile = gd >> 3, g = gd & 7, bj = g >> 2, wc = g & 3;
    if (tile < 3) return C_QLAT + gd * 32;
    if (tile < 5) return C_KVLAT + (gd - 24) * 32;
    if (tile == 5) return (wc == 0) ? C_KPE + bj * 32 : -1;
    if (tile < 10) { const int base = tile < 8 ? C_RQ : C_RK, tl = tile < 8 ? tile - 6 : tile - 8; const int head = 2 * tl + (wc >> 1); return base + head * 128 + bj * 64 + (wc & 1) * 32; }
    if (tile < 14) return C_RV + (gd - 80) * 32;
    if (tile < 18) return C_RG + (gd - 112) * 32;
    if (tile < 22) return C_GA + (gd - 144) * 32;
    return C_GB + (gd - 176) * 32;
}
__device__ __forceinline__ int w_src_col(int wid, int row) {
    const int rho = row & 31, s = row & 255, wc = (s >> 5) & 3, t = row >> 8;
    const int n = rho >> 4, i = rho & 15; return t * 192 + 128 + 16 * wc + i + 32 * n;
}
__device__ __forceinline__ int w_group_base(int wid, int gd) {
    const int g = gd & 7, bj = g >> 2, wc = g & 3, t = gd >> 3;
    switch (wid) {
    case W_IN: return win_src(gd);
    case W_QUP: return bj == 0 ? t * 192 + 32 * wc : (wc < 2 ? -2 : -1);
    case W_KVUP: return t * 256 + 128 * bj + 32 * wc;
    case W_UP: return (bj ? D_FF : 0) + 128 * t + 32 * wc;
    default: return gd * 32;
    }
}
struct WItemRegs { f32x4 v[8]; float g[8]; };
__device__ __forceinline__ void p0_item_load(WItemRegs& R, const float* __restrict__ W, int ldw, const float* __restrict__ gain, int base, int kb, int lane) {
    const int k0 = kb * 64, c = lane & 7;
    if (base >= 0) {
#pragma unroll
        for (int i = 0; i < 8; ++i) { const int kk = (lane >> 3) + 8 * i; R.g[i] = gain ? gain[k0 + kk] : 1.f; R.v[i] = *(const f32x4*)(W + (size_t)(k0 + kk) * ldw + base + 4 * c); } }
}
__device__ __forceinline__ void p0_item_finish(const WItemRegs& R, const float* __restrict__ W, int ldw, int K, const float* __restrict__ gain, int wid, int base, bf16_t* __restrict__ Wt, int gd, int kb, LAS float* scr, int lane) {
    const int k0 = kb * 64, c = lane & 7;
    bf16_t* dst = Wt + (size_t)(gd * 32) * K + k0;
    if (base == -1) {
#pragma unroll
        for (int jj = 0; jj < 4; ++jj) { const int n = (lane >> 3) + 8 * jj; *(u32x4*)(dst + (size_t)n * K + 8 * c) = (u32x4){0u, 0u, 0u, 0u}; }
        return;
    }
    if (base >= 0) {
#pragma unroll
        for (int i = 0; i < 8; ++i) { const int kk = (lane >> 3) + 8 * i; LAS float* d = scr + kk * 33 + 4 * c; const float g = R.g[i]; d[0] = R.v[i][0] * g; d[1] = R.v[i][1] * g; d[2] = R.v[i][2] * g; d[3] = R.v[i][3] * g; }
    } else {
        const int sc = w_src_col(wid, gd * 32 + (lane & 31));
#pragma unroll 8
        for (int i = 0; i < 32; ++i) { const int kk = 2 * i + (lane >> 5); const float g = gain ? gain[k0 + kk] : 1.f; scr[kk * 33 + (lane & 31)] = W[(size_t)(k0 + kk) * ldw + sc] * g; }
    }
    asm volatile("s_waitcnt lgkmcnt(0)" ::: "memory");
#pragma unroll
    for (int jj = 0; jj < 4; ++jj) { const int n = (lane >> 3) + 8 * jj; const LAS float* s = scr + (8 * c) * 33 + (base >= 0 ? pg::perm32(n) : n);
        u32x4 o; o.x = cvt_pk_bf16(s[0 * 33], s[1 * 33]); o.y = cvt_pk_bf16(s[2 * 33], s[3 * 33]); o.z = cvt_pk_bf16(s[4 * 33], s[5 * 33]); o.w = cvt_pk_bf16(s[6 * 33], s[7 * 33]);
        *(u32x4*)(dst + (size_t)n * K + 8 * c) = o; }
    asm volatile("s_waitcnt lgkmcnt(0)" ::: "memory");
}
struct WDesc { const float* W; const float* gain; int ldw, K, wid, ngroups, local; size_t off; };
__device__ __forceinline__ bool w_decode(Frame& F, int it, WDesc& d) {
    if (it < 3328) { d = WDesc{FIN(7), FIN(6), IN_W, 1024, W_IN, 208, it, WS_FWIN}; return true; } it -= 3328;
    if (it < 768) { d = WDesc{FIN(9), FIN(8), 1536, 768, W_QUP, 64, it, WS_FWQUP}; return true; } it -= 768;
    if (it < 512) { d = WDesc{FIN(13), nullptr, 2048, 512, W_KVUP, 64, it, WS_FWKVUP}; return true; } it -= 512;
    if (it < 512) { d = WDesc{FIN(17), nullptr, 1024, 1024, W_OBA, 32, it, WS_FWOBA}; return true; } it -= 512;
    if (it < 512) { d = WDesc{FIN(17) + (size_t)1024 * 1024, nullptr, 1024, 1024, W_OBB, 32, it, WS_FWOBB}; return true; } it -= 512;
    if (it < 512) { d = WDesc{FIN(18), nullptr, 1024, 1024, W_OUT, 32, it, WS_FWOUT}; return true; } it -= 512;
    if (it < 2816) { d = WDesc{FIN(20), FIN(19), FF2, 1024, W_UP, 176, it, WS_FWUP}; return true; } it -= 2816;
    if (it < 1408) { d = WDesc{FIN(23), nullptr, 1024, D_FF, W_DOWN, 32, it, WS_FWDOWN}; return true; }
    return false;
}
__device__ __forceinline__ void p0_all_weights(Frame& F, LAS float* scr, int gw, int NGW) {
    for (int it = gw; it < 10368; it += 2 * NGW) {
        WDesc dA, dB; w_decode(F, it, dA); const bool hasB = w_decode(F, it + NGW, dB);
        const int gdA = dA.local % dA.ngroups, kbA = dA.local / dA.ngroups, baseA = w_group_base(dA.wid, gdA);
        const int gdB = hasB ? dB.local % dB.ngroups : 0, kbB = hasB ? dB.local / dB.ngroups : 0, baseB = hasB ? w_group_base(dB.wid, gdB) : -1;
        WItemRegs RA, RB;
        p0_item_load(RA, dA.W, dA.ldw, dA.gain, baseA, kbA, F.lane);
        if (hasB) p0_item_load(RB, dB.W, dB.ldw, dB.gain, baseB, kbB, F.lane);
        p0_item_finish(RA, dA.W, dA.ldw, dA.K, dA.gain, dA.wid, baseA, (bf16_t*)(F.ws + dA.off), gdA, kbA, scr, F.lane);
        if (hasB) p0_item_finish(RB, dB.W, dB.ldw, dB.K, dB.gain, dB.wid, baseB, (bf16_t*)(F.ws + dB.off), gdB, kbB, scr, F.lane);
    }
}
__device__ __forceinline__ float2 rope_cs(int pos, double f) {
    const double t = (double)pos * f * 0.15915494309189535; const float rev = (float)(t - rint(t));
    return make_float2(__builtin_amdgcn_cosf(rev), __builtin_amdgcn_sinf(rev));
}
__device__ __forceinline__ void p0_prologue(Frame& F) {
    LAS float* scr = (LAS float*)(F.lds + F.wave * 16384);
    const int gw = F.vcu * 8 + F.wave, NGW = F.G * 8;
    if (F.vcu == 0 && F.tid < 128) ((float*)(F.ws + WS_SSQS))[F.tid] = 0.f;
    probe_stamp(F, 20);
    p0_all_weights(F, scr, gw, NGW);
    probe_stamp(F, 21);
    {   bf16_t* XN = (bf16_t*)(F.ws + WS_XN);
        for (int r = gw; r < MPAD; r += 2 * NGW) {
            const int r2 = r + NGW; f32x4 v[2][4];
#pragma unroll
            for (int q = 0; q < 2; ++q) { const int rr = q ? r2 : r; if (rr < MT) { const float* x = rr < MP ? FIN(0) + (size_t)rr * D_MODEL : FIN(1) + (size_t)(rr - MP) * D_MODEL; const f32x4* xr = (const f32x4*)x + F.lane;
#pragma unroll
                    for (int jj = 0; jj < 4; ++jj) v[q][jj] = xr[64 * jj]; } else {
#pragma unroll
                    for (int jj = 0; jj < 4; ++jj) v[q][jj] = (f32x4){0.f, 0.f, 0.f, 0.f}; } }
#pragma unroll
            for (int q = 0; q < 2; ++q) { const int rr = q ? r2 : r; if (rr >= MPAD) continue; float s = 0.f;
#pragma unroll
                for (int jj = 0; jj < 4; ++jj) s += (v[q][jj][0] * v[q][jj][0] + v[q][jj][1] * v[q][jj][1]) + (v[q][jj][2] * v[q][jj][2] + v[q][jj][3] * v[q][jj][3]);
                const float inv = rsqrtf(fwave_sum(s) * (1.f / D_MODEL) + EPS); u32x2* o8 = (u32x2*)(XN + (size_t)rr * D_MODEL) + F.lane;
#pragma unroll
                for (int jj = 0; jj < 4; ++jj) { u32x2 w; w.x = cvt_pk_bf16(v[q][jj][0] * inv, v[q][jj][1] * inv); w.y = cvt_pk_bf16(v[q][jj][2] * inv, v[q][jj][3] * inv); o8[64 * jj] = w; } }
        } }
    probe_stamp(F, 22);
    {   bf16_t* lats = (bf16_t*)(F.ws + WS_LATS); bf16_t* pes = (bf16_t*)(F.ws + WS_PES);
        const int gt = F.vcu * NTHR + F.tid, NG = F.G * NTHR;
        for (int i0 = gt; i0 < DEC_BATCH * PAST * (KV_LORA / 4); i0 += 4 * NG) { f32x4 v[4];
#pragma unroll
            for (int q = 0; q < 4; ++q) v[q] = *((const f32x4*)FIN(2) + i0 + q * NG);
#pragma unroll
            for (int q = 0; q < 4; ++q) { const int i = i0 + q * NG, c4 = i % (KV_LORA / 4), rj = i / (KV_LORA / 4), jr = rj % PAST, b = rj / PAST; u32x2 w; w.x = cvt_pk_bf16(v[q][0], v[q][1]); w.y = cvt_pk_bf16(v[q][2], v[q][3]);
                *(u32x2*)(lats + ((size_t)b * SKEYS + jr) * KV_LORA + c4 * 4) = w; } }
        for (int i = gt; i < DEC_BATCH * PAST * (QK_ROPE / 4); i += NG) { const int c4 = i % (QK_ROPE / 4), rj = i / (QK_ROPE / 4), jr = rj % PAST, b = rj / PAST;
            const f32x4 v = *((const f32x4*)FIN(3) + i); u32x2 w; w.x = cvt_pk_bf16(v[0], v[1]); w.y = cvt_pk_bf16(v[2], v[3]);
            *(u32x2*)(pes + ((size_t)b * SKEYS + jr) * QK_ROPE + c4 * 4) = w; }
        probe_stamp(F, 23);
        float2* tab32 = (float2*)(F.ws + WS_TAB32); float2* tab64 = (float2*)(F.ws + WS_TAB64);
        {   const int k64 = gt & 63, k32 = gt & 31;
            const double f64 = exp2(-(double)k64 * (13.287712379549449 / 64.0)), f32 = exp2(-(double)k32 * (13.287712379549449 / 32.0));
            for (int i = gt; i < 8192 * 64; i += NG) { tab64[i] = rope_cs(i >> 6, f64); if (i < 8192 * 32) tab32[i] = rope_cs(i >> 5, f32); } } }
}

__device__ __forceinline__ bool reg_unit(int x, int j, int i, int nN, int& pm, int& pn) { const int u = j + 32 * i; if (u >= 8 * nN) return false; pm = 8 * x + (u & 7); pn = u >> 3; return true; }
#define LDS_F(off) ((LAS float*)(lds + EPI_OFF) + (off))

enum { K_QLAT = 0, K_KVLAT, K_KPE, K_RQ, K_RK, K_RV, K_RG, K_GS, K_QUP, K_KVP, K_KVS, K_GA, K_AD, K_GB, K_RD, K_OUT, K_UP, K_DOWN };
struct SchedP1 {
    int x, j; const char* ws;
    __device__ __forceinline__ bool next(int i, pg::UnitG& u) const {
        int pm, pn;
        if (!reg_unit(x, j, i, 18, pm, pn)) { if (i == 4 && j >= 16) { const int k = (j - 16) * 8 + x; if (k >= 26) return false; pm = 64; pn = k; } else return false; }
        u.pm = pm; u.pn = pn; u.A = ws + WS_XN + (size_t)pm * 256 * 2048; u.B = ws + WS_FWIN + (size_t)pn * 256 * 2048; u.lda = 2048; u.ldb = 2048; u.nt = 16; u.half = pm == 64;
        u.kind = pn < 3 ? K_QLAT : pn < 5 ? K_KVLAT : pn == 5 ? K_KPE : pn < 8 ? K_RQ : pn < 10 ? K_RK : pn < 14 ? K_RV : pn < 18 ? K_RG : K_GS;
        return true;
    }
};
struct EpiP1 {
    unsigned char* ws; float* out; const float *g_kvlat, *g_kr;
    __device__ __forceinline__ void operator()(const pg::Acc& acc, const pg::UnitG& u, LAS unsigned char* lds, int wr, int wc, int fr, int fq) const {
        bf16_t* const ZQ = (bf16_t*)(ws + WS_ZQ); bf16_t* const KVL = (bf16_t*)(ws + WS_KVL); bf16_t* const KPE = (bf16_t*)(ws + WS_KPE); bf16_t* const PES = (bf16_t*)(ws + WS_PES); bf16_t* const LATS = (bf16_t*)(ws + WS_LATS);
        bf16_t* const RQ = (bf16_t*)(ws + WS_RQ); bf16_t* const RK = (bf16_t*)(ws + WS_RK); bf16_t* const RV = (bf16_t*)(ws + WS_RV); bf16_t* const RG = (bf16_t*)(ws + WS_RG);
        float* const slotq = (float*)(ws + WS_SLOTQ); float* const slotkv = (float*)(ws + WS_SLOTKV);
        const float2* const tab32 = (const float2*)(ws + WS_TAB32); const float2* const tab64 = (const float2*)(ws + WS_TAB64);
        int rl0 = wr * 64 + fr, cw = wc * 32 + fq * 8; asm volatile("" : "+v"(rl0), "+v"(cw));
        const int kind = u.kind, rb = u.pm * 256 + rl0;
        if (kind == K_QLAT || kind == K_KVLAT) {
            const int t = kind == K_QLAT ? u.pn : u.pn - 3; const int ld = kind == K_QLAT ? Q_LORA : KV_LORA; bf16_t* dst = kind == K_QLAT ? ZQ : KVL;
            f32x4 g[2][2];
#pragma unroll
            for (int bj = 0; bj < 2; ++bj)
#pragma unroll
                for (int n = 0; n < 2; ++n) g[bj][n] = kind == K_KVLAT ? *(const f32x4*)(g_kvlat + t * 256 + bj * 128 + cw + 4 * n) : (f32x4){1.f, 1.f, 1.f, 1.f};
#pragma unroll
            for (int ai = 0; ai < 2; ++ai)
#pragma unroll
                for (int m = 0; m < 4; ++m) { const int row = rb + ai * 128 + m * 16; float ss = 0.f;
                    const bool snew = (kind == K_KVLAT) && row >= MP && row < MT;
                    const int rs = row - MP; bf16_t* lrow = LATS + ((size_t)(rs / DEC_SEQ) * SKEYS + PAST + (rs % DEC_SEQ)) * KV_LORA;
#pragma unroll
                    for (int bj = 0; bj < 2; ++bj) { const f32x4 v0 = acc[ai][bj][m][0], v1 = acc[ai][bj][m][1];
                        ss += (v0[0] * v0[0] + v0[1] * v0[1]) + (v0[2] * v0[2] + v0[3] * v0[3]) + (v1[0] * v1[0] + v1[1] * v1[1]) + (v1[2] * v1[2] + v1[3] * v1[3]);
                        const u32x4 w = pack8f(v0 * g[bj][0], v1 * g[bj][1]);
                        *(u32x4*)(dst + (size_t)row * ld + t * 256 + bj * 128 + cw) = w;
                        if (snew) *(u32x4*)(lrow + t * 256 + bj * 128 + cw) = w; }
                    ss += __shfl_xor(ss, 16); ss += __shfl_xor(ss, 32);
                    if (fq == 0) { if (kind == K_QLAT) slotq[(size_t)row * 12 + t * 4 + wc] = ss; else slotkv[(size_t)row * 8 + t * 4 + wc] = ss; } }
        } else if (kind == K_KPE) {
            if (wc != 0) return;
            const int d0 = fq * 8;
            f32x4 g1[2], g2[2];
#pragma unroll
            for (int n = 0; n < 2; ++n) { g1[n] = *(const f32x4*)(g_kr + d0 + 4 * n); g2[n] = *(const f32x4*)(g_kr + 32 + d0 + 4 * n); }
#pragma unroll
            for (int ai = 0; ai < 2; ++ai)
#pragma unroll
                for (int m = 0; m < 4; ++m) { const int row = rb + ai * 128 + m * 16; const int pos = row_pos(row < MT ? row : 0);
                    f32x4 x1[2], x2[2]; float ss = 0.f;
#pragma unroll
                    for (int n = 0; n < 2; ++n) { x1[n] = acc[ai][0][m][n]; x2[n] = acc[ai][1][m][n];
                        ss += (x1[n][0] * x1[n][0] + x1[n][1] * x1[n][1]) + (x1[n][2] * x1[n][2] + x1[n][3] * x1[n][3]) + (x2[n][0] * x2[n][0] + x2[n][1] * x2[n][1]) + (x2[n][2] * x2[n][2] + x2[n][3] * x2[n][3]); }
                    ss += __shfl_xor(ss, 16); ss += __shfl_xor(ss, 32);
                    const float inv = rsqrtf(ss * (1.f / 64.f) + EPS);
                    f32x4 o1[2], o2[2];
#pragma unroll
                    for (int n = 0; n < 2; ++n) { const f32x4 y1 = x1[n] * inv * g1[n], y2 = x2[n] * inv * g2[n];
                        const f32x4 cs0 = *(const f32x4*)(tab32 + pos * 32 + d0 + 4 * n), cs1 = *(const f32x4*)(tab32 + pos * 32 + d0 + 4 * n + 2);
                        const f32x4 c = {cs0[0], cs0[2], cs1[0], cs1[2]}, s = {cs0[1], cs0[3], cs1[1], cs1[3]};
                        o1[n] = y1 * c - y2 * s; o2[n] = y1 * s + y2 * c; }
                    *(u32x4*)(KPE + (size_t)row * 64 + d0) = pack8f(o1[0], o1[1]); *(u32x4*)(KPE + (size_t)row * 64 + 32 + d0) = pack8f(o2[0], o2[1]);
                    if (row < MT) {
                        float* o = row < MP ? out + O_RKP + (size_t)row * 64 : out + O_RKS + (size_t)(row - MP) * 64;
                        *(f32x4*)(o + d0) = o1[0]; *(f32x4*)(o + d0 + 4) = o1[1]; *(f32x4*)(o + 32 + d0) = o2[0]; *(f32x4*)(o + 32 + d0 + 4) = o2[1];
                        if (row >= MP) { const int rs = row - MP, b = rs / DEC_SEQ, tt = rs % DEC_SEQ; bf16_t* p = PES + ((size_t)b * SKEYS + PAST + tt) * 64;
                            *(u32x4*)(p + d0) = pack8f(o1[0], o1[1]); *(u32x4*)(p + 32 + d0) = pack8f(o2[0], o2[1]); } } }
        } else if (kind == K_RQ || kind == K_RK) {
            const int tl = kind == K_RQ ? u.pn - 6 : u.pn - 8; const int head = 2 * tl + (wc >> 1), i0 = 32 * (wc & 1) + fq * 8;
            bf16_t* dst = kind == K_RQ ? RQ : RK; const float sc = kind == K_RQ ? 1.0f : 0.08838834764831845f;
#pragma unroll
            for (int ai = 0; ai < 2; ++ai)
#pragma unroll
                for (int m = 0; m < 4; ++m) { const int row = rb + ai * 128 + m * 16; const int pos = row_pos(row < MT ? row : 0);
                    f32x4 o1[2], o2[2];
#pragma unroll
                    for (int n = 0; n < 2; ++n) { const f32x4 x1 = acc[ai][0][m][n], x2 = acc[ai][1][m][n];
                        const f32x4 cs0 = *(const f32x4*)(tab64 + pos * 64 + i0 + 4 * n), cs1 = *(const f32x4*)(tab64 + pos * 64 + i0 + 4 * n + 2);
                        const f32x4 c = {cs0[0], cs0[2], cs1[0], cs1[2]}, s = {cs0[1], cs0[3], cs1[1], cs1[3]};
                        o1[n] = (x1 * c - x2 * s) * sc; o2[n] = (x1 * s + x2 * c) * sc; }
                    *(u32x4*)(dst + (size_t)row * 512 + head * 128 + i0) = pack8f(o1[0], o1[1]); *(u32x4*)(dst + (size_t)row * 512 + head * 128 + 64 + i0) = pack8f(o2[0], o2[1]); }
        } else if (kind == K_GS) {
            bf16_t* dst = (bf16_t*)(ws + (u.pn < 22 ? WS_GAS : WS_GBS)); const int t = u.pn < 22 ? u.pn - 18 : u.pn - 22;
#pragma unroll
            for (int m = 0; m < 4; ++m) { const int rl = rl0 + m * 16;
#pragma unroll
                for (int bj = 0; bj < 2; ++bj) { f32x4 v0 = acc[0][bj][m][0], v1 = acc[0][bj][m][1];
#pragma unroll
                    for (int e = 0; e < 4; ++e) { v0[e] = 1.f / (1.f + __expf(-v0[e])); v1[e] = 1.f / (1.f + __expf(-v1[e])); }
                    *(u32x4*)(dst + (size_t)rl * 1024 + t * 256 + bj * 128 + cw) = pack8f(v0, v1); } }
        } else {
            const int t = kind == K_RV ? u.pn - 10 : u.pn - 14; bf16_t* dst = kind == K_RV ? RV : RG;
#pragma unroll
            for (int ai = 0; ai < 2; ++ai)
#pragma unroll
                for (int m = 0; m < 4; ++m) { const int row = rb + ai * 128 + m * 16;
#pragma unroll
                    for (int bj = 0; bj < 2; ++bj) { f32x4 v0 = acc[ai][bj][m][0], v1 = acc[ai][bj][m][1];
                        if (kind == K_RG) {
#pragma unroll
                            for (int e = 0; e < 4; ++e) { v0[e] = v0[e] / (1.f + __expf(-v0[e])); v1[e] = v1[e] / (1.f + __expf(-v1[e])); } }
                        *(u32x4*)(dst + (size_t)row * 1024 + t * 256 + bj * 128 + cw) = pack8f(v0, v1); } }
        }
    }
};
__device__ __forceinline__ void p1_inproj(Frame& F) {
    SchedP1 S{F.x, F.j, (const char*)F.ws};
    EpiP1 E{F.ws, F.out, FIN(12), FIN(15)};
    pg::gemm_stream(F.lds, S, E);
}

__device__ __forceinline__ float slot_rs(const float* slots, int n, float invn) {
    float a = 0.f; for (int i = 0; i < n; i += 4) { const f32x4 v = *(const f32x4*)(slots + i); a += (v[0] + v[1]) + (v[2] + v[3]); } return rsqrtf(a * invn + EPS);
}
struct SchedP2 {
    int x, j; const char* ws; int sample;
    __device__ __forceinline__ bool next(int i, pg::UnitG& u) const {
        int pm, pn, kind;
        if (sample) {
            if (i < 2) { reg_unit(x, j, i, 8, pm, pn); kind = K_QUP; }
            else if (i < 4) { reg_unit(x, j, i - 2, 8, pm, pn); kind = K_KVS; }
            else if (i == 4 && j < 2) { const int k = j * 8 + x; pm = 64; pn = k & 7; kind = k < 8 ? K_QUP : K_KVS; }
            else return false;
        } else { if (i >= 2) return false; reg_unit(x, j, i, 8, pm, pn); kind = K_KVP; }
        u.pm = pm; u.pn = pn; u.kind = kind; u.half = pm == 64;
        if (kind == K_QUP) { u.A = ws + WS_ZQ + (size_t)pm * 256 * 1536; u.lda = 1536; u.B = ws + WS_FWQUP + (size_t)pn * 256 * 1536; u.ldb = 1536; u.nt = 12; }
        else { u.A = ws + (kind == K_KVS ? WS_LATS : WS_KVL) + (size_t)pm * 256 * 1024; u.lda = 1024; u.B = ws + WS_FWKVUP + (size_t)pn * 256 * 1024; u.ldb = 1024; u.nt = 8; }
        return true;
    }
};
struct EpiP2 {
    unsigned char* ws; float* out; const float *g_qn, *g_qr, *g_kn;
    __device__ __forceinline__ void operator()(const pg::Acc& acc, const pg::UnitG& u, LAS unsigned char* lds, int wr, int wc, int fr, int fq) const {
        int rl0 = wr * 64 + fr, cw = wc * 32 + fq * 8; asm volatile("" : "+v"(rl0), "+v"(cw));
        const int kind = u.kind, h = u.pn, rb = u.pm * 256 + rl0;
        const float* const slotq = (const float*)(ws + WS_SLOTQ); const float* const slotkv = (const float*)(ws + WS_SLOTKV);
        float rs[2][4];
#pragma unroll
        for (int ai = 0; ai < 2; ++ai)
#pragma unroll
            for (int m = 0; m < 4; ++m) { const int row = rb + ai * 128 + m * 16;
                if (kind == K_QUP) rs[ai][m] = slot_rs(slotq + (size_t)row * 12, 12, 1.f / Q_LORA);
                else if (kind == K_KVP) rs[ai][m] = slot_rs(slotkv + (size_t)row * 8, 8, 1.f / KV_LORA);
                else { const int b = row / SKEYS, jj = row - b * SKEYS; rs[ai][m] = (row < LROWS && jj >= PAST) ? slot_rs(slotkv + (size_t)(MP + b * DEC_SEQ + jj - PAST) * 8, 8, 1.f / KV_LORA) : 1.f; } }
#pragma unroll
        for (int ai = 0; ai < 2; ++ai)
#pragma unroll
            for (int m = 0; m < 4; ++m) { float p0 = 0.f, p1 = 0.f; const float s2 = rs[ai][m] * rs[ai][m];
#pragma unroll
                for (int n = 0; n < 2; ++n) { const f32x4 a = acc[ai][0][m][n], b = acc[ai][1][m][n];
                    p0 += (a[0] * a[0] + a[1] * a[1]) + (a[2] * a[2] + a[3] * a[3]); p1 += (b[0] * b[0] + b[1] * b[1]) + (b[2] * b[2] + b[3] * b[3]); }
                p0 += __shfl_xor(p0, 16); p0 += __shfl_xor(p0, 32); p1 += __shfl_xor(p1, 16); p1 += __shfl_xor(p1, 32);
                if (fq == 0) { LAS float* d = LDS_F((rl0 + ai * 128 + m * 16) * 8 + wc * 2); d[0] = p0 * s2; d[1] = p1 * s2; } }
        asm volatile("s_waitcnt lgkmcnt(0)" ::: "memory"); __builtin_amdgcn_s_barrier(); asm volatile("" ::: "memory");
        if (kind == K_QUP) {
            bf16_t* const Q = (bf16_t*)out;
            const float2* const tab32 = (const float2*)(ws + WS_TAB32);
            const float C2 = 0.07216878364870323f * 1.4426950408889634f;
            f32x4 gn[2]; gn[0] = *(const f32x4*)(g_qn + cw); gn[1] = *(const f32x4*)(g_qn + cw + 4);
            const int ir = 16 * (wc & 1) + 4 * fq; const f32x4 gr1 = *(const f32x4*)(g_qr + ir), gr2 = *(const f32x4*)(g_qr + 32 + ir);
#pragma unroll
            for (int ai = 0; ai < 2; ++ai)
#pragma unroll
                for (int m = 0; m < 4; ++m) { const int row = rb + ai * 128 + m * 16; const int pos = row_pos(row < MT ? row : 0);
                    const LAS float* d = LDS_F((rl0 + ai * 128 + m * 16) * 8); const f32x4 e0 = *(const LAS f32x4*)d, e1 = *(const LAS f32x4*)(d + 4);
                    const float inn = rsqrtf((e0[0] + e0[2] + e1[0] + e1[2]) * (1.f / 128.f) + EPS) * rs[ai][m] * C2, inr = rsqrtf((e0[1] + e0[3]) * (1.f / 64.f) + EPS) * rs[ai][m];
                    bf16_t* qrow = Q + (size_t)row * 1536 + h * 192;
                    *(u32x4*)(qrow + cw) = pack8f(acc[ai][0][m][0] * inn * gn[0], acc[ai][0][m][1] * inn * gn[1]);
                    if (wc < 2) { const f32x4 y1 = acc[ai][1][m][0] * inr * gr1, y2 = acc[ai][1][m][1] * inr * gr2;
                        const f32x4 cs0 = *(const f32x4*)(tab32 + pos * 32 + ir), cs1 = *(const f32x4*)(tab32 + pos * 32 + ir + 2);
                        const f32x4 c = {cs0[0], cs0[2], cs1[0], cs1[2]}, s = {cs0[1], cs0[3], cs1[1], cs1[3]};
                        const f32x4 o1 = (y1 * c - y2 * s) * C2, o2 = (y1 * s + y2 * c) * C2;
                        u32x2 w1, w2; w1.x = cvt_pk_bf16(o1[0], o1[1]); w1.y = cvt_pk_bf16(o1[2], o1[3]); w2.x = cvt_pk_bf16(o2[0], o2[1]); w2.y = cvt_pk_bf16(o2[2], o2[3]);
                        *(u32x2*)(qrow + 128 + ir) = w1; *(u32x2*)(qrow + 160 + ir) = w2; } }
        } else {
            bf16_t* const KN = (bf16_t*)(ws + WS_KN); bf16_t* const V = (bf16_t*)(ws + WS_V);
            f32x4 gk[2]; gk[0] = *(const f32x4*)(g_kn + cw); gk[1] = *(const f32x4*)(g_kn + cw + 4);
#pragma unroll
            for (int ai = 0; ai < 2; ++ai)
#pragma unroll
                for (int m = 0; m < 4; ++m) { const int row = rb + ai * 128 + m * 16;
                    const LAS float* d = LDS_F((rl0 + ai * 128 + m * 16) * 8); const f32x4 e0 = *(const LAS f32x4*)d, e1 = *(const LAS f32x4*)(d + 4);
                    const float s = rs[ai][m], inn = rsqrtf((e0[0] + e0[2] + e1[0] + e1[2]) * (1.f / 128.f) + EPS) * s;
                    *(u32x4*)(KN + (size_t)row * 1024 + h * 128 + cw) = pack8f(acc[ai][0][m][0] * inn * gk[0], acc[ai][0][m][1] * inn * gk[1]);
                    *(u32x4*)(V + (size_t)row * 1024 + h * 128 + cw) = pack8f(acc[ai][1][m][0] * s, acc[ai][1][m][1] * s); }
        }
    }
};
__device__ __forceinline__ void p2_qkv(Frame& F, int sample) {
    SchedP2 S{F.x, F.j, (const char*)F.ws, sample};
    EpiP2 E{F.ws, F.out, FIN(10), FIN(11), FIN(14)};
    pg::gemm_stream(F.lds, S, E);
}

struct SchedP5 {
    int x, j, vcu; const char* ws; int phase;
    __device__ __forceinline__ const char* arow(size_t base, size_t base_s, int pm, size_t rowbytes) const { return ws + (pm < 64 ? base + (size_t)pm * 256 * rowbytes : base_s); }
    __device__ __forceinline__ bool next(int i, pg::UnitG& u) const {
        int pm, pn;
        if (phase == 5) {
            int sub;
            if (i < 4) { sub = i; pm = 8 * x + (j & 7); pn = j >> 3; } else return false;
            u.pm = pm; u.pn = pn; u.kind = K_GA + sub; u.lda = 2048; u.ldb = 2048; u.nt = 16; u.half = pm == 64;
            if (sub == 0) { u.A = ws + WS_XN2 + (size_t)pm * 256 * 2048; u.B = ws + WS_FWIN + (size_t)(18 + pn) * 256 * 2048; }
            else if (sub == 1) { u.A = arow(WS_ATT, WS_ATTS, pm, 2048); u.B = ws + WS_FWOBA + (size_t)pn * 256 * 2048; }
            else if (sub == 2) { u.A = ws + WS_XN2 + (size_t)pm * 256 * 2048; u.B = ws + WS_FWIN + (size_t)(22 + pn) * 256 * 2048; }
            else { u.A = ws + WS_RET + (size_t)pm * 256 * 2048; u.B = ws + WS_FWOBB + (size_t)pn * 256 * 2048; }
            return true;
        }
        if (phase == 6 || phase == 9) {
            if (i == 0) { pm = 8 * x + (j & 7); pn = j >> 3; } else return false;
            u.pm = pm; u.pn = pn; u.half = pm == 64;
            if (phase == 6) { u.kind = K_OUT; u.A = ws + WS_MERGED + (size_t)pm * 256 * 2048; u.lda = 2048; u.B = ws + WS_FWOUT + (size_t)pn * 256 * 2048; u.ldb = 2048; u.nt = 16; }
            else { u.kind = K_DOWN; u.A = ws + WS_U + (size_t)pm * 256 * (FF2 * 2); u.lda = FF2 * 2; u.B = ws + WS_FWDOWN + (size_t)pn * 256 * (D_FF * 2); u.ldb = D_FF * 2; u.nt = 44; }
            return true;
        }
        if (!reg_unit(x, j, i, 22, pm, pn)) return false;
        u.half = pm == 64; u.pm = pm; u.pn = pn; u.kind = K_UP; u.A = ws + WS_X1B + (size_t)pm * 256 * 2048; u.lda = 2048; u.B = ws + WS_FWUP + (size_t)pn * 256 * 2048; u.ldb = 2048; u.nt = 16;
        return true;
    }
};
struct EpiP5 {
    unsigned char* ws; float* out; const float* xp; const float* xs; int vcu;
    __device__ __forceinline__ void operator()(pg::Acc& acc, const pg::UnitG& u, LAS unsigned char* lds, int wr, int wc, int fr, int fq) const {
        int rl0 = wr * 64 + fr, cw = wc * 32 + fq * 8; asm volatile("" : "+v"(rl0), "+v"(cw));
        const int kind = u.kind, rb = u.pm * 256 + rl0;
        if (kind >= K_GA && kind <= K_RD) {
            bf16_t* const T1 = (bf16_t*)(ws + WS_T1) + (size_t)vcu * 65536; bf16_t* const T2 = (bf16_t*)out + (size_t)vcu * 65536;
            bf16_t* const MG = (bf16_t*)(ws + WS_MERGED);
#pragma unroll
            for (int ai = 0; ai < 2; ++ai)
#pragma unroll
                for (int m = 0; m < 4; ++m)
#pragma unroll
                    for (int bj = 0; bj < 2; ++bj) { const size_t so = (size_t)(rl0 + ai * 128 + m * 16) * 256 + bj * 128 + cw;
                        f32x4 v0 = acc[ai][bj][m][0], v1 = acc[ai][bj][m][1];
                        if (kind == K_GA || kind == K_GB) {
#pragma unroll
                            for (int e = 0; e < 4; ++e) { v0[e] = 1.f / (1.f + __expf(-v0[e])); v1[e] = 1.f / (1.f + __expf(-v1[e])); }
                            *(u32x4*)((kind == K_GA ? T1 : T2) + so) = pack8f(v0, v1);
                        } else if (kind == K_AD) {
                            const u32x4 t = u.pm == 64 ? *(const u32x4*)((const bf16_t*)(ws + WS_GAS) + (size_t)(rl0 + ai * 128 + m * 16) * 1024 + u.pn * 256 + bj * 128 + cw) : *(const u32x4*)(T1 + so);
                            const f32x4 g0 = {__uint_as_float(t.x << 16), __uint_as_float(t.x & 0xffff0000u), __uint_as_float(t.y << 16), __uint_as_float(t.y & 0xffff0000u)};
                            const f32x4 g1 = {__uint_as_float(t.z << 16), __uint_as_float(t.z & 0xffff0000u), __uint_as_float(t.w << 16), __uint_as_float(t.w & 0xffff0000u)};
                            *(u32x4*)(T1 + so) = pack8f(v0 * g0, v1 * g1);
                        } else {
                            const u32x4 t = *(const u32x4*)(T1 + so), q = u.pm == 64 ? *(const u32x4*)((const bf16_t*)(ws + WS_GBS) + (size_t)(rl0 + ai * 128 + m * 16) * 1024 + u.pn * 256 + bj * 128 + cw) : *(const u32x4*)(T2 + so);
                            const f32x4 a0 = {__uint_as_float(t.x << 16), __uint_as_float(t.x & 0xffff0000u), __uint_as_float(t.y << 16), __uint_as_float(t.y & 0xffff0000u)};
                            const f32x4 a1 = {__uint_as_float(t.z << 16), __uint_as_float(t.z & 0xffff0000u), __uint_as_float(t.w << 16), __uint_as_float(t.w & 0xffff0000u)};
                            const f32x4 g0 = {__uint_as_float(q.x << 16), __uint_as_float(q.x & 0xffff0000u), __uint_as_float(q.y << 16), __uint_as_float(q.y & 0xffff0000u)};
                            const f32x4 g1 = {__uint_as_float(q.z << 16), __uint_as_float(q.z & 0xffff0000u), __uint_as_float(q.w << 16), __uint_as_float(q.w & 0xffff0000u)};
                            *(u32x4*)(MG + (size_t)(rb + ai * 128 + m * 16) * 1024 + u.pn * 256 + bj * 128 + cw) = pack8f(a0 + v0 * g0, a1 + v1 * g1);
                        }
                        if (bj == 1 && (m & 1)) asm volatile("" ::: "memory"); }
        } else if (kind == K_OUT) {
            float* const slotx = (float*)(ws + WS_SLOTX1); bf16_t* const X1B = (bf16_t*)(ws + WS_X1B);
#pragma unroll
            for (int ai = 0; ai < 2; ++ai)
#pragma unroll
                for (int m = 0; m < 4; ++m) { const int row = rb + ai * 128 + m * 16; float ss = 0.f;
                    const float* xr = row < MP ? xp + (size_t)row * D_MODEL : xs + (size_t)((row < MT ? row : MP) - MP) * D_MODEL;
#pragma unroll
                    for (int bj = 0; bj < 2; ++bj) { const int c = u.pn * 256 + bj * 128 + cw;
                        const f32x4 x0 = *(const f32x4*)(xr + c), x1 = *(const f32x4*)(xr + c + 4);
                        const f32x4 v0 = acc[ai][bj][m][0] + x0, v1 = acc[ai][bj][m][1] + x1;
                        ss += (v0[0] * v0[0] + v0[1] * v0[1]) + (v0[2] * v0[2] + v0[3] * v0[3]) + (v1[0] * v1[0] + v1[1] * v1[1]) + (v1[2] * v1[2] + v1[3] * v1[3]);
                        if (row < MT) { *(f32x4*)(out + (size_t)row * D_MODEL + c) = v0; *(f32x4*)(out + (size_t)row * D_MODEL + c + 4) = v1; }
                        *(u32x4*)(X1B + (size_t)row * D_MODEL + c) = pack8f(v0, v1); }
                    ss += __shfl_xor(ss, 16); ss += __shfl_xor(ss, 32);
                    if (fq == 0) slotx[(size_t)row * 16 + u.pn * 4 + wc] = ss;
                    asm volatile("" ::: "memory"); }
        } else if (kind == K_UP) {
            const float* const slotx = (const float*)(ws + WS_SLOTX1); bf16_t* const U = (bf16_t*)(ws + WS_U);
#pragma unroll
            for (int ai = 0; ai < 2; ++ai)
#pragma unroll
                for (int m = 0; m < 4; ++m) { const int row = rb + ai * 128 + m * 16;
                    float a = 0.f;
#pragma unroll
                    for (int i = 0; i < 16; i += 4) { const f32x4 v = *(const f32x4*)(slotx + (size_t)row * 16 + i); a += (v[0] + v[1]) + (v[2] + v[3]); }
                    const float s = rsqrtf(a * (1.f / D_MODEL) + EPS);
                    const f32x4 ug0 = acc[ai][0][m][0] * s, ug1 = acc[ai][0][m][1] * s, uv0 = acc[ai][1][m][0] * s, uv1 = acc[ai][1][m][1] * s;
                    const u32x4 wg = pack8f(ug0, ug1), wv = pack8f(uv0, uv1); const int cg = u.pn * 128 + cw, cv = D_FF + cg;
                    *(u32x4*)(U + (size_t)row * FF2 + cg) = wg; *(u32x4*)(U + (size_t)row * FF2 + cv) = wv;
                    if ((row & 255) >= 254 && row < MP - 2) { bf16_t* hp = (bf16_t*)(ws + WS_HALO) + ((size_t)((row >> 8) + 1) * 2 + (row & 1)) * FF2; *(u32x4*)(hp + cg) = wg; *(u32x4*)(hp + cv) = wv; }
                    if (row < MT) { const int tpos = row < MP ? (row & (SEQ - 1)) - (SEQ - 2) : ((row - MP) & (DEC_SEQ - 1)) - (DEC_SEQ - 2);
                        if (tpos >= 0) { float* cp = row < MP ? out + O_CONVP + ((size_t)(row >> 13) * 2 + tpos) * FF2 : out + O_CONVS + ((size_t)((row - MP) >> 4) * 2 + tpos) * FF2;
                            *(f32x4*)(cp + cg) = ug0; *(f32x4*)(cp + cg + 4) = ug1; *(f32x4*)(cp + cv) = uv0; *(f32x4*)(cp + cv + 4) = uv1; } }
                    if (m & 1) asm volatile("" ::: "memory"); }
        } else {
#pragma unroll
            for (int ai = 0; ai < 2; ++ai)
#pragma unroll
                for (int m = 0; m < 4; ++m) { const int row = rb + ai * 128 + m * 16; if (row >= MT) continue;
#pragma unroll
                    for (int bj = 0; bj < 2; ++bj) { float* p = out + (size_t)row * D_MODEL + u.pn * 256 + bj * 128 + cw;
                        const f32x4 x0 = *(const f32x4*)p, x1 = *(const f32x4*)(p + 4);
                        *(f32x4*)p = x0 + acc[ai][bj][m][0]; *(f32x4*)(p + 4) = x1 + acc[ai][bj][m][1]; }
                    asm volatile("" ::: "memory"); }
        }
    }
};
__device__ __forceinline__ void p5_gemm(Frame& F, int phase) {
    SchedP5 S{F.x, F.j, F.vcu, (const char*)F.ws, phase};
    EpiP5 E{F.ws, F.out, FIN(0), FIN(1), F.vcu};
    pg::gemm_stream(F.lds, S, E);
}

namespace rt {
typedef short s16x4 __attribute__((ext_vector_type(4)));
constexpr int QST = 136, KDST = 144, VST = 272, PST = 72;
constexpr int Q_OFF = 0, QS_OFF = 17408, K_OFF = 34816, KD_OFF = 52224, V_OFF = 70656, P_OFF = 105472, ST_OFF = 114688, RG_OFF = 118784;
constexpr int SC_TOK = 256, NSC = SEQ / SC_TOK;
__device__ __forceinline__ s16x4 trrd(const LAS bf16_t* p) { return __builtin_bit_cast(s16x4, __builtin_amdgcn_ds_read_tr16_b64_v4i16((LAS s16x4*)p)); }
__device__ __forceinline__ bf16x8 cat8(s16x4 lo, s16x4 hi) { return (bf16x8){lo[0], lo[1], lo[2], lo[3], hi[0], hi[1], hi[2], hi[3]}; }
__device__ __forceinline__ u32x4 scale8(u32x4 w, float s) {
    u32x4 o;
    o.x = cvt_pk_bf16(__uint_as_float(w.x << 16) * s, __uint_as_float(w.x & 0xffff0000u) * s); o.y = cvt_pk_bf16(__uint_as_float(w.y << 16) * s, __uint_as_float(w.y & 0xffff0000u) * s);
    o.z = cvt_pk_bf16(__uint_as_float(w.z << 16) * s, __uint_as_float(w.z & 0xffff0000u) * s); o.w = cvt_pk_bf16(__uint_as_float(w.w << 16) * s, __uint_as_float(w.w & 0xffff0000u) * s);
    return o;
}
__device__ __forceinline__ float row16_sum(float v) {
    v += __builtin_bit_cast(float, __builtin_amdgcn_update_dpp(0, __builtin_bit_cast(int, v), 0xB1, 0xf, 0xf, true));
    v += __builtin_bit_cast(float, __builtin_amdgcn_update_dpp(0, __builtin_bit_cast(int, v), 0x4E, 0xf, 0xf, true));
    v += __builtin_bit_cast(float, __builtin_amdgcn_update_dpp(0, __builtin_bit_cast(int, v), 0x141, 0xf, 0xf, true));
    v += __builtin_bit_cast(float, __builtin_amdgcn_update_dpp(0, __builtin_bit_cast(int, v), 0x140, 0xf, 0xf, true));
    return v;
}
template <bool FULL>
__device__ __forceinline__ void ret_unit(Frame& F, int h, int row0, int nch, int L, const float* Sin, float* Sout, const float* g_ret) {
    LAS unsigned char* lds = F.lds;
    const int tid = F.tid, w = F.wave, l = F.lane, fr = l & 15, g = l >> 4, tq = fr >> 2, tp = fr & 3;
    const float lg2 = log2f(1.f - exp2f(-5.f - (float)h));
    const bf16_t* RQ = (const bf16_t*)(F.ws + WS_RQ); const bf16_t* RK = (const bf16_t*)(F.ws + WS_RK); const bf16_t* RV = (const bf16_t*)(F.ws + WS_RV);
    const bf16_t* RG = (const bf16_t*)(F.ws + WS_RG); bf16_t* RET = (bf16_t*)(F.ws + WS_RET);
    LAS bf16_t* q_l = (LAS bf16_t*)(lds + Q_OFF); LAS bf16_t* qs_l = (LAS bf16_t*)(lds + QS_OFF); LAS bf16_t* k_l = (LAS bf16_t*)(lds + K_OFF);
    LAS bf16_t* kd_l = (LAS bf16_t*)(lds + KD_OFF); LAS bf16_t* v_l = (LAS bf16_t*)(lds + V_OFF); LAS bf16_t* p_l = (LAS bf16_t*)(lds + P_OFF); LAS float* st_l = (LAS float*)(lds + ST_OFF);
    LAS bf16_t* g_l = (LAS bf16_t*)(lds + RG_OFF);
    f32x4 S[8][2];
#pragma unroll
    for (int db = 0; db < 8; ++db)
#pragma unroll
        for (int nb = 0; nb < 2; ++nb) {
            if (Sin) { int so = (16 * db + 4 * g) * RET_DV + 32 * w + 16 * nb + fr; asm volatile("" : "+v"(so));
#pragma unroll
                for (int r = 0; r < 4; ++r) S[db][nb][r] = Sin[so + r * RET_DV]; }
            else S[db][nb] = (f32x4){0.f, 0.f, 0.f, 0.f}; }
    const float gL = exp2f(lg2 * (float)L);
    float gr[2]; if (FULL) { gr[0] = g_ret[h * 256 + 32 * w + fr]; gr[1] = g_ret[h * 256 + 32 * w + 16 + fr]; }
    for (int c = 0; c < nch; ++c) {
        const size_t r0 = (size_t)row0 + (size_t)c * L;
        __syncthreads();
        {   u32x4 pk[2], pq[2], pv[4], pgt[4]; const u32x4 z_ = {0u, 0u, 0u, 0u};
#pragma unroll
            for (int it = 0; it < 2; ++it) { const int idx = tid + 512 * it, tok = idx >> 4, c8 = idx & 15; const bool ok = tok < L;
                pk[it] = ok ? *(const u32x4*)(RK + (r0 + tok) * 512 + h * 128 + c8 * 8) : z_; if (FULL) pq[it] = ok ? *(const u32x4*)(RQ + (r0 + tok) * 512 + h * 128 + c8 * 8) : z_; }
#pragma unroll
            for (int it = 0; it < 4; ++it) { const int idx = tid + 512 * it, tok = idx >> 5, c8 = idx & 31; const bool ok = tok < L;
                pv[it] = ok ? *(const u32x4*)(RV + (r0 + tok) * 1024 + h * 256 + c8 * 8) : z_; if (FULL) pgt[it] = ok ? *(const u32x4*)(RG + (r0 + tok) * 1024 + h * 256 + c8 * 8) : z_; }
#pragma unroll
            for (int it = 0; it < 2; ++it) { const int idx = tid + 512 * it, tok = idx >> 4, c8 = idx & 15;
                *(LAS u32x4*)(kd_l + tok * KDST + c8 * 8) = scale8(pk[it], exp2f(lg2 * (float)(L - 1 - tok)));
                if (FULL) { *(LAS u32x4*)(k_l + tok * QST + c8 * 8) = pk[it]; *(LAS u32x4*)(q_l + tok * QST + c8 * 8) = pq[it]; *(LAS u32x4*)(qs_l + tok * QST + c8 * 8) = scale8(pq[it], exp2f(lg2 * (float)(tok + 1))); } }
#pragma unroll
            for (int it = 0; it < 4; ++it) { const int idx = tid + 512 * it, tok = idx >> 5, c8 = idx & 31;
                *(LAS u32x4*)(v_l + tok * VST + c8 * 8) = pv[it]; if (FULL) *(LAS u32x4*)(g_l + tok * VST + c8 * 8) = pgt[it]; } }
        __syncthreads();
        f32x4 o[4][2];
        if (FULL) {
            const int ib = w >> 1, jb0 = 2 * (w & 1);
            f32x4 p0 = {0.f, 0.f, 0.f, 0.f}, p1 = {0.f, 0.f, 0.f, 0.f};
#pragma unroll
            for (int s = 0; s < 4; ++s) { const bf16x8 a = *(const LAS bf16x8*)(q_l + (16 * ib + fr) * QST + 32 * s + 8 * g);
                const bf16x8 b0 = *(const LAS bf16x8*)(k_l + (16 * jb0 + fr) * QST + 32 * s + 8 * g), b1 = *(const LAS bf16x8*)(k_l + (16 * jb0 + 16 + fr) * QST + 32 * s + 8 * g);
                p0 = __builtin_amdgcn_mfma_f32_16x16x32_bf16(a, b0, p0, 0, 0, 0); p1 = __builtin_amdgcn_mfma_f32_16x16x32_bf16(a, b1, p1, 0, 0, 0); }
#pragma unroll
            for (int r = 0; r < 4; ++r) { const int i = 16 * ib + 4 * g + r, j0 = 16 * jb0 + fr, j1 = j0 + 16;
                const float v0 = j0 <= i ? p0[r] * exp2f(lg2 * (float)(i - j0)) : 0.f, v1 = j1 <= i ? p1[r] * exp2f(lg2 * (float)(i - j1)) : 0.f;
                p_l[i * PST + j0] = f2bf(v0); p_l[i * PST + j1] = f2bf(v1); }
            __syncthreads();
#pragma unroll
            for (int i = 0; i < 4; ++i) { o[i][0] = (f32x4){0.f, 0.f, 0.f, 0.f}; o[i][1] = (f32x4){0.f, 0.f, 0.f, 0.f}; }
        }
        bf16x8 vf[2][2];
#pragma unroll
        for (int s = 0; s < 2; ++s)
#pragma unroll
            for (int nb = 0; nb < 2; ++nb) { const LAS bf16_t* pp = v_l + (32 * s + 8 * g + tq) * VST + 32 * w + 16 * nb + 4 * tp; vf[s][nb] = cat8(trrd(pp), trrd(pp + 4 * VST)); }
        if (FULL) {
#pragma unroll
            for (int i = 0; i < 4; ++i)
#pragma unroll
                for (int s = 0; s < 2; ++s) { const bf16x8 a = *(const LAS bf16x8*)(p_l + (16 * i + fr) * PST + 32 * s + 8 * g);
                    o[i][0] = __builtin_amdgcn_mfma_f32_16x16x32_bf16(a, vf[s][0], o[i][0], 0, 0, 0); o[i][1] = __builtin_amdgcn_mfma_f32_16x16x32_bf16(a, vf[s][1], o[i][1], 0, 0, 0); }
#pragma unroll
            for (int s = 0; s < 4; ++s) {
                bf16x8 bS[2];
#pragma unroll
                for (int nb = 0; nb < 2; ++nb) { u32x4 wv; wv.x = cvt_pk_bf16(S[2 * s][nb][0], S[2 * s][nb][1]); wv.y = cvt_pk_bf16(S[2 * s][nb][2], S[2 * s][nb][3]);
                    wv.z = cvt_pk_bf16(S[2 * s + 1][nb][0], S[2 * s + 1][nb][1]); wv.w = cvt_pk_bf16(S[2 * s + 1][nb][2], S[2 * s + 1][nb][3]); bS[nb] = __builtin_bit_cast(bf16x8, wv); }
#pragma unroll
                for (int i = 0; i < 4; ++i) { const LAS bf16_t* qp = qs_l + (16 * i + fr) * QST + 32 * s + 4 * g;
                    const s16x4 lo = *(const LAS s16x4*)qp, hi = *(const LAS s16x4*)(qp + 16); const bf16x8 a = cat8(lo, hi);
                    o[i][0] = __builtin_amdgcn_mfma_f32_16x16x32_bf16(a, bS[0], o[i][0], 0, 0, 0); o[i][1] = __builtin_amdgcn_mfma_f32_16x16x32_bf16(a, bS[1], o[i][1], 0, 0, 0); }
            }
        }
#pragma unroll
        for (int db = 0; db < 8; ++db) { S[db][0] = S[db][0] * gL; S[db][1] = S[db][1] * gL; }
#pragma unroll
        for (int s = 0; s < 2; ++s)
#pragma unroll
            for (int db = 0; db < 8; ++db) { const LAS bf16_t* pp = kd_l + (32 * s + 8 * g + tq) * KDST + 16 * db + 4 * tp; const bf16x8 a = cat8(trrd(pp), trrd(pp + 4 * KDST));
                S[db][0] = __builtin_amdgcn_mfma_f32_16x16x32_bf16(a, vf[s][0], S[db][0], 0, 0, 0); S[db][1] = __builtin_amdgcn_mfma_f32_16x16x32_bf16(a, vf[s][1], S[db][1], 0, 0, 0); }
        if (FULL) {
#pragma unroll
            for (int i = 0; i < 4; ++i)
#pragma unroll
                for (int r = 0; r < 4; ++r) { float sm = o[i][0][r] + o[i][1][r], sq = o[i][0][r] * o[i][0][r] + o[i][1][r] * o[i][1][r];
                    sm = row16_sum(sm); sq = row16_sum(sq);
                    if (fr == 0) { LAS float* d = st_l + ((16 * i + 4 * g + r) * 8 + w) * 2; d[0] = sm; d[1] = sq; } }
            __syncthreads();
#pragma unroll
            for (int i = 0; i < 4; ++i)
#pragma unroll
                for (int r = 0; r < 4; ++r) { const int tok = 16 * i + 4 * g + r;
                    const LAS f32x4* d = (const LAS f32x4*)(st_l + tok * 16); const f32x4 a0 = d[0], a1 = d[1], a2 = d[2], a3 = d[3];
                    const float sm = (a0[0] + a0[2]) + (a1[0] + a1[2]) + (a2[0] + a2[2]) + (a3[0] + a3[2]), sq = (a0[1] + a0[3]) + (a1[1] + a1[3]) + (a2[1] + a2[3]) + (a3[1] + a3[3]);
                    const float mu = sm * (1.f / 256.f), var = fmaxf(sq * (1.f / 256.f) - mu * mu, 0.f), rstd = rsqrtf(var + EPS);
#pragma unroll
                    for (int nb = 0; nb < 2; ++nb) { LAS bf16_t* ge = g_l + tok * VST + 32 * w + 16 * nb + fr; *ge = f2bf((o[i][nb][r] - mu) * rstd * gr[nb] * bf2f(*ge)); } }
            __syncthreads();
#pragma unroll
            for (int it = 0; it < 4; ++it) { const int idx = tid + 512 * it, tok = idx >> 5, c8 = idx & 31;
                if (tok < L) *(u32x4*)(RET + (r0 + tok) * 1024 + h * 256 + c8 * 8) = *(const LAS u32x4*)(g_l + tok * VST + c8 * 8); }
        }
    }
    if (Sout) {
#pragma unroll
        for (int db = 0; db < 8; ++db)
#pragma unroll
            for (int nb = 0; nb < 2; ++nb) { int so = (16 * db + 4 * g) * RET_DV + 32 * w + 16 * nb + fr; asm volatile("" : "+v"(so));
#pragma unroll
                for (int r = 0; r < 4; ++r) Sout[so + r * RET_DV] = S[db][nb][r]; }
    }
}
}
__device__ __forceinline__ void r1_states(Frame& F) {
    const int bh = F.vcu >> 5, sc = F.vcu & 31, b = bh >> 2, h = bh & 3;
    rt::ret_unit<false>(F, h, b * SEQ + sc * rt::SC_TOK, 4, 64, nullptr, F.out + ((size_t)bh * rt::NSC + sc) * 32768, nullptr);
}
__device__ __forceinline__ void r2_scan(Frame& F) {
    float* U = F.out; const int gt = F.vcu * NTHR + F.tid;
    for (int e = gt; e < 8 * 32768; e += F.G * NTHR) { const int bh = e >> 15, idx = e & 32767, h = bh & 3;
        const float g256 = exp2f(log2f(1.f - exp2f(-5.f - (float)h)) * 256.f);
        float u[32];
#pragma unroll
        for (int sc = 0; sc < 32; ++sc) u[sc] = U[((size_t)bh * 32 + sc) * 32768 + idx];
        float carry = 0.f;
#pragma unroll
        for (int sc = 0; sc < 32; ++sc) { U[((size_t)bh * 32 + sc) * 32768 + idx] = carry; carry = g256 * carry + u[sc]; }
        F.out[O_RETP + (size_t)bh * 32768 + idx] = carry; }
}
__device__ __forceinline__ void r3_outputs(Frame& F) {
    const int bh = F.vcu >> 5, sc = F.vcu & 31, b = bh >> 2, h = bh & 3;
    rt::ret_unit<true>(F, h, b * SEQ + sc * rt::SC_TOK, 4, 64, F.out + ((size_t)bh * rt::NSC + sc) * 32768, nullptr, FIN(16));
    if (F.vcu < DEC_BATCH * RET_H) { const int sb = F.vcu >> 2, sh = F.vcu & 3;
        rt::ret_unit<true>(F, sh, MP + sb * DEC_SEQ, 1, DEC_SEQ, FIN(4) + (size_t)F.vcu * 32768, F.out + O_RETS + (size_t)F.vcu * 32768, FIN(16)); }
}

namespace at {
typedef float f32x16 __attribute__((ext_vector_type(16)));
typedef short s16x4 __attribute__((ext_vector_type(4)));
constexpr int KN_ST = 272, KP_ST = 144;
constexpr int KN_B = 64 * KN_ST, KP_B = 64 * KP_ST, V_B = 16384, BUF_B = KN_B + KP_B + V_B;
constexpr int SCR_OFF = 2 * BUF_B;
constexpr float THR = 8.f;
__device__ __forceinline__ int v_st(int k, int c) { const int kk = (k & ~0xC) | ((k & 4) << 1) | ((k & 8) >> 1); return ((kk >> 3) * 4 + (c >> 5)) * 512 + ((kk & 7) * 32 + (c & 31)) * 2; }
__device__ __forceinline__ int v_rd_base(int lane) { return ((lane & 3) << 3) | (((lane >> 2) & 3) << 6) | (((lane >> 4) & 1) << 5) | (((lane >> 5) & 1) << 8); }
constexpr int v_rd_off(int d0, int ks, int half) { return d0 * 512 + ks * 4096 + half * 2048; }
__device__ __forceinline__ int crow(int r, int hi) { return (r & 3) + 8 * (r >> 2) + 4 * hi; }
#define AT_SBAR() __builtin_amdgcn_sched_barrier(0)

__device__ __forceinline__ void qkt(f32x16& p0, f32x16& p1, const LAS unsigned char* kn, const LAS unsigned char* kp, const bf16x8* qr) {
    p0 = f32x16{}; p1 = f32x16{};
#pragma unroll
    for (int d0 = 0; d0 < 8; ++d0) { const bf16x8 a0 = *(const LAS bf16x8*)(kn + d0 * 32), a1 = *(const LAS bf16x8*)(kn + d0 * 32 + 32 * KN_ST);
        p0 = __builtin_amdgcn_mfma_f32_32x32x16_bf16(a0, qr[d0], p0, 0, 0, 0); p1 = __builtin_amdgcn_mfma_f32_32x32x16_bf16(a1, qr[d0], p1, 0, 0, 0); }
#pragma unroll
    for (int d0 = 0; d0 < 4; ++d0) { const bf16x8 a0 = *(const LAS bf16x8*)(kp + d0 * 32), a1 = *(const LAS bf16x8*)(kp + d0 * 32 + 32 * KP_ST);
        p0 = __builtin_amdgcn_mfma_f32_32x32x16_bf16(a0, qr[8 + d0], p0, 0, 0, 0); p1 = __builtin_amdgcn_mfma_f32_32x32x16_bf16(a1, qr[8 + d0], p1, 0, 0, 0); }
}
__device__ __forceinline__ void pv_tile(f32x16* o, int vb0, bf16x8 pa0, bf16x8 pa1, bf16x8 pa2, bf16x8 pa3) {
#define AT_TRRD(dst, off) asm volatile("ds_read_b64_tr_b16 %0, %1 offset:%2" : "=&v"(dst) : "v"(vb0), "i"(off) : "memory")
#define AT_PV_D0(d0) do { s16x4 l0, l1, l2, l3, h0, h1, h2, h3; constexpr int b_ = v_rd_off(d0, 0, 0);   \
        AT_TRRD(l0, b_); AT_TRRD(h0, b_ + 2048); AT_TRRD(l1, b_ + 4096); AT_TRRD(h1, b_ + 6144); AT_TRRD(l2, b_ + 8192); AT_TRRD(h2, b_ + 10240); AT_TRRD(l3, b_ + 12288); AT_TRRD(h3, b_ + 14336); \
        asm volatile("s_waitcnt lgkmcnt(0)" ::: "memory"); AT_SBAR();   \
        o[d0] = __builtin_amdgcn_mfma_f32_32x32x16_bf16(pa0, (bf16x8){l0[0], l0[1], l0[2], l0[3], h0[0], h0[1], h0[2], h0[3]}, o[d0], 0, 0, 0);   \
        o[d0] = __builtin_amdgcn_mfma_f32_32x32x16_bf16(pa1, (bf16x8){l1[0], l1[1], l1[2], l1[3], h1[0], h1[1], h1[2], h1[3]}, o[d0], 0, 0, 0);   \
        o[d0] = __builtin_amdgcn_mfma_f32_32x32x16_bf16(pa2, (bf16x8){l2[0], l2[1], l2[2], l2[3], h2[0], h2[1], h2[2], h2[3]}, o[d0], 0, 0, 0);   \
        o[d0] = __builtin_amdgcn_mfma_f32_32x32x16_bf16(pa3, (bf16x8){l3[0], l3[1], l3[2], l3[3], h3[0], h3[1], h3[2], h3[3]}, o[d0], 0, 0, 0); } while (0)
    AT_PV_D0(0); AT_PV_D0(1); AT_PV_D0(2); AT_PV_D0(3);
#undef AT_PV_D0
#undef AT_TRRD
}
template <bool PARTIAL>
__device__ __forceinline__ void attn_unit(LAS unsigned char* lds, const bf16_t* Qw, const bf16_t* KN, const bf16_t* KPE, const bf16_t* V, bf16_t* Ow, float* Pw, int NT, int tmax_w, int nkeys, int orows, int t0, int tstride) {
    const int tid = threadIdx.x, wid = __builtin_amdgcn_readfirstlane(tid >> 6), lane = tid & 63, r32 = lane & 31, hi = lane >> 5;
    bf16x8 qr[12];
#pragma unroll
    for (int d0 = 0; d0 < 12; ++d0) qr[d0] = *(const bf16x8*)(Qw + (size_t)r32 * 1536 + d0 * 16 + hi * 8);
    const int sr = tid >> 4, sc = (tid & 15) * 8, pr = tid >> 3, pc = (tid & 7) * 8;
    const int kn_w0 = sr * KN_ST + sc * 2, kn_w1 = (32 + sr) * KN_ST + sc * 2, kp_w = KN_B + pr * KP_ST + pc * 2, v_w0 = KN_B + KP_B + v_st(sr, sc), v_w1 = KN_B + KP_B + v_st(32 + sr, sc);
    const int kn_r = r32 * KN_ST + hi * 16, kp_r = KN_B + r32 * KP_ST + hi * 16;
    const int vb_base = (int)(unsigned)(uintptr_t)(lds + KN_B + KP_B) + v_rd_base(lane);
    LAS float* scr = (LAS float*)(lds + SCR_OFF) + wid * 64;
    float m_reg = -1e30f, l_reg = 0.f; f32x16 o[4] = {};
    u32x4 st_kn0, st_kn1, st_kp, st_v0, st_v1;
#define AT_LOAD(t) do { const size_t k0_ = (size_t)(t0 + (t) * tstride) * 64; const bool v0_ = (int)k0_ + sr < nkeys, v1_ = (int)k0_ + 32 + sr < nkeys, vp_ = (int)k0_ + pr < nkeys; const u32x4 z_ = {0u, 0u, 0u, 0u}; \
        st_kn0 = v0_ ? *(const u32x4*)(KN + (k0_ + sr) * 1024 + sc) : z_; st_kn1 = v1_ ? *(const u32x4*)(KN + (k0_ + 32 + sr) * 1024 + sc) : z_; \
        st_v0 = v0_ ? *(const u32x4*)(V + (k0_ + sr) * 1024 + sc) : z_; st_v1 = v1_ ? *(const u32x4*)(V + (k0_ + 32 + sr) * 1024 + sc) : z_; \
        st_kp = vp_ ? *(const u32x4*)(KPE + (k0_ + pr) * 64 + pc) : z_; } while (0)
#define AT_WRITE(bf) do { LAS unsigned char* b_ = lds + (bf) * BUF_B; *(LAS u32x4*)(b_ + kn_w0) = st_kn0; *(LAS u32x4*)(b_ + kn_w1) = st_kn1; *(LAS u32x4*)(b_ + kp_w) = st_kp; \
        *(LAS u32x4*)(b_ + v_w0) = st_v0; *(LAS u32x4*)(b_ + v_w1) = st_v1; } while (0)
    AT_LOAD(0); AT_WRITE(0);
    __syncthreads();
    for (int t = 0; t < NT; ++t) {
        const int bf = t & 1;
        if (t + 1 < NT) AT_LOAD(t + 1);
        if (t <= tmax_w) {
            f32x16 p0, p1;
            const LAS unsigned char* bb = lds + bf * BUF_B;
            qkt(p0, p1, bb + kn_r, bb + kp_r, qr);
            if ((t0 + t * tstride + 1) * 64 > nkeys) {
                const int kb = (t0 + t * tstride) * 64 + 4 * hi;
#pragma unroll
                for (int r = 0; r < 16; ++r) { const int kv = kb + (r & 3) + 8 * (r >> 2); if (kv >= nkeys) p0[r] = -INFINITY; if (kv + 32 >= nkeys) p1[r] = -INFINITY; } }
            float pmax = p0[0];
#pragma unroll
            for (int r = 1; r < 16; ++r) pmax = fmaxf(pmax, p0[r]);
#pragma unroll
            for (int r = 0; r < 16; ++r) pmax = fmaxf(pmax, p1[r]);
            { auto rr = __builtin_amdgcn_permlane32_swap(__float_as_uint(pmax), __float_as_uint(pmax), false, false); pmax = fmaxf(__uint_as_float(rr[0]), __uint_as_float(rr[1])); }
            float alpha = 1.f; bool resc = false;
            if (!__all(pmax - m_reg <= THR)) { const float mn = fmaxf(m_reg, pmax); alpha = __builtin_amdgcn_exp2f(m_reg - mn); m_reg = mn; resc = true; }
#pragma unroll
            for (int r = 0; r < 16; ++r) { p0[r] = __builtin_amdgcn_exp2f(p0[r] - m_reg); p1[r] = __builtin_amdgcn_exp2f(p1[r] - m_reg); }
            float ps = 0.f;
#pragma unroll
            for (int r = 0; r < 16; ++r) ps += p0[r] + p1[r];
            { auto rr = __builtin_amdgcn_permlane32_swap(__float_as_uint(ps), __float_as_uint(ps), false, false); ps = __uint_as_float(rr[0]) + __uint_as_float(rr[1]); }
            l_reg = l_reg * alpha + ps;
            bf16x8 pa0, pa1, pa2, pa3;
#define AT_PK4(P, B_, OUT) do { unsigned a0 = cvt_pk_bf16(P[B_ + 0], P[B_ + 1]), a1 = cvt_pk_bf16(P[B_ + 2], P[B_ + 3]); unsigned b0 = cvt_pk_bf16(P[B_ + 4], P[B_ + 5]), b1 = cvt_pk_bf16(P[B_ + 6], P[B_ + 7]); \
        auto r0 = __builtin_amdgcn_permlane32_swap(a0, b0, false, false); auto r1 = __builtin_amdgcn_permlane32_swap(a1, b1, false, false); \
        u32x4 w_ = {r0[0], r1[0], r0[1], r1[1]}; OUT = __builtin_bit_cast(bf16x8, w_); } while (0)
            AT_PK4(p0, 0, pa0); AT_PK4(p0, 8, pa1); AT_PK4(p1, 0, pa2); AT_PK4(p1, 8, pa3);
#undef AT_PK4
            if (resc) { if (hi == 0) scr[r32] = alpha; asm volatile("s_waitcnt lgkmcnt(0)" ::: "memory");
#pragma unroll
                for (int d_ = 0; d_ < 4; ++d_)
#pragma unroll
                    for (int r = 0; r < 16; ++r) o[d_][r] *= scr[crow(r, hi)]; }
            AT_SBAR();
            pv_tile(o, vb_base + bf * BUF_B, pa0, pa1, pa2, pa3);
        }
        if (t + 1 < NT) AT_WRITE(bf ^ 1);
        __syncthreads();
    }
    if (PARTIAL) {
        if (wid == 0) {
#pragma unroll
            for (int r = 0; r < 16; ++r) { const int orow = crow(r, hi); if (orow < orows) {
#pragma unroll
                for (int d0 = 0; d0 < 4; ++d0) Pw[orow * 132 + d0 * 32 + r32] = o[d0][r]; } }
            if (hi == 0 && r32 < orows) { Pw[r32 * 132 + 128] = m_reg; Pw[r32 * 132 + 129] = l_reg; } }
        __syncthreads();
        return;
    }
    if (hi == 0) scr[32 + r32] = l_reg; asm volatile("s_waitcnt lgkmcnt(0)" ::: "memory");
#pragma unroll
    for (int r = 0; r < 16; ++r) { const int orow = crow(r, hi); const float rl = __builtin_amdgcn_rcpf(scr[32 + orow]);
#pragma unroll
        for (int d0 = 0; d0 < 4; ++d0) { const float v = o[d0][r] * rl; const float vn = __shfl_xor(v, 1);
            if ((r32 & 1) == 0 && orow < orows) *(unsigned*)(Ow + (size_t)orow * 1024 + d0 * 32 + r32) = cvt_pk_bf16(v, vn); } }
    __syncthreads();
#undef AT_LOAD
#undef AT_WRITE
}
#undef AT_SBAR
}
__device__ __forceinline__ void p3_attn_prompt(Frame& F) {
    const int bh = F.vcu >> 4, s = F.vcu & 15, b = bh >> 3, h = bh & 7;
    const bf16_t* Q = (const bf16_t*)F.out; const bf16_t* KN = (const bf16_t*)(F.ws + WS_KN); const bf16_t* KPE = (const bf16_t*)(F.ws + WS_KPE); const bf16_t* V = (const bf16_t*)(F.ws + WS_V); bf16_t* ATT = (bf16_t*)(F.ws + WS_ATT);
#pragma unroll 1
    for (int it = 0; it < 2; ++it) { const int qb = it == 0 ? s : 31 - s; const size_t row0 = (size_t)b * SEQ + (size_t)qb * 256 + F.wave * 32;
        at::attn_unit<false>(F.lds, Q + row0 * 1536 + h * 192, KN + (size_t)b * SEQ * 1024 + h * 128, KPE + (size_t)b * SEQ * 64, V + (size_t)b * SEQ * 1024 + h * 128,
                      ATT + row0 * 1024 + h * 128, nullptr, 4 * qb + 4, 4 * qb + (F.wave >> 1), 1 << 30, 32, 0, 1); }
}
__device__ __forceinline__ void xn_rows(Frame& F, bf16_t* XN) {
    const int gw = F.vcu * 8 + F.wave, NGW = F.G * 8;
    for (int r = gw; r < MPAD; r += NGW) {
        u32x2* o8 = (u32x2*)(XN + (size_t)r * D_MODEL) + F.lane;
        if (r >= MT) { for (int jj = 0; jj < 4; ++jj) o8[64 * jj] = (u32x2){0u, 0u}; continue; }
        const float* x = r < MP ? FIN(0) + (size_t)r * D_MODEL : FIN(1) + (size_t)(r - MP) * D_MODEL;
        const f32x4* xr = (const f32x4*)x + F.lane; f32x4 v[4]; float s = 0.f;
#pragma unroll
        for (int jj = 0; jj < 4; ++jj) { v[jj] = xr[64 * jj]; s += (v[jj][0] * v[jj][0] + v[jj][1] * v[jj][1]) + (v[jj][2] * v[jj][2] + v[jj][3] * v[jj][3]); }
        const float inv = rsqrtf(fwave_sum(s) * (1.f / D_MODEL) + EPS);
#pragma unroll
        for (int jj = 0; jj < 4; ++jj) { u32x2 w; w.x = cvt_pk_bf16(v[jj][0] * inv, v[jj][1] * inv); w.y = cvt_pk_bf16(v[jj][2] * inv, v[jj][3] * inv); o8[64 * jj] = w; }
    }
}
constexpr size_t WS_PART = WS_ATTS + 512 * KiB;
__device__ __forceinline__ void p3_attn_sample(Frame& F) {
    {   const int bh = F.vcu >> 2, part = F.vcu & 3, b = bh >> 3, h = bh & 7;
        const bf16_t* Q = (const bf16_t*)F.out; const bf16_t* KN = (const bf16_t*)(F.ws + WS_KN); const bf16_t* PES = (const bf16_t*)(F.ws + WS_PES); const bf16_t* V = (const bf16_t*)(F.ws + WS_V);
        const size_t row0 = (size_t)MP + (size_t)b * DEC_SEQ;
        at::attn_unit<true>(F.lds, Q + row0 * 1536 + h * 192, KN + (size_t)b * SKEYS * 1024 + h * 128, PES + (size_t)b * SKEYS * 64, V + (size_t)b * SKEYS * 1024 + h * 128,
                            nullptr, (float*)(F.ws + WS_PART) + (size_t)F.vcu * 16 * 132, part == 0 ? 9 : 8, F.wave == 0 ? 1000 : -1, SKEYS, DEC_SEQ, part, 4); }
    xn_rows(F, (bf16_t*)(F.ws + WS_XN2));
    {   const int gw = F.vcu * 8 + F.wave, NGW = F.G * 8; const bf16_t* KVL = (const bf16_t*)(F.ws + WS_KVL); const float* slotkv = (const float*)(F.ws + WS_SLOTKV);
        for (int r = gw; r < MT; r += NGW) { const float s = slot_rs(slotkv + (size_t)r * 8, 8, 1.f / KV_LORA);
            float* o = r < MP ? F.out + O_LATP + (size_t)r * KV_LORA : F.out + O_LATS + (size_t)(r - MP) * KV_LORA;
            const u32x4 w = *((const u32x4*)(KVL + (size_t)r * KV_LORA) + F.lane);
            f32x4 a = {__uint_as_float(w.x << 16), __uint_as_float(w.x & 0xffff0000u), __uint_as_float(w.y << 16), __uint_as_float(w.y & 0xffff0000u)};
            f32x4 c = {__uint_as_float(w.z << 16), __uint_as_float(w.z & 0xffff0000u), __uint_as_float(w.w << 16), __uint_as_float(w.w & 0xffff0000u)};
            *((f32x4*)o + 2 * F.lane) = a * s; *((f32x4*)o + 2 * F.lane + 1) = c * s; } }
}
__device__ __forceinline__ void attn_sample_combine(Frame& F) {
    if (F.vcu >= DEC_BATCH * HEADS) return;
    const int b = F.vcu >> 3, h = F.vcu & 7; const float* P = (const float*)(F.ws + WS_PART) + (size_t)F.vcu * 4 * 16 * 132; bf16_t* ATTS = (bf16_t*)(F.ws + WS_ATTS);
    for (int e = F.tid; e < 16 * 128; e += NTHR) { const int q = e >> 7, d = e & 127;
        float m[4], M = -1e30f;
#pragma unroll
        for (int p = 0; p < 4; ++p) { m[p] = P[(p * 16 + q) * 132 + 128]; M = fmaxf(M, m[p]); }
        float num = 0.f, den = 0.f;
#pragma unroll
        for (int p = 0; p < 4; ++p) { const float w = exp2f(m[p] - M); num += w * P[(p * 16 + q) * 132 + d]; den += w * P[(p * 16 + q) * 132 + 129]; }
        ATTS[(size_t)(b * DEC_SEQ + q) * 1024 + h * 128 + d] = f2bf(num / den); }
}
__device__ __forceinline__ void unpack8(const u32x4 w, float* f) {
    f[0] = __uint_as_float(w.x << 16); f[1] = __uint_as_float(w.x & 0xffff0000u); f[2] = __uint_as_float(w.y << 16); f[3] = __uint_as_float(w.y & 0xffff0000u);
    f[4] = __uint_as_float(w.z << 16); f[5] = __uint_as_float(w.z & 0xffff0000u); f[6] = __uint_as_float(w.w << 16); f[7] = __uint_as_float(w.w & 0xffff0000u);
}
__device__ __forceinline__ void p8_conv(Frame& F) {
    bf16_t* U = (bf16_t*)(F.ws + WS_U); const bf16_t* HALO = (const bf16_t*)(F.ws + WS_HALO); const float* cw = FIN(21); const float* cb = FIN(22); const float* prev = FIN(5);
    const int seg = F.wave, cgi = F.lane;
    for (int unit = F.vcu; unit < 72 * 6; unit += F.G) { const int ch = unit / 6, strip = unit % 6; const int n = strip * 512 + cgi * 8, nv = n + D_FF; const bool cok = n < D_FF;
        int r0, nr; if (ch < 64) { r0 = ch * 256 + seg * 32; nr = 32; } else { r0 = MP + (ch - 64) * DEC_SEQ; nr = seg == 0 ? DEC_SEQ : 0; }
        if (!cok) nr = 0;
        float wg[3][8], wv[3][8], bg[8], bv[8], g2[8], g1[8], v2[8], v1[8];
#pragma unroll
        for (int e = 0; e < 8; ++e) { g2[e] = 0.f; g1[e] = 0.f; v2[e] = 0.f; v1[e] = 0.f; }
        if (cok) {
#pragma unroll
            for (int k = 0; k < 3; ++k) { const f32x4 a0 = *(const f32x4*)(cw + k * FF2 + n), a1 = *(const f32x4*)(cw + k * FF2 + n + 4), c0 = *(const f32x4*)(cw + k * FF2 + nv), c1 = *(const f32x4*)(cw + k * FF2 + nv + 4);
#pragma unroll
                for (int e = 0; e < 4; ++e) { wg[k][e] = a0[e]; wg[k][4 + e] = a1[e]; wv[k][e] = c0[e]; wv[k][4 + e] = c1[e]; } }
            { const f32x4 a0 = *(const f32x4*)(cb + n), a1 = *(const f32x4*)(cb + n + 4), c0 = *(const f32x4*)(cb + nv), c1 = *(const f32x4*)(cb + nv + 4);
#pragma unroll
              for (int e = 0; e < 4; ++e) { bg[e] = a0[e]; bg[4 + e] = a1[e]; bv[e] = c0[e]; bv[4 + e] = c1[e]; } }
            if (ch < 64) {
                if (seg > 0) { unpack8(*(const u32x4*)(U + (size_t)(r0 - 2) * FF2 + n), g2); unpack8(*(const u32x4*)(U + (size_t)(r0 - 1) * FF2 + n), g1); unpack8(*(const u32x4*)(U + (size_t)(r0 - 2) * FF2 + nv), v2); unpack8(*(const u32x4*)(U + (size_t)(r0 - 1) * FF2 + nv), v1); }
                else if ((ch & 31) != 0) { const bf16_t* hp = HALO + (size_t)ch * 2 * FF2; unpack8(*(const u32x4*)(hp + n), g2); unpack8(*(const u32x4*)(hp + FF2 + n), g1); unpack8(*(const u32x4*)(hp + nv), v2); unpack8(*(const u32x4*)(hp + FF2 + nv), v1); }
            } else if (seg == 0) { const float* pp = prev + (size_t)(ch - 64) * 2 * FF2;
#pragma unroll
                for (int e = 0; e < 8; ++e) { g2[e] = pp[n + e]; g1[e] = pp[FF2 + n + e]; v2[e] = pp[nv + e]; v1[e] = pp[FF2 + nv + e]; } }
        }
        __syncthreads();
#pragma unroll 2
        for (int i = 0; i < nr; ++i) { bf16_t* row = U + (size_t)(r0 + i) * FF2; float g0[8], v0[8], h[8];
            unpack8(*(const u32x4*)(row + n), g0); unpack8(*(const u32x4*)(row + nv), v0);
#pragma unroll
            for (int e = 0; e < 8; ++e) { const float cg = g2[e] * wg[0][e] + g1[e] * wg[1][e] + g0[e] * wg[2][e] + bg[e], cv = v2[e] * wv[0][e] + v1[e] * wv[1][e] + v0[e] * wv[2][e] + bv[e];
                h[e] = cg * __builtin_amdgcn_rcpf(1.f + __expf(-cg)) * cv; g2[e] = g1[e]; g1[e] = g0[e]; v2[e] = v1[e]; v1[e] = v0[e]; }
            u32x4 w; w.x = cvt_pk_bf16(h[0], h[1]); w.y = cvt_pk_bf16(h[2], h[3]); w.z = cvt_pk_bf16(h[4], h[5]); w.w = cvt_pk_bf16(h[6], h[7]);
            *(u32x4*)(row + n) = w; }
        __syncthreads();
    }
}
namespace sk {
__device__ __forceinline__ int wrow(int c) { const int c5 = c & 31; return (c & ~31) + 16 * ((c5 >> 2) & 1) + 4 * (c5 >> 3) + (c5 & 3); }
__device__ __forceinline__ f32x4 mm(LAS unsigned char* lds, const bf16_t* __restrict__ A, size_t lda, const bf16_t* __restrict__ Bp, int K, int w, int lane) {
    const int fr = lane & 15, g = lane >> 4, ksteps = K >> 5;
    f32x4 acc[8];
#pragma unroll
    for (int b = 0; b < 8; ++b) acc[b] = (f32x4){0.f, 0.f, 0.f, 0.f};
    const bf16_t* Ap = A + (size_t)fr * lda + 8 * g;
    for (int s0 = w; s0 < ksteps; s0 += 32) {
        bf16x8 bq[4], aq[4][8];
#pragma unroll
        for (int q = 0; q < 4; ++q) { const int s = s0 + 8 * q; const bool ok = s < ksteps; const bf16x8 z = {0, 0, 0, 0, 0, 0, 0, 0};
            bq[q] = ok ? *(const bf16x8*)(Bp + 32 * s) : z;
#pragma unroll
            for (int b = 0; b < 8; ++b) aq[q][b] = ok ? *(const bf16x8*)(Ap + (size_t)(16 * b) * lda + 32 * s) : z; }
#pragma unroll
        for (int q = 0; q < 4; ++q)
#pragma unroll
            for (int b = 0; b < 8; ++b) acc[b] = __builtin_amdgcn_mfma_f32_16x16x32_bf16(aq[q][b], bq[q], acc[b], 0, 0, 0);
    }
    LAS f32x4* red = (LAS f32x4*)lds;
#pragma unroll
    for (int b = 0; b < 8; ++b) red[(w * 8 + b) * 64 + lane] = acc[b];
    __syncthreads();
    f32x4 r = red[w * 64 + lane];
#pragma unroll
    for (int ww = 1; ww < 8; ++ww) r = r + red[(ww * 8 + w) * 64 + lane];
    __syncthreads();
    return r;
}
}
__device__ __forceinline__ void sk_merge(Frame& F, int su) {
    const int w = F.wave, fr = F.lane & 15, g = F.lane >> 4, c = 16 * su + fr, wr_ = sk::wrow(c);
    const bf16_t* ATTS = (const bf16_t*)(F.ws + WS_ATTS); const bf16_t* RET = (const bf16_t*)(F.ws + WS_RET) + (size_t)MP * 1024;
    const f32x4 aA = sk::mm(F.lds, ATTS, 1024, (const bf16_t*)(F.ws + WS_FWOBA) + (size_t)wr_ * 1024 + 8 * g, 1024, w, F.lane);
    const f32x4 aR = sk::mm(F.lds, RET, 1024, (const bf16_t*)(F.ws + WS_FWOBB) + (size_t)wr_ * 1024 + 8 * g, 1024, w, F.lane);
    const bf16_t* gas_ = (const bf16_t*)(F.ws + WS_GAS); const bf16_t* gbs_ = (const bf16_t*)(F.ws + WS_GBS); bf16_t* MG = (bf16_t*)(F.ws + WS_MERGED) + (size_t)MP * 1024;
#pragma unroll
    for (int r = 0; r < 4; ++r) { const size_t i = (size_t)(16 * w + 4 * g + r) * 1024 + c; MG[i] = f2bf(bf2f(gas_[i]) * aA[r] + bf2f(gbs_[i]) * aR[r]); }
}
__device__ __forceinline__ void sk_out(Frame& F, int su) {
    const int w = F.wave, fr = F.lane & 15, g = F.lane >> 4, c = 16 * su + fr;
    const bf16_t* MG = (const bf16_t*)(F.ws + WS_MERGED) + (size_t)MP * 1024;
    const f32x4 a = sk::mm(F.lds, MG, 1024, (const bf16_t*)(F.ws + WS_FWOUT) + (size_t)sk::wrow(c) * 1024 + 8 * g, 1024, w, F.lane);
    bf16_t* X1B = (bf16_t*)(F.ws + WS_X1B) + (size_t)MP * 1024; float* ssq = (float*)(F.ws + WS_SSQS); const float* xs = FIN(1);
#pragma unroll
    for (int r = 0; r < 4; ++r) { const int row = 16 * w + 4 * g + r; const size_t i = (size_t)row * 1024 + c; const float v = xs[i] + a[r];
        F.out[O_YS + i] = v; X1B[i] = f2bf(v); const float q = rt::row16_sum(v * v); if (fr == 0) atomicAdd(ssq + row, q); }
}
__device__ __forceinline__ void sk_up(Frame& F, int su) {
    const int w = F.wave, fr = F.lane & 15, g = F.lane >> 4, c = 16 * su + fr;
    const int cc = c < D_FF ? c : c - D_FF, drow = (cc >> 7) * 256 + (c < D_FF ? 0 : 128) + sk::wrow(cc & 127);
    const bf16_t* X1B = (const bf16_t*)(F.ws + WS_X1B) + (size_t)MP * 1024;
    const f32x4 a = sk::mm(F.lds, X1B, 1024, (const bf16_t*)(F.ws + WS_FWUP) + (size_t)drow * 1024 + 8 * g, 1024, w, F.lane);
    bf16_t* U = (bf16_t*)(F.ws + WS_U) + (size_t)MP * FF2; const float* ssq = (const float*)(F.ws + WS_SSQS);
#pragma unroll
    for (int r = 0; r < 4; ++r) { const int row = 16 * w + 4 * g + r; const float u = a[r] * rsqrtf(ssq[row] * (1.f / D_MODEL) + EPS);
        U[(size_t)row * FF2 + c] = f2bf(u); const int t = row & (DEC_SEQ - 1); if (t >= DEC_SEQ - 2) F.out[O_CONVS + ((size_t)(row >> 4) * 2 + (t - (DEC_SEQ - 2))) * FF2 + c] = u; }
}
__device__ __forceinline__ void sk_down(Frame& F, int su) {
    const int w = F.wave, fr = F.lane & 15, g = F.lane >> 4, c = 16 * su + fr;
    const bf16_t* U = (const bf16_t*)(F.ws + WS_U) + (size_t)MP * FF2;
    const f32x4 a = sk::mm(F.lds, U, FF2, (const bf16_t*)(F.ws + WS_FWDOWN) + (size_t)sk::wrow(c) * D_FF + 8 * g, D_FF, w, F.lane);
#pragma unroll
    for (int r = 0; r < 4; ++r) { const size_t i = (size_t)(16 * w + 4 * g + r) * 1024 + c; F.out[O_YS + i] += a[r]; }
}
__global__ void __launch_bounds__(NTHR, 2) mk(const MArgs a) {
    extern __shared__ __attribute__((aligned(16))) unsigned char lds_raw[];
    Frame F;
    F.lds = (LAS unsigned char*)lds_raw;
    F.tid = threadIdx.x; F.lane = F.tid & 63; F.wave = __builtin_amdgcn_readfirstlane(F.tid >> 6);
    F.G = gridDim.x; F.x = blockIdx.x % 8; F.j = blockIdx.x / 8; F.vcu = F.x * (F.G / 8) + F.j;
    F.a = &a; F.out = a.out; F.ws = a.ws;
    volatile LAS unsigned* MISC = (volatile LAS unsigned*)(F.lds + MISC_OFF);
    if (F.tid < 32) MISC[F.tid] = 0u;
    __syncthreads();
    XcdBarrier bar = xcd_barrier_post((unsigned*)(a.ws + WS_CTL) + CW_BAR + a.li * XCD_BAR_WORDS, MISC + 8);
    const int lo = a.ph_lo, hi = a.ph_hi;
#define IN_(k) (lo <= (k) && (k) < hi)
#define SEAM_(k) do { if (IN_(k) && IN_((k) + 1)) xcd_barrier(bar); } while (0)
#define STAMP_(k) probe_stamp(F, (k))
    STAMP_(0); if (IN_(0)) { p0_prologue(F); } SEAM_(0);
    STAMP_(1); if (IN_(1)) { p1_inproj(F); } SEAM_(1);
    STAMP_(2); if (IN_(2)) { r1_states(F); } SEAM_(2);
    STAMP_(3); if (IN_(3)) { r2_scan(F); } SEAM_(3);
    STAMP_(4); if (IN_(4)) { r3_outputs(F); } SEAM_(4);
    STAMP_(5); if (IN_(5)) { p2_qkv(F, 1); } SEAM_(5);
    STAMP_(6); if (IN_(6)) { p3_attn_sample(F); } SEAM_(6);
    STAMP_(7); if (IN_(7)) { attn_sample_combine(F); p2_qkv(F, 0); } SEAM_(7);
    STAMP_(8); if (IN_(8)) { p3_attn_prompt(F); } SEAM_(8);
    STAMP_(9); if (IN_(9)) { p5_gemm(F, 5); if (F.vcu < 64) sk_merge(F, F.vcu); } SEAM_(9);
    STAMP_(10); if (IN_(10)) { p5_gemm(F, 6); if (F.vcu < 64) sk_out(F, F.vcu); } SEAM_(10);
    STAMP_(11); if (IN_(11)) { p5_gemm(F, 7); if (F.j >= 16) { for (int su = F.x * 16 + (F.j - 16); su < FF2 / 16; su += 128) sk_up(F, su); } } SEAM_(11);
    STAMP_(12); if (IN_(12)) { p8_conv(F); } SEAM_(12);
    STAMP_(13); if (IN_(13)) { p5_gemm(F, 9); if (F.vcu < 64) sk_down(F, F.vcu); }
    if (PROBE_LO >= 0) { __syncthreads(); STAMP_(14);
        if (blockIdx.x == 0 && F.tid == 0) { const unsigned long long t_end = __builtin_amdgcn_s_memrealtime() + (unsigned long long)PROBE_MULT * ((((unsigned long long)MISC[19] << 32) | MISC[18]) - (((unsigned long long)MISC[17] << 32) | MISC[16]));
            while (__builtin_amdgcn_s_memrealtime() < t_end) __builtin_amdgcn_s_sleep(8); } }
}

extern "C" void kernel_launch(void* const* d_in, const int* in_sizes, int n_in, void* d_out, int out_size, void* d_ws, size_t ws_size, hipStream_t stream) {
    static int ok = 0;
    if (ok == 0) {
        ok = 1;
        if (ws_size < 256 * MiB || n_in != 24) { fprintf(stderr, "kernel_launch: bad ws/n_in: %zu %d\n", ws_size, n_in); ok = -1; }
        int dev = 0, cus = 0; (void)hipGetDevice(&dev); (void)hipDeviceGetAttribute(&cus, hipDeviceAttributeMultiprocessorCount, dev);
        if (cus != 256) { fprintf(stderr, "kernel_launch: built for 256 CUs, got %d\n", cus); ok = -1; }
        if (hipFuncSetAttribute((const void*)mk, hipFuncAttributeMaxDynamicSharedMemorySize, LDS_BYTES) != hipSuccess) { fprintf(stderr, "kernel_launch: hipFuncSetAttribute(mk) failed\n"); ok = -1; }
        (void)hipGetLastError();
    }
    if (ok < 0) return;
    (void)hipMemsetAsync((char*)d_ws + WS_CTL, 0, CTL_BYTES, stream);
    MArgs a{}; for (int i = 0; i < 24; ++i) a.in[i] = (const float*)d_in[i]; a.out = (float*)d_out; a.ws = (unsigned char*)d_ws; a.ph_lo = 0; a.ph_hi = 14; a.li = 0;
    hipLaunchKernelGGL(mk, dim3(256), dim3(NTHR), LDS_BYTES, stream, a);
}
```

```cpp
#include <hip/hip_runtime.h>
#include <stdint.h>
#include <cstdio>

typedef unsigned short bf16_t;
typedef short bf16x8 __attribute__((ext_vector_type(8)));
typedef float f32x4 __attribute__((ext_vector_type(4)));
typedef float f32x2 __attribute__((ext_vector_type(2)));
typedef unsigned u32x4 __attribute__((ext_vector_type(4)));
typedef unsigned u32x2 __attribute__((ext_vector_type(2)));

constexpr int D_MODEL = 1024, BATCH = 2, SEQ = 8192, DEC_BATCH = 8, DEC_SEQ = 16, PAST = 2048;
constexpr int MP = BATCH * SEQ, MS = DEC_BATCH * DEC_SEQ, MT = MP + MS;
constexpr int MPAD = 16640;
constexpr int Q_LORA = 768, KV_LORA = 512, QK_NOPE = 128, QK_ROPE = 64, V_HEAD = 128, HEADS = 8;
constexpr int RET_H = 4, RET_DK = 128, RET_DV = 256;
constexpr int D_FF = 2816, FF2 = 2 * D_FF;
constexpr int IN_W = 6464;
constexpr int SKEYS = PAST + DEC_SEQ;
constexpr int LROWS = DEC_BATCH * SKEYS;
constexpr float EPS = 1e-6f;
constexpr int C_QLAT = 0, C_KVLAT = 768, C_KPE = 1280, C_RQ = 1344, C_RK = 1856, C_RV = 2368, C_RG = 3392, C_GA = 4416, C_GB = 5440;

constexpr size_t O_YP = 0, O_YS = 16777216, O_LATP = 16908288, O_RKP = 25296896, O_RETP = 26345472, O_CONVP = 26607616,
                 O_LATS = 26630144, O_RKS = 26695680, O_RETS = 26703872, O_CONVS = 27752448;

constexpr size_t MiB = 1u << 20, KiB = 1024;
constexpr size_t WS_CTL = 0, CTL_BYTES = 64 * KiB, WS_SSQS = 64 * KiB;
constexpr size_t WS_RSQ = 128 * KiB, WS_RSKV = 256 * KiB;
constexpr size_t WS_SLOTQ = 1 * MiB, WS_SLOTKV = 2 * MiB, WS_SLOTX1 = 3 * MiB;
constexpr size_t WS_TAB32 = 4 * MiB + 256 * KiB, WS_TAB64 = 6 * MiB + 256 * KiB;
constexpr size_t WS_FWUP = 10 * MiB + 512 * KiB, WS_FWDOWN = 21 * MiB + 512 * KiB, WS_FWIN = 27 * MiB, WS_FWQUP = 40 * MiB, WS_FWKVUP = 43 * MiB,
                 WS_FWOBA = 45 * MiB, WS_FWOBB = 47 * MiB, WS_FWOUT = 49 * MiB;
constexpr size_t WS_XN = 51 * MiB, WS_RET = 51 * MiB;
constexpr size_t WS_LATS = 83 * MiB + 512 * KiB, WS_PES = 99 * MiB + 768 * KiB, WS_ZQ = 102 * MiB, WS_KVL = 126 * MiB + 512 * KiB, WS_KPE = 142 * MiB + 768 * KiB;
constexpr size_t WS_RQ = 145 * MiB, WS_RK = 161 * MiB + 256 * KiB, WS_RV = 177 * MiB + 512 * KiB, WS_RG = 210 * MiB;
constexpr size_t WS_KN = 145 * MiB, WS_V = 177 * MiB + 512 * KiB, WS_ATTS = 242 * MiB + 512 * KiB, WS_XN2 = 210 * MiB, WS_ATT = 102 * MiB;
constexpr size_t WS_T1 = 166 * MiB + 512 * KiB, WS_MERGED = 134 * MiB;
constexpr size_t WS_GAS = 246 * MiB, WS_GBS = 247 * MiB;
constexpr size_t WS_X1B = 223 * MiB + 512 * KiB, WS_UG = 27 * MiB, WS_UV = 116 * MiB + 512 * KiB, WS_HALO = 206 * MiB;

__device__ __forceinline__ bf16_t f2bf(float f) { unsigned u = __float_as_uint(f); u = (u + 0x7fffu + ((u >> 16) & 1u)) >> 16; return (bf16_t)u; }
__device__ __forceinline__ float bf2f(bf16_t b) { return __uint_as_float(((unsigned)b) << 16); }

#define LAS __attribute__((address_space(3)))
#define GAS __attribute__((address_space(1)))
constexpr int NTHR = 512;
constexpr int RING_BYTES = 131072, EPI_OFF = RING_BYTES, EPI_BYTES = 8192, LDS_BYTES = 163840, MISC_OFF = LDS_BYTES - 256;
constexpr int CW_BAR = 1024;

__device__ __forceinline__ unsigned cvt_pk_bf16(float lo, float hi) { unsigned r; asm volatile("v_cvt_pk_bf16_f32 %0, %1, %2" : "=v"(r) : "v"(lo), "v"(hi)); return r; }
__device__ __forceinline__ void st16_sc1(void* p, const u32x4 v) { asm volatile("global_store_dwordx4 %0, %1, off sc1\n\ts_nop 1" :: "v"(p), "v"(v) : "memory"); }
__device__ __forceinline__ u32x4 ld16_sc1(const void* p) { u32x4 v; asm volatile("global_load_dwordx4 %0, %1, off sc1\n\ts_waitcnt vmcnt(0)" : "=&v"(v) : "v"(p) : "memory"); return v; }
__device__ __forceinline__ unsigned cvt_pk_bf16_t(float lo, float hi) { unsigned r; asm volatile("s_nop 0\n\tv_cvt_pk_bf16_f32 %0, %1, %2" : "=v"(r) : "v"(lo), "v"(hi)); return r; }
__device__ __forceinline__ u32x4 pack8f_t(const f32x4& a, const f32x4& b) { u32x4 w; w.x = cvt_pk_bf16_t(a[0], a[1]); w.y = cvt_pk_bf16_t(a[2], a[3]); w.z = cvt_pk_bf16_t(b[0], b[1]); w.w = cvt_pk_bf16_t(b[2], b[3]); return w; }
__device__ __forceinline__ u32x4 pack8f(const f32x4& a, const f32x4& b) { u32x4 w; w.x = cvt_pk_bf16(a[0], a[1]); w.y = cvt_pk_bf16(a[2], a[3]); w.z = cvt_pk_bf16(b[0], b[1]); w.w = cvt_pk_bf16(b[2], b[3]); return w; }
__device__ __forceinline__ int row_pos(int row) { return row < MP ? (row & (SEQ - 1)) : PAST + ((row - MP) & (DEC_SEQ - 1)); }

#define XB_TMO      128
#define XB_XCNT(j)  (256  + 64 * (j))
#define XB_XSUB(j)  (1280 + 64 * (j))
#define XB_XGEN(j)  (2304 + 64 * (j))
#define XB_TOP      3328
#define XB_TOPGEN   3392
#define XCD_BAR_WORDS 3456
#define XB_SPIN_CAP (1u << 18)
__device__ __forceinline__ unsigned xb_ld(unsigned* p)              { return __hip_atomic_load(p, __ATOMIC_RELAXED, __HIP_MEMORY_SCOPE_AGENT); }
__device__ __forceinline__ unsigned xb_add(unsigned* p, unsigned v) { return __hip_atomic_fetch_add(p, v, __ATOMIC_RELAXED, __HIP_MEMORY_SCOPE_AGENT); }
__device__ __forceinline__ unsigned xb_xcc_id() { return (unsigned)__builtin_amdgcn_s_getreg((3 << 11) | 20) & 0xFu; }
#define XB_SPIN(cond, bar) do { unsigned _sp = 0; while (cond) { __builtin_amdgcn_s_sleep(1); \
    if ((++_sp & 255u) == 0u) { if (xb_ld(&(bar)[XB_TMO])) break; if (_sp > XB_SPIN_CAP) { atomicAdd(&(bar)[XB_TMO], 1u); break; } } } } while (0)
struct XcdBarrier { unsigned* bar; unsigned x; volatile LAS unsigned* st; };
__device__ __forceinline__ XcdBarrier xcd_barrier_post(unsigned* bar, volatile LAS unsigned* st) {
    XcdBarrier b; b.bar = bar; b.x = xb_xcc_id(); b.st = st;
    if (threadIdx.x == 0) (void)xb_add(&bar[XB_XCNT(b.x)], 1u);
    return b;
}
__device__ __forceinline__ void xcd_barrier_complete(unsigned* bar, unsigned x, unsigned& nloc, unsigned& nx) {
    const unsigned G = gridDim.x * gridDim.y * gridDim.z;
    unsigned sum, cnt, mine, sp = 0u;
    for (;;) {
        sum = 0u; cnt = 0u; mine = 0u;
#pragma unroll
        for (unsigned j = 0; j < 16; ++j) { const unsigned c = xb_ld(&bar[XB_XCNT(j)]); sum += c; cnt += (c > 0u) ? 1u : 0u; mine = (j == x) ? c : mine; }
        if (sum == G) break;
        __builtin_amdgcn_s_sleep(1);
        if ((++sp & 255u) == 0u) { if (xb_ld(&bar[XB_TMO])) break; if (sp > XB_SPIN_CAP) { atomicAdd(&bar[XB_TMO], 1u); break; } }
    }
    nloc = mine > 0u ? mine : 1u; nx = cnt > 0u ? cnt : 1u;
}
__device__ __forceinline__ void xcd_barrier(const XcdBarrier& b) {
    asm volatile("s_waitcnt vmcnt(0)" ::: "memory");
    __syncthreads();
    if (threadIdx.x == 0) {
        unsigned* bar = b.bar;
        __builtin_amdgcn_s_waitcnt(0);
        unsigned nloc = b.st[0], nx = b.st[1];
        if (nloc == 0u) { xcd_barrier_complete(bar, b.x, nloc, nx); b.st[0] = nloc; b.st[1] = nx; }
        const unsigned old = xb_add(&bar[XB_XSUB(b.x)], 1u);
        const unsigned gen = old / nloc;
        if (old + 1u == (gen + 1u) * nloc) {
            __builtin_amdgcn_fence(__ATOMIC_RELEASE, "agent");
            asm volatile("s_waitcnt vmcnt(0)" ::: "memory");
            const unsigned og = xb_add(&bar[XB_TOP], 1u);
            const unsigned tg = og / nx;
            if (og + 1u == (tg + 1u) * nx) xb_add(&bar[XB_TOPGEN], 1u);
            else XB_SPIN(xb_ld(&bar[XB_TOPGEN]) == tg, bar);
            xb_add(&bar[XB_XGEN(b.x)], 1u);
            __builtin_amdgcn_fence(__ATOMIC_ACQUIRE, "agent");
            asm volatile("s_waitcnt vmcnt(0)" ::: "memory");
        } else {
            XB_SPIN(xb_ld(&bar[XB_XGEN(b.x)]) == gen, bar);
            __builtin_amdgcn_fence(__ATOMIC_ACQUIRE, "agent");
            asm volatile("s_waitcnt vmcnt(0)" ::: "memory");
        }
    }
    __syncthreads();
}

namespace pg {
constexpr int BK = 64, HALF = 128, HTB = HALF * BK * 2;
__host__ __device__ __forceinline__ int lds_byte(int r, int c) { const int st = (r >> 4) * 2 + (c >> 5), rr = r & 15, cc = c & 31, ob = rr * 64 + cc * 2; return st * 1024 + (ob ^ (((ob >> 9) & 1) << 5)); }
__host__ __device__ __forceinline__ void stage_rc(int b, int& R, int& C) { const int st = b / 1024, sb = b % 1024, swz = sb ^ (((sb >> 9) & 1) << 5); R = (st >> 1) * 16 + swz / 64; C = (st & 1) * 32 + (swz % 64) / 2; }
__host__ __device__ __forceinline__ int perm32(int rho) { const int n = rho >> 4, i = rho & 15; return 8 * (i >> 2) + 4 * n + (i & 3); }
struct UnitG { const char* A; const char* B; unsigned lda, ldb; int nt; int pm, pn, kind; int half; };
typedef f32x4 Acc[2][2][4][2];

template <class Sched, class Epi>
__device__ __forceinline__ void gemm_stream(LAS unsigned char* lds, const Sched& S, const Epi& E) {
    int tid = threadIdx.x; asm volatile("" : "+v"(tid));
    const int wid = __builtin_amdgcn_readfirstlane(tid >> 6), lane = tid & 63, wr = wid >> 2, wc = wid & 3, fr = lane & 15, fq = lane >> 4;
    unsigned Rr[2], Cc[2];
#pragma unroll
    for (int i = 0; i < 2; ++i) { int R, C; stage_rc(tid * 16 + i * 8192, R, C); Rr[i] = (unsigned)R; Cc[i] = (unsigned)C * 2u; }
    const unsigned ldsw = (unsigned)wid * 1024u;
    const int aoff = lds_byte(wr * 64 + fr, fq * 8), boff = lds_byte(wc * 32 + fr, fq * 8);
#define PG_SA(b, h) (((b) * 2 + (h)) * HTB)
#define PG_SB(b, h) ((4 + (b) * 2 + (h)) * HTB)
#define PG_STAGE(bufoff, gbase, ld) do { _Pragma("unroll") for (int _i = 0; _i < 2; ++_i) \
        __builtin_amdgcn_global_load_lds((const unsigned*)((const char*)(gbase) + (size_t)(Rr[_i] * (ld) + Cc[_i])), (LAS unsigned*)(lds + (bufoff) + ldsw + _i * 8192), 16, 0, 0); } while (0)
#define PG_LDA(dst, b, h) do { _Pragma("unroll") for (int m = 0; m < 4; ++m) _Pragma("unroll") for (int k = 0; k < 2; ++k) dst[m][k] = *(const LAS bf16x8*)(lds + PG_SA(b, h) + aoff + m * 2048 + k * 1024); } while (0)
#define PG_LDB(dst, b, h) do { _Pragma("unroll") for (int n = 0; n < 2; ++n) _Pragma("unroll") for (int k = 0; k < 2; ++k) dst[n][k] = *(const LAS bf16x8*)(lds + PG_SB(b, h) + boff + n * 2048 + k * 1024); } while (0)
#define PG_MMA(ai, bj, At, Bt) do { __builtin_amdgcn_s_setprio(1); _Pragma("unroll") for (int m = 0; m < 4; ++m) _Pragma("unroll") for (int n = 0; n < 2; ++n) _Pragma("unroll") for (int k = 0; k < 2; ++k) \
        acc[ai][bj][m][n] = __builtin_amdgcn_mfma_f32_16x16x32_bf16(Bt[n][k], At[m][k], acc[ai][bj][m][n], 0, 0, 0); __builtin_amdgcn_s_setprio(0); } while (0)
#define PG_WAIT_V(n) asm volatile("s_waitcnt vmcnt(" #n ")" ::: "memory")
#define PG_WAIT_L(n) asm volatile("s_waitcnt lgkmcnt(" #n ")" ::: "memory")
#define PG_BAR __builtin_amdgcn_s_barrier()
#define PG_SCHED __builtin_amdgcn_sched_barrier(0)
    UnitG cur, nxt; int ui = 0;
    if (!S.next(0, cur)) return;
    Acc acc;
#pragma unroll
    for (int a = 0; a < 2; ++a)
#pragma unroll
        for (int b = 0; b < 2; ++b)
#pragma unroll
            for (int m = 0; m < 4; ++m)
#pragma unroll
                for (int n = 0; n < 2; ++n) acc[a][b][m][n] = (f32x4){0.f, 0.f, 0.f, 0.f};
    bf16x8 At[4][2], B0[2][2], B1[2][2];
    const char* cA = cur.A; const char* cB = cur.B; unsigned clda = cur.lda, cldb = cur.ldb;
    PG_STAGE(PG_SB(0, 0), cB, cldb); PG_STAGE(PG_SB(0, 1), cB + (size_t)HALF * cldb, cldb); PG_STAGE(PG_SA(0, 0), cA, clda); PG_STAGE(PG_SA(0, 1), cA + (size_t)HALF * clda, clda);
    if (wr == 1) PG_BAR;
    PG_WAIT_V(2); PG_BAR;
    PG_STAGE(PG_SB(1, 0), cB + 128, cldb); PG_STAGE(PG_SA(1, 0), cA + 128, clda); PG_STAGE(PG_SB(1, 1), cB + (size_t)HALF * cldb + 128, cldb);
    PG_WAIT_V(6); PG_BAR;
    for (;;) {
        const bool has_next = S.next(ui + 1, nxt);
        const char* nA = has_next ? nxt.A : cA; const char* nB = has_next ? nxt.B : cB;
        const unsigned nlda = has_next ? nxt.lda : clda, nldb = has_next ? nxt.ldb : cldb;
        const int nt = cur.nt; const bool chalf = cur.half != 0;
        for (int t = 0; t < nt; t += 2) {
            const bool last = (t == nt - 2);
            const char* a1 = cA + (size_t)(t + 1) * 128;
            const char* a2 = last ? nA : cA + (size_t)(t + 2) * 128; const char* b2 = last ? nB : cB + (size_t)(t + 2) * 128;
            const unsigned lda2 = last ? nlda : clda, ldb2 = last ? nldb : cldb;
            const char* a3 = a2 + 128; const char* b3 = b2 + 128;
            PG_LDB(B0, 0, 0); PG_LDB(B1, 0, 1); PG_SCHED; PG_LDA(At, 0, 0); PG_STAGE(PG_SA(1, 1), a1 + (size_t)HALF * clda, clda);
            PG_WAIT_V(8); PG_WAIT_L(0); PG_BAR; PG_MMA(0, 0, At, B0); PG_MMA(0, 1, At, B1); PG_BAR; PG_SCHED;
            PG_LDA(At, 0, 1); PG_STAGE(PG_SB(0, 0), b2, ldb2); PG_STAGE(PG_SB(0, 1), b2 + (size_t)HALF * ldb2, ldb2); PG_STAGE(PG_SA(0, 0), a2, lda2);
            PG_WAIT_V(8); PG_WAIT_L(0); PG_BAR; if (!chalf) { PG_MMA(1, 0, At, B0); PG_MMA(1, 1, At, B1); } PG_BAR; PG_SCHED;
            PG_LDB(B0, 1, 0); PG_LDB(B1, 1, 1); PG_SCHED; PG_LDA(At, 1, 0); PG_STAGE(PG_SA(0, 1), a2 + (size_t)HALF * lda2, lda2);
            PG_WAIT_V(8); PG_WAIT_L(0); PG_BAR; PG_MMA(0, 0, At, B0); PG_MMA(0, 1, At, B1); PG_BAR; PG_SCHED;
            PG_LDA(At, 1, 1); PG_STAGE(PG_SB(1, 0), b3, ldb2); PG_STAGE(PG_SB(1, 1), b3 + (size_t)HALF * ldb2, ldb2); PG_STAGE(PG_SA(1, 0), a3, lda2);
            PG_WAIT_V(8); PG_WAIT_L(0); PG_BAR; if (!chalf) { PG_MMA(1, 0, At, B0); PG_MMA(1, 1, At, B1); } PG_BAR; PG_SCHED;
        }
        if (wr == 0) PG_BAR;
        E(acc, cur, lds, wr, wc, fr, fq);
        if (!has_next) break;
#pragma unroll
        for (int a = 0; a < 2; ++a)
#pragma unroll
            for (int b = 0; b < 2; ++b)
#pragma unroll
                for (int m = 0; m < 4; ++m)
#pragma unroll
                    for (int n = 0; n < 2; ++n) acc[a][b][m][n] = (f32x4){0.f, 0.f, 0.f, 0.f};
        cur = nxt; cA = nA; cB = nB; clda = nlda; cldb = nldb; ++ui;
        if (wr == 1) PG_BAR;
    }
    PG_WAIT_V(0);
    PG_BAR;
#undef PG_SA
#undef PG_SB
#undef PG_STAGE
#undef PG_LDA
#undef PG_LDB
#undef PG_MMA
#undef PG_WAIT_V
#undef PG_WAIT_L
#undef PG_BAR
#undef PG_SCHED
}
}

struct MArgs { const float* in[24]; float* out; unsigned char* ws; int ph_lo, ph_hi, li, pad; };
struct Frame {
    LAS unsigned char* lds; int tid, lane, wave; int x, j, vcu, G;
    const MArgs* a; float* out; unsigned char* ws;
};
#define FIN(k) (F.a->in[k])
__device__ __forceinline__ float fwave_sum(float v) {
#pragma unroll
    for (int o = 1; o < 64; o <<= 1) v += __shfl_xor(v, o);
    return v;
}

#ifndef PROBE_LO
#define PROBE_LO -1
#define PROBE_HI -1
#define PROBE_MULT 1
#define PROBE_BLK 0
#endif
__device__ __forceinline__ void probe_stamp(Frame& F, int k) {
    if (PROBE_LO >= 0 && blockIdx.x == PROBE_BLK && F.tid == 0) { volatile LAS unsigned* M = (volatile LAS unsigned*)(F.lds + MISC_OFF); const unsigned long long t_ = __builtin_amdgcn_s_memrealtime();
        if (k == PROBE_LO) { M[16] = (unsigned)t_; M[17] = (unsigned)(t_ >> 32); } if (k == PROBE_HI) { M[18] = (unsigned)t_; M[19] = (unsigned)(t_ >> 32); } }
}
enum { W_IN = 0, W_QUP, W_KVUP, W_OBA, W_OBB, W_OUT, W_UP, W_DOWN };
__device__ __forceinline__ int win_src(int gd) {
    const int tile = gd >> 3, g = gd & 7, bj = g >> 2, wc = g & 3;
    if (tile < 3) return C_QLAT + gd * 32;
    if (tile < 5) return C_KVLAT + (gd - 24) * 32;
    if (tile == 5) return (wc == 0) ? C_KPE + bj * 32 : -1;
    if (tile < 10) { const int base = tile < 8 ? C_RQ : C_RK, tl = tile < 8 ? tile - 6 : tile - 8; const int head = 2 * tl + (wc >> 1); return base + head * 128 + bj * 64 + (wc & 1) * 32; }
    if (tile < 14) return C_RV + (gd - 80) * 32;
    if (tile < 18) return C_RG + (gd - 112) * 32;
    if (tile < 22) return C_GA + (gd - 144) * 32;
    return C_GB + (gd - 176) * 32;
}
__device__ __forceinline__ int w_src_col(int wid, int row) {
    const int rho = row & 31, s = row & 255, wc = (s >> 5) & 3, t = row >> 8;
    const int n = rho >> 4, i = rho & 15; return t * 192 + 128 + 16 * wc + i + 32 * n;
}
__device__ __forceinline__ int w_group_base(int wid, int gd) {
    const int g = gd & 7, bj = g >> 2, wc = g & 3, t = gd >> 3;
    switch (wid) {
    case W_IN: return win_src(gd);
    case W_QUP: return bj == 0 ? t * 192 + 32 * wc : (wc < 2 ? -2 : -1);
    case W_KVUP: return t * 256 + 128 * bj + 32 * wc;
    case W_UP: return (bj ? D_FF : 0) + 128 * t + 32 * wc;
    default: return gd * 32;
    }
}
struct WItemRegs { f32x4 v[8]; float g[8]; };
__device__ __forceinline__ void p0_item_load(WItemRegs& R, const float* __restrict__ W, int ldw, const float* __restrict__ gain, int base, int kb, int lane) {
    const int k0 = kb * 64, c = lane & 7;
    if (base >= 0) {
#pragma unroll
        for (int i = 0; i < 8; ++i) { const int kk = (lane >> 3) + 8 * i; R.g[i] = gain ? gain[k0 + kk] : 1.f; R.v[i] = *(const f32x4*)(W + (size_t)(k0 + kk) * ldw + base + 4 * c); } }
}
__device__ __forceinline__ void p0_item_finish(const WItemRegs& R, const float* __restrict__ W, int ldw, int K, const float* __restrict__ gain, int wid, int base, bf16_t* __restrict__ Wt, int gd, int kb, LAS float* scr, int lane) {
    const int k0 = kb * 64, c = lane & 7;
    bf16_t* dst = Wt + (size_t)(gd * 32) * K + k0;
    if (base == -1) {
#pragma unroll
        for (int jj = 0; jj < 4; ++jj) { const int n = (lane >> 3) + 8 * jj; *(u32x4*)(dst + (size_t)n * K + 8 * c) = (u32x4){0u, 0u, 0u, 0u}; }
        return;
    }
    if (base >= 0) {
#pragma unroll
        for (int i = 0; i < 8; ++i) { const int kk = (lane >> 3) + 8 * i; LAS float* d = scr + kk * 33 + 4 * c; const float g = R.g[i]; d[0] = R.v[i][0] * g; d[1] = R.v[i][1] * g; d[2] = R.v[i][2] * g; d[3] = R.v[i][3] * g; }
    } else {
        const int sc = w_src_col(wid, gd * 32 + (lane & 31));
#pragma unroll 8
        for (int i = 0; i < 32; ++i) { const int kk = 2 * i + (lane >> 5); const float g = gain ? gain[k0 + kk] : 1.f; scr[kk * 33 + (lane & 31)] = W[(size_t)(k0 + kk) * ldw + sc] * g; }
    }
    asm volatile("s_waitcnt lgkmcnt(0)" ::: "memory");
#pragma unroll
    for (int jj = 0; jj < 4; ++jj) { const int n = (lane >> 3) + 8 * jj; const LAS float* s = scr + (8 * c) * 33 + (base >= 0 ? pg::perm32(n) : n);
        u32x4 o; o.x = cvt_pk_bf16(s[0 * 33], s[1 * 33]); o.y = cvt_pk_bf16(s[2 * 33], s[3 * 33]); o.z = cvt_pk_bf16(s[4 * 33], s[5 * 33]); o.w = cvt_pk_bf16(s[6 * 33], s[7 * 33]);
        *(u32x4*)(dst + (size_t)n * K + 8 * c) = o; }
    asm volatile("s_waitcnt lgkmcnt(0)" ::: "memory");
}
struct WDesc { const float* W; const float* gain; int ldw, K, wid, ngroups, local; size_t off; };
__device__ __forceinline__ bool w_decode(Frame& F, int it, WDesc& d) {
    if (it < 3328) { d = WDesc{FIN(7), FIN(6), IN_W, 1024, W_IN, 208, it, WS_FWIN}; return true; } it -= 3328;
    if (it < 768) { d = WDesc{FIN(9), FIN(8), 1536, 768, W_QUP, 64, it, WS_FWQUP}; return true; } it -= 768;
    if (it < 512) { d = WDesc{FIN(13), nullptr, 2048, 512, W_KVUP, 64, it, WS_FWKVUP}; return true; } it -= 512;
    if (it < 512) { d = WDesc{FIN(17), nullptr, 1024, 1024, W_OBA, 32, it, WS_FWOBA}; return true; } it -= 512;
    if (it < 512) { d = WDesc{FIN(17) + (size_t)1024 * 1024, nullptr, 1024, 1024, W_OBB, 32, it, WS_FWOBB}; return true; } it -= 512;
    if (it < 512) { d = WDesc{FIN(18), nullptr, 1024, 1024, W_OUT, 32, it, WS_FWOUT}; return true; } it -= 512;
    if (it < 2816) { d = WDesc{FIN(20), FIN(19), FF2, 1024, W_UP, 176, it, WS_FWUP}; return true; } it -= 2816;
    if (it < 1408) { d = WDesc{FIN(23), nullptr, 1024, D_FF, W_DOWN, 32, it, WS_FWDOWN}; return true; }
    return false;
}
__device__ __forceinline__ void p0_all_weights(Frame& F, LAS float* scr, int gw, int NGW, int it_lo, int it_hi) {
    for (int it = it_lo + gw; it < it_hi; it += 2 * NGW) {
        WDesc dA, dB; w_decode(F, it, dA); const bool hasB = (it + NGW < it_hi) && w_decode(F, it + NGW, dB);
        const int gdA = dA.local % dA.ngroups, kbA = dA.local / dA.ngroups, baseA = w_group_base(dA.wid, gdA);
        const int gdB = hasB ? dB.local % dB.ngroups : 0, kbB = hasB ? dB.local / dB.ngroups : 0, baseB = hasB ? w_group_base(dB.wid, gdB) : -1;
        WItemRegs RA, RB;
        p0_item_load(RA, dA.W, dA.ldw, dA.gain, baseA, kbA, F.lane);
        if (hasB) p0_item_load(RB, dB.W, dB.ldw, dB.gain, baseB, kbB, F.lane);
        p0_item_finish(RA, dA.W, dA.ldw, dA.K, dA.gain, dA.wid, baseA, (bf16_t*)(F.ws + dA.off), gdA, kbA, scr, F.lane);
        if (hasB) p0_item_finish(RB, dB.W, dB.ldw, dB.K, dB.gain, dB.wid, baseB, (bf16_t*)(F.ws + dB.off), gdB, kbB, scr, F.lane);
    }
}
__device__ __forceinline__ float2 rope_cs(int pos, double f) {
    const double t = (double)pos * f * 0.15915494309189535; const float rev = (float)(t - rint(t));
    return make_float2(__builtin_amdgcn_cosf(rev), __builtin_amdgcn_sinf(rev));
}
__device__ __forceinline__ void p0_prologue(Frame& F) {
    LAS float* scr = (LAS float*)(F.lds + F.wave * 16384);
    const int gw = F.vcu * 8 + F.wave, NGW = F.G * 8;
    if (F.vcu == 0 && F.tid < 128) ((float*)(F.ws + WS_SSQS))[F.tid] = 0.f;
    probe_stamp(F, 20);
    p0_all_weights(F, scr, gw, NGW, 0, 4608);
    p0_all_weights(F, scr, gw, NGW, 6144, 8960);
    probe_stamp(F, 21);
    {   bf16_t* XN = (bf16_t*)(F.ws + WS_XN);
        for (int r = gw; r < MPAD; r += 2 * NGW) {
            const int r2 = r + NGW; f32x4 v[2][4];
#pragma unroll
            for (int q = 0; q < 2; ++q) { const int rr = q ? r2 : r; if (rr < MT) { const float* x = rr < MP ? FIN(0) + (size_t)rr * D_MODEL : FIN(1) + (size_t)(rr - MP) * D_MODEL; const f32x4* xr = (const f32x4*)x + F.lane;
#pragma unroll
                    for (int jj = 0; jj < 4; ++jj) v[q][jj] = xr[64 * jj]; } else {
#pragma unroll
                    for (int jj = 0; jj < 4; ++jj) v[q][jj] = (f32x4){0.f, 0.f, 0.f, 0.f}; } }
#pragma unroll
            for (int q = 0; q < 2; ++q) { const int rr = q ? r2 : r; if (rr >= MPAD) continue; float s = 0.f;
#pragma unroll
                for (int jj = 0; jj < 4; ++jj) s += (v[q][jj][0] * v[q][jj][0] + v[q][jj][1] * v[q][jj][1]) + (v[q][jj][2] * v[q][jj][2] + v[q][jj][3] * v[q][jj][3]);
                const float inv = rsqrtf(fwave_sum(s) * (1.f / D_MODEL) + EPS); u32x2* o8 = (u32x2*)(XN + (size_t)rr * D_MODEL) + F.lane;
#pragma unroll
                for (int jj = 0; jj < 4; ++jj) { u32x2 w; w.x = cvt_pk_bf16(v[q][jj][0] * inv, v[q][jj][1] * inv); w.y = cvt_pk_bf16(v[q][jj][2] * inv, v[q][jj][3] * inv); o8[64 * jj] = w; } }
        } }
    {
    bf16_t* lats = (bf16_t*)(F.ws + WS_LATS); bf16_t* pes = (bf16_t*)(F.ws + WS_PES);
    const int gt = F.vcu * NTHR + F.tid, NG = F.G * NTHR;
    for (int i0 = gt; i0 < DEC_BATCH * PAST * (KV_LORA / 4); i0 += 4 * NG) { f32x4 v[4];
#pragma unroll
        for (int qq = 0; qq < 4; ++qq) v[qq] = *((const f32x4*)FIN(2) + i0 + qq * NG);
#pragma unroll
        for (int qq = 0; qq < 4; ++qq) { const int i = i0 + qq * NG, c4 = i % (KV_LORA / 4), rj = i / (KV_LORA / 4), jr = rj % PAST, b = rj / PAST; u32x2 w; w.x = cvt_pk_bf16(v[qq][0], v[qq][1]); w.y = cvt_pk_bf16(v[qq][2], v[qq][3]);
            *(u32x2*)(lats + ((size_t)b * SKEYS + jr) * KV_LORA + c4 * 4) = w; } }
    for (int i = gt; i < DEC_BATCH * PAST * (QK_ROPE / 4); i += NG) { const int c4 = i % (QK_ROPE / 4), rj = i / (QK_ROPE / 4), jr = rj % PAST, b = rj / PAST;
        const f32x4 v = *((const f32x4*)FIN(3) + i); u32x2 w; w.x = cvt_pk_bf16(v[0], v[1]); w.y = cvt_pk_bf16(v[2], v[3]);
        *(u32x2*)(pes + ((size_t)b * SKEYS + jr) * QK_ROPE + c4 * 4) = w; }
    }
    {   const int gt = F.vcu * NTHR + F.tid, NG = F.G * NTHR;
        probe_stamp(F, 23);
        float2* tab32 = (float2*)(F.ws + WS_TAB32); float2* tab64 = (float2*)(F.ws + WS_TAB64);
        {   const int k64 = gt & 63, k32 = gt & 31;
            const double f64 = exp2(-(double)k64 * (13.287712379549449 / 64.0)), f32 = exp2(-(double)k32 * (13.287712379549449 / 32.0));
            for (int i = gt; i < 8192 * 64; i += NG) { tab64[i] = rope_cs(i >> 6, f64); if (i < 8192 * 32) tab32[i] = rope_cs(i >> 5, f32); } } }
}

__device__ __forceinline__ void p1_late_prologue(Frame& F) {
    if (F.j < 16) return;
    const int q = F.x * 16 + (F.j - 16);
    LAS float* scr = (LAS float*)(F.lds + F.wave * 16384);
    p0_all_weights(F, scr, q * 8 + F.wave, 128 * 8, 4608, 6144);
    p0_all_weights(F, scr, q * 8 + F.wave, 128 * 8, 8960, 10368);
}
__device__ __forceinline__ bool reg_unit(int x, int j, int i, int nN, int& pm, int& pn) { const int u = j + 32 * i; if (u >= 8 * nN) return false; pm = 8 * x + (u & 7); pn = u >> 3; return true; }
#define LDS_F(off) ((LAS float*)(lds + EPI_OFF) + (off))

enum { K_QLAT = 0, K_KVLAT, K_KPE, K_RQ, K_RK, K_RV, K_RG, K_GS, K_QUP, K_KVP, K_KVS, K_GA, K_AD, K_GB, K_RD, K_OUT, K_UP, K_DOWN };
struct SchedP1 {
    int x, j; const char* ws;
    __device__ __forceinline__ bool next(int i, pg::UnitG& u) const {
        int pm, pn;
        if (!reg_unit(x, j, i, 18, pm, pn)) { if (i == 4 && j >= 16) { const int k = (j - 16) * 8 + x; if (k >= 26) return false; pm = 64; pn = k; } else return false; }
        u.pm = pm; u.pn = pn; u.A = ws + WS_XN + (size_t)pm * 256 * 2048; u.B = ws + WS_FWIN + (size_t)pn * 256 * 2048; u.lda = 2048; u.ldb = 2048; u.nt = 16; u.half = pm == 64;
        u.kind = pn < 3 ? K_QLAT : pn < 5 ? K_KVLAT : pn == 5 ? K_KPE : pn < 8 ? K_RQ : pn < 10 ? K_RK : pn < 14 ? K_RV : pn < 18 ? K_RG : K_GS;
        return true;
    }
};
struct EpiP1 {
    unsigned char* ws; float* out; const float *g_kvlat, *g_kr;
    __device__ __forceinline__ void operator()(const pg::Acc& acc, const pg::UnitG& u, LAS unsigned char* lds, int wr, int wc, int fr, int fq) const {
        bf16_t* const ZQ = (bf16_t*)(ws + WS_ZQ); bf16_t* const KVL = (bf16_t*)(ws + WS_KVL); bf16_t* const KPE = (bf16_t*)(ws + WS_KPE); bf16_t* const PES = (bf16_t*)(ws + WS_PES); bf16_t* const LATS = (bf16_t*)(ws + WS_LATS);
        bf16_t* const RQ = (bf16_t*)(ws + WS_RQ); bf16_t* const RK = (bf16_t*)(ws + WS_RK); bf16_t* const RV = (bf16_t*)(ws + WS_RV); bf16_t* const RG = (bf16_t*)(ws + WS_RG);
        float* const slotq = (float*)(ws + WS_SLOTQ); float* const slotkv = (float*)(ws + WS_SLOTKV);
        const float2* const tab32 = (const float2*)(ws + WS_TAB32); const float2* const tab64 = (const float2*)(ws + WS_TAB64);
        int rl0 = wr * 64 + fr, cw = wc * 32 + fq * 8; asm volatile("" : "+v"(rl0), "+v"(cw));
        const int kind = u.kind, rb = u.pm * 256 + rl0;
        if (kind == K_QLAT || kind == K_KVLAT) {
            const int t = kind == K_QLAT ? u.pn : u.pn - 3; const int ld = kind == K_QLAT ? Q_LORA : KV_LORA; bf16_t* dst = kind == K_QLAT ? ZQ : KVL;
            f32x4 g[2][2];
#pragma unroll
            for (int bj = 0; bj < 2; ++bj)
#pragma unroll
                for (int n = 0; n < 2; ++n) g[bj][n] = kind == K_KVLAT ? *(const f32x4*)(g_kvlat + t * 256 + bj * 128 + cw + 4 * n) : (f32x4){1.f, 1.f, 1.f, 1.f};
#pragma unroll
            for (int ai = 0; ai < 2; ++ai)
#pragma unroll
                for (int m = 0; m < 4; ++m) { const int row = rb + ai * 128 + m * 16; float ss = 0.f;
                    const bool snew = (kind == K_KVLAT) && row >= MP && row < MT;
                    const int rs = row - MP; bf16_t* lrow = LATS + ((size_t)(rs / DEC_SEQ) * SKEYS + PAST + (rs % DEC_SEQ)) * KV_LORA;
#pragma unroll
                    for (int bj = 0; bj < 2; ++bj) { const f32x4 v0 = acc[ai][bj][m][0], v1 = acc[ai][bj][m][1];
                        ss += (v0[0] * v0[0] + v0[1] * v0[1]) + (v0[2] * v0[2] + v0[3] * v0[3]) + (v1[0] * v1[0] + v1[1] * v1[1]) + (v1[2] * v1[2] + v1[3] * v1[3]);
                        const u32x4 w = pack8f(v0 * g[bj][0], v1 * g[bj][1]);
                        *(u32x4*)(dst + (size_t)row * ld + t * 256 + bj * 128 + cw) = w;
                        if (snew) *(u32x4*)(lrow + t * 256 + bj * 128 + cw) = w; }
                    ss += __shfl_xor(ss, 16); ss += __shfl_xor(ss, 32);
                    if (fq == 0) { if (kind == K_QLAT) slotq[(size_t)row * 12 + t * 4 + wc] = ss; else slotkv[(size_t)row * 8 + t * 4 + wc] = ss; } }
        } else if (kind == K_KPE) {
            if (wc != 0) return;
            const int d0 = fq * 8;
            f32x4 g1[2], g2[2];
#pragma unroll
            for (int n = 0; n < 2; ++n) { g1[n] = *(const f32x4*)(g_kr + d0 + 4 * n); g2[n] = *(const f32x4*)(g_kr + 32 + d0 + 4 * n); }
#pragma unroll
            for (int ai = 0; ai < 2; ++ai)
#pragma unroll
                for (int m = 0; m < 4; ++m) { const int row = rb + ai * 128 + m * 16; const int pos = row_pos(row < MT ? row : 0);
                    f32x4 x1[2], x2[2]; float ss = 0.f;
#pragma unroll
                    for (int n = 0; n < 2; ++n) { x1[n] = acc[ai][0][m][n]; x2[n] = acc[ai][1][m][n];
                        ss += (x1[n][0] * x1[n][0] + x1[n][1] * x1[n][1]) + (x1[n][2] * x1[n][2] + x1[n][3] * x1[n][3]) + (x2[n][0] * x2[n][0] + x2[n][1] * x2[n][1]) + (x2[n][2] * x2[n][2] + x2[n][3] * x2[n][3]); }
                    ss += __shfl_xor(ss, 16); ss += __shfl_xor(ss, 32);
                    const float inv = rsqrtf(ss * (1.f / 64.f) + EPS);
                    f32x4 o1[2], o2[2];
#pragma unroll
                    for (int n = 0; n < 2; ++n) { const f32x4 y1 = x1[n] * inv * g1[n], y2 = x2[n] * inv * g2[n];
                        const f32x4 cs0 = *(const f32x4*)(tab32 + pos * 32 + d0 + 4 * n), cs1 = *(const f32x4*)(tab32 + pos * 32 + d0 + 4 * n + 2);
                        const f32x4 c = {cs0[0], cs0[2], cs1[0], cs1[2]}, s = {cs0[1], cs0[3], cs1[1], cs1[3]};
                        o1[n] = y1 * c - y2 * s; o2[n] = y1 * s + y2 * c; }
                    *(u32x4*)(KPE + (size_t)row * 64 + d0) = pack8f(o1[0], o1[1]); *(u32x4*)(KPE + (size_t)row * 64 + 32 + d0) = pack8f(o2[0], o2[1]);
                    if (row < MT) {
                        float* o = row < MP ? out + O_RKP + (size_t)row * 64 : out + O_RKS + (size_t)(row - MP) * 64;
                        *(f32x4*)(o + d0) = o1[0]; *(f32x4*)(o + d0 + 4) = o1[1]; *(f32x4*)(o + 32 + d0) = o2[0]; *(f32x4*)(o + 32 + d0 + 4) = o2[1];
                        if (row >= MP) { const int rs = row - MP, b = rs / DEC_SEQ, tt = rs % DEC_SEQ; bf16_t* p = PES + ((size_t)b * SKEYS + PAST + tt) * 64;
                            *(u32x4*)(p + d0) = pack8f(o1[0], o1[1]); *(u32x4*)(p + 32 + d0) = pack8f(o2[0], o2[1]); } } }
        } else if (kind == K_RQ || kind == K_RK) {
            const int tl = kind == K_RQ ? u.pn - 6 : u.pn - 8; const int head = 2 * tl + (wc >> 1), i0 = 32 * (wc & 1) + fq * 8;
            bf16_t* dst = kind == K_RQ ? RQ : RK; const float sc = kind == K_RQ ? 1.0f : 0.08838834764831845f;
#pragma unroll
            for (int ai = 0; ai < 2; ++ai)
#pragma unroll
                for (int m = 0; m < 4; ++m) { const int row = rb + ai * 128 + m * 16; const int pos = row_pos(row < MT ? row : 0);
                    f32x4 o1[2], o2[2];
#pragma unroll
                    for (int n = 0; n < 2; ++n) { const f32x4 x1 = acc[ai][0][m][n], x2 = acc[ai][1][m][n];
                        const f32x4 cs0 = *(const f32x4*)(tab64 + pos * 64 + i0 + 4 * n), cs1 = *(const f32x4*)(tab64 + pos * 64 + i0 + 4 * n + 2);
                        const f32x4 c = {cs0[0], cs0[2], cs1[0], cs1[2]}, s = {cs0[1], cs0[3], cs1[1], cs1[3]};
                        o1[n] = (x1 * c - x2 * s) * sc; o2[n] = (x1 * s + x2 * c) * sc; }
                    *(u32x4*)(dst + (size_t)row * 512 + head * 128 + i0) = pack8f(o1[0], o1[1]); *(u32x4*)(dst + (size_t)row * 512 + head * 128 + 64 + i0) = pack8f(o2[0], o2[1]); }
        } else if (kind == K_GS) {
            bf16_t* dst = (bf16_t*)(ws + (u.pn < 22 ? WS_GAS : WS_GBS)); const int t = u.pn < 22 ? u.pn - 18 : u.pn - 22;
#pragma unroll
            for (int m = 0; m < 4; ++m) { const int rl = rl0 + m * 16;
#pragma unroll
                for (int bj = 0; bj < 2; ++bj) { f32x4 v0 = acc[0][bj][m][0], v1 = acc[0][bj][m][1];
#pragma unroll
                    for (int e = 0; e < 4; ++e) { v0[e] = __builtin_amdgcn_rcpf(1.f + __expf(-v0[e])); v1[e] = __builtin_amdgcn_rcpf(1.f + __expf(-v1[e])); }
                    *(u32x4*)(dst + (size_t)rl * 1024 + t * 256 + bj * 128 + cw) = pack8f_t(v0, v1); } }
        } else {
            const int t = kind == K_RV ? u.pn - 10 : u.pn - 14; bf16_t* dst = kind == K_RV ? RV : RG;
#pragma unroll
            for (int ai = 0; ai < 2; ++ai)
#pragma unroll
                for (int m = 0; m < 4; ++m) { const int row = rb + ai * 128 + m * 16;
#pragma unroll
                    for (int bj = 0; bj < 2; ++bj) { f32x4 v0 = acc[ai][bj][m][0], v1 = acc[ai][bj][m][1];
                        if (kind == K_RG) {
#pragma unroll
                            for (int e = 0; e < 4; ++e) { v0[e] = v0[e] * __builtin_amdgcn_rcpf(1.f + __expf(-v0[e])); v1[e] = v1[e] * __builtin_amdgcn_rcpf(1.f + __expf(-v1[e])); } }
                        *(u32x4*)(dst + (size_t)row * 1024 + t * 256 + bj * 128 + cw) = pack8f(v0, v1); } }
        }
    }
};
__device__ __forceinline__ void p1_inproj(Frame& F) {
    SchedP1 S{F.x, F.j, (const char*)F.ws};
    EpiP1 E{F.ws, F.out, FIN(12), FIN(15)};
    pg::gemm_stream(F.lds, S, E);
}

__device__ __forceinline__ float slot_rs(const float* slots, int n, float invn) {
    float a = 0.f; for (int i = 0; i < n; i += 4) { const f32x4 v = *(const f32x4*)(slots + i); a += (v[0] + v[1]) + (v[2] + v[3]); } return rsqrtf(a * invn + EPS);
}
struct SchedP2 {
    int x, j; const char* ws; int sample;
    __device__ __forceinline__ bool next(int i, pg::UnitG& u) const {
        int pm, pn, kind;
        if (sample) {
            if (i < 2) { reg_unit(x, j, i, 8, pm, pn); kind = K_QUP; }
            else if (i < 4) { reg_unit(x, j, i - 2, 8, pm, pn); kind = K_KVS; }
            else if (i == 4 && j < 2) { const int k = j * 8 + x; pm = 64; pn = k & 7; kind = k < 8 ? K_QUP : K_KVS; }
            else return false;
        } else { if (i >= 2) return false; reg_unit(x, j, i, 8, pm, pn); kind = K_KVP; }
        u.pm = pm; u.pn = pn; u.kind = kind; u.half = pm == 64;
        if (kind == K_QUP) { u.A = ws + WS_ZQ + (size_t)pm * 256 * 1536; u.lda = 1536; u.B = ws + WS_FWQUP + (size_t)pn * 256 * 1536; u.ldb = 1536; u.nt = 12; }
        else { u.A = ws + (kind == K_KVS ? WS_LATS : WS_KVL) + (size_t)pm * 256 * 1024; u.lda = 1024; u.B = ws + WS_FWKVUP + (size_t)pn * 256 * 1024; u.ldb = 1024; u.nt = 8; }
        return true;
    }
};
struct EpiP2 {
    unsigned char* ws; float* out; const float *g_qn, *g_qr, *g_kn;
    __device__ __forceinline__ void operator()(const pg::Acc& acc, const pg::UnitG& u, LAS unsigned char* lds, int wr, int wc, int fr, int fq) const {
        int rl0 = wr * 64 + fr, cw = wc * 32 + fq * 8; asm volatile("" : "+v"(rl0), "+v"(cw));
        const int kind = u.kind, h = u.pn, rb = u.pm * 256 + rl0;
        const float* const rsq = (const float*)(ws + WS_RSQ); const float* const rskv = (const float*)(ws + WS_RSKV);
        float rs[2][4];
#pragma unroll
        for (int ai = 0; ai < 2; ++ai)
#pragma unroll
            for (int m = 0; m < 4; ++m) { const int row = rb + ai * 128 + m * 16;
                if (kind == K_QUP) rs[ai][m] = rsq[row];
                else if (kind == K_KVP) rs[ai][m] = rskv[row];
                else { const int b = row / SKEYS, jj = row - b * SKEYS; rs[ai][m] = (row < LROWS && jj >= PAST) ? rskv[MP + b * DEC_SEQ + jj - PAST] : 1.f; } }
#pragma unroll
        for (int ai = 0; ai < 2; ++ai)
#pragma unroll
            for (int m = 0; m < 4; ++m) { float p0 = 0.f, p1 = 0.f; const float s2 = rs[ai][m] * rs[ai][m];
#pragma unroll
                for (int n = 0; n < 2; ++n) { const f32x4 a = acc[ai][0][m][n], b = acc[ai][1][m][n];
                    p0 += (a[0] * a[0] + a[1] * a[1]) + (a[2] * a[2] + a[3] * a[3]); p1 += (b[0] * b[0] + b[1] * b[1]) + (b[2] * b[2] + b[3] * b[3]); }
                p0 += __shfl_xor(p0, 16); p0 += __shfl_xor(p0, 32); p1 += __shfl_xor(p1, 16); p1 += __shfl_xor(p1, 32);
                if (fq == 0) { LAS float* d = LDS_F((rl0 + ai * 128 + m * 16) * 8 + wc * 2); d[0] = p0 * s2; d[1] = p1 * s2; } }
        asm volatile("s_waitcnt lgkmcnt(0)" ::: "memory"); __builtin_amdgcn_s_barrier(); asm volatile("" ::: "memory");
        if (kind == K_QUP) {
            bf16_t* const Q = (bf16_t*)out;
            const float2* const tab32 = (const float2*)(ws + WS_TAB32);
            const float C2 = 0.07216878364870323f * 1.4426950408889634f;
            f32x4 gn[2]; gn[0] = *(const f32x4*)(g_qn + cw); gn[1] = *(const f32x4*)(g_qn + cw + 4);
            const int ir = 16 * (wc & 1) + 4 * fq; const f32x4 gr1 = *(const f32x4*)(g_qr + ir), gr2 = *(const f32x4*)(g_qr + 32 + ir);
#pragma unroll
            for (int ai = 0; ai < 2; ++ai)
#pragma unroll
                for (int m = 0; m < 4; ++m) { const int row = rb + ai * 128 + m * 16; const int pos = row_pos(row < MT ? row : 0);
                    const LAS float* d = LDS_F((rl0 + ai * 128 + m * 16) * 8); const f32x4 e0 = *(const LAS f32x4*)d, e1 = *(const LAS f32x4*)(d + 4);
                    const float inn = rsqrtf((e0[0] + e0[2] + e1[0] + e1[2]) * (1.f / 128.f) + EPS) * rs[ai][m] * C2, inr = rsqrtf((e0[1] + e0[3]) * (1.f / 64.f) + EPS) * rs[ai][m];
                    bf16_t* qrow = Q + (size_t)row * 1536 + h * 192;
                    *(u32x4*)(qrow + cw) = pack8f(acc[ai][0][m][0] * inn * gn[0], acc[ai][0][m][1] * inn * gn[1]);
                    if (wc < 2) { const f32x4 y1 = acc[ai][1][m][0] * inr * gr1, y2 = acc[ai][1][m][1] * inr * gr2;
                        const f32x4 cs0 = *(const f32x4*)(tab32 + pos * 32 + ir), cs1 = *(const f32x4*)(tab32 + pos * 32 + ir + 2);
                        const f32x4 c = {cs0[0], cs0[2], cs1[0], cs1[2]}, s = {cs0[1], cs0[3], cs1[1], cs1[3]};
                        const f32x4 o1 = (y1 * c - y2 * s) * C2, o2 = (y1 * s + y2 * c) * C2;
                        u32x2 w1, w2; w1.x = cvt_pk_bf16(o1[0], o1[1]); w1.y = cvt_pk_bf16(o1[2], o1[3]); w2.x = cvt_pk_bf16(o2[0], o2[1]); w2.y = cvt_pk_bf16(o2[2], o2[3]);
                        *(u32x2*)(qrow + 128 + ir) = w1; *(u32x2*)(qrow + 160 + ir) = w2; } }
        } else {
            bf16_t* const KN = (bf16_t*)(ws + WS_KN); bf16_t* const V = (bf16_t*)(ws + WS_V);
            f32x4 gk[2]; gk[0] = *(const f32x4*)(g_kn + cw); gk[1] = *(const f32x4*)(g_kn + cw + 4);
#pragma unroll
            for (int ai = 0; ai < 2; ++ai)
#pragma unroll
                for (int m = 0; m < 4; ++m) { const int row = rb + ai * 128 + m * 16;
                    const LAS float* d = LDS_F((rl0 + ai * 128 + m * 16) * 8); const f32x4 e0 = *(const LAS f32x4*)d, e1 = *(const LAS f32x4*)(d + 4);
                    const float s = rs[ai][m], inn = rsqrtf((e0[0] + e0[2] + e1[0] + e1[2]) * (1.f / 128.f) + EPS) * s;
                    *(u32x4*)(KN + (size_t)row * 1024 + h * 128 + cw) = pack8f(acc[ai][0][m][0] * inn * gk[0], acc[ai][0][m][1] * inn * gk[1]);
                    *(u32x4*)(V + (size_t)row * 1024 + h * 128 + cw) = pack8f(acc[ai][1][m][0] * s, acc[ai][1][m][1] * s); }
        }
    }
};
__device__ __forceinline__ void p2_qkv(Frame& F, int sample) {
    SchedP2 S{F.x, F.j, (const char*)F.ws, sample};
    EpiP2 E{F.ws, F.out, FIN(10), FIN(11), FIN(14)};
    pg::gemm_stream(F.lds, S, E);
}

struct SchedP5 {
    int x, j, vcu; const char* ws; int phase;
    int i_lo, i_hi;
    int umap;
    __device__ __forceinline__ const char* arow(size_t base, size_t base_s, int pm, size_t rowbytes) const { return ws + (pm < 64 ? base + (size_t)pm * 256 * rowbytes : base_s); }
    __device__ __forceinline__ bool next(int i, pg::UnitG& u) const {
        int pm, pn;
        if (phase == 5) {
            int sub;
            if (i < 4) { sub = i; pm = 8 * x + (j & 7); pn = j >> 3; } else return false;
            u.pm = pm; u.pn = pn; u.kind = K_GA + sub; u.lda = 2048; u.ldb = 2048; u.nt = 16; u.half = pm == 64;
            if (sub == 0) { u.A = ws + WS_XN2 + (size_t)pm * 256 * 2048; u.B = ws + WS_FWIN + (size_t)(18 + pn) * 256 * 2048; }
            else if (sub == 1) { u.A = arow(WS_ATT, WS_ATTS, pm, 2048); u.B = ws + WS_FWOBA + (size_t)pn * 256 * 2048; }
            else if (sub == 2) { u.A = ws + WS_XN2 + (size_t)pm * 256 * 2048; u.B = ws + WS_FWIN + (size_t)(22 + pn) * 256 * 2048; }
            else { u.A = ws + WS_RET + (size_t)pm * 256 * 2048; u.B = ws + WS_FWOBB + (size_t)pn * 256 * 2048; }
            return true;
        }
        if (phase == 6 || phase == 9) {
            if (i == 0) { pm = 8 * x + (j & 7); pn = j >> 3; } else return false;
            u.pm = pm; u.pn = pn; u.half = pm == 64;
            if (phase == 6) { u.kind = K_OUT; u.A = ws + WS_MERGED + (size_t)pm * 256 * 2048; u.lda = 2048; u.B = ws + WS_FWOUT + (size_t)pn * 256 * 2048; u.ldb = 2048; u.nt = 16; }
            else { u.kind = K_DOWN; u.A = ws + WS_UG + (size_t)pm * 256 * (D_FF * 2); u.lda = D_FF * 2; u.B = ws + WS_FWDOWN + (size_t)pn * 256 * (D_FF * 2); u.ldb = D_FF * 2; u.nt = 44; }
            return true;
        }
        if (i_lo < 0) { if (i > 0) return false; pm = 64; pn = i_hi; }
        else if (umap) { const int ii = i + i_lo, q = j >> 3; if (ii >= i_hi) return false;
            if (ii < 4) pn = q + 4 * ii; else if (q == 3) return false; else if (ii == 4) pn = q + 16; else if (ii == 5) pn = q == 2 ? 19 : 20 + q; else return false;
            pm = 8 * x + (j & 7); }
        else if (i + i_lo >= i_hi || !reg_unit(x, j, i + i_lo, 22, pm, pn)) return false;
        u.half = pm == 64; u.pm = pm; u.pn = pn; u.kind = K_UP; u.A = ws + WS_X1B + (size_t)pm * 256 * 2048; u.lda = 2048; u.B = ws + WS_FWUP + (size_t)pn * 256 * 2048; u.ldb = 2048; u.nt = 16;
        return true;
    }
};
struct EpiP5 {
    unsigned char* ws; float* out; const float* xp; const float* xs; int vcu;
    __device__ __forceinline__ void operator()(pg::Acc& acc, const pg::UnitG& u, LAS unsigned char* lds, int wr, int wc, int fr, int fq) const {
        int rl0 = wr * 64 + fr, cw = wc * 32 + fq * 8; asm volatile("" : "+v"(rl0), "+v"(cw));
        const int kind = u.kind, rb = u.pm * 256 + rl0;
        if (kind >= K_GA && kind <= K_RD) {
            bf16_t* const T1 = (bf16_t*)(ws + WS_T1) + (size_t)vcu * 65536; bf16_t* const T2 = (bf16_t*)out + (size_t)vcu * 65536;
            bf16_t* const MG = (bf16_t*)(ws + WS_MERGED);
#pragma unroll
            for (int ai = 0; ai < 2; ++ai)
#pragma unroll
                for (int m = 0; m < 4; ++m)
#pragma unroll
                    for (int bj = 0; bj < 2; ++bj) { const size_t so = (size_t)(rl0 + ai * 128 + m * 16) * 256 + bj * 128 + cw;
                        f32x4 v0 = acc[ai][bj][m][0], v1 = acc[ai][bj][m][1];
                        if (kind == K_GA || kind == K_GB) {
#pragma unroll
                            for (int e = 0; e < 4; ++e) { v0[e] = __builtin_amdgcn_rcpf(1.f + __expf(-v0[e])); v1[e] = __builtin_amdgcn_rcpf(1.f + __expf(-v1[e])); }
                            *(u32x4*)((kind == K_GA ? T1 : T2) + so) = pack8f_t(v0, v1);
                        } else if (kind == K_AD) {
                            const u32x4 t = u.pm == 64 ? *(const u32x4*)((const bf16_t*)(ws + WS_GAS) + (size_t)(rl0 + ai * 128 + m * 16) * 1024 + u.pn * 256 + bj * 128 + cw) : *(const u32x4*)(T1 + so);
                            const f32x4 g0 = {__uint_as_float(t.x << 16), __uint_as_float(t.x & 0xffff0000u), __uint_as_float(t.y << 16), __uint_as_float(t.y & 0xffff0000u)};
                            const f32x4 g1 = {__uint_as_float(t.z << 16), __uint_as_float(t.z & 0xffff0000u), __uint_as_float(t.w << 16), __uint_as_float(t.w & 0xffff0000u)};
                            *(u32x4*)(T1 + so) = pack8f(v0 * g0, v1 * g1);
                        } else {
                            const u32x4 t = *(const u32x4*)(T1 + so), q = u.pm == 64 ? *(const u32x4*)((const bf16_t*)(ws + WS_GBS) + (size_t)(rl0 + ai * 128 + m * 16) * 1024 + u.pn * 256 + bj * 128 + cw) : *(const u32x4*)(T2 + so);
                            const f32x4 a0 = {__uint_as_float(t.x << 16), __uint_as_float(t.x & 0xffff0000u), __uint_as_float(t.y << 16), __uint_as_float(t.y & 0xffff0000u)};
                            const f32x4 a1 = {__uint_as_float(t.z << 16), __uint_as_float(t.z & 0xffff0000u), __uint_as_float(t.w << 16), __uint_as_float(t.w & 0xffff0000u)};
                            const f32x4 g0 = {__uint_as_float(q.x << 16), __uint_as_float(q.x & 0xffff0000u), __uint_as_float(q.y << 16), __uint_as_float(q.y & 0xffff0000u)};
                            const f32x4 g1 = {__uint_as_float(q.z << 16), __uint_as_float(q.z & 0xffff0000u), __uint_as_float(q.w << 16), __uint_as_float(q.w & 0xffff0000u)};
                            *(u32x4*)(MG + (size_t)(rb + ai * 128 + m * 16) * 1024 + u.pn * 256 + bj * 128 + cw) = pack8f(a0 + v0 * g0, a1 + v1 * g1);
                        }
                        if (bj == 1 && (m & 1)) asm volatile("" ::: "memory"); }
        } else if (kind == K_OUT) {
            float* const slotx = (float*)(ws + WS_SLOTX1); bf16_t* const X1B = (bf16_t*)(ws + WS_X1B);
#pragma unroll
            for (int ai = 0; ai < 2; ++ai)
#pragma unroll
                for (int m = 0; m < 4; ++m) { const int row = rb + ai * 128 + m * 16; float ss = 0.f;
                    const float* xr = row < MP ? xp + (size_t)row * D_MODEL : xs + (size_t)((row < MT ? row : MP) - MP) * D_MODEL;
#pragma unroll
                    for (int bj = 0; bj < 2; ++bj) { const int c = u.pn * 256 + bj * 128 + cw;
                        const f32x4 x0 = *(const f32x4*)(xr + c), x1 = *(const f32x4*)(xr + c + 4);
                        const f32x4 v0 = acc[ai][bj][m][0] + x0, v1 = acc[ai][bj][m][1] + x1;
                        ss += (v0[0] * v0[0] + v0[1] * v0[1]) + (v0[2] * v0[2] + v0[3] * v0[3]) + (v1[0] * v1[0] + v1[1] * v1[1]) + (v1[2] * v1[2] + v1[3] * v1[3]);
                        *(u32x4*)(X1B + (size_t)row * D_MODEL + c) = pack8f(v0, v1); }
                    ss += __shfl_xor(ss, 16); ss += __shfl_xor(ss, 32);
                    if (fq == 0) slotx[(size_t)row * 16 + u.pn * 4 + wc] = ss;
                    asm volatile("" ::: "memory"); }
        } else if (kind == K_UP) {
            bf16_t* const U = (bf16_t*)(ws + WS_UG); bf16_t* const UVb = (bf16_t*)(ws + WS_UV);
#pragma unroll
            for (int ai = 0; ai < 2; ++ai)
#pragma unroll
                for (int m = 0; m < 4; ++m) { const int row = rb + ai * 128 + m * 16;
                    const float s = *LDS_F(rl0 + ai * 128 + m * 16);
                    const f32x4 ug0 = acc[ai][0][m][0] * s, ug1 = acc[ai][0][m][1] * s, uv0 = acc[ai][1][m][0] * s, uv1 = acc[ai][1][m][1] * s;
                    const u32x4 wg = pack8f(ug0, ug1), wv = pack8f(uv0, uv1); const int cg = u.pn * 128 + cw, cv = D_FF + cg;
                    *(u32x4*)(U + (size_t)row * D_FF + cg) = wg; *(u32x4*)(UVb + (size_t)row * D_FF + cg) = wv;
                    if ((row & 255) >= 254 && row < MP - 2) { bf16_t* hp = (bf16_t*)(ws + WS_HALO) + ((size_t)((row >> 8) + 1) * 2 + (row & 1)) * FF2; st16_sc1(hp + cg, wg); st16_sc1(hp + cv, wv); }
                    if (row < MT) { const int tpos = row < MP ? (row & (SEQ - 1)) - (SEQ - 2) : ((row - MP) & (DEC_SEQ - 1)) - (DEC_SEQ - 2);
                        if (tpos >= 0) { float* cp = row < MP ? out + O_CONVP + ((size_t)(row >> 13) * 2 + tpos) * FF2 : out + O_CONVS + ((size_t)((row - MP) >> 4) * 2 + tpos) * FF2;
                            *(f32x4*)(cp + cg) = ug0; *(f32x4*)(cp + cg + 4) = ug1; *(f32x4*)(cp + cv) = uv0; *(f32x4*)(cp + cv + 4) = uv1; } }
                    if (m & 1) asm volatile("" ::: "memory"); }
        } else {
            const bf16_t* const X1B = (const bf16_t*)(ws + WS_X1B);
            u32x4 t[2][4][2];
#pragma unroll
            for (int ai = 0; ai < 2; ++ai)
#pragma unroll
                for (int m = 0; m < 4; ++m)
#pragma unroll
                    for (int bj = 0; bj < 2; ++bj) t[ai][m][bj] = *(const u32x4*)(X1B + (size_t)(rb + ai * 128 + m * 16) * D_MODEL + u.pn * 256 + bj * 128 + cw);
            asm volatile("" ::: "memory");
#pragma unroll
            for (int ai = 0; ai < 2; ++ai)
#pragma unroll
                for (int m = 0; m < 4; ++m) { const int row = rb + ai * 128 + m * 16;
#pragma unroll
                    for (int bj = 0; bj < 2; ++bj) { const int c = u.pn * 256 + bj * 128 + cw; float* p = out + (size_t)row * D_MODEL + c; const u32x4 tt = t[ai][m][bj];
                        const f32x4 x0 = {__uint_as_float(tt.x << 16), __uint_as_float(tt.x & 0xffff0000u), __uint_as_float(tt.y << 16), __uint_as_float(tt.y & 0xffff0000u)};
                        const f32x4 x1 = {__uint_as_float(tt.z << 16), __uint_as_float(tt.z & 0xffff0000u), __uint_as_float(tt.w << 16), __uint_as_float(tt.w & 0xffff0000u)};
                        *(f32x4*)p = x0 + acc[ai][bj][m][0]; *(f32x4*)(p + 4) = x1 + acc[ai][bj][m][1]; }
                    if (m & 1) asm volatile("" ::: "memory"); }
        }
    }
};
__device__ __forceinline__ void p5_gemm(Frame& F, int phase) {
    SchedP5 S{F.x, F.j, F.vcu, (const char*)F.ws, phase, 0, 1 << 20, 0};
    EpiP5 E{F.ws, F.out, FIN(0), FIN(1), F.vcu};
    pg::gemm_stream(F.lds, S, E);
}

namespace rt {
typedef short s16x4 __attribute__((ext_vector_type(4)));
constexpr int QST = 136, KDST = 144, VST = 272, PST = 72;
constexpr int Q_OFF = 0, QS_OFF = 17408, K_OFF = 34816, KD_OFF = 52224, V_OFF = 70656, P_OFF = 105472, ST_OFF = 114688, RG_OFF = 118784;
constexpr int SC_TOK = 256, NSC = SEQ / SC_TOK;
__device__ __forceinline__ s16x4 trrd(const LAS bf16_t* p) { return __builtin_bit_cast(s16x4, __builtin_amdgcn_ds_read_tr16_b64_v4i16((LAS s16x4*)p)); }
__device__ __forceinline__ bf16x8 cat8(s16x4 lo, s16x4 hi) { return (bf16x8){lo[0], lo[1], lo[2], lo[3], hi[0], hi[1], hi[2], hi[3]}; }
__device__ __forceinline__ u32x4 scale8(u32x4 w, float s) {
    u32x4 o;
    o.x = cvt_pk_bf16(__uint_as_float(w.x << 16) * s, __uint_as_float(w.x & 0xffff0000u) * s); o.y = cvt_pk_bf16(__uint_as_float(w.y << 16) * s, __uint_as_float(w.y & 0xffff0000u) * s);
    o.z = cvt_pk_bf16(__uint_as_float(w.z << 16) * s, __uint_as_float(w.z & 0xffff0000u) * s); o.w = cvt_pk_bf16(__uint_as_float(w.w << 16) * s, __uint_as_float(w.w & 0xffff0000u) * s);
    return o;
}
__device__ __forceinline__ float row16_sum(float v) {
    v += __builtin_bit_cast(float, __builtin_amdgcn_update_dpp(0, __builtin_bit_cast(int, v), 0xB1, 0xf, 0xf, true));
    v += __builtin_bit_cast(float, __builtin_amdgcn_update_dpp(0, __builtin_bit_cast(int, v), 0x4E, 0xf, 0xf, true));
    v += __builtin_bit_cast(float, __builtin_amdgcn_update_dpp(0, __builtin_bit_cast(int, v), 0x141, 0xf, 0xf, true));
    v += __builtin_bit_cast(float, __builtin_amdgcn_update_dpp(0, __builtin_bit_cast(int, v), 0x140, 0xf, 0xf, true));
    return v;
}
template <bool FULL>
__device__ __forceinline__ void ret_unit(Frame& F, int h, int row0, int nch, int L, const float* Sin, float* Sout, const float* g_ret) {
    LAS unsigned char* lds = F.lds;
    const int tid = F.tid, w = F.wave, l = F.lane, fr = l & 15, g = l >> 4, tq = fr >> 2, tp = fr & 3;
    const float lg2 = log2f(1.f - exp2f(-5.f - (float)h));
    const bf16_t* RQ = (const bf16_t*)(F.ws + WS_RQ); const bf16_t* RK = (const bf16_t*)(F.ws + WS_RK); const bf16_t* RV = (const bf16_t*)(F.ws + WS_RV);
    const bf16_t* RG = (const bf16_t*)(F.ws + WS_RG); bf16_t* RET = (bf16_t*)(F.ws + WS_RET);
    LAS bf16_t* q_l = (LAS bf16_t*)(lds + Q_OFF); LAS bf16_t* qs_l = (LAS bf16_t*)(lds + QS_OFF); LAS bf16_t* k_l = (LAS bf16_t*)(lds + K_OFF);
    LAS bf16_t* kd_l = (LAS bf16_t*)(lds + KD_OFF); LAS bf16_t* v_l = (LAS bf16_t*)(lds + V_OFF); LAS bf16_t* p_l = (LAS bf16_t*)(lds + P_OFF); LAS float* st_l = (LAS float*)(lds + ST_OFF);
    LAS bf16_t* g_l = (LAS bf16_t*)(lds + RG_OFF);
    f32x4 S[8][2];
#pragma unroll
    for (int db = 0; db < 8; ++db)
#pragma unroll
        for (int nb = 0; nb < 2; ++nb) {
            if (Sin) { int so = (16 * db + 4 * g) * RET_DV + 32 * w + 16 * nb + fr; asm volatile("" : "+v"(so));
#pragma unroll
                for (int r = 0; r < 4; ++r) S[db][nb][r] = Sin[so + r * RET_DV]; }
            else S[db][nb] = (f32x4){0.f, 0.f, 0.f, 0.f}; }
    const float gL = exp2f(lg2 * (float)L);
    float gr[2]; if (FULL) { gr[0] = g_ret[h * 256 + 32 * w + fr]; gr[1] = g_ret[h * 256 + 32 * w + 16 + fr]; }
    for (int c = 0; c < nch; ++c) {
        const size_t r0 = (size_t)row0 + (size_t)c * L;
        __syncthreads();
        {   u32x4 pk[2], pq[2], pv[4], pgt[4]; const u32x4 z_ = {0u, 0u, 0u, 0u};
#pragma unroll
            for (int it = 0; it < 2; ++it) { const int idx = tid + 512 * it, tok = idx >> 4, c8 = idx & 15; const bool ok = tok < L;
                pk[it] = ok ? *(const u32x4*)(RK + (r0 + tok) * 512 + h * 128 + c8 * 8) : z_; if (FULL) pq[it] = ok ? *(const u32x4*)(RQ + (r0 + tok) * 512 + h * 128 + c8 * 8) : z_; }
#pragma unroll
            for (int it = 0; it < 4; ++it) { const int idx = tid + 512 * it, tok = idx >> 5, c8 = idx & 31; const bool ok = tok < L;
                pv[it] = ok ? *(const u32x4*)(RV + (r0 + tok) * 1024 + h * 256 + c8 * 8) : z_; if (FULL) pgt[it] = ok ? *(const u32x4*)(RG + (r0 + tok) * 1024 + h * 256 + c8 * 8) : z_; }
#pragma unroll
            for (int it = 0; it < 2; ++it) { const int idx = tid + 512 * it, tok = idx >> 4, c8 = idx & 15;
                *(LAS u32x4*)(kd_l + tok * KDST + c8 * 8) = scale8(pk[it], exp2f(lg2 * (float)(L - 1 - tok)));
                if (FULL) { *(LAS u32x4*)(k_l + tok * QST + c8 * 8) = pk[it]; *(LAS u32x4*)(q_l + tok * QST + c8 * 8) = pq[it]; *(LAS u32x4*)(qs_l + tok * QST + c8 * 8) = scale8(pq[it], exp2f(lg2 * (float)(tok + 1))); } }
#pragma unroll
            for (int it = 0; it < 4; ++it) { const int idx = tid + 512 * it, tok = idx >> 5, c8 = idx & 31;
                *(LAS u32x4*)(v_l + tok * VST + c8 * 8) = pv[it]; if (FULL) *(LAS u32x4*)(g_l + tok * VST + c8 * 8) = pgt[it]; } }
        __syncthreads();
        f32x4 o[4][2];
        if (FULL) {
            const int ib = w >> 1, jb0 = 2 * (w & 1);
            f32x4 p0 = {0.f, 0.f, 0.f, 0.f}, p1 = {0.f, 0.f, 0.f, 0.f};
#pragma unroll
            for (int s = 0; s < 4; ++s) { const bf16x8 a = *(const LAS bf16x8*)(q_l + (16 * ib + fr) * QST + 32 * s + 8 * g);
                const bf16x8 b0 = *(const LAS bf16x8*)(k_l + (16 * jb0 + fr) * QST + 32 * s + 8 * g), b1 = *(const LAS bf16x8*)(k_l + (16 * jb0 + 16 + fr) * QST + 32 * s + 8 * g);
                p0 = __builtin_amdgcn_mfma_f32_16x16x32_bf16(a, b0, p0, 0, 0, 0); p1 = __builtin_amdgcn_mfma_f32_16x16x32_bf16(a, b1, p1, 0, 0, 0); }
#pragma unroll
            for (int r = 0; r < 4; ++r) { const int i = 16 * ib + 4 * g + r, j0 = 16 * jb0 + fr, j1 = j0 + 16;
                const float v0 = j0 <= i ? p0[r] * exp2f(lg2 * (float)(i - j0)) : 0.f, v1 = j1 <= i ? p1[r] * exp2f(lg2 * (float)(i - j1)) : 0.f;
                p_l[i * PST + j0] = f2bf(v0); p_l[i * PST + j1] = f2bf(v1); }
            __syncthreads();
#pragma unroll
            for (int i = 0; i < 4; ++i) { o[i][0] = (f32x4){0.f, 0.f, 0.f, 0.f}; o[i][1] = (f32x4){0.f, 0.f, 0.f, 0.f}; }
        }
        bf16x8 vf[2][2];
#pragma unroll
        for (int s = 0; s < 2; ++s)
#pragma unroll
            for (int nb = 0; nb < 2; ++nb) { const LAS bf16_t* pp = v_l + (32 * s + 8 * g + tq) * VST + 32 * w + 16 * nb + 4 * tp; vf[s][nb] = cat8(trrd(pp), trrd(pp + 4 * VST)); }
        if (FULL) {
#pragma unroll
            for (int i = 0; i < 4; ++i)
#pragma unroll
                for (int s = 0; s < 2; ++s) { const bf16x8 a = *(const LAS bf16x8*)(p_l + (16 * i + fr) * PST + 32 * s + 8 * g);
                    o[i][0] = __builtin_amdgcn_mfma_f32_16x16x32_bf16(a, vf[s][0], o[i][0], 0, 0, 0); o[i][1] = __builtin_amdgcn_mfma_f32_16x16x32_bf16(a, vf[s][1], o[i][1], 0, 0, 0); }
#pragma unroll
            for (int s = 0; s < 4; ++s) {
                bf16x8 bS[2];
#pragma unroll
                for (int nb = 0; nb < 2; ++nb) { u32x4 wv; wv.x = cvt_pk_bf16(S[2 * s][nb][0], S[2 * s][nb][1]); wv.y = cvt_pk_bf16(S[2 * s][nb][2], S[2 * s][nb][3]);
                    wv.z = cvt_pk_bf16(S[2 * s + 1][nb][0], S[2 * s + 1][nb][1]); wv.w = cvt_pk_bf16(S[2 * s + 1][nb][2], S[2 * s + 1][nb][3]); bS[nb] = __builtin_bit_cast(bf16x8, wv); }
#pragma unroll
                for (int i = 0; i < 4; ++i) { const LAS bf16_t* qp = qs_l + (16 * i + fr) * QST + 32 * s + 4 * g;
                    const s16x4 lo = *(const LAS s16x4*)qp, hi = *(const LAS s16x4*)(qp + 16); const bf16x8 a = cat8(lo, hi);
                    o[i][0] = __builtin_amdgcn_mfma_f32_16x16x32_bf16(a, bS[0], o[i][0], 0, 0, 0); o[i][1] = __builtin_amdgcn_mfma_f32_16x16x32_bf16(a, bS[1], o[i][1], 0, 0, 0); }
            }
        }
#pragma unroll
        for (int db = 0; db < 8; ++db) { S[db][0] = S[db][0] * gL; S[db][1] = S[db][1] * gL; }
#pragma unroll
        for (int s = 0; s < 2; ++s)
#pragma unroll
            for (int db = 0; db < 8; ++db) { const LAS bf16_t* pp = kd_l + (32 * s + 8 * g + tq) * KDST + 16 * db + 4 * tp; const bf16x8 a = cat8(trrd(pp), trrd(pp + 4 * KDST));
                S[db][0] = __builtin_amdgcn_mfma_f32_16x16x32_bf16(a, vf[s][0], S[db][0], 0, 0, 0); S[db][1] = __builtin_amdgcn_mfma_f32_16x16x32_bf16(a, vf[s][1], S[db][1], 0, 0, 0); }
        if (FULL) {
#pragma unroll
            for (int i = 0; i < 4; ++i)
#pragma unroll
                for (int r = 0; r < 4; ++r) { float sm = o[i][0][r] + o[i][1][r], sq = o[i][0][r] * o[i][0][r] + o[i][1][r] * o[i][1][r];
                    sm = row16_sum(sm); sq = row16_sum(sq);
                    if (fr == 0) { LAS float* d = st_l + ((16 * i + 4 * g + r) * 8 + w) * 2; d[0] = sm; d[1] = sq; } }
            __syncthreads();
#pragma unroll
            for (int i = 0; i < 4; ++i)
#pragma unroll
                for (int r = 0; r < 4; ++r) { const int tok = 16 * i + 4 * g + r;
                    const LAS f32x4* d = (const LAS f32x4*)(st_l + tok * 16); const f32x4 a0 = d[0], a1 = d[1], a2 = d[2], a3 = d[3];
                    const float sm = (a0[0] + a0[2]) + (a1[0] + a1[2]) + (a2[0] + a2[2]) + (a3[0] + a3[2]), sq = (a0[1] + a0[3]) + (a1[1] + a1[3]) + (a2[1] + a2[3]) + (a3[1] + a3[3]);
                    const float mu = sm * (1.f / 256.f), var = fmaxf(sq * (1.f / 256.f) - mu * mu, 0.f), rstd = rsqrtf(var + EPS);
#pragma unroll
                    for (int nb = 0; nb < 2; ++nb) { LAS bf16_t* ge = g_l + tok * VST + 32 * w + 16 * nb + fr; *ge = f2bf((o[i][nb][r] - mu) * rstd * gr[nb] * bf2f(*ge)); } }
            __syncthreads();
#pragma unroll
            for (int it = 0; it < 4; ++it) { const int idx = tid + 512 * it, tok = idx >> 5, c8 = idx & 31;
                if (tok < L) *(u32x4*)(RET + (r0 + tok) * 1024 + h * 256 + c8 * 8) = *(const LAS u32x4*)(g_l + tok * VST + c8 * 8); }
        }
    }
    if (Sout) {
#pragma unroll
        for (int db = 0; db < 8; ++db)
#pragma unroll
            for (int nb = 0; nb < 2; ++nb) { int so = (16 * db + 4 * g) * RET_DV + 32 * w + 16 * nb + fr; asm volatile("" : "+v"(so));
#pragma unroll
                for (int r = 0; r < 4; ++r) Sout[so + r * RET_DV] = S[db][nb][r]; }
    }
}
}
__device__ __forceinline__ void r1_states(Frame& F) {
    const int bh = F.vcu >> 5, sc = F.vcu & 31, b = bh >> 2, h = bh & 3;
    rt::ret_unit<false>(F, h, b * SEQ + sc * rt::SC_TOK, 4, 64, nullptr, F.out + ((size_t)bh * rt::NSC + sc) * 32768, nullptr);
}
__device__ __forceinline__ void r2_scan(Frame& F) {
    float* U = F.out; const int gt = F.vcu * NTHR + F.tid;
    if (gt < MPAD) { const float* sq_ = (const float*)(F.ws + WS_SLOTQ) + (size_t)gt * 12; const float* sk_ = (const float*)(F.ws + WS_SLOTKV) + (size_t)gt * 8; float a = 0.f, b = 0.f;
#pragma unroll
        for (int i = 0; i < 12; ++i) a += sq_[i];
#pragma unroll
        for (int i = 0; i < 8; ++i) b += sk_[i];
        ((float*)(F.ws + WS_RSQ))[gt] = rsqrtf(a * (1.f / Q_LORA) + EPS); ((float*)(F.ws + WS_RSKV))[gt] = rsqrtf(b * (1.f / KV_LORA) + EPS); }
    for (int e = gt; e < 8 * 32768; e += F.G * NTHR) { const int bh = e >> 15, idx = e & 32767, h = bh & 3;
        const float g256 = exp2f(log2f(1.f - exp2f(-5.f - (float)h)) * 256.f);
        float u[32];
#pragma unroll
        for (int sc = 0; sc < 32; ++sc) u[sc] = U[((size_t)bh * 32 + sc) * 32768 + idx];
        float carry = 0.f;
#pragma unroll
        for (int sc = 0; sc < 32; ++sc) { U[((size_t)bh * 32 + sc) * 32768 + idx] = carry; carry = g256 * carry + u[sc]; }
        F.out[O_RETP + (size_t)bh * 32768 + idx] = carry; }
}
__device__ __forceinline__ void r3_outputs(Frame& F) {
    const int bh = F.vcu >> 5, sc = F.vcu & 31, b = bh >> 2, h = bh & 3;
    rt::ret_unit<true>(F, h, b * SEQ + sc * rt::SC_TOK, 4, 64, F.out + ((size_t)bh * rt::NSC + sc) * 32768, nullptr, FIN(16));
    if (F.vcu < DEC_BATCH * RET_H) { const int sb = F.vcu >> 2, sh = F.vcu & 3;
        rt::ret_unit<true>(F, sh, MP + sb * DEC_SEQ, 1, DEC_SEQ, FIN(4) + (size_t)F.vcu * 32768, F.out + O_RETS + (size_t)F.vcu * 32768, FIN(16)); }
}

namespace at {
typedef float f32x16 __attribute__((ext_vector_type(16)));
typedef short s16x4 __attribute__((ext_vector_type(4)));
constexpr int KN_ST = 272, KP_ST = 144;
constexpr int KN_B = 64 * KN_ST, KP_B = 64 * KP_ST, V_B = 16384, BUF_B = KN_B + KP_B + V_B;
constexpr int SCR_OFF = 2 * BUF_B;
constexpr float THR = 8.f;
__device__ __forceinline__ int v_st(int k, int c) { const int kk = (k & ~0xC) | ((k & 4) << 1) | ((k & 8) >> 1); return ((kk >> 3) * 4 + (c >> 5)) * 512 + ((kk & 7) * 32 + (c & 31)) * 2; }
__device__ __forceinline__ int v_rd_base(int lane) { return ((lane & 3) << 3) | (((lane >> 2) & 3) << 6) | (((lane >> 4) & 1) << 5) | (((lane >> 5) & 1) << 8); }
constexpr int v_rd_off(int d0, int ks, int half) { return d0 * 512 + ks * 4096 + half * 2048; }
__device__ __forceinline__ int crow(int r, int hi) { return (r & 3) + 8 * (r >> 2) + 4 * hi; }
#define AT_SBAR() __builtin_amdgcn_sched_barrier(0)

__device__ __forceinline__ void qkt(f32x16& p0, f32x16& p1, const LAS unsigned char* kn, const LAS unsigned char* kp, const bf16x8* qr) {
    p0 = f32x16{}; p1 = f32x16{};
#pragma unroll
    for (int d0 = 0; d0 < 8; ++d0) { const bf16x8 a0 = *(const LAS bf16x8*)(kn + d0 * 32), a1 = *(const LAS bf16x8*)(kn + d0 * 32 + 32 * KN_ST);
        p0 = __builtin_amdgcn_mfma_f32_32x32x16_bf16(a0, qr[d0], p0, 0, 0, 0); p1 = __builtin_amdgcn_mfma_f32_32x32x16_bf16(a1, qr[d0], p1, 0, 0, 0); }
#pragma unroll
    for (int d0 = 0; d0 < 4; ++d0) { const bf16x8 a0 = *(const LAS bf16x8*)(kp + d0 * 32), a1 = *(const LAS bf16x8*)(kp + d0 * 32 + 32 * KP_ST);
        p0 = __builtin_amdgcn_mfma_f32_32x32x16_bf16(a0, qr[8 + d0], p0, 0, 0, 0); p1 = __builtin_amdgcn_mfma_f32_32x32x16_bf16(a1, qr[8 + d0], p1, 0, 0, 0); }
}
__device__ __forceinline__ void pv_tile(f32x16* o, int vb0, bf16x8 pa0, bf16x8 pa1, bf16x8 pa2, bf16x8 pa3) {
#define AT_TRRD(dst, off) asm volatile("ds_read_b64_tr_b16 %0, %1 offset:%2" : "=&v"(dst) : "v"(vb0), "i"(off) : "memory")
#define AT_PV_D0(d0) do { s16x4 l0, l1, l2, l3, h0, h1, h2, h3; constexpr int b_ = v_rd_off(d0, 0, 0);   \
        AT_TRRD(l0, b_); AT_TRRD(h0, b_ + 2048); AT_TRRD(l1, b_ + 4096); AT_TRRD(h1, b_ + 6144); AT_TRRD(l2, b_ + 8192); AT_TRRD(h2, b_ + 10240); AT_TRRD(l3, b_ + 12288); AT_TRRD(h3, b_ + 14336); \
        asm volatile("s_waitcnt lgkmcnt(0)" ::: "memory"); AT_SBAR();   \
        o[d0] = __builtin_amdgcn_mfma_f32_32x32x16_bf16(pa0, (bf16x8){l0[0], l0[1], l0[2], l0[3], h0[0], h0[1], h0[2], h0[3]}, o[d0], 0, 0, 0);   \
        o[d0] = __builtin_amdgcn_mfma_f32_32x32x16_bf16(pa1, (bf16x8){l1[0], l1[1], l1[2], l1[3], h1[0], h1[1], h1[2], h1[3]}, o[d0], 0, 0, 0);   \
        o[d0] = __builtin_amdgcn_mfma_f32_32x32x16_bf16(pa2, (bf16x8){l2[0], l2[1], l2[2], l2[3], h2[0], h2[1], h2[2], h2[3]}, o[d0], 0, 0, 0);   \
        o[d0] = __builtin_amdgcn_mfma_f32_32x32x16_bf16(pa3, (bf16x8){l3[0], l3[1], l3[2], l3[3], h3[0], h3[1], h3[2], h3[3]}, o[d0], 0, 0, 0); } while (0)
    AT_PV_D0(0); AT_PV_D0(1); AT_PV_D0(2); AT_PV_D0(3);
#undef AT_PV_D0
#undef AT_TRRD
}
template <bool PARTIAL>
__device__ __forceinline__ void attn_unit(LAS unsigned char* lds, const bf16_t* Qw, const bf16_t* KN, const bf16_t* KPE, const bf16_t* V, bf16_t* Ow, float* Pw, int NT, int tmax_w, int nkeys, int orows, int t0, int tstride) {
    const int tid = threadIdx.x, wid = __builtin_amdgcn_readfirstlane(tid >> 6), lane = tid & 63, r32 = lane & 31, hi = lane >> 5;
    bf16x8 qr[12];
#pragma unroll
    for (int d0 = 0; d0 < 12; ++d0) qr[d0] = *(const bf16x8*)(Qw + (size_t)r32 * 1536 + d0 * 16 + hi * 8);
    const int sr = tid >> 4, sc = (tid & 15) * 8, pr = tid >> 3, pc = (tid & 7) * 8;
    const int kn_w0 = sr * KN_ST + sc * 2, kn_w1 = (32 + sr) * KN_ST + sc * 2, kp_w = KN_B + pr * KP_ST + pc * 2, v_w0 = KN_B + KP_B + v_st(sr, sc), v_w1 = KN_B + KP_B + v_st(32 + sr, sc);
    const int kn_r = r32 * KN_ST + hi * 16, kp_r = KN_B + r32 * KP_ST + hi * 16;
    const int vb_base = (int)(unsigned)(uintptr_t)(lds + KN_B + KP_B) + v_rd_base(lane);
    LAS float* scr = (LAS float*)(lds + SCR_OFF) + wid * 64;
    float m_reg = -1e30f, l_reg = 0.f; f32x16 o[4] = {};
    u32x4 st_kn0, st_kn1, st_kp, st_v0, st_v1;
#define AT_LOAD(t) do { const size_t k0_ = (size_t)(t0 + (t) * tstride) * 64; const bool v0_ = (int)k0_ + sr < nkeys, v1_ = (int)k0_ + 32 + sr < nkeys, vp_ = (int)k0_ + pr < nkeys; const u32x4 z_ = {0u, 0u, 0u, 0u}; \
        st_kn0 = v0_ ? *(const u32x4*)(KN + (k0_ + sr) * 1024 + sc) : z_; st_kn1 = v1_ ? *(const u32x4*)(KN + (k0_ + 32 + sr) * 1024 + sc) : z_; \
        st_v0 = v0_ ? *(const u32x4*)(V + (k0_ + sr) * 1024 + sc) : z_; st_v1 = v1_ ? *(const u32x4*)(V + (k0_ + 32 + sr) * 1024 + sc) : z_; \
        st_kp = vp_ ? *(const u32x4*)(KPE + (k0_ + pr) * 64 + pc) : z_; } while (0)
#define AT_WRITE(bf) do { LAS unsigned char* b_ = lds + (bf) * BUF_B; *(LAS u32x4*)(b_ + kn_w0) = st_kn0; *(LAS u32x4*)(b_ + kn_w1) = st_kn1; *(LAS u32x4*)(b_ + kp_w) = st_kp; \
        *(LAS u32x4*)(b_ + v_w0) = st_v0; *(LAS u32x4*)(b_ + v_w1) = st_v1; } while (0)
    AT_LOAD(0); AT_WRITE(0);
    __syncthreads();
    for (int t = 0; t < NT; ++t) {
        const int bf = t & 1;
        if (t + 1 < NT) AT_LOAD(t + 1);
        if (t <= tmax_w) {
            f32x16 p0, p1;
            const LAS unsigned char* bb = lds + bf * BUF_B;
            qkt(p0, p1, bb + kn_r, bb + kp_r, qr);
            if ((t0 + t * tstride + 1) * 64 > nkeys) {
                const int kb = (t0 + t * tstride) * 64 + 4 * hi;
#pragma unroll
                for (int r = 0; r < 16; ++r) { const int kv = kb + (r & 3) + 8 * (r >> 2); if (kv >= nkeys) p0[r] = -INFINITY; if (kv + 32 >= nkeys) p1[r] = -INFINITY; } }
            float pmax = p0[0];
#pragma unroll
            for (int r = 1; r < 16; ++r) pmax = fmaxf(pmax, p0[r]);
#pragma unroll
            for (int r = 0; r < 16; ++r) pmax = fmaxf(pmax, p1[r]);
            { auto rr = __builtin_amdgcn_permlane32_swap(__float_as_uint(pmax), __float_as_uint(pmax), false, false); pmax = fmaxf(__uint_as_float(rr[0]), __uint_as_float(rr[1])); }
            float alpha = 1.f; bool resc = false;
            if (!__all(pmax - m_reg <= THR)) { const float mn = fmaxf(m_reg, pmax); alpha = __builtin_amdgcn_exp2f(m_reg - mn); m_reg = mn; resc = true; }
#pragma unroll
            for (int r = 0; r < 16; ++r) { p0[r] = __builtin_amdgcn_exp2f(p0[r] - m_reg); p1[r] = __builtin_amdgcn_exp2f(p1[r] - m_reg); }
            float ps = 0.f;
#pragma unroll
            for (int r = 0; r < 16; ++r) ps += p0[r] + p1[r];
            { auto rr = __builtin_amdgcn_permlane32_swap(__float_as_uint(ps), __float_as_uint(ps), false, false); ps = __uint_as_float(rr[0]) + __uint_as_float(rr[1]); }
            l_reg = l_reg * alpha + ps;
            bf16x8 pa0, pa1, pa2, pa3;
#define AT_PK4(P, B_, OUT) do { unsigned a0 = cvt_pk_bf16(P[B_ + 0], P[B_ + 1]), a1 = cvt_pk_bf16(P[B_ + 2], P[B_ + 3]); unsigned b0 = cvt_pk_bf16(P[B_ + 4], P[B_ + 5]), b1 = cvt_pk_bf16(P[B_ + 6], P[B_ + 7]); \
        auto r0 = __builtin_amdgcn_permlane32_swap(a0, b0, false, false); auto r1 = __builtin_amdgcn_permlane32_swap(a1, b1, false, false); \
        u32x4 w_ = {r0[0], r1[0], r0[1], r1[1]}; OUT = __builtin_bit_cast(bf16x8, w_); } while (0)
            AT_PK4(p0, 0, pa0); AT_PK4(p0, 8, pa1); AT_PK4(p1, 0, pa2); AT_PK4(p1, 8, pa3);
#undef AT_PK4
            if (resc) { if (hi == 0) scr[r32] = alpha; asm volatile("s_waitcnt lgkmcnt(0)" ::: "memory");
#pragma unroll
                for (int d_ = 0; d_ < 4; ++d_)
#pragma unroll
                    for (int r = 0; r < 16; ++r) o[d_][r] *= scr[crow(r, hi)]; }
            AT_SBAR();
            pv_tile(o, vb_base + bf * BUF_B, pa0, pa1, pa2, pa3);
        }
        if (t + 1 < NT) AT_WRITE(bf ^ 1);
        __syncthreads();
    }
    if (PARTIAL) {
        if (wid == 0) {
#pragma unroll
            for (int r = 0; r < 16; ++r) { const int orow = crow(r, hi); if (orow < orows) {
#pragma unroll
                for (int d0 = 0; d0 < 4; ++d0) Pw[orow * 132 + d0 * 32 + r32] = o[d0][r]; } }
            if (hi == 0 && r32 < orows) { Pw[r32 * 132 + 128] = m_reg; Pw[r32 * 132 + 129] = l_reg; } }
        __syncthreads();
        return;
    }
    if (hi == 0) scr[32 + r32] = l_reg; asm volatile("s_waitcnt lgkmcnt(0)" ::: "memory");
#pragma unroll
    for (int r = 0; r < 16; ++r) { const int orow = crow(r, hi); const float rl = __builtin_amdgcn_rcpf(scr[32 + orow]);
#pragma unroll
        for (int d0 = 0; d0 < 4; ++d0) { const float v = o[d0][r] * rl; const float vn = __shfl_xor(v, 1);
            if ((r32 & 1) == 0 && orow < orows) *(unsigned*)(Ow + (size_t)orow * 1024 + d0 * 32 + r32) = cvt_pk_bf16(v, vn); } }
    __syncthreads();
#undef AT_LOAD
#undef AT_WRITE
}
#undef AT_SBAR
}
__device__ __forceinline__ void p3_attn_prompt(Frame& F) {
    const int bh = F.vcu >> 4, s = F.vcu & 15, b = bh >> 3, h = bh & 7;
    const bf16_t* Q = (const bf16_t*)F.out; const bf16_t* KN = (const bf16_t*)(F.ws + WS_KN); const bf16_t* KPE = (const bf16_t*)(F.ws + WS_KPE); const bf16_t* V = (const bf16_t*)(F.ws + WS_V); bf16_t* ATT = (bf16_t*)(F.ws + WS_ATT);
#pragma unroll 1
    for (int it = 0; it < 2; ++it) { const int qb = it == 0 ? s : 31 - s; const size_t row0 = (size_t)b * SEQ + (size_t)qb * 256 + F.wave * 32;
        at::attn_unit<false>(F.lds, Q + row0 * 1536 + h * 192, KN + (size_t)b * SEQ * 1024 + h * 128, KPE + (size_t)b * SEQ * 64, V + (size_t)b * SEQ * 1024 + h * 128,
                      ATT + row0 * 1024 + h * 128, nullptr, 4 * qb + 4, 4 * qb + (F.wave >> 1), 1 << 30, 32, 0, 1); }
}
__device__ __forceinline__ void xn_rows(Frame& F, bf16_t* XN, int gw, int NGW) {
    for (int r = gw; r < MPAD; r += NGW) {
        u32x2* o8 = (u32x2*)(XN + (size_t)r * D_MODEL) + F.lane;
        if (r >= MT) { for (int jj = 0; jj < 4; ++jj) o8[64 * jj] = (u32x2){0u, 0u}; continue; }
        const float* x = r < MP ? FIN(0) + (size_t)r * D_MODEL : FIN(1) + (size_t)(r - MP) * D_MODEL;
        const f32x4* xr = (const f32x4*)x + F.lane; f32x4 v[4]; float s = 0.f;
#pragma unroll
        for (int jj = 0; jj < 4; ++jj) { v[jj] = xr[64 * jj]; s += (v[jj][0] * v[jj][0] + v[jj][1] * v[jj][1]) + (v[jj][2] * v[jj][2] + v[jj][3] * v[jj][3]); }
        const float inv = rsqrtf(fwave_sum(s) * (1.f / D_MODEL) + EPS);
#pragma unroll
        for (int jj = 0; jj < 4; ++jj) { u32x2 w; w.x = cvt_pk_bf16(v[jj][0] * inv, v[jj][1] * inv); w.y = cvt_pk_bf16(v[jj][2] * inv, v[jj][3] * inv); o8[64 * jj] = w; }
    }
}
constexpr size_t WS_PART = WS_ATTS + 512 * KiB;
__device__ __forceinline__ void p3_attn_sample(Frame& F) {
    {   const int bh = F.vcu >> 2, part = F.vcu & 3, b = bh >> 3, h = bh & 7;
        const bf16_t* Q = (const bf16_t*)F.out; const bf16_t* KN = (const bf16_t*)(F.ws + WS_KN); const bf16_t* PES = (const bf16_t*)(F.ws + WS_PES); const bf16_t* V = (const bf16_t*)(F.ws + WS_V);
        const size_t row0 = (size_t)MP + (size_t)b * DEC_SEQ;
        at::attn_unit<true>(F.lds, Q + row0 * 1536 + h * 192, KN + (size_t)b * SKEYS * 1024 + h * 128, PES + (size_t)b * SKEYS * 64, V + (size_t)b * SKEYS * 1024 + h * 128,
                            nullptr, (float*)(F.ws + WS_PART) + (size_t)F.vcu * 16 * 132, part == 0 ? 9 : 8, F.wave == 0 ? 1000 : -1, SKEYS, DEC_SEQ, part, 4); }
}
__device__ __forceinline__ void p5_side(Frame& F) {
    if (F.j < 2) return;
    const int q = F.x * 30 + (F.j - 2);
    xn_rows(F, (bf16_t*)(F.ws + WS_XN2), q * 8 + F.wave, 240 * 8);
    {   const int gw = q * 8 + F.wave, NGW = 240 * 8; const bf16_t* KVL = (const bf16_t*)(F.ws + WS_KVL); const float* slotkv = (const float*)(F.ws + WS_SLOTKV);
        for (int r = gw; r < MT; r += NGW) { const float s = ((const float*)(F.ws + WS_RSKV))[r];
            float* o = r < MP ? F.out + O_LATP + (size_t)r * KV_LORA : F.out + O_LATS + (size_t)(r - MP) * KV_LORA;
            const u32x4 w = *((const u32x4*)(KVL + (size_t)r * KV_LORA) + F.lane);
            f32x4 a = {__uint_as_float(w.x << 16), __uint_as_float(w.x & 0xffff0000u), __uint_as_float(w.y << 16), __uint_as_float(w.y & 0xffff0000u)};
            f32x4 c = {__uint_as_float(w.z << 16), __uint_as_float(w.z & 0xffff0000u), __uint_as_float(w.w << 16), __uint_as_float(w.w & 0xffff0000u)};
            *((f32x4*)o + 2 * F.lane) = a * s; *((f32x4*)o + 2 * F.lane + 1) = c * s; } }
}
__device__ __forceinline__ void attn_sample_combine(Frame& F) {
    if (F.vcu >= DEC_BATCH * HEADS) return;
    const int b = F.vcu >> 3, h = F.vcu & 7; const float* P = (const float*)(F.ws + WS_PART) + (size_t)F.vcu * 4 * 16 * 132; bf16_t* ATTS = (bf16_t*)(F.ws + WS_ATTS);
    for (int e = F.tid; e < 16 * 128; e += NTHR) { const int q = e >> 7, d = e & 127;
        float m[4], M = -1e30f;
#pragma unroll
        for (int p = 0; p < 4; ++p) { m[p] = P[(p * 16 + q) * 132 + 128]; M = fmaxf(M, m[p]); }
        float num = 0.f, den = 0.f;
#pragma unroll
        for (int p = 0; p < 4; ++p) { const float w = exp2f(m[p] - M); num += w * P[(p * 16 + q) * 132 + d]; den += w * P[(p * 16 + q) * 132 + 129]; }
        ATTS[(size_t)(b * DEC_SEQ + q) * 1024 + h * 128 + d] = f2bf(num / den); }
}
__device__ __forceinline__ void unpack8(const u32x4 w, float* f) {
    f[0] = __uint_as_float(w.x << 16); f[1] = __uint_as_float(w.x & 0xffff0000u); f[2] = __uint_as_float(w.y << 16); f[3] = __uint_as_float(w.y & 0xffff0000u);
    f[4] = __uint_as_float(w.z << 16); f[5] = __uint_as_float(w.z & 0xffff0000u); f[6] = __uint_as_float(w.w << 16); f[7] = __uint_as_float(w.w & 0xffff0000u);
}
template <int STEPS>
__device__ __forceinline__ void conv_thread(Frame& F, bool on, int r0, int n, int hist, int hch) {
    bf16_t* UG = (bf16_t*)(F.ws + WS_UG); const bf16_t* UV = (const bf16_t*)(F.ws + WS_UV); const float* cw = FIN(21); const float* cb = FIN(22);
    const int nv = n + D_FF;
    float wg[3][8], wv[3][8], bg[8], bv[8], g2[8], g1[8], v2[8], v1[8];
    u32x4 rg[8], rv[8];
#pragma unroll
    for (int e = 0; e < 8; ++e) { g2[e] = 0.f; g1[e] = 0.f; v2[e] = 0.f; v1[e] = 0.f; }
    if (on) {
#pragma unroll
        for (int i = 0; i < 8; ++i) { rg[i] = *(const u32x4*)(UG + (size_t)(r0 + i) * D_FF + n); rv[i] = *(const u32x4*)(UV + (size_t)(r0 + i) * D_FF + n); }
#pragma unroll
        for (int k = 0; k < 3; ++k) { const f32x4 a0 = *(const f32x4*)(cw + k * FF2 + n), a1 = *(const f32x4*)(cw + k * FF2 + n + 4), c0 = *(const f32x4*)(cw + k * FF2 + nv), c1 = *(const f32x4*)(cw + k * FF2 + nv + 4);
#pragma unroll
            for (int e = 0; e < 4; ++e) { wg[k][e] = a0[e]; wg[k][4 + e] = a1[e]; wv[k][e] = c0[e]; wv[k][4 + e] = c1[e]; } }
        { const f32x4 a0 = *(const f32x4*)(cb + n), a1 = *(const f32x4*)(cb + n + 4), c0 = *(const f32x4*)(cb + nv), c1 = *(const f32x4*)(cb + nv + 4);
#pragma unroll
          for (int e = 0; e < 4; ++e) { bg[e] = a0[e]; bg[4 + e] = a1[e]; bv[e] = c0[e]; bv[4 + e] = c1[e]; } }
        if (hist == 1) { unpack8(*(const u32x4*)(UG + (size_t)(r0 - 2) * D_FF + n), g2); unpack8(*(const u32x4*)(UG + (size_t)(r0 - 1) * D_FF + n), g1); unpack8(*(const u32x4*)(UV + (size_t)(r0 - 2) * D_FF + n), v2); unpack8(*(const u32x4*)(UV + (size_t)(r0 - 1) * D_FF + n), v1); }
        else if (hist == 2) { const bf16_t* hp = (const bf16_t*)(F.ws + WS_HALO) + (size_t)hch * 2 * FF2; unpack8(*(const u32x4*)(hp + n), g2); unpack8(*(const u32x4*)(hp + FF2 + n), g1); unpack8(*(const u32x4*)(hp + nv), v2); unpack8(*(const u32x4*)(hp + FF2 + nv), v1); }
        else if (hist == 3) { const float* pp = FIN(5) + (size_t)hch * 2 * FF2;
#pragma unroll
            for (int e = 0; e < 8; ++e) { g2[e] = pp[n + e]; g1[e] = pp[FF2 + n + e]; v2[e] = pp[nv + e]; v1[e] = pp[FF2 + nv + e]; } }
    }
    __syncthreads();
    if (on) {
#pragma unroll
        for (int s = 0; s < STEPS; ++s) {
#pragma unroll
            for (int i = 0; i < 8; ++i) { float g0[8], v0[8], h[8]; unpack8(rg[i], g0); unpack8(rv[i], v0);
#pragma unroll
                for (int e = 0; e < 8; ++e) { const float cg = g2[e] * wg[0][e] + g1[e] * wg[1][e] + g0[e] * wg[2][e] + bg[e], cv = v2[e] * wv[0][e] + v1[e] * wv[1][e] + v0[e] * wv[2][e] + bv[e];
                    h[e] = cg * __builtin_amdgcn_rcpf(1.f + __expf(-cg)) * cv; g2[e] = g1[e]; g1[e] = g0[e]; v2[e] = v1[e]; v1[e] = v0[e]; }
                u32x4 w; w.x = cvt_pk_bf16(h[0], h[1]); w.y = cvt_pk_bf16(h[2], h[3]); w.z = cvt_pk_bf16(h[4], h[5]); w.w = cvt_pk_bf16(h[6], h[7]);
                *(u32x4*)(UG + (size_t)(r0 + 8 * s + i) * D_FF + n) = w; }
            if (s + 1 < STEPS) {
#pragma unroll
                for (int i = 0; i < 8; ++i) { rg[i] = *(const u32x4*)(UG + (size_t)(r0 + 8 * (s + 1) + i) * D_FF + n); rv[i] = *(const u32x4*)(UV + (size_t)(r0 + 8 * (s + 1) + i) * D_FF + n); } }
        }
    }
}
namespace sk {
__device__ __forceinline__ int wrow(int c) { const int c5 = c & 31; return (c & ~31) + 16 * ((c5 >> 2) & 1) + 4 * (c5 >> 3) + (c5 & 3); }
__device__ __forceinline__ f32x4 mm(LAS unsigned char* lds, const bf16_t* __restrict__ A, size_t lda, const bf16_t* __restrict__ Bp, int K, int w, int lane) {
    const int fr = lane & 15, g = lane >> 4, ksteps = K >> 5;
    f32x4 acc[8];
#pragma unroll
    for (int b = 0; b < 8; ++b) acc[b] = (f32x4){0.f, 0.f, 0.f, 0.f};
    const bf16_t* Ap = A + (size_t)fr * lda + 8 * g;
    for (int s0 = w; s0 < ksteps; s0 += 32) {
        bf16x8 bq[4], aq[4][8];
#pragma unroll
        for (int q = 0; q < 4; ++q) { const int s = s0 + 8 * q; const bool ok = s < ksteps; const bf16x8 z = {0, 0, 0, 0, 0, 0, 0, 0};
            bq[q] = ok ? *(const bf16x8*)(Bp + 32 * s) : z;
#pragma unroll
            for (int b = 0; b < 8; ++b) aq[q][b] = ok ? *(const bf16x8*)(Ap + (size_t)(16 * b) * lda + 32 * s) : z; }
#pragma unroll
        for (int q = 0; q < 4; ++q)
#pragma unroll
            for (int b = 0; b < 8; ++b) acc[b] = __builtin_amdgcn_mfma_f32_16x16x32_bf16(aq[q][b], bq[q], acc[b], 0, 0, 0);
    }
    LAS f32x4* red = (LAS f32x4*)lds;
#pragma unroll
    for (int b = 0; b < 8; ++b) red[(w * 8 + b) * 64 + lane] = acc[b];
    __syncthreads();
    f32x4 r = red[w * 64 + lane];
#pragma unroll
    for (int ww = 1; ww < 8; ++ww) r = r + red[(ww * 8 + w) * 64 + lane];
    __syncthreads();
    return r;
}
}
__device__ __forceinline__ void sk_merge(Frame& F, int su) {
    const int lane_ = (int)(threadIdx.x & 63), w = __builtin_amdgcn_readfirstlane((int)(threadIdx.x >> 6)), fr = lane_ & 15, g = lane_ >> 4, c = 16 * su + fr, wr_ = sk::wrow(c);
    const bf16_t* ATTS = (const bf16_t*)(F.ws + WS_ATTS); const bf16_t* RET = (const bf16_t*)(F.ws + WS_RET) + (size_t)MP * 1024;
    const f32x4 aA = sk::mm(F.lds, ATTS, 1024, (const bf16_t*)(F.ws + WS_FWOBA) + (size_t)wr_ * 1024 + 8 * g, 1024, w, lane_);
    const f32x4 aR = sk::mm(F.lds, RET, 1024, (const bf16_t*)(F.ws + WS_FWOBB) + (size_t)wr_ * 1024 + 8 * g, 1024, w, lane_);
    const bf16_t* gas_ = (const bf16_t*)(F.ws + WS_GAS); const bf16_t* gbs_ = (const bf16_t*)(F.ws + WS_GBS); bf16_t* MG = (bf16_t*)(F.ws + WS_MERGED) + (size_t)MP * 1024;
#pragma unroll
    for (int r = 0; r < 4; ++r) { const size_t i = (size_t)(16 * w + 4 * g + r) * 1024 + c; MG[i] = f2bf(bf2f(gas_[i]) * aA[r] + bf2f(gbs_[i]) * aR[r]); }
}
__device__ __forceinline__ void sk_out(Frame& F, int su) {
    const int lane_ = (int)(threadIdx.x & 63), w = __builtin_amdgcn_readfirstlane((int)(threadIdx.x >> 6)), fr = lane_ & 15, g = lane_ >> 4, c = 16 * su + fr;
    const bf16_t* MG = (const bf16_t*)(F.ws + WS_MERGED) + (size_t)MP * 1024;
    const f32x4 a = sk::mm(F.lds, MG, 1024, (const bf16_t*)(F.ws + WS_FWOUT) + (size_t)sk::wrow(c) * 1024 + 8 * g, 1024, w, lane_);
    bf16_t* X1B = (bf16_t*)(F.ws + WS_X1B) + (size_t)MP * 1024; float* ssq = (float*)(F.ws + WS_SSQS); const float* xs = FIN(1);
#pragma unroll
    for (int r = 0; r < 4; ++r) { const int row = 16 * w + 4 * g + r; const size_t i = (size_t)row * 1024 + c; const float v = xs[i] + a[r];
        F.out[O_YS + i] = v; X1B[i] = f2bf(v); const float q = rt::row16_sum(v * v); if (fr == 0) atomicAdd(ssq + row, q); }
}
__device__ __forceinline__ void sk_up(Frame& F, int su) {
    const int lane_ = (int)(threadIdx.x & 63), w = __builtin_amdgcn_readfirstlane((int)(threadIdx.x >> 6)), fr = lane_ & 15, g = lane_ >> 4, c = 16 * su + fr;
    const int cc = c < D_FF ? c : c - D_FF, drow = (cc >> 7) * 256 + (c < D_FF ? 0 : 128) + sk::wrow(cc & 127);
    const bf16_t* X1B = (const bf16_t*)(F.ws + WS_X1B) + (size_t)MP * 1024;
    const f32x4 a = sk::mm(F.lds, X1B, 1024, (const bf16_t*)(F.ws + WS_FWUP) + (size_t)drow * 1024 + 8 * g, 1024, w, lane_);
    bf16_t* U = (c < D_FF ? (bf16_t*)(F.ws + WS_UG) : (bf16_t*)(F.ws + WS_UV)) + (size_t)MP * D_FF; const float* ssq = (const float*)(F.ws + WS_SSQS);
#pragma unroll
    for (int r = 0; r < 4; ++r) { const int row = 16 * w + 4 * g + r; const float u = a[r] * rsqrtf(ssq[row] * (1.f / D_MODEL) + EPS);
        U[(size_t)row * D_FF + cc] = f2bf(u); const int t = row & (DEC_SEQ - 1); if (t >= DEC_SEQ - 2) F.out[O_CONVS + ((size_t)(row >> 4) * 2 + (t - (DEC_SEQ - 2))) * FF2 + c] = u; }
}
__device__ __forceinline__ void sk_down(Frame& F, int su) {
    const int lane_ = (int)(threadIdx.x & 63), w = __builtin_amdgcn_readfirstlane((int)(threadIdx.x >> 6)), fr = lane_ & 15, g = lane_ >> 4, c = 16 * su + fr;
    const bf16_t* U = (const bf16_t*)(F.ws + WS_UG) + (size_t)MP * D_FF;
    const f32x4 a = sk::mm(F.lds, U, D_FF, (const bf16_t*)(F.ws + WS_FWDOWN) + (size_t)sk::wrow(c) * D_FF + 8 * g, D_FF, w, lane_);
#pragma unroll
    for (int r = 0; r < 4; ++r) { const size_t i = (size_t)(16 * w + 4 * g + r) * 1024 + c; F.out[O_YS + i] += a[r]; }
}
#define STAMP_(k) probe_stamp(F, (k))
constexpr int CW_GRP = 4608;
constexpr int GW_P7D = 0, GW_G8 = 256, GW_C3 = 320, GW_C4 = 321, GW_XID = 322, GW_SKM = 64;
__device__ __forceinline__ unsigned* grp_word(Frame& F, int idx) { return (unsigned*)(F.ws + WS_CTL) + CW_GRP + 16 * idx; }
__device__ __forceinline__ void grp_arrive(Frame& F, int idx, bool local) {
    asm volatile("s_waitcnt vmcnt(0)" ::: "memory");
    __syncthreads();
    if (threadIdx.x == 0) { if (!local) { __builtin_amdgcn_fence(__ATOMIC_RELEASE, "agent"); asm volatile("s_waitcnt vmcnt(0)" ::: "memory"); } (void)xb_add(grp_word(F, idx), 1u); }
}
__device__ __forceinline__ void grp_wait(Frame& F, int idx, unsigned target, bool  ) {
    if (threadIdx.x == 0) { unsigned* bar = (unsigned*)(F.ws + WS_CTL) + CW_BAR; unsigned* w = grp_word(F, idx);
        XB_SPIN(xb_ld(w) < target, bar);
        __builtin_amdgcn_fence(__ATOMIC_ACQUIRE, "agent"); asm volatile("s_waitcnt vmcnt(0)" ::: "memory"); }
    __syncthreads();
}
__device__ __forceinline__ void s2_row_scales(Frame& F, int pm) {
    LAS unsigned char* lds = F.lds; const int t = (int)threadIdx.x;
    if (t < 256) { const int row = pm * 256 + t; float a = 0.f;
        if (row >= MP) a = ((const float*)(F.ws + WS_SSQS))[row < MT ? row - MP : 0];
        else { const float* slotx = (const float*)(F.ws + WS_SLOTX1);
#pragma unroll
            for (int i = 0; i < 16; i += 4) { const f32x4 v = *(const f32x4*)(slotx + (size_t)row * 16 + i); a += (v[0] + v[1]) + (v[2] + v[3]); } }
        *LDS_F(t) = rsqrtf(a * (1.f / D_MODEL) + EPS); }
    __syncthreads();
}
__device__ __forceinline__ void s2_chain(Frame& F) {
    const int r = F.j & 7, pm = 8 * F.x + r, q = F.j >> 3, cls = (q + F.j) & 3;
    const int sidx = r < 3 ? r * 8 + F.x : 1 << 20; const bool stype = sidx < 22;
    const int nun = stype ? (q < 3 ? 6 : 4) : (F.j < 16 ? 6 : 5);
#define S2_PN(i) (!stype || (i) < 4 ? q + 4 * (i) : (i) == 4 ? q + 16 : (q == 2 ? 19 : 20 + q))
    const int vprev = (F.j & 7) ? F.vcu - 1 : F.vcu - 32 + 7, vnext = (F.j & 7) != 7 ? F.vcu + 1 : F.vcu + 32 - 7;
    volatile LAS unsigned* MISC = (volatile LAS unsigned*)(F.lds + MISC_OFF);
    if (threadIdx.x < 8) {
        const int l = (int)threadIdx.x; const int v = l < 4 ? F.x * 32 + (F.j & 7) + 8 * l : l == 4 ? ((pm & 31) ? vprev : F.vcu) : l == 5 ? ((pm & 31) != 31 ? vnext : F.vcu) : F.vcu;
        const unsigned id = xb_ld(grp_word(F, GW_XID + v)), me = __shfl(id, 6);
        const unsigned same = (id == me && me != 0u) ? 1u : 0u; const unsigned long long bal = __ballot(same != 0u);
        if (l == 0) { MISC[20] = (bal & 0xFull) == 0xFull ? 1u : 0u; MISC[21] = (unsigned)((bal >> 4) & 1ull); MISC[22] = (unsigned)((bal >> 5) & 1ull); } }
    __syncthreads();
    const bool loc_grp = MISC[20] != 0u, loc_prev = MISC[21] != 0u, loc_next = MISC[22] != 0u;
    if (stype && q == 3) {
        s2_row_scales(F, 64);
        {   SchedP5 S{F.x, F.j, F.vcu, (const char*)F.ws, 7, -1, sidx, 0};
            EpiP5 E{F.ws, F.out, FIN(0), FIN(1), F.vcu};
            pg::gemm_stream(F.lds, S, E); }
        grp_arrive(F, GW_C3, false);
    }
    s2_row_scales(F, pm);
    int i0 = 0, ck = 0;
#pragma unroll 1
    while (i0 < nun) {
        int i1 = ck == 0 ? 2 + cls : nun; if (i1 > nun) i1 = nun;
        {   SchedP5 S{F.x, F.j, F.vcu, (const char*)F.ws, 7, i0, i1, stype ? 1 : 0};
            EpiP5 E{F.ws, F.out, FIN(0), FIN(1), F.vcu};
            pg::gemm_stream(F.lds, S, E); }
#pragma unroll 1
        for (int i = i0; i < i1; ++i) { int t = (int)threadIdx.x; asm volatile("" : "+v"(t)); const int seg = t >> 4; conv_thread<1>(F, seg != 0, pm * 256 + seg * 8, S2_PN(i) * 128 + (t & 15) * 8, 1, 0); }
        if (ck == 0 && F.j == 31 && F.x < 6) {
            grp_wait(F, GW_C3, 22u, false);
            int t = (int)threadIdx.x; asm volatile("" : "+v"(t)); const int it = F.x * 32 + (t >> 4), b = it / 22, pn = it - b * 22; const bool on = it < 8 * 22;
            conv_thread<2>(F, on, MP + (on ? b : 0) * DEC_SEQ, (on ? pn : 0) * 128 + (t & 15) * 8, 3, on ? b : 0);
            grp_arrive(F, GW_C4, false);
        }
        i0 = i1; ++ck;
    }
    if (r >= 3 && r < 7 && q >= 2) { grp_wait(F, GW_C4, 6u, false); sk_down(F, ((r - 3) * 2 + (q - 2)) * 8 + F.x); }
    STAMP_(12);
    grp_arrive(F, GW_P7D + pm, true);
    if (pm & 31) grp_wait(F, GW_P7D + pm - 1, 4u, loc_prev);
    {   int t = (int)threadIdx.x; asm volatile("" : "+v"(t)); const int ui = t >> 4; const bool on = ui < nun; const int uu = on ? ui : 0; conv_thread<1>(F, on, pm * 256, S2_PN(uu) * 128 + (t & 15) * 8, (pm & 31) ? 2 : 0, pm); }
    grp_arrive(F, GW_G8 + pm, loc_grp);
    grp_wait(F, GW_G8 + pm, 4u, loc_grp);
    STAMP_(13);
    p5_gemm(F, 9);
}
__global__ void __launch_bounds__(NTHR, 2) mk(const MArgs a) {
    extern __shared__ __attribute__((aligned(16))) unsigned char lds_raw[];
    Frame F;
    F.lds = (LAS unsigned char*)lds_raw;
    F.tid = threadIdx.x; F.lane = F.tid & 63; F.wave = __builtin_amdgcn_readfirstlane(F.tid >> 6);
    F.G = gridDim.x; F.x = blockIdx.x % 8; F.j = blockIdx.x / 8; F.vcu = F.x * (F.G / 8) + F.j;
    F.a = &a; F.out = a.out; F.ws = a.ws;
    volatile LAS unsigned* MISC = (volatile LAS unsigned*)(F.lds + MISC_OFF);
    if (F.tid < 32) MISC[F.tid] = 0u;
    __syncthreads();
    XcdBarrier bar = xcd_barrier_post((unsigned*)(a.ws + WS_CTL) + CW_BAR + a.li * XCD_BAR_WORDS, MISC + 8);
    const int lo = a.ph_lo, hi = a.ph_hi;
#define IN_(k) (lo <= (k) && (k) < hi)
#define SEAM_(k) do { if (IN_(k) && IN_((k) + 1)) xcd_barrier(bar); } while (0)
    STAMP_(0); if (IN_(0)) { if (F.tid == 0) (void)xb_add(grp_word(F, GW_XID + F.vcu), 1u + xb_xcc_id()); p0_prologue(F); } SEAM_(0);
    STAMP_(1); if (IN_(1)) { p1_late_prologue(F); __syncthreads(); p1_inproj(F); } SEAM_(1);
    STAMP_(2); if (IN_(2)) { r1_states(F); } SEAM_(2);
    STAMP_(3); if (IN_(3)) { r2_scan(F); } SEAM_(3);
    STAMP_(4); if (IN_(4)) { r3_outputs(F); } SEAM_(4);
    STAMP_(5); if (IN_(5)) { p2_qkv(F, 1); p5_side(F); } SEAM_(5);
    STAMP_(6); if (IN_(6)) { p3_attn_sample(F); } SEAM_(6);
    STAMP_(7); if (IN_(7)) { attn_sample_combine(F); p2_qkv(F, 0); } SEAM_(7);
    STAMP_(8); if (IN_(8)) { p3_attn_prompt(F); } SEAM_(8);
    STAMP_(9); if (IN_(9)) { if (F.vcu < 64) { sk_merge(F, F.vcu); grp_arrive(F, GW_SKM, false); } p5_gemm(F, 5); if (F.vcu >= 64 && F.vcu < 128) { grp_wait(F, GW_SKM, 64u, false); sk_out(F, F.vcu - 64); } } SEAM_(9);
    STAMP_(10); if (IN_(10)) { p5_gemm(F, 6); } SEAM_(10);
    STAMP_(11); if (IN_(11)) { s2_chain(F); }
    if (PROBE_LO >= 0) { __syncthreads(); STAMP_(14);
        if (blockIdx.x == PROBE_BLK && F.tid == 0) { const unsigned long long t_end = __builtin_amdgcn_s_memrealtime() + (unsigned long long)PROBE_MULT * ((((unsigned long long)MISC[19] << 32) | MISC[18]) - (((unsigned long long)MISC[17] << 32) | MISC[16]));
            while (__builtin_amdgcn_s_memrealtime() < t_end) __builtin_amdgcn_s_sleep(8); } }
}

extern "C" void kernel_launch(void* const* d_in, const int* in_sizes, int n_in, void* d_out, int out_size, void* d_ws, size_t ws_size, hipStream_t stream) {
    static int ok = 0;
    if (ok == 0) {
        ok = 1;
        if (ws_size < 256 * MiB || n_in != 24) { fprintf(stderr, "kernel_launch: bad ws/n_in: %zu %d\n", ws_size, n_in); ok = -1; }
        int dev = 0, cus = 0; (void)hipGetDevice(&dev); (void)hipDeviceGetAttribute(&cus, hipDeviceAttributeMultiprocessorCount, dev);
        if (cus != 256) { fprintf(stderr, "kernel_launch: built for 256 CUs, got %d\n", cus); ok = -1; }
        if (hipFuncSetAttribute((const void*)mk, hipFuncAttributeMaxDynamicSharedMemorySize, LDS_BYTES) != hipSuccess) { fprintf(stderr, "kernel_launch: hipFuncSetAttribute(mk) failed\n"); ok = -1; }
        (void)hipGetLastError();
    }
    if (ok < 0) return;
    (void)hipMemsetAsync((char*)d_ws + WS_CTL, 0, CTL_BYTES, stream);
    MArgs a{}; for (int i = 0; i < 24; ++i) a.in[i] = (const float*)d_in[i]; a.out = (float*)d_out; a.ws = (unsigned char*)d_ws; a.ph_lo = 0; a.ph_hi = 14; a.li = 0;
    hipLaunchKernelGGL(mk, dim3(256), dim3(NTHR), LDS_BYTES, stream, a);
}
```

```cpp
#include <hip/hip_runtime.h>
#include <stdint.h>
#include <cstdio>

typedef unsigned short bf16_t;
typedef short bf16x8 __attribute__((ext_vector_type(8)));
typedef float f32x4 __attribute__((ext_vector_type(4)));
typedef float f32x2 __attribute__((ext_vector_type(2)));
typedef unsigned u32x4 __attribute__((ext_vector_type(4)));
typedef unsigned u32x2 __attribute__((ext_vector_type(2)));

constexpr int D_MODEL = 1024, BATCH = 2, SEQ = 8192, DEC_BATCH = 8, DEC_SEQ = 16, PAST = 2048;
constexpr int MP = BATCH * SEQ, MS = DEC_BATCH * DEC_SEQ, MT = MP + MS;
constexpr int MPAD = 16640;
constexpr int Q_LORA = 768, KV_LORA = 512, QK_NOPE = 128, QK_ROPE = 64, V_HEAD = 128, HEADS = 8;
constexpr int RET_H = 4, RET_DK = 128, RET_DV = 256;
constexpr int D_FF = 2816, FF2 = 2 * D_FF;
constexpr int IN_W = 6464;
constexpr int SKEYS = PAST + DEC_SEQ;
constexpr int LROWS = DEC_BATCH * SKEYS;
constexpr float EPS = 1e-6f;
constexpr int C_QLAT = 0, C_KVLAT = 768, C_KPE = 1280, C_RQ = 1344, C_RK = 1856, C_RV = 2368, C_RG = 3392, C_GA = 4416, C_GB = 5440;

constexpr size_t O_YP = 0, O_YS = 16777216, O_LATP = 16908288, O_RKP = 25296896, O_RETP = 26345472, O_CONVP = 26607616,
                 O_LATS = 26630144, O_RKS = 26695680, O_RETS = 26703872, O_CONVS = 27752448;

constexpr size_t MiB = 1u << 20, KiB = 1024;
constexpr size_t WS_CTL = 0, CTL_BYTES = 64 * KiB, WS_SSQS = 64 * KiB;
constexpr size_t WS_RSQ = 128 * KiB, WS_RSKV = 256 * KiB;
constexpr size_t WS_SLOTQ = 1 * MiB, WS_SLOTKV = 2 * MiB, WS_SLOTX1 = 3 * MiB;
constexpr size_t WS_TAB32 = 4 * MiB + 256 * KiB, WS_TAB64 = 6 * MiB + 256 * KiB;
constexpr size_t WS_FWUP = 10 * MiB + 512 * KiB, WS_FWDOWN = 21 * MiB + 512 * KiB, WS_FWIN = 27 * MiB, WS_FWQUP = 40 * MiB, WS_FWKVUP = 43 * MiB,
                 WS_FWOBA = 45 * MiB, WS_FWOBB = 47 * MiB, WS_FWOUT = 49 * MiB;
constexpr size_t WS_XN = 51 * MiB, WS_RET = 210 * MiB;
constexpr size_t WS_LATS = 83 * MiB + 512 * KiB, WS_PES = 99 * MiB + 768 * KiB, WS_ZQ = 102 * MiB, WS_KVL = 126 * MiB + 512 * KiB, WS_KPE = 142 * MiB + 768 * KiB;
constexpr size_t WS_RQ = 145 * MiB, WS_RK = 161 * MiB + 256 * KiB, WS_RV = 177 * MiB + 512 * KiB, WS_RG = 210 * MiB;
constexpr size_t WS_KN = 145 * MiB, WS_V = 177 * MiB + 512 * KiB, WS_ATTS = 242 * MiB + 512 * KiB, WS_XN2 = 51 * MiB, WS_ATT = 102 * MiB;
constexpr size_t WS_T1 = 166 * MiB + 512 * KiB, WS_MERGED = 134 * MiB;
constexpr size_t WS_GAS = 246 * MiB, WS_GBS = 247 * MiB;
constexpr size_t WS_X1B = 223 * MiB + 512 * KiB, WS_UG = 27 * MiB, WS_UV = 116 * MiB + 512 * KiB, WS_HALO = 206 * MiB;

__device__ __forceinline__ bf16_t f2bf(float f) { unsigned u = __float_as_uint(f); u = (u + 0x7fffu + ((u >> 16) & 1u)) >> 16; return (bf16_t)u; }
__device__ __forceinline__ float bf2f(bf16_t b) { return __uint_as_float(((unsigned)b) << 16); }

#define LAS __attribute__((address_space(3)))
#define GAS __attribute__((address_space(1)))
constexpr int NTHR = 512;
constexpr int RING_BYTES = 131072, EPI_OFF = RING_BYTES, EPI_BYTES = 8192, LDS_BYTES = 163840, MISC_OFF = LDS_BYTES - 256;
constexpr int CW_BAR = 1024;

__device__ __forceinline__ unsigned cvt_pk_bf16(float lo, float hi) { unsigned r; asm volatile("v_cvt_pk_bf16_f32 %0, %1, %2" : "=v"(r) : "v"(lo), "v"(hi)); return r; }
__device__ __forceinline__ void st16_sc1(void* p, const u32x4 v) { asm volatile("global_store_dwordx4 %0, %1, off sc1\n\ts_nop 1" :: "v"(p), "v"(v) : "memory"); }
__device__ __forceinline__ u32x4 ld16_sc1(const void* p) { u32x4 v; asm volatile("global_load_dwordx4 %0, %1, off sc1\n\ts_waitcnt vmcnt(0)" : "=&v"(v) : "v"(p) : "memory"); return v; }
__device__ __forceinline__ unsigned cvt_pk_bf16_t(float lo, float hi) { unsigned r; asm volatile("s_nop 0\n\tv_cvt_pk_bf16_f32 %0, %1, %2" : "=v"(r) : "v"(lo), "v"(hi)); return r; }
__device__ __forceinline__ u32x4 pack8f_t(const f32x4& a, const f32x4& b) { u32x4 w; w.x = cvt_pk_bf16_t(a[0], a[1]); w.y = cvt_pk_bf16_t(a[2], a[3]); w.z = cvt_pk_bf16_t(b[0], b[1]); w.w = cvt_pk_bf16_t(b[2], b[3]); return w; }
__device__ __forceinline__ u32x4 pack8f(const f32x4& a, const f32x4& b) { u32x4 w; w.x = cvt_pk_bf16(a[0], a[1]); w.y = cvt_pk_bf16(a[2], a[3]); w.z = cvt_pk_bf16(b[0], b[1]); w.w = cvt_pk_bf16(b[2], b[3]); return w; }
__device__ __forceinline__ int row_pos(int row) { return row < MP ? (row & (SEQ - 1)) : PAST + ((row - MP) & (DEC_SEQ - 1)); }

#define XB_TMO      128
#define XB_XCNT(j)  (256  + 64 * (j))
#define XB_XSUB(j)  (1280 + 64 * (j))
#define XB_XGEN(j)  (2304 + 64 * (j))
#define XB_TOP      3328
#define XB_TOPGEN   3392
#define XCD_BAR_WORDS 3456
#define XB_SPIN_CAP (1u << 18)
__device__ __forceinline__ unsigned xb_ld(unsigned* p)              { return __hip_atomic_load(p, __ATOMIC_RELAXED, __HIP_MEMORY_SCOPE_AGENT); }
__device__ __forceinline__ unsigned xb_add(unsigned* p, unsigned v) { return __hip_atomic_fetch_add(p, v, __ATOMIC_RELAXED, __HIP_MEMORY_SCOPE_AGENT); }
__device__ __forceinline__ unsigned xb_xcc_id() { return (unsigned)__builtin_amdgcn_s_getreg((3 << 11) | 20) & 0xFu; }
#define XB_SPIN(cond, bar) do { unsigned _sp = 0; while (cond) { __builtin_amdgcn_s_sleep(1); \
    if ((++_sp & 255u) == 0u) { if (xb_ld(&(bar)[XB_TMO])) break; if (_sp > XB_SPIN_CAP) { atomicAdd(&(bar)[XB_TMO], 1u); break; } } } } while (0)
struct XcdBarrier { unsigned* bar; unsigned x; volatile LAS unsigned* st; };
__device__ __forceinline__ XcdBarrier xcd_barrier_post(unsigned* bar, volatile LAS unsigned* st) {
    XcdBarrier b; b.bar = bar; b.x = xb_xcc_id(); b.st = st;
    if (threadIdx.x == 0) (void)xb_add(&bar[XB_XCNT(b.x)], 1u);
    return b;
}
__device__ __forceinline__ void xcd_barrier_complete(unsigned* bar, unsigned x, unsigned& nloc, unsigned& nx) {
    const unsigned G = gridDim.x * gridDim.y * gridDim.z;
    unsigned sum, cnt, mine, sp = 0u;
    for (;;) {
        sum = 0u; cnt = 0u; mine = 0u;
#pragma unroll
        for (unsigned j = 0; j < 16; ++j) { const unsigned c = xb_ld(&bar[XB_XCNT(j)]); sum += c; cnt += (c > 0u) ? 1u : 0u; mine = (j == x) ? c : mine; }
        if (sum == G) break;
        __builtin_amdgcn_s_sleep(1);
        if ((++sp & 255u) == 0u) { if (xb_ld(&bar[XB_TMO])) break; if (sp > XB_SPIN_CAP) { atomicAdd(&bar[XB_TMO], 1u); break; } }
    }
    nloc = mine > 0u ? mine : 1u; nx = cnt > 0u ? cnt : 1u;
}
__device__ __forceinline__ void xcd_barrier(const XcdBarrier& b) {
    asm volatile("s_waitcnt vmcnt(0)" ::: "memory");
    __syncthreads();
    if (threadIdx.x == 0) {
        unsigned* bar = b.bar;
        __builtin_amdgcn_s_waitcnt(0);
        unsigned nloc = b.st[0], nx = b.st[1];
        if (nloc == 0u) { xcd_barrier_complete(bar, b.x, nloc, nx); b.st[0] = nloc; b.st[1] = nx; }
        const unsigned old = xb_add(&bar[XB_XSUB(b.x)], 1u);
        const unsigned gen = old / nloc;
        if (old + 1u == (gen + 1u) * nloc) {
            __builtin_amdgcn_fence(__ATOMIC_RELEASE, "agent");
            asm volatile("s_waitcnt vmcnt(0)" ::: "memory");
            const unsigned og = xb_add(&bar[XB_TOP], 1u);
            const unsigned tg = og / nx;
            if (og + 1u == (tg + 1u) * nx) xb_add(&bar[XB_TOPGEN], 1u);
            else XB_SPIN(xb_ld(&bar[XB_TOPGEN]) == tg, bar);
            xb_add(&bar[XB_XGEN(b.x)], 1u);
            __builtin_amdgcn_fence(__ATOMIC_ACQUIRE, "agent");
            asm volatile("s_waitcnt vmcnt(0)" ::: "memory");
        } else {
            XB_SPIN(xb_ld(&bar[XB_XGEN(b.x)]) == gen, bar);
            __builtin_amdgcn_fence(__ATOMIC_ACQUIRE, "agent");
            asm volatile("s_waitcnt vmcnt(0)" ::: "memory");
        }
    }
    __syncthreads();
}

namespace pg {
constexpr int BK = 64, HALF = 128, HTB = HALF * BK * 2;
__host__ __device__ __forceinline__ int lds_byte(int r, int c) { const int st = (r >> 4) * 2 + (c >> 5), rr = r & 15, cc = c & 31, ob = rr * 64 + cc * 2; return st * 1024 + (ob ^ (((ob >> 9) & 1) << 5)); }
__host__ __device__ __forceinline__ void stage_rc(int b, int& R, int& C) { const int st = b / 1024, sb = b % 1024, swz = sb ^ (((sb >> 9) & 1) << 5); R = (st >> 1) * 16 + swz / 64; C = (st & 1) * 32 + (swz % 64) / 2; }
__host__ __device__ __forceinline__ int perm32(int rho) { const int n = rho >> 4, i = rho & 15; return 8 * (i >> 2) + 4 * n + (i & 3); }
struct UnitG { const char* A; const char* B; unsigned lda, ldb; int nt; int pm, pn, kind; int half; };
typedef f32x4 Acc[2][2][4][2];

template <class Sched, class Epi>
__device__ __forceinline__ void gemm_stream(LAS unsigned char* lds, const Sched& S, const Epi& E) {
    int tid = threadIdx.x; asm volatile("" : "+v"(tid));
    const int wid = __builtin_amdgcn_readfirstlane(tid >> 6), lane = tid & 63, wr = wid >> 2, wc = wid & 3, fr = lane & 15, fq = lane >> 4;
    unsigned Rr[2], Cc[2];
#pragma unroll
    for (int i = 0; i < 2; ++i) { int R, C; stage_rc(tid * 16 + i * 8192, R, C); Rr[i] = (unsigned)R; Cc[i] = (unsigned)C * 2u; }
    const unsigned ldsw = (unsigned)wid * 1024u;
    const int aoff = lds_byte(wr * 64 + fr, fq * 8), boff = lds_byte(wc * 32 + fr, fq * 8);
#define PG_SA(b, h) (((b) * 2 + (h)) * HTB)
#define PG_SB(b, h) ((4 + (b) * 2 + (h)) * HTB)
#define PG_STAGE(bufoff, gbase, ld) do { _Pragma("unroll") for (int _i = 0; _i < 2; ++_i) \
        __builtin_amdgcn_global_load_lds((const unsigned*)((const char*)(gbase) + (size_t)(Rr[_i] * (ld) + Cc[_i])), (LAS unsigned*)(lds + (bufoff) + ldsw + _i * 8192), 16, 0, 0); } while (0)
#define PG_LDA(dst, b, h) do { _Pragma("unroll") for (int m = 0; m < 4; ++m) _Pragma("unroll") for (int k = 0; k < 2; ++k) dst[m][k] = *(const LAS bf16x8*)(lds + PG_SA(b, h) + aoff + m * 2048 + k * 1024); } while (0)
#define PG_LDB(dst, b, h) do { _Pragma("unroll") for (int n = 0; n < 2; ++n) _Pragma("unroll") for (int k = 0; k < 2; ++k) dst[n][k] = *(const LAS bf16x8*)(lds + PG_SB(b, h) + boff + n * 2048 + k * 1024); } while (0)
#define PG_MMA(ai, bj, At, Bt) do { __builtin_amdgcn_s_setprio(1); _Pragma("unroll") for (int m = 0; m < 4; ++m) _Pragma("unroll") for (int n = 0; n < 2; ++n) _Pragma("unroll") for (int k = 0; k < 2; ++k) \
        acc[ai][bj][m][n] = __builtin_amdgcn_mfma_f32_16x16x32_bf16(Bt[n][k], At[m][k], acc[ai][bj][m][n], 0, 0, 0); __builtin_amdgcn_s_setprio(0); } while (0)
#define PG_WAIT_V(n) asm volatile("s_waitcnt vmcnt(" #n ")" ::: "memory")
#define PG_WAIT_L(n) asm volatile("s_waitcnt lgkmcnt(" #n ")" ::: "memory")
#define PG_BAR __builtin_amdgcn_s_barrier()
#define PG_SCHED __builtin_amdgcn_sched_barrier(0)
    UnitG cur, nxt; int ui = 0;
    if (!S.next(0, cur)) return;
    Acc acc;
#pragma unroll
    for (int a = 0; a < 2; ++a)
#pragma unroll
        for (int b = 0; b < 2; ++b)
#pragma unroll
            for (int m = 0; m < 4; ++m)
#pragma unroll
                for (int n = 0; n < 2; ++n) acc[a][b][m][n] = (f32x4){0.f, 0.f, 0.f, 0.f};
    bf16x8 At[4][2], B0[2][2], B1[2][2];
    const char* cA = cur.A; const char* cB = cur.B; unsigned clda = cur.lda, cldb = cur.ldb;
    PG_STAGE(PG_SB(0, 0), cB, cldb); PG_STAGE(PG_SB(0, 1), cB + (size_t)HALF * cldb, cldb); PG_STAGE(PG_SA(0, 0), cA, clda); PG_STAGE(PG_SA(0, 1), cA + (size_t)HALF * clda, clda);
    if (wr == 1) PG_BAR;
    PG_WAIT_V(2); PG_BAR;
    PG_STAGE(PG_SB(1, 0), cB + 128, cldb); PG_STAGE(PG_SA(1, 0), cA + 128, clda); PG_STAGE(PG_SB(1, 1), cB + (size_t)HALF * cldb + 128, cldb);
    PG_WAIT_V(6); PG_BAR;
    for (;;) {
        const bool has_next = S.next(ui + 1, nxt);
        const char* nA = has_next ? nxt.A : cA; const char* nB = has_next ? nxt.B : cB;
        const unsigned nlda = has_next ? nxt.lda : clda, nldb = has_next ? nxt.ldb : cldb;
        const int nt = cur.nt; const bool chalf = cur.half != 0;
        for (int t = 0; t < nt; t += 2) {
            const bool last = (t == nt - 2);
            const char* a1 = cA + (size_t)(t + 1) * 128;
            const char* a2 = last ? nA : cA + (size_t)(t + 2) * 128; const char* b2 = last ? nB : cB + (size_t)(t + 2) * 128;
            const unsigned lda2 = last ? nlda : clda, ldb2 = last ? nldb : cldb;
            const char* a3 = a2 + 128; const char* b3 = b2 + 128;
            PG_LDB(B0, 0, 0); PG_LDB(B1, 0, 1); PG_SCHED; PG_LDA(At, 0, 0); PG_STAGE(PG_SA(1, 1), a1 + (size_t)HALF * clda, clda);
            PG_WAIT_V(8); PG_WAIT_L(0); PG_BAR; PG_MMA(0, 0, At, B0); PG_MMA(0, 1, At, B1); PG_BAR; PG_SCHED;
            PG_LDA(At, 0, 1); PG_STAGE(PG_SB(0, 0), b2, ldb2); PG_STAGE(PG_SB(0, 1), b2 + (size_t)HALF * ldb2, ldb2); PG_STAGE(PG_SA(0, 0), a2, lda2);
            PG_WAIT_V(8); PG_WAIT_L(0); PG_BAR; if (!chalf) { PG_MMA(1, 0, At, B0); PG_MMA(1, 1, At, B1); } PG_BAR; PG_SCHED;
            PG_LDB(B0, 1, 0); PG_LDB(B1, 1, 1); PG_SCHED; PG_LDA(At, 1, 0); PG_STAGE(PG_SA(0, 1), a2 + (size_t)HALF * lda2, lda2);
            PG_WAIT_V(8); PG_WAIT_L(0); PG_BAR; PG_MMA(0, 0, At, B0); PG_MMA(0, 1, At, B1); PG_BAR; PG_SCHED;
            PG_LDA(At, 1, 1); PG_STAGE(PG_SB(1, 0), b3, ldb2); PG_STAGE(PG_SB(1, 1), b3 + (size_t)HALF * ldb2, ldb2); PG_STAGE(PG_SA(1, 0), a3, lda2);
            PG_WAIT_V(8); PG_WAIT_L(0); PG_BAR; if (!chalf) { PG_MMA(1, 0, At, B0); PG_MMA(1, 1, At, B1); } PG_BAR; PG_SCHED;
        }
        if (wr == 0) PG_BAR;
        E(acc, cur, lds, wr, wc, fr, fq);
        if (!has_next) break;
#pragma unroll
        for (int a = 0; a < 2; ++a)
#pragma unroll
            for (int b = 0; b < 2; ++b)
#pragma unroll
                for (int m = 0; m < 4; ++m)
#pragma unroll
                    for (int n = 0; n < 2; ++n) acc[a][b][m][n] = (f32x4){0.f, 0.f, 0.f, 0.f};
        cur = nxt; cA = nA; cB = nB; clda = nlda; cldb = nldb; ++ui;
        if (wr == 1) PG_BAR;
    }
    PG_WAIT_V(0);
    PG_BAR;
#undef PG_SA
#undef PG_SB
#undef PG_STAGE
#undef PG_LDA
#undef PG_LDB
#undef PG_MMA
#undef PG_WAIT_V
#undef PG_WAIT_L
#undef PG_BAR
#undef PG_SCHED
}
}

struct MArgs { const float* in[24]; float* out; unsigned char* ws; int ph_lo, ph_hi, li, pad; };
struct Frame {
    LAS unsigned char* lds; int tid, lane, wave; int x, j, vcu, G;
    const MArgs* a; float* out; unsigned char* ws;
};
#define FIN(k) (F.a->in[k])
__device__ __forceinline__ float fwave_sum(float v) {
#pragma unroll
    for (int o = 1; o < 64; o <<= 1) v += __shfl_xor(v, o);
    return v;
}

#ifndef PROBE_LO
#define PROBE_LO -1
#define PROBE_HI -1
#define PROBE_MULT 1
#define PROBE_BLK 0
#endif
__device__ __forceinline__ void probe_stamp(Frame& F, int k) {
    if (PROBE_LO >= 0 && blockIdx.x == PROBE_BLK && F.tid == 0) { volatile LAS unsigned* M = (volatile LAS unsigned*)(F.lds + MISC_OFF); const unsigned long long t_ = __builtin_amdgcn_s_memrealtime();
        if (k == PROBE_LO) { M[16] = (unsigned)t_; M[17] = (unsigned)(t_ >> 32); } if (k == PROBE_HI) { M[18] = (unsigned)t_; M[19] = (unsigned)(t_ >> 32); } }
}
enum { W_IN = 0, W_QUP, W_KVUP, W_OBA, W_OBB, W_OUT, W_UP, W_DOWN };
__device__ __forceinline__ int win_src(int gd) {
    const int tile = gd >> 3, g = gd & 7, bj = g >> 2, wc = g & 3;
    if (tile < 3) return C_QLAT + gd * 32;
    if (tile < 5) return C_KVLAT + (gd - 24) * 32;
    if (tile == 5) return (wc == 0) ? C_KPE + bj * 32 : -1;
    if (tile < 10) { const int base = tile < 8 ? C_RQ : C_RK, tl = tile < 8 ? tile - 6 : tile - 8; const int head = 2 * tl + (wc >> 1); return base + head * 128 + bj * 64 + (wc & 1) * 32; }
    if (tile < 14) return C_RV + (gd - 80) * 32;
    if (tile < 18) return C_RG + (gd - 112) * 32;
    if (tile < 22) return C_GA + (gd - 144) * 32;
    return C_GB + (gd - 176) * 32;
}
__device__ __forceinline__ int w_src_col(int wid, int row) {
    const int rho = row & 31, s = row & 255, wc = (s >> 5) & 3, t = row >> 8;
    const int n = rho >> 4, i = rho & 15; return t * 192 + 128 + 16 * wc + i + 32 * n;
}
__device__ __forceinline__ int w_group_base(int wid, int gd) {
    const int g = gd & 7, bj = g >> 2, wc = g & 3, t = gd >> 3;
    switch (wid) {
    case W_IN: return win_src(gd);
    case W_QUP: return bj == 0 ? t * 192 + 32 * wc : (wc < 2 ? -2 : -1);
    case W_KVUP: return t * 256 + 128 * bj + 32 * wc;
    case W_UP: return (bj ? D_FF : 0) + 128 * t + 32 * wc;
    default: return gd * 32;
    }
}
struct WItemRegs { f32x4 v[8]; float g[8]; };
__device__ __forceinline__ void p0_item_load(WItemRegs& R, const float* __restrict__ W, int ldw, const float* __restrict__ gain, int base, int kb, int lane) {
    const int k0 = kb * 64, c = lane & 7;
    if (base >= 0) {
#pragma unroll
        for (int i = 0; i < 8; ++i) { const int kk = (lane >> 3) + 8 * i; R.g[i] = gain ? gain[k0 + kk] : 1.f; R.v[i] = __builtin_nontemporal_load((const f32x4*)(W + (size_t)(k0 + kk) * ldw + base + 4 * c)); } }
}
__device__ __forceinline__ void p0_item_finish(const WItemRegs& R, const float* __restrict__ W, int ldw, int K, const float* __restrict__ gain, int wid, int base, bf16_t* __restrict__ Wt, int gd, int kb, LAS float* scr, int lane) {
    const int k0 = kb * 64, c = lane & 7;
    bf16_t* dst = Wt + (size_t)(gd * 32) * K + k0;
    if (base == -1) {
#pragma unroll
        for (int jj = 0; jj < 4; ++jj) { const int n = (lane >> 3) + 8 * jj; *(u32x4*)(dst + (size_t)n * K + 8 * c) = (u32x4){0u, 0u, 0u, 0u}; }
        return;
    }
    if (base >= 0) {
#pragma unroll
        for (int i = 0; i < 8; ++i) { const int kk = (lane >> 3) + 8 * i; LAS float* d = scr + kk * 33 + 4 * c; const float g = R.g[i]; d[0] = R.v[i][0] * g; d[1] = R.v[i][1] * g; d[2] = R.v[i][2] * g; d[3] = R.v[i][3] * g; }
    } else {
        const int sc = w_src_col(wid, gd * 32 + (lane & 31));
#pragma unroll 8
        for (int i = 0; i < 32; ++i) { const int kk = 2 * i + (lane >> 5); const float g = gain ? gain[k0 + kk] : 1.f; scr[kk * 33 + (lane & 31)] = W[(size_t)(k0 + kk) * ldw + sc] * g; }
    }
    asm volatile("s_waitcnt lgkmcnt(0)" ::: "memory");
#pragma unroll
    for (int jj = 0; jj < 4; ++jj) { const int n = (lane >> 3) + 8 * jj; const LAS float* s = scr + (8 * c) * 33 + (base >= 0 ? pg::perm32(n) : n);
        u32x4 o; o.x = cvt_pk_bf16(s[0 * 33], s[1 * 33]); o.y = cvt_pk_bf16(s[2 * 33], s[3 * 33]); o.z = cvt_pk_bf16(s[4 * 33], s[5 * 33]); o.w = cvt_pk_bf16(s[6 * 33], s[7 * 33]);
        *(u32x4*)(dst + (size_t)n * K + 8 * c) = o; }
    asm volatile("s_waitcnt lgkmcnt(0)" ::: "memory");
}
struct WDesc { const float* W; const float* gain; int ldw, K, wid, ngroups, local; size_t off; };
__device__ __forceinline__ bool w_decode(Frame& F, int it, WDesc& d) {
    if (it < 3328) { d = WDesc{FIN(7), FIN(6), IN_W, 1024, W_IN, 208, it, WS_FWIN}; return true; } it -= 3328;
    if (it < 768) { d = WDesc{FIN(9), FIN(8), 1536, 768, W_QUP, 64, it, WS_FWQUP}; return true; } it -= 768;
    if (it < 512) { d = WDesc{FIN(13), nullptr, 2048, 512, W_KVUP, 64, it, WS_FWKVUP}; return true; } it -= 512;
    if (it < 512) { d = WDesc{FIN(17), nullptr, 1024, 1024, W_OBA, 32, it, WS_FWOBA}; return true; } it -= 512;
    if (it < 512) { d = WDesc{FIN(17) + (size_t)1024 * 1024, nullptr, 1024, 1024, W_OBB, 32, it, WS_FWOBB}; return true; } it -= 512;
    if (it < 512) { d = WDesc{FIN(18), nullptr, 1024, 1024, W_OUT, 32, it, WS_FWOUT}; return true; } it -= 512;
    if (it < 2816) { d = WDesc{FIN(20), FIN(19), FF2, 1024, W_UP, 176, it, WS_FWUP}; return true; } it -= 2816;
    if (it < 1408) { d = WDesc{FIN(23), nullptr, 1024, D_FF, W_DOWN, 32, it, WS_FWDOWN}; return true; }
    return false;
}
__device__ __forceinline__ void p0_all_weights(Frame& F, LAS float* scr, int gw, int NGW, int it_lo, int it_hi) {
    for (int it = it_lo + gw; it < it_hi; it += 2 * NGW) {
        WDesc dA, dB; w_decode(F, it, dA); const bool hasB = (it + NGW < it_hi) && w_decode(F, it + NGW, dB);
        const int gdA = dA.local % dA.ngroups, kbA = dA.local / dA.ngroups, baseA = w_group_base(dA.wid, gdA);
        const int gdB = hasB ? dB.local % dB.ngroups : 0, kbB = hasB ? dB.local / dB.ngroups : 0, baseB = hasB ? w_group_base(dB.wid, gdB) : -1;
        WItemRegs RA, RB;
        p0_item_load(RA, dA.W, dA.ldw, dA.gain, baseA, kbA, F.lane);
        if (hasB) p0_item_load(RB, dB.W, dB.ldw, dB.gain, baseB, kbB, F.lane);
        p0_item_finish(RA, dA.W, dA.ldw, dA.K, dA.gain, dA.wid, baseA, (bf16_t*)(F.ws + dA.off), gdA, kbA, scr, F.lane);
        if (hasB) p0_item_finish(RB, dB.W, dB.ldw, dB.K, dB.gain, dB.wid, baseB, (bf16_t*)(F.ws + dB.off), gdB, kbB, scr, F.lane);
    }
}
__device__ __forceinline__ void cache_convert(Frame& F, int gt, int NG) {
    bf16_t* lats = (bf16_t*)(F.ws + WS_LATS); bf16_t* pes = (bf16_t*)(F.ws + WS_PES);
    for (int i0 = gt; i0 < DEC_BATCH * PAST * (KV_LORA / 4); i0 += 4 * NG) { f32x4 v[4];
#pragma unroll
        for (int qq = 0; qq < 4; ++qq) v[qq] = __builtin_nontemporal_load((const f32x4*)FIN(2) + i0 + qq * NG);
#pragma unroll
        for (int qq = 0; qq < 4; ++qq) { const int i = i0 + qq * NG, c4 = i % (KV_LORA / 4), rj = i / (KV_LORA / 4), jr = rj % PAST, b = rj / PAST; u32x2 w; w.x = cvt_pk_bf16(v[qq][0], v[qq][1]); w.y = cvt_pk_bf16(v[qq][2], v[qq][3]);
            *(u32x2*)(lats + ((size_t)b * SKEYS + jr) * KV_LORA + c4 * 4) = w; } }
    for (int i = gt; i < DEC_BATCH * PAST * (QK_ROPE / 4); i += NG) { const int c4 = i % (QK_ROPE / 4), rj = i / (QK_ROPE / 4), jr = rj % PAST, b = rj / PAST;
        const f32x4 v = __builtin_nontemporal_load((const f32x4*)FIN(3) + i); u32x2 w; w.x = cvt_pk_bf16(v[0], v[1]); w.y = cvt_pk_bf16(v[2], v[3]);
        *(u32x2*)(pes + ((size_t)b * SKEYS + jr) * QK_ROPE + c4 * 4) = w; }
    }
__device__ __forceinline__ float2 rope_cs(int pos, double f) {
    const double t = (double)pos * f * 0.15915494309189535; const float rev = (float)(t - rint(t));
    return make_float2(__builtin_amdgcn_cosf(rev), __builtin_amdgcn_sinf(rev));
}
__device__ __forceinline__ void p0_prologue(Frame& F) {
    LAS float* scr = (LAS float*)(F.lds + F.wave * 16384);
    const int gw = F.vcu * 8 + F.wave, NGW = F.G * 8;
    if (F.vcu == 0 && F.tid < 128) ((float*)(F.ws + WS_SSQS))[F.tid] = 0.f;
    probe_stamp(F, 20);
    p0_all_weights(F, scr, gw, NGW, 0, 4608);
    probe_stamp(F, 21);
    {   bf16_t* XN = (bf16_t*)(F.ws + WS_XN);
        for (int r = gw; r < MPAD; r += 2 * NGW) {
            const int r2 = r + NGW; f32x4 v[2][4];
#pragma unroll
            for (int q = 0; q < 2; ++q) { const int rr = q ? r2 : r; if (rr < MT) { const float* x = rr < MP ? FIN(0) + (size_t)rr * D_MODEL : FIN(1) + (size_t)(rr - MP) * D_MODEL; const f32x4* xr = (const f32x4*)x + F.lane;
#pragma unroll
                    for (int jj = 0; jj < 4; ++jj) v[q][jj] = __builtin_nontemporal_load(xr + 64 * jj); } else {
#pragma unroll
                    for (int jj = 0; jj < 4; ++jj) v[q][jj] = (f32x4){0.f, 0.f, 0.f, 0.f}; } }
#pragma unroll
            for (int q = 0; q < 2; ++q) { const int rr = q ? r2 : r; if (rr >= MPAD) continue; float s = 0.f;
#pragma unroll
                for (int jj = 0; jj < 4; ++jj) s += (v[q][jj][0] * v[q][jj][0] + v[q][jj][1] * v[q][jj][1]) + (v[q][jj][2] * v[q][jj][2] + v[q][jj][3] * v[q][jj][3]);
                const float inv = rsqrtf(fwave_sum(s) * (1.f / D_MODEL) + EPS); u32x2* o8 = (u32x2*)(XN + (size_t)rr * D_MODEL) + F.lane;
#pragma unroll
                for (int jj = 0; jj < 4; ++jj) { u32x2 w; w.x = cvt_pk_bf16(v[q][jj][0] * inv, v[q][jj][1] * inv); w.y = cvt_pk_bf16(v[q][jj][2] * inv, v[q][jj][3] * inv); o8[64 * jj] = w; } }
        } }
    {   const int gt = F.vcu * NTHR + F.tid, NG = F.G * NTHR;
        probe_stamp(F, 23);
        float2* tab32 = (float2*)(F.ws + WS_TAB32); float2* tab64 = (float2*)(F.ws + WS_TAB64);
        {   const int k64 = gt & 63, k32 = gt & 31;
            const double f64 = exp2(-(double)k64 * (13.287712379549449 / 64.0)), f32 = exp2(-(double)k32 * (13.287712379549449 / 32.0));
            for (int i = gt; i < 8192 * 64; i += NG) { tab64[i] = rope_cs(i >> 6, f64); if (i < 8192 * 32) tab32[i] = rope_cs(i >> 5, f32); } } }
}

__device__ __forceinline__ void p1_late_prologue(Frame& F) {
    if (F.j < 16) return;
    const int q = F.x * 16 + (F.j - 16);
    LAS float* scr = (LAS float*)(F.lds + F.wave * 16384);
    p0_all_weights(F, scr, q * 8 + F.wave, 128 * 8, 4608, 6144);
    if (F.j >= 24) cache_convert(F, ((F.j - 24) * 8 + F.x) * NTHR + F.tid, 64 * NTHR);
}
__device__ __forceinline__ bool reg_unit(int x, int j, int i, int nN, int& pm, int& pn) { const int u = j + 32 * i; if (u >= 8 * nN) return false; pm = 8 * x + (u & 7); pn = u >> 3; return true; }
#define LDS_F(off) ((LAS float*)(lds + EPI_OFF) + (off))

enum { K_QLAT = 0, K_KVLAT, K_KPE, K_RQ, K_RK, K_RV, K_RG, K_GS, K_QUP, K_KVP, K_KVS, K_GA, K_AD, K_GB, K_RD, K_OUT, K_UP, K_DOWN };
struct SchedP1 {
    int x, j; const char* ws;
    __device__ __forceinline__ bool next(int i, pg::UnitG& u) const {
        int pm, pn;
        if (!reg_unit(x, j, i, 18, pm, pn)) { if (i == 4 && j >= 16) { const int k = (j - 16) * 8 + x; if (k >= 26) return false; pm = 64; pn = k; } else return false; }
        u.pm = pm; u.pn = pn; u.A = ws + WS_XN + (size_t)pm * 256 * 2048; u.B = ws + WS_FWIN + (size_t)pn * 256 * 2048; u.lda = 2048; u.ldb = 2048; u.nt = 16; u.half = pm == 64;
        u.kind = pn < 3 ? K_QLAT : pn < 5 ? K_KVLAT : pn == 5 ? K_KPE : pn < 8 ? K_RQ : pn < 10 ? K_RK : pn < 14 ? K_RV : pn < 18 ? K_RG : K_GS;
        return true;
    }
};
struct EpiP1 {
    unsigned char* ws; float* out; const float *g_kvlat, *g_kr;
    __device__ __forceinline__ void operator()(const pg::Acc& acc, const pg::UnitG& u, LAS unsigned char* lds, int wr, int wc, int fr, int fq) const {
        bf16_t* const ZQ = (bf16_t*)(ws + WS_ZQ); bf16_t* const KVL = (bf16_t*)(ws + WS_KVL); bf16_t* const KPE = (bf16_t*)(ws + WS_KPE); bf16_t* const PES = (bf16_t*)(ws + WS_PES); bf16_t* const LATS = (bf16_t*)(ws + WS_LATS);
        bf16_t* const RQ = (bf16_t*)(ws + WS_RQ); bf16_t* const RK = (bf16_t*)(ws + WS_RK); bf16_t* const RV = (bf16_t*)(ws + WS_RV); bf16_t* const RG = (bf16_t*)(ws + WS_RG);
        float* const slotq = (float*)(ws + WS_SLOTQ); float* const slotkv = (float*)(ws + WS_SLOTKV);
        const float2* const tab32 = (const float2*)(ws + WS_TAB32); const float2* const tab64 = (const float2*)(ws + WS_TAB64);
        int rl0 = wr * 64 + fr, cw = wc * 32 + fq * 8; asm volatile("" : "+v"(rl0), "+v"(cw));
        const int kind = u.kind, rb = u.pm * 256 + rl0;
        if (kind == K_QLAT || kind == K_KVLAT) {
            const int t = kind == K_QLAT ? u.pn : u.pn - 3; const int ld = kind == K_QLAT ? Q_LORA : KV_LORA; bf16_t* dst = kind == K_QLAT ? ZQ : KVL;
            f32x4 g[2][2];
#pragma unroll
            for (int bj = 0; bj < 2; ++bj)
#pragma unroll
                for (int n = 0; n < 2; ++n) g[bj][n] = kind == K_KVLAT ? *(const f32x4*)(g_kvlat + t * 256 + bj * 128 + cw + 4 * n) : (f32x4){1.f, 1.f, 1.f, 1.f};
#pragma unroll
            for (int ai = 0; ai < 2; ++ai)
#pragma unroll
                for (int m = 0; m < 4; ++m) { const int row = rb + ai * 128 + m * 16; float ss = 0.f;
                    const bool snew = (kind == K_KVLAT) && row >= MP && row < MT;
                    const int rs = row - MP; bf16_t* lrow = LATS + ((size_t)(rs / DEC_SEQ) * SKEYS + PAST + (rs % DEC_SEQ)) * KV_LORA;
#pragma unroll
                    for (int bj = 0; bj < 2; ++bj) { const f32x4 v0 = acc[ai][bj][m][0], v1 = acc[ai][bj][m][1];
                        ss += (v0[0] * v0[0] + v0[1] * v0[1]) + (v0[2] * v0[2] + v0[3] * v0[3]) + (v1[0] * v1[0] + v1[1] * v1[1]) + (v1[2] * v1[2] + v1[3] * v1[3]);
                        const u32x4 w = pack8f(v0 * g[bj][0], v1 * g[bj][1]);
                        *(u32x4*)(dst + (size_t)row * ld + t * 256 + bj * 128 + cw) = w;
                        if (snew) *(u32x4*)(lrow + t * 256 + bj * 128 + cw) = w; }
                    ss += __shfl_xor(ss, 16); ss += __shfl_xor(ss, 32);
                    if (fq == 0) { if (kind == K_QLAT) slotq[(size_t)row * 12 + t * 4 + wc] = ss; else slotkv[(size_t)row * 8 + t * 4 + wc] = ss; } }
        } else if (kind == K_KPE) {
            if (wc != 0) return;
            const int d0 = fq * 8;
            f32x4 g1[2], g2[2];
#pragma unroll
            for (int n = 0; n < 2; ++n) { g1[n] = *(const f32x4*)(g_kr + d0 + 4 * n); g2[n] = *(const f32x4*)(g_kr + 32 + d0 + 4 * n); }
#pragma unroll
            for (int ai = 0; ai < 2; ++ai)
#pragma unroll
                for (int m = 0; m < 4; ++m) { const int row = rb + ai * 128 + m * 16; const int pos = row_pos(row < MT ? row : 0);
                    f32x4 x1[2], x2[2]; float ss = 0.f;
#pragma unroll
                    for (int n = 0; n < 2; ++n) { x1[n] = acc[ai][0][m][n]; x2[n] = acc[ai][1][m][n];
                        ss += (x1[n][0] * x1[n][0] + x1[n][1] * x1[n][1]) + (x1[n][2] * x1[n][2] + x1[n][3] * x1[n][3]) + (x2[n][0] * x2[n][0] + x2[n][1] * x2[n][1]) + (x2[n][2] * x2[n][2] + x2[n][3] * x2[n][3]); }
                    ss += __shfl_xor(ss, 16); ss += __shfl_xor(ss, 32);
                    const float inv = rsqrtf(ss * (1.f / 64.f) + EPS);
                    f32x4 o1[2], o2[2];
#pragma unroll
                    for (int n = 0; n < 2; ++n) { const f32x4 y1 = x1[n] * inv * g1[n], y2 = x2[n] * inv * g2[n];
                        const f32x4 cs0 = *(const f32x4*)(tab32 + pos * 32 + d0 + 4 * n), cs1 = *(const f32x4*)(tab32 + pos * 32 + d0 + 4 * n + 2);
                        const f32x4 c = {cs0[0], cs0[2], cs1[0], cs1[2]}, s = {cs0[1], cs0[3], cs1[1], cs1[3]};
                        o1[n] = y1 * c - y2 * s; o2[n] = y1 * s + y2 * c; }
                    *(u32x4*)(KPE + (size_t)row * 64 + d0) = pack8f(o1[0], o1[1]); *(u32x4*)(KPE + (size_t)row * 64 + 32 + d0) = pack8f(o2[0], o2[1]);
                    if (row < MT) {
                        float* o = row < MP ? out + O_RKP + (size_t)row * 64 : out + O_RKS + (size_t)(row - MP) * 64;
                        *(f32x4*)(o + d0) = o1[0]; *(f32x4*)(o + d0 + 4) = o1[1]; *(f32x4*)(o + 32 + d0) = o2[0]; *(f32x4*)(o + 32 + d0 + 4) = o2[1];
                        if (row >= MP) { const int rs = row - MP, b = rs / DEC_SEQ, tt = rs % DEC_SEQ; bf16_t* p = PES + ((size_t)b * SKEYS + PAST + tt) * 64;
                            *(u32x4*)(p + d0) = pack8f(o1[0], o1[1]); *(u32x4*)(p + 32 + d0) = pack8f(o2[0], o2[1]); } } }
        } else if (kind == K_RQ || kind == K_RK) {
            const int tl = kind == K_RQ ? u.pn - 6 : u.pn - 8; const int head = 2 * tl + (wc >> 1), i0 = 32 * (wc & 1) + fq * 8;
            bf16_t* dst = kind == K_RQ ? RQ : RK; const float sc = kind == K_RQ ? 1.0f : 0.08838834764831845f;
#pragma unroll
            for (int ai = 0; ai < 2; ++ai)
#pragma unroll
                for (int m = 0; m < 4; ++m) { const int row = rb + ai * 128 + m * 16; const int pos = row_pos(row < MT ? row : 0);
                    f32x4 o1[2], o2[2];
#pragma unroll
                    for (int n = 0; n < 2; ++n) { const f32x4 x1 = acc[ai][0][m][n], x2 = acc[ai][1][m][n];
                        const f32x4 cs0 = *(const f32x4*)(tab64 + pos * 64 + i0 + 4 * n), cs1 = *(const f32x4*)(tab64 + pos * 64 + i0 + 4 * n + 2);
                        const f32x4 c = {cs0[0], cs0[2], cs1[0], cs1[2]}, s = {cs0[1], cs0[3], cs1[1], cs1[3]};
                        o1[n] = (x1 * c - x2 * s) * sc; o2[n] = (x1 * s + x2 * c) * sc; }
                    *(u32x4*)(dst + (size_t)row * 512 + head * 128 + i0) = pack8f(o1[0], o1[1]); *(u32x4*)(dst + (size_t)row * 512 + head * 128 + 64 + i0) = pack8f(o2[0], o2[1]); }
        } else if (kind == K_GS) {
            bf16_t* dst = (bf16_t*)(ws + (u.pn < 22 ? WS_GAS : WS_GBS)); const int t = u.pn < 22 ? u.pn - 18 : u.pn - 22;
#pragma unroll
            for (int m = 0; m < 4; ++m) { const int rl = rl0 + m * 16;
#pragma unroll
                for (int bj = 0; bj < 2; ++bj) { f32x4 v0 = acc[0][bj][m][0], v1 = acc[0][bj][m][1];
#pragma unroll
                    for (int e = 0; e < 4; ++e) { v0[e] = __builtin_amdgcn_rcpf(1.f + __expf(-v0[e])); v1[e] = __builtin_amdgcn_rcpf(1.f + __expf(-v1[e])); }
                    *(u32x4*)(dst + (size_t)rl * 1024 + t * 256 + bj * 128 + cw) = pack8f_t(v0, v1); } }
        } else {
            const int t = kind == K_RV ? u.pn - 10 : u.pn - 14; bf16_t* dst = kind == K_RV ? RV : RG;
#pragma unroll
            for (int ai = 0; ai < 2; ++ai)
#pragma unroll
                for (int m = 0; m < 4; ++m) { const int row = rb + ai * 128 + m * 16;
#pragma unroll
                    for (int bj = 0; bj < 2; ++bj) { f32x4 v0 = acc[ai][bj][m][0], v1 = acc[ai][bj][m][1];
                        if (kind == K_RG) {
#pragma unroll
                            for (int e = 0; e < 4; ++e) { v0[e] = v0[e] * __builtin_amdgcn_rcpf(1.f + __expf(-v0[e])); v1[e] = v1[e] * __builtin_amdgcn_rcpf(1.f + __expf(-v1[e])); } }
                        *(u32x4*)(dst + (size_t)row * 1024 + t * 256 + bj * 128 + cw) = pack8f(v0, v1); } }
        }
    }
};
__device__ __forceinline__ void p1_inproj(Frame& F) {
    SchedP1 S{F.x, F.j, (const char*)F.ws};
    EpiP1 E{F.ws, F.out, FIN(12), FIN(15)};
    pg::gemm_stream(F.lds, S, E);
}

__device__ __forceinline__ float slot_rs(const float* slots, int n, float invn) {
    float a = 0.f; for (int i = 0; i < n; i += 4) { const f32x4 v = *(const f32x4*)(slots + i); a += (v[0] + v[1]) + (v[2] + v[3]); } return rsqrtf(a * invn + EPS);
}
struct SchedP2 {
    int x, j; const char* ws; int sample;
    __device__ __forceinline__ bool next(int i, pg::UnitG& u) const {
        int pm, pn, kind;
        if (sample) {
            if (i < 2) { reg_unit(x, j, i, 8, pm, pn); kind = K_QUP; }
            else if (i < 4) { reg_unit(x, j, i - 2, 8, pm, pn); kind = K_KVS; }
            else if (i == 4 && j < 2) { const int k = j * 8 + x; pm = 64; pn = k & 7; kind = k < 8 ? K_QUP : K_KVS; }
            else return false;
        } else { if (i >= 2) return false; reg_unit(x, j, i, 8, pm, pn); kind = K_KVP; }
        u.pm = pm; u.pn = pn; u.kind = kind; u.half = pm == 64;
        if (kind == K_QUP) { u.A = ws + WS_ZQ + (size_t)pm * 256 * 1536; u.lda = 1536; u.B = ws + WS_FWQUP + (size_t)pn * 256 * 1536; u.ldb = 1536; u.nt = 12; }
        else { u.A = ws + (kind == K_KVS ? WS_LATS : WS_KVL) + (size_t)pm * 256 * 1024; u.lda = 1024; u.B = ws + WS_FWKVUP + (size_t)pn * 256 * 1024; u.ldb = 1024; u.nt = 8; }
        return true;
    }
};
struct EpiP2 {
    unsigned char* ws; float* out; const float *g_qn, *g_qr, *g_kn;
    __device__ __forceinline__ void operator()(const pg::Acc& acc, const pg::UnitG& u, LAS unsigned char* lds, int wr, int wc, int fr, int fq) const {
        int rl0 = wr * 64 + fr, cw = wc * 32 + fq * 8; asm volatile("" : "+v"(rl0), "+v"(cw));
        const int kind = u.kind, h = u.pn, rb = u.pm * 256 + rl0;
        const float* const rsq = (const float*)(ws + WS_RSQ); const float* const rskv = (const float*)(ws + WS_RSKV);
        float rs[2][4];
#pragma unroll
        for (int ai = 0; ai < 2; ++ai)
#pragma unroll
            for (int m = 0; m < 4; ++m) { const int row = rb + ai * 128 + m * 16;
                if (kind == K_QUP) rs[ai][m] = rsq[row];
                else if (kind == K_KVP) rs[ai][m] = rskv[row];
                else { const int b = row / SKEYS, jj = row - b * SKEYS; rs[ai][m] = (row < LROWS && jj >= PAST) ? rskv[MP + b * DEC_SEQ + jj - PAST] : 1.f; } }
#pragma unroll
        for (int ai = 0; ai < 2; ++ai)
#pragma unroll
            for (int m = 0; m < 4; ++m) { float p0 = 0.f, p1 = 0.f; const float s2 = rs[ai][m] * rs[ai][m];
#pragma unroll
                for (int n = 0; n < 2; ++n) { const f32x4 a = acc[ai][0][m][n], b = acc[ai][1][m][n];
                    p0 += (a[0] * a[0] + a[1] * a[1]) + (a[2] * a[2] + a[3] * a[3]); p1 += (b[0] * b[0] + b[1] * b[1]) + (b[2] * b[2] + b[3] * b[3]); }
                p0 += __shfl_xor(p0, 16); p0 += __shfl_xor(p0, 32); p1 += __shfl_xor(p1, 16); p1 += __shfl_xor(p1, 32);
                if (fq == 0) { LAS float* d = LDS_F((rl0 + ai * 128 + m * 16) * 8 + wc * 2); d[0] = p0 * s2; d[1] = p1 * s2; } }
        asm volatile("s_waitcnt lgkmcnt(0)" ::: "memory"); __builtin_amdgcn_s_barrier(); asm volatile("" ::: "memory");
        if (kind == K_QUP) {
            bf16_t* const Q = (bf16_t*)out;
            const float2* const tab32 = (const float2*)(ws + WS_TAB32);
            const float C2 = 0.07216878364870323f * 1.4426950408889634f;
            f32x4 gn[2]; gn[0] = *(const f32x4*)(g_qn + cw); gn[1] = *(const f32x4*)(g_qn + cw + 4);
            const int ir = 16 * (wc & 1) + 4 * fq; const f32x4 gr1 = *(const f32x4*)(g_qr + ir), gr2 = *(const f32x4*)(g_qr + 32 + ir);
#pragma unroll
            for (int ai = 0; ai < 2; ++ai)
#pragma unroll
                for (int m = 0; m < 4; ++m) { const int row = rb + ai * 128 + m * 16; const int pos = row_pos(row < MT ? row : 0);
                    const LAS float* d = LDS_F((rl0 + ai * 128 + m * 16) * 8); const f32x4 e0 = *(const LAS f32x4*)d, e1 = *(const LAS f32x4*)(d + 4);
                    const float inn = rsqrtf((e0[0] + e0[2] + e1[0] + e1[2]) * (1.f / 128.f) + EPS) * rs[ai][m] * C2, inr = rsqrtf((e0[1] + e0[3]) * (1.f / 64.f) + EPS) * rs[ai][m];
                    bf16_t* qrow = Q + (size_t)row * 1536 + h * 192;
                    *(u32x4*)(qrow + cw) = pack8f(acc[ai][0][m][0] * inn * gn[0], acc[ai][0][m][1] * inn * gn[1]);
                    if (wc < 2) { const f32x4 y1 = acc[ai][1][m][0] * inr * gr1, y2 = acc[ai][1][m][1] * inr * gr2;
                        const f32x4 cs0 = *(const f32x4*)(tab32 + pos * 32 + ir), cs1 = *(const f32x4*)(tab32 + pos * 32 + ir + 2);
                        const f32x4 c = {cs0[0], cs0[2], cs1[0], cs1[2]}, s = {cs0[1], cs0[3], cs1[1], cs1[3]};
                        const f32x4 o1 = (y1 * c - y2 * s) * C2, o2 = (y1 * s + y2 * c) * C2;
                        u32x2 w1, w2; w1.x = cvt_pk_bf16(o1[0], o1[1]); w1.y = cvt_pk_bf16(o1[2], o1[3]); w2.x = cvt_pk_bf16(o2[0], o2[1]); w2.y = cvt_pk_bf16(o2[2], o2[3]);
                        *(u32x2*)(qrow + 128 + ir) = w1; *(u32x2*)(qrow + 160 + ir) = w2; } }
        } else {
            bf16_t* const KN = (bf16_t*)(ws + WS_KN); bf16_t* const V = (bf16_t*)(ws + WS_V);
            f32x4 gk[2]; gk[0] = *(const f32x4*)(g_kn + cw); gk[1] = *(const f32x4*)(g_kn + cw + 4);
#pragma unroll
            for (int ai = 0; ai < 2; ++ai)
#pragma unroll
                for (int m = 0; m < 4; ++m) { const int row = rb + ai * 128 + m * 16;
                    const LAS float* d = LDS_F((rl0 + ai * 128 + m * 16) * 8); const f32x4 e0 = *(const LAS f32x4*)d, e1 = *(const LAS f32x4*)(d + 4);
                    const float s = rs[ai][m], inn = rsqrtf((e0[0] + e0[2] + e1[0] + e1[2]) * (1.f / 128.f) + EPS) * s;
                    *(u32x4*)(KN + (size_t)row * 1024 + h * 128 + cw) = pack8f(acc[ai][0][m][0] * inn * gk[0], acc[ai][0][m][1] * inn * gk[1]);
                    *(u32x4*)(V + (size_t)row * 1024 + h * 128 + cw) = pack8f(acc[ai][1][m][0] * s, acc[ai][1][m][1] * s); }
        }
    }
};
__device__ __forceinline__ void p2_qkv(Frame& F, int sample) {
    SchedP2 S{F.x, F.j, (const char*)F.ws, sample};
    EpiP2 E{F.ws, F.out, FIN(10), FIN(11), FIN(14)};
    pg::gemm_stream(F.lds, S, E);
}

struct SchedP5 {
    int x, j, vcu; const char* ws; int phase;
    int i_lo, i_hi;
    int umap;
    __device__ __forceinline__ const char* arow(size_t base, size_t base_s, int pm, size_t rowbytes) const { return ws + (pm < 64 ? base + (size_t)pm * 256 * rowbytes : base_s); }
    __device__ __forceinline__ bool next(int i, pg::UnitG& u) const {
        int pm, pn;
        if (phase == 5) {
            int sub;
            if (i < 4) { sub = i; pm = 8 * x + (j & 7); pn = j >> 3; } else return false;
            u.pm = pm; u.pn = pn; u.kind = K_GA + sub; u.lda = 2048; u.ldb = 2048; u.nt = 16; u.half = pm == 64;
            if (sub == 0) { u.A = ws + WS_XN2 + (size_t)pm * 256 * 2048; u.B = ws + WS_FWIN + (size_t)(18 + pn) * 256 * 2048; }
            else if (sub == 1) { u.A = arow(WS_ATT, WS_ATTS, pm, 2048); u.B = ws + WS_FWOBA + (size_t)pn * 256 * 2048; }
            else if (sub == 2) { u.A = ws + WS_XN2 + (size_t)pm * 256 * 2048; u.B = ws + WS_FWIN + (size_t)(22 + pn) * 256 * 2048; }
            else { u.A = ws + WS_RET + (size_t)pm * 256 * 2048; u.B = ws + WS_FWOBB + (size_t)pn * 256 * 2048; }
            return true;
        }
        if (phase == 6 || phase == 9) {
            if (i == 0) { pm = 8 * x + (j & 7); pn = j >> 3; } else return false;
            u.pm = pm; u.pn = pn; u.half = pm == 64;
            if (phase == 6) { u.kind = K_OUT; u.A = ws + WS_MERGED + (size_t)pm * 256 * 2048; u.lda = 2048; u.B = ws + WS_FWOUT + (size_t)pn * 256 * 2048; u.ldb = 2048; u.nt = 16; }
            else { u.kind = K_DOWN; u.A = ws + WS_UG + (size_t)pm * 256 * (D_FF * 2); u.lda = D_FF * 2; u.B = ws + WS_FWDOWN + (size_t)pn * 256 * (D_FF * 2); u.ldb = D_FF * 2; u.nt = 44; }
            return true;
        }
        if (i_lo < 0) { if (i > 0) return false; pm = 64; pn = i_hi; }
        else if (umap) { const int ii = i + i_lo, q = j >> 3; if (ii >= i_hi) return false;
            if (ii < 4) pn = q + 4 * ii; else if (q == 3) return false; else if (ii == 4) pn = q + 16; else if (ii == 5) pn = q == 2 ? 19 : 20 + q; else return false;
            pm = 8 * x + (j & 7); }
        else if (i + i_lo >= i_hi || !reg_unit(x, j, i + i_lo, 22, pm, pn)) return false;
        u.half = pm == 64; u.pm = pm; u.pn = pn; u.kind = K_UP; u.A = ws + WS_X1B + (size_t)pm * 256 * 2048; u.lda = 2048; u.B = ws + WS_FWUP + (size_t)pn * 256 * 2048; u.ldb = 2048; u.nt = 16;
        return true;
    }
};
struct EpiP5 {
    unsigned char* ws; float* out; const float* xp; const float* xs; int vcu;
    __device__ __forceinline__ void operator()(pg::Acc& acc, const pg::UnitG& u, LAS unsigned char* lds, int wr, int wc, int fr, int fq) const {
        int rl0 = wr * 64 + fr, cw = wc * 32 + fq * 8; asm volatile("" : "+v"(rl0), "+v"(cw));
        const int kind = u.kind, rb = u.pm * 256 + rl0;
        if (kind >= K_GA && kind <= K_RD) {
            bf16_t* const T1 = (bf16_t*)(ws + WS_T1) + (size_t)vcu * 65536; bf16_t* const T2 = (bf16_t*)out + (size_t)vcu * 65536;
            bf16_t* const MG = (bf16_t*)(ws + WS_MERGED);
#pragma unroll
            for (int ai = 0; ai < 2; ++ai)
#pragma unroll
                for (int m = 0; m < 4; ++m)
#pragma unroll
                    for (int bj = 0; bj < 2; ++bj) { const size_t so = (size_t)(rl0 + ai * 128 + m * 16) * 256 + bj * 128 + cw;
                        f32x4 v0 = acc[ai][bj][m][0], v1 = acc[ai][bj][m][1];
                        if (kind == K_GA || kind == K_GB) {
#pragma unroll
                            for (int e = 0; e < 4; ++e) { v0[e] = __builtin_amdgcn_rcpf(1.f + __expf(-v0[e])); v1[e] = __builtin_amdgcn_rcpf(1.f + __expf(-v1[e])); }
                            *(u32x4*)((kind == K_GA ? T1 : T2) + so) = pack8f_t(v0, v1);
                        } else if (kind == K_AD) {
                            const u32x4 t = u.pm == 64 ? *(const u32x4*)((const bf16_t*)(ws + WS_GAS) + (size_t)(rl0 + ai * 128 + m * 16) * 1024 + u.pn * 256 + bj * 128 + cw) : *(const u32x4*)(T1 + so);
                            const f32x4 g0 = {__uint_as_float(t.x << 16), __uint_as_float(t.x & 0xffff0000u), __uint_as_float(t.y << 16), __uint_as_float(t.y & 0xffff0000u)};
                            const f32x4 g1 = {__uint_as_float(t.z << 16), __uint_as_float(t.z & 0xffff0000u), __uint_as_float(t.w << 16), __uint_as_float(t.w & 0xffff0000u)};
                            *(u32x4*)(T1 + so) = pack8f(v0 * g0, v1 * g1);
                        } else {
                            const u32x4 t = *(const u32x4*)(T1 + so), q = u.pm == 64 ? *(const u32x4*)((const bf16_t*)(ws + WS_GBS) + (size_t)(rl0 + ai * 128 + m * 16) * 1024 + u.pn * 256 + bj * 128 + cw) : *(const u32x4*)(T2 + so);
                            const f32x4 a0 = {__uint_as_float(t.x << 16), __uint_as_float(t.x & 0xffff0000u), __uint_as_float(t.y << 16), __uint_as_float(t.y & 0xffff0000u)};
                            const f32x4 a1 = {__uint_as_float(t.z << 16), __uint_as_float(t.z & 0xffff0000u), __uint_as_float(t.w << 16), __uint_as_float(t.w & 0xffff0000u)};
                            const f32x4 g0 = {__uint_as_float(q.x << 16), __uint_as_float(q.x & 0xffff0000u), __uint_as_float(q.y << 16), __uint_as_float(q.y & 0xffff0000u)};
                            const f32x4 g1 = {__uint_as_float(q.z << 16), __uint_as_float(q.z & 0xffff0000u), __uint_as_float(q.w << 16), __uint_as_float(q.w & 0xffff0000u)};
                            *(u32x4*)(MG + (size_t)(rb + ai * 128 + m * 16) * 1024 + u.pn * 256 + bj * 128 + cw) = pack8f(a0 + v0 * g0, a1 + v1 * g1);
                        }
                        if (bj == 1 && (m & 1)) asm volatile("" ::: "memory"); }
        } else if (kind == K_OUT) {
            float* const slotx = (float*)(ws + WS_SLOTX1); bf16_t* const X1B = (bf16_t*)(ws + WS_X1B);
#pragma unroll
            for (int ai = 0; ai < 2; ++ai)
#pragma unroll
                for (int m = 0; m < 4; ++m) { const int row = rb + ai * 128 + m * 16; float ss = 0.f;
                    const float* xr = row < MP ? xp + (size_t)row * D_MODEL : xs + (size_t)((row < MT ? row : MP) - MP) * D_MODEL;
#pragma unroll
                    for (int bj = 0; bj < 2; ++bj) { const int c = u.pn * 256 + bj * 128 + cw;
                        const f32x4 x0 = __builtin_nontemporal_load((const f32x4*)(xr + c)), x1 = __builtin_nontemporal_load((const f32x4*)(xr + c + 4));
                        const f32x4 v0 = acc[ai][bj][m][0] + x0, v1 = acc[ai][bj][m][1] + x1;
                        ss += (v0[0] * v0[0] + v0[1] * v0[1]) + (v0[2] * v0[2] + v0[3] * v0[3]) + (v1[0] * v1[0] + v1[1] * v1[1]) + (v1[2] * v1[2] + v1[3] * v1[3]);
                        *(u32x4*)(X1B + (size_t)row * D_MODEL + c) = pack8f(v0, v1); }
                    ss += __shfl_xor(ss, 16); ss += __shfl_xor(ss, 32);
                    if (fq == 0) slotx[(size_t)row * 16 + u.pn * 4 + wc] = ss;
                    if (m & 1) asm volatile("" ::: "memory"); }
        } else if (kind == K_UP) {
            bf16_t* const U = (bf16_t*)(ws + WS_UG); bf16_t* const UVb = (bf16_t*)(ws + WS_UV);
#pragma unroll
            for (int ai = 0; ai < 2; ++ai)
#pragma unroll
                for (int m = 0; m < 4; ++m) { const int row = rb + ai * 128 + m * 16;
                    const float s = *LDS_F(rl0 + ai * 128 + m * 16);
                    const f32x4 ug0 = acc[ai][0][m][0] * s, ug1 = acc[ai][0][m][1] * s, uv0 = acc[ai][1][m][0] * s, uv1 = acc[ai][1][m][1] * s;
                    const u32x4 wg = pack8f(ug0, ug1), wv = pack8f(uv0, uv1); const int cg = u.pn * 128 + cw, cv = D_FF + cg;
                    *(u32x4*)(U + (size_t)row * D_FF + cg) = wg; *(u32x4*)(UVb + (size_t)row * D_FF + cg) = wv;
                    if ((row & 255) >= 254 && row < MP - 2) { bf16_t* hp = (bf16_t*)(ws + WS_HALO) + ((size_t)((row >> 8) + 1) * 2 + (row & 1)) * FF2; st16_sc1(hp + cg, wg); st16_sc1(hp + cv, wv); }
                    if (row < MT) { const int tpos = row < MP ? (row & (SEQ - 1)) - (SEQ - 2) : ((row - MP) & (DEC_SEQ - 1)) - (DEC_SEQ - 2);
                        if (tpos >= 0) { float* cp = row < MP ? out + O_CONVP + ((size_t)(row >> 13) * 2 + tpos) * FF2 : out + O_CONVS + ((size_t)((row - MP) >> 4) * 2 + tpos) * FF2;
                            *(f32x4*)(cp + cg) = ug0; *(f32x4*)(cp + cg + 4) = ug1; *(f32x4*)(cp + cv) = uv0; *(f32x4*)(cp + cv + 4) = uv1; } }
                    if (m & 1) asm volatile("" ::: "memory"); }
        } else {
            const bf16_t* const X1B = (const bf16_t*)(ws + WS_X1B);
#pragma unroll
            for (int ai = 0; ai < 2; ++ai)
#pragma unroll
                for (int m = 0; m < 4; ++m) { const int row = rb + ai * 128 + m * 16;
#pragma unroll
                    for (int bj = 0; bj < 2; ++bj) { const int c = u.pn * 256 + bj * 128 + cw; float* p = out + (size_t)row * D_MODEL + c;
                        const u32x4 t = *(const u32x4*)(X1B + (size_t)row * D_MODEL + c);
                        const f32x4 x0 = {__uint_as_float(t.x << 16), __uint_as_float(t.x & 0xffff0000u), __uint_as_float(t.y << 16), __uint_as_float(t.y & 0xffff0000u)};
                        const f32x4 x1 = {__uint_as_float(t.z << 16), __uint_as_float(t.z & 0xffff0000u), __uint_as_float(t.w << 16), __uint_as_float(t.w & 0xffff0000u)};
                        __builtin_nontemporal_store(x0 + acc[ai][bj][m][0], (f32x4*)p); __builtin_nontemporal_store(x1 + acc[ai][bj][m][1], (f32x4*)(p + 4)); }
                    asm volatile("" ::: "memory"); }
        }
    }
};
__device__ __forceinline__ void p5_gemm(Frame& F, int phase) {
    SchedP5 S{F.x, F.j, F.vcu, (const char*)F.ws, phase, 0, 1 << 20, 0};
    EpiP5 E{F.ws, F.out, FIN(0), FIN(1), F.vcu};
    pg::gemm_stream(F.lds, S, E);
}

namespace rt {
typedef short s16x4 __attribute__((ext_vector_type(4)));
constexpr int QST = 136, KDST = 144, VST = 272, PST = 72;
constexpr int Q_OFF = 0, QS_OFF = 17408, K_OFF = 34816, KD_OFF = 52224, V_OFF = 70656, P_OFF = 105472, ST_OFF = 114688, RG_OFF = 118784;
constexpr int SC_TOK = 256, NSC = SEQ / SC_TOK;
__device__ __forceinline__ s16x4 trrd(const LAS bf16_t* p) { return __builtin_bit_cast(s16x4, __builtin_amdgcn_ds_read_tr16_b64_v4i16((LAS s16x4*)p)); }
__device__ __forceinline__ bf16x8 cat8(s16x4 lo, s16x4 hi) { return (bf16x8){lo[0], lo[1], lo[2], lo[3], hi[0], hi[1], hi[2], hi[3]}; }
__device__ __forceinline__ u32x4 scale8(u32x4 w, float s) {
    u32x4 o;
    o.x = cvt_pk_bf16(__uint_as_float(w.x << 16) * s, __uint_as_float(w.x & 0xffff0000u) * s); o.y = cvt_pk_bf16(__uint_as_float(w.y << 16) * s, __uint_as_float(w.y & 0xffff0000u) * s);
    o.z = cvt_pk_bf16(__uint_as_float(w.z << 16) * s, __uint_as_float(w.z & 0xffff0000u) * s); o.w = cvt_pk_bf16(__uint_as_float(w.w << 16) * s, __uint_as_float(w.w & 0xffff0000u) * s);
    return o;
}
__device__ __forceinline__ float row16_sum(float v) {
    v += __builtin_bit_cast(float, __builtin_amdgcn_update_dpp(0, __builtin_bit_cast(int, v), 0xB1, 0xf, 0xf, true));
    v += __builtin_bit_cast(float, __builtin_amdgcn_update_dpp(0, __builtin_bit_cast(int, v), 0x4E, 0xf, 0xf, true));
    v += __builtin_bit_cast(float, __builtin_amdgcn_update_dpp(0, __builtin_bit_cast(int, v), 0x141, 0xf, 0xf, true));
    v += __builtin_bit_cast(float, __builtin_amdgcn_update_dpp(0, __builtin_bit_cast(int, v), 0x140, 0xf, 0xf, true));
    return v;
}
template <bool FULL>
__device__ __forceinline__ void ret_unit(Frame& F, int h, int row0, int nch, int L, const float* Sin, float* Sout, const float* g_ret) {
    LAS unsigned char* lds = F.lds;
    const int tid = F.tid, w = F.wave, l = F.lane, fr = l & 15, g = l >> 4, tq = fr >> 2, tp = fr & 3;
    const float lg2 = log2f(1.f - exp2f(-5.f - (float)h));
    const bf16_t* RQ = (const bf16_t*)(F.ws + WS_RQ); const bf16_t* RK = (const bf16_t*)(F.ws + WS_RK); const bf16_t* RV = (const bf16_t*)(F.ws + WS_RV);
    const bf16_t* RG = (const bf16_t*)(F.ws + WS_RG); bf16_t* RET = (bf16_t*)(F.ws + WS_RET);
    LAS bf16_t* q_l = (LAS bf16_t*)(lds + Q_OFF); LAS bf16_t* qs_l = (LAS bf16_t*)(lds + QS_OFF); LAS bf16_t* k_l = (LAS bf16_t*)(lds + K_OFF);
    LAS bf16_t* kd_l = (LAS bf16_t*)(lds + KD_OFF); LAS bf16_t* v_l = (LAS bf16_t*)(lds + V_OFF); LAS bf16_t* p_l = (LAS bf16_t*)(lds + P_OFF); LAS float* st_l = (LAS float*)(lds + ST_OFF);
    LAS bf16_t* g_l = (LAS bf16_t*)(lds + RG_OFF);
    f32x4 S[8][2];
#pragma unroll
    for (int db = 0; db < 8; ++db)
#pragma unroll
        for (int nb = 0; nb < 2; ++nb) {
            if (Sin) { int so = (16 * db + 4 * g) * RET_DV + 32 * w + 16 * nb + fr; asm volatile("" : "+v"(so));
#pragma unroll
                for (int r = 0; r < 4; ++r) S[db][nb][r] = Sin[so + r * RET_DV]; }
            else S[db][nb] = (f32x4){0.f, 0.f, 0.f, 0.f}; }
    const float gL = exp2f(lg2 * (float)L);
    float gr[2]; if (FULL) { gr[0] = g_ret[h * 256 + 32 * w + fr]; gr[1] = g_ret[h * 256 + 32 * w + 16 + fr]; }
    for (int c = 0; c < nch; ++c) {
        const size_t r0 = (size_t)row0 + (size_t)c * L;
        __syncthreads();
        {   u32x4 pk[2], pq[2], pv[4], pgt[4]; const u32x4 z_ = {0u, 0u, 0u, 0u};
#pragma unroll
            for (int it = 0; it < 2; ++it) { const int idx = tid + 512 * it, tok = idx >> 4, c8 = idx & 15; const bool ok = tok < L;
                pk[it] = ok ? *(const u32x4*)(RK + (r0 + tok) * 512 + h * 128 + c8 * 8) : z_; if (FULL) pq[it] = ok ? *(const u32x4*)(RQ + (r0 + tok) * 512 + h * 128 + c8 * 8) : z_; }
#pragma unroll
            for (int it = 0; it < 4; ++it) { const int idx = tid + 512 * it, tok = idx >> 5, c8 = idx & 31; const bool ok = tok < L;
                pv[it] = ok ? *(const u32x4*)(RV + (r0 + tok) * 1024 + h * 256 + c8 * 8) : z_; if (FULL) pgt[it] = ok ? *(const u32x4*)(RG + (r0 + tok) * 1024 + h * 256 + c8 * 8) : z_; }
#pragma unroll
            for (int it = 0; it < 2; ++it) { const int idx = tid + 512 * it, tok = idx >> 4, c8 = idx & 15;
                *(LAS u32x4*)(kd_l + tok * KDST + c8 * 8) = scale8(pk[it], exp2f(lg2 * (float)(L - 1 - tok)));
                if (FULL) { *(LAS u32x4*)(k_l + tok * QST + c8 * 8) = pk[it]; *(LAS u32x4*)(q_l + tok * QST + c8 * 8) = pq[it]; *(LAS u32x4*)(qs_l + tok * QST + c8 * 8) = scale8(pq[it], exp2f(lg2 * (float)(tok + 1))); } }
#pragma unroll
            for (int it = 0; it < 4; ++it) { const int idx = tid + 512 * it, tok = idx >> 5, c8 = idx & 31;
                *(LAS u32x4*)(v_l + tok * VST + c8 * 8) = pv[it]; if (FULL) *(LAS u32x4*)(g_l + tok * VST + c8 * 8) = pgt[it]; } }
        __syncthreads();
        f32x4 o[4][2];
        if (FULL) {
            const int ib = w >> 1, jb0 = 2 * (w & 1);
            f32x4 p0 = {0.f, 0.f, 0.f, 0.f}, p1 = {0.f, 0.f, 0.f, 0.f};
#pragma unroll
            for (int s = 0; s < 4; ++s) { const bf16x8 a = *(const LAS bf16x8*)(q_l + (16 * ib + fr) * QST + 32 * s + 8 * g);
                const bf16x8 b0 = *(const LAS bf16x8*)(k_l + (16 * jb0 + fr) * QST + 32 * s + 8 * g), b1 = *(const LAS bf16x8*)(k_l + (16 * jb0 + 16 + fr) * QST + 32 * s + 8 * g);
                p0 = __builtin_amdgcn_mfma_f32_16x16x32_bf16(a, b0, p0, 0, 0, 0); p1 = __builtin_amdgcn_mfma_f32_16x16x32_bf16(a, b1, p1, 0, 0, 0); }
#pragma unroll
            for (int r = 0; r < 4; ++r) { const int i = 16 * ib + 4 * g + r, j0 = 16 * jb0 + fr, j1 = j0 + 16;
                const float v0 = j0 <= i ? p0[r] * exp2f(lg2 * (float)(i - j0)) : 0.f, v1 = j1 <= i ? p1[r] * exp2f(lg2 * (float)(i - j1)) : 0.f;
                p_l[i * PST + j0] = f2bf(v0); p_l[i * PST + j1] = f2bf(v1); }
            __syncthreads();
#pragma unroll
            for (int i = 0; i < 4; ++i) { o[i][0] = (f32x4){0.f, 0.f, 0.f, 0.f}; o[i][1] = (f32x4){0.f, 0.f, 0.f, 0.f}; }
        }
        bf16x8 vf[2][2];
#pragma unroll
        for (int s = 0; s < 2; ++s)
#pragma unroll
            for (int nb = 0; nb < 2; ++nb) { const LAS bf16_t* pp = v_l + (32 * s + 8 * g + tq) * VST + 32 * w + 16 * nb + 4 * tp; vf[s][nb] = cat8(trrd(pp), trrd(pp + 4 * VST)); }
        if (FULL) {
#pragma unroll
            for (int i = 0; i < 4; ++i)
#pragma unroll
                for (int s = 0; s < 2; ++s) { const bf16x8 a = *(const LAS bf16x8*)(p_l + (16 * i + fr) * PST + 32 * s + 8 * g);
                    o[i][0] = __builtin_amdgcn_mfma_f32_16x16x32_bf16(a, vf[s][0], o[i][0], 0, 0, 0); o[i][1] = __builtin_amdgcn_mfma_f32_16x16x32_bf16(a, vf[s][1], o[i][1], 0, 0, 0); }
#pragma unroll
            for (int s = 0; s < 4; ++s) {
                bf16x8 bS[2];
#pragma unroll
                for (int nb = 0; nb < 2; ++nb) { u32x4 wv; wv.x = cvt_pk_bf16(S[2 * s][nb][0], S[2 * s][nb][1]); wv.y = cvt_pk_bf16(S[2 * s][nb][2], S[2 * s][nb][3]);
                    wv.z = cvt_pk_bf16(S[2 * s + 1][nb][0], S[2 * s + 1][nb][1]); wv.w = cvt_pk_bf16(S[2 * s + 1][nb][2], S[2 * s + 1][nb][3]); bS[nb] = __builtin_bit_cast(bf16x8, wv); }
#pragma unroll
                for (int i = 0; i < 4; ++i) { const LAS bf16_t* qp = qs_l + (16 * i + fr) * QST + 32 * s + 4 * g;
                    const s16x4 lo = *(const LAS s16x4*)qp, hi = *(const LAS s16x4*)(qp + 16); const bf16x8 a = cat8(lo, hi);
                    o[i][0] = __builtin_amdgcn_mfma_f32_16x16x32_bf16(a, bS[0], o[i][0], 0, 0, 0); o[i][1] = __builtin_amdgcn_mfma_f32_16x16x32_bf16(a, bS[1], o[i][1], 0, 0, 0); }
            }
        }
#pragma unroll
        for (int db = 0; db < 8; ++db) { S[db][0] = S[db][0] * gL; S[db][1] = S[db][1] * gL; }
#pragma unroll
        for (int s = 0; s < 2; ++s)
#pragma unroll
            for (int db = 0; db < 8; ++db) { const LAS bf16_t* pp = kd_l + (32 * s + 8 * g + tq) * KDST + 16 * db + 4 * tp; const bf16x8 a = cat8(trrd(pp), trrd(pp + 4 * KDST));
                S[db][0] = __builtin_amdgcn_mfma_f32_16x16x32_bf16(a, vf[s][0], S[db][0], 0, 0, 0); S[db][1] = __builtin_amdgcn_mfma_f32_16x16x32_bf16(a, vf[s][1], S[db][1], 0, 0, 0); }
        if (FULL) {
#pragma unroll
            for (int i = 0; i < 4; ++i)
#pragma unroll
                for (int r = 0; r < 4; ++r) { float sm = o[i][0][r] + o[i][1][r], sq = o[i][0][r] * o[i][0][r] + o[i][1][r] * o[i][1][r];
                    sm = row16_sum(sm); sq = row16_sum(sq);
                    if (fr == 0) { LAS float* d = st_l + ((16 * i + 4 * g + r) * 8 + w) * 2; d[0] = sm; d[1] = sq; } }
            __syncthreads();
#pragma unroll
            for (int i = 0; i < 4; ++i)
#pragma unroll
                for (int r = 0; r < 4; ++r) { const int tok = 16 * i + 4 * g + r;
                    const LAS f32x4* d = (const LAS f32x4*)(st_l + tok * 16); const f32x4 a0 = d[0], a1 = d[1], a2 = d[2], a3 = d[3];
                    const float sm = (a0[0] + a0[2]) + (a1[0] + a1[2]) + (a2[0] + a2[2]) + (a3[0] + a3[2]), sq = (a0[1] + a0[3]) + (a1[1] + a1[3]) + (a2[1] + a2[3]) + (a3[1] + a3[3]);
                    const float mu = sm * (1.f / 256.f), var = fmaxf(sq * (1.f / 256.f) - mu * mu, 0.f), rstd = rsqrtf(var + EPS);
#pragma unroll
                    for (int nb = 0; nb < 2; ++nb) { LAS bf16_t* ge = g_l + tok * VST + 32 * w + 16 * nb + fr; *ge = f2bf((o[i][nb][r] - mu) * rstd * gr[nb] * bf2f(*ge)); } }
            __syncthreads();
#pragma unroll
            for (int it = 0; it < 4; ++it) { const int idx = tid + 512 * it, tok = idx >> 5, c8 = idx & 31;
                if (tok < L) *(u32x4*)(RET + (r0 + tok) * 1024 + h * 256 + c8 * 8) = *(const LAS u32x4*)(g_l + tok * VST + c8 * 8); }
        }
    }
    if (Sout) {
#pragma unroll
        for (int db = 0; db < 8; ++db)
#pragma unroll
            for (int nb = 0; nb < 2; ++nb) { int so = (16 * db + 4 * g) * RET_DV + 32 * w + 16 * nb + fr; asm volatile("" : "+v"(so));
#pragma unroll
                for (int r = 0; r < 4; ++r) Sout[so + r * RET_DV] = S[db][nb][r]; }
    }
}
}
__device__ __forceinline__ void r1_states(Frame& F) {
    const int bh = F.vcu >> 5, sc = F.vcu & 31, b = bh >> 2, h = bh & 3;
    rt::ret_unit<false>(F, h, b * SEQ + sc * rt::SC_TOK, 4, 64, nullptr, F.out + ((size_t)bh * rt::NSC + sc) * 32768, nullptr);
}
__device__ __forceinline__ void r2_scan(Frame& F) {
    if (F.vcu < DEC_BATCH * RET_H) { const int sb = F.vcu >> 2, sh = F.vcu & 3;
        rt::ret_unit<true>(F, sh, MP + sb * DEC_SEQ, 1, DEC_SEQ, FIN(4) + (size_t)F.vcu * 32768, F.out + O_RETS + (size_t)F.vcu * 32768, FIN(16)); return; }
    float* U = F.out; const int gt = (F.vcu - DEC_BATCH * RET_H) * NTHR + F.tid;
    if (gt < MPAD) { const float* sq_ = (const float*)(F.ws + WS_SLOTQ) + (size_t)gt * 12; const float* sk_ = (const float*)(F.ws + WS_SLOTKV) + (size_t)gt * 8; float a = 0.f, b = 0.f;
#pragma unroll
        for (int i = 0; i < 12; ++i) a += sq_[i];
#pragma unroll
        for (int i = 0; i < 8; ++i) b += sk_[i];
        ((float*)(F.ws + WS_RSQ))[gt] = rsqrtf(a * (1.f / Q_LORA) + EPS); ((float*)(F.ws + WS_RSKV))[gt] = rsqrtf(b * (1.f / KV_LORA) + EPS); }
    for (int e = gt; e < 8 * 32768; e += (F.G - DEC_BATCH * RET_H) * NTHR) { const int bh = e >> 15, idx = e & 32767, h = bh & 3;
        const float g256 = exp2f(log2f(1.f - exp2f(-5.f - (float)h)) * 256.f);
        float u[32];
#pragma unroll
        for (int sc = 0; sc < 32; ++sc) u[sc] = U[((size_t)bh * 32 + sc) * 32768 + idx];
        float carry = 0.f;
#pragma unroll
        for (int sc = 0; sc < 32; ++sc) { U[((size_t)bh * 32 + sc) * 32768 + idx] = carry; carry = g256 * carry + u[sc]; }
        F.out[O_RETP + (size_t)bh * 32768 + idx] = carry; }
}
__device__ __forceinline__ void r3_outputs(Frame& F) {
    const int bh = F.vcu >> 5, sc = F.vcu & 31, b = bh >> 2, h = bh & 3;
    rt::ret_unit<true>(F, h, b * SEQ + sc * rt::SC_TOK, 4, 64, F.out + ((size_t)bh * rt::NSC + sc) * 32768, nullptr, FIN(16));
}

namespace at {
typedef float f32x16 __attribute__((ext_vector_type(16)));
typedef short s16x4 __attribute__((ext_vector_type(4)));
constexpr int KN_ST = 272, KP_ST = 144;
constexpr int KN_B = 64 * KN_ST, KP_B = 64 * KP_ST, V_B = 16384, BUF_B = KN_B + KP_B + V_B;
constexpr int SCR_OFF = 2 * BUF_B;
constexpr float THR = 8.f;
__device__ __forceinline__ int v_st(int k, int c) { const int kk = (k & ~0xC) | ((k & 4) << 1) | ((k & 8) >> 1); return ((kk >> 3) * 4 + (c >> 5)) * 512 + ((kk & 7) * 32 + (c & 31)) * 2; }
__device__ __forceinline__ int v_rd_base(int lane) { return ((lane & 3) << 3) | (((lane >> 2) & 3) << 6) | (((lane >> 4) & 1) << 5) | (((lane >> 5) & 1) << 8); }
constexpr int v_rd_off(int d0, int ks, int half) { return d0 * 512 + ks * 4096 + half * 2048; }
__device__ __forceinline__ int crow(int r, int hi) { return (r & 3) + 8 * (r >> 2) + 4 * hi; }
#define AT_SBAR() __builtin_amdgcn_sched_barrier(0)

__device__ __forceinline__ void qkt(f32x16& p0, f32x16& p1, const LAS unsigned char* kn, const LAS unsigned char* kp, const bf16x8* qr) {
    p0 = f32x16{}; p1 = f32x16{};
#pragma unroll
    for (int d0 = 0; d0 < 8; ++d0) { const bf16x8 a0 = *(const LAS bf16x8*)(kn + d0 * 32), a1 = *(const LAS bf16x8*)(kn + d0 * 32 + 32 * KN_ST);
        p0 = __builtin_amdgcn_mfma_f32_32x32x16_bf16(a0, qr[d0], p0, 0, 0, 0); p1 = __builtin_amdgcn_mfma_f32_32x32x16_bf16(a1, qr[d0], p1, 0, 0, 0); }
#pragma unroll
    for (int d0 = 0; d0 < 4; ++d0) { const bf16x8 a0 = *(const LAS bf16x8*)(kp + d0 * 32), a1 = *(const LAS bf16x8*)(kp + d0 * 32 + 32 * KP_ST);
        p0 = __builtin_amdgcn_mfma_f32_32x32x16_bf16(a0, qr[8 + d0], p0, 0, 0, 0); p1 = __builtin_amdgcn_mfma_f32_32x32x16_bf16(a1, qr[8 + d0], p1, 0, 0, 0); }
}
__device__ __forceinline__ void pv_tile(f32x16* o, int vb0, bf16x8 pa0, bf16x8 pa1, bf16x8 pa2, bf16x8 pa3) {
#define AT_TRRD(dst, off) asm volatile("ds_read_b64_tr_b16 %0, %1 offset:%2" : "=&v"(dst) : "v"(vb0), "i"(off) : "memory")
#define AT_PV_D0(d0) do { s16x4 l0, l1, l2, l3, h0, h1, h2, h3; constexpr int b_ = v_rd_off(d0, 0, 0);   \
        AT_TRRD(l0, b_); AT_TRRD(h0, b_ + 2048); AT_TRRD(l1, b_ + 4096); AT_TRRD(h1, b_ + 6144); AT_TRRD(l2, b_ + 8192); AT_TRRD(h2, b_ + 10240); AT_TRRD(l3, b_ + 12288); AT_TRRD(h3, b_ + 14336); \
        asm volatile("s_waitcnt lgkmcnt(0)" ::: "memory"); AT_SBAR();   \
        o[d0] = __builtin_amdgcn_mfma_f32_32x32x16_bf16(pa0, (bf16x8){l0[0], l0[1], l0[2], l0[3], h0[0], h0[1], h0[2], h0[3]}, o[d0], 0, 0, 0);   \
        o[d0] = __builtin_amdgcn_mfma_f32_32x32x16_bf16(pa1, (bf16x8){l1[0], l1[1], l1[2], l1[3], h1[0], h1[1], h1[2], h1[3]}, o[d0], 0, 0, 0);   \
        o[d0] = __builtin_amdgcn_mfma_f32_32x32x16_bf16(pa2, (bf16x8){l2[0], l2[1], l2[2], l2[3], h2[0], h2[1], h2[2], h2[3]}, o[d0], 0, 0, 0);   \
        o[d0] = __builtin_amdgcn_mfma_f32_32x32x16_bf16(pa3, (bf16x8){l3[0], l3[1], l3[2], l3[3], h3[0], h3[1], h3[2], h3[3]}, o[d0], 0, 0, 0); } while (0)
    AT_PV_D0(0); AT_PV_D0(1); AT_PV_D0(2); AT_PV_D0(3);
#undef AT_PV_D0
#undef AT_TRRD
}
template <bool PARTIAL>
__device__ __forceinline__ void attn_unit(LAS unsigned char* lds, const bf16_t* Qw, const bf16_t* KN, const bf16_t* KPE, const bf16_t* V, bf16_t* Ow, float* Pw, int NT, int tmax_w, int nkeys, int orows, int t0, int tstride) {
    const int tid = threadIdx.x, wid = __builtin_amdgcn_readfirstlane(tid >> 6), lane = tid & 63, r32 = lane & 31, hi = lane >> 5;
    bf16x8 qr[12];
#pragma unroll
    for (int d0 = 0; d0 < 12; ++d0) qr[d0] = *(const bf16x8*)(Qw + (size_t)r32 * 1536 + d0 * 16 + hi * 8);
    const int sr = tid >> 4, sc = (tid & 15) * 8, pr = tid >> 3, pc = (tid & 7) * 8;
    const int kn_w0 = sr * KN_ST + sc * 2, kn_w1 = (32 + sr) * KN_ST + sc * 2, kp_w = KN_B + pr * KP_ST + pc * 2, v_w0 = KN_B + KP_B + v_st(sr, sc), v_w1 = KN_B + KP_B + v_st(32 + sr, sc);
    const int kn_r = r32 * KN_ST + hi * 16, kp_r = KN_B + r32 * KP_ST + hi * 16;
    const int vb_base = (int)(unsigned)(uintptr_t)(lds + KN_B + KP_B) + v_rd_base(lane);
    LAS float* scr = (LAS float*)(lds + SCR_OFF) + wid * 64;
    float m_reg = -1e30f, l_reg = 0.f; f32x16 o[4] = {};
    u32x4 st_kn0, st_kn1, st_kp, st_v0, st_v1;
#define AT_LOAD(t) do { const size_t k0_ = (size_t)(t0 + (t) * tstride) * 64; const bool v0_ = (int)k0_ + sr < nkeys, v1_ = (int)k0_ + 32 + sr < nkeys, vp_ = (int)k0_ + pr < nkeys; const u32x4 z_ = {0u, 0u, 0u, 0u}; \
        st_kn0 = v0_ ? *(const u32x4*)(KN + (k0_ + sr) * 1024 + sc) : z_; st_kn1 = v1_ ? *(const u32x4*)(KN + (k0_ + 32 + sr) * 1024 + sc) : z_; \
        st_v0 = v0_ ? *(const u32x4*)(V + (k0_ + sr) * 1024 + sc) : z_; st_v1 = v1_ ? *(const u32x4*)(V + (k0_ + 32 + sr) * 1024 + sc) : z_; \
        st_kp = vp_ ? *(const u32x4*)(KPE + (k0_ + pr) * 64 + pc) : z_; } while (0)
#define AT_WRITE(bf) do { LAS unsigned char* b_ = lds + (bf) * BUF_B; *(LAS u32x4*)(b_ + kn_w0) = st_kn0; *(LAS u32x4*)(b_ + kn_w1) = st_kn1; *(LAS u32x4*)(b_ + kp_w) = st_kp; \
        *(LAS u32x4*)(b_ + v_w0) = st_v0; *(LAS u32x4*)(b_ + v_w1) = st_v1; } while (0)
    AT_LOAD(0); AT_WRITE(0);
    __syncthreads();
    for (int t = 0; t < NT; ++t) {
        const int bf = t & 1;
        if (t + 1 < NT) AT_LOAD(t + 1);
        if (t <= tmax_w) {
            f32x16 p0, p1;
            const LAS unsigned char* bb = lds + bf * BUF_B;
            qkt(p0, p1, bb + kn_r, bb + kp_r, qr);
            if ((t0 + t * tstride + 1) * 64 > nkeys) {
                const int kb = (t0 + t * tstride) * 64 + 4 * hi;
#pragma unroll
                for (int r = 0; r < 16; ++r) { const int kv = kb + (r & 3) + 8 * (r >> 2); if (kv >= nkeys) p0[r] = -INFINITY; if (kv + 32 >= nkeys) p1[r] = -INFINITY; } }
            float pmax = p0[0];
#pragma unroll
            for (int r = 1; r < 16; ++r) pmax = fmaxf(pmax, p0[r]);
#pragma unroll
            for (int r = 0; r < 16; ++r) pmax = fmaxf(pmax, p1[r]);
            { auto rr = __builtin_amdgcn_permlane32_swap(__float_as_uint(pmax), __float_as_uint(pmax), false, false); pmax = fmaxf(__uint_as_float(rr[0]), __uint_as_float(rr[1])); }
            float alpha = 1.f; bool resc = false;
            if (!__all(pmax - m_reg <= THR)) { const float mn = fmaxf(m_reg, pmax); alpha = __builtin_amdgcn_exp2f(m_reg - mn); m_reg = mn; resc = true; }
#pragma unroll
            for (int r = 0; r < 16; ++r) { p0[r] = __builtin_amdgcn_exp2f(p0[r] - m_reg); p1[r] = __builtin_amdgcn_exp2f(p1[r] - m_reg); }
            float ps = 0.f;
#pragma unroll
            for (int r = 0; r < 16; ++r) ps += p0[r] + p1[r];
            { auto rr = __builtin_amdgcn_permlane32_swap(__float_as_uint(ps), __float_as_uint(ps), false, false); ps = __uint_as_float(rr[0]) + __uint_as_float(rr[1]); }
            l_reg = l_reg * alpha + ps;
            bf16x8 pa0, pa1, pa2, pa3;
#define AT_PK4(P, B_, OUT) do { unsigned a0 = cvt_pk_bf16(P[B_ + 0], P[B_ + 1]), a1 = cvt_pk_bf16(P[B_ + 2], P[B_ + 3]); unsigned b0 = cvt_pk_bf16(P[B_ + 4], P[B_ + 5]), b1 = cvt_pk_bf16(P[B_ + 6], P[B_ + 7]); \
        auto r0 = __builtin_amdgcn_permlane32_swap(a0, b0, false, false); auto r1 = __builtin_amdgcn_permlane32_swap(a1, b1, false, false); \
        u32x4 w_ = {r0[0], r1[0], r0[1], r1[1]}; OUT = __builtin_bit_cast(bf16x8, w_); } while (0)
            AT_PK4(p0, 0, pa0); AT_PK4(p0, 8, pa1); AT_PK4(p1, 0, pa2); AT_PK4(p1, 8, pa3);
#undef AT_PK4
            if (resc) { if (hi == 0) scr[r32] = alpha; asm volatile("s_waitcnt lgkmcnt(0)" ::: "memory");
#pragma unroll
                for (int d_ = 0; d_ < 4; ++d_)
#pragma unroll
                    for (int r = 0; r < 16; ++r) o[d_][r] *= scr[crow(r, hi)]; }
            AT_SBAR();
            pv_tile(o, vb_base + bf * BUF_B, pa0, pa1, pa2, pa3);
        }
        if (t + 1 < NT) AT_WRITE(bf ^ 1);
        __syncthreads();
    }
    if (PARTIAL) {
        if (wid == 0) {
#pragma unroll
            for (int r = 0; r < 16; ++r) { const int orow = crow(r, hi); if (orow < orows) {
#pragma unroll
                for (int d0 = 0; d0 < 4; ++d0) Pw[orow * 132 + d0 * 32 + r32] = o[d0][r]; } }
            if (hi == 0 && r32 < orows) { Pw[r32 * 132 + 128] = m_reg; Pw[r32 * 132 + 129] = l_reg; } }
        __syncthreads();
        return;
    }
    if (hi == 0) scr[32 + r32] = l_reg; asm volatile("s_waitcnt lgkmcnt(0)" ::: "memory");
#pragma unroll
    for (int r = 0; r < 16; ++r) { const int orow = crow(r, hi); const float rl = __builtin_amdgcn_rcpf(scr[32 + orow]);
#pragma unroll
        for (int d0 = 0; d0 < 4; ++d0) { const float v = o[d0][r] * rl; const float vn = __shfl_xor(v, 1);
            if ((r32 & 1) == 0 && orow < orows) *(unsigned*)(Ow + (size_t)orow * 1024 + d0 * 32 + r32) = cvt_pk_bf16(v, vn); } }
    __syncthreads();
#undef AT_LOAD
#undef AT_WRITE
}
#undef AT_SBAR
}
__device__ __forceinline__ void p3_attn_prompt(Frame& F) {
    const int bh = F.vcu >> 4, s = F.vcu & 15, b = bh >> 3, h = bh & 7;
    const bf16_t* Q = (const bf16_t*)F.out; const bf16_t* KN = (const bf16_t*)(F.ws + WS_KN); const bf16_t* KPE = (const bf16_t*)(F.ws + WS_KPE); const bf16_t* V = (const bf16_t*)(F.ws + WS_V); bf16_t* ATT = (bf16_t*)(F.ws + WS_ATT);
#pragma unroll 1
    for (int it = 0; it < 2; ++it) { const int qb = it == 0 ? s : 31 - s; const size_t row0 = (size_t)b * SEQ + (size_t)qb * 256 + F.wave * 32;
        at::attn_unit<false>(F.lds, Q + row0 * 1536 + h * 192, KN + (size_t)b * SEQ * 1024 + h * 128, KPE + (size_t)b * SEQ * 64, V + (size_t)b * SEQ * 1024 + h * 128,
                      ATT + row0 * 1024 + h * 128, nullptr, 4 * qb + 4, 4 * qb + (F.wave >> 1), 1 << 30, 32, 0, 1); }
}
__device__ __forceinline__ void xn_rows(Frame& F, bf16_t* XN, int gw, int NGW) {
    for (int r = gw; r < MPAD; r += NGW) {
        u32x2* o8 = (u32x2*)(XN + (size_t)r * D_MODEL) + F.lane;
        if (r >= MT) { for (int jj = 0; jj < 4; ++jj) o8[64 * jj] = (u32x2){0u, 0u}; continue; }
        const float* x = r < MP ? FIN(0) + (size_t)r * D_MODEL : FIN(1) + (size_t)(r - MP) * D_MODEL;
        const f32x4* xr = (const f32x4*)x + F.lane; f32x4 v[4]; float s = 0.f;
#pragma unroll
        for (int jj = 0; jj < 4; ++jj) { v[jj] = xr[64 * jj]; s += (v[jj][0] * v[jj][0] + v[jj][1] * v[jj][1]) + (v[jj][2] * v[jj][2] + v[jj][3] * v[jj][3]); }
        const float inv = rsqrtf(fwave_sum(s) * (1.f / D_MODEL) + EPS);
#pragma unroll
        for (int jj = 0; jj < 4; ++jj) { u32x2 w; w.x = cvt_pk_bf16(v[jj][0] * inv, v[jj][1] * inv); w.y = cvt_pk_bf16(v[jj][2] * inv, v[jj][3] * inv); o8[64 * jj] = w; }
    }
}
constexpr size_t WS_PART = WS_ATTS + 512 * KiB;
__device__ __forceinline__ void p3_attn_sample(Frame& F) {
    {   const int bh = F.vcu >> 2, part = F.vcu & 3, b = bh >> 3, h = bh & 7;
        const bf16_t* Q = (const bf16_t*)F.out; const bf16_t* KN = (const bf16_t*)(F.ws + WS_KN); const bf16_t* PES = (const bf16_t*)(F.ws + WS_PES); const bf16_t* V = (const bf16_t*)(F.ws + WS_V);
        const size_t row0 = (size_t)MP + (size_t)b * DEC_SEQ;
        at::attn_unit<true>(F.lds, Q + row0 * 1536 + h * 192, KN + (size_t)b * SKEYS * 1024 + h * 128, PES + (size_t)b * SKEYS * 64, V + (size_t)b * SKEYS * 1024 + h * 128,
                            nullptr, (float*)(F.ws + WS_PART) + (size_t)F.vcu * 16 * 132, part == 0 ? 9 : 8, F.wave == 0 ? 1000 : -1, SKEYS, DEC_SEQ, part, 4); }
}
__device__ __forceinline__ void p5_side(Frame& F) {
    if (F.j < 2) return;
    const int q = F.x * 30 + (F.j - 2);
    {   LAS float* scr = (LAS float*)(F.lds + F.wave * 16384);
        p0_all_weights(F, scr, q * 8 + F.wave, 240 * 8, 6144, 8960);
        p0_all_weights(F, scr, q * 8 + F.wave, 240 * 8, 8960, 10368); }
    {   const int gw = q * 8 + F.wave, NGW = 240 * 8; const bf16_t* KVL = (const bf16_t*)(F.ws + WS_KVL); const float* slotkv = (const float*)(F.ws + WS_SLOTKV);
        for (int r = gw; r < MT; r += NGW) { const float s = ((const float*)(F.ws + WS_RSKV))[r];
            float* o = r < MP ? F.out + O_LATP + (size_t)r * KV_LORA : F.out + O_LATS + (size_t)(r - MP) * KV_LORA;
            const u32x4 w = *((const u32x4*)(KVL + (size_t)r * KV_LORA) + F.lane);
            f32x4 a = {__uint_as_float(w.x << 16), __uint_as_float(w.x & 0xffff0000u), __uint_as_float(w.y << 16), __uint_as_float(w.y & 0xffff0000u)};
            f32x4 c = {__uint_as_float(w.z << 16), __uint_as_float(w.z & 0xffff0000u), __uint_as_float(w.w << 16), __uint_as_float(w.w & 0xffff0000u)};
            __builtin_nontemporal_store(a * s, (f32x4*)o + 2 * F.lane); __builtin_nontemporal_store(c * s, (f32x4*)o + 2 * F.lane + 1); } }
}
__device__ __forceinline__ void attn_sample_combine(Frame& F) {
    if (F.vcu >= DEC_BATCH * HEADS) return;
    const int b = F.vcu >> 3, h = F.vcu & 7; const float* P = (const float*)(F.ws + WS_PART) + (size_t)F.vcu * 4 * 16 * 132; bf16_t* ATTS = (bf16_t*)(F.ws + WS_ATTS);
    for (int e = F.tid; e < 16 * 128; e += NTHR) { const int q = e >> 7, d = e & 127;
        float m[4], M = -1e30f;
#pragma unroll
        for (int p = 0; p < 4; ++p) { m[p] = P[(p * 16 + q) * 132 + 128]; M = fmaxf(M, m[p]); }
        float num = 0.f, den = 0.f;
#pragma unroll
        for (int p = 0; p < 4; ++p) { const float w = exp2f(m[p] - M); num += w * P[(p * 16 + q) * 132 + d]; den += w * P[(p * 16 + q) * 132 + 129]; }
        ATTS[(size_t)(b * DEC_SEQ + q) * 1024 + h * 128 + d] = f2bf(num / den); }
}
__device__ __forceinline__ void unpack8(const u32x4 w, float* f) {
    f[0] = __uint_as_float(w.x << 16); f[1] = __uint_as_float(w.x & 0xffff0000u); f[2] = __uint_as_float(w.y << 16); f[3] = __uint_as_float(w.y & 0xffff0000u);
    f[4] = __uint_as_float(w.z << 16); f[5] = __uint_as_float(w.z & 0xffff0000u); f[6] = __uint_as_float(w.w << 16); f[7] = __uint_as_float(w.w & 0xffff0000u);
}
template <int STEPS>
__device__ __forceinline__ void conv_thread(Frame& F, bool on, int r0, int n, int hist, int hch) {
    bf16_t* UG = (bf16_t*)(F.ws + WS_UG); const bf16_t* UV = (const bf16_t*)(F.ws + WS_UV); const float* cw = FIN(21); const float* cb = FIN(22);
    const int nv = n + D_FF;
    float wg[3][8], wv[3][8], bg[8], bv[8], g2[8], g1[8], v2[8], v1[8];
    u32x4 rg[8], rv[8];
#pragma unroll
    for (int e = 0; e < 8; ++e) { g2[e] = 0.f; g1[e] = 0.f; v2[e] = 0.f; v1[e] = 0.f; }
    if (on) {
#pragma unroll
        for (int i = 0; i < 8; ++i) { rg[i] = *(const u32x4*)(UG + (size_t)(r0 + i) * D_FF + n); rv[i] = *(const u32x4*)(UV + (size_t)(r0 + i) * D_FF + n); }
#pragma unroll
        for (int k = 0; k < 3; ++k) { const f32x4 a0 = *(const f32x4*)(cw + k * FF2 + n), a1 = *(const f32x4*)(cw + k * FF2 + n + 4), c0 = *(const f32x4*)(cw + k * FF2 + nv), c1 = *(const f32x4*)(cw + k * FF2 + nv + 4);
#pragma unroll
            for (int e = 0; e < 4; ++e) { wg[k][e] = a0[e]; wg[k][4 + e] = a1[e]; wv[k][e] = c0[e]; wv[k][4 + e] = c1[e]; } }
        { const f32x4 a0 = *(const f32x4*)(cb + n), a1 = *(const f32x4*)(cb + n + 4), c0 = *(const f32x4*)(cb + nv), c1 = *(const f32x4*)(cb + nv + 4);
#pragma unroll
          for (int e = 0; e < 4; ++e) { bg[e] = a0[e]; bg[4 + e] = a1[e]; bv[e] = c0[e]; bv[4 + e] = c1[e]; } }
        if (hist == 1) { unpack8(*(const u32x4*)(UG + (size_t)(r0 - 2) * D_FF + n), g2); unpack8(*(const u32x4*)(UG + (size_t)(r0 - 1) * D_FF + n), g1); unpack8(*(const u32x4*)(UV + (size_t)(r0 - 2) * D_FF + n), v2); unpack8(*(const u32x4*)(UV + (size_t)(r0 - 1) * D_FF + n), v1); }
        else if (hist == 2) { const bf16_t* hp = (const bf16_t*)(F.ws + WS_HALO) + (size_t)hch * 2 * FF2; unpack8(*(const u32x4*)(hp + n), g2); unpack8(*(const u32x4*)(hp + FF2 + n), g1); unpack8(*(const u32x4*)(hp + nv), v2); unpack8(*(const u32x4*)(hp + FF2 + nv), v1); }
        else if (hist == 3) { const float* pp = FIN(5) + (size_t)hch * 2 * FF2;
#pragma unroll
            for (int e = 0; e < 8; ++e) { g2[e] = pp[n + e]; g1[e] = pp[FF2 + n + e]; v2[e] = pp[nv + e]; v1[e] = pp[FF2 + nv + e]; } }
    }
    __syncthreads();
    if (on) {
#pragma unroll
        for (int s = 0; s < STEPS; ++s) {
#pragma unroll
            for (int i = 0; i < 8; ++i) { float g0[8], v0[8], h[8]; unpack8(rg[i], g0); unpack8(rv[i], v0);
#pragma unroll
                for (int e = 0; e < 8; ++e) { const float cg = g2[e] * wg[0][e] + g1[e] * wg[1][e] + g0[e] * wg[2][e] + bg[e], cv = v2[e] * wv[0][e] + v1[e] * wv[1][e] + v0[e] * wv[2][e] + bv[e];
                    h[e] = cg * __builtin_amdgcn_rcpf(1.f + __expf(-cg)) * cv; g2[e] = g1[e]; g1[e] = g0[e]; v2[e] = v1[e]; v1[e] = v0[e]; }
                u32x4 w; w.x = cvt_pk_bf16(h[0], h[1]); w.y = cvt_pk_bf16(h[2], h[3]); w.z = cvt_pk_bf16(h[4], h[5]); w.w = cvt_pk_bf16(h[6], h[7]);
                *(u32x4*)(UG + (size_t)(r0 + 8 * s + i) * D_FF + n) = w; }
            if (s + 1 < STEPS) {
#pragma unroll
                for (int i = 0; i < 8; ++i) { rg[i] = *(const u32x4*)(UG + (size_t)(r0 + 8 * (s + 1) + i) * D_FF + n); rv[i] = *(const u32x4*)(UV + (size_t)(r0 + 8 * (s + 1) + i) * D_FF + n); } }
        }
    }
}
namespace sk {
__device__ __forceinline__ int wrow(int c) { const int c5 = c & 31; return (c & ~31) + 16 * ((c5 >> 2) & 1) + 4 * (c5 >> 3) + (c5 & 3); }
template <int NB>
__device__ __forceinline__ f32x4 mm(LAS unsigned char* lds, const bf16_t* __restrict__ A, size_t lda, const bf16_t* __restrict__ Bp, int K, int w, int lane) {
    const int fr = lane & 15, g = lane >> 4, ksteps = K >> 5;
    f32x4 acc[NB];
#pragma unroll
    for (int b = 0; b < NB; ++b) acc[b] = (f32x4){0.f, 0.f, 0.f, 0.f};
    const bf16_t* Ap = A + (size_t)fr * lda + 8 * g;
    for (int s0 = w; s0 < ksteps; s0 += 32) {
        bf16x8 bq[4], aq[4][NB];
#pragma unroll
        for (int q = 0; q < 4; ++q) { const int s = s0 + 8 * q; const bool ok = s < ksteps; const bf16x8 z = {0, 0, 0, 0, 0, 0, 0, 0};
            bq[q] = ok ? *(const bf16x8*)(Bp + 32 * s) : z;
#pragma unroll
            for (int b = 0; b < NB; ++b) aq[q][b] = ok ? *(const bf16x8*)(Ap + (size_t)(16 * b) * lda + 32 * s) : z; }
#pragma unroll
        for (int q = 0; q < 4; ++q)
#pragma unroll
            for (int b = 0; b < NB; ++b) acc[b] = __builtin_amdgcn_mfma_f32_16x16x32_bf16(aq[q][b], bq[q], acc[b], 0, 0, 0);
    }
    LAS f32x4* red = (LAS f32x4*)lds;
#pragma unroll
    for (int b = 0; b < NB; ++b) red[(w * NB + b) * 64 + lane] = acc[b];
    __syncthreads();
    f32x4 r = {0.f, 0.f, 0.f, 0.f};
    if (w < NB) { r = red[w * 64 + lane];
#pragma unroll
        for (int ww = 1; ww < 8; ++ww) r = r + red[(ww * NB + w) * 64 + lane]; }
    __syncthreads();
    return r;
}
}
__device__ __forceinline__ void sk_merge(Frame& F, int su, int b0) {
    const int lane_ = (int)(threadIdx.x & 63), w = __builtin_amdgcn_readfirstlane((int)(threadIdx.x >> 6)), fr = lane_ & 15, g = lane_ >> 4, c = 16 * su + fr, wr_ = sk::wrow(c);
    const bf16_t* ATTS = (const bf16_t*)(F.ws + WS_ATTS) + (size_t)(16 * b0) * 1024; const bf16_t* RET = (const bf16_t*)(F.ws + WS_RET) + (size_t)(MP + 16 * b0) * 1024;
    const f32x4 aA = sk::mm<4>(F.lds, ATTS, 1024, (const bf16_t*)(F.ws + WS_FWOBA) + (size_t)wr_ * 1024 + 8 * g, 1024, w, lane_);
    const f32x4 aR = sk::mm<4>(F.lds, RET, 1024, (const bf16_t*)(F.ws + WS_FWOBB) + (size_t)wr_ * 1024 + 8 * g, 1024, w, lane_);
    const bf16_t* gas_ = (const bf16_t*)(F.ws + WS_GAS); const bf16_t* gbs_ = (const bf16_t*)(F.ws + WS_GBS); bf16_t* MG = (bf16_t*)(F.ws + WS_MERGED) + (size_t)MP * 1024;
    if (w < 4) {
#pragma unroll
        for (int r = 0; r < 4; ++r) { const size_t i = (size_t)(16 * (b0 + w) + 4 * g + r) * 1024 + c; MG[i] = f2bf(bf2f(gas_[i]) * aA[r] + bf2f(gbs_[i]) * aR[r]); } }
}
__device__ __forceinline__ void sk_out(Frame& F, int su, int b0) {
    const int lane_ = (int)(threadIdx.x & 63), w = __builtin_amdgcn_readfirstlane((int)(threadIdx.x >> 6)), fr = lane_ & 15, g = lane_ >> 4, c = 16 * su + fr;
    const bf16_t* MG = (const bf16_t*)(F.ws + WS_MERGED) + (size_t)(MP + 16 * b0) * 1024;
    const f32x4 a = sk::mm<4>(F.lds, MG, 1024, (const bf16_t*)(F.ws + WS_FWOUT) + (size_t)sk::wrow(c) * 1024 + 8 * g, 1024, w, lane_);
    bf16_t* X1B = (bf16_t*)(F.ws + WS_X1B) + (size_t)MP * 1024; float* ssq = (float*)(F.ws + WS_SSQS); const float* xs = FIN(1);
    if (w < 4) {
#pragma unroll
        for (int r = 0; r < 4; ++r) { const int row = 16 * (b0 + w) + 4 * g + r; const size_t i = (size_t)row * 1024 + c; const float v = xs[i] + a[r];
            F.out[O_YS + i] = v; X1B[i] = f2bf(v); const float q = rt::row16_sum(v * v); if (fr == 0) atomicAdd(ssq + row, q); } }
}
__device__ __forceinline__ void sk_up(Frame& F, int su) {
    const int lane_ = (int)(threadIdx.x & 63), w = __builtin_amdgcn_readfirstlane((int)(threadIdx.x >> 6)), fr = lane_ & 15, g = lane_ >> 4, c = 16 * su + fr;
    const int cc = c < D_FF ? c : c - D_FF, drow = (cc >> 7) * 256 + (c < D_FF ? 0 : 128) + sk::wrow(cc & 127);
    const bf16_t* X1B = (const bf16_t*)(F.ws + WS_X1B) + (size_t)MP * 1024;
    const f32x4 a = sk::mm<8>(F.lds, X1B, 1024, (const bf16_t*)(F.ws + WS_FWUP) + (size_t)drow * 1024 + 8 * g, 1024, w, lane_);
    bf16_t* U = (c < D_FF ? (bf16_t*)(F.ws + WS_UG) : (bf16_t*)(F.ws + WS_UV)) + (size_t)MP * D_FF; const float* ssq = (const float*)(F.ws + WS_SSQS);
#pragma unroll
    for (int r = 0; r < 4; ++r) { const int row = 16 * w + 4 * g + r; const float u = a[r] * rsqrtf(ssq[row] * (1.f / D_MODEL) + EPS);
        U[(size_t)row * D_FF + cc] = f2bf(u); const int t = row & (DEC_SEQ - 1); if (t >= DEC_SEQ - 2) F.out[O_CONVS + ((size_t)(row >> 4) * 2 + (t - (DEC_SEQ - 2))) * FF2 + c] = u; }
}
__device__ __forceinline__ void sk_down(Frame& F, int su) {
    const int lane_ = (int)(threadIdx.x & 63), w = __builtin_amdgcn_readfirstlane((int)(threadIdx.x >> 6)), fr = lane_ & 15, g = lane_ >> 4, c = 16 * su + fr;
    const bf16_t* U = (const bf16_t*)(F.ws + WS_UG) + (size_t)MP * D_FF;
    const f32x4 a = sk::mm<8>(F.lds, U, D_FF, (const bf16_t*)(F.ws + WS_FWDOWN) + (size_t)sk::wrow(c) * D_FF + 8 * g, D_FF, w, lane_);
#pragma unroll
    for (int r = 0; r < 4; ++r) { const size_t i = (size_t)(16 * w + 4 * g + r) * 1024 + c; F.out[O_YS + i] += a[r]; }
}
#define STAMP_(k) probe_stamp(F, (k))
constexpr int CW_GRP = 4608;
constexpr int GW_P7D = 0, GW_G8 = 256, GW_C3 = 320, GW_C4 = 321, GW_XID = 322, GW_SKM = 64;
__device__ __forceinline__ unsigned* grp_word(Frame& F, int idx) { return (unsigned*)(F.ws + WS_CTL) + CW_GRP + 16 * idx; }
__device__ __forceinline__ void grp_arrive(Frame& F, int idx, bool local) {
    asm volatile("s_waitcnt vmcnt(0)" ::: "memory");
    __syncthreads();
    if (threadIdx.x == 0) { if (!local) { __builtin_amdgcn_fence(__ATOMIC_RELEASE, "agent"); asm volatile("s_waitcnt vmcnt(0)" ::: "memory"); } (void)xb_add(grp_word(F, idx), 1u); }
}
__device__ __forceinline__ void grp_wait(Frame& F, int idx, unsigned target, bool  ) {
    if (threadIdx.x == 0) { unsigned* bar = (unsigned*)(F.ws + WS_CTL) + CW_BAR; unsigned* w = grp_word(F, idx);
        XB_SPIN(xb_ld(w) < target, bar);
        __builtin_amdgcn_fence(__ATOMIC_ACQUIRE, "agent"); asm volatile("s_waitcnt vmcnt(0)" ::: "memory"); }
    __syncthreads();
}
__device__ __forceinline__ void s2_row_scales(Frame& F, int pm) {
    LAS unsigned char* lds = F.lds; const int t = (int)threadIdx.x;
    if (t < 256) { const int row = pm * 256 + t; float a = 0.f;
        if (row >= MP) a = ((const float*)(F.ws + WS_SSQS))[row < MT ? row - MP : 0];
        else { const float* slotx = (const float*)(F.ws + WS_SLOTX1);
#pragma unroll
            for (int i = 0; i < 16; i += 4) { const f32x4 v = *(const f32x4*)(slotx + (size_t)row * 16 + i); a += (v[0] + v[1]) + (v[2] + v[3]); } }
        *LDS_F(t) = rsqrtf(a * (1.f / D_MODEL) + EPS); }
    __syncthreads();
}
__device__ __forceinline__ void s2_chain(Frame& F) {
    const int r = F.j & 7, pm = 8 * F.x + r, q = F.j >> 3, cls = (q + F.j) & 3;
    const int sidx = r < 3 ? r * 8 + F.x : 1 << 20; const bool stype = sidx < 22;
    const int nun = stype ? (q < 3 ? 6 : 4) : (F.j < 16 ? 6 : 5);
#define S2_PN(i) (!stype || (i) < 4 ? q + 4 * (i) : (i) == 4 ? q + 16 : (q == 2 ? 19 : 20 + q))
    const int vprev = (F.j & 7) ? F.vcu - 1 : F.vcu - 32 + 7, vnext = (F.j & 7) != 7 ? F.vcu + 1 : F.vcu + 32 - 7;
    volatile LAS unsigned* MISC = (volatile LAS unsigned*)(F.lds + MISC_OFF);
    if (threadIdx.x < 8) {
        const int l = (int)threadIdx.x; const int v = l < 4 ? F.x * 32 + (F.j & 7) + 8 * l : l == 4 ? ((pm & 31) ? vprev : F.vcu) : l == 5 ? ((pm & 31) != 31 ? vnext : F.vcu) : F.vcu;
        const unsigned id = xb_ld(grp_word(F, GW_XID + v)), me = __shfl(id, 6);
        const unsigned same = (id == me && me != 0u) ? 1u : 0u; const unsigned long long bal = __ballot(same != 0u);
        if (l == 0) { MISC[20] = (bal & 0xFull) == 0xFull ? 1u : 0u; MISC[21] = (unsigned)((bal >> 4) & 1ull); MISC[22] = (unsigned)((bal >> 5) & 1ull); } }
    __syncthreads();
    const bool loc_grp = MISC[20] != 0u, loc_prev = MISC[21] != 0u, loc_next = MISC[22] != 0u;
    if (stype && q == 3) {
        s2_row_scales(F, 64);
        {   SchedP5 S{F.x, F.j, F.vcu, (const char*)F.ws, 7, -1, sidx, 0};
            EpiP5 E{F.ws, F.out, FIN(0), FIN(1), F.vcu};
            pg::gemm_stream(F.lds, S, E); }
        grp_arrive(F, GW_C3, false);
    }
    s2_row_scales(F, pm);
    int i0 = 0, ck = 0;
#pragma unroll 1
    while (i0 < nun) {
        int i1 = ck == 0 ? 2 + cls : nun; if (i1 > nun) i1 = nun;
        {   SchedP5 S{F.x, F.j, F.vcu, (const char*)F.ws, 7, i0, i1, stype ? 1 : 0};
            EpiP5 E{F.ws, F.out, FIN(0), FIN(1), F.vcu};
            pg::gemm_stream(F.lds, S, E); }
#pragma unroll 1
        for (int i = i0; i < i1; ++i) { int t = (int)threadIdx.x; asm volatile("" : "+v"(t)); const int seg = t >> 4; conv_thread<1>(F, seg != 0, pm * 256 + seg * 8, S2_PN(i) * 128 + (t & 15) * 8, 1, 0); }
        if (ck == 0 && F.j == 31 && F.x < 6) {
            grp_wait(F, GW_C3, 22u, false);
            int t = (int)threadIdx.x; asm volatile("" : "+v"(t)); const int it = F.x * 32 + (t >> 4), b = it / 22, pn = it - b * 22; const bool on = it < 8 * 22;
            conv_thread<2>(F, on, MP + (on ? b : 0) * DEC_SEQ, (on ? pn : 0) * 128 + (t & 15) * 8, 3, on ? b : 0);
            grp_arrive(F, GW_C4, false);
        }
        i0 = i1; ++ck;
    }
    if (r >= 3 && r < 7 && q >= 2) { grp_wait(F, GW_C4, 6u, false); sk_down(F, ((r - 3) * 2 + (q - 2)) * 8 + F.x); }
    STAMP_(12);
    grp_arrive(F, GW_P7D + pm, true);
    if (pm & 31) grp_wait(F, GW_P7D + pm - 1, 4u, loc_prev);
    {   int t = (int)threadIdx.x; asm volatile("" : "+v"(t)); const int ui = t >> 4; const bool on = ui < nun; const int uu = on ? ui : 0; conv_thread<1>(F, on, pm * 256, S2_PN(uu) * 128 + (t & 15) * 8, (pm & 31) ? 2 : 0, pm); }
    grp_arrive(F, GW_G8 + pm, loc_grp);
    grp_wait(F, GW_G8 + pm, 4u, loc_grp);
    STAMP_(13);
    p5_gemm(F, 9);
}
__global__ void __launch_bounds__(NTHR, 2) mk(const MArgs a) {
    extern __shared__ __attribute__((aligned(16))) unsigned char lds_raw[];
    Frame F;
    F.lds = (LAS unsigned char*)lds_raw;
    F.tid = threadIdx.x; F.lane = F.tid & 63; F.wave = __builtin_amdgcn_readfirstlane(F.tid >> 6);
    F.G = gridDim.x; F.x = blockIdx.x % 8; F.j = blockIdx.x / 8; F.vcu = F.x * (F.G / 8) + F.j;
    F.a = &a; F.out = a.out; F.ws = a.ws;
    volatile LAS unsigned* MISC = (volatile LAS unsigned*)(F.lds + MISC_OFF);
    if (F.tid < 32) MISC[F.tid] = 0u;
    __syncthreads();
    XcdBarrier bar = xcd_barrier_post((unsigned*)(a.ws + WS_CTL) + CW_BAR + a.li * XCD_BAR_WORDS, MISC + 8);
    const int lo = a.ph_lo, hi = a.ph_hi;
#define IN_(k) (lo <= (k) && (k) < hi)
#define SEAM_(k) do { if (IN_(k) && IN_((k) + 1)) xcd_barrier(bar); } while (0)
    STAMP_(0); if (IN_(0)) { if (F.tid == 0) (void)xb_add(grp_word(F, GW_XID + F.vcu), 1u + xb_xcc_id()); p0_prologue(F); } SEAM_(0);
    STAMP_(1); if (IN_(1)) { p1_late_prologue(F); __syncthreads(); p1_inproj(F); } SEAM_(1);
    STAMP_(2); if (IN_(2)) { r1_states(F); } SEAM_(2);
    STAMP_(3); if (IN_(3)) { r2_scan(F); } SEAM_(3);
    STAMP_(4); if (IN_(4)) { r3_outputs(F); } SEAM_(4);
    STAMP_(5); if (IN_(5)) { p2_qkv(F, 1); p5_side(F); } SEAM_(5);
    STAMP_(6); if (IN_(6)) { p3_attn_sample(F); } SEAM_(6);
    STAMP_(7); if (IN_(7)) { attn_sample_combine(F); p2_qkv(F, 0); } SEAM_(7);
    STAMP_(8); if (IN_(8)) { p3_attn_prompt(F); } SEAM_(8);
    STAMP_(9); if (IN_(9)) { if (F.vcu < 128) { sk_merge(F, F.vcu >> 1, (F.vcu & 1) * 4); grp_arrive(F, GW_SKM, false); } p5_gemm(F, 5); if (F.vcu >= 128) { grp_wait(F, GW_SKM, 128u, false); sk_out(F, (F.vcu - 128) >> 1, (F.vcu & 1) * 4); } } SEAM_(9);
    STAMP_(10); if (IN_(10)) { p5_gemm(F, 6); } SEAM_(10);
    STAMP_(11); if (IN_(11)) { s2_chain(F); }
    if (PROBE_LO >= 0) { __syncthreads(); STAMP_(14);
        if (blockIdx.x == PROBE_BLK && F.tid == 0) { const unsigned long long t_end = __builtin_amdgcn_s_memrealtime() + (unsigned long long)PROBE_MULT * ((((unsigned long long)MISC[19] << 32) | MISC[18]) - (((unsigned long long)MISC[17] << 32) | MISC[16]));
            while (__builtin_amdgcn_s_memrealtime() < t_end) __builtin_amdgcn_s_sleep(8); } }
}

extern "C" void kernel_launch(void* const* d_in, const int* in_sizes, int n_in, void* d_out, int out_size, void* d_ws, size_t ws_size, hipStream_t stream) {
    static int ok = 0;
    if (ok == 0) {
        ok = 1;
        if (ws_size < 256 * MiB || n_in != 24) { fprintf(stderr, "kernel_launch: bad ws/n_in: %zu %d\n", ws_size, n_in); ok = -1; }
        int dev = 0, cus = 0; (void)hipGetDevice(&dev); (void)hipDeviceGetAttribute(&cus, hipDeviceAttributeMultiprocessorCount, dev);
        if (cus != 256) { fprintf(stderr, "kernel_launch: built for 256 CUs, got %d\n", cus); ok = -1; }
        if (hipFuncSetAttribute((const void*)mk, hipFuncAttributeMaxDynamicSharedMemorySize, LDS_BYTES) != hipSuccess) { fprintf(stderr, "kernel_launch: hipFuncSetAttribute(mk) failed\n"); ok = -1; }
        (void)hipGetLastError();
    }
    if (ok < 0) return;
    (void)hipMemsetAsync((char*)d_ws + WS_CTL, 0, CTL_BYTES, stream);
    MArgs a{}; for (int i = 0; i < 24; ++i) a.in[i] = (const float*)d_in[i]; a.out = (float*)d_out; a.ws = (unsigned char*)d_ws; a.ph_lo = 0; a.ph_hi = 14; a.li = 0;
    hipLaunchKernelGGL(mk, dim3(256), dim3(NTHR), LDS_BYTES, stream, a);
}
```
